# Optimizing an MI355X kernel written in HIP

```python
import math
import jax, jax.numpy as jnp
from jax import lax
import numpy as np

D_MODEL = 1024
BATCH = 8
SEQ = 8192
DEPTH = 2

GRID_W = 64
CTX_LEN = 256
N_MIXERS = 2
N_RWKV = (DEPTH + N_MIXERS - 1) // N_MIXERS
N_MLA = DEPTH // N_MIXERS
NORM_EPS = 1e-6
RWKV_HEAD = 64
RWKV_HEADS = D_MODEL // RWKV_HEAD
DECAY_LORA = 64
ICLR_LORA = 64
GN_EPS = 64e-5
N_DIR = 2
MLA_HEADS = 16
QK_NOPE = 64
QK_ROPE = 32
V_HEAD = 64
Q_LORA = 384
KV_LORA = 256
MLA_GATE = MLA_HEADS * V_HEAD
MLA_IN = Q_LORA + KV_LORA + QK_ROPE + MLA_GATE
ROPE_THETA = 10000.0
Q_BLOCK = 128

kernel_name = 'hybrid_rwkv7_mla_dit_prefix'


def rmsnorm(x, g, eps=NORM_EPS):
    xf = x.astype(jnp.float32)
    y = xf * lax.rsqrt(jnp.mean(xf * xf, axis=-1, keepdims=True) + eps)
    return (y * g.astype(jnp.float32)).astype(x.dtype)


def centred_shift(h):
    prev = jnp.pad(h[:, :-1], ((0, 0), (1, 0), (0, 0)))
    nxt = jnp.pad(h[:, 1:], ((0, 0), (0, 1), (0, 0)))
    return 0.5 * (prev + nxt) - h


def rwkv_prepare(h, mu, w_in, w0, w1, w2, a0, a1, a2, k_k, k_a):
    B, T, D = h.shape
    xx = centred_shift(h)
    lerp = lambda j: h + xx * mu[j]
    heads = lambda t: t.reshape(t.shape[:-1] + (RWKV_HEADS, RWKV_HEAD))
    r = heads(lerp(0) @ w_in[0])
    k = heads(lerp(1) @ w_in[1])
    v = heads(lerp(2) @ w_in[2])
    gate = lerp(3) @ w_in[3]
    xw, xa = lerp(4), lerp(5)
    wpre = w0[:, None, None, :] + jnp.einsum('nbtr,nrd->nbtd', jnp.tanh(jnp.einsum('btd,ndr->nbtr', xw, w1)), w2)
    wpre = wpre.astype(jnp.float32)
    logw = heads(-jnp.exp(-jax.nn.softplus(-wpre) - 0.5))
    a = heads(jax.nn.sigmoid(a0[:, None, None, :] + jnp.einsum('nbtr,nrd->nbtd', jnp.einsum('btd,ndr->nbtr', xa, a1), a2)))
    kkf = (k * k_k.reshape(RWKV_HEADS, RWKV_HEAD)).astype(jnp.float32)
    kk = (kkf / jnp.maximum(jnp.linalg.norm(kkf, axis=-1, keepdims=True), 1e-12)).astype(h.dtype)
    k_dir = k[None] * (1.0 + (a - 1.0) * k_a.reshape(RWKV_HEADS, RWKV_HEAD))
    b = kk[None] * a
    return r, logw, k_dir, v, -kk, b, gate


def orient_shared(t):
    return jnp.stack([t, jnp.flip(t, 1)])


def orient_dir(t):
    return jnp.stack([t[0], jnp.flip(t[1], 1)])


def wkv_scan(r, logw, k, v, a, b, s0):
    tm = lambda t: jnp.moveaxis(t.astype(jnp.float32), 2, 0)

    def step(s, inp):
        r_t, lw_t, k_t, v_t, a_t, b_t = inp
        sa = jnp.einsum('dbhij,dbhj->dbhi', s, a_t)
        s = s * jnp.exp(lw_t)[..., None, :] + sa[..., None] * b_t[..., None, :] + v_t[..., None] * k_t[..., None, :]
        return s, jnp.einsum('dbhij,dbhj->dbhi', s, r_t)

    s_fin, y = lax.scan(step, s0, (tm(r), tm(logw), tm(k), tm(v), tm(a), tm(b)))
    return jnp.moveaxis(y, 0, 2), s_fin


def rwkv_run(prep, s0):
    r, logw, k_dir, v, a_vec, b, gate = prep
    return wkv_scan(orient_shared(r), orient_dir(logw), orient_dir(k_dir), orient_shared(v),
                    orient_shared(a_vec), orient_dir(b), s0)


def rwkv_readout(y, prep, r_k, lnx_g, lnx_b, w_out):
    r, logw, k_dir, v, a_vec, b, gate = prep
    B, T, D = gate.shape
    yf = y[0] + jnp.flip(y[1], 1)
    mean = jnp.mean(yf, axis=-1, keepdims=True)
    var = jnp.mean(jnp.square(yf - mean), axis=-1, keepdims=True)
    yn = ((yf - mean) * lax.rsqrt(var + GN_EPS)).reshape(B, T, D).astype(gate.dtype) * lnx_g + lnx_b
    bonus = jnp.sum(r[None] * k_dir * r_k, axis=(0, -1))[..., None] * v
    o = (yn + bonus.reshape(B, T, D)) * jax.nn.silu(gate)
    return o @ w_out


def rwkv_mixer(h_x, h_c, mu, w_in, w0, w1, w2, a0, a1, a2, k_k, k_a, r_k, lnx_g, lnx_b, w_out, need_ctx):
    B = h_x.shape[0]
    p_c = rwkv_prepare(h_c, mu, w_in, w0, w1, w2, a0, a1, a2, k_k, k_a)
    p_x = rwkv_prepare(h_x, mu, w_in, w0, w1, w2, a0, a1, a2, k_k, k_a)
    s0 = jnp.zeros((N_DIR, B, RWKV_HEADS, RWKV_HEAD, RWKV_HEAD), jnp.float32)
    y_c, s_c = rwkv_run(p_c, s0)
    y_x, _ = rwkv_run(p_x, s_c)
    d_x = rwkv_readout(y_x, p_x, r_k, lnx_g, lnx_b, w_out)
    d_c = rwkv_readout(y_c, p_c, r_k, lnx_g, lnx_b, w_out) if need_ctx else None
    return d_x, d_c


def axial_rope_angles(T, rows):
    row = jnp.broadcast_to(jnp.arange(rows)[:, None], (rows, GRID_W)).reshape(T).astype(jnp.float32)
    col = jnp.broadcast_to(jnp.arange(GRID_W)[None, :], (rows, GRID_W)).reshape(T).astype(jnp.float32)
    n_axis = QK_ROPE // 2
    inv = 1.0 / (ROPE_THETA ** (jnp.arange(0, n_axis, 2, dtype=jnp.float32) / n_axis))
    ang = jnp.concatenate([row[:, None] * inv, col[:, None] * inv], axis=-1)
    return jnp.cos(ang), jnp.sin(ang)


def apply_rope(x, cos, sin):
    half = QK_ROPE // 2
    x1, x2 = x[..., :half], x[..., half:]
    c = cos[:, None, :].astype(x.dtype)
    s = sin[:, None, :].astype(x.dtype)
    return jnp.concatenate([x1 * c - x2 * s, x1 * s + x2 * c], axis=-1)


def mla_project(h, w_in, q_norm_g, w_qb, kv_norm_g, w_kvb, cos=None, sin=None):
    B, T, D = h.shape
    p = h @ w_in
    q_c, kv_c, k_pe, gate = jnp.split(p, [Q_LORA, Q_LORA + KV_LORA, Q_LORA + KV_LORA + QK_ROPE], axis=-1)
    q = (rmsnorm(q_c, q_norm_g) @ w_qb).reshape(B, T, MLA_HEADS, QK_NOPE + QK_ROPE)
    kv = (rmsnorm(kv_c, kv_norm_g) @ w_kvb).reshape(B, T, MLA_HEADS, QK_NOPE + V_HEAD)
    q_nope, q_pe = q[..., :QK_NOPE], q[..., QK_NOPE:]
    k_nope, v = kv[..., :QK_NOPE], kv[..., QK_NOPE:]
    k_pe = k_pe[:, :, None, :]
    if cos is not None:
        q_pe = apply_rope(q_pe, cos, sin)
        k_pe = apply_rope(k_pe, cos, sin)
    q = jnp.concatenate([q_nope, q_pe], axis=-1)
    k = jnp.concatenate([k_nope, jnp.broadcast_to(k_pe, (B, T, MLA_HEADS, QK_ROPE))], axis=-1)
    return q, k, v, gate


def attend(q, k, v):
    s = jnp.einsum('bqhd,bkhd->bhqk', q, k, preferred_element_type=jnp.float32) * (1.0 / math.sqrt(QK_NOPE + QK_ROPE))
    p = jax.nn.softmax(s, axis=-1).astype(v.dtype)
    return jnp.einsum('bhqk,bkhd->bqhd', p, v, preferred_element_type=jnp.float32).astype(q.dtype)


def mla_mixer(h_x, h_c, cos, sin, w_in, q_norm_g, w_qb, kv_norm_g, w_kvb, w_out, need_ctx):
    B, T, D = h_x.shape
    L = h_c.shape[1]
    q_x, k_x, v_x, g_x = mla_project(h_x, w_in, q_norm_g, w_qb, kv_norm_g, w_kvb, cos, sin)
    q_c, k_c, v_c, g_c = mla_project(h_c, w_in, q_norm_g, w_qb, kv_norm_g, w_kvb)
    k_all = jnp.concatenate([k_x, k_c], axis=1)
    v_all = jnp.concatenate([v_x, v_c], axis=1)
    qb = q_x.reshape(B, T // Q_BLOCK, Q_BLOCK, MLA_HEADS, QK_NOPE + QK_ROPE).swapaxes(0, 1)
    o = lax.map(lambda qblk: attend(qblk, k_all, v_all), qb)
    o = o.swapaxes(0, 1).reshape(B, T, MLA_GATE)
    d_x = (o * jax.nn.silu(g_x)) @ w_out
    d_c = None
    if need_ctx:
        o_c = attend(q_c, k_c, v_c).reshape(B, L, MLA_GATE)
        d_c = (o_c * jax.nn.silu(g_c)) @ w_out
    return d_x, d_c


def setup_inputs(seed: int = 0) -> dict:
    key = jax.random.key(seed)
    ks = iter(jax.random.split(key, 40))
    nrm = lambda shape, scale: scale * jax.random.normal(next(ks), shape, jnp.float32)
    D, NR, NM = D_MODEL, N_RWKV, N_MLA
    return {
        'x': nrm((BATCH, SEQ, D), 1.0),
        'c': nrm((BATCH, D), 1.0),
        'ctx': nrm((BATCH, CTX_LEN, D), 1.0),
        'c_ctx': nrm((D,), 1.0),
        'norm_g': 1.0 + nrm((DEPTH, D), 0.05),
        'mod_w': nrm((DEPTH, D, 3 * D), 0.5 * D ** -0.5),
        'mod_b': nrm((DEPTH, 3 * D), 0.05),
        'rwkv_mu': jax.random.uniform(next(ks), (NR, 6, D), jnp.float32),
        'rwkv_w_in': nrm((NR, 4, D, D), D ** -0.5),
        'rwkv_w0': jax.random.uniform(next(ks), (NR, N_DIR, D), jnp.float32, -6.0, -1.0),
        'rwkv_w1': nrm((NR, N_DIR, D, DECAY_LORA), D ** -0.5),
        'rwkv_w2': nrm((NR, N_DIR, DECAY_LORA, D), 0.5 * DECAY_LORA ** -0.5),
        'rwkv_a0': nrm((NR, N_DIR, D), 0.1),
        'rwkv_a1': nrm((NR, N_DIR, D, ICLR_LORA), D ** -0.5),
        'rwkv_a2': nrm((NR, N_DIR, ICLR_LORA, D), 0.5 * ICLR_LORA ** -0.5),
        'rwkv_k_k': 0.85 + nrm((NR, D), 0.05),
        'rwkv_k_a': 1.0 + nrm((NR, D), 0.05),
        'rwkv_r_k': nrm((NR, RWKV_HEADS, RWKV_HEAD), 0.1),
        'rwkv_lnx_g': 1.0 + nrm((NR, D), 0.05),
        'rwkv_lnx_b': nrm((NR, D), 0.02),
        'rwkv_w_out': nrm((NR, D, D), D ** -0.5),
        'mla_w_in': nrm((NM, D, MLA_IN), D ** -0.5),
        'mla_q_norm_g': 1.0 + nrm((NM, Q_LORA), 0.05),
        'mla_w_qb': nrm((NM, Q_LORA, MLA_HEADS * (QK_NOPE + QK_ROPE)), Q_LORA ** -0.5),
        'mla_kv_norm_g': 1.0 + nrm((NM, KV_LORA), 0.05),
        'mla_w_kvb': nrm((NM, KV_LORA, MLA_HEADS * (QK_NOPE + V_HEAD)), KV_LORA ** -0.5),
        'mla_w_out': nrm((NM, MLA_GATE, D), MLA_GATE ** -0.5),
        'final_g': 1.0 + nrm((D,), 0.05),
    }


def reference(x, c, ctx, c_ctx, norm_g, mod_w, mod_b, rwkv_mu, rwkv_w_in, rwkv_w0, rwkv_w1, rwkv_w2,
              rwkv_a0, rwkv_a1, rwkv_a2, rwkv_k_k, rwkv_k_a, rwkv_r_k, rwkv_lnx_g, rwkv_lnx_b, rwkv_w_out,
              mla_w_in, mla_q_norm_g, mla_w_qb, mla_kv_norm_g, mla_w_kvb, mla_w_out, final_g):
    T = x.shape[1]
    ROWS = T // GRID_W
    cos, sin = axial_rope_angles(T, ROWS)
    for i in range(DEPTH):
        last = i == DEPTH - 1
        mod_x = jax.nn.silu(c) @ mod_w[i] + mod_b[i]
        mod_c = jax.nn.silu(c_ctx) @ mod_w[i] + mod_b[i]
        sh_x, sc_x, g_x = jnp.split(mod_x[:, None, :], 3, axis=-1)
        sh_c, sc_c, g_c = jnp.split(mod_c, 3, axis=-1)
        h_x = rmsnorm(x, norm_g[i]) * (1.0 + sc_x) + sh_x
        h_c = rmsnorm(ctx, norm_g[i]) * (1.0 + sc_c) + sh_c
        j = i // N_MIXERS
        if i % N_MIXERS == 0:
            d_x, d_c = rwkv_mixer(h_x, h_c, rwkv_mu[j], rwkv_w_in[j], rwkv_w0[j], rwkv_w1[j], rwkv_w2[j],
                                  rwkv_a0[j], rwkv_a1[j], rwkv_a2[j], rwkv_k_k[j], rwkv_k_a[j], rwkv_r_k[j],
                                  rwkv_lnx_g[j], rwkv_lnx_b[j], rwkv_w_out[j], not last)
        else:
            d_x, d_c = mla_mixer(h_x, h_c, cos, sin, mla_w_in[j], mla_q_norm_g[j], mla_w_qb[j],
                                 mla_kv_norm_g[j], mla_w_kvb[j], mla_w_out[j], not last)
        x = x + g_x * d_x
        if not last:
            ctx = ctx + g_c * d_c
    return rmsnorm(x, final_g)
```

```cpp
#include <hip/hip_runtime.h>
#include <hip/hip_cooperative_groups.h>
#include <cstdio>
#include <cstdint>
namespace cg = cooperative_groups;

typedef unsigned short bf16_t;
typedef short bf16x8 __attribute__((ext_vector_type(8)));
typedef short s16x4 __attribute__((ext_vector_type(4)));
typedef float f32x16 __attribute__((ext_vector_type(16)));
typedef float f32x4 __attribute__((ext_vector_type(4)));
typedef float f32x2 __attribute__((ext_vector_type(2)));
typedef unsigned u32x4 __attribute__((ext_vector_type(4)));
typedef unsigned u32x2 __attribute__((ext_vector_type(2)));

constexpr int D = 1024, NB = 8, T = 8192, L = 256, TL = T + L, NTOK = NB * TL;
constexpr int NTHR = 512;

constexpr size_t U = (size_t)NTOK * 1024 * 2;
constexpr size_t OFF_H = 0, OFF_R = U, OFF_K = 2 * U, OFF_V = 3 * U, OFF_G = 4 * U, OFF_Y0 = 5 * U, OFF_Y1 = 6 * U;
constexpr size_t OFF_LORA = 7 * U;
constexpr size_t OFF_BONUS = OFF_LORA + (size_t)NTOK * 256 * 2;
constexpr size_t OFF_WIN0 = OFF_BONUS + (size_t)2 * NTOK * 16 * 4;
constexpr size_t OFF_WOUT0 = OFF_WIN0 + (size_t)4352 * 1024 * 2;
constexpr size_t OFF_WIN1 = OFF_WOUT0 + (size_t)1024 * 1024 * 2;
constexpr size_t OFF_WQB = OFF_WIN1 + (size_t)1792 * 1024 * 2;
constexpr size_t OFF_WKVB = OFF_WQB + (size_t)1536 * 384 * 2;
constexpr size_t OFF_WOUT1 = OFF_WKVB + (size_t)2048 * 256 * 2;
constexpr size_t OFF_MOD = OFF_WOUT1 + (size_t)1024 * 1024 * 2;
constexpr size_t OFF_ROPE = OFF_MOD + (size_t)2 * 9 * 3072 * 4;
constexpr size_t OFF_CTX1 = OFF_ROPE + (size_t)128 * 8 * 2 * 4;
constexpr size_t WS_END = OFF_CTX1 + (size_t)2048 * 1024 * 4;
constexpr size_t OFF_QC = OFF_V;
constexpr size_t OFF_KVC = OFF_QC + (size_t)NTOK * 384 * 2;
constexpr size_t OFF_KPE = OFF_KVC + (size_t)NTOK * 256 * 2;
constexpr size_t OFF_G1 = OFF_G;
constexpr size_t OFF_Q = OFF_R;
constexpr size_t OFF_KV = OFF_Y0;

struct Params { const float* in[28]; float* out; unsigned char* ws; };

__device__ __forceinline__ unsigned cvtpk(float lo, float hi) { unsigned r; asm("v_cvt_pk_bf16_f32 %0, %1, %2" : "=v"(r) : "v"(lo), "v"(hi)); return r; }
__device__ __forceinline__ float bf2f(bf16_t u) { return __uint_as_float(((unsigned)u) << 16); }
__device__ __forceinline__ bf16_t f2bf(float f) { return (bf16_t)(cvtpk(f, 0.f) & 0xffffu); }
__device__ __forceinline__ float lo16(unsigned w) { return __uint_as_float(w << 16); }
__device__ __forceinline__ float hi16(unsigned w) { return __uint_as_float(w & 0xffff0000u); }
__device__ __forceinline__ void st_bf16x4(bf16_t* p, float a, float b, float c, float d) { u32x2 w = {cvtpk(a, b), cvtpk(c, d)}; *(u32x2*)p = w; }
__device__ __forceinline__ float wave_sum(float v) {
#pragma unroll
  for (int o = 32; o; o >>= 1) v += __shfl_xor(v, o);
  return v;
}
__device__ __forceinline__ float dpp_f(float v, const int ctrl_sel) {
  int r;
  if (ctrl_sel == 0) r = __builtin_amdgcn_update_dpp(0, __float_as_int(v), 0xB1, 0xF, 0xF, true);
  else if (ctrl_sel == 1) r = __builtin_amdgcn_update_dpp(0, __float_as_int(v), 0x4E, 0xF, 0xF, true);
  else r = __builtin_amdgcn_update_dpp(0, __float_as_int(v), 0x141, 0xF, 0xF, true);
  return __int_as_float(r);
}
__device__ __forceinline__ float red8(float v) { v += dpp_f(v, 0); v += dpp_f(v, 1); v += dpp_f(v, 2); return v; }
__device__ __forceinline__ int crow(int r, int hi) { return (r & 3) + 8 * (r >> 2) + 4 * hi; }
__device__ __forceinline__ float sigmoidf_(float x) { return 1.f / (1.f + __expf(-x)); }
#define MFMA(a, b, c) __builtin_amdgcn_mfma_f32_32x32x16_bf16((a), (b), (c), 0, 0, 0)

constexpr int G_LDT = 144;
constexpr int G_STAGE = 256 * G_LDT + 128 * G_LDT;
constexpr int G_SSQ_OFF = 2 * G_STAGE;
constexpr int LDS_BYTES = G_SSQ_OFF + 1024;

template <int AMODE, class Epi>
__device__ __forceinline__ void gemm_tile(const bf16_t* A, const int lda, const bf16_t* Bt, const int K, const int m0, const float* mu, char* lds, const Epi& epi) {
  const int tid = threadIdx.x, lane = tid & 63, wid = tid >> 6, r32 = lane & 31, hi = lane >> 5;
  const int wm = wid >> 1, wn = wid & 1;
  const int srow = tid >> 3, scc = (tid & 7) * 8;
  f32x16 acc[2][2];
#pragma unroll
  for (int i = 0; i < 2; ++i)
#pragma unroll
    for (int j = 0; j < 2; ++j)
#pragma unroll
      for (int r = 0; r < 16; ++r) acc[i][j][r] = 0.f;
  bf16x8 ra[4], rb[2], rp[4], rn[4];
  float ssq[4] = {0.f, 0.f, 0.f, 0.f};
  int dprev[4], dnext[4];
  if constexpr (AMODE == 1) {
    const int t0 = m0 % TL;
#pragma unroll
    for (int i = 0; i < 4; ++i) { const int t = t0 + srow + 64 * i; dprev[i] = (t != 0 && t != T) ? 1 : 0; dnext[i] = (t != T - 1 && t != TL - 1) ? 1 : 0; }
  }
  auto gload = [&](int k0) {
#pragma unroll
    for (int i = 0; i < 4; ++i) {
      const bf16_t* ap = A + (size_t)(m0 + srow + 64 * i) * lda + k0 + scc;
      ra[i] = *(const bf16x8*)ap;
      if constexpr (AMODE == 1) { rp[i] = *(const bf16x8*)(ap - dprev[i] * lda); rn[i] = *(const bf16x8*)(ap + dnext[i] * lda); }
    }
#pragma unroll
    for (int i = 0; i < 2; ++i) rb[i] = *(const bf16x8*)(Bt + (size_t)(srow + 64 * i) * K + k0 + scc);
  };
  auto lstore = [&](int s, int k0) {
    char* base = lds + s * G_STAGE;
    if constexpr (AMODE == 1) {
      const f32x4 m0v = *(const f32x4*)(mu + k0 + scc), m1v = *(const f32x4*)(mu + k0 + scc + 4);
      const float mm[8] = {m0v[0], m0v[1], m0v[2], m0v[3], m1v[0], m1v[1], m1v[2], m1v[3]};
#pragma unroll
      for (int i = 0; i < 4; ++i) {
        const u32x4 hc = *(const u32x4*)&ra[i], hp = *(const u32x4*)&rp[i], hn = *(const u32x4*)&rn[i];
        const float fp = dprev[i] ? 0.5f : 0.f, fn = dnext[i] ? 0.5f : 0.f;
        u32x4 w;
#pragma unroll
        for (int q = 0; q < 4; ++q) {
          const float c0 = lo16(hc[q]), c1 = hi16(hc[q]);
          const float x0 = fp * lo16(hp[q]) + fn * lo16(hn[q]) - c0, x1 = fp * hi16(hp[q]) + fn * hi16(hn[q]) - c1;
          w[q] = cvtpk(c0 + x0 * mm[2 * q], c1 + x1 * mm[2 * q + 1]);
        }
        *(u32x4*)(base + (srow + 64 * i) * G_LDT + scc * 2) = w;
      }
    } else {
#pragma unroll
      for (int i = 0; i < 4; ++i) {
        *(bf16x8*)(base + (srow + 64 * i) * G_LDT + scc * 2) = ra[i];
        if constexpr (AMODE == 2) {
          const u32x4 hc = *(const u32x4*)&ra[i];
#pragma unroll
          for (int q = 0; q < 4; ++q) { const float c0 = lo16(hc[q]), c1 = hi16(hc[q]); ssq[i] += c0 * c0 + c1 * c1; }
        }
      }
    }
#pragma unroll
    for (int i = 0; i < 2; ++i) *(bf16x8*)(base + 256 * G_LDT + (srow + 64 * i) * G_LDT + scc * 2) = rb[i];
  };
  const int nk = K >> 6;
  gload(0);
  lstore(0, 0);
  __syncthreads();
  for (int kt = 0; kt < nk; ++kt) {
    const int s = kt & 1;
    if (kt + 1 < nk) gload((kt + 1) * 64);
    {
      const char* Ab = lds + s * G_STAGE + (wm * 64 + r32) * G_LDT + hi * 16;
      const char* Bb = lds + s * G_STAGE + 256 * G_LDT + (wn * 64 + r32) * G_LDT + hi * 16;
#pragma unroll
      for (int ks = 0; ks < 4; ++ks) {
        const bf16x8 a0 = *(const bf16x8*)(Ab + ks * 32), a1 = *(const bf16x8*)(Ab + 32 * G_LDT + ks * 32);
        const bf16x8 b0 = *(const bf16x8*)(Bb + ks * 32), b1 = *(const bf16x8*)(Bb + 32 * G_LDT + ks * 32);
        acc[0][0] = MFMA(b0, a0, acc[0][0]); acc[0][1] = MFMA(b1, a0, acc[0][1]);
        acc[1][0] = MFMA(b0, a1, acc[1][0]); acc[1][1] = MFMA(b1, a1, acc[1][1]);
      }
    }
    if (kt + 1 < nk) lstore(s ^ 1, (kt + 1) * 64);
    __syncthreads();
  }
  float* ssq_l = (float*)(lds + G_SSQ_OFF);
  if constexpr (AMODE == 2) {
#pragma unroll
    for (int i = 0; i < 4; ++i) { const float v = red8(ssq[i]); if ((tid & 7) == 0) ssq_l[srow + 64 * i] = v; }
    __syncthreads();
  }
#pragma unroll
  for (int mi = 0; mi < 2; ++mi) {
    const int lrow = wm * 64 + mi * 32 + r32;
    float aux = 0.f;
    if constexpr (AMODE == 2) aux = ssq_l[lrow];
#pragma unroll
    for (int ni = 0; ni < 2; ++ni) epi(lrow, wn * 64 + ni * 32 + 4 * hi, acc[mi][ni], aux);
  }
}

struct EpiBf16 {
  bf16_t* dst; int ldd; int col0; int m0; int act; float invK;
  __device__ __forceinline__ void operator()(int lrow, int nc, const f32x16& a, float aux) const {
    float sc = 1.f;
    if (invK > 0.f) sc = rsqrtf(aux * invK + 1e-6f);
    bf16_t* p = dst + (size_t)(m0 + lrow) * ldd + col0 + nc;
#pragma unroll
    for (int g = 0; g < 4; ++g) {
      float v0 = a[4 * g] * sc, v1 = a[4 * g + 1] * sc, v2 = a[4 * g + 2] * sc, v3 = a[4 * g + 3] * sc;
      if (act) {
        v0 = 1.f - 2.f / (__expf(2.f * v0) + 1.f); v1 = 1.f - 2.f / (__expf(2.f * v1) + 1.f);
        v2 = 1.f - 2.f / (__expf(2.f * v2) + 1.f); v3 = 1.f - 2.f / (__expf(2.f * v3) + 1.f);
      }
      st_bf16x4(p + 8 * g, v0, v1, v2, v3);
    }
  }
};
struct EpiResid {
  const float* xin; float* xout; const float* gvec; int n0;
  __device__ __forceinline__ void operator()(int lrow, int nc, const f32x16& a, float) const {
    const size_t o = (size_t)lrow * 1024 + n0 + nc;
#pragma unroll
    for (int g = 0; g < 4; ++g) {
      const f32x4 xv = *(const f32x4*)(xin + o + 8 * g), gv = *(const f32x4*)(gvec + n0 + nc + 8 * g);
      f32x4 r; r[0] = xv[0] + gv[0] * a[4 * g]; r[1] = xv[1] + gv[1] * a[4 * g + 1]; r[2] = xv[2] + gv[2] * a[4 * g + 2]; r[3] = xv[3] + gv[3] * a[4 * g + 3];
      *(f32x4*)(xout + o + 8 * g) = r;
    }
  }
};
struct EpiMlaIn {
  bf16_t *QC, *KVC, *KPE, *G1; const float* rope; int nt; int m0;
  __device__ __forceinline__ void operator()(int lrow, int nc, const f32x16& a, float) const {
    const int row = m0 + lrow;
    if (nt == 5) {
      if (nc >= 32) return;
      const int t = (m0 % TL) + lrow, hi4 = nc;
      bf16_t* p = KPE + (size_t)row * 32;
      if (t < T) {
        const f32x2* tr = (const f32x2*)rope + (t >> 6) * 8 + hi4;
        const f32x2* tc = (const f32x2*)rope + (t & 63) * 8 + hi4;
        float o1[8], o2[8];
#pragma unroll
        for (int e = 0; e < 4; ++e) {
          const f32x2 cs0 = tr[e], cs1 = tc[e];
          const float x1a = a[e], x2a = a[8 + e];
          const float x1b = a[4 + e], x2b = a[12 + e];
          o1[e] = x1a * cs0[0] - x2a * cs0[1]; o2[e] = x1a * cs0[1] + x2a * cs0[0];
          o1[4 + e] = x1b * cs1[0] - x2b * cs1[1]; o2[4 + e] = x1b * cs1[1] + x2b * cs1[0];
        }
        st_bf16x4(p + hi4, o1[0], o1[1], o1[2], o1[3]);
        st_bf16x4(p + 8 + hi4, o1[4], o1[5], o1[6], o1[7]);
        st_bf16x4(p + 16 + hi4, o2[0], o2[1], o2[2], o2[3]);
        st_bf16x4(p + 24 + hi4, o2[4], o2[5], o2[6], o2[7]);
      } else {
#pragma unroll
        for (int g = 0; g < 4; ++g) st_bf16x4(p + 8 * g + hi4, a[4 * g], a[4 * g + 1], a[4 * g + 2], a[4 * g + 3]);
      }
      return;
    }
    bf16_t* p;
    if (nt < 3) p = QC + (size_t)row * 384 + nt * 128 + nc;
    else if (nt < 5) p = KVC + (size_t)row * 256 + (nt - 3) * 128 + nc;
    else p = G1 + (size_t)row * 1024 + (nt - 6) * 128 + nc;
#pragma unroll
    for (int g = 0; g < 4; ++g) st_bf16x4(p + 8 * g, a[4 * g], a[4 * g + 1], a[4 * g + 2], a[4 * g + 3]);
  }
};

__device__ void tr_job(const float* src, int ld, int K, int N, bf16_t* dst, const float* kscale, char* lds) {
  float* tile = (float*)lds;
  const int tid = threadIdx.x, nK = K >> 6, nN = (N + 63) >> 6;
  for (int tIdx = blockIdx.x; tIdx < nK * nN; tIdx += gridDim.x) {
    const int k0 = (tIdx % nK) * 64, n0 = (tIdx / nK) * 64;
#pragma unroll
    for (int i = 0; i < 8; ++i) {
      const int kk = (tid >> 6) + 8 * i, nn = tid & 63;
      float v = 0.f;
      if (n0 + nn < N) { v = src[(size_t)(k0 + kk) * ld + n0 + nn]; if (kscale) v *= kscale[k0 + kk]; }
      tile[kk * 65 + nn] = v;
    }
    __syncthreads();
#pragma unroll
    for (int i = 0; i < 8; ++i) {
      const int nn = (tid >> 6) + 8 * i, kk = tid & 63;
      if (n0 + nn < N) dst[(size_t)(n0 + nn) * K + k0 + kk] = f2bf(tile[kk * 65 + nn]);
    }
    __syncthreads();
  }
}

__device__ void phase_prologue(const Params& p, char* lds) {
  unsigned char* ws = p.ws;
  bf16_t* WIN0 = (bf16_t*)(ws + OFF_WIN0);
  for (int j = 0; j < 4; ++j) tr_job(p.in[8] + (size_t)j * 1024 * 1024, 1024, 1024, 1024, WIN0 + (size_t)j * 1024 * 1024, nullptr, lds);
  for (int d = 0; d < 2; ++d) {
    tr_job(p.in[10] + (size_t)d * 1024 * 64, 64, 1024, 64, WIN0 + (size_t)(4096 + d * 64) * 1024, nullptr, lds);
    tr_job(p.in[13] + (size_t)d * 1024 * 64, 64, 1024, 64, WIN0 + (size_t)(4224 + d * 64) * 1024, nullptr, lds);
  }
  tr_job(p.in[20], 1024, 1024, 1024, (bf16_t*)(ws + OFF_WOUT0), nullptr, lds);
  bf16_t* WIN1 = (bf16_t*)(ws + OFF_WIN1);
  tr_job(p.in[21], 1696, 1024, 640, WIN1, nullptr, lds);
  tr_job(p.in[21] + 640, 1696, 1024, 32, WIN1 + (size_t)640 * 1024, nullptr, lds);
  tr_job(p.in[21] + 672, 1696, 1024, 1024, WIN1 + (size_t)768 * 1024, nullptr, lds);
  for (int i = blockIdx.x * NTHR + threadIdx.x; i < 96 * 1024; i += gridDim.x * NTHR) WIN1[(size_t)672 * 1024 + i] = 0;
  tr_job(p.in[23], 1536, 384, 1536, (bf16_t*)(ws + OFF_WQB), p.in[22], lds);
  tr_job(p.in[25], 2048, 256, 2048, (bf16_t*)(ws + OFF_WKVB), p.in[24], lds);
  tr_job(p.in[26], 1024, 1024, 1024, (bf16_t*)(ws + OFF_WOUT1), nullptr, lds);
  {
    const int i = blockIdx.x * NTHR + threadIdx.x;
    if (i < 1024) {
      const float invf[8] = {1.f, 0.316227766016838f, 0.1f, 0.0316227766016838f, 0.01f, 0.00316227766016838f, 0.001f, 0.000316227766016838f};
      const int pos = i >> 3, m = i & 7;
      float inv = invf[0];
#pragma unroll
      for (int q = 1; q < 8; ++q) inv = (m == q) ? invf[q] : inv;
      const float ang = (float)pos * inv;
      const float kf = rintf(ang * 0.15915494309189535f);
      float r = fmaf(-kf, 6.28125f, ang);
      r = fmaf(-kf, 1.9353071795864769e-3f, r);
      float* rt = (float*)(ws + OFF_ROPE);
      rt[2 * i] = cosf(r); rt[2 * i + 1] = sinf(r);
    }
  }
  {
    float* sil = (float*)lds;
    float* red = sil + 9 * 1024;
    const int tid = threadIdx.x;
    for (int i = tid; i < 9 * 1024; i += NTHR) {
      const int bi = i >> 10, k = i & 1023;
      const float cv = bi < 8 ? p.in[1][bi * 1024 + k] : p.in[3][k];
      sil[i] = cv / (1.f + __expf(-cv));
    }
    __syncthreads();
    float* mod = (float*)(ws + OFF_MOD);
    for (int item = blockIdx.x; item < 192; item += gridDim.x) {
      const int l = item / 96, n0 = (item % 96) * 32, col = tid & 31, kg = tid >> 5;
      float acc[9];
#pragma unroll
      for (int bi = 0; bi < 9; ++bi) acc[bi] = 0.f;
      const float* wp = p.in[5] + ((size_t)l * 1024 + kg * 64) * 3072 + n0 + col;
      for (int kk = 0; kk < 64; ++kk) {
        const float w = wp[(size_t)kk * 3072];
#pragma unroll
        for (int bi = 0; bi < 9; ++bi) acc[bi] += sil[bi * 1024 + kg * 64 + kk] * w;
      }
#pragma unroll
      for (int bi = 0; bi < 9; ++bi) red[(kg * 9 + bi) * 32 + col] = acc[bi];
      __syncthreads();
      if (tid < 288) {
        const int bi = tid >> 5;
        float s = 0.f;
#pragma unroll
        for (int g = 0; g < 16; ++g) s += red[(g * 9 + bi) * 32 + col];
        mod[((size_t)l * 9 + bi) * 3072 + n0 + col] = s + p.in[6][l * 3072 + n0 + col];
      }
      __syncthreads();
    }
  }
}

__device__ void phase_norm(const float* xsrc, const float* csrc, const float* ng, const float* mod, bf16_t* H) {
  const int lane = threadIdx.x & 63, gw = blockIdx.x * 8 + (threadIdx.x >> 6), nw = gridDim.x * 8;
  for (int n = gw; n < NTOK; n += nw) {
    const int b = n / TL, t = n - b * TL;
    const float* src; int bi;
    if (t < T) { src = xsrc + ((size_t)b * T + t) * D; bi = b; } else { src = csrc + ((size_t)b * L + (t - T)) * D; bi = 8; }
    f32x4 v[4]; float ss = 0.f;
#pragma unroll
    for (int i = 0; i < 4; ++i) { v[i] = *(const f32x4*)(src + i * 256 + lane * 4); ss += v[i][0] * v[i][0] + v[i][1] * v[i][1] + v[i][2] * v[i][2] + v[i][3] * v[i][3]; }
    ss = wave_sum(ss);
    const float rstd = rsqrtf(ss * (1.f / 1024.f) + 1e-6f);
    const float* m = mod + bi * 3072;
#pragma unroll
    for (int i = 0; i < 4; ++i) {
      const int c = i * 256 + lane * 4;
      const f32x4 g4 = *(const f32x4*)(ng + c), sh = *(const f32x4*)(m + c), sc = *(const f32x4*)(m + 1024 + c);
      float o[4];
#pragma unroll
      for (int e = 0; e < 4; ++e) o[e] = v[i][e] * rstd * g4[e] * (1.f + sc[e]) + sh[e];
      st_bf16x4(H + (size_t)n * 1024 + c, o[0], o[1], o[2], o[3]);
    }
  }
}

__device__ void phase_final(float* out, const float* fg) {
  const int lane = threadIdx.x & 63, gw = blockIdx.x * 8 + (threadIdx.x >> 6), nw = gridDim.x * 8;
  for (int n = gw; n < NB * T; n += nw) {
    float* src = out + (size_t)n * D;
    f32x4 v[4]; float ss = 0.f;
#pragma unroll
    for (int i = 0; i < 4; ++i) { v[i] = *(const f32x4*)(src + i * 256 + lane * 4); ss += v[i][0] * v[i][0] + v[i][1] * v[i][1] + v[i][2] * v[i][2] + v[i][3] * v[i][3]; }
    ss = wave_sum(ss);
    const float rstd = rsqrtf(ss * (1.f / 1024.f) + 1e-6f);
#pragma unroll
    for (int i = 0; i < 4; ++i) {
      const int c = i * 256 + lane * 4;
      const f32x4 g4 = *(const f32x4*)(fg + c);
      f32x4 o;
#pragma unroll
      for (int e = 0; e < 4; ++e) o[e] = v[i][e] * rstd * g4[e];
      *(f32x4*)(src + c) = o;
    }
  }
}

__device__ __forceinline__ int scan_row(int g, int d, int b) {
  if (g < L) { const int tt = d ? (L - 1 - g) : g; return b * TL + T + tt; }
  g -= L; const int tt = d ? (T - 1 - g) : g; return b * TL + tt;
}
__device__ void phase_scan(const Params& p, char* lds) {
  unsigned char* ws = p.ws;
  float* Wd = (float*)lds; float* Aa = Wd + 2048; float* Bv = Aa + 2048; float* Kd = Bv + 2048; float* Rr = Kd + 2048; float* Vv = Rr + 2048; float* IC = Vv + 2048; float* Yb = IC + 2048;
  const int tid = threadIdx.x, lane = tid & 63, wid = tid >> 6, r32 = lane & 31, hi = lane >> 5;
  const bf16_t* Rg = (const bf16_t*)(ws + OFF_R); const bf16_t* Kg = (const bf16_t*)(ws + OFF_K); const bf16_t* Vg = (const bf16_t*)(ws + OFF_V);
  const bf16_t* Lg = (const bf16_t*)(ws + OFF_LORA);
  for (int sidx = blockIdx.x; sidx < 256; sidx += gridDim.x) {
    const int d = sidx >> 7, b = (sidx >> 4) & 7, h = sidx & 15;
    bf16_t* Yg = (bf16_t*)(ws + (d ? OFF_Y1 : OFF_Y0));
    float* Bg = (float*)(ws + OFF_BONUS) + (size_t)d * NTOK * 16;
    const int col = h * 64 + lane;
    const float kkc = p.in[15][col], kac = p.in[16][col], rkc = p.in[17][col];
    const int mat = (wid >> 1) & 1, jh = wid & 1;
    bf16x8 w2f[4]; float bias = 0.f;
    {
      const float* W2 = (mat ? p.in[14] : p.in[11]) + (size_t)d * 64 * 1024;
#pragma unroll
      for (int ks = 0; ks < 4; ++ks) {
        u32x4 w;
#pragma unroll
        for (int q = 0; q < 4; ++q) {
          const int r0 = ks * 16 + 8 * hi + 2 * q;
          w[q] = cvtpk(W2[(size_t)r0 * 1024 + h * 64 + jh * 32 + r32], W2[(size_t)(r0 + 1) * 1024 + h * 64 + jh * 32 + r32]);
        }
        w2f[ks] = *(bf16x8*)&w;
      }
      bias = (mat ? p.in[12] : p.in[9])[d * 1024 + h * 64 + jh * 32 + r32];
    }
    float S[8];
#pragma unroll
    for (int e = 0; e < 8; ++e) S[e] = 0.f;
    const int si = tid >> 3, jb = tid & 7;
    bf16_t pr[4], pk[4], pv[4]; bf16x8 pl[4];
    auto prefetch = [&](int c) {
#pragma unroll
      for (int i = 0; i < 4; ++i) {
        const size_t row = (size_t)scan_row(c * 32 + wid + 8 * i, d, b);
        pr[i] = Rg[row * 1024 + col]; pk[i] = Kg[row * 1024 + col]; pv[i] = Vg[row * 1024 + col];
      }
      if (wid < 4) {
        const size_t row = (size_t)scan_row(c * 32 + r32, d, b);
#pragma unroll
        for (int ks = 0; ks < 4; ++ks) pl[ks] = *(const bf16x8*)(Lg + row * 256 + mat * 128 + d * 64 + ks * 16 + hi * 8);
      }
    };
    prefetch(0);
    for (int c = 0; c < TL / 32; ++c) {
      if (wid < 4) {
        f32x16 acc;
#pragma unroll
        for (int r = 0; r < 16; ++r) acc[r] = 0.f;
#pragma unroll
        for (int ks = 0; ks < 4; ++ks) acc = MFMA(pl[ks], w2f[ks], acc);
#pragma unroll
        for (int r = 0; r < 16; ++r) {
          const int step = crow(r, hi), j = jh * 32 + r32;
          const float sg = sigmoidf_(acc[r] + bias);
          if (mat == 0) Wd[step * 64 + j] = __expf(-0.6065306597126334f * sg); else IC[step * 64 + j] = sg;
        }
      }
      float kk[4], kr[4], rr[4];
#pragma unroll
      for (int i = 0; i < 4; ++i) {
        const int step = wid + 8 * i;
        const float rf = bf2f(pr[i]), kf = bf2f(pk[i]), vf = bf2f(pv[i]);
        Rr[step * 64 + lane] = rf; Vv[step * 64 + lane] = vf;
        const float kkf = kf * kkc;
        const float ss = wave_sum(kkf * kkf);
        kk[i] = kkf / fmaxf(sqrtf(ss), 1e-12f); kr[i] = kf; rr[i] = rf;
      }
      __syncthreads();
#pragma unroll
      for (int i = 0; i < 4; ++i) {
        const int step = wid + 8 * i;
        const float ic = IC[step * 64 + lane];
        Aa[step * 64 + lane] = -kk[i]; Bv[step * 64 + lane] = kk[i] * ic;
        const float kd = kr[i] * (1.f + (ic - 1.f) * kac);
        Kd[step * 64 + lane] = kd;
        const float bs = wave_sum(rr[i] * kd * rkc);
        if (lane == 0) Bg[(size_t)scan_row(c * 32 + step, d, b) * 16 + h] = bs;
      }
      __syncthreads();
      if (c + 1 < TL / 32) prefetch(c + 1);
#pragma unroll 2
      for (int s = 0; s < 32; ++s) {
        const int o = s * 64 + jb * 8;
        const f32x4 a0 = *(const f32x4*)(Aa + o), a1 = *(const f32x4*)(Aa + o + 4);
        const f32x4 w0 = *(const f32x4*)(Wd + o), w1 = *(const f32x4*)(Wd + o + 4);
        const f32x4 b0 = *(const f32x4*)(Bv + o), b1 = *(const f32x4*)(Bv + o + 4);
        const f32x4 k0 = *(const f32x4*)(Kd + o), k1 = *(const f32x4*)(Kd + o + 4);
        const f32x4 q0 = *(const f32x4*)(Rr + o), q1 = *(const f32x4*)(Rr + o + 4);
        const float vi = Vv[s * 64 + si];
        float pa = S[0] * a0[0] + S[1] * a0[1] + S[2] * a0[2] + S[3] * a0[3] + S[4] * a1[0] + S[5] * a1[1] + S[6] * a1[2] + S[7] * a1[3];
        pa = red8(pa);
#pragma unroll
        for (int e = 0; e < 4; ++e) {
          S[e] = S[e] * w0[e] + (pa * b0[e] + vi * k0[e]);
          S[4 + e] = S[4 + e] * w1[e] + (pa * b1[e] + vi * k1[e]);
        }
        float py = S[0] * q0[0] + S[1] * q0[1] + S[2] * q0[2] + S[3] * q0[3] + S[4] * q1[0] + S[5] * q1[1] + S[6] * q1[2] + S[7] * q1[3];
        py = red8(py);
        if (jb == 0) Yb[s * 64 + si] = py;
      }
      __syncthreads();
      {
        const int step = tid >> 4, c4 = (tid & 15) * 4;
        const f32x4 yv = *(const f32x4*)(Yb + step * 64 + c4);
        st_bf16x4(Yg + (size_t)scan_row(c * 32 + step, d, b) * 1024 + h * 64 + c4, yv[0], yv[1], yv[2], yv[3]);
      }
    }
    __syncthreads();
  }
}

__device__ void phase_readout(const Params& p) {
  unsigned char* ws = p.ws;
  const bf16_t* Y0 = (const bf16_t*)(ws + OFF_Y0); const bf16_t* Y1 = (const bf16_t*)(ws + OFF_Y1); const bf16_t* Vg = (const bf16_t*)(ws + OFF_V);
  bf16_t* G = (bf16_t*)(ws + OFF_G);
  const float* B0 = (const float*)(ws + OFF_BONUS); const float* B1 = B0 + (size_t)NTOK * 16;
  const int lane = threadIdx.x & 63, gw = blockIdx.x * 8 + (threadIdx.x >> 6), nw = gridDim.x * 8;
  const int c0 = lane * 16, hd = lane >> 2;
  float lg[16], lb[16];
#pragma unroll
  for (int e = 0; e < 16; ++e) { lg[e] = p.in[18][c0 + e]; lb[e] = p.in[19][c0 + e]; }
  for (int n = gw; n < NTOK; n += nw) {
    const size_t o = (size_t)n * 1024 + c0;
    float y[16], v[16], g[16];
#pragma unroll
    for (int q = 0; q < 2; ++q) {
      const u32x4 a = *(const u32x4*)(Y0 + o + 8 * q), bq = *(const u32x4*)(Y1 + o + 8 * q), vv = *(const u32x4*)(Vg + o + 8 * q), gg = *(const u32x4*)(G + o + 8 * q);
#pragma unroll
      for (int w = 0; w < 4; ++w) {
        y[8 * q + 2 * w] = lo16(a[w]) + lo16(bq[w]); y[8 * q + 2 * w + 1] = hi16(a[w]) + hi16(bq[w]);
        v[8 * q + 2 * w] = lo16(vv[w]); v[8 * q + 2 * w + 1] = hi16(vv[w]);
        g[8 * q + 2 * w] = lo16(gg[w]); g[8 * q + 2 * w + 1] = hi16(gg[w]);
      }
    }
    float s = 0.f;
#pragma unroll
    for (int e = 0; e < 16; ++e) s += y[e];
    s += dpp_f(s, 0); s += dpp_f(s, 1);
    const float mean = s * (1.f / 64.f);
    float q2 = 0.f;
#pragma unroll
    for (int e = 0; e < 16; ++e) { const float dlt = y[e] - mean; q2 += dlt * dlt; }
    q2 += dpp_f(q2, 0); q2 += dpp_f(q2, 1);
    const float rs = rsqrtf(q2 * (1.f / 64.f) + 64e-5f);
    const float bonus = B0[(size_t)n * 16 + hd] + B1[(size_t)n * 16 + hd];
    float r[16];
#pragma unroll
    for (int e = 0; e < 16; ++e) {
      const float yn = (y[e] - mean) * rs * lg[e] + lb[e];
      r[e] = (yn + bonus * v[e]) * (g[e] * sigmoidf_(g[e]));
    }
    u32x4 w0 = {cvtpk(r[0], r[1]), cvtpk(r[2], r[3]), cvtpk(r[4], r[5]), cvtpk(r[6], r[7])};
    u32x4 w1 = {cvtpk(r[8], r[9]), cvtpk(r[10], r[11]), cvtpk(r[12], r[13]), cvtpk(r[14], r[15])};
    *(u32x4*)(G + o) = w0; *(u32x4*)(G + o + 8) = w1;
  }
}

constexpr int AT_SHMV = 16384, AT_KROW = 208, AT_SHMK = 64 * AT_KROW;
constexpr int AT_KOFF = 2 * AT_SHMV, AT_WOFF = AT_KOFF + 2 * AT_SHMK;
constexpr float AT_SCALE = 0.10206207261596575f;
constexpr float AT_THR = 8.f;
#define SBAR() __builtin_amdgcn_sched_barrier(0)
__device__ __forceinline__ void at_partialSM(f32x16& p0, f32x16& p1, float& m_reg, float& mn, float& alpha) {
  constexpr float C = AT_SCALE * 1.4426950408889634f;
  float pmax = p0[0];
#pragma unroll
  for (int r = 1; r < 16; ++r) pmax = fmaxf(pmax, p0[r]);
#pragma unroll
  for (int r = 0; r < 16; ++r) pmax = fmaxf(pmax, p1[r]);
  { auto rr = __builtin_amdgcn_permlane32_swap(__float_as_uint(pmax), __float_as_uint(pmax), false, false);
    pmax = fmaxf(__uint_as_float(rr[0]), __uint_as_float(rr[1])); }
  if (__builtin_expect(__all(pmax - m_reg <= AT_THR / AT_SCALE), 1)) { mn = m_reg; alpha = 1.f; }
  else { mn = fmaxf(m_reg, pmax); alpha = __builtin_amdgcn_exp2f((m_reg - mn) * C); m_reg = mn; }
  const float mnC = -mn * C;
#pragma unroll
  for (int r = 0; r < 16; ++r) p0[r] = fmaf(p0[r], C, mnC);
#pragma unroll
  for (int r = 0; r < 16; ++r) p1[r] = fmaf(p1[r], C, mnC);
#pragma unroll
  for (int r = 0; r < 16; ++r) p0[r] = __builtin_amdgcn_exp2f(p0[r]);
}
__device__ __forceinline__ void at_finishSM(f32x16& p0, f32x16& p1, float alpha, float& l_reg, bf16x8& pa0, bf16x8& pa1, bf16x8& pa2, bf16x8& pa3) {
#pragma unroll
  for (int r = 0; r < 16; ++r) p1[r] = __builtin_amdgcn_exp2f(p1[r]);
  float ps = 0;
#pragma unroll
  for (int r = 0; r < 16; ++r) ps += p0[r];
#pragma unroll
  for (int r = 0; r < 16; ++r) ps += p1[r];
  { auto rr = __builtin_amdgcn_permlane32_swap(__float_as_uint(ps), __float_as_uint(ps), false, false);
    ps = __uint_as_float(rr[0]) + __uint_as_float(rr[1]); }
  l_reg = l_reg * alpha + ps;
#define PK4(P, BASE, OUT) do { unsigned a0 = cvtpk(P[BASE + 0], P[BASE + 1]), a1 = cvtpk(P[BASE + 2], P[BASE + 3]);   \
    unsigned b0 = cvtpk(P[BASE + 4], P[BASE + 5]), b1 = cvtpk(P[BASE + 6], P[BASE + 7]);                              \
    auto r0 = __builtin_amdgcn_permlane32_swap(a0, b0, false, false); auto r1 = __builtin_amdgcn_permlane32_swap(a1, b1, false, false); \
    u32x4 w = {r0[0], r1[0], r0[1], r1[1]}; OUT = *reinterpret_cast<bf16x8*>(&w); } while (0)
  PK4(p0, 0, pa0); PK4(p0, 8, pa1); PK4(p1, 0, pa2); PK4(p1, 8, pa3);
#undef PK4
}
__device__ __forceinline__ void at_qkt(f32x16& p0, f32x16& p1, const char* Ks, const bf16x8* qr, int r32, int hi) {
#pragma unroll
  for (int r = 0; r < 16; ++r) { p0[r] = 0.f; p1[r] = 0.f; }
#pragma unroll
  for (int d0 = 0; d0 < 6; ++d0) {
    const bf16x8 b0 = *(const bf16x8*)(Ks + r32 * AT_KROW + d0 * 32 + hi * 16);
    const bf16x8 b1 = *(const bf16x8*)(Ks + (32 + r32) * AT_KROW + d0 * 32 + hi * 16);
    p0 = MFMA(b0, qr[d0], p0);
    p1 = MFMA(b1, qr[d0], p1);
  }
}
__device__ __forceinline__ int v_st(int k, int c) { const int kk = (k & ~0xC) | ((k & 4) << 1) | ((k & 8) >> 1); return ((kk >> 3) * 4 + (c >> 5)) * 512 + ((kk & 7) * 32 + (c & 31)) * 2; }
__device__ __forceinline__ int v_rd_base(int lane) { return ((lane & 3) << 3) | (((lane >> 2) & 3) << 6) | (((lane >> 4) & 1) << 5) | (((lane >> 5) & 1) << 8); }
constexpr int v_rd_off(int d0, int ks, int half) { return d0 * 512 + ks * 4096 + half * 2048; }
template <int OFF> __device__ __forceinline__ s16x4 tr_read(int vb) {
  s16x4 r; asm volatile("ds_read_b64_tr_b16 %0, %1 offset:%2" : "=&v"(r) : "v"(vb), "i"(OFF) : "memory"); return r;
}
template <int D0> __device__ __forceinline__ void pv_one(f32x16& od, int vb, bf16x8 pa0, bf16x8 pa1, bf16x8 pa2, bf16x8 pa3) {
  const s16x4 l0 = tr_read<v_rd_off(D0, 0, 0)>(vb), h0 = tr_read<v_rd_off(D0, 0, 1)>(vb), l1 = tr_read<v_rd_off(D0, 1, 0)>(vb), h1 = tr_read<v_rd_off(D0, 1, 1)>(vb);
  const s16x4 l2 = tr_read<v_rd_off(D0, 2, 0)>(vb), h2 = tr_read<v_rd_off(D0, 2, 1)>(vb), l3 = tr_read<v_rd_off(D0, 3, 0)>(vb), h3 = tr_read<v_rd_off(D0, 3, 1)>(vb);
  asm volatile("s_waitcnt lgkmcnt(0)" ::: "memory"); SBAR();
#define PK(Lx, Hx) (bf16x8){Lx[0], Lx[1], Lx[2], Lx[3], Hx[0], Hx[1], Hx[2], Hx[3]}
  od = MFMA(pa0, PK(l0, h0), od);
  od = MFMA(pa1, PK(l1, h1), od);
  od = MFMA(pa2, PK(l2, h2), od);
  od = MFMA(pa3, PK(l3, h3), od);
#undef PK
}
__device__ __forceinline__ void pv_d0(f32x16* o, int vb, bf16x8 pa0, bf16x8 pa1, bf16x8 pa2, bf16x8 pa3) {
  pv_one<0>(o[0], vb, pa0, pa1, pa2, pa3); pv_one<1>(o[1], vb, pa0, pa1, pa2, pa3);
}

__device__ void phase_attn(const Params& p, char* lds) {
  unsigned char* ws = p.ws;
  const bf16_t* Qg = (const bf16_t*)(ws + OFF_Q); const bf16_t* KVg = (const bf16_t*)(ws + OFF_KV); const bf16_t* KPg = (const bf16_t*)(ws + OFF_KPE);
  bf16_t* G1 = (bf16_t*)(ws + OFF_G1);
  const f32x2* rope = (const f32x2*)(ws + OFF_ROPE);
  const int tid = threadIdx.x, wid = tid >> 6, lane = tid & 63, r32 = lane & 31, hi = lane >> 5;
  char* V_lds = lds; char* K_lds = lds + AT_KOFF;
  float* wsl = (float*)(lds + AT_WOFF) + wid * 64; float* li_l = wsl; float* al_l = wsl + 32;
  const int skey = tid >> 3, sc8 = (tid & 7) * 8;
  const int pkey = (tid & 255) >> 2, pc8 = (tid & 3) * 8;
  const int vst = v_st(skey, sc8), kst = skey * AT_KROW + sc8 * 2, pst = pkey * AT_KROW + (64 + pc8) * 2;
  const int vb0 = (int)(uintptr_t)V_lds + v_rd_base(lane);
  const int nitems = NB * 16 * 32;
  const int xcd = blockIdx.x & 7, slot = blockIdx.x >> 3, per = gridDim.x >> 3;
  for (int it = slot; it < nitems / 8; it += per) {
    const int pair = (it >> 5) * 8 + xcd, qblk = it & 31;
    const int b = pair >> 4, h = pair & 15;
    const size_t row0 = (size_t)b * TL;
    const size_t qrow = row0 + qblk * 256 + wid * 32 + r32;
    const bf16_t* Kh = KVg + row0 * 2048 + h * 128;
    const bf16_t* Kp = KPg + row0 * 32;
    float m_reg = -1e30f, l_reg = 0.f;
    f32x16 o[2];
#pragma unroll
    for (int dd = 0; dd < 2; ++dd)
#pragma unroll
      for (int r = 0; r < 16; ++r) o[dd][r] = 0.f;
    bf16x8 qr[6];
    {
      const bf16_t* Qw = Qg + qrow * 1536 + h * 96 + hi * 8;
#pragma unroll
      for (int d0 = 0; d0 < 6; ++d0) qr[d0] = *(const bf16x8*)(Qw + d0 * 16);
      const int t = qblk * 256 + wid * 32 + r32;
      const f32x2* tb = rope + (hi ? (t & 63) : (t >> 6)) * 8;
      const u32x4 x1 = *(const u32x4*)&qr[4], x2 = *(const u32x4*)&qr[5];
      u32x4 n1, n2;
#pragma unroll
      for (int q = 0; q < 4; ++q) {
        const f32x2 csA = tb[2 * q], csB = tb[2 * q + 1];
        const float a0 = lo16(x1[q]), a1 = hi16(x1[q]), b0 = lo16(x2[q]), b1 = hi16(x2[q]);
        n1[q] = cvtpk(a0 * csA[0] - b0 * csA[1], a1 * csB[0] - b1 * csB[1]);
        n2[q] = cvtpk(a0 * csA[1] + b0 * csA[0], a1 * csB[1] + b1 * csB[0]);
      }
      qr[4] = *(bf16x8*)&n1; qr[5] = *(bf16x8*)&n2;
    }
    struct { bf16x8 vs, ks, ps; } sr_[2];
#define SLOAD(i, k0) do { sr_[i].vs = *(const bf16x8*)(Kh + (size_t)((k0) + skey) * 2048 + 64 + sc8); \
    sr_[i].ks = *(const bf16x8*)(Kh + (size_t)((k0) + skey) * 2048 + sc8); \
    sr_[i].ps = *(const bf16x8*)(Kp + (size_t)((k0) + pkey) * 32 + pc8); } while (0)
#define SWRITE(bb, i) do { *(bf16x8*)(V_lds + (bb) * AT_SHMV + vst) = sr_[i].vs; \
    *(bf16x8*)(K_lds + (bb) * AT_SHMK + kst) = sr_[i].ks; \
    *(bf16x8*)(K_lds + (bb) * AT_SHMK + pst) = sr_[i].ps; } while (0)
#define SWAIT() asm volatile("s_waitcnt vmcnt(3)" ::: "memory")
#define RESC(a) do { if (__any((a) < 1.f)) { if (hi == 0) al_l[r32] = (a); asm volatile("s_waitcnt lgkmcnt(0)" ::: "memory"); \
    _Pragma("unroll") for (int dd = 0; dd < 2; ++dd) _Pragma("unroll") for (int r = 0; r < 16; ++r) o[dd][r] *= al_l[crow(r, hi)]; } } while (0)
    f32x16 pA0, pA1, pB0, pB1; float mnA, mnB, alA, alB; bf16x8 pa0, pa1, pa2, pa3;
    constexpr int NT = TL / 64;
    SLOAD(0, 0); asm volatile("s_waitcnt vmcnt(0)" ::: "memory"); SWRITE(0, 0); __syncthreads();
    at_qkt(pA0, pA1, K_lds, qr, r32, hi); at_partialSM(pA0, pA1, m_reg, mnA, alA);
    SLOAD(1, 64); SLOAD(0, 128);
    SWAIT(); SWRITE(1, 1); __syncthreads();
    for (int j = 1; j + 1 < NT; j += 2) {
      SBAR(); at_qkt(pB0, pB1, K_lds + AT_SHMK, qr, r32, hi);
      at_finishSM(pA0, pA1, alA, l_reg, pa0, pa1, pa2, pa3); SBAR();
      SLOAD(1, (j + 2) * 64); SBAR();
      pv_d0(o, vb0, pa0, pa1, pa2, pa3); at_partialSM(pB0, pB1, m_reg, mnB, alB);
      __syncthreads(); SWAIT(); SWRITE(0, 0);
      RESC(alB); __syncthreads();
      SBAR(); at_qkt(pA0, pA1, K_lds, qr, r32, hi);
      at_finishSM(pB0, pB1, alB, l_reg, pa0, pa1, pa2, pa3); SBAR();
      if (j + 3 < NT) SLOAD(0, (j + 3) * 64); SBAR();
      pv_d0(o, vb0 + AT_SHMV, pa0, pa1, pa2, pa3); at_partialSM(pA0, pA1, m_reg, mnA, alA);
      __syncthreads(); SWAIT(); SWRITE(1, 1);
      RESC(alA); __syncthreads();
    }
    SBAR(); at_qkt(pB0, pB1, K_lds + AT_SHMK, qr, r32, hi);
    at_finishSM(pA0, pA1, alA, l_reg, pa0, pa1, pa2, pa3); SBAR();
    pv_d0(o, vb0, pa0, pa1, pa2, pa3); at_partialSM(pB0, pB1, m_reg, mnB, alB);
    __syncthreads(); RESC(alB);
    at_finishSM(pB0, pB1, alB, l_reg, pa0, pa1, pa2, pa3); SBAR();
    pv_d0(o, vb0 + AT_SHMV, pa0, pa1, pa2, pa3);
    if (hi == 0) li_l[r32] = l_reg;
    asm volatile("s_waitcnt lgkmcnt(0)" ::: "memory");
    float rli[16];
#pragma unroll
    for (int r = 0; r < 16; ++r) rli[r] = __builtin_amdgcn_rcpf(li_l[crow(r, hi)]);
    bf16_t* Gw = G1 + (row0 + qblk * 256 + wid * 32) * 1024 + h * 64 + r32;
#pragma unroll
    for (int r = 0; r < 16; ++r) {
      const int orow = crow(r, hi);
#pragma unroll
      for (int d0 = 0; d0 < 2; ++d0) {
        bf16_t* gp = Gw + (size_t)orow * 1024 + d0 * 32;
        const float gt = bf2f(*gp);
        *gp = f2bf(o[d0][r] * rli[r] * gt * sigmoidf_(gt));
      }
    }
    __syncthreads();
#undef SLOAD
#undef SWRITE
#undef SWAIT
#undef RESC
  }
}

__global__ __launch_bounds__(NTHR, 1) void fwd_megakernel(Params p) {
  extern __shared__ __attribute__((aligned(16))) char lds[];
  cg::grid_group grid = cg::this_grid();
  unsigned char* ws = p.ws;
  bf16_t* H = (bf16_t*)(ws + OFF_H);
  float* mod = (float*)(ws + OFF_MOD);
  float* CTX1 = (float*)(ws + OFF_CTX1);

  phase_prologue(p, lds);
  grid.sync();
  phase_norm(p.in[0], p.in[2], p.in[4], mod, H);
  grid.sync();
  {
    const bf16_t* WIN0 = (const bf16_t*)(ws + OFF_WIN0);
    for (int tile = blockIdx.x; tile < 264 * 34; tile += gridDim.x) {
      const int mt = tile / 34, nt = tile % 34, m0 = mt * 256;
      const int j = nt < 32 ? (nt >> 3) : (nt - 28);
      EpiBf16 e;
      if (nt < 32) { e.dst = (bf16_t*)(ws + OFF_R + (size_t)j * U); e.ldd = 1024; e.col0 = (nt & 7) * 128; e.act = 0; }
      else { e.dst = (bf16_t*)(ws + OFF_LORA); e.ldd = 256; e.col0 = (nt - 32) * 128; e.act = (nt == 32) ? 1 : 0; }
      e.m0 = m0; e.invK = 0.f;
      gemm_tile<1>(H, 1024, WIN0 + (size_t)nt * 128 * 1024, 1024, m0, p.in[7] + j * 1024, lds, e);
    }
  }
  grid.sync();
  phase_scan(p, lds);
  grid.sync();
  phase_readout(p);
  grid.sync();
  {
    const bf16_t* A = (const bf16_t*)(ws + OFF_G); const bf16_t* W = (const bf16_t*)(ws + OFF_WOUT0);
    for (int tile = blockIdx.x; tile < 264 * 8; tile += gridDim.x) {
      const int mt = tile >> 3, nt = tile & 7, m0 = mt * 256;
      const int b = m0 / TL, t0 = m0 - b * TL;
      EpiResid e;
      if (t0 < T) { const size_t orow = (size_t)b * T + t0; e.xin = p.in[0] + orow * 1024; e.xout = p.out + orow * 1024; e.gvec = mod + (size_t)b * 3072 + 2048; }
      else { const size_t orow = (size_t)b * L + (t0 - T); e.xin = p.in[2] + orow * 1024; e.xout = CTX1 + orow * 1024; e.gvec = mod + (size_t)8 * 3072 + 2048; }
      e.n0 = nt * 128;
      gemm_tile<0>(A, 1024, W + (size_t)nt * 128 * 1024, 1024, m0, nullptr, lds, e);
    }
  }
  grid.sync();
  phase_norm(p.out, CTX1, p.in[4] + 1024, mod + 9 * 3072, H);
  grid.sync();
  {
    const bf16_t* W = (const bf16_t*)(ws + OFF_WIN1);
    for (int tile = blockIdx.x; tile < 264 * 14; tile += gridDim.x) {
      const int mt = tile / 14, nt = tile % 14, m0 = mt * 256;
      EpiMlaIn e; e.QC = (bf16_t*)(ws + OFF_QC); e.KVC = (bf16_t*)(ws + OFF_KVC); e.KPE = (bf16_t*)(ws + OFF_KPE); e.G1 = (bf16_t*)(ws + OFF_G1);
      e.rope = (const float*)(ws + OFF_ROPE); e.nt = nt; e.m0 = m0;
      gemm_tile<0>(H, 1024, W + (size_t)nt * 128 * 1024, 1024, m0, nullptr, lds, e);
    }
  }
  grid.sync();
  {
    const bf16_t* WQ = (const bf16_t*)(ws + OFF_WQB); const bf16_t* WKV = (const bf16_t*)(ws + OFF_WKVB);
    const int nq = 256 * 12, nkv = 264 * 16;
    for (int tile = blockIdx.x; tile < nq + nkv; tile += gridDim.x) {
      EpiBf16 e; e.act = 0;
      if (tile < nq) {
        const int mt2 = tile / 12, nt = tile % 12, b = mt2 >> 5, m0 = b * TL + (mt2 & 31) * 256;
        e.dst = (bf16_t*)(ws + OFF_Q); e.ldd = 1536; e.col0 = nt * 128; e.m0 = m0; e.invK = 1.f / 384.f;
        gemm_tile<2>((const bf16_t*)(ws + OFF_QC), 384, WQ + (size_t)nt * 128 * 384, 384, m0, nullptr, lds, e);
      } else {
        const int t2 = tile - nq, mt = t2 >> 4, nt = t2 & 15, m0 = mt * 256;
        e.dst = (bf16_t*)(ws + OFF_KV); e.ldd = 2048; e.col0 = nt * 128; e.m0 = m0; e.invK = 1.f / 256.f;
        gemm_tile<2>((const bf16_t*)(ws + OFF_KVC), 256, WKV + (size_t)nt * 128 * 256, 256, m0, nullptr, lds, e);
      }
    }
  }
  grid.sync();
  phase_attn(p, lds);
  grid.sync();
  {
    const bf16_t* A = (const bf16_t*)(ws + OFF_G1); const bf16_t* W = (const bf16_t*)(ws + OFF_WOUT1);
    for (int tile = blockIdx.x; tile < 256 * 8; tile += gridDim.x) {
      const int mt2 = tile >> 3, nt = tile & 7, b = mt2 >> 5, t0 = (mt2 & 31) * 256, m0 = b * TL + t0;
      const size_t orow = (size_t)b * T + t0;
      EpiResid e; e.xin = p.out + orow * 1024; e.xout = p.out + orow * 1024; e.gvec = mod + (size_t)(9 + b) * 3072 + 2048; e.n0 = nt * 128;
      gemm_tile<0>(A, 1024, W + (size_t)nt * 128 * 1024, 1024, m0, nullptr, lds, e);
    }
  }
  grid.sync();
  phase_final(p.out, p.in[27]);
}

extern "C" void kernel_launch(void* const* d_in, const int* in_sizes, int n_in, void* d_out, int out_size, void* d_ws, size_t ws_size, hipStream_t stream) {
  static int grid_blocks = 0;
  if (grid_blocks == 0) {
    if (n_in != 28 || ws_size < WS_END || out_size != NB * T * D) { fprintf(stderr, "kernel_launch: unexpected shapes (n_in %d, ws %zu need %zu, out %d)\n", n_in, ws_size, (size_t)WS_END, out_size); grid_blocks = -1; return; }
    int dev = 0, cus = 0, per_cu = 0;
    hipGetDevice(&dev);
    hipDeviceGetAttribute(&cus, hipDeviceAttributeMultiprocessorCount, dev);
    if (hipFuncSetAttribute((const void*)fwd_megakernel, hipFuncAttributeMaxDynamicSharedMemorySize, LDS_BYTES) != hipSuccess) { fprintf(stderr, "kernel_launch: hipFuncSetAttribute failed\n"); grid_blocks = -1; return; }
    hipOccupancyMaxActiveBlocksPerMultiprocessor(&per_cu, (const void*)fwd_megakernel, NTHR, LDS_BYTES);
    if (per_cu < 1) { fprintf(stderr, "kernel_launch: occupancy query says %d blocks per CU\n", per_cu); per_cu = 1; }
    (void)hipGetLastError();
    grid_blocks = cus;
    if (grid_blocks > 256) grid_blocks = 256;
    grid_blocks &= ~7;
  }
  if (grid_blocks <= 0) return;
  Params p{};
  for (int i = 0; i < 28; ++i) p.in[i] = (const float*)d_in[i];
  p.out = (float*)d_out; p.ws = (unsigned char*)d_ws;
  void* args[] = {&p};
  hipError_t e = hipLaunchCooperativeKernel((const void*)fwd_megakernel, dim3(grid_blocks), dim3(NTHR), args, LDS_BYTES, stream);
  if (e != hipSuccess) fprintf(stderr, "cooperative launch failed: %s (grid %d)\n", hipGetErrorString(e), grid_blocks);
}
```

```cpp
#include <hip/hip_runtime.h>
#include <hip/hip_cooperative_groups.h>
#include <cstdio>
#include <cstdint>
namespace cg = cooperative_groups;

typedef unsigned short bf16_t;
typedef short bf16x8 __attribute__((ext_vector_type(8)));
typedef short s16x4 __attribute__((ext_vector_type(4)));
typedef float f32x16 __attribute__((ext_vector_type(16)));
typedef float f32x4 __attribute__((ext_vector_type(4)));
typedef float f32x2 __attribute__((ext_vector_type(2)));
typedef unsigned u32x4 __attribute__((ext_vector_type(4)));
typedef unsigned u32x2 __attribute__((ext_vector_type(2)));

constexpr int D = 1024, NB = 8, T = 8192, L = 256, TL = T + L, NTOK = NB * TL;
constexpr int NTHR = 512;

constexpr size_t U = (size_t)NTOK * 1024 * 2;
constexpr size_t OFF_H = 0, OFF_R = U, OFF_K = 2 * U, OFF_V = 3 * U, OFF_G = 4 * U, OFF_Y0 = 5 * U, OFF_Y1 = 6 * U;
constexpr size_t OFF_LORA = 7 * U;
constexpr size_t OFF_BONUS = OFF_LORA + (size_t)NTOK * 256 * 2;
constexpr size_t OFF_WIN0 = OFF_BONUS + (size_t)2 * NTOK * 16 * 4;
constexpr size_t OFF_WOUT0 = OFF_WIN0 + (size_t)4352 * 1024 * 2;
constexpr size_t OFF_WIN1 = OFF_WOUT0 + (size_t)1024 * 1024 * 2;
constexpr size_t OFF_WQB = OFF_WIN1 + (size_t)1792 * 1024 * 2;
constexpr size_t OFF_WKVB = OFF_WQB + (size_t)1536 * 384 * 2;
constexpr size_t OFF_WOUT1 = OFF_WKVB + (size_t)2048 * 256 * 2;
constexpr size_t OFF_MOD = OFF_WOUT1 + (size_t)1024 * 1024 * 2;
constexpr size_t OFF_ROPE = OFF_MOD + (size_t)2 * 9 * 3072 * 4;
constexpr size_t OFF_CTX1 = OFF_ROPE + (size_t)128 * 8 * 2 * 4;
constexpr size_t WS_END = OFF_CTX1 + (size_t)2048 * 1024 * 4;
constexpr size_t OFF_QC = OFF_V;
constexpr size_t OFF_KVC = OFF_QC + (size_t)NTOK * 384 * 2;
constexpr size_t OFF_KPE = OFF_KVC + (size_t)NTOK * 256 * 2;
constexpr size_t OFF_G1 = OFF_G;
constexpr size_t OFF_Q = OFF_R;
constexpr size_t OFF_KV = OFF_Y0;

struct Params { const float* in[28]; float* out; unsigned char* ws; };

typedef __bf16 bf16x2_t __attribute__((ext_vector_type(2)));
__device__ __forceinline__ unsigned cvtpk(float lo, float hi) { f32x2 v = {lo, hi}; bf16x2_t b = __builtin_convertvector(v, bf16x2_t); return *(unsigned*)&b; }
__device__ __forceinline__ float bf2f(bf16_t u) { return __uint_as_float(((unsigned)u) << 16); }
__device__ __forceinline__ bf16_t f2bf(float f) { return (bf16_t)(cvtpk(f, 0.f) & 0xffffu); }
__device__ __forceinline__ float lo16(unsigned w) { return __uint_as_float(w << 16); }
__device__ __forceinline__ float hi16(unsigned w) { return __uint_as_float(w & 0xffff0000u); }
__device__ __forceinline__ void st_bf16x4(bf16_t* p, float a, float b, float c, float d) { u32x2 w = {cvtpk(a, b), cvtpk(c, d)}; *(u32x2*)p = w; }
__device__ __forceinline__ float wave_sum(float v) {
#pragma unroll
  for (int o = 32; o; o >>= 1) v += __shfl_xor(v, o);
  return v;
}
__device__ __forceinline__ float dpp_f(float v, const int ctrl_sel) {
  int r;
  if (ctrl_sel == 0) r = __builtin_amdgcn_update_dpp(0, __float_as_int(v), 0xB1, 0xF, 0xF, true);
  else if (ctrl_sel == 1) r = __builtin_amdgcn_update_dpp(0, __float_as_int(v), 0x4E, 0xF, 0xF, true);
  else r = __builtin_amdgcn_update_dpp(0, __float_as_int(v), 0x141, 0xF, 0xF, true);
  return __int_as_float(r);
}
__device__ __forceinline__ float red8(float v) { v += dpp_f(v, 0); v += dpp_f(v, 1); v += dpp_f(v, 2); return v; }
__device__ __forceinline__ int crow(int r, int hi) { return (r & 3) + 8 * (r >> 2) + 4 * hi; }
__device__ __forceinline__ float sigmoidf_(float x) { return 1.f / (1.f + __expf(-x)); }
#define MFMA(a, b, c) __builtin_amdgcn_mfma_f32_32x32x16_bf16((a), (b), (c), 0, 0, 0)

constexpr int G_LDT = 144;
constexpr int G_STAGE = 256 * G_LDT + 128 * G_LDT;
constexpr int G_SSQ_OFF = 2 * G_STAGE;
constexpr int LDS_BYTES = 141056;

template <int AMODE, class Epi>
__device__ __forceinline__ void gemm_tile(const bf16_t* A, const int lda, const bf16_t* Bt, const int K, const int m0, const float* mu, char* lds, const Epi& epi) {
  const int tid = threadIdx.x, lane = tid & 63, wid = tid >> 6, r32 = lane & 31, hi = lane >> 5;
  const int wm = wid >> 1, wn = wid & 1;
  const int srow = tid >> 3, scc = (tid & 7) * 8;
  f32x16 acc[2][2];
#pragma unroll
  for (int i = 0; i < 2; ++i)
#pragma unroll
    for (int j = 0; j < 2; ++j)
#pragma unroll
      for (int r = 0; r < 16; ++r) acc[i][j][r] = 0.f;
  bf16x8 ra[4], rb[2], rp[4], rn[4];
  float ssq[4] = {0.f, 0.f, 0.f, 0.f};
  int dprev[4], dnext[4];
  if constexpr (AMODE == 1) {
    const int t0 = m0 % TL;
#pragma unroll
    for (int i = 0; i < 4; ++i) { const int t = t0 + srow + 64 * i; dprev[i] = (t != 0 && t != T) ? 1 : 0; dnext[i] = (t != T - 1 && t != TL - 1) ? 1 : 0; }
  }
  auto gload = [&](int k0) {
#pragma unroll
    for (int i = 0; i < 4; ++i) {
      const bf16_t* ap = A + (size_t)(m0 + srow + 64 * i) * lda + k0 + scc;
      ra[i] = *(const bf16x8*)ap;
      if constexpr (AMODE == 1) { rp[i] = *(const bf16x8*)(ap - dprev[i] * lda); rn[i] = *(const bf16x8*)(ap + dnext[i] * lda); }
    }
#pragma unroll
    for (int i = 0; i < 2; ++i) rb[i] = *(const bf16x8*)(Bt + (size_t)(srow + 64 * i) * K + k0 + scc);
  };
  auto lstore = [&](int s, int k0) {
    char* base = lds + s * G_STAGE;
    if constexpr (AMODE == 1) {
      const f32x4 m0v = *(const f32x4*)(mu + k0 + scc), m1v = *(const f32x4*)(mu + k0 + scc + 4);
      const float mm[8] = {m0v[0], m0v[1], m0v[2], m0v[3], m1v[0], m1v[1], m1v[2], m1v[3]};
#pragma unroll
      for (int i = 0; i < 4; ++i) {
        const u32x4 hc = *(const u32x4*)&ra[i], hp = *(const u32x4*)&rp[i], hn = *(const u32x4*)&rn[i];
        const float fp = dprev[i] ? 0.5f : 0.f, fn = dnext[i] ? 0.5f : 0.f;
        u32x4 w;
#pragma unroll
        for (int q = 0; q < 4; ++q) {
          const float c0 = lo16(hc[q]), c1 = hi16(hc[q]);
          const float x0 = fp * lo16(hp[q]) + fn * lo16(hn[q]) - c0, x1 = fp * hi16(hp[q]) + fn * hi16(hn[q]) - c1;
          w[q] = cvtpk(c0 + x0 * mm[2 * q], c1 + x1 * mm[2 * q + 1]);
        }
        *(u32x4*)(base + (srow + 64 * i) * G_LDT + scc * 2) = w;
      }
    } else {
#pragma unroll
      for (int i = 0; i < 4; ++i) {
        *(bf16x8*)(base + (srow + 64 * i) * G_LDT + scc * 2) = ra[i];
        if constexpr (AMODE == 2) {
          const u32x4 hc = *(const u32x4*)&ra[i];
#pragma unroll
          for (int q = 0; q < 4; ++q) { const float c0 = lo16(hc[q]), c1 = hi16(hc[q]); ssq[i] += c0 * c0 + c1 * c1; }
        }
      }
    }
#pragma unroll
    for (int i = 0; i < 2; ++i) *(bf16x8*)(base + 256 * G_LDT + (srow + 64 * i) * G_LDT + scc * 2) = rb[i];
  };
  const int nk = K >> 6;
  gload(0);
  lstore(0, 0);
  __syncthreads();
#pragma unroll 1
  for (int kt = 0; kt < nk; ++kt) {
    const int s = kt & 1;
    if (kt + 1 < nk) gload((kt + 1) * 64);
    {
      const char* Ab = lds + s * G_STAGE + (wm * 64 + r32) * G_LDT + hi * 16;
      const char* Bb = lds + s * G_STAGE + 256 * G_LDT + (wn * 64 + r32) * G_LDT + hi * 16;
#pragma unroll
      for (int ks = 0; ks < 4; ++ks) {
        const bf16x8 a0 = *(const bf16x8*)(Ab + ks * 32), a1 = *(const bf16x8*)(Ab + 32 * G_LDT + ks * 32);
        const bf16x8 b0 = *(const bf16x8*)(Bb + ks * 32), b1 = *(const bf16x8*)(Bb + 32 * G_LDT + ks * 32);
        acc[0][0] = MFMA(b0, a0, acc[0][0]); acc[0][1] = MFMA(b1, a0, acc[0][1]);
        acc[1][0] = MFMA(b0, a1, acc[1][0]); acc[1][1] = MFMA(b1, a1, acc[1][1]);
      }
    }
    if (kt + 1 < nk) lstore(s ^ 1, (kt + 1) * 64);
    __syncthreads();
  }
  float* ssq_l = (float*)(lds + G_SSQ_OFF);
  if constexpr (AMODE == 2) {
#pragma unroll
    for (int i = 0; i < 4; ++i) { const float v = red8(ssq[i]); if ((tid & 7) == 0) ssq_l[srow + 64 * i] = v; }
    __syncthreads();
  }
#pragma unroll
  for (int mi = 0; mi < 2; ++mi) {
    const int lrow = wm * 64 + mi * 32 + r32;
    float aux = 0.f;
    if constexpr (AMODE == 2) aux = ssq_l[lrow];
#pragma unroll
    for (int ni = 0; ni < 2; ++ni) epi(lrow, wn * 64 + ni * 32 + 4 * hi, acc[mi][ni], aux);
  }
}

struct EpiBf16 {
  bf16_t* dst; int ldd; int col0; int m0; int act; float invK;
  __device__ __forceinline__ void operator()(int lrow, int nc, const f32x16& a, float aux) const {
    float sc = 1.f;
    if (invK > 0.f) sc = rsqrtf(aux * invK + 1e-6f);
    bf16_t* p = dst + (size_t)(m0 + lrow) * ldd + col0 + nc;
#pragma unroll
    for (int g = 0; g < 4; ++g) {
      float v0 = a[4 * g] * sc, v1 = a[4 * g + 1] * sc, v2 = a[4 * g + 2] * sc, v3 = a[4 * g + 3] * sc;
      if (act) {
        v0 = 1.f - 2.f / (__expf(2.f * v0) + 1.f); v1 = 1.f - 2.f / (__expf(2.f * v1) + 1.f);
        v2 = 1.f - 2.f / (__expf(2.f * v2) + 1.f); v3 = 1.f - 2.f / (__expf(2.f * v3) + 1.f);
      }
      st_bf16x4(p + 8 * g, v0, v1, v2, v3);
    }
  }
};
struct EpiResid {
  const float* xin; float* xout; const float* gvec; int n0;
  __device__ __forceinline__ void operator()(int lrow, int nc, const f32x16& a, float) const {
    const size_t o = (size_t)lrow * 1024 + n0 + nc;
#pragma unroll
    for (int g = 0; g < 4; ++g) {
      const f32x4 xv = *(const f32x4*)(xin + o + 8 * g), gv = *(const f32x4*)(gvec + n0 + nc + 8 * g);
      f32x4 r; r[0] = xv[0] + gv[0] * a[4 * g]; r[1] = xv[1] + gv[1] * a[4 * g + 1]; r[2] = xv[2] + gv[2] * a[4 * g + 2]; r[3] = xv[3] + gv[3] * a[4 * g + 3];
      *(f32x4*)(xout + o + 8 * g) = r;
    }
  }
};
struct EpiMlaIn {
  bf16_t *QC, *KVC, *KPE, *G1; const float* rope; int nt; int m0;
  __device__ __forceinline__ void operator()(int lrow, int nc, const f32x16& a, float) const {
    const int row = m0 + lrow;
    if (nt == 5) {
      if (nc >= 32) return;
      const int t = (m0 % TL) + lrow, hi4 = nc;
      bf16_t* p = KPE + (size_t)row * 32;
      if (t < T) {
        const f32x2* tr = (const f32x2*)rope + (t >> 6) * 8 + hi4;
        const f32x2* tc = (const f32x2*)rope + (t & 63) * 8 + hi4;
        float o1[8], o2[8];
#pragma unroll
        for (int e = 0; e < 4; ++e) {
          const f32x2 cs0 = tr[e], cs1 = tc[e];
          const float x1a = a[e], x2a = a[8 + e];
          const float x1b = a[4 + e], x2b = a[12 + e];
          o1[e] = x1a * cs0[0] - x2a * cs0[1]; o2[e] = x1a * cs0[1] + x2a * cs0[0];
          o1[4 + e] = x1b * cs1[0] - x2b * cs1[1]; o2[4 + e] = x1b * cs1[1] + x2b * cs1[0];
        }
        st_bf16x4(p + hi4, o1[0], o1[1], o1[2], o1[3]);
        st_bf16x4(p + 8 + hi4, o1[4], o1[5], o1[6], o1[7]);
        st_bf16x4(p + 16 + hi4, o2[0], o2[1], o2[2], o2[3]);
        st_bf16x4(p + 24 + hi4, o2[4], o2[5], o2[6], o2[7]);
      } else {
#pragma unroll
        for (int g = 0; g < 4; ++g) st_bf16x4(p + 8 * g + hi4, a[4 * g], a[4 * g + 1], a[4 * g + 2], a[4 * g + 3]);
      }
      return;
    }
    bf16_t* p;
    if (nt < 3) p = QC + (size_t)row * 384 + nt * 128 + nc;
    else if (nt < 5) p = KVC + (size_t)row * 256 + (nt - 3) * 128 + nc;
    else p = G1 + (size_t)row * 1024 + (nt - 6) * 128 + nc;
#pragma unroll
    for (int g = 0; g < 4; ++g) st_bf16x4(p + 8 * g, a[4 * g], a[4 * g + 1], a[4 * g + 2], a[4 * g + 3]);
  }
};

__device__ void tr_job(const float* src, int ld, int K, int N, bf16_t* dst, const float* kscale, char* lds) {
  float* tile = (float*)lds;
  const int tid = threadIdx.x, nK = K >> 6, nN = (N + 63) >> 6;
  for (int tIdx = blockIdx.x; tIdx < nK * nN; tIdx += gridDim.x) {
    const int k0 = (tIdx % nK) * 64, n0 = (tIdx / nK) * 64;
#pragma unroll
    for (int i = 0; i < 8; ++i) {
      const int kk = (tid >> 6) + 8 * i, nn = tid & 63;
      float v = 0.f;
      if (n0 + nn < N) { v = src[(size_t)(k0 + kk) * ld + n0 + nn]; if (kscale) v *= kscale[k0 + kk]; }
      tile[kk * 65 + nn] = v;
    }
    __syncthreads();
#pragma unroll
    for (int i = 0; i < 8; ++i) {
      const int nn = (tid >> 6) + 8 * i, kk = tid & 63;
      if (n0 + nn < N) dst[(size_t)(n0 + nn) * K + k0 + kk] = f2bf(tile[kk * 65 + nn]);
    }
    __syncthreads();
  }
}

__device__ void phase_prologue(const Params& p, char* lds) {
  unsigned char* ws = p.ws;
  bf16_t* WIN0 = (bf16_t*)(ws + OFF_WIN0);
  for (int j = 0; j < 4; ++j) tr_job(p.in[8] + (size_t)j * 1024 * 1024, 1024, 1024, 1024, WIN0 + (size_t)j * 1024 * 1024, nullptr, lds);
  for (int d = 0; d < 2; ++d) {
    tr_job(p.in[10] + (size_t)d * 1024 * 64, 64, 1024, 64, WIN0 + (size_t)(4096 + d * 64) * 1024, nullptr, lds);
    tr_job(p.in[13] + (size_t)d * 1024 * 64, 64, 1024, 64, WIN0 + (size_t)(4224 + d * 64) * 1024, nullptr, lds);
  }
  tr_job(p.in[20], 1024, 1024, 1024, (bf16_t*)(ws + OFF_WOUT0), nullptr, lds);
  bf16_t* WIN1 = (bf16_t*)(ws + OFF_WIN1);
  tr_job(p.in[21], 1696, 1024, 640, WIN1, nullptr, lds);
  tr_job(p.in[21] + 640, 1696, 1024, 32, WIN1 + (size_t)640 * 1024, nullptr, lds);
  tr_job(p.in[21] + 672, 1696, 1024, 1024, WIN1 + (size_t)768 * 1024, nullptr, lds);
  for (int i = blockIdx.x * NTHR + threadIdx.x; i < 96 * 1024; i += gridDim.x * NTHR) WIN1[(size_t)672 * 1024 + i] = 0;
  tr_job(p.in[23], 1536, 384, 1536, (bf16_t*)(ws + OFF_WQB), p.in[22], lds);
  tr_job(p.in[25], 2048, 256, 2048, (bf16_t*)(ws + OFF_WKVB), p.in[24], lds);
  tr_job(p.in[26], 1024, 1024, 1024, (bf16_t*)(ws + OFF_WOUT1), nullptr, lds);
  {
    const int i = blockIdx.x * NTHR + threadIdx.x;
    if (i < 1024) {
      const float invf[8] = {1.f, 0.316227766016838f, 0.1f, 0.0316227766016838f, 0.01f, 0.00316227766016838f, 0.001f, 0.000316227766016838f};
      const int pos = i >> 3, m = i & 7;
      float inv = invf[0];
#pragma unroll
      for (int q = 1; q < 8; ++q) inv = (m == q) ? invf[q] : inv;
      const float ang = (float)pos * inv;
      const float kf = rintf(ang * 0.15915494309189535f);
      float r = fmaf(-kf, 6.28125f, ang);
      r = fmaf(-kf, 1.9353071795864769e-3f, r);
      float* rt = (float*)(ws + OFF_ROPE);
      rt[2 * i] = cosf(r); rt[2 * i + 1] = sinf(r);
    }
  }
  {
    float* sil = (float*)lds;
    float* red = sil + 9 * 1024;
    const int tid = threadIdx.x;
    for (int i = tid; i < 9 * 1024; i += NTHR) {
      const int bi = i >> 10, k = i & 1023;
      const float cv = bi < 8 ? p.in[1][bi * 1024 + k] : p.in[3][k];
      sil[i] = cv / (1.f + __expf(-cv));
    }
    __syncthreads();
    float* mod = (float*)(ws + OFF_MOD);
    for (int item = blockIdx.x; item < 192; item += gridDim.x) {
      const int l = item / 96, n0 = (item % 96) * 32, col = tid & 31, kg = tid >> 5;
      float acc[9];
#pragma unroll
      for (int bi = 0; bi < 9; ++bi) acc[bi] = 0.f;
      const float* wp = p.in[5] + ((size_t)l * 1024 + kg * 64) * 3072 + n0 + col;
      for (int kk = 0; kk < 64; ++kk) {
        const float w = wp[(size_t)kk * 3072];
#pragma unroll
        for (int bi = 0; bi < 9; ++bi) acc[bi] += sil[bi * 1024 + kg * 64 + kk] * w;
      }
#pragma unroll
      for (int bi = 0; bi < 9; ++bi) red[(kg * 9 + bi) * 32 + col] = acc[bi];
      __syncthreads();
      if (tid < 288) {
        const int bi = tid >> 5;
        float s = 0.f;
#pragma unroll
        for (int g = 0; g < 16; ++g) s += red[(g * 9 + bi) * 32 + col];
        mod[((size_t)l * 9 + bi) * 3072 + n0 + col] = s + p.in[6][l * 3072 + n0 + col];
      }
      __syncthreads();
    }
  }
}

__device__ void phase_norm(const float* xsrc, const float* csrc, const float* ng, const float* mod, bf16_t* H) {
  const int lane = threadIdx.x & 63, gw = blockIdx.x * 8 + (threadIdx.x >> 6), nw = gridDim.x * 8;
  for (int n = gw; n < NTOK; n += nw) {
    const int b = n / TL, t = n - b * TL;
    const float* src; int bi;
    if (t < T) { src = xsrc + ((size_t)b * T + t) * D; bi = b; } else { src = csrc + ((size_t)b * L + (t - T)) * D; bi = 8; }
    f32x4 v[4]; float ss = 0.f;
#pragma unroll
    for (int i = 0; i < 4; ++i) { v[i] = *(const f32x4*)(src + i * 256 + lane * 4); ss += v[i][0] * v[i][0] + v[i][1] * v[i][1] + v[i][2] * v[i][2] + v[i][3] * v[i][3]; }
    ss = wave_sum(ss);
    const float rstd = rsqrtf(ss * (1.f / 1024.f) + 1e-6f);
    const float* m = mod + bi * 3072;
#pragma unroll
    for (int i = 0; i < 4; ++i) {
      const int c = i * 256 + lane * 4;
      const f32x4 g4 = *(const f32x4*)(ng + c), sh = *(const f32x4*)(m + c), sc = *(const f32x4*)(m + 1024 + c);
      float o[4];
#pragma unroll
      for (int e = 0; e < 4; ++e) o[e] = v[i][e] * rstd * g4[e] * (1.f + sc[e]) + sh[e];
      st_bf16x4(H + (size_t)n * 1024 + c, o[0], o[1], o[2], o[3]);
    }
  }
}

__device__ void phase_final(float* out, const float* fg) {
  const int lane = threadIdx.x & 63, gw = blockIdx.x * 8 + (threadIdx.x >> 6), nw = gridDim.x * 8;
  for (int n = gw; n < NB * T; n += nw) {
    float* src = out + (size_t)n * D;
    f32x4 v[4]; float ss = 0.f;
#pragma unroll
    for (int i = 0; i < 4; ++i) { v[i] = *(const f32x4*)(src + i * 256 + lane * 4); ss += v[i][0] * v[i][0] + v[i][1] * v[i][1] + v[i][2] * v[i][2] + v[i][3] * v[i][3]; }
    ss = wave_sum(ss);
    const float rstd = rsqrtf(ss * (1.f / 1024.f) + 1e-6f);
#pragma unroll
    for (int i = 0; i < 4; ++i) {
      const int c = i * 256 + lane * 4;
      const f32x4 g4 = *(const f32x4*)(fg + c);
      f32x4 o;
#pragma unroll
      for (int e = 0; e < 4; ++e) o[e] = v[i][e] * rstd * g4[e];
      *(f32x4*)(src + c) = o;
    }
  }
}

__device__ __forceinline__ int scan_row(int g, int d, int b) {
  if (g < L) { const int tt = d ? (L - 1 - g) : g; return b * TL + T + tt; }
  g -= L; const int tt = d ? (T - 1 - g) : g; return b * TL + tt;
}
constexpr int SC_WD = 0, SC_AR = 8192, SC_BK = SC_AR + 33 * 256, SC_VV = SC_BK + 32768, SC_BUF = SC_VV + 8192;
constexpr int SC_IC = 2 * SC_BUF, SC_YB = SC_IC + 8192, SC_DUMP = SC_YB + 2 * 33 * 256, SC_END = SC_DUMP + 256;
#define MFMA16(a, b, c) __builtin_amdgcn_mfma_f32_16x16x32_bf16((a), (b), (c), 0, 0, 0)
struct ScCoef { u32x2 a0, a1, a2, a3; f32x4 w0, w1, w2, w3; u32x4 k0, k1, k2, k3; float vi; };
__device__ __forceinline__ ScCoef sc_ld(const char* buf, int t, int arOff, int wOff, int bkOff, int vOff) {
  ScCoef c;
  const char* ar = buf + SC_AR + t * 256 + arOff;
  c.a0 = *(const u32x2*)(ar); c.a1 = *(const u32x2*)(ar + 32); c.a2 = *(const u32x2*)(ar + 64); c.a3 = *(const u32x2*)(ar + 96);
  const char* wd = buf + SC_WD + t * 256 + wOff;
  c.w0 = *(const f32x4*)(wd); c.w1 = *(const f32x4*)(wd + 64); c.w2 = *(const f32x4*)(wd + 128); c.w3 = *(const f32x4*)(wd + 192);
  const char* bk = buf + SC_BK + t * 1024 + bkOff;
  c.k0 = *(const u32x4*)(bk); c.k1 = *(const u32x4*)(bk + 256); c.k2 = *(const u32x4*)(bk + 512); c.k3 = *(const u32x4*)(bk + 768);
  c.vi = *(const float*)(buf + SC_VV + t * 256 + vOff);
  return c;
}
__device__ void phase_scan(const Params& p, char* lds) {
  unsigned char* ws = p.ws;
  const int tid = threadIdx.x, lane = tid & 63, wid = __builtin_amdgcn_readfirstlane(tid >> 6), r32 = lane & 31, hi = lane >> 5;
  const bf16_t* Rg = (const bf16_t*)(ws + OFF_R); const bf16_t* Kg = (const bf16_t*)(ws + OFF_K); const bf16_t* Vg = (const bf16_t*)(ws + OFF_V);
  const bf16_t* Lg = (const bf16_t*)(ws + OFF_LORA);
  constexpr int NCH = TL / 32;
  for (int sidx = blockIdx.x; sidx < 256; sidx += gridDim.x) {
    const int d = sidx >> 7, b = (sidx >> 4) & 7, h = sidx & 15;
    bf16_t* Yg = (bf16_t*)(ws + (d ? OFF_Y1 : OFF_Y0));
    if (wid < 4) {
      const int cw = wid, c16 = lane & 15, q = lane >> 4;
      const int arOff = (c16 & 1) * 128 + q * 8, wOff = q * 16, bkOff = c16 * 16, vOff = (cw * 16 + c16) * 4;
      f32x4 St0 = {0.f, 0.f, 0.f, 0.f}, St1 = St0, St2 = St0, St3 = St0;
      __syncthreads();
      __syncthreads();
      for (int c = 0; c < NCH; ++c) {
        const char* buf = lds + (c & 1) * SC_BUF;
        char* yb = (q == 0) ? (lds + SC_YB + (c & 1) * (33 * 256) + (cw * 16 + c16) * 4) : (lds + SC_DUMP + lane * 4);
        const int ystride = (q == 0) ? 256 : 0;
        ScCoef cur = sc_ld(buf, 0, arOff, wOff, bkOff, vOff);
#pragma unroll 1
        for (int half = 0; half < 2; ++half) {
#pragma unroll 4
          for (int tt = 0; tt < 16; ++tt) {
            const int t = half * 16 + tt;
            const ScCoef nxt = sc_ld(buf, t + 1, arOff, wOff, bkOff, vOff);
            u32x4 b1 = {cvtpk(St0[0], St0[1]), cvtpk(St0[2], St0[3]), cvtpk(St1[0], St1[1]), cvtpk(St1[2], St1[3])};
            u32x4 b2 = {cvtpk(St2[0], St2[1]), cvtpk(St2[2], St2[3]), cvtpk(St3[0], St3[1]), cvtpk(St3[2], St3[3])};
            u32x4 a1 = {cur.a0[0], cur.a0[1], cur.a1[0], cur.a1[1]}, a2 = {cur.a2[0], cur.a2[1], cur.a3[0], cur.a3[1]};
            f32x4 out = {0.f, 0.f, 0.f, 0.f};
            out = MFMA16(*(bf16x8*)&a1, *(bf16x8*)&b1, out);
            out = MFMA16(*(bf16x8*)&a2, *(bf16x8*)&b2, out);
            St0 *= cur.w0; St1 *= cur.w1; St2 *= cur.w2; St3 *= cur.w3;
            u32x4 bu = {q == 0 ? cvtpk(out[0], cur.vi) : 0u, 0u, 0u, 0u};
            St0 = MFMA16(*(bf16x8*)&cur.k0, *(bf16x8*)&bu, St0);
            St1 = MFMA16(*(bf16x8*)&cur.k1, *(bf16x8*)&bu, St1);
            St2 = MFMA16(*(bf16x8*)&cur.k2, *(bf16x8*)&bu, St2);
            St3 = MFMA16(*(bf16x8*)&cur.k3, *(bf16x8*)&bu, St3);
            *(float*)(yb + t * ystride) = out[1];
            cur = nxt;
          }
          if (half == 1) {
            u32x4 b1 = {cvtpk(St0[0], St0[1]), cvtpk(St0[2], St0[3]), cvtpk(St1[0], St1[1]), cvtpk(St1[2], St1[3])};
            u32x4 b2 = {cvtpk(St2[0], St2[1]), cvtpk(St2[2], St2[3]), cvtpk(St3[0], St3[1]), cvtpk(St3[2], St3[3])};
            u32x4 a1 = {cur.a0[0], cur.a0[1], cur.a1[0], cur.a1[1]}, a2 = {cur.a2[0], cur.a2[1], cur.a3[0], cur.a3[1]};
            f32x4 out = {0.f, 0.f, 0.f, 0.f};
            out = MFMA16(*(bf16x8*)&a1, *(bf16x8*)&b1, out);
            out = MFMA16(*(bf16x8*)&a2, *(bf16x8*)&b2, out);
            *(float*)(yb + 32 * ystride) = out[1];
          }
          __syncthreads();
        }
      }
    } else {
      const int pw = wid - 4, ptid = tid - 256;
      const int pstep = ptid >> 3, j0 = (ptid & 7) * 8;
      float* Bg = (float*)(ws + OFF_BONUS) + (size_t)d * NTOK * 16;
      float kkc[8], kac[8], rkc[8];
#pragma unroll
      for (int e = 0; e < 8; ++e) { kkc[e] = p.in[15][h * 64 + j0 + e]; kac[e] = p.in[16][h * 64 + j0 + e]; rkc[e] = p.in[17][h * 64 + j0 + e]; }
      const int mat = pw >> 1, jh = pw & 1;
      bf16x8 w2f[4]; float bias;
      {
        const float* W2 = (mat ? p.in[14] : p.in[11]) + (size_t)d * 64 * 1024;
#pragma unroll
        for (int ks = 0; ks < 4; ++ks) {
          u32x4 w;
#pragma unroll
          for (int qq = 0; qq < 4; ++qq) {
            const int r0 = ks * 16 + 8 * hi + 2 * qq;
            w[qq] = cvtpk(W2[(size_t)r0 * 1024 + h * 64 + jh * 32 + r32], W2[(size_t)(r0 + 1) * 1024 + h * 64 + jh * 32 + r32]);
          }
          w2f[ks] = *(bf16x8*)&w;
        }
        bias = (mat ? p.in[12] : p.in[9])[d * 1024 + h * 64 + jh * 32 + r32];
      }
      u32x4 pR, pK, pV; bf16x8 pl[4];
      float kk[8], kr[8], rr[8];
      float* IC = (float*)(lds + SC_IC);
      auto prefetch = [&](int c) {
        const size_t row = (size_t)scan_row(c * 32 + pstep, d, b) * 1024 + h * 64 + j0;
        pR = *(const u32x4*)(Rg + row); pK = *(const u32x4*)(Kg + row); pV = *(const u32x4*)(Vg + row);
        const size_t lrow = (size_t)scan_row(c * 32 + r32, d, b);
#pragma unroll
        for (int ks = 0; ks < 4; ++ks) pl[ks] = *(const bf16x8*)(Lg + lrow * 256 + mat * 128 + d * 64 + ks * 16 + hi * 8);
      };
      auto stageA = [&](int c) {
        char* buf = lds + (c & 1) * SC_BUF;
        float* Wd = (float*)(buf + SC_WD); float* Vv = (float*)(buf + SC_VV); bf16_t* AR = (bf16_t*)(buf + SC_AR);
        f32x16 acc;
#pragma unroll
        for (int r = 0; r < 16; ++r) acc[r] = 0.f;
#pragma unroll
        for (int ks = 0; ks < 4; ++ks) acc = MFMA(pl[ks], w2f[ks], acc);
#pragma unroll
        for (int r = 0; r < 16; ++r) {
          const int step = crow(r, hi), j = jh * 32 + r32;
          const float sg = __builtin_amdgcn_rcpf(1.f + __expf(-(acc[r] + bias)));
          if (mat == 0) Wd[step * 64 + j] = __expf(-0.6065306597126334f * sg); else IC[step * 64 + j] = sg;
        }
        *(u32x4*)(AR + (pstep + 1) * 128 + 64 + j0) = pR;
        float ss = 0.f;
#pragma unroll
        for (int w = 0; w < 4; ++w) {
          rr[2 * w] = lo16(pR[w]); rr[2 * w + 1] = hi16(pR[w]);
          kr[2 * w] = lo16(pK[w]); kr[2 * w + 1] = hi16(pK[w]);
        }
        f32x4 v0 = {lo16(pV[0]), hi16(pV[0]), lo16(pV[1]), hi16(pV[1])}, v1 = {lo16(pV[2]), hi16(pV[2]), lo16(pV[3]), hi16(pV[3])};
        *(f32x4*)(Vv + pstep * 64 + j0) = v0; *(f32x4*)(Vv + pstep * 64 + j0 + 4) = v1;
#pragma unroll
        for (int e = 0; e < 8; ++e) { kk[e] = kr[e] * kkc[e]; ss += kk[e] * kk[e]; }
        ss = red8(ss);
        const float inv = rsqrtf(fmaxf(ss, 1e-24f));
#pragma unroll
        for (int e = 0; e < 8; ++e) kk[e] *= inv;
      };
      auto stageB = [&](int c) {
        char* buf = lds + (c & 1) * SC_BUF;
        u32x4* BK = (u32x4*)(buf + SC_BK); bf16_t* AR = (bf16_t*)(buf + SC_AR);
        const f32x4 i0 = *(const f32x4*)(IC + pstep * 64 + j0), i1 = *(const f32x4*)(IC + pstep * 64 + j0 + 4);
        const float ic[8] = {i0[0], i0[1], i0[2], i0[3], i1[0], i1[1], i1[2], i1[3]};
        u32x4 an = {cvtpk(-kk[0], -kk[1]), cvtpk(-kk[2], -kk[3]), cvtpk(-kk[4], -kk[5]), cvtpk(-kk[6], -kk[7])};
        *(u32x4*)(AR + pstep * 128 + j0) = an;
        float bs = 0.f;
#pragma unroll
        for (int e = 0; e < 8; ++e) {
          const float kd = kr[e] * (1.f + (ic[e] - 1.f) * kac[e]);
          u32x4 slot = {cvtpk(kk[e] * ic[e], kd), 0u, 0u, 0u};
          BK[pstep * 64 + j0 + e] = slot;
          bs += rr[e] * kd * rkc[e];
        }
        bs = red8(bs);
        if ((ptid & 7) == 0) Bg[(size_t)scan_row(c * 32 + pstep, d, b) * 16 + h] = bs;
      };
      auto writeout = [&](int c) {
        const float* Yb = (const float*)(lds + SC_YB + (c & 1) * (33 * 256)) + (pstep + 1) * 64 + j0;
        const f32x4 y0 = *(const f32x4*)(Yb), y1 = *(const f32x4*)(Yb + 4);
        u32x4 w = {cvtpk(y0[0], y0[1]), cvtpk(y0[2], y0[3]), cvtpk(y1[0], y1[1]), cvtpk(y1[2], y1[3])};
        *(u32x4*)(Yg + (size_t)scan_row(c * 32 + pstep, d, b) * 1024 + h * 64 + j0) = w;
      };
      prefetch(0);
      stageA(0);
      __syncthreads();
      stageB(0);
      prefetch(1);
      __syncthreads();
      for (int c = 0; c < NCH; ++c) {
        if (c >= 1) writeout(c - 1);
        if (c + 1 < NCH) stageA(c + 1);
        __syncthreads();
        if (c + 1 < NCH) { stageB(c + 1); if (c + 2 < NCH) prefetch(c + 2); }
        __syncthreads();
      }
      writeout(NCH - 1);
    }
    __syncthreads();
  }
}

__device__ void phase_readout(const Params& p) {
  unsigned char* ws = p.ws;
  const bf16_t* Y0 = (const bf16_t*)(ws + OFF_Y0); const bf16_t* Y1 = (const bf16_t*)(ws + OFF_Y1); const bf16_t* Vg = (const bf16_t*)(ws + OFF_V);
  bf16_t* G = (bf16_t*)(ws + OFF_G);
  const float* B0 = (const float*)(ws + OFF_BONUS); const float* B1 = B0 + (size_t)NTOK * 16;
  const int lane = threadIdx.x & 63, gw = blockIdx.x * 8 + (threadIdx.x >> 6), nw = gridDim.x * 8;
  const int c0 = lane * 16, hd = lane >> 2;
  float lg[16], lb[16];
#pragma unroll
  for (int e = 0; e < 16; ++e) { lg[e] = p.in[18][c0 + e]; lb[e] = p.in[19][c0 + e]; }
  for (int n = gw; n < NTOK; n += nw) {
    const size_t o = (size_t)n * 1024 + c0;
    float y[16], v[16], g[16];
#pragma unroll
    for (int q = 0; q < 2; ++q) {
      const u32x4 a = *(const u32x4*)(Y0 + o + 8 * q), bq = *(const u32x4*)(Y1 + o + 8 * q), vv = *(const u32x4*)(Vg + o + 8 * q), gg = *(const u32x4*)(G + o + 8 * q);
#pragma unroll
      for (int w = 0; w < 4; ++w) {
        y[8 * q + 2 * w] = lo16(a[w]) + lo16(bq[w]); y[8 * q + 2 * w + 1] = hi16(a[w]) + hi16(bq[w]);
        v[8 * q + 2 * w] = lo16(vv[w]); v[8 * q + 2 * w + 1] = hi16(vv[w]);
        g[8 * q + 2 * w] = lo16(gg[w]); g[8 * q + 2 * w + 1] = hi16(gg[w]);
      }
    }
    float s = 0.f;
#pragma unroll
    for (int e = 0; e < 16; ++e) s += y[e];
    s += dpp_f(s, 0); s += dpp_f(s, 1);
    const float mean = s * (1.f / 64.f);
    float q2 = 0.f;
#pragma unroll
    for (int e = 0; e < 16; ++e) { const float dlt = y[e] - mean; q2 += dlt * dlt; }
    q2 += dpp_f(q2, 0); q2 += dpp_f(q2, 1);
    const float rs = rsqrtf(q2 * (1.f / 64.f) + 64e-5f);
    const float bonus = B0[(size_t)n * 16 + hd] + B1[(size_t)n * 16 + hd];
    float r[16];
#pragma unroll
    for (int e = 0; e < 16; ++e) {
      const float yn = (y[e] - mean) * rs * lg[e] + lb[e];
      r[e] = (yn + bonus * v[e]) * (g[e] * sigmoidf_(g[e]));
    }
    u32x4 w0 = {cvtpk(r[0], r[1]), cvtpk(r[2], r[3]), cvtpk(r[4], r[5]), cvtpk(r[6], r[7])};
    u32x4 w1 = {cvtpk(r[8], r[9]), cvtpk(r[10], r[11]), cvtpk(r[12], r[13]), cvtpk(r[14], r[15])};
    *(u32x4*)(G + o) = w0; *(u32x4*)(G + o + 8) = w1;
  }
}

constexpr int AT_SHMV = 16384, AT_KROW = 208, AT_SHMK = 64 * AT_KROW;
constexpr int AT_KOFF = 2 * AT_SHMV, AT_WOFF = AT_KOFF + 2 * AT_SHMK;
constexpr float AT_SCALE = 0.10206207261596575f;
constexpr float AT_THR = 8.f;
#define SBAR() __builtin_amdgcn_sched_barrier(0)
__device__ __forceinline__ void at_partialSM(f32x16& p0, f32x16& p1, float& m_reg, float& mn, float& alpha) {
  constexpr float C = AT_SCALE * 1.4426950408889634f;
  float pmax = p0[0];
#pragma unroll
  for (int r = 1; r < 16; ++r) pmax = fmaxf(pmax, p0[r]);
#pragma unroll
  for (int r = 0; r < 16; ++r) pmax = fmaxf(pmax, p1[r]);
  { auto rr = __builtin_amdgcn_permlane32_swap(__float_as_uint(pmax), __float_as_uint(pmax), false, false);
    pmax = fmaxf(__uint_as_float(rr[0]), __uint_as_float(rr[1])); }
  if (__builtin_expect(__all(pmax - m_reg <= AT_THR / AT_SCALE), 1)) { mn = m_reg; alpha = 1.f; }
  else { mn = fmaxf(m_reg, pmax); alpha = __builtin_amdgcn_exp2f((m_reg - mn) * C); m_reg = mn; }
  const float mnC = -mn * C;
#pragma unroll
  for (int r = 0; r < 16; ++r) p0[r] = fmaf(p0[r], C, mnC);
#pragma unroll
  for (int r = 0; r < 16; ++r) p1[r] = fmaf(p1[r], C, mnC);
#pragma unroll
  for (int r = 0; r < 16; ++r) p0[r] = __builtin_amdgcn_exp2f(p0[r]);
}
__device__ __forceinline__ void at_finishSM(f32x16& p0, f32x16& p1, float alpha, float& l_reg, bf16x8& pa0, bf16x8& pa1, bf16x8& pa2, bf16x8& pa3) {
#pragma unroll
  for (int r = 0; r < 16; ++r) p1[r] = __builtin_amdgcn_exp2f(p1[r]);
  float ps = 0;
#pragma unroll
  for (int r = 0; r < 16; ++r) ps += p0[r];
#pragma unroll
  for (int r = 0; r < 16; ++r) ps += p1[r];
  { auto rr = __builtin_amdgcn_permlane32_swap(__float_as_uint(ps), __float_as_uint(ps), false, false);
    ps = __uint_as_float(rr[0]) + __uint_as_float(rr[1]); }
  l_reg = l_reg * alpha + ps;
#define PK4(P, BASE, OUT) do { unsigned a0 = cvtpk(P[BASE + 0], P[BASE + 1]), a1 = cvtpk(P[BASE + 2], P[BASE + 3]);   \
    unsigned b0 = cvtpk(P[BASE + 4], P[BASE + 5]), b1 = cvtpk(P[BASE + 6], P[BASE + 7]);                              \
    auto r0 = __builtin_amdgcn_permlane32_swap(a0, b0, false, false); auto r1 = __builtin_amdgcn_permlane32_swap(a1, b1, false, false); \
    u32x4 w = {r0[0], r1[0], r0[1], r1[1]}; OUT = *reinterpret_cast<bf16x8*>(&w); } while (0)
  PK4(p0, 0, pa0); PK4(p0, 8, pa1); PK4(p1, 0, pa2); PK4(p1, 8, pa3);
#undef PK4
}
__device__ __forceinline__ void at_qkt(f32x16& p0, f32x16& p1, const char* Ks, const bf16x8* qr, int r32, int hi) {
#pragma unroll
  for (int r = 0; r < 16; ++r) { p0[r] = 0.f; p1[r] = 0.f; }
#pragma unroll
  for (int d0 = 0; d0 < 6; ++d0) {
    const bf16x8 b0 = *(const bf16x8*)(Ks + r32 * AT_KROW + d0 * 32 + hi * 16);
    const bf16x8 b1 = *(const bf16x8*)(Ks + (32 + r32) * AT_KROW + d0 * 32 + hi * 16);
    p0 = MFMA(b0, qr[d0], p0);
    p1 = MFMA(b1, qr[d0], p1);
  }
}
__device__ __forceinline__ int v_st(int k, int c) { const int kk = (k & ~0xC) | ((k & 4) << 1) | ((k & 8) >> 1); return ((kk >> 3) * 4 + (c >> 5)) * 512 + ((kk & 7) * 32 + (c & 31)) * 2; }
__device__ __forceinline__ int v_rd_base(int lane) { return ((lane & 3) << 3) | (((lane >> 2) & 3) << 6) | (((lane >> 4) & 1) << 5) | (((lane >> 5) & 1) << 8); }
constexpr int v_rd_off(int d0, int ks, int half) { return d0 * 512 + ks * 4096 + half * 2048; }
template <int OFF> __device__ __forceinline__ s16x4 tr_read(int vb) {
  s16x4 r; asm volatile("ds_read_b64_tr_b16 %0, %1 offset:%2" : "=&v"(r) : "v"(vb), "i"(OFF) : "memory"); return r;
}
template <int D0> __device__ __forceinline__ void pv_one(f32x16& od, int vb, bf16x8 pa0, bf16x8 pa1, bf16x8 pa2, bf16x8 pa3) {
  const s16x4 l0 = tr_read<v_rd_off(D0, 0, 0)>(vb), h0 = tr_read<v_rd_off(D0, 0, 1)>(vb), l1 = tr_read<v_rd_off(D0, 1, 0)>(vb), h1 = tr_read<v_rd_off(D0, 1, 1)>(vb);
  const s16x4 l2 = tr_read<v_rd_off(D0, 2, 0)>(vb), h2 = tr_read<v_rd_off(D0, 2, 1)>(vb), l3 = tr_read<v_rd_off(D0, 3, 0)>(vb), h3 = tr_read<v_rd_off(D0, 3, 1)>(vb);
  asm volatile("s_waitcnt lgkmcnt(0)" ::: "memory"); SBAR();
#define PK(Lx, Hx) (bf16x8){Lx[0], Lx[1], Lx[2], Lx[3], Hx[0], Hx[1], Hx[2], Hx[3]}
  od = MFMA(pa0, PK(l0, h0), od);
  od = MFMA(pa1, PK(l1, h1), od);
  od = MFMA(pa2, PK(l2, h2), od);
  od = MFMA(pa3, PK(l3, h3), od);
#undef PK
}
__device__ __forceinline__ void pv_d0(f32x16* o, int vb, bf16x8 pa0, bf16x8 pa1, bf16x8 pa2, bf16x8 pa3) {
  pv_one<0>(o[0], vb, pa0, pa1, pa2, pa3); pv_one<1>(o[1], vb, pa0, pa1, pa2, pa3);
}

__device__ void phase_attn(const Params& p, char* lds) {
  unsigned char* ws = p.ws;
  const bf16_t* Qg = (const bf16_t*)(ws + OFF_Q); const bf16_t* KVg = (const bf16_t*)(ws + OFF_KV); const bf16_t* KPg = (const bf16_t*)(ws + OFF_KPE);
  bf16_t* G1 = (bf16_t*)(ws + OFF_G1);
  const f32x2* rope = (const f32x2*)(ws + OFF_ROPE);
  const int tid = threadIdx.x, wid = tid >> 6, lane = tid & 63, r32 = lane & 31, hi = lane >> 5;
  char* V_lds = lds; char* K_lds = lds + AT_KOFF;
  float* wsl = (float*)(lds + AT_WOFF) + wid * 64; float* li_l = wsl; float* al_l = wsl + 32;
  const int skey = tid >> 3, sc8 = (tid & 7) * 8;
  const int pkey = (tid & 255) >> 2, pc8 = (tid & 3) * 8;
  const int vst = v_st(skey, sc8), kst = skey * AT_KROW + sc8 * 2, pst = pkey * AT_KROW + (64 + pc8) * 2;
  const int vb0 = (int)(uintptr_t)V_lds + v_rd_base(lane);
  const int nitems = NB * 16 * 32;
  const int xcd = blockIdx.x & 7, slot = blockIdx.x >> 3, per = gridDim.x >> 3;
  for (int it = slot; it < nitems / 8; it += per) {
    const int pair = (it >> 5) * 8 + xcd, qblk = it & 31;
    const int b = pair >> 4, h = pair & 15;
    const size_t row0 = (size_t)b * TL;
    const size_t qrow = row0 + qblk * 256 + wid * 32 + r32;
    const bf16_t* Kh = KVg + row0 * 2048 + h * 128;
    const bf16_t* Kp = KPg + row0 * 32;
    float m_reg = -1e30f, l_reg = 0.f;
    f32x16 o[2];
#pragma unroll
    for (int dd = 0; dd < 2; ++dd)
#pragma unroll
      for (int r = 0; r < 16; ++r) o[dd][r] = 0.f;
    bf16x8 qr[6];
    {
      const bf16_t* Qw = Qg + qrow * 1536 + h * 96 + hi * 8;
#pragma unroll
      for (int d0 = 0; d0 < 6; ++d0) qr[d0] = *(const bf16x8*)(Qw + d0 * 16);
      const int t = qblk * 256 + wid * 32 + r32;
      const f32x2* tb = rope + (hi ? (t & 63) : (t >> 6)) * 8;
      const u32x4 x1 = *(const u32x4*)&qr[4], x2 = *(const u32x4*)&qr[5];
      u32x4 n1, n2;
#pragma unroll
      for (int q = 0; q < 4; ++q) {
        const f32x2 csA = tb[2 * q], csB = tb[2 * q + 1];
        const float a0 = lo16(x1[q]), a1 = hi16(x1[q]), b0 = lo16(x2[q]), b1 = hi16(x2[q]);
        n1[q] = cvtpk(a0 * csA[0] - b0 * csA[1], a1 * csB[0] - b1 * csB[1]);
        n2[q] = cvtpk(a0 * csA[1] + b0 * csA[0], a1 * csB[1] + b1 * csB[0]);
      }
      qr[4] = *(bf16x8*)&n1; qr[5] = *(bf16x8*)&n2;
    }
    struct { bf16x8 vs, ks, ps; } sr_[2];
#define SLOAD(i, k0) do { sr_[i].vs = *(const bf16x8*)(Kh + (size_t)((k0) + skey) * 2048 + 64 + sc8); \
    sr_[i].ks = *(const bf16x8*)(Kh + (size_t)((k0) + skey) * 2048 + sc8); \
    sr_[i].ps = *(const bf16x8*)(Kp + (size_t)((k0) + pkey) * 32 + pc8); } while (0)
#define SWRITE(bb, i) do { *(bf16x8*)(V_lds + (bb) * AT_SHMV + vst) = sr_[i].vs; \
    *(bf16x8*)(K_lds + (bb) * AT_SHMK + kst) = sr_[i].ks; \
    *(bf16x8*)(K_lds + (bb) * AT_SHMK + pst) = sr_[i].ps; } while (0)
#define SWAIT() asm volatile("s_waitcnt vmcnt(3)" ::: "memory")
#define RESC(a) do { if (__any((a) < 1.f)) { if (hi == 0) al_l[r32] = (a); asm volatile("s_waitcnt lgkmcnt(0)" ::: "memory"); \
    _Pragma("unroll") for (int dd = 0; dd < 2; ++dd) _Pragma("unroll") for (int r = 0; r < 16; ++r) o[dd][r] *= al_l[crow(r, hi)]; } } while (0)
    f32x16 pA0, pA1, pB0, pB1; float mnA, mnB, alA, alB; bf16x8 pa0, pa1, pa2, pa3;
    constexpr int NT = TL / 64;
    SLOAD(0, 0); asm volatile("s_waitcnt vmcnt(0)" ::: "memory"); SWRITE(0, 0); __syncthreads();
    at_qkt(pA0, pA1, K_lds, qr, r32, hi); at_partialSM(pA0, pA1, m_reg, mnA, alA);
    SLOAD(1, 64); SLOAD(0, 128);
    SWAIT(); SWRITE(1, 1); __syncthreads();
    for (int j = 1; j + 1 < NT; j += 2) {
      SBAR(); at_qkt(pB0, pB1, K_lds + AT_SHMK, qr, r32, hi);
      at_finishSM(pA0, pA1, alA, l_reg, pa0, pa1, pa2, pa3); SBAR();
      SLOAD(1, (j + 2) * 64); SBAR();
      pv_d0(o, vb0, pa0, pa1, pa2, pa3); at_partialSM(pB0, pB1, m_reg, mnB, alB);
      __syncthreads(); SWAIT(); SWRITE(0, 0);
      RESC(alB); __syncthreads();
      SBAR(); at_qkt(pA0, pA1, K_lds, qr, r32, hi);
      at_finishSM(pB0, pB1, alB, l_reg, pa0, pa1, pa2, pa3); SBAR();
      if (j + 3 < NT) SLOAD(0, (j + 3) * 64); SBAR();
      pv_d0(o, vb0 + AT_SHMV, pa0, pa1, pa2, pa3); at_partialSM(pA0, pA1, m_reg, mnA, alA);
      __syncthreads(); SWAIT(); SWRITE(1, 1);
      RESC(alA); __syncthreads();
    }
    SBAR(); at_qkt(pB0, pB1, K_lds + AT_SHMK, qr, r32, hi);
    at_finishSM(pA0, pA1, alA, l_reg, pa0, pa1, pa2, pa3); SBAR();
    pv_d0(o, vb0, pa0, pa1, pa2, pa3); at_partialSM(pB0, pB1, m_reg, mnB, alB);
    __syncthreads(); RESC(alB);
    at_finishSM(pB0, pB1, alB, l_reg, pa0, pa1, pa2, pa3); SBAR();
    pv_d0(o, vb0 + AT_SHMV, pa0, pa1, pa2, pa3);
    if (hi == 0) li_l[r32] = l_reg;
    asm volatile("s_waitcnt lgkmcnt(0)" ::: "memory");
    float rli[16];
#pragma unroll
    for (int r = 0; r < 16; ++r) rli[r] = __builtin_amdgcn_rcpf(li_l[crow(r, hi)]);
    bf16_t* Gw = G1 + (row0 + qblk * 256 + wid * 32) * 1024 + h * 64 + r32;
#pragma unroll
    for (int r = 0; r < 16; ++r) {
      const int orow = crow(r, hi);
#pragma unroll
      for (int d0 = 0; d0 < 2; ++d0) {
        bf16_t* gp = Gw + (size_t)orow * 1024 + d0 * 32;
        const float gt = bf2f(*gp);
        *gp = f2bf(o[d0][r] * rli[r] * gt * sigmoidf_(gt));
      }
    }
    __syncthreads();
#undef SLOAD
#undef SWRITE
#undef SWAIT
#undef RESC
  }
}

__global__ __launch_bounds__(NTHR, 1) void fwd_megakernel(Params p) {
  extern __shared__ __attribute__((aligned(16))) char lds[];
  cg::grid_group grid = cg::this_grid();
  unsigned char* ws = p.ws;
  bf16_t* H = (bf16_t*)(ws + OFF_H);
  float* mod = (float*)(ws + OFF_MOD);
  float* CTX1 = (float*)(ws + OFF_CTX1);

  phase_prologue(p, lds);
  grid.sync();
  phase_norm(p.in[0], p.in[2], p.in[4], mod, H);
  grid.sync();
  {
    const bf16_t* WIN0 = (const bf16_t*)(ws + OFF_WIN0);
    for (int tile = blockIdx.x; tile < 264 * 34; tile += gridDim.x) {
      const int mt = tile / 34, nt = tile % 34, m0 = mt * 256;
      const int j = nt < 32 ? (nt >> 3) : (nt - 28);
      EpiBf16 e;
      if (nt < 32) { e.dst = (bf16_t*)(ws + OFF_R + (size_t)j * U); e.ldd = 1024; e.col0 = (nt & 7) * 128; e.act = 0; }
      else { e.dst = (bf16_t*)(ws + OFF_LORA); e.ldd = 256; e.col0 = (nt - 32) * 128; e.act = (nt == 32) ? 1 : 0; }
      e.m0 = m0; e.invK = 0.f;
      gemm_tile<1>(H, 1024, WIN0 + (size_t)nt * 128 * 1024, 1024, m0, p.in[7] + j * 1024, lds, e);
    }
  }
  grid.sync();
  phase_scan(p, lds);
  grid.sync();
  phase_readout(p);
  grid.sync();
  {
    const bf16_t* A = (const bf16_t*)(ws + OFF_G); const bf16_t* W = (const bf16_t*)(ws + OFF_WOUT0);
    for (int tile = blockIdx.x; tile < 264 * 8; tile += gridDim.x) {
      const int mt = tile >> 3, nt = tile & 7, m0 = mt * 256;
      const int b = m0 / TL, t0 = m0 - b * TL;
      EpiResid e;
      if (t0 < T) { const size_t orow = (size_t)b * T + t0; e.xin = p.in[0] + orow * 1024; e.xout = p.out + orow * 1024; e.gvec = mod + (size_t)b * 3072 + 2048; }
      else { const size_t orow = (size_t)b * L + (t0 - T); e.xin = p.in[2] + orow * 1024; e.xout = CTX1 + orow * 1024; e.gvec = mod + (size_t)8 * 3072 + 2048; }
      e.n0 = nt * 128;
      gemm_tile<0>(A, 1024, W + (size_t)nt * 128 * 1024, 1024, m0, nullptr, lds, e);
    }
  }
  grid.sync();
  phase_norm(p.out, CTX1, p.in[4] + 1024, mod + 9 * 3072, H);
  grid.sync();
  {
    const bf16_t* W = (const bf16_t*)(ws + OFF_WIN1);
    for (int tile = blockIdx.x; tile < 264 * 14; tile += gridDim.x) {
      const int mt = tile / 14, nt = tile % 14, m0 = mt * 256;
      EpiMlaIn e; e.QC = (bf16_t*)(ws + OFF_QC); e.KVC = (bf16_t*)(ws + OFF_KVC); e.KPE = (bf16_t*)(ws + OFF_KPE); e.G1 = (bf16_t*)(ws + OFF_G1);
      e.rope = (const float*)(ws + OFF_ROPE); e.nt = nt; e.m0 = m0;
      gemm_tile<0>(H, 1024, W + (size_t)nt * 128 * 1024, 1024, m0, nullptr, lds, e);
    }
  }
  grid.sync();
  {
    const bf16_t* WQ = (const bf16_t*)(ws + OFF_WQB); const bf16_t* WKV = (const bf16_t*)(ws + OFF_WKVB);
    const int nq = 256 * 12, nkv = 264 * 16;
    for (int tile = blockIdx.x; tile < nq + nkv; tile += gridDim.x) {
      EpiBf16 e; e.act = 0;
      if (tile < nq) {
        const int mt2 = tile / 12, nt = tile % 12, b = mt2 >> 5, m0 = b * TL + (mt2 & 31) * 256;
        e.dst = (bf16_t*)(ws + OFF_Q); e.ldd = 1536; e.col0 = nt * 128; e.m0 = m0; e.invK = 1.f / 384.f;
        gemm_tile<2>((const bf16_t*)(ws + OFF_QC), 384, WQ + (size_t)nt * 128 * 384, 384, m0, nullptr, lds, e);
      } else {
        const int t2 = tile - nq, mt = t2 >> 4, nt = t2 & 15, m0 = mt * 256;
        e.dst = (bf16_t*)(ws + OFF_KV); e.ldd = 2048; e.col0 = nt * 128; e.m0 = m0; e.invK = 1.f / 256.f;
        gemm_tile<2>((const bf16_t*)(ws + OFF_KVC), 256, WKV + (size_t)nt * 128 * 256, 256, m0, nullptr, lds, e);
      }
    }
  }
  grid.sync();
  phase_attn(p, lds);
  grid.sync();
  {
    const bf16_t* A = (const bf16_t*)(ws + OFF_G1); const bf16_t* W = (const bf16_t*)(ws + OFF_WOUT1);
    for (int tile = blockIdx.x; tile < 256 * 8; tile += gridDim.x) {
      const int mt2 = tile >> 3, nt = tile & 7, b = mt2 >> 5, t0 = (mt2 & 31) * 256, m0 = b * TL + t0;
      const size_t orow = (size_t)b * T + t0;
      EpiResid e; e.xin = p.out + orow * 1024; e.xout = p.out + orow * 1024; e.gvec = mod + (size_t)(9 + b) * 3072 + 2048; e.n0 = nt * 128;
      gemm_tile<0>(A, 1024, W + (size_t)nt * 128 * 1024, 1024, m0, nullptr, lds, e);
    }
  }
  grid.sync();
  phase_final(p.out, p.in[27]);
}

extern "C" void kernel_launch(void* const* d_in, const int* in_sizes, int n_in, void* d_out, int out_size, void* d_ws, size_t ws_size, hipStream_t stream) {
  static int grid_blocks = 0;
  if (grid_blocks == 0) {
    if (n_in != 28 || ws_size < WS_END || out_size != NB * T * D) { fprintf(stderr, "kernel_launch: unexpected shapes (n_in %d, ws %zu need %zu, out %d)\n", n_in, ws_size, (size_t)WS_END, out_size); grid_blocks = -1; return; }
    int dev = 0, cus = 0, per_cu = 0;
    hipGetDevice(&dev);
    hipDeviceGetAttribute(&cus, hipDeviceAttributeMultiprocessorCount, dev);
    if (hipFuncSetAttribute((const void*)fwd_megakernel, hipFuncAttributeMaxDynamicSharedMemorySize, LDS_BYTES) != hipSuccess) { fprintf(stderr, "kernel_launch: hipFuncSetAttribute failed\n"); grid_blocks = -1; return; }
    hipOccupancyMaxActiveBlocksPerMultiprocessor(&per_cu, (const void*)fwd_megakernel, NTHR, LDS_BYTES);
    if (per_cu < 1) { fprintf(stderr, "kernel_launch: occupancy query says %d blocks per CU\n", per_cu); per_cu = 1; }
    (void)hipGetLastError();
    grid_blocks = cus;
    if (grid_blocks > 256) grid_blocks = 256;
    grid_blocks &= ~7;
  }
  if (grid_blocks <= 0) return;
  Params p{};
  for (int i = 0; i < 28; ++i) p.in[i] = (const float*)d_in[i];
  p.out = (float*)d_out; p.ws = (unsigned char*)d_ws;
  void* args[] = {&p};
  hipError_t e = hipLaunchCooperativeKernel((const void*)fwd_megakernel, dim3(grid_blocks), dim3(NTHR), args, LDS_BYTES, stream);
  if (e != hipSuccess) fprintf(stderr, "cooperative launch failed: %s (grid %d)\n", hipGetErrorString(e), grid_blocks);
}
```

```cpp
#include <hip/hip_runtime.h>
#include <hip/hip_cooperative_groups.h>
#include <cstdio>
#include <cstdint>
namespace cg = cooperative_groups;

typedef unsigned short bf16_t;
typedef short bf16x8 __attribute__((ext_vector_type(8)));
typedef short s16x4 __attribute__((ext_vector_type(4)));
typedef float f32x16 __attribute__((ext_vector_type(16)));
typedef float f32x4 __attribute__((ext_vector_type(4)));
typedef float f32x2 __attribute__((ext_vector_type(2)));
typedef unsigned u32x4 __attribute__((ext_vector_type(4)));
typedef unsigned u32x2 __attribute__((ext_vector_type(2)));

constexpr int D = 1024, NB = 8, T = 8192, L = 256, TL = T + L, NTOK = NB * TL;
constexpr int NTHR = 512;

constexpr size_t U = (size_t)NTOK * 1024 * 2;
constexpr size_t OFF_H = 0, OFF_R = U, OFF_K = 2 * U, OFF_V = 3 * U, OFF_G = 4 * U, OFF_Y0 = 5 * U, OFF_Y1 = 6 * U;
constexpr size_t OFF_LORA = 7 * U;
constexpr size_t OFF_BONUS = OFF_LORA + (size_t)NTOK * 256 * 2;
constexpr size_t OFF_WIN0 = OFF_BONUS + (size_t)2 * NTOK * 16 * 4;
constexpr size_t OFF_WOUT0 = OFF_WIN0 + (size_t)4352 * 1024 * 2;
constexpr size_t OFF_WIN1 = OFF_WOUT0 + (size_t)1024 * 1024 * 2;
constexpr size_t OFF_WQB = OFF_WIN1 + (size_t)1792 * 1024 * 2;
constexpr size_t OFF_WKVB = OFF_WQB + (size_t)1536 * 384 * 2;
constexpr size_t OFF_WOUT1 = OFF_WKVB + (size_t)2048 * 256 * 2;
constexpr size_t OFF_MOD = OFF_WOUT1 + (size_t)1024 * 1024 * 2;
constexpr size_t OFF_ROPE = OFF_MOD + (size_t)2 * 9 * 3072 * 4;
constexpr size_t OFF_CTX1 = OFF_ROPE + (size_t)128 * 8 * 2 * 4;
constexpr size_t WS_END = OFF_CTX1 + (size_t)2048 * 1024 * 4;
constexpr size_t OFF_QC = OFF_V;
constexpr size_t OFF_KVC = OFF_QC + (size_t)NTOK * 384 * 2;
constexpr size_t OFF_KPE = OFF_KVC + (size_t)NTOK * 256 * 2;
constexpr size_t OFF_G1 = OFF_G;
constexpr size_t OFF_Q = OFF_R;
constexpr size_t OFF_KV = OFF_Y0;

struct Params { const float* in[28]; float* out; unsigned char* ws; };

typedef __bf16 bf16x2_t __attribute__((ext_vector_type(2)));
__device__ __forceinline__ unsigned cvtpk(float lo, float hi) { f32x2 v = {lo, hi}; bf16x2_t b = __builtin_convertvector(v, bf16x2_t); return *(unsigned*)&b; }
__device__ __forceinline__ float bf2f(bf16_t u) { return __uint_as_float(((unsigned)u) << 16); }
__device__ __forceinline__ bf16_t f2bf(float f) { return (bf16_t)(cvtpk(f, 0.f) & 0xffffu); }
__device__ __forceinline__ float lo16(unsigned w) { return __uint_as_float(w << 16); }
__device__ __forceinline__ float hi16(unsigned w) { return __uint_as_float(w & 0xffff0000u); }
__device__ __forceinline__ void st_bf16x4(bf16_t* p, float a, float b, float c, float d) { u32x2 w = {cvtpk(a, b), cvtpk(c, d)}; *(u32x2*)p = w; }
__device__ __forceinline__ float wave_sum(float v) {
#pragma unroll
  for (int o = 32; o; o >>= 1) v += __shfl_xor(v, o);
  return v;
}
__device__ __forceinline__ float dpp_f(float v, const int ctrl_sel) {
  int r;
  if (ctrl_sel == 0) r = __builtin_amdgcn_update_dpp(0, __float_as_int(v), 0xB1, 0xF, 0xF, true);
  else if (ctrl_sel == 1) r = __builtin_amdgcn_update_dpp(0, __float_as_int(v), 0x4E, 0xF, 0xF, true);
  else r = __builtin_amdgcn_update_dpp(0, __float_as_int(v), 0x141, 0xF, 0xF, true);
  return __int_as_float(r);
}
__device__ __forceinline__ float red8(float v) { v += dpp_f(v, 0); v += dpp_f(v, 1); v += dpp_f(v, 2); return v; }
__device__ __forceinline__ int crow(int r, int hi) { return (r & 3) + 8 * (r >> 2) + 4 * hi; }
__device__ __forceinline__ float sigmoidf_(float x) { return 1.f / (1.f + __expf(-x)); }
#define MFMA(a, b, c) __builtin_amdgcn_mfma_f32_32x32x16_bf16((a), (b), (c), 0, 0, 0)

constexpr int G_LDT = 144;
constexpr int G_SSQ_OFF = 2 * (256 + 256) * G_LDT;
constexpr int LDS_BYTES = G_SSQ_OFF + 1024;

template <int AMODE, int BN, class Epi>
__device__ __forceinline__ void gemm_tile(const bf16_t* A, const int lda, const bf16_t* Bt, const int K, const int m0, const float* mu, char* lds, const Epi& epi) {
  constexpr int WN = BN / 64, MI = WN, NBR = BN / 64, G_STAGE = (256 + BN) * G_LDT;
  const int tid = threadIdx.x, lane = tid & 63, wid = tid >> 6, r32 = lane & 31, hi = lane >> 5;
  const int wm = wid / WN, wn = wid % WN;
  const int srow = tid >> 3, scc = (tid & 7) * 8;
  f32x16 acc[MI][2];
#pragma unroll
  for (int i = 0; i < MI; ++i)
#pragma unroll
    for (int j = 0; j < 2; ++j)
#pragma unroll
      for (int r = 0; r < 16; ++r) acc[i][j][r] = 0.f;
  bf16x8 ra[4], rb[NBR], rp[4], rn[4];
  float ssq[4] = {0.f, 0.f, 0.f, 0.f};
  int dprev[4], dnext[4];
  if constexpr (AMODE == 1) {
    const int t0 = m0 % TL;
#pragma unroll
    for (int i = 0; i < 4; ++i) { const int t = t0 + srow + 64 * i; dprev[i] = (t != 0 && t != T) ? 1 : 0; dnext[i] = (t != T - 1 && t != TL - 1) ? 1 : 0; }
  }
  auto gload = [&](int k0) {
#pragma unroll
    for (int i = 0; i < 4; ++i) {
      const bf16_t* ap = A + (size_t)(m0 + srow + 64 * i) * lda + k0 + scc;
      ra[i] = *(const bf16x8*)ap;
      if constexpr (AMODE == 1) { rp[i] = *(const bf16x8*)(ap - dprev[i] * lda); rn[i] = *(const bf16x8*)(ap + dnext[i] * lda); }
    }
#pragma unroll
    for (int i = 0; i < NBR; ++i) rb[i] = *(const bf16x8*)(Bt + (size_t)(srow + 64 * i) * K + k0 + scc);
  };
  auto lstore = [&](int s, int k0) {
    char* base = lds + s * G_STAGE;
    if constexpr (AMODE == 1) {
      const f32x4 m0v = *(const f32x4*)(mu + k0 + scc), m1v = *(const f32x4*)(mu + k0 + scc + 4);
      const float mm[8] = {m0v[0], m0v[1], m0v[2], m0v[3], m1v[0], m1v[1], m1v[2], m1v[3]};
#pragma unroll
      for (int i = 0; i < 4; ++i) {
        const u32x4 hc = *(const u32x4*)&ra[i], hp = *(const u32x4*)&rp[i], hn = *(const u32x4*)&rn[i];
        const float fp = dprev[i] ? 0.5f : 0.f, fn = dnext[i] ? 0.5f : 0.f;
        u32x4 w;
#pragma unroll
        for (int q = 0; q < 4; ++q) {
          const float c0 = lo16(hc[q]), c1 = hi16(hc[q]);
          const float x0 = fp * lo16(hp[q]) + fn * lo16(hn[q]) - c0, x1 = fp * hi16(hp[q]) + fn * hi16(hn[q]) - c1;
          w[q] = cvtpk(c0 + x0 * mm[2 * q], c1 + x1 * mm[2 * q + 1]);
        }
        *(u32x4*)(base + (srow + 64 * i) * G_LDT + scc * 2) = w;
      }
    } else {
#pragma unroll
      for (int i = 0; i < 4; ++i) {
        *(bf16x8*)(base + (srow + 64 * i) * G_LDT + scc * 2) = ra[i];
        if constexpr (AMODE == 2) {
          const u32x4 hc = *(const u32x4*)&ra[i];
#pragma unroll
          for (int q = 0; q < 4; ++q) { const float c0 = lo16(hc[q]), c1 = hi16(hc[q]); ssq[i] += c0 * c0 + c1 * c1; }
        }
      }
    }
#pragma unroll
    for (int i = 0; i < NBR; ++i) *(bf16x8*)(base + 256 * G_LDT + (srow + 64 * i) * G_LDT + scc * 2) = rb[i];
  };
  const int nk = K >> 6;
  gload(0);
  lstore(0, 0);
  __syncthreads();
#pragma unroll 1
  for (int kt = 0; kt < nk; ++kt) {
    const int s = kt & 1;
    if (kt + 1 < nk) gload((kt + 1) * 64);
    {
      const char* Ab = lds + s * G_STAGE + (wm * (32 * MI) + r32) * G_LDT + hi * 16;
      const char* Bb = lds + s * G_STAGE + 256 * G_LDT + (wn * 64 + r32) * G_LDT + hi * 16;
#pragma unroll 2
      for (int ks = 0; ks < 4; ++ks) {
        const bf16x8 b0 = *(const bf16x8*)(Bb + ks * 32), b1 = *(const bf16x8*)(Bb + 32 * G_LDT + ks * 32);
#pragma unroll
        for (int mi = 0; mi < MI; ++mi) {
          const bf16x8 a0 = *(const bf16x8*)(Ab + mi * 32 * G_LDT + ks * 32);
          acc[mi][0] = MFMA(b0, a0, acc[mi][0]); acc[mi][1] = MFMA(b1, a0, acc[mi][1]);
        }
      }
    }
    if (kt + 1 < nk) lstore(s ^ 1, (kt + 1) * 64);
    __syncthreads();
  }
  float* ssq_l = (float*)(lds + G_SSQ_OFF);
  if constexpr (AMODE == 2) {
#pragma unroll
    for (int i = 0; i < 4; ++i) { const float v = red8(ssq[i]); if ((tid & 7) == 0) ssq_l[srow + 64 * i] = v; }
    __syncthreads();
  }
#pragma unroll
  for (int mi = 0; mi < MI; ++mi) {
    const int lrow = wm * (32 * MI) + mi * 32 + r32;
    float aux = 0.f;
    if constexpr (AMODE == 2) aux = ssq_l[lrow];
#pragma unroll
    for (int ni = 0; ni < 2; ++ni) epi(lrow, wn * 64 + ni * 32 + 4 * hi, acc[mi][ni], aux);
  }
}

struct EpiBf16 {
  bf16_t* dst; int ldd; int col0; int m0; int act; float invK;
  __device__ __forceinline__ void operator()(int lrow, int nc, const f32x16& a, float aux) const {
    float sc = 1.f;
    if (invK > 0.f) sc = rsqrtf(aux * invK + 1e-6f);
    bf16_t* p = dst + (size_t)(m0 + lrow) * ldd + col0 + nc;
#pragma unroll
    for (int g = 0; g < 4; ++g) {
      float v0 = a[4 * g] * sc, v1 = a[4 * g + 1] * sc, v2 = a[4 * g + 2] * sc, v3 = a[4 * g + 3] * sc;
      if (act) {
        v0 = 1.f - 2.f / (__expf(2.f * v0) + 1.f); v1 = 1.f - 2.f / (__expf(2.f * v1) + 1.f);
        v2 = 1.f - 2.f / (__expf(2.f * v2) + 1.f); v3 = 1.f - 2.f / (__expf(2.f * v3) + 1.f);
      }
      st_bf16x4(p + 8 * g, v0, v1, v2, v3);
    }
  }
};
struct EpiResid {
  const float* xin; float* xout; const float* gvec; int n0;
  __device__ __forceinline__ void operator()(int lrow, int nc, const f32x16& a, float) const {
    const size_t o = (size_t)lrow * 1024 + n0 + nc;
#pragma unroll
    for (int g = 0; g < 4; ++g) {
      const f32x4 xv = *(const f32x4*)(xin + o + 8 * g), gv = *(const f32x4*)(gvec + n0 + nc + 8 * g);
      f32x4 r; r[0] = xv[0] + gv[0] * a[4 * g]; r[1] = xv[1] + gv[1] * a[4 * g + 1]; r[2] = xv[2] + gv[2] * a[4 * g + 2]; r[3] = xv[3] + gv[3] * a[4 * g + 3];
      *(f32x4*)(xout + o + 8 * g) = r;
    }
  }
};
struct EpiMlaIn {
  bf16_t *QC, *KVC, *KPE, *G1; const float* rope; int n0; int m0;
  __device__ __forceinline__ void operator()(int lrow, int nc, const f32x16& a, float) const {
    const int row = m0 + lrow, gc = n0 + nc, g32 = gc & ~31;
    if (g32 == 640) {
      const int t = (m0 % TL) + lrow, hi4 = gc - 640;
      bf16_t* p = KPE + (size_t)row * 32;
      if (t < T) {
        const f32x2* tr = (const f32x2*)rope + (t >> 6) * 8 + hi4;
        const f32x2* tc = (const f32x2*)rope + (t & 63) * 8 + hi4;
        float o1[8], o2[8];
#pragma unroll
        for (int e = 0; e < 4; ++e) {
          const f32x2 cs0 = tr[e], cs1 = tc[e];
          const float x1a = a[e], x2a = a[8 + e];
          const float x1b = a[4 + e], x2b = a[12 + e];
          o1[e] = x1a * cs0[0] - x2a * cs0[1]; o2[e] = x1a * cs0[1] + x2a * cs0[0];
          o1[4 + e] = x1b * cs1[0] - x2b * cs1[1]; o2[4 + e] = x1b * cs1[1] + x2b * cs1[0];
        }
        st_bf16x4(p + hi4, o1[0], o1[1], o1[2], o1[3]);
        st_bf16x4(p + 8 + hi4, o1[4], o1[5], o1[6], o1[7]);
        st_bf16x4(p + 16 + hi4, o2[0], o2[1], o2[2], o2[3]);
        st_bf16x4(p + 24 + hi4, o2[4], o2[5], o2[6], o2[7]);
      } else {
#pragma unroll
        for (int g = 0; g < 4; ++g) st_bf16x4(p + 8 * g + hi4, a[4 * g], a[4 * g + 1], a[4 * g + 2], a[4 * g + 3]);
      }
      return;
    }
    if (g32 > 640 && g32 < 768) return;
    bf16_t* p;
    if (gc < 384) p = QC + (size_t)row * 384 + gc;
    else if (gc < 640) p = KVC + (size_t)row * 256 + (gc - 384);
    else p = G1 + (size_t)row * 1024 + (gc - 768);
#pragma unroll
    for (int g = 0; g < 4; ++g) st_bf16x4(p + 8 * g, a[4 * g], a[4 * g + 1], a[4 * g + 2], a[4 * g + 3]);
  }
};

__device__ void tr_job(const float* src, int ld, int K, int N, bf16_t* dst, const float* kscale, char* lds) {
  float* tile = (float*)lds;
  const int tid = threadIdx.x, nK = K >> 6, nN = (N + 63) >> 6;
  for (int tIdx = blockIdx.x; tIdx < nK * nN; tIdx += gridDim.x) {
    const int k0 = (tIdx % nK) * 64, n0 = (tIdx / nK) * 64;
#pragma unroll
    for (int i = 0; i < 8; ++i) {
      const int kk = (tid >> 6) + 8 * i, nn = tid & 63;
      float v = 0.f;
      if (n0 + nn < N) { v = src[(size_t)(k0 + kk) * ld + n0 + nn]; if (kscale) v *= kscale[k0 + kk]; }
      tile[kk * 65 + nn] = v;
    }
    __syncthreads();
#pragma unroll
    for (int i = 0; i < 8; ++i) {
      const int nn = (tid >> 6) + 8 * i, kk = tid & 63;
      if (n0 + nn < N) dst[(size_t)(n0 + nn) * K + k0 + kk] = f2bf(tile[kk * 65 + nn]);
    }
    __syncthreads();
  }
}

__device__ void phase_prologue(const Params& p, char* lds) {
  unsigned char* ws = p.ws;
  bf16_t* WIN0 = (bf16_t*)(ws + OFF_WIN0);
  for (int j = 0; j < 4; ++j) tr_job(p.in[8] + (size_t)j * 1024 * 1024, 1024, 1024, 1024, WIN0 + (size_t)j * 1024 * 1024, nullptr, lds);
  for (int d = 0; d < 2; ++d) {
    tr_job(p.in[10] + (size_t)d * 1024 * 64, 64, 1024, 64, WIN0 + (size_t)(4096 + d * 64) * 1024, nullptr, lds);
    tr_job(p.in[13] + (size_t)d * 1024 * 64, 64, 1024, 64, WIN0 + (size_t)(4224 + d * 64) * 1024, nullptr, lds);
  }
  tr_job(p.in[20], 1024, 1024, 1024, (bf16_t*)(ws + OFF_WOUT0), nullptr, lds);
  bf16_t* WIN1 = (bf16_t*)(ws + OFF_WIN1);
  tr_job(p.in[21], 1696, 1024, 640, WIN1, nullptr, lds);
  tr_job(p.in[21] + 640, 1696, 1024, 32, WIN1 + (size_t)640 * 1024, nullptr, lds);
  tr_job(p.in[21] + 672, 1696, 1024, 1024, WIN1 + (size_t)768 * 1024, nullptr, lds);
  for (int i = blockIdx.x * NTHR + threadIdx.x; i < 96 * 1024; i += gridDim.x * NTHR) WIN1[(size_t)672 * 1024 + i] = 0;
  tr_job(p.in[23], 1536, 384, 1536, (bf16_t*)(ws + OFF_WQB), p.in[22], lds);
  tr_job(p.in[25], 2048, 256, 2048, (bf16_t*)(ws + OFF_WKVB), p.in[24], lds);
  tr_job(p.in[26], 1024, 1024, 1024, (bf16_t*)(ws + OFF_WOUT1), nullptr, lds);
  {
    const int i = blockIdx.x * NTHR + threadIdx.x;
    if (i < 1024) {
      const float invf[8] = {1.f, 0.316227766016838f, 0.1f, 0.0316227766016838f, 0.01f, 0.00316227766016838f, 0.001f, 0.000316227766016838f};
      const int pos = i >> 3, m = i & 7;
      float inv = invf[0];
#pragma unroll
      for (int q = 1; q < 8; ++q) inv = (m == q) ? invf[q] : inv;
      const float ang = (float)pos * inv;
      const float kf = rintf(ang * 0.15915494309189535f);
      float r = fmaf(-kf, 6.28125f, ang);
      r = fmaf(-kf, 1.9353071795864769e-3f, r);
      float* rt = (float*)(ws + OFF_ROPE);
      rt[2 * i] = cosf(r); rt[2 * i + 1] = sinf(r);
    }
  }
  {
    float* sil = (float*)lds;
    float* red = sil + 9 * 1024;
    const int tid = threadIdx.x;
    for (int i = tid; i < 9 * 1024; i += NTHR) {
      const int bi = i >> 10, k = i & 1023;
      const float cv = bi < 8 ? p.in[1][bi * 1024 + k] : p.in[3][k];
      sil[i] = cv / (1.f + __expf(-cv));
    }
    __syncthreads();
    float* mod = (float*)(ws + OFF_MOD);
    for (int item = blockIdx.x; item < 192; item += gridDim.x) {
      const int l = item / 96, n0 = (item % 96) * 32, col = tid & 31, kg = tid >> 5;
      float acc[9];
#pragma unroll
      for (int bi = 0; bi < 9; ++bi) acc[bi] = 0.f;
      const float* wp = p.in[5] + ((size_t)l * 1024 + kg * 64) * 3072 + n0 + col;
      for (int kk = 0; kk < 64; ++kk) {
        const float w = wp[(size_t)kk * 3072];
#pragma unroll
        for (int bi = 0; bi < 9; ++bi) acc[bi] += sil[bi * 1024 + kg * 64 + kk] * w;
      }
#pragma unroll
      for (int bi = 0; bi < 9; ++bi) red[(kg * 9 + bi) * 32 + col] = acc[bi];
      __syncthreads();
      if (tid < 288) {
        const int bi = tid >> 5;
        float s = 0.f;
#pragma unroll
        for (int g = 0; g < 16; ++g) s += red[(g * 9 + bi) * 32 + col];
        mod[((size_t)l * 9 + bi) * 3072 + n0 + col] = s + p.in[6][l * 3072 + n0 + col];
      }
      __syncthreads();
    }
  }
}

__device__ void phase_norm(const float* xsrc, const float* csrc, const float* ng, const float* mod, bf16_t* H) {
  const int lane = threadIdx.x & 63, gw = blockIdx.x * 8 + (threadIdx.x >> 6), nw = gridDim.x * 8;
  for (int n = gw; n < NTOK; n += nw) {
    const int b = n / TL, t = n - b * TL;
    const float* src; int bi;
    if (t < T) { src = xsrc + ((size_t)b * T + t) * D; bi = b; } else { src = csrc + ((size_t)b * L + (t - T)) * D; bi = 8; }
    f32x4 v[4]; float ss = 0.f;
#pragma unroll
    for (int i = 0; i < 4; ++i) { v[i] = *(const f32x4*)(src + i * 256 + lane * 4); ss += v[i][0] * v[i][0] + v[i][1] * v[i][1] + v[i][2] * v[i][2] + v[i][3] * v[i][3]; }
    ss = wave_sum(ss);
    const float rstd = rsqrtf(ss * (1.f / 1024.f) + 1e-6f);
    const float* m = mod + bi * 3072;
#pragma unroll
    for (int i = 0; i < 4; ++i) {
      const int c = i * 256 + lane * 4;
      const f32x4 g4 = *(const f32x4*)(ng + c), sh = *(const f32x4*)(m + c), sc = *(const f32x4*)(m + 1024 + c);
      float o[4];
#pragma unroll
      for (int e = 0; e < 4; ++e) o[e] = v[i][e] * rstd * g4[e] * (1.f + sc[e]) + sh[e];
      st_bf16x4(H + (size_t)n * 1024 + c, o[0], o[1], o[2], o[3]);
    }
  }
}

constexpr int LERP3_SPLIT = 63488;
__device__ __forceinline__ bf16_t* lerp_base(const Params& p, int j, int row) {
  if (j == 0) return (bf16_t*)(p.ws + OFF_Y0);
  if (j == 1) return (bf16_t*)(p.ws + OFF_Y1);
  if (j == 2) return (bf16_t*)p.out;
  if (row < LERP3_SPLIT) return (bf16_t*)p.out + (size_t)NTOK * 1024;
  return (bf16_t*)(p.ws + WS_END) - (size_t)LERP3_SPLIT * 1024;
}
__device__ __forceinline__ void norm_row(const Params& p, const float* mod, int n, int lane, float (&h)[16]) {
  const int b = n / TL, t = n - b * TL;
  const float* src; int bi;
  if (t < T) { src = p.in[0] + ((size_t)b * T + t) * D; bi = b; } else { src = p.in[2] + ((size_t)b * L + (t - T)) * D; bi = 8; }
  f32x4 v[4]; float ss = 0.f;
#pragma unroll
  for (int i = 0; i < 4; ++i) { v[i] = *(const f32x4*)(src + i * 256 + lane * 4); ss += v[i][0] * v[i][0] + v[i][1] * v[i][1] + v[i][2] * v[i][2] + v[i][3] * v[i][3]; }
  ss = wave_sum(ss);
  const float rstd = rsqrtf(ss * (1.f / 1024.f) + 1e-6f);
  const float* m = mod + bi * 3072;
#pragma unroll
  for (int i = 0; i < 4; ++i) {
    const int c = i * 256 + lane * 4;
    const f32x4 g4 = *(const f32x4*)(p.in[4] + c), sh = *(const f32x4*)(m + c), sc = *(const f32x4*)(m + 1024 + c);
#pragma unroll
    for (int e = 0; e < 4; ++e) {
      const float hv = v[i][e] * rstd * g4[e] * (1.f + sc[e]) + sh[e];
      h[4 * i + e] = __uint_as_float(cvtpk(hv, 0.f) << 16);
    }
  }
}
__device__ void phase_norm_lerp(const Params& p, const float* mod) {
  const int lane = threadIdx.x & 63, gw = blockIdx.x * 8 + (threadIdx.x >> 6), nw = gridDim.x * 8;
  const int per = (NTOK + nw - 1) / nw;
  const int r0 = gw * per, r1 = (r0 + per < NTOK) ? r0 + per : NTOK;
  if (r0 >= r1) return;
  bf16_t* H = (bf16_t*)(p.ws + OFF_H);
  float mu[4][16];
#pragma unroll
  for (int j = 0; j < 4; ++j)
#pragma unroll
    for (int i = 0; i < 4; ++i) {
      const f32x4 m4 = *(const f32x4*)(p.in[7] + j * 1024 + i * 256 + lane * 4);
      mu[j][4 * i] = m4[0]; mu[j][4 * i + 1] = m4[1]; mu[j][4 * i + 2] = m4[2]; mu[j][4 * i + 3] = m4[3];
    }
  float hp[16], hc[16], hn[16];
  if (r0 > 0) norm_row(p, mod, r0 - 1, lane, hp);
  else {
#pragma unroll
    for (int e = 0; e < 16; ++e) hp[e] = 0.f;
  }
  norm_row(p, mod, r0, lane, hc);
  for (int n = r0; n < r1; ++n) {
    const int t = n % TL;
    if (n + 1 < NTOK) norm_row(p, mod, n + 1, lane, hn);
    else {
#pragma unroll
      for (int e = 0; e < 16; ++e) hn[e] = 0.f;
    }
    const float fp = (t != 0 && t != T) ? 0.5f : 0.f, fn = (t != T - 1 && t != TL - 1) ? 0.5f : 0.f;
#pragma unroll
    for (int i = 0; i < 4; ++i) st_bf16x4(H + (size_t)n * 1024 + i * 256 + lane * 4, hc[4 * i], hc[4 * i + 1], hc[4 * i + 2], hc[4 * i + 3]);
#pragma unroll
    for (int j = 0; j < 4; ++j) {
      bf16_t* dst = lerp_base(p, j, n) + (size_t)n * 1024 + lane * 4;
#pragma unroll
      for (int i = 0; i < 4; ++i) {
        float o[4];
#pragma unroll
        for (int e = 0; e < 4; ++e) { const float c = hc[4 * i + e]; o[e] = c + (fp * hp[4 * i + e] + fn * hn[4 * i + e] - c) * mu[j][4 * i + e]; }
        st_bf16x4(dst + i * 256, o[0], o[1], o[2], o[3]);
      }
    }
#pragma unroll
    for (int e = 0; e < 16; ++e) { hp[e] = hc[e]; hc[e] = hn[e]; }
  }
}

__device__ void phase_final(float* out, const float* fg) {
  const int lane = threadIdx.x & 63, gw = blockIdx.x * 8 + (threadIdx.x >> 6), nw = gridDim.x * 8;
  for (int n = gw; n < NB * T; n += nw) {
    float* src = out + (size_t)n * D;
    f32x4 v[4]; float ss = 0.f;
#pragma unroll
    for (int i = 0; i < 4; ++i) { v[i] = *(const f32x4*)(src + i * 256 + lane * 4); ss += v[i][0] * v[i][0] + v[i][1] * v[i][1] + v[i][2] * v[i][2] + v[i][3] * v[i][3]; }
    ss = wave_sum(ss);
    const float rstd = rsqrtf(ss * (1.f / 1024.f) + 1e-6f);
#pragma unroll
    for (int i = 0; i < 4; ++i) {
      const int c = i * 256 + lane * 4;
      const f32x4 g4 = *(const f32x4*)(fg + c);
      f32x4 o;
#pragma unroll
      for (int e = 0; e < 4; ++e) o[e] = v[i][e] * rstd * g4[e];
      *(f32x4*)(src + c) = o;
    }
  }
}

__device__ __forceinline__ int scan_row(int g, int d, int b) {
  if (g < L) { const int tt = d ? (L - 1 - g) : g; return b * TL + T + tt; }
  g -= L; const int tt = d ? (T - 1 - g) : g; return b * TL + tt;
}
constexpr int SC_WD = 0, SC_AR = 8192, SC_BK = SC_AR + 33 * 256, SC_VV = SC_BK + 32768, SC_BUF = SC_VV + 8192;
constexpr int SC_IC = 2 * SC_BUF, SC_YB = SC_IC + 8192, SC_DUMP = SC_YB + 2 * 33 * 256, SC_END = SC_DUMP + 256;
#define MFMA16(a, b, c) __builtin_amdgcn_mfma_f32_16x16x32_bf16((a), (b), (c), 0, 0, 0)
struct ScCoef { u32x4 a0, a1; f32x4 w0, w1, w2, w3; u32x4 k0, k1, k2, k3; float vi; };
__device__ __forceinline__ ScCoef sc_ld(const char* buf, int t, int arOff, int wOff, int bkOff, int vOff) {
  ScCoef c;
  const char* ar = buf + SC_AR + t * 256 + arOff;
  c.a0 = *(const u32x4*)(ar); c.a1 = *(const u32x4*)(ar + 64);
  const char* wd = buf + SC_WD + t * 256 + wOff;
  c.w0 = *(const f32x4*)(wd); c.w1 = *(const f32x4*)(wd + 64); c.w2 = *(const f32x4*)(wd + 128); c.w3 = *(const f32x4*)(wd + 192);
  const char* bk = buf + SC_BK + t * 1024 + bkOff;
  c.k0 = *(const u32x4*)(bk); c.k1 = *(const u32x4*)(bk + 256); c.k2 = *(const u32x4*)(bk + 512); c.k3 = *(const u32x4*)(bk + 768);
  c.vi = *(const float*)(buf + SC_VV + t * 256 + vOff);
  return c;
}
__device__ void phase_scan(const Params& p, char* lds) {
  unsigned char* ws = p.ws;
  const int tid = threadIdx.x, lane = tid & 63, wid = __builtin_amdgcn_readfirstlane(tid >> 6), r32 = lane & 31, hi = lane >> 5;
  const bf16_t* Rg = (const bf16_t*)(ws + OFF_R); const bf16_t* Kg = (const bf16_t*)(ws + OFF_K); const bf16_t* Vg = (const bf16_t*)(ws + OFF_V);
  const bf16_t* Lg = (const bf16_t*)(ws + OFF_LORA);
  constexpr int NCH = TL / 32;
  for (int sidx = blockIdx.x; sidx < 256; sidx += gridDim.x) {
    const int d = sidx >> 7, b = (sidx >> 4) & 7, h = sidx & 15;
    bf16_t* Yg = (bf16_t*)(ws + (d ? OFF_Y1 : OFF_Y0));
    if (wid < 4) {
      const int cw = wid, c16 = lane & 15, q = lane >> 4;
      const int arOff = (c16 & 1) * 128 + q * 16, wOff = q * 16, bkOff = c16 * 16, vOff = (cw * 16 + c16) * 4;
      f32x4 St0 = {0.f, 0.f, 0.f, 0.f}, St1 = St0, St2 = St0, St3 = St0;
      __syncthreads();
      __syncthreads();
      for (int c = 0; c < NCH; ++c) {
        const char* buf = lds + (c & 1) * SC_BUF;
        char* yb = (q == 0) ? (lds + SC_YB + (c & 1) * (33 * 256) + (cw * 16 + c16) * 4) : (lds + SC_DUMP + lane * 4);
        const int ystride = (q == 0) ? 256 : 0;
        ScCoef cur = sc_ld(buf, 0, arOff, wOff, bkOff, vOff);
#pragma unroll 1
        for (int half = 0; half < 2; ++half) {
#pragma unroll 4
          for (int tt = 0; tt < 16; ++tt) {
            const int t = half * 16 + tt;
            const ScCoef nxt = sc_ld(buf, t + 1, arOff, wOff, bkOff, vOff);
            u32x4 b1 = {cvtpk(St0[0], St0[1]), cvtpk(St0[2], St0[3]), cvtpk(St1[0], St1[1]), cvtpk(St1[2], St1[3])};
            u32x4 b2 = {cvtpk(St2[0], St2[1]), cvtpk(St2[2], St2[3]), cvtpk(St3[0], St3[1]), cvtpk(St3[2], St3[3])};
            f32x4 out = {0.f, 0.f, 0.f, 0.f};
            out = MFMA16(*(bf16x8*)&cur.a0, *(bf16x8*)&b1, out);
            out = MFMA16(*(bf16x8*)&cur.a1, *(bf16x8*)&b2, out);
            St0 *= cur.w0; St1 *= cur.w1; St2 *= cur.w2; St3 *= cur.w3;
            u32x4 bu = {q == 0 ? cvtpk(out[0], cur.vi) : 0u, 0u, 0u, 0u};
            St0 = MFMA16(*(bf16x8*)&cur.k0, *(bf16x8*)&bu, St0);
            St1 = MFMA16(*(bf16x8*)&cur.k1, *(bf16x8*)&bu, St1);
            St2 = MFMA16(*(bf16x8*)&cur.k2, *(bf16x8*)&bu, St2);
            St3 = MFMA16(*(bf16x8*)&cur.k3, *(bf16x8*)&bu, St3);
            *(float*)(yb + t * ystride) = out[1];
            cur = nxt;
          }
          if (half == 1) {
            u32x4 b1 = {cvtpk(St0[0], St0[1]), cvtpk(St0[2], St0[3]), cvtpk(St1[0], St1[1]), cvtpk(St1[2], St1[3])};
            u32x4 b2 = {cvtpk(St2[0], St2[1]), cvtpk(St2[2], St2[3]), cvtpk(St3[0], St3[1]), cvtpk(St3[2], St3[3])};
            f32x4 out = {0.f, 0.f, 0.f, 0.f};
            out = MFMA16(*(bf16x8*)&cur.a0, *(bf16x8*)&b1, out);
            out = MFMA16(*(bf16x8*)&cur.a1, *(bf16x8*)&b2, out);
            *(float*)(yb + 32 * ystride) = out[1];
          }
          __syncthreads();
        }
      }
    } else {
      const int pw = wid - 4, ptid = tid - 256;
      const int pstep = ptid >> 3, j0 = (ptid & 7) * 8;
      const int apos0 = (j0 >> 5) * 32 + (((j0 & 31) & 15) >> 2) * 8 + 4 * ((j0 & 31) >> 4), apos1 = apos0 + 8;
      float* Bg = (float*)(ws + OFF_BONUS) + (size_t)d * NTOK * 16;
      float kkc[8], kac[8], rkc[8];
#pragma unroll
      for (int e = 0; e < 8; ++e) { kkc[e] = p.in[15][h * 64 + j0 + e]; kac[e] = p.in[16][h * 64 + j0 + e]; rkc[e] = p.in[17][h * 64 + j0 + e]; }
      const int mat = pw >> 1, jh = pw & 1;
      bf16x8 w2f[4]; float bias;
      {
        const float* W2 = (mat ? p.in[14] : p.in[11]) + (size_t)d * 64 * 1024;
#pragma unroll
        for (int ks = 0; ks < 4; ++ks) {
          u32x4 w;
#pragma unroll
          for (int qq = 0; qq < 4; ++qq) {
            const int r0 = ks * 16 + 8 * hi + 2 * qq;
            w[qq] = cvtpk(W2[(size_t)r0 * 1024 + h * 64 + jh * 32 + r32], W2[(size_t)(r0 + 1) * 1024 + h * 64 + jh * 32 + r32]);
          }
          w2f[ks] = *(bf16x8*)&w;
        }
        bias = (mat ? p.in[12] : p.in[9])[d * 1024 + h * 64 + jh * 32 + r32];
      }
      u32x4 pR, pK, pV; bf16x8 pl[4];
      float kk[8], kr[8], rr[8];
      float* IC = (float*)(lds + SC_IC);
      auto prefetch = [&](int c) {
        const size_t row = (size_t)scan_row(c * 32 + pstep, d, b) * 1024 + h * 64 + j0;
        pR = *(const u32x4*)(Rg + row); pK = *(const u32x4*)(Kg + row); pV = *(const u32x4*)(Vg + row);
        const size_t lrow = (size_t)scan_row(c * 32 + r32, d, b);
#pragma unroll
        for (int ks = 0; ks < 4; ++ks) pl[ks] = *(const bf16x8*)(Lg + lrow * 256 + mat * 128 + d * 64 + ks * 16 + hi * 8);
      };
      auto stageA = [&](int c) {
        char* buf = lds + (c & 1) * SC_BUF;
        float* Wd = (float*)(buf + SC_WD); float* Vv = (float*)(buf + SC_VV); bf16_t* AR = (bf16_t*)(buf + SC_AR);
        f32x16 acc;
#pragma unroll
        for (int r = 0; r < 16; ++r) acc[r] = 0.f;
#pragma unroll
        for (int ks = 0; ks < 4; ++ks) acc = MFMA(pl[ks], w2f[ks], acc);
#pragma unroll
        for (int r = 0; r < 16; ++r) {
          const int step = crow(r, hi), j = jh * 32 + r32;
          const float sg = __builtin_amdgcn_rcpf(1.f + __expf(-(acc[r] + bias)));
          if (mat == 0) Wd[step * 64 + j] = __expf(-0.6065306597126334f * sg); else IC[step * 64 + j] = sg;
        }
        { u32x2 lo = {pR[0], pR[1]}, hi2 = {pR[2], pR[3]};
          *(u32x2*)(AR + (pstep + 1) * 128 + 64 + apos0) = lo; *(u32x2*)(AR + (pstep + 1) * 128 + 64 + apos1) = hi2; }
        float ss = 0.f;
#pragma unroll
        for (int w = 0; w < 4; ++w) {
          rr[2 * w] = lo16(pR[w]); rr[2 * w + 1] = hi16(pR[w]);
          kr[2 * w] = lo16(pK[w]); kr[2 * w + 1] = hi16(pK[w]);
        }
        f32x4 v0 = {lo16(pV[0]), hi16(pV[0]), lo16(pV[1]), hi16(pV[1])}, v1 = {lo16(pV[2]), hi16(pV[2]), lo16(pV[3]), hi16(pV[3])};
        *(f32x4*)(Vv + pstep * 64 + j0) = v0; *(f32x4*)(Vv + pstep * 64 + j0 + 4) = v1;
#pragma unroll
        for (int e = 0; e < 8; ++e) { kk[e] = kr[e] * kkc[e]; ss += kk[e] * kk[e]; }
        ss = red8(ss);
        const float inv = rsqrtf(fmaxf(ss, 1e-24f));
#pragma unroll
        for (int e = 0; e < 8; ++e) kk[e] *= inv;
      };
      auto stageB = [&](int c) {
        char* buf = lds + (c & 1) * SC_BUF;
        u32x4* BK = (u32x4*)(buf + SC_BK); bf16_t* AR = (bf16_t*)(buf + SC_AR);
        const f32x4 i0 = *(const f32x4*)(IC + pstep * 64 + j0), i1 = *(const f32x4*)(IC + pstep * 64 + j0 + 4);
        const float ic[8] = {i0[0], i0[1], i0[2], i0[3], i1[0], i1[1], i1[2], i1[3]};
        { u32x2 lo = {cvtpk(-kk[0], -kk[1]), cvtpk(-kk[2], -kk[3])}, hi2 = {cvtpk(-kk[4], -kk[5]), cvtpk(-kk[6], -kk[7])};
          *(u32x2*)(AR + pstep * 128 + apos0) = lo; *(u32x2*)(AR + pstep * 128 + apos1) = hi2; }
        float bs = 0.f;
#pragma unroll
        for (int e = 0; e < 8; ++e) {
          const float kd = kr[e] * (1.f + (ic[e] - 1.f) * kac[e]);
          u32x4 slot = {cvtpk(kk[e] * ic[e], kd), 0u, 0u, 0u};
          BK[pstep * 64 + j0 + e] = slot;
          bs += rr[e] * kd * rkc[e];
        }
        bs = red8(bs);
        if ((ptid & 7) == 0) Bg[(size_t)scan_row(c * 32 + pstep, d, b) * 16 + h] = bs;
      };
      auto writeout = [&](int c) {
        const float* Yb = (const float*)(lds + SC_YB + (c & 1) * (33 * 256)) + (pstep + 1) * 64 + j0;
        const f32x4 y0 = *(const f32x4*)(Yb), y1 = *(const f32x4*)(Yb + 4);
        u32x4 w = {cvtpk(y0[0], y0[1]), cvtpk(y0[2], y0[3]), cvtpk(y1[0], y1[1]), cvtpk(y1[2], y1[3])};
        *(u32x4*)(Yg + (size_t)scan_row(c * 32 + pstep, d, b) * 1024 + h * 64 + j0) = w;
      };
      prefetch(0);
      stageA(0);
      __syncthreads();
      stageB(0);
      prefetch(1);
      __syncthreads();
      for (int c = 0; c < NCH; ++c) {
        if (c >= 1) writeout(c - 1);
        if (c + 1 < NCH) stageA(c + 1);
        __syncthreads();
        if (c + 1 < NCH) { stageB(c + 1); if (c + 2 < NCH) prefetch(c + 2); }
        __syncthreads();
      }
      writeout(NCH - 1);
    }
    __syncthreads();
  }
}

__device__ void phase_readout(const Params& p) {
  unsigned char* ws = p.ws;
  const bf16_t* Y0 = (const bf16_t*)(ws + OFF_Y0); const bf16_t* Y1 = (const bf16_t*)(ws + OFF_Y1); const bf16_t* Vg = (const bf16_t*)(ws + OFF_V);
  bf16_t* G = (bf16_t*)(ws + OFF_G);
  const float* B0 = (const float*)(ws + OFF_BONUS); const float* B1 = B0 + (size_t)NTOK * 16;
  const int lane = threadIdx.x & 63, gw = blockIdx.x * 8 + (threadIdx.x >> 6), nw = gridDim.x * 8;
  const int c0 = lane * 16, hd = lane >> 2;
  float lg[16], lb[16];
#pragma unroll
  for (int e = 0; e < 16; ++e) { lg[e] = p.in[18][c0 + e]; lb[e] = p.in[19][c0 + e]; }
  for (int n = gw; n < NTOK; n += nw) {
    const size_t o = (size_t)n * 1024 + c0;
    float y[16], v[16], g[16];
#pragma unroll
    for (int q = 0; q < 2; ++q) {
      const u32x4 a = *(const u32x4*)(Y0 + o + 8 * q), bq = *(const u32x4*)(Y1 + o + 8 * q), vv = *(const u32x4*)(Vg + o + 8 * q), gg = *(const u32x4*)(G + o + 8 * q);
#pragma unroll
      for (int w = 0; w < 4; ++w) {
        y[8 * q + 2 * w] = lo16(a[w]) + lo16(bq[w]); y[8 * q + 2 * w + 1] = hi16(a[w]) + hi16(bq[w]);
        v[8 * q + 2 * w] = lo16(vv[w]); v[8 * q + 2 * w + 1] = hi16(vv[w]);
        g[8 * q + 2 * w] = lo16(gg[w]); g[8 * q + 2 * w + 1] = hi16(gg[w]);
      }
    }
    float s = 0.f;
#pragma unroll
    for (int e = 0; e < 16; ++e) s += y[e];
    s += dpp_f(s, 0); s += dpp_f(s, 1);
    const float mean = s * (1.f / 64.f);
    float q2 = 0.f;
#pragma unroll
    for (int e = 0; e < 16; ++e) { const float dlt = y[e] - mean; q2 += dlt * dlt; }
    q2 += dpp_f(q2, 0); q2 += dpp_f(q2, 1);
    const float rs = rsqrtf(q2 * (1.f / 64.f) + 64e-5f);
    const float bonus = B0[(size_t)n * 16 + hd] + B1[(size_t)n * 16 + hd];
    float r[16];
#pragma unroll
    for (int e = 0; e < 16; ++e) {
      const float yn = (y[e] - mean) * rs * lg[e] + lb[e];
      r[e] = (yn + bonus * v[e]) * (g[e] * sigmoidf_(g[e]));
    }
    u32x4 w0 = {cvtpk(r[0], r[1]), cvtpk(r[2], r[3]), cvtpk(r[4], r[5]), cvtpk(r[6], r[7])};
    u32x4 w1 = {cvtpk(r[8], r[9]), cvtpk(r[10], r[11]), cvtpk(r[12], r[13]), cvtpk(r[14], r[15])};
    *(u32x4*)(G + o) = w0; *(u32x4*)(G + o + 8) = w1;
  }
}

constexpr int AT_SHMV = 16384, AT_KROW = 208, AT_SHMK = 64 * AT_KROW;
constexpr int AT_KOFF = 2 * AT_SHMV, AT_WOFF = AT_KOFF + 2 * AT_SHMK;
constexpr float AT_SCALE = 0.10206207261596575f;
constexpr float AT_THR = 8.f;
#define SBAR() __builtin_amdgcn_sched_barrier(0)
__device__ __forceinline__ void at_partialSM(f32x16& p0, f32x16& p1, float& m_reg, float& mn, float& alpha) {
  constexpr float C = AT_SCALE * 1.4426950408889634f;
  float pmax = p0[0];
#pragma unroll
  for (int r = 1; r < 16; ++r) pmax = fmaxf(pmax, p0[r]);
#pragma unroll
  for (int r = 0; r < 16; ++r) pmax = fmaxf(pmax, p1[r]);
  { auto rr = __builtin_amdgcn_permlane32_swap(__float_as_uint(pmax), __float_as_uint(pmax), false, false);
    pmax = fmaxf(__uint_as_float(rr[0]), __uint_as_float(rr[1])); }
  if (__builtin_expect(__all(pmax - m_reg <= AT_THR / AT_SCALE), 1)) { mn = m_reg; alpha = 1.f; }
  else { mn = fmaxf(m_reg, pmax); alpha = __builtin_amdgcn_exp2f((m_reg - mn) * C); m_reg = mn; }
  const float mnC = -mn * C;
#pragma unroll
  for (int r = 0; r < 16; ++r) p0[r] = fmaf(p0[r], C, mnC);
#pragma unroll
  for (int r = 0; r < 16; ++r) p1[r] = fmaf(p1[r], C, mnC);
#pragma unroll
  for (int r = 0; r < 16; ++r) p0[r] = __builtin_amdgcn_exp2f(p0[r]);
}
__device__ __forceinline__ void at_finishSM(f32x16& p0, f32x16& p1, float alpha, float& l_reg, bf16x8& pa0, bf16x8& pa1, bf16x8& pa2, bf16x8& pa3) {
#pragma unroll
  for (int r = 0; r < 16; ++r) p1[r] = __builtin_amdgcn_exp2f(p1[r]);
  float ps = 0;
#pragma unroll
  for (int r = 0; r < 16; ++r) ps += p0[r];
#pragma unroll
  for (int r = 0; r < 16; ++r) ps += p1[r];
  { auto rr = __builtin_amdgcn_permlane32_swap(__float_as_uint(ps), __float_as_uint(ps), false, false);
    ps = __uint_as_float(rr[0]) + __uint_as_float(rr[1]); }
  l_reg = l_reg * alpha + ps;
#define PK4(P, BASE, OUT) do { unsigned a0 = cvtpk(P[BASE + 0], P[BASE + 1]), a1 = cvtpk(P[BASE + 2], P[BASE + 3]);   \
    unsigned b0 = cvtpk(P[BASE + 4], P[BASE + 5]), b1 = cvtpk(P[BASE + 6], P[BASE + 7]);                              \
    auto r0 = __builtin_amdgcn_permlane32_swap(a0, b0, false, false); auto r1 = __builtin_amdgcn_permlane32_swap(a1, b1, false, false); \
    u32x4 w = {r0[0], r1[0], r0[1], r1[1]}; OUT = *reinterpret_cast<bf16x8*>(&w); } while (0)
  PK4(p0, 0, pa0); PK4(p0, 8, pa1); PK4(p1, 0, pa2); PK4(p1, 8, pa3);
#undef PK4
}
__device__ __forceinline__ void at_qkt(f32x16& p0, f32x16& p1, const char* Ks, const bf16x8* qr, int r32, int hi) {
#pragma unroll
  for (int r = 0; r < 16; ++r) { p0[r] = 0.f; p1[r] = 0.f; }
#pragma unroll
  for (int d0 = 0; d0 < 6; ++d0) {
    const bf16x8 b0 = *(const bf16x8*)(Ks + r32 * AT_KROW + d0 * 32 + hi * 16);
    const bf16x8 b1 = *(const bf16x8*)(Ks + (32 + r32) * AT_KROW + d0 * 32 + hi * 16);
    p0 = MFMA(b0, qr[d0], p0);
    p1 = MFMA(b1, qr[d0], p1);
  }
}
__device__ __forceinline__ int v_st(int k, int c) { const int kk = (k & ~0xC) | ((k & 4) << 1) | ((k & 8) >> 1); return ((kk >> 3) * 4 + (c >> 5)) * 512 + ((kk & 7) * 32 + (c & 31)) * 2; }
__device__ __forceinline__ int v_rd_base(int lane) { return ((lane & 3) << 3) | (((lane >> 2) & 3) << 6) | (((lane >> 4) & 1) << 5) | (((lane >> 5) & 1) << 8); }
constexpr int v_rd_off(int d0, int ks, int half) { return d0 * 512 + ks * 4096 + half * 2048; }
template <int OFF> __device__ __forceinline__ s16x4 tr_read(int vb) {
  s16x4 r; asm volatile("ds_read_b64_tr_b16 %0, %1 offset:%2" : "=&v"(r) : "v"(vb), "i"(OFF) : "memory"); return r;
}
template <int D0> __device__ __forceinline__ void pv_one(f32x16& od, int vb, bf16x8 pa0, bf16x8 pa1, bf16x8 pa2, bf16x8 pa3) {
  const s16x4 l0 = tr_read<v_rd_off(D0, 0, 0)>(vb), h0 = tr_read<v_rd_off(D0, 0, 1)>(vb), l1 = tr_read<v_rd_off(D0, 1, 0)>(vb), h1 = tr_read<v_rd_off(D0, 1, 1)>(vb);
  const s16x4 l2 = tr_read<v_rd_off(D0, 2, 0)>(vb), h2 = tr_read<v_rd_off(D0, 2, 1)>(vb), l3 = tr_read<v_rd_off(D0, 3, 0)>(vb), h3 = tr_read<v_rd_off(D0, 3, 1)>(vb);
  asm volatile("s_waitcnt lgkmcnt(0)" ::: "memory"); SBAR();
#define PK(Lx, Hx) (bf16x8){Lx[0], Lx[1], Lx[2], Lx[3], Hx[0], Hx[1], Hx[2], Hx[3]}
  od = MFMA(pa0, PK(l0, h0), od);
  od = MFMA(pa1, PK(l1, h1), od);
  od = MFMA(pa2, PK(l2, h2), od);
  od = MFMA(pa3, PK(l3, h3), od);
#undef PK
}
__device__ __forceinline__ void pv_d0(f32x16* o, int vb, bf16x8 pa0, bf16x8 pa1, bf16x8 pa2, bf16x8 pa3) {
  pv_one<0>(o[0], vb, pa0, pa1, pa2, pa3); pv_one<1>(o[1], vb, pa0, pa1, pa2, pa3);
}

__device__ void phase_attn(const Params& p, char* lds) {
  unsigned char* ws = p.ws;
  const bf16_t* Qg = (const bf16_t*)(ws + OFF_Q); const bf16_t* KVg = (const bf16_t*)(ws + OFF_KV); const bf16_t* KPg = (const bf16_t*)(ws + OFF_KPE);
  bf16_t* G1 = (bf16_t*)(ws + OFF_G1);
  const f32x2* rope = (const f32x2*)(ws + OFF_ROPE);
  const int tid = threadIdx.x, wid = tid >> 6, lane = tid & 63, r32 = lane & 31, hi = lane >> 5;
  char* V_lds = lds; char* K_lds = lds + AT_KOFF;
  float* wsl = (float*)(lds + AT_WOFF) + wid * 64; float* li_l = wsl; float* al_l = wsl + 32;
  const int skey = tid >> 3, sc8 = (tid & 7) * 8;
  const int pkey = (tid & 255) >> 2, pc8 = (tid & 3) * 8;
  const int vst = v_st(skey, sc8), kst = skey * AT_KROW + sc8 * 2, pst = pkey * AT_KROW + (64 + pc8) * 2;
  const int vb0 = (int)(uintptr_t)V_lds + v_rd_base(lane);
  const int nitems = NB * 16 * 32;
  const int xcd = blockIdx.x & 7, slot = blockIdx.x >> 3, per = gridDim.x >> 3;
  for (int it = slot; it < nitems / 8; it += per) {
    const int pair = (it >> 5) * 8 + xcd, qblk = it & 31;
    const int b = pair >> 4, h = pair & 15;
    const size_t row0 = (size_t)b * TL;
    const size_t qrow = row0 + qblk * 256 + wid * 32 + r32;
    const bf16_t* Kh = KVg + row0 * 2048 + h * 128;
    const bf16_t* Kp = KPg + row0 * 32;
    float m_reg = -1e30f, l_reg = 0.f;
    f32x16 o[2];
#pragma unroll
    for (int dd = 0; dd < 2; ++dd)
#pragma unroll
      for (int r = 0; r < 16; ++r) o[dd][r] = 0.f;
    bf16x8 qr[6];
    {
      const bf16_t* Qw = Qg + qrow * 1536 + h * 96 + hi * 8;
#pragma unroll
      for (int d0 = 0; d0 < 6; ++d0) qr[d0] = *(const bf16x8*)(Qw + d0 * 16);
      const int t = qblk * 256 + wid * 32 + r32;
      const f32x2* tb = rope + (hi ? (t & 63) : (t >> 6)) * 8;
      const u32x4 x1 = *(const u32x4*)&qr[4], x2 = *(const u32x4*)&qr[5];
      u32x4 n1, n2;
#pragma unroll
      for (int q = 0; q < 4; ++q) {
        const f32x2 csA = tb[2 * q], csB = tb[2 * q + 1];
        const float a0 = lo16(x1[q]), a1 = hi16(x1[q]), b0 = lo16(x2[q]), b1 = hi16(x2[q]);
        n1[q] = cvtpk(a0 * csA[0] - b0 * csA[1], a1 * csB[0] - b1 * csB[1]);
        n2[q] = cvtpk(a0 * csA[1] + b0 * csA[0], a1 * csB[1] + b1 * csB[0]);
      }
      qr[4] = *(bf16x8*)&n1; qr[5] = *(bf16x8*)&n2;
    }
    struct { bf16x8 vs, ks, ps; } sr_[2];
#define SLOAD(i, k0) do { sr_[i].vs = *(const bf16x8*)(Kh + (size_t)((k0) + skey) * 2048 + 64 + sc8); \
    sr_[i].ks = *(const bf16x8*)(Kh + (size_t)((k0) + skey) * 2048 + sc8); \
    sr_[i].ps = *(const bf16x8*)(Kp + (size_t)((k0) + pkey) * 32 + pc8); } while (0)
#define SWRITE(bb, i) do { *(bf16x8*)(V_lds + (bb) * AT_SHMV + vst) = sr_[i].vs; \
    *(bf16x8*)(K_lds + (bb) * AT_SHMK + kst) = sr_[i].ks; \
    *(bf16x8*)(K_lds + (bb) * AT_SHMK + pst) = sr_[i].ps; } while (0)
#define SWAIT() asm volatile("s_waitcnt vmcnt(3)" ::: "memory")
#define RESC(a) do { if (__any((a) < 1.f)) { if (hi == 0) al_l[r32] = (a); asm volatile("s_waitcnt lgkmcnt(0)" ::: "memory"); \
    _Pragma("unroll") for (int dd = 0; dd < 2; ++dd) _Pragma("unroll") for (int r = 0; r < 16; ++r) o[dd][r] *= al_l[crow(r, hi)]; } } while (0)
    f32x16 pA0, pA1, pB0, pB1; float mnA, mnB, alA, alB; bf16x8 pa0, pa1, pa2, pa3;
    constexpr int NT = TL / 64;
    SLOAD(0, 0); asm volatile("s_waitcnt vmcnt(0)" ::: "memory"); SWRITE(0, 0); __syncthreads();
    at_qkt(pA0, pA1, K_lds, qr, r32, hi); at_partialSM(pA0, pA1, m_reg, mnA, alA);
    SLOAD(1, 64); SLOAD(0, 128);
    SWAIT(); SWRITE(1, 1); __syncthreads();
    for (int j = 1; j + 1 < NT; j += 2) {
      SBAR(); at_qkt(pB0, pB1, K_lds + AT_SHMK, qr, r32, hi);
      at_finishSM(pA0, pA1, alA, l_reg, pa0, pa1, pa2, pa3); SBAR();
      SLOAD(1, (j + 2) * 64); SBAR();
      pv_d0(o, vb0, pa0, pa1, pa2, pa3); at_partialSM(pB0, pB1, m_reg, mnB, alB);
      __syncthreads(); SWAIT(); SWRITE(0, 0);
      RESC(alB); __syncthreads();
      SBAR(); at_qkt(pA0, pA1, K_lds, qr, r32, hi);
      at_finishSM(pB0, pB1, alB, l_reg, pa0, pa1, pa2, pa3); SBAR();
      if (j + 3 < NT) SLOAD(0, (j + 3) * 64); SBAR();
      pv_d0(o, vb0 + AT_SHMV, pa0, pa1, pa2, pa3); at_partialSM(pA0, pA1, m_reg, mnA, alA);
      __syncthreads(); SWAIT(); SWRITE(1, 1);
      RESC(alA); __syncthreads();
    }
    SBAR(); at_qkt(pB0, pB1, K_lds + AT_SHMK, qr, r32, hi);
    at_finishSM(pA0, pA1, alA, l_reg, pa0, pa1, pa2, pa3); SBAR();
    pv_d0(o, vb0, pa0, pa1, pa2, pa3); at_partialSM(pB0, pB1, m_reg, mnB, alB);
    __syncthreads(); RESC(alB);
    at_finishSM(pB0, pB1, alB, l_reg, pa0, pa1, pa2, pa3); SBAR();
    pv_d0(o, vb0 + AT_SHMV, pa0, pa1, pa2, pa3);
    if (hi == 0) li_l[r32] = l_reg;
    asm volatile("s_waitcnt lgkmcnt(0)" ::: "memory");
    float rli[16];
#pragma unroll
    for (int r = 0; r < 16; ++r) rli[r] = __builtin_amdgcn_rcpf(li_l[crow(r, hi)]);
    bf16_t* Gw = G1 + (row0 + qblk * 256 + wid * 32) * 1024 + h * 64 + r32;
#pragma unroll
    for (int r = 0; r < 16; ++r) {
      const int orow = crow(r, hi);
#pragma unroll
      for (int d0 = 0; d0 < 2; ++d0) {
        bf16_t* gp = Gw + (size_t)orow * 1024 + d0 * 32;
        const float gt = bf2f(*gp);
        *gp = f2bf(o[d0][r] * rli[r] * gt * sigmoidf_(gt));
      }
    }
    __syncthreads();
#undef SLOAD
#undef SWRITE
#undef SWAIT
#undef RESC
  }
}

__global__ __launch_bounds__(NTHR, 1) void fwd_megakernel(Params p) {
  extern __shared__ __attribute__((aligned(16))) char lds[];
  cg::grid_group grid = cg::this_grid();
  unsigned char* ws = p.ws;
  bf16_t* H = (bf16_t*)(ws + OFF_H);
  float* mod = (float*)(ws + OFF_MOD);
  float* CTX1 = (float*)(ws + OFF_CTX1);

  phase_prologue(p, lds);
  grid.sync();
  phase_norm_lerp(p, mod);
  grid.sync();
  {
    const bf16_t* WIN0 = (const bf16_t*)(ws + OFF_WIN0);
    const int nbig = 264 * 16;
    for (int tile = blockIdx.x; tile < nbig + 264 * 2; tile += gridDim.x) {
      EpiBf16 e; e.invK = 0.f;
      if (tile < nbig) {
        const int mt = tile >> 4, jn = tile & 15, j = jn >> 2, n4 = jn & 3, m0 = mt * 256;
        e.dst = (bf16_t*)(ws + OFF_R + (size_t)j * U); e.ldd = 1024; e.col0 = n4 * 256; e.act = 0; e.m0 = m0;
        gemm_tile<0, 256>(lerp_base(p, j, m0), 1024, WIN0 + (size_t)(j * 1024 + n4 * 256) * 1024, 1024, m0, nullptr, lds, e);
      } else {
        const int t2 = tile - nbig, mt = t2 >> 1, nt = 32 + (t2 & 1), m0 = mt * 256;
        e.dst = (bf16_t*)(ws + OFF_LORA); e.ldd = 256; e.col0 = (nt - 32) * 128; e.act = (nt == 32) ? 1 : 0; e.m0 = m0;
        gemm_tile<1, 128>(H, 1024, WIN0 + (size_t)nt * 128 * 1024, 1024, m0, p.in[7] + (nt - 28) * 1024, lds, e);
      }
    }
  }
  grid.sync();
  phase_scan(p, lds);
  grid.sync();
  phase_readout(p);
  grid.sync();
  {
    const bf16_t* A = (const bf16_t*)(ws + OFF_G); const bf16_t* W = (const bf16_t*)(ws + OFF_WOUT0);
    for (int tile = blockIdx.x; tile < 264 * 4; tile += gridDim.x) {
      const int mt = tile >> 2, nt = tile & 3, m0 = mt * 256;
      const int b = m0 / TL, t0 = m0 - b * TL;
      EpiResid e;
      if (t0 < T) { const size_t orow = (size_t)b * T + t0; e.xin = p.in[0] + orow * 1024; e.xout = p.out + orow * 1024; e.gvec = mod + (size_t)b * 3072 + 2048; }
      else { const size_t orow = (size_t)b * L + (t0 - T); e.xin = p.in[2] + orow * 1024; e.xout = CTX1 + orow * 1024; e.gvec = mod + (size_t)8 * 3072 + 2048; }
      e.n0 = nt * 256;
      gemm_tile<0, 256>(A, 1024, W + (size_t)nt * 256 * 1024, 1024, m0, nullptr, lds, e);
    }
  }
  grid.sync();
  phase_norm(p.out, CTX1, p.in[4] + 1024, mod + 9 * 3072, H);
  grid.sync();
  {
    const bf16_t* W = (const bf16_t*)(ws + OFF_WIN1);
    for (int tile = blockIdx.x; tile < 264 * 7; tile += gridDim.x) {
      const int mt = tile / 7, nt = tile % 7, m0 = mt * 256;
      EpiMlaIn e; e.QC = (bf16_t*)(ws + OFF_QC); e.KVC = (bf16_t*)(ws + OFF_KVC); e.KPE = (bf16_t*)(ws + OFF_KPE); e.G1 = (bf16_t*)(ws + OFF_G1);
      e.rope = (const float*)(ws + OFF_ROPE); e.n0 = nt * 256; e.m0 = m0;
      gemm_tile<0, 256>(H, 1024, W + (size_t)nt * 256 * 1024, 1024, m0, nullptr, lds, e);
    }
  }
  grid.sync();
  {
    const bf16_t* WQ = (const bf16_t*)(ws + OFF_WQB); const bf16_t* WKV = (const bf16_t*)(ws + OFF_WKVB);
    const int nq = 256 * 6, nkv = 264 * 8;
    for (int tile = blockIdx.x; tile < nq + nkv; tile += gridDim.x) {
      EpiBf16 e; e.act = 0;
      if (tile < nq) {
        const int mt2 = tile / 6, nt = tile % 6, b = mt2 >> 5, m0 = b * TL + (mt2 & 31) * 256;
        e.dst = (bf16_t*)(ws + OFF_Q); e.ldd = 1536; e.col0 = nt * 256; e.m0 = m0; e.invK = 1.f / 384.f;
        gemm_tile<2, 256>((const bf16_t*)(ws + OFF_QC), 384, WQ + (size_t)nt * 256 * 384, 384, m0, nullptr, lds, e);
      } else {
        const int t2 = tile - nq, mt = t2 >> 3, nt = t2 & 7, m0 = mt * 256;
        e.dst = (bf16_t*)(ws + OFF_KV); e.ldd = 2048; e.col0 = nt * 256; e.m0 = m0; e.invK = 1.f / 256.f;
        gemm_tile<2, 256>((const bf16_t*)(ws + OFF_KVC), 256, WKV + (size_t)nt * 256 * 256, 256, m0, nullptr, lds, e);
      }
    }
  }
  grid.sync();
  phase_attn(p, lds);
  grid.sync();
  {
    const bf16_t* A = (const bf16_t*)(ws + OFF_G1); const bf16_t* W = (const bf16_t*)(ws + OFF_WOUT1);
    for (int tile = blockIdx.x; tile < 256 * 4; tile += gridDim.x) {
      const int mt2 = tile >> 2, nt = tile & 3, b = mt2 >> 5, t0 = (mt2 & 31) * 256, m0 = b * TL + t0;
      const size_t orow = (size_t)b * T + t0;
      EpiResid e; e.xin = p.out + orow * 1024; e.xout = p.out + orow * 1024; e.gvec = mod + (size_t)(9 + b) * 3072 + 2048; e.n0 = nt * 256;
      gemm_tile<0, 256>(A, 1024, W + (size_t)nt * 256 * 1024, 1024, m0, nullptr, lds, e);
    }
  }
  grid.sync();
  phase_final(p.out, p.in[27]);
}

extern "C" void kernel_launch(void* const* d_in, const int* in_sizes, int n_in, void* d_out, int out_size, void* d_ws, size_t ws_size, hipStream_t stream) {
  static int grid_blocks = 0;
  if (grid_blocks == 0) {
    if (n_in != 28 || ws_size < WS_END + (size_t)(NTOK - LERP3_SPLIT) * 2048 || out_size != NB * T * D) { fprintf(stderr, "kernel_launch: unexpected shapes (n_in %d, ws %zu need %zu, out %d)\n", n_in, ws_size, (size_t)WS_END, out_size); grid_blocks = -1; return; }
    int dev = 0, cus = 0, per_cu = 0;
    hipGetDevice(&dev);
    hipDeviceGetAttribute(&cus, hipDeviceAttributeMultiprocessorCount, dev);
    if (hipFuncSetAttribute((const void*)fwd_megakernel, hipFuncAttributeMaxDynamicSharedMemorySize, LDS_BYTES) != hipSuccess) { fprintf(stderr, "kernel_launch: hipFuncSetAttribute failed\n"); grid_blocks = -1; return; }
    hipOccupancyMaxActiveBlocksPerMultiprocessor(&per_cu, (const void*)fwd_megakernel, NTHR, LDS_BYTES);
    if (per_cu < 1) { fprintf(stderr, "kernel_launch: occupancy query says %d blocks per CU\n", per_cu); per_cu = 1; }
    (void)hipGetLastError();
    grid_blocks = cus;
    if (grid_blocks > 256) grid_blocks = 256;
    grid_blocks &= ~7;
  }
  if (grid_blocks <= 0) return;
  Params p{};
  for (int i = 0; i < 28; ++i) p.in[i] = (const float*)d_in[i];
  p.out = (float*)d_out; p.ws = (unsigned char*)d_ws;
  void* args[] = {&p};
  hipError_t e = hipLaunchCooperativeKernel((const void*)fwd_megakernel, dim3(grid_blocks), dim3(NTHR), args, LDS_BYTES, stream);
  if (e != hipSuccess) fprintf(stderr, "cooperative launch failed: %s (grid %d)\n", hipGetErrorString(e), grid_blocks);
}
```

```cpp
#include <hip/hip_runtime.h>
#include <hip/hip_cooperative_groups.h>
#include <cstdio>
#include <cstdint>
namespace cg = cooperative_groups;

typedef unsigned short bf16_t;
typedef short bf16x8 __attribute__((ext_vector_type(8)));
typedef short s16x4 __attribute__((ext_vector_type(4)));
typedef float f32x16 __attribute__((ext_vector_type(16)));
typedef float f32x4 __attribute__((ext_vector_type(4)));
typedef float f32x2 __attribute__((ext_vector_type(2)));
typedef unsigned u32x4 __attribute__((ext_vector_type(4)));
typedef unsigned u32x2 __attribute__((ext_vector_type(2)));

constexpr int D = 1024, NB = 8, T = 8192, L = 256, TL = T + L, NTOK = NB * TL;
constexpr int NTHR = 512;

constexpr size_t U = (size_t)NTOK * 1024 * 2;
constexpr size_t OFF_H = 0, OFF_R = U, OFF_K = 2 * U, OFF_V = 3 * U, OFF_G = 4 * U, OFF_Y0 = 5 * U, OFF_Y1 = 6 * U;
constexpr size_t OFF_LORA = 7 * U;
constexpr size_t OFF_BONUS = OFF_LORA + (size_t)NTOK * 256 * 2;
constexpr size_t OFF_WIN0 = OFF_BONUS + (size_t)2 * NTOK * 16 * 4;
constexpr size_t OFF_WOUT0 = OFF_WIN0 + (size_t)4352 * 1024 * 2;
constexpr size_t OFF_WIN1 = OFF_WOUT0 + (size_t)1024 * 1024 * 2;
constexpr size_t OFF_WQB = OFF_WIN1 + (size_t)1792 * 1024 * 2;
constexpr size_t OFF_WKVB = OFF_WQB + (size_t)1536 * 384 * 2;
constexpr size_t OFF_WOUT1 = OFF_WKVB + (size_t)2048 * 256 * 2;
constexpr size_t OFF_MOD = OFF_WOUT1 + (size_t)1024 * 1024 * 2;
constexpr size_t OFF_ROPE = OFF_MOD + (size_t)2 * 9 * 3072 * 4;
constexpr size_t OFF_CTX1 = OFF_ROPE + (size_t)128 * 8 * 2 * 4;
constexpr size_t WS_END = OFF_CTX1 + (size_t)2048 * 1024 * 4;
constexpr size_t OFF_QC = OFF_V;
constexpr size_t OFF_KVC = OFF_QC + (size_t)NTOK * 384 * 2;
constexpr size_t OFF_KPE = OFF_KVC + (size_t)NTOK * 256 * 2;
constexpr size_t OFF_G1 = OFF_G;
constexpr size_t OFF_Q = OFF_R;
constexpr size_t OFF_KV = OFF_Y0;

struct Params { const float* in[28]; float* out; unsigned char* ws; };

typedef __bf16 bf16x2_t __attribute__((ext_vector_type(2)));
__device__ __forceinline__ unsigned cvtpk(float lo, float hi) { f32x2 v = {lo, hi}; bf16x2_t b = __builtin_convertvector(v, bf16x2_t); return *(unsigned*)&b; }
__device__ __forceinline__ float bf2f(bf16_t u) { return __uint_as_float(((unsigned)u) << 16); }
__device__ __forceinline__ bf16_t f2bf(float f) { return (bf16_t)(cvtpk(f, 0.f) & 0xffffu); }
__device__ __forceinline__ float lo16(unsigned w) { return __uint_as_float(w << 16); }
__device__ __forceinline__ float hi16(unsigned w) { return __uint_as_float(w & 0xffff0000u); }
__device__ __forceinline__ void st_bf16x4(bf16_t* p, float a, float b, float c, float d) { u32x2 w = {cvtpk(a, b), cvtpk(c, d)}; *(u32x2*)p = w; }
__device__ __forceinline__ float wave_sum(float v) {
#pragma unroll
  for (int o = 32; o; o >>= 1) v += __shfl_xor(v, o);
  return v;
}
__device__ __forceinline__ float dpp_f(float v, const int ctrl_sel) {
  int r;
  if (ctrl_sel == 0) r = __builtin_amdgcn_update_dpp(0, __float_as_int(v), 0xB1, 0xF, 0xF, true);
  else if (ctrl_sel == 1) r = __builtin_amdgcn_update_dpp(0, __float_as_int(v), 0x4E, 0xF, 0xF, true);
  else r = __builtin_amdgcn_update_dpp(0, __float_as_int(v), 0x141, 0xF, 0xF, true);
  return __int_as_float(r);
}
__device__ __forceinline__ float red8(float v) { v += dpp_f(v, 0); v += dpp_f(v, 1); v += dpp_f(v, 2); return v; }
__device__ __forceinline__ int crow(int r, int hi) { return (r & 3) + 8 * (r >> 2) + 4 * hi; }
__device__ __forceinline__ float sigmoidf_(float x) { return 1.f / (1.f + __expf(-x)); }
#define MFMA(a, b, c) __builtin_amdgcn_mfma_f32_32x32x16_bf16((a), (b), (c), 0, 0, 0)

constexpr int G_LDT = 144;
constexpr int G_SSQ_OFF = 2 * (256 + 256) * G_LDT;
constexpr int LDS_BYTES = G_SSQ_OFF + 1024;

template <int AMODE, int BN, class Epi>
__device__ __forceinline__ void gemm_tile(const bf16_t* A, const int lda, const bf16_t* Bt, const int K, const int m0, const float* mu, char* lds, const Epi& epi) {
  constexpr int WN = BN / 64, MI = WN, NBR = BN / 64, G_STAGE = (256 + BN) * G_LDT;
  const int tid = threadIdx.x, lane = tid & 63, wid = tid >> 6, r32 = lane & 31, hi = lane >> 5;
  const int wm = wid / WN, wn = wid % WN;
  const int srow = tid >> 3, scc = (tid & 7) * 8;
  f32x16 acc[MI][2];
#pragma unroll
  for (int i = 0; i < MI; ++i)
#pragma unroll
    for (int j = 0; j < 2; ++j)
#pragma unroll
      for (int r = 0; r < 16; ++r) acc[i][j][r] = 0.f;
  bf16x8 ra[4], rb[NBR], rp[4], rn[4];
  float ssq[4] = {0.f, 0.f, 0.f, 0.f};
  int dprev[4], dnext[4];
  if constexpr (AMODE == 1) {
    const int t0 = m0 % TL;
#pragma unroll
    for (int i = 0; i < 4; ++i) { const int t = t0 + srow + 64 * i; dprev[i] = (t != 0 && t != T) ? 1 : 0; dnext[i] = (t != T - 1 && t != TL - 1) ? 1 : 0; }
  }
  auto gload = [&](int k0) {
#pragma unroll
    for (int i = 0; i < 4; ++i) {
      const bf16_t* ap = A + (size_t)(m0 + srow + 64 * i) * lda + k0 + scc;
      ra[i] = *(const bf16x8*)ap;
      if constexpr (AMODE == 1) { rp[i] = *(const bf16x8*)(ap - dprev[i] * lda); rn[i] = *(const bf16x8*)(ap + dnext[i] * lda); }
    }
#pragma unroll
    for (int i = 0; i < NBR; ++i) rb[i] = *(const bf16x8*)(Bt + (size_t)(srow + 64 * i) * K + k0 + scc);
  };
  auto lstore = [&](int s, int k0) {
    char* base = lds + s * G_STAGE;
    if constexpr (AMODE == 1) {
      const f32x4 m0v = *(const f32x4*)(mu + k0 + scc), m1v = *(const f32x4*)(mu + k0 + scc + 4);
      const float mm[8] = {m0v[0], m0v[1], m0v[2], m0v[3], m1v[0], m1v[1], m1v[2], m1v[3]};
#pragma unroll
      for (int i = 0; i < 4; ++i) {
        const u32x4 hc = *(const u32x4*)&ra[i], hp = *(const u32x4*)&rp[i], hn = *(const u32x4*)&rn[i];
        const float fp = dprev[i] ? 0.5f : 0.f, fn = dnext[i] ? 0.5f : 0.f;
        u32x4 w;
#pragma unroll
        for (int q = 0; q < 4; ++q) {
          const float c0 = lo16(hc[q]), c1 = hi16(hc[q]);
          const float x0 = fp * lo16(hp[q]) + fn * lo16(hn[q]) - c0, x1 = fp * hi16(hp[q]) + fn * hi16(hn[q]) - c1;
          w[q] = cvtpk(c0 + x0 * mm[2 * q], c1 + x1 * mm[2 * q + 1]);
        }
        *(u32x4*)(base + (srow + 64 * i) * G_LDT + scc * 2) = w;
      }
    } else {
#pragma unroll
      for (int i = 0; i < 4; ++i) {
        *(bf16x8*)(base + (srow + 64 * i) * G_LDT + scc * 2) = ra[i];
        if constexpr (AMODE == 2) {
          const u32x4 hc = *(const u32x4*)&ra[i];
#pragma unroll
          for (int q = 0; q < 4; ++q) { const float c0 = lo16(hc[q]), c1 = hi16(hc[q]); ssq[i] += c0 * c0 + c1 * c1; }
        }
      }
    }
#pragma unroll
    for (int i = 0; i < NBR; ++i) *(bf16x8*)(base + 256 * G_LDT + (srow + 64 * i) * G_LDT + scc * 2) = rb[i];
  };
  const int nk = K >> 6;
  gload(0);
  lstore(0, 0);
  if (nk > 1) gload(64);
  __syncthreads();
#pragma unroll 1
  for (int kt = 0; kt < nk; ++kt) {
    const int s = kt & 1;
    if (kt + 1 < nk) lstore(s ^ 1, (kt + 1) * 64);
    if (kt + 2 < nk) gload((kt + 2) * 64);
    {
      const char* Ab = lds + s * G_STAGE + (wm * (32 * MI) + r32) * G_LDT + hi * 16;
      const char* Bb = lds + s * G_STAGE + 256 * G_LDT + (wn * 64 + r32) * G_LDT + hi * 16;
#pragma unroll 2
      for (int ks = 0; ks < 4; ++ks) {
        const bf16x8 b0 = *(const bf16x8*)(Bb + ks * 32), b1 = *(const bf16x8*)(Bb + 32 * G_LDT + ks * 32);
#pragma unroll
        for (int mi = 0; mi < MI; ++mi) {
          const bf16x8 a0 = *(const bf16x8*)(Ab + mi * 32 * G_LDT + ks * 32);
          acc[mi][0] = MFMA(b0, a0, acc[mi][0]); acc[mi][1] = MFMA(b1, a0, acc[mi][1]);
        }
      }
    }
    __syncthreads();
  }
  float* ssq_l = (float*)(lds + G_SSQ_OFF);
  if constexpr (AMODE == 2) {
#pragma unroll
    for (int i = 0; i < 4; ++i) { const float v = red8(ssq[i]); if ((tid & 7) == 0) ssq_l[srow + 64 * i] = v; }
    __syncthreads();
  }
#pragma unroll
  for (int mi = 0; mi < MI; ++mi) {
    const int lrow = wm * (32 * MI) + mi * 32 + r32;
    float aux = 0.f;
    if constexpr (AMODE == 2) aux = ssq_l[lrow];
    epi(lrow, wn * 64 + 4 * hi, acc[mi][0], acc[mi][1], aux);
  }
}

struct EpiBf16 {
  bf16_t* dst; int ldd; int col0; int m0; int act; float invK;
  __device__ __forceinline__ void operator()(int lrow, int nc, const f32x16& a0, const f32x16& a1, float aux) const { one(lrow, nc, a0, aux); one(lrow, nc + 32, a1, aux); }
  __device__ __forceinline__ void one(int lrow, int nc, const f32x16& a, float aux) const {
    float sc = 1.f;
    if (invK > 0.f) sc = rsqrtf(aux * invK + 1e-6f);
    bf16_t* p = dst + (size_t)(m0 + lrow) * ldd + col0 + nc;
#pragma unroll
    for (int g = 0; g < 4; ++g) {
      float v0 = a[4 * g] * sc, v1 = a[4 * g + 1] * sc, v2 = a[4 * g + 2] * sc, v3 = a[4 * g + 3] * sc;
      if (act) {
        v0 = 1.f - 2.f / (__expf(2.f * v0) + 1.f); v1 = 1.f - 2.f / (__expf(2.f * v1) + 1.f);
        v2 = 1.f - 2.f / (__expf(2.f * v2) + 1.f); v3 = 1.f - 2.f / (__expf(2.f * v3) + 1.f);
      }
      st_bf16x4(p + 8 * g, v0, v1, v2, v3);
    }
  }
};
struct EpiResid {
  const float* xin; float* xout; const float* gvec; int n0;
  __device__ __forceinline__ void operator()(int lrow, int nc, const f32x16& a0, const f32x16& a1, float) const {
    const size_t o = (size_t)lrow * 1024 + n0 + nc;
    f32x4 xv[8], gv[8];
#pragma unroll
    for (int g = 0; g < 4; ++g) {
      xv[g] = *(const f32x4*)(xin + o + 8 * g); xv[4 + g] = *(const f32x4*)(xin + o + 32 + 8 * g);
      gv[g] = *(const f32x4*)(gvec + n0 + nc + 8 * g); gv[4 + g] = *(const f32x4*)(gvec + n0 + nc + 32 + 8 * g);
    }
    f32x4 r[8];
#pragma unroll
    for (int g = 0; g < 4; ++g)
#pragma unroll
      for (int e = 0; e < 4; ++e) { r[g][e] = xv[g][e] + gv[g][e] * a0[4 * g + e]; r[4 + g][e] = xv[4 + g][e] + gv[4 + g][e] * a1[4 * g + e]; }
    asm volatile("" ::: "memory");
#pragma unroll
    for (int g = 0; g < 4; ++g) { *(f32x4*)(xout + o + 8 * g) = r[g]; *(f32x4*)(xout + o + 32 + 8 * g) = r[4 + g]; }
  }
};
struct EpiMlaIn {
  bf16_t *QC, *KVC, *KPE, *G1; const float* rope; int n0; int m0;
  __device__ __forceinline__ void operator()(int lrow, int nc, const f32x16& a0, const f32x16& a1, float) const { one(lrow, nc, a0); one(lrow, nc + 32, a1); }
  __device__ __forceinline__ void one(int lrow, int nc, const f32x16& a) const {
    const int row = m0 + lrow, gc = n0 + nc, g32 = gc & ~31;
    if (g32 == 640) {
      const int t = (m0 % TL) + lrow, hi4 = gc - 640;
      bf16_t* p = KPE + (size_t)row * 32;
      if (t < T) {
        const f32x2* tr = (const f32x2*)rope + (t >> 6) * 8 + hi4;
        const f32x2* tc = (const f32x2*)rope + (t & 63) * 8 + hi4;
        float o1[8], o2[8];
#pragma unroll
        for (int e = 0; e < 4; ++e) {
          const f32x2 cs0 = tr[e], cs1 = tc[e];
          const float x1a = a[e], x2a = a[8 + e];
          const float x1b = a[4 + e], x2b = a[12 + e];
          o1[e] = x1a * cs0[0] - x2a * cs0[1]; o2[e] = x1a * cs0[1] + x2a * cs0[0];
          o1[4 + e] = x1b * cs1[0] - x2b * cs1[1]; o2[4 + e] = x1b * cs1[1] + x2b * cs1[0];
        }
        st_bf16x4(p + hi4, o1[0], o1[1], o1[2], o1[3]);
        st_bf16x4(p + 8 + hi4, o1[4], o1[5], o1[6], o1[7]);
        st_bf16x4(p + 16 + hi4, o2[0], o2[1], o2[2], o2[3]);
        st_bf16x4(p + 24 + hi4, o2[4], o2[5], o2[6], o2[7]);
      } else {
#pragma unroll
        for (int g = 0; g < 4; ++g) st_bf16x4(p + 8 * g + hi4, a[4 * g], a[4 * g + 1], a[4 * g + 2], a[4 * g + 3]);
      }
      return;
    }
    if (g32 > 640 && g32 < 768) return;
    bf16_t* p;
    if (gc < 384) p = QC + (size_t)row * 384 + gc;
    else if (gc < 640) p = KVC + (size_t)row * 256 + (gc - 384);
    else p = G1 + (size_t)row * 1024 + (gc - 768);
#pragma unroll
    for (int g = 0; g < 4; ++g) st_bf16x4(p + 8 * g, a[4 * g], a[4 * g + 1], a[4 * g + 2], a[4 * g + 3]);
  }
};

__device__ void tr_job(const float* src, int ld, int K, int N, bf16_t* dst, const float* kscale, char* lds) {
  float* tile = (float*)lds;
  const int tid = threadIdx.x, nK = K >> 6, nN = (N + 63) >> 6;
  for (int tIdx = blockIdx.x; tIdx < nK * nN; tIdx += gridDim.x) {
    const int k0 = (tIdx % nK) * 64, n0 = (tIdx / nK) * 64;
#pragma unroll
    for (int i = 0; i < 8; ++i) {
      const int kk = (tid >> 6) + 8 * i, nn = tid & 63;
      float v = 0.f;
      if (n0 + nn < N) { v = src[(size_t)(k0 + kk) * ld + n0 + nn]; if (kscale) v *= kscale[k0 + kk]; }
      tile[kk * 65 + nn] = v;
    }
    __syncthreads();
#pragma unroll
    for (int i = 0; i < 8; ++i) {
      const int nn = (tid >> 6) + 8 * i, kk = tid & 63;
      if (n0 + nn < N) dst[(size_t)(n0 + nn) * K + k0 + kk] = f2bf(tile[kk * 65 + nn]);
    }
    __syncthreads();
  }
}

__device__ void phase_prologue(const Params& p, char* lds) {
  unsigned char* ws = p.ws;
  bf16_t* WIN0 = (bf16_t*)(ws + OFF_WIN0);
  for (int j = 0; j < 4; ++j) tr_job(p.in[8] + (size_t)j * 1024 * 1024, 1024, 1024, 1024, WIN0 + (size_t)j * 1024 * 1024, nullptr, lds);
  for (int d = 0; d < 2; ++d) {
    tr_job(p.in[10] + (size_t)d * 1024 * 64, 64, 1024, 64, WIN0 + (size_t)(4096 + d * 64) * 1024, nullptr, lds);
    tr_job(p.in[13] + (size_t)d * 1024 * 64, 64, 1024, 64, WIN0 + (size_t)(4224 + d * 64) * 1024, nullptr, lds);
  }
  tr_job(p.in[20], 1024, 1024, 1024, (bf16_t*)(ws + OFF_WOUT0), nullptr, lds);
  bf16_t* WIN1 = (bf16_t*)(ws + OFF_WIN1);
  tr_job(p.in[21], 1696, 1024, 640, WIN1, nullptr, lds);
  tr_job(p.in[21] + 640, 1696, 1024, 32, WIN1 + (size_t)640 * 1024, nullptr, lds);
  tr_job(p.in[21] + 672, 1696, 1024, 1024, WIN1 + (size_t)768 * 1024, nullptr, lds);
  for (int i = blockIdx.x * NTHR + threadIdx.x; i < 96 * 1024; i += gridDim.x * NTHR) WIN1[(size_t)672 * 1024 + i] = 0;
  tr_job(p.in[23], 1536, 384, 1536, (bf16_t*)(ws + OFF_WQB), p.in[22], lds);
  tr_job(p.in[25], 2048, 256, 2048, (bf16_t*)(ws + OFF_WKVB), p.in[24], lds);
  tr_job(p.in[26], 1024, 1024, 1024, (bf16_t*)(ws + OFF_WOUT1), nullptr, lds);
  {
    const int i = blockIdx.x * NTHR + threadIdx.x;
    if (i < 1024) {
      const float invf[8] = {1.f, 0.316227766016838f, 0.1f, 0.0316227766016838f, 0.01f, 0.00316227766016838f, 0.001f, 0.000316227766016838f};
      const int pos = i >> 3, m = i & 7;
      float inv = invf[0];
#pragma unroll
      for (int q = 1; q < 8; ++q) inv = (m == q) ? invf[q] : inv;
      const float ang = (float)pos * inv;
      const float kf = rintf(ang * 0.15915494309189535f);
      float r = fmaf(-kf, 6.28125f, ang);
      r = fmaf(-kf, 1.9353071795864769e-3f, r);
      float* rt = (float*)(ws + OFF_ROPE);
      rt[2 * i] = cosf(r); rt[2 * i + 1] = sinf(r);
    }
  }
  {
    float* sil = (float*)lds;
    float* red = sil + 9 * 1024;
    const int tid = threadIdx.x;
    for (int i = tid; i < 9 * 1024; i += NTHR) {
      const int bi = i >> 10, k = i & 1023;
      const float cv = bi < 8 ? p.in[1][bi * 1024 + k] : p.in[3][k];
      sil[i] = cv / (1.f + __expf(-cv));
    }
    __syncthreads();
    float* mod = (float*)(ws + OFF_MOD);
    for (int item = blockIdx.x; item < 192; item += gridDim.x) {
      const int l = item / 96, n0 = (item % 96) * 32, col = tid & 31, kg = tid >> 5;
      float acc[9];
#pragma unroll
      for (int bi = 0; bi < 9; ++bi) acc[bi] = 0.f;
      const float* wp = p.in[5] + ((size_t)l * 1024 + kg * 64) * 3072 + n0 + col;
      for (int kk = 0; kk < 64; ++kk) {
        const float w = wp[(size_t)kk * 3072];
#pragma unroll
        for (int bi = 0; bi < 9; ++bi) acc[bi] += sil[bi * 1024 + kg * 64 + kk] * w;
      }
#pragma unroll
      for (int bi = 0; bi < 9; ++bi) red[(kg * 9 + bi) * 32 + col] = acc[bi];
      __syncthreads();
      if (tid < 288) {
        const int bi = tid >> 5;
        float s = 0.f;
#pragma unroll
        for (int g = 0; g < 16; ++g) s += red[(g * 9 + bi) * 32 + col];
        mod[((size_t)l * 9 + bi) * 3072 + n0 + col] = s + p.in[6][l * 3072 + n0 + col];
      }
      __syncthreads();
    }
  }
}

__device__ __forceinline__ const float* row_src(const float* xsrc, const float* csrc, int n, int& bi) {
  const int b = n / TL, t = n - b * TL;
  if (t < T) { bi = b; return xsrc + ((size_t)b * T + t) * D; }
  bi = 8; return csrc + ((size_t)b * L + (t - T)) * D;
}
__device__ void phase_norm(const float* xsrc, const float* csrc, const float* ng, const float* mod, bf16_t* H) {
  const int lane = threadIdx.x & 63, gw = blockIdx.x * 8 + (threadIdx.x >> 6), nw = gridDim.x * 8;
  f32x4 g4[4];
#pragma unroll
  for (int i = 0; i < 4; ++i) g4[i] = *(const f32x4*)(ng + i * 256 + lane * 4);
  f32x4 va[4], vb[4]; int bia = 0, bib = 0;
  if (gw < NTOK) { const float* src = row_src(xsrc, csrc, gw, bia);
#pragma unroll
    for (int i = 0; i < 4; ++i) va[i] = *(const f32x4*)(src + i * 256 + lane * 4); }
  for (int n = gw; n < NTOK; n += nw) {
    if (n + nw < NTOK) { const float* src = row_src(xsrc, csrc, n + nw, bib);
#pragma unroll
      for (int i = 0; i < 4; ++i) vb[i] = *(const f32x4*)(src + i * 256 + lane * 4); }
    float ss = 0.f;
#pragma unroll
    for (int i = 0; i < 4; ++i) ss += va[i][0] * va[i][0] + va[i][1] * va[i][1] + va[i][2] * va[i][2] + va[i][3] * va[i][3];
    ss = wave_sum(ss);
    const float rstd = rsqrtf(ss * (1.f / 1024.f) + 1e-6f);
    const float* m = mod + bia * 3072;
#pragma unroll
    for (int i = 0; i < 4; ++i) {
      const int c = i * 256 + lane * 4;
      const f32x4 sh = *(const f32x4*)(m + c), sc = *(const f32x4*)(m + 1024 + c);
      float o[4];
#pragma unroll
      for (int e = 0; e < 4; ++e) o[e] = va[i][e] * rstd * g4[i][e] * (1.f + sc[e]) + sh[e];
      st_bf16x4(H + (size_t)n * 1024 + c, o[0], o[1], o[2], o[3]);
    }
#pragma unroll
    for (int i = 0; i < 4; ++i) va[i] = vb[i];
    bia = bib;
  }
}

constexpr int LERP3_SPLIT = 63488;
__device__ __forceinline__ bf16_t* lerp_base(const Params& p, int j, int row) {
  if (j == 0) return (bf16_t*)(p.ws + OFF_Y0);
  if (j == 1) return (bf16_t*)(p.ws + OFF_Y1);
  if (j == 2) return (bf16_t*)p.out;
  if (row < LERP3_SPLIT) return (bf16_t*)p.out + (size_t)NTOK * 1024;
  return (bf16_t*)(p.ws + WS_END) - (size_t)LERP3_SPLIT * 1024;
}
struct RowX { f32x4 v[4]; int bi; };
__device__ __forceinline__ void ld_row(const Params& p, int n, int lane, RowX& r) {
  const float* src = row_src(p.in[0], p.in[2], n, r.bi);
#pragma unroll
  for (int i = 0; i < 4; ++i) r.v[i] = *(const f32x4*)(src + i * 256 + lane * 4);
}
__device__ __forceinline__ void fin_row(const float* mod, const f32x4 (&g4)[4], int lane, const RowX& r, float (&h)[16]) {
  float ss = 0.f;
#pragma unroll
  for (int i = 0; i < 4; ++i) ss += r.v[i][0] * r.v[i][0] + r.v[i][1] * r.v[i][1] + r.v[i][2] * r.v[i][2] + r.v[i][3] * r.v[i][3];
  ss = wave_sum(ss);
  const float rstd = rsqrtf(ss * (1.f / 1024.f) + 1e-6f);
  const float* m = mod + r.bi * 3072;
#pragma unroll
  for (int i = 0; i < 4; ++i) {
    const int c = i * 256 + lane * 4;
    const f32x4 sh = *(const f32x4*)(m + c), sc = *(const f32x4*)(m + 1024 + c);
#pragma unroll
    for (int e = 0; e < 4; ++e) {
      const float hv = r.v[i][e] * rstd * g4[i][e] * (1.f + sc[e]) + sh[e];
      h[4 * i + e] = __uint_as_float(cvtpk(hv, 0.f) << 16);
    }
  }
}
__device__ void phase_norm_lerp(const Params& p, const float* mod) {
  const int lane = threadIdx.x & 63, gw = blockIdx.x * 8 + (threadIdx.x >> 6), nw = gridDim.x * 8;
  const int per = (NTOK + nw - 1) / nw;
  const int r0 = gw * per, r1 = (r0 + per < NTOK) ? r0 + per : NTOK;
  if (r0 >= r1) return;
  bf16_t* H = (bf16_t*)(p.ws + OFF_H);
  f32x4 g4[4];
#pragma unroll
  for (int i = 0; i < 4; ++i) g4[i] = *(const f32x4*)(p.in[4] + i * 256 + lane * 4);
  float mu[4][16];
#pragma unroll
  for (int j = 0; j < 4; ++j)
#pragma unroll
    for (int i = 0; i < 4; ++i) {
      const f32x4 m4 = *(const f32x4*)(p.in[7] + j * 1024 + i * 256 + lane * 4);
      mu[j][4 * i] = m4[0]; mu[j][4 * i + 1] = m4[1]; mu[j][4 * i + 2] = m4[2]; mu[j][4 * i + 3] = m4[3];
    }
  float hp[16], hc[16], hn[16];
  RowX xa, xb, xc;
  if (r0 > 0) { ld_row(p, r0 - 1, lane, xc); }
  ld_row(p, r0, lane, xa);
  if (r0 + 1 < NTOK) ld_row(p, r0 + 1, lane, xb);
  if (r0 > 0) fin_row(mod, g4, lane, xc, hp);
  else {
#pragma unroll
    for (int e = 0; e < 16; ++e) hp[e] = 0.f;
  }
  fin_row(mod, g4, lane, xa, hc);
  xa = xb;
  if (r0 + 2 < NTOK) ld_row(p, r0 + 2, lane, xb);
  for (int n = r0; n < r1; ++n) {
    const int t = n % TL;
    if (n + 3 < NTOK) ld_row(p, n + 3, lane, xc);
    if (n + 1 < NTOK) fin_row(mod, g4, lane, xa, hn);
    else {
#pragma unroll
      for (int e = 0; e < 16; ++e) hn[e] = 0.f;
    }
    const float fp = (t != 0 && t != T) ? 0.5f : 0.f, fn = (t != T - 1 && t != TL - 1) ? 0.5f : 0.f;
#pragma unroll
    for (int i = 0; i < 4; ++i) st_bf16x4(H + (size_t)n * 1024 + i * 256 + lane * 4, hc[4 * i], hc[4 * i + 1], hc[4 * i + 2], hc[4 * i + 3]);
#pragma unroll
    for (int j = 0; j < 4; ++j) {
      bf16_t* dst = lerp_base(p, j, n) + (size_t)n * 1024 + lane * 4;
#pragma unroll
      for (int i = 0; i < 4; ++i) {
        float o[4];
#pragma unroll
        for (int e = 0; e < 4; ++e) { const float c = hc[4 * i + e]; o[e] = c + (fp * hp[4 * i + e] + fn * hn[4 * i + e] - c) * mu[j][4 * i + e]; }
        st_bf16x4(dst + i * 256, o[0], o[1], o[2], o[3]);
      }
    }
#pragma unroll
    for (int e = 0; e < 16; ++e) { hp[e] = hc[e]; hc[e] = hn[e]; }
    xa = xb; xb = xc;
  }
}

__device__ void phase_final(float* out, const float* fg) {
  const int lane = threadIdx.x & 63, gw = blockIdx.x * 8 + (threadIdx.x >> 6), nw = gridDim.x * 8;
  f32x4 g4[4];
#pragma unroll
  for (int i = 0; i < 4; ++i) g4[i] = *(const f32x4*)(fg + i * 256 + lane * 4);
  f32x4 va[4], vb[4];
  if (gw < NB * T) {
#pragma unroll
    for (int i = 0; i < 4; ++i) va[i] = *(const f32x4*)(out + (size_t)gw * D + i * 256 + lane * 4); }
  for (int n = gw; n < NB * T; n += nw) {
    if (n + nw < NB * T) {
#pragma unroll
      for (int i = 0; i < 4; ++i) vb[i] = *(const f32x4*)(out + (size_t)(n + nw) * D + i * 256 + lane * 4); }
    float ss = 0.f;
#pragma unroll
    for (int i = 0; i < 4; ++i) ss += va[i][0] * va[i][0] + va[i][1] * va[i][1] + va[i][2] * va[i][2] + va[i][3] * va[i][3];
    ss = wave_sum(ss);
    const float rstd = rsqrtf(ss * (1.f / 1024.f) + 1e-6f);
#pragma unroll
    for (int i = 0; i < 4; ++i) {
      f32x4 o;
#pragma unroll
      for (int e = 0; e < 4; ++e) o[e] = va[i][e] * rstd * g4[i][e];
      *(f32x4*)(out + (size_t)n * D + i * 256 + lane * 4) = o;
    }
#pragma unroll
    for (int i = 0; i < 4; ++i) va[i] = vb[i];
  }
}

__device__ __forceinline__ int scan_row(int g, int d, int b) {
  if (g < L) { const int tt = d ? (L - 1 - g) : g; return b * TL + T + tt; }
  g -= L; const int tt = d ? (T - 1 - g) : g; return b * TL + tt;
}
constexpr int SC_WD = 0, SC_AR = 8192, SC_BK = SC_AR + 33 * 256, SC_VV = SC_BK + 32768, SC_BUF = SC_VV + 8192;
constexpr int SC_IC = 2 * SC_BUF, SC_YB = SC_IC + 8192, SC_DUMP = SC_YB + 2 * 33 * 256, SC_END = SC_DUMP + 256;
#define MFMA16(a, b, c) __builtin_amdgcn_mfma_f32_16x16x32_bf16((a), (b), (c), 0, 0, 0)
struct ScCoef { u32x4 a0, a1; f32x4 w0, w1, w2, w3; u32x4 k0, k1, k2, k3; float vi; };
__device__ __forceinline__ ScCoef sc_ld(const char* buf, int t, int arOff, int wOff, int bkOff, int vOff) {
  ScCoef c;
  const char* ar = buf + SC_AR + t * 256 + arOff;
  c.a0 = *(const u32x4*)(ar); c.a1 = *(const u32x4*)(ar + 64);
  const char* wd = buf + SC_WD + t * 256 + wOff;
  c.w0 = *(const f32x4*)(wd); c.w1 = *(const f32x4*)(wd + 64); c.w2 = *(const f32x4*)(wd + 128); c.w3 = *(const f32x4*)(wd + 192);
  const char* bk = buf + SC_BK + t * 1024 + bkOff;
  c.k0 = *(const u32x4*)(bk); c.k1 = *(const u32x4*)(bk + 256); c.k2 = *(const u32x4*)(bk + 512); c.k3 = *(const u32x4*)(bk + 768);
  c.vi = *(const float*)(buf + SC_VV + t * 256 + vOff);
  return c;
}
__device__ void phase_scan(const Params& p, char* lds) {
  unsigned char* ws = p.ws;
  const int tid = threadIdx.x, lane = tid & 63, wid = __builtin_amdgcn_readfirstlane(tid >> 6), r32 = lane & 31, hi = lane >> 5;
  const bf16_t* Rg = (const bf16_t*)(ws + OFF_R); const bf16_t* Kg = (const bf16_t*)(ws + OFF_K); const bf16_t* Vg = (const bf16_t*)(ws + OFF_V);
  const bf16_t* Lg = (const bf16_t*)(ws + OFF_LORA);
  constexpr int NCH = TL / 32;
  for (int sidx = blockIdx.x; sidx < 256; sidx += gridDim.x) {
    const int d = sidx >> 7, b = (sidx >> 4) & 7, h = sidx & 15;
    bf16_t* Yg = (bf16_t*)(ws + (d ? OFF_Y1 : OFF_Y0));
    if (wid < 4) {
      const int cw = wid, c16 = lane & 15, q = lane >> 4;
      const int arOff = (c16 & 1) * 128 + q * 16, wOff = q * 16, bkOff = c16 * 16, vOff = (cw * 16 + c16) * 4;
      f32x4 St0 = {0.f, 0.f, 0.f, 0.f}, St1 = St0, St2 = St0, St3 = St0;
      __syncthreads();
      __syncthreads();
      for (int c = 0; c < NCH; ++c) {
        const char* buf = lds + (c & 1) * SC_BUF;
        char* yb = (q == 0) ? (lds + SC_YB + (c & 1) * (33 * 256) + (cw * 16 + c16) * 4) : (lds + SC_DUMP + lane * 4);
        const int ystride = (q == 0) ? 256 : 0;
        ScCoef cur = sc_ld(buf, 0, arOff, wOff, bkOff, vOff);
#pragma unroll 1
        for (int half = 0; half < 2; ++half) {
#pragma unroll 4
          for (int tt = 0; tt < 16; ++tt) {
            const int t = half * 16 + tt;
            const ScCoef nxt = sc_ld(buf, t + 1, arOff, wOff, bkOff, vOff);
            u32x4 b1 = {cvtpk(St0[0], St0[1]), cvtpk(St0[2], St0[3]), cvtpk(St1[0], St1[1]), cvtpk(St1[2], St1[3])};
            u32x4 b2 = {cvtpk(St2[0], St2[1]), cvtpk(St2[2], St2[3]), cvtpk(St3[0], St3[1]), cvtpk(St3[2], St3[3])};
            f32x4 out = {0.f, 0.f, 0.f, 0.f};
            out = MFMA16(*(bf16x8*)&cur.a0, *(bf16x8*)&b1, out);
            out = MFMA16(*(bf16x8*)&cur.a1, *(bf16x8*)&b2, out);
            St0 *= cur.w0; St1 *= cur.w1; St2 *= cur.w2; St3 *= cur.w3;
            u32x4 bu = {q == 0 ? cvtpk(out[0], cur.vi) : 0u, 0u, 0u, 0u};
            St0 = MFMA16(*(bf16x8*)&cur.k0, *(bf16x8*)&bu, St0);
            St1 = MFMA16(*(bf16x8*)&cur.k1, *(bf16x8*)&bu, St1);
            St2 = MFMA16(*(bf16x8*)&cur.k2, *(bf16x8*)&bu, St2);
            St3 = MFMA16(*(bf16x8*)&cur.k3, *(bf16x8*)&bu, St3);
            *(float*)(yb + t * ystride) = out[1];
            cur = nxt;
          }
          if (half == 1) {
            u32x4 b1 = {cvtpk(St0[0], St0[1]), cvtpk(St0[2], St0[3]), cvtpk(St1[0], St1[1]), cvtpk(St1[2], St1[3])};
            u32x4 b2 = {cvtpk(St2[0], St2[1]), cvtpk(St2[2], St2[3]), cvtpk(St3[0], St3[1]), cvtpk(St3[2], St3[3])};
            f32x4 out = {0.f, 0.f, 0.f, 0.f};
            out = MFMA16(*(bf16x8*)&cur.a0, *(bf16x8*)&b1, out);
            out = MFMA16(*(bf16x8*)&cur.a1, *(bf16x8*)&b2, out);
            *(float*)(yb + 32 * ystride) = out[1];
          }
          __syncthreads();
        }
      }
    } else {
      const int pw = wid - 4, ptid = tid - 256;
      const int pstep = ptid >> 3, j0 = (ptid & 7) * 8;
      const int apos0 = (j0 >> 5) * 32 + (((j0 & 31) & 15) >> 2) * 8 + 4 * ((j0 & 31) >> 4), apos1 = apos0 + 8;
      float* Bg = (float*)(ws + OFF_BONUS) + (size_t)d * NTOK * 16;
      float kkc[8], kac[8], rkc[8];
#pragma unroll
      for (int e = 0; e < 8; ++e) { kkc[e] = p.in[15][h * 64 + j0 + e]; kac[e] = p.in[16][h * 64 + j0 + e]; rkc[e] = p.in[17][h * 64 + j0 + e]; }
      const int mat = pw >> 1, jh = pw & 1;
      bf16x8 w2f[4]; float bias;
      {
        const float* W2 = (mat ? p.in[14] : p.in[11]) + (size_t)d * 64 * 1024;
#pragma unroll
        for (int ks = 0; ks < 4; ++ks) {
          u32x4 w;
#pragma unroll
          for (int qq = 0; qq < 4; ++qq) {
            const int r0 = ks * 16 + 8 * hi + 2 * qq;
            w[qq] = cvtpk(W2[(size_t)r0 * 1024 + h * 64 + jh * 32 + r32], W2[(size_t)(r0 + 1) * 1024 + h * 64 + jh * 32 + r32]);
          }
          w2f[ks] = *(bf16x8*)&w;
        }
        bias = (mat ? p.in[12] : p.in[9])[d * 1024 + h * 64 + jh * 32 + r32];
      }
      u32x4 pR, pK, pV; bf16x8 pl[4];
      float kk[8], kr[8], rr[8];
      float* IC = (float*)(lds + SC_IC);
      auto prefetch = [&](int c) {
        const size_t row = (size_t)scan_row(c * 32 + pstep, d, b) * 1024 + h * 64 + j0;
        pR = *(const u32x4*)(Rg + row); pK = *(const u32x4*)(Kg + row); pV = *(const u32x4*)(Vg + row);
        const size_t lrow = (size_t)scan_row(c * 32 + r32, d, b);
#pragma unroll
        for (int ks = 0; ks < 4; ++ks) pl[ks] = *(const bf16x8*)(Lg + lrow * 256 + mat * 128 + d * 64 + ks * 16 + hi * 8);
      };
      auto stageA = [&](int c) {
        char* buf = lds + (c & 1) * SC_BUF;
        float* Wd = (float*)(buf + SC_WD); float* Vv = (float*)(buf + SC_VV); bf16_t* AR = (bf16_t*)(buf + SC_AR);
        f32x16 acc;
#pragma unroll
        for (int r = 0; r < 16; ++r) acc[r] = 0.f;
#pragma unroll
        for (int ks = 0; ks < 4; ++ks) acc = MFMA(pl[ks], w2f[ks], acc);
#pragma unroll
        for (int r = 0; r < 16; ++r) {
          const int step = crow(r, hi), j = jh * 32 + r32;
          const float sg = __builtin_amdgcn_rcpf(1.f + __expf(-(acc[r] + bias)));
          if (mat == 0) Wd[step * 64 + j] = __expf(-0.6065306597126334f * sg); else IC[step * 64 + j] = sg;
        }
        { u32x2 lo = {pR[0], pR[1]}, hi2 = {pR[2], pR[3]};
          *(u32x2*)(AR + (pstep + 1) * 128 + 64 + apos0) = lo; *(u32x2*)(AR + (pstep + 1) * 128 + 64 + apos1) = hi2; }
        float ss = 0.f;
#pragma unroll
        for (int w = 0; w < 4; ++w) {
          rr[2 * w] = lo16(pR[w]); rr[2 * w + 1] = hi16(pR[w]);
          kr[2 * w] = lo16(pK[w]); kr[2 * w + 1] = hi16(pK[w]);
        }
        f32x4 v0 = {lo16(pV[0]), hi16(pV[0]), lo16(pV[1]), hi16(pV[1])}, v1 = {lo16(pV[2]), hi16(pV[2]), lo16(pV[3]), hi16(pV[3])};
        *(f32x4*)(Vv + pstep * 64 + j0) = v0; *(f32x4*)(Vv + pstep * 64 + j0 + 4) = v1;
#pragma unroll
        for (int e = 0; e < 8; ++e) { kk[e] = kr[e] * kkc[e]; ss += kk[e] * kk[e]; }
        ss = red8(ss);
        const float inv = rsqrtf(fmaxf(ss, 1e-24f));
#pragma unroll
        for (int e = 0; e < 8; ++e) kk[e] *= inv;
      };
      auto stageB = [&](int c) {
        char* buf = lds + (c & 1) * SC_BUF;
        u32x4* BK = (u32x4*)(buf + SC_BK); bf16_t* AR = (bf16_t*)(buf + SC_AR);
        const f32x4 i0 = *(const f32x4*)(IC + pstep * 64 + j0), i1 = *(const f32x4*)(IC + pstep * 64 + j0 + 4);
        const float ic[8] = {i0[0], i0[1], i0[2], i0[3], i1[0], i1[1], i1[2], i1[3]};
        { u32x2 lo = {cvtpk(-kk[0], -kk[1]), cvtpk(-kk[2], -kk[3])}, hi2 = {cvtpk(-kk[4], -kk[5]), cvtpk(-kk[6], -kk[7])};
          *(u32x2*)(AR + pstep * 128 + apos0) = lo; *(u32x2*)(AR + pstep * 128 + apos1) = hi2; }
        float bs = 0.f;
#pragma unroll
        for (int e = 0; e < 8; ++e) {
          const float kd = kr[e] * (1.f + (ic[e] - 1.f) * kac[e]);
          u32x4 slot = {cvtpk(kk[e] * ic[e], kd), 0u, 0u, 0u};
          BK[pstep * 64 + j0 + e] = slot;
          bs += rr[e] * kd * rkc[e];
        }
        bs = red8(bs);
        if ((ptid & 7) == 0) Bg[(size_t)scan_row(c * 32 + pstep, d, b) * 16 + h] = bs;
      };
      auto writeout = [&](int c) {
        const float* Yb = (const float*)(lds + SC_YB + (c & 1) * (33 * 256)) + (pstep + 1) * 64 + j0;
        const f32x4 y0 = *(const f32x4*)(Yb), y1 = *(const f32x4*)(Yb + 4);
        u32x4 w = {cvtpk(y0[0], y0[1]), cvtpk(y0[2], y0[3]), cvtpk(y1[0], y1[1]), cvtpk(y1[2], y1[3])};
        *(u32x4*)(Yg + (size_t)scan_row(c * 32 + pstep, d, b) * 1024 + h * 64 + j0) = w;
      };
      prefetch(0);
      stageA(0);
      __syncthreads();
      stageB(0);
      prefetch(1);
      __syncthreads();
      for (int c = 0; c < NCH; ++c) {
        if (c >= 1) writeout(c - 1);
        if (c + 1 < NCH) stageA(c + 1);
        __syncthreads();
        if (c + 1 < NCH) { stageB(c + 1); if (c + 2 < NCH) prefetch(c + 2); }
        __syncthreads();
      }
      writeout(NCH - 1);
    }
    __syncthreads();
  }
}

__device__ void phase_readout(const Params& p) {
  unsigned char* ws = p.ws;
  const bf16_t* Y0 = (const bf16_t*)(ws + OFF_Y0); const bf16_t* Y1 = (const bf16_t*)(ws + OFF_Y1); const bf16_t* Vg = (const bf16_t*)(ws + OFF_V);
  bf16_t* G = (bf16_t*)(ws + OFF_G);
  const float* B0 = (const float*)(ws + OFF_BONUS); const float* B1 = B0 + (size_t)NTOK * 16;
  const int lane = threadIdx.x & 63, gw = blockIdx.x * 8 + (threadIdx.x >> 6), nw = gridDim.x * 8;
  const int c0 = lane * 16, hd = lane >> 2;
  float lg[16], lb[16];
#pragma unroll
  for (int e = 0; e < 16; ++e) { lg[e] = p.in[18][c0 + e]; lb[e] = p.in[19][c0 + e]; }
  for (int n = gw; n < NTOK; n += nw) {
    const size_t o = (size_t)n * 1024 + c0;
    float y[16], v[16], g[16];
#pragma unroll
    for (int q = 0; q < 2; ++q) {
      const u32x4 a = *(const u32x4*)(Y0 + o + 8 * q), bq = *(const u32x4*)(Y1 + o + 8 * q), vv = *(const u32x4*)(Vg + o + 8 * q), gg = *(const u32x4*)(G + o + 8 * q);
#pragma unroll
      for (int w = 0; w < 4; ++w) {
        y[8 * q + 2 * w] = lo16(a[w]) + lo16(bq[w]); y[8 * q + 2 * w + 1] = hi16(a[w]) + hi16(bq[w]);
        v[8 * q + 2 * w] = lo16(vv[w]); v[8 * q + 2 * w + 1] = hi16(vv[w]);
        g[8 * q + 2 * w] = lo16(gg[w]); g[8 * q + 2 * w + 1] = hi16(gg[w]);
      }
    }
    float s = 0.f;
#pragma unroll
    for (int e = 0; e < 16; ++e) s += y[e];
    s += dpp_f(s, 0); s += dpp_f(s, 1);
    const float mean = s * (1.f / 64.f);
    float q2 = 0.f;
#pragma unroll
    for (int e = 0; e < 16; ++e) { const float dlt = y[e] - mean; q2 += dlt * dlt; }
    q2 += dpp_f(q2, 0); q2 += dpp_f(q2, 1);
    const float rs = rsqrtf(q2 * (1.f / 64.f) + 64e-5f);
    const float bonus = B0[(size_t)n * 16 + hd] + B1[(size_t)n * 16 + hd];
    float r[16];
#pragma unroll
    for (int e = 0; e < 16; ++e) {
      const float yn = (y[e] - mean) * rs * lg[e] + lb[e];
      r[e] = (yn + bonus * v[e]) * (g[e] * sigmoidf_(g[e]));
    }
    u32x4 w0 = {cvtpk(r[0], r[1]), cvtpk(r[2], r[3]), cvtpk(r[4], r[5]), cvtpk(r[6], r[7])};
    u32x4 w1 = {cvtpk(r[8], r[9]), cvtpk(r[10], r[11]), cvtpk(r[12], r[13]), cvtpk(r[14], r[15])};
    *(u32x4*)(G + o) = w0; *(u32x4*)(G + o + 8) = w1;
  }
}

constexpr int AT_SHMV = 16384, AT_KROW = 208, AT_SHMK = 64 * AT_KROW;
constexpr int AT_KOFF = 2 * AT_SHMV, AT_WOFF = AT_KOFF + 2 * AT_SHMK;
constexpr float AT_SCALE = 0.10206207261596575f;
constexpr float AT_THR = 8.f;
#define SBAR() __builtin_amdgcn_sched_barrier(0)
__device__ __forceinline__ void at_partialSM(f32x16& p0, f32x16& p1, float& m_reg, float& mn, float& alpha) {
  constexpr float C = AT_SCALE * 1.4426950408889634f;
  float pmax = p0[0];
#pragma unroll
  for (int r = 1; r < 16; ++r) pmax = fmaxf(pmax, p0[r]);
#pragma unroll
  for (int r = 0; r < 16; ++r) pmax = fmaxf(pmax, p1[r]);
  { auto rr = __builtin_amdgcn_permlane32_swap(__float_as_uint(pmax), __float_as_uint(pmax), false, false);
    pmax = fmaxf(__uint_as_float(rr[0]), __uint_as_float(rr[1])); }
  if (__builtin_expect(__all(pmax - m_reg <= AT_THR / AT_SCALE), 1)) { mn = m_reg; alpha = 1.f; }
  else { mn = fmaxf(m_reg, pmax); alpha = __builtin_amdgcn_exp2f((m_reg - mn) * C); m_reg = mn; }
  const float mnC = -mn * C;
#pragma unroll
  for (int r = 0; r < 16; ++r) p0[r] = fmaf(p0[r], C, mnC);
#pragma unroll
  for (int r = 0; r < 16; ++r) p1[r] = fmaf(p1[r], C, mnC);
#pragma unroll
  for (int r = 0; r < 16; ++r) p0[r] = __builtin_amdgcn_exp2f(p0[r]);
}
__device__ __forceinline__ void at_finishSM(f32x16& p0, f32x16& p1, float alpha, float& l_reg, bf16x8& pa0, bf16x8& pa1, bf16x8& pa2, bf16x8& pa3) {
#pragma unroll
  for (int r = 0; r < 16; ++r) p1[r] = __builtin_amdgcn_exp2f(p1[r]);
  float ps = 0;
#pragma unroll
  for (int r = 0; r < 16; ++r) ps += p0[r];
#pragma unroll
  for (int r = 0; r < 16; ++r) ps += p1[r];
  { auto rr = __builtin_amdgcn_permlane32_swap(__float_as_uint(ps), __float_as_uint(ps), false, false);
    ps = __uint_as_float(rr[0]) + __uint_as_float(rr[1]); }
  l_reg = l_reg * alpha + ps;
#define PK4(P, BASE, OUT) do { unsigned a0 = cvtpk(P[BASE + 0], P[BASE + 1]), a1 = cvtpk(P[BASE + 2], P[BASE + 3]);   \
    unsigned b0 = cvtpk(P[BASE + 4], P[BASE + 5]), b1 = cvtpk(P[BASE + 6], P[BASE + 7]);                              \
    auto r0 = __builtin_amdgcn_permlane32_swap(a0, b0, false, false); auto r1 = __builtin_amdgcn_permlane32_swap(a1, b1, false, false); \
    u32x4 w = {r0[0], r1[0], r0[1], r1[1]}; OUT = *reinterpret_cast<bf16x8*>(&w); } while (0)
  PK4(p0, 0, pa0); PK4(p0, 8, pa1); PK4(p1, 0, pa2); PK4(p1, 8, pa3);
#undef PK4
}
__device__ __forceinline__ void at_qkt(f32x16& p0, f32x16& p1, const char* Ks, const bf16x8* qr, int r32, int hi) {
#pragma unroll
  for (int r = 0; r < 16; ++r) { p0[r] = 0.f; p1[r] = 0.f; }
#pragma unroll
  for (int d0 = 0; d0 < 6; ++d0) {
    const bf16x8 b0 = *(const bf16x8*)(Ks + r32 * AT_KROW + d0 * 32 + hi * 16);
    const bf16x8 b1 = *(const bf16x8*)(Ks + (32 + r32) * AT_KROW + d0 * 32 + hi * 16);
    p0 = MFMA(b0, qr[d0], p0);
    p1 = MFMA(b1, qr[d0], p1);
  }
}
__device__ __forceinline__ int v_st(int k, int c) { const int kk = (k & ~0xC) | ((k & 4) << 1) | ((k & 8) >> 1); return ((kk >> 3) * 4 + (c >> 5)) * 512 + ((kk & 7) * 32 + (c & 31)) * 2; }
__device__ __forceinline__ int v_rd_base(int lane) { return ((lane & 3) << 3) | (((lane >> 2) & 3) << 6) | (((lane >> 4) & 1) << 5) | (((lane >> 5) & 1) << 8); }
constexpr int v_rd_off(int d0, int ks, int half) { return d0 * 512 + ks * 4096 + half * 2048; }
template <int OFF> __device__ __forceinline__ s16x4 tr_read(int vb) {
  s16x4 r; asm volatile("ds_read_b64_tr_b16 %0, %1 offset:%2" : "=&v"(r) : "v"(vb), "i"(OFF) : "memory"); return r;
}
template <int D0> __device__ __forceinline__ void pv_one(f32x16& od, int vb, bf16x8 pa0, bf16x8 pa1, bf16x8 pa2, bf16x8 pa3) {
  const s16x4 l0 = tr_read<v_rd_off(D0, 0, 0)>(vb), h0 = tr_read<v_rd_off(D0, 0, 1)>(vb), l1 = tr_read<v_rd_off(D0, 1, 0)>(vb), h1 = tr_read<v_rd_off(D0, 1, 1)>(vb);
  const s16x4 l2 = tr_read<v_rd_off(D0, 2, 0)>(vb), h2 = tr_read<v_rd_off(D0, 2, 1)>(vb), l3 = tr_read<v_rd_off(D0, 3, 0)>(vb), h3 = tr_read<v_rd_off(D0, 3, 1)>(vb);
  asm volatile("s_waitcnt lgkmcnt(0)" ::: "memory"); SBAR();
#define PK(Lx, Hx) (bf16x8){Lx[0], Lx[1], Lx[2], Lx[3], Hx[0], Hx[1], Hx[2], Hx[3]}
  od = MFMA(pa0, PK(l0, h0), od);
  od = MFMA(pa1, PK(l1, h1), od);
  od = MFMA(pa2, PK(l2, h2), od);
  od = MFMA(pa3, PK(l3, h3), od);
#undef PK
}
__device__ __forceinline__ void pv_d0(f32x16* o, int vb, bf16x8 pa0, bf16x8 pa1, bf16x8 pa2, bf16x8 pa3) {
  pv_one<0>(o[0], vb, pa0, pa1, pa2, pa3); pv_one<1>(o[1], vb, pa0, pa1, pa2, pa3);
}

__device__ void phase_attn(const Params& p, char* lds) {
  unsigned char* ws = p.ws;
  const bf16_t* Qg = (const bf16_t*)(ws + OFF_Q); const bf16_t* KVg = (const bf16_t*)(ws + OFF_KV); const bf16_t* KPg = (const bf16_t*)(ws + OFF_KPE);
  bf16_t* G1 = (bf16_t*)(ws + OFF_G1);
  const f32x2* rope = (const f32x2*)(ws + OFF_ROPE);
  const int tid = threadIdx.x, wid = tid >> 6, lane = tid & 63, r32 = lane & 31, hi = lane >> 5;
  char* V_lds = lds; char* K_lds = lds + AT_KOFF;
  float* wsl = (float*)(lds + AT_WOFF) + wid * 64; float* li_l = wsl; float* al_l = wsl + 32;
  const int skey = tid >> 3, sc8 = (tid & 7) * 8;
  const int pkey = (tid & 255) >> 2, pc8 = (tid & 3) * 8;
  const int vst = v_st(skey, sc8), kst = skey * AT_KROW + sc8 * 2, pst = pkey * AT_KROW + (64 + pc8) * 2;
  const int vb0 = (int)(uintptr_t)V_lds + v_rd_base(lane);
  const int nitems = NB * 16 * 32;
  const int xcd = blockIdx.x & 7, slot = blockIdx.x >> 3, per = gridDim.x >> 3;
  for (int it = slot; it < nitems / 8; it += per) {
    const int pair = (it >> 5) * 8 + xcd, qblk = it & 31;
    const int b = pair >> 4, h = pair & 15;
    const size_t row0 = (size_t)b * TL;
    const size_t qrow = row0 + qblk * 256 + wid * 32 + r32;
    const bf16_t* Kh = KVg + row0 * 2048 + h * 128;
    const bf16_t* Kp = KPg + row0 * 32;
    float m_reg = -1e30f, l_reg = 0.f;
    f32x16 o[2];
#pragma unroll
    for (int dd = 0; dd < 2; ++dd)
#pragma unroll
      for (int r = 0; r < 16; ++r) o[dd][r] = 0.f;
    bf16x8 qr[6];
    {
      const bf16_t* Qw = Qg + qrow * 1536 + h * 96 + hi * 8;
#pragma unroll
      for (int d0 = 0; d0 < 6; ++d0) qr[d0] = *(const bf16x8*)(Qw + d0 * 16);
      const int t = qblk * 256 + wid * 32 + r32;
      const f32x2* tb = rope + (hi ? (t & 63) : (t >> 6)) * 8;
      const u32x4 x1 = *(const u32x4*)&qr[4], x2 = *(const u32x4*)&qr[5];
      u32x4 n1, n2;
#pragma unroll
      for (int q = 0; q < 4; ++q) {
        const f32x2 csA = tb[2 * q], csB = tb[2 * q + 1];
        const float a0 = lo16(x1[q]), a1 = hi16(x1[q]), b0 = lo16(x2[q]), b1 = hi16(x2[q]);
        n1[q] = cvtpk(a0 * csA[0] - b0 * csA[1], a1 * csB[0] - b1 * csB[1]);
        n2[q] = cvtpk(a0 * csA[1] + b0 * csA[0], a1 * csB[1] + b1 * csB[0]);
      }
      qr[4] = *(bf16x8*)&n1; qr[5] = *(bf16x8*)&n2;
    }
    struct { bf16x8 vs, ks, ps; } sr_[2];
#define SLOAD(i, k0) do { sr_[i].vs = *(const bf16x8*)(Kh + (size_t)((k0) + skey) * 2048 + 64 + sc8); \
    sr_[i].ks = *(const bf16x8*)(Kh + (size_t)((k0) + skey) * 2048 + sc8); \
    sr_[i].ps = *(const bf16x8*)(Kp + (size_t)((k0) + pkey) * 32 + pc8); } while (0)
#define SWRITE(bb, i) do { *(bf16x8*)(V_lds + (bb) * AT_SHMV + vst) = sr_[i].vs; \
    *(bf16x8*)(K_lds + (bb) * AT_SHMK + kst) = sr_[i].ks; \
    *(bf16x8*)(K_lds + (bb) * AT_SHMK + pst) = sr_[i].ps; } while (0)
#define SWAIT() asm volatile("s_waitcnt vmcnt(3)" ::: "memory")
#define RESC(a) do { if (__any((a) < 1.f)) { if (hi == 0) al_l[r32] = (a); asm volatile("s_waitcnt lgkmcnt(0)" ::: "memory"); \
    _Pragma("unroll") for (int dd = 0; dd < 2; ++dd) _Pragma("unroll") for (int r = 0; r < 16; ++r) o[dd][r] *= al_l[crow(r, hi)]; } } while (0)
    f32x16 pA0, pA1, pB0, pB1; float mnA, mnB, alA, alB; bf16x8 pa0, pa1, pa2, pa3;
    constexpr int NT = TL / 64;
    SLOAD(0, 0); asm volatile("s_waitcnt vmcnt(0)" ::: "memory"); SWRITE(0, 0); __syncthreads();
    at_qkt(pA0, pA1, K_lds, qr, r32, hi); at_partialSM(pA0, pA1, m_reg, mnA, alA);
    SLOAD(1, 64); SLOAD(0, 128);
    SWAIT(); SWRITE(1, 1); __syncthreads();
    for (int j = 1; j + 1 < NT; j += 2) {
      SBAR(); at_qkt(pB0, pB1, K_lds + AT_SHMK, qr, r32, hi);
      at_finishSM(pA0, pA1, alA, l_reg, pa0, pa1, pa2, pa3); SBAR();
      SLOAD(1, (j + 2) * 64); SBAR();
      pv_d0(o, vb0, pa0, pa1, pa2, pa3); at_partialSM(pB0, pB1, m_reg, mnB, alB);
      __syncthreads(); SWAIT(); SWRITE(0, 0);
      RESC(alB); __syncthreads();
      SBAR(); at_qkt(pA0, pA1, K_lds, qr, r32, hi);
      at_finishSM(pB0, pB1, alB, l_reg, pa0, pa1, pa2, pa3); SBAR();
      if (j + 3 < NT) SLOAD(0, (j + 3) * 64); SBAR();
      pv_d0(o, vb0 + AT_SHMV, pa0, pa1, pa2, pa3); at_partialSM(pA0, pA1, m_reg, mnA, alA);
      __syncthreads(); SWAIT(); SWRITE(1, 1);
      RESC(alA); __syncthreads();
    }
    SBAR(); at_qkt(pB0, pB1, K_lds + AT_SHMK, qr, r32, hi);
    at_finishSM(pA0, pA1, alA, l_reg, pa0, pa1, pa2, pa3); SBAR();
    pv_d0(o, vb0, pa0, pa1, pa2, pa3); at_partialSM(pB0, pB1, m_reg, mnB, alB);
    __syncthreads(); RESC(alB);
    at_finishSM(pB0, pB1, alB, l_reg, pa0, pa1, pa2, pa3); SBAR();
    pv_d0(o, vb0 + AT_SHMV, pa0, pa1, pa2, pa3);
    if (hi == 0) li_l[r32] = l_reg;
    asm volatile("s_waitcnt lgkmcnt(0)" ::: "memory");
    float rli[16];
#pragma unroll
    for (int r = 0; r < 16; ++r) rli[r] = __builtin_amdgcn_rcpf(li_l[crow(r, hi)]);
    bf16_t* Gw = G1 + (row0 + qblk * 256 + wid * 32) * 1024 + h * 64 + r32;
    bf16_t gin[32];
#pragma unroll
    for (int r = 0; r < 16; ++r) { gin[2 * r] = Gw[(size_t)crow(r, hi) * 1024]; gin[2 * r + 1] = Gw[(size_t)crow(r, hi) * 1024 + 32]; }
    asm volatile("" ::: "memory");
#pragma unroll
    for (int r = 0; r < 16; ++r) {
      const int orow = crow(r, hi);
#pragma unroll
      for (int d0 = 0; d0 < 2; ++d0) {
        const float gt = bf2f(gin[2 * r + d0]);
        Gw[(size_t)orow * 1024 + d0 * 32] = f2bf(o[d0][r] * rli[r] * gt * sigmoidf_(gt));
      }
    }
    __syncthreads();
#undef SLOAD
#undef SWRITE
#undef SWAIT
#undef RESC
  }
}

struct XcdWalk {
  int start, count, step, idx;
  __device__ __forceinline__ void init(int ntiles) {
    const int x = blockIdx.x & 7, base = ntiles >> 3, rem = ntiles & 7;
    count = base + (x < rem ? 1 : 0); start = x * base + (x < rem ? x : rem); step = gridDim.x >> 3; idx = blockIdx.x >> 3;
  }
  __device__ __forceinline__ bool next(int& o) { if (idx >= count) return false; o = start + idx; idx += step; return true; }
};
__device__ __forceinline__ void tile_mn(int o, int NT, int& mt, int& nt) { const int g = o >> 3; mt = (g / NT) * 8 + (o & 7); nt = g % NT; }

__global__ __launch_bounds__(NTHR, 1) void fwd_megakernel(Params p) {
  extern __shared__ __attribute__((aligned(16))) char lds[];
  cg::grid_group grid = cg::this_grid();
  unsigned char* ws = p.ws;
  bf16_t* H = (bf16_t*)(ws + OFF_H);
  float* mod = (float*)(ws + OFF_MOD);
  float* CTX1 = (float*)(ws + OFF_CTX1);

  phase_prologue(p, lds);
  grid.sync();
  phase_norm_lerp(p, mod);
  grid.sync();
  {
    const bf16_t* WIN0 = (const bf16_t*)(ws + OFF_WIN0);
    const int nbig = 264 * 16;
    XcdWalk wk; wk.init(nbig); int o;
    while (wk.next(o)) {
      EpiBf16 e; e.invK = 0.f;
      {
        int mt, jn; tile_mn(o, 16, mt, jn);
        const int j = jn >> 2, n4 = jn & 3, m0 = mt * 256;
        e.dst = (bf16_t*)(ws + OFF_R + (size_t)j * U); e.ldd = 1024; e.col0 = n4 * 256; e.act = 0; e.m0 = m0;
        gemm_tile<0, 256>(lerp_base(p, j, m0), 1024, WIN0 + (size_t)(j * 1024 + n4 * 256) * 1024, 1024, m0, nullptr, lds, e);
      }
    }
    wk.init(264 * 2);
    while (wk.next(o)) {
      EpiBf16 e; e.invK = 0.f;
      {
        int mt, n2; tile_mn(o, 2, mt, n2);
        const int nt = 32 + n2, m0 = mt * 256;
        e.dst = (bf16_t*)(ws + OFF_LORA); e.ldd = 256; e.col0 = (nt - 32) * 128; e.act = (nt == 32) ? 1 : 0; e.m0 = m0;
        gemm_tile<1, 128>(H, 1024, WIN0 + (size_t)nt * 128 * 1024, 1024, m0, p.in[7] + (nt - 28) * 1024, lds, e);
      }
    }
  }
  grid.sync();
  phase_scan(p, lds);
  grid.sync();
  phase_readout(p);
  grid.sync();
  {
    const bf16_t* A = (const bf16_t*)(ws + OFF_G); const bf16_t* W = (const bf16_t*)(ws + OFF_WOUT0);
    XcdWalk wk; wk.init(264 * 4); int o;
    while (wk.next(o)) {
      int mt, nt; tile_mn(o, 4, mt, nt);
      const int m0 = mt * 256;
      const int b = m0 / TL, t0 = m0 - b * TL;
      EpiResid e;
      if (t0 < T) { const size_t orow = (size_t)b * T + t0; e.xin = p.in[0] + orow * 1024; e.xout = p.out + orow * 1024; e.gvec = mod + (size_t)b * 3072 + 2048; }
      else { const size_t orow = (size_t)b * L + (t0 - T); e.xin = p.in[2] + orow * 1024; e.xout = CTX1 + orow * 1024; e.gvec = mod + (size_t)8 * 3072 + 2048; }
      e.n0 = nt * 256;
      gemm_tile<0, 256>(A, 1024, W + (size_t)nt * 256 * 1024, 1024, m0, nullptr, lds, e);
    }
  }
  grid.sync();
  phase_norm(p.out, CTX1, p.in[4] + 1024, mod + 9 * 3072, H);
  grid.sync();
  {
    const bf16_t* W = (const bf16_t*)(ws + OFF_WIN1);
    XcdWalk wk; wk.init(264 * 7); int o;
    while (wk.next(o)) {
      int mt, nt; tile_mn(o, 7, mt, nt);
      const int m0 = mt * 256;
      EpiMlaIn e; e.QC = (bf16_t*)(ws + OFF_QC); e.KVC = (bf16_t*)(ws + OFF_KVC); e.KPE = (bf16_t*)(ws + OFF_KPE); e.G1 = (bf16_t*)(ws + OFF_G1);
      e.rope = (const float*)(ws + OFF_ROPE); e.n0 = nt * 256; e.m0 = m0;
      gemm_tile<0, 256>(H, 1024, W + (size_t)nt * 256 * 1024, 1024, m0, nullptr, lds, e);
    }
  }
  grid.sync();
  {
    const bf16_t* WQ = (const bf16_t*)(ws + OFF_WQB); const bf16_t* WKV = (const bf16_t*)(ws + OFF_WKVB);
    const int nq = 256 * 6, nkv = 264 * 8;
    XcdWalk wk; wk.init(nq); int o;
    while (wk.next(o)) {
      EpiBf16 e; e.act = 0;
      {
        int mt2, nt; tile_mn(o, 6, mt2, nt);
        const int b = mt2 >> 5, m0 = b * TL + (mt2 & 31) * 256;
        e.dst = (bf16_t*)(ws + OFF_Q); e.ldd = 1536; e.col0 = nt * 256; e.m0 = m0; e.invK = 1.f / 384.f;
        gemm_tile<2, 256>((const bf16_t*)(ws + OFF_QC), 384, WQ + (size_t)nt * 256 * 384, 384, m0, nullptr, lds, e);
      }
    }
    wk.init(nkv);
    while (wk.next(o)) {
      EpiBf16 e; e.act = 0;
      {
        int mt, nt; tile_mn(o, 8, mt, nt);
        const int m0 = mt * 256;
        e.dst = (bf16_t*)(ws + OFF_KV); e.ldd = 2048; e.col0 = nt * 256; e.m0 = m0; e.invK = 1.f / 256.f;
        gemm_tile<2, 256>((const bf16_t*)(ws + OFF_KVC), 256, WKV + (size_t)nt * 256 * 256, 256, m0, nullptr, lds, e);
      }
    }
  }
  grid.sync();
  phase_attn(p, lds);
  grid.sync();
  {
    const bf16_t* A = (const bf16_t*)(ws + OFF_G1); const bf16_t* W = (const bf16_t*)(ws + OFF_WOUT1);
    XcdWalk wk; wk.init(256 * 4); int o;
    while (wk.next(o)) {
      int mt2, nt; tile_mn(o, 4, mt2, nt);
      const int b = mt2 >> 5, t0 = (mt2 & 31) * 256, m0 = b * TL + t0;
      const size_t orow = (size_t)b * T + t0;
      EpiResid e; e.xin = p.out + orow * 1024; e.xout = p.out + orow * 1024; e.gvec = mod + (size_t)(9 + b) * 3072 + 2048; e.n0 = nt * 256;
      gemm_tile<0, 256>(A, 1024, W + (size_t)nt * 256 * 1024, 1024, m0, nullptr, lds, e);
    }
  }
  grid.sync();
  phase_final(p.out, p.in[27]);
}

extern "C" void kernel_launch(void* const* d_in, const int* in_sizes, int n_in, void* d_out, int out_size, void* d_ws, size_t ws_size, hipStream_t stream) {
  static int grid_blocks = 0;
  if (grid_blocks == 0) {
    if (n_in != 28 || ws_size < WS_END + (size_t)(NTOK - LERP3_SPLIT) * 2048 || out_size != NB * T * D) { fprintf(stderr, "kernel_launch: unexpected shapes (n_in %d, ws %zu need %zu, out %d)\n", n_in, ws_size, (size_t)WS_END, out_size); grid_blocks = -1; return; }
    int dev = 0, cus = 0, per_cu = 0;
    hipGetDevice(&dev);
    hipDeviceGetAttribute(&cus, hipDeviceAttributeMultiprocessorCount, dev);
    if (hipFuncSetAttribute((const void*)fwd_megakernel, hipFuncAttributeMaxDynamicSharedMemorySize, LDS_BYTES) != hipSuccess) { fprintf(stderr, "kernel_launch: hipFuncSetAttribute failed\n"); grid_blocks = -1; return; }
    hipOccupancyMaxActiveBlocksPerMultiprocessor(&per_cu, (const void*)fwd_megakernel, NTHR, LDS_BYTES);
    if (per_cu < 1) { fprintf(stderr, "kernel_launch: occupancy query says %d blocks per CU\n", per_cu); per_cu = 1; }
    (void)hipGetLastError();
    grid_blocks = cus;
    if (grid_blocks > 256) grid_blocks = 256;
    grid_blocks &= ~7;
  }
  if (grid_blocks <= 0) return;
  Params p{};
  for (int i = 0; i < 28; ++i) p.in[i] = (const float*)d_in[i];
  p.out = (float*)d_out; p.ws = (unsigned char*)d_ws;
  void* args[] = {&p};
  hipError_t e = hipLaunchCooperativeKernel((const void*)fwd_megakernel, dim3(grid_blocks), dim3(NTHR), args, LDS_BYTES, stream);
  if (e != hipSuccess) fprintf(stderr, "cooperative launch failed: %s (grid %d)\n", hipGetErrorString(e), grid_blocks);
}
```

```cpp
#include <hip/hip_runtime.h>
#include <hip/hip_cooperative_groups.h>
#include <cstdio>
#include <cstdint>
namespace cg = cooperative_groups;

typedef unsigned short bf16_t;
typedef short bf16x8 __attribute__((ext_vector_type(8)));
typedef short s16x4 __attribute__((ext_vector_type(4)));
typedef float f32x16 __attribute__((ext_vector_type(16)));
typedef float f32x4 __attribute__((ext_vector_type(4)));
typedef float f32x2 __attribute__((ext_vector_type(2)));
typedef unsigned u32x4 __attribute__((ext_vector_type(4)));
typedef unsigned u32x2 __attribute__((ext_vector_type(2)));

constexpr int D = 1024, NB = 8, T = 8192, L = 256, TL = T + L, NTOK = NB * TL;
constexpr int NTHR = 512;

constexpr size_t U = (size_t)NTOK * 1024 * 2;
constexpr size_t OFF_H = 0, OFF_R = U, OFF_K = 2 * U, OFF_V = 3 * U, OFF_G = 4 * U, OFF_Y0 = 5 * U, OFF_Y1 = 6 * U;
constexpr size_t OFF_LORA = 7 * U;
constexpr size_t OFF_BONUS = OFF_LORA + (size_t)NTOK * 256 * 2;
constexpr size_t OFF_WIN0 = OFF_BONUS + (size_t)2 * NTOK * 16 * 4;
constexpr size_t OFF_WOUT0 = OFF_WIN0 + (size_t)4352 * 1024 * 2;
constexpr size_t OFF_WIN1 = OFF_WOUT0 + (size_t)1024 * 1024 * 2;
constexpr size_t OFF_WQB = OFF_WIN1 + (size_t)1792 * 1024 * 2;
constexpr size_t OFF_WKVB = OFF_WQB + (size_t)1536 * 384 * 2;
constexpr size_t OFF_WOUT1 = OFF_WKVB + (size_t)2048 * 256 * 2;
constexpr size_t OFF_MOD = OFF_WOUT1 + (size_t)1024 * 1024 * 2;
constexpr size_t OFF_ROPE = OFF_MOD + (size_t)2 * 9 * 3072 * 4;
constexpr size_t OFF_CTX1 = OFF_ROPE + (size_t)128 * 8 * 2 * 4;
constexpr size_t WS_END = OFF_CTX1 + (size_t)2048 * 1024 * 4;
constexpr size_t OFF_QC = OFF_V;
constexpr size_t OFF_KVC = OFF_QC + (size_t)NTOK * 384 * 2;
constexpr size_t OFF_KPE = OFF_KVC + (size_t)NTOK * 256 * 2;
constexpr size_t OFF_G1 = OFF_G;
constexpr size_t OFF_Q = OFF_R;
constexpr size_t OFF_KV = OFF_Y0;

struct Params { const float* in[28]; float* out; unsigned char* ws; };

typedef __bf16 bf16x2_t __attribute__((ext_vector_type(2)));
__device__ __forceinline__ unsigned cvtpk(float lo, float hi) { f32x2 v = {lo, hi}; bf16x2_t b = __builtin_convertvector(v, bf16x2_t); return *(unsigned*)&b; }
__device__ __forceinline__ float bf2f(bf16_t u) { return __uint_as_float(((unsigned)u) << 16); }
__device__ __forceinline__ bf16_t f2bf(float f) { return (bf16_t)(cvtpk(f, 0.f) & 0xffffu); }
__device__ __forceinline__ float lo16(unsigned w) { return __uint_as_float(w << 16); }
__device__ __forceinline__ float hi16(unsigned w) { return __uint_as_float(w & 0xffff0000u); }
__device__ __forceinline__ void st_bf16x4(bf16_t* p, float a, float b, float c, float d) { u32x2 w = {cvtpk(a, b), cvtpk(c, d)}; *(u32x2*)p = w; }
__device__ __forceinline__ float wave_sum(float v) {
#pragma unroll
  for (int o = 32; o; o >>= 1) v += __shfl_xor(v, o);
  return v;
}
__device__ __forceinline__ float dpp_f(float v, const int ctrl_sel) {
  int r;
  if (ctrl_sel == 0) r = __builtin_amdgcn_update_dpp(0, __float_as_int(v), 0xB1, 0xF, 0xF, true);
  else if (ctrl_sel == 1) r = __builtin_amdgcn_update_dpp(0, __float_as_int(v), 0x4E, 0xF, 0xF, true);
  else r = __builtin_amdgcn_update_dpp(0, __float_as_int(v), 0x141, 0xF, 0xF, true);
  return __int_as_float(r);
}
__device__ __forceinline__ float red8(float v) { v += dpp_f(v, 0); v += dpp_f(v, 1); v += dpp_f(v, 2); return v; }
__device__ __forceinline__ int crow(int r, int hi) { return (r & 3) + 8 * (r >> 2) + 4 * hi; }
__device__ __forceinline__ float sigmoidf_(float x) { return 1.f / (1.f + __expf(-x)); }
#define MFMA(a, b, c) __builtin_amdgcn_mfma_f32_32x32x16_bf16((a), (b), (c), 0, 0, 0)

constexpr int G_LDT = 144;
constexpr int G_SSQ_OFF = 2 * (256 + 256) * G_LDT;
constexpr int LDS_BYTES = G_SSQ_OFF + 1024;

template <int AMODE, int BN, class Epi>
__device__ __forceinline__ void gemm_tile(const bf16_t* A, const int lda, const bf16_t* Bt, const int K, const int m0, const float* mu, char* lds, const Epi& epi) {
  constexpr int WN = BN / 64, MI = WN, NBR = BN / 64, G_STAGE = (256 + BN) * G_LDT;
  const int tid = threadIdx.x, lane = tid & 63, wid = tid >> 6, r32 = lane & 31, hi = lane >> 5;
  const int wm = wid / WN, wn = wid % WN;
  const int srow = tid >> 3, scc = (tid & 7) * 8;
  f32x16 acc[MI][2];
#pragma unroll
  for (int i = 0; i < MI; ++i)
#pragma unroll
    for (int j = 0; j < 2; ++j)
#pragma unroll
      for (int r = 0; r < 16; ++r) acc[i][j][r] = 0.f;
  bf16x8 ra[4], rb[NBR], rp[4], rn[4];
  float ssq[4] = {0.f, 0.f, 0.f, 0.f};
  int dprev[4], dnext[4];
  if constexpr (AMODE == 1) {
    const int t0 = m0 % TL;
#pragma unroll
    for (int i = 0; i < 4; ++i) { const int t = t0 + srow + 64 * i; dprev[i] = (t != 0 && t != T) ? 1 : 0; dnext[i] = (t != T - 1 && t != TL - 1) ? 1 : 0; }
  }
  auto gload = [&](int k0) {
#pragma unroll
    for (int i = 0; i < 4; ++i) {
      const bf16_t* ap = A + (size_t)(m0 + srow + 64 * i) * lda + k0 + scc;
      ra[i] = *(const bf16x8*)ap;
      if constexpr (AMODE == 1) { rp[i] = *(const bf16x8*)(ap - dprev[i] * lda); rn[i] = *(const bf16x8*)(ap + dnext[i] * lda); }
    }
#pragma unroll
    for (int i = 0; i < NBR; ++i) rb[i] = *(const bf16x8*)(Bt + (size_t)(srow + 64 * i) * K + k0 + scc);
  };
  auto lstore = [&](int s, int k0) {
    char* base = lds + s * G_STAGE;
    if constexpr (AMODE == 1) {
      const f32x4 m0v = *(const f32x4*)(mu + k0 + scc), m1v = *(const f32x4*)(mu + k0 + scc + 4);
      const float mm[8] = {m0v[0], m0v[1], m0v[2], m0v[3], m1v[0], m1v[1], m1v[2], m1v[3]};
#pragma unroll
      for (int i = 0; i < 4; ++i) {
        const u32x4 hc = *(const u32x4*)&ra[i], hp = *(const u32x4*)&rp[i], hn = *(const u32x4*)&rn[i];
        const float fp = dprev[i] ? 0.5f : 0.f, fn = dnext[i] ? 0.5f : 0.f;
        u32x4 w;
#pragma unroll
        for (int q = 0; q < 4; ++q) {
          const float c0 = lo16(hc[q]), c1 = hi16(hc[q]);
          const float x0 = fp * lo16(hp[q]) + fn * lo16(hn[q]) - c0, x1 = fp * hi16(hp[q]) + fn * hi16(hn[q]) - c1;
          w[q] = cvtpk(c0 + x0 * mm[2 * q], c1 + x1 * mm[2 * q + 1]);
        }
        *(u32x4*)(base + (srow + 64 * i) * G_LDT + scc * 2) = w;
      }
    } else {
#pragma unroll
      for (int i = 0; i < 4; ++i) {
        *(bf16x8*)(base + (srow + 64 * i) * G_LDT + scc * 2) = ra[i];
        if constexpr (AMODE == 2) {
          const u32x4 hc = *(const u32x4*)&ra[i];
#pragma unroll
          for (int q = 0; q < 4; ++q) { const float c0 = lo16(hc[q]), c1 = hi16(hc[q]); ssq[i] += c0 * c0 + c1 * c1; }
        }
      }
    }
#pragma unroll
    for (int i = 0; i < NBR; ++i) *(bf16x8*)(base + 256 * G_LDT + (srow + 64 * i) * G_LDT + scc * 2) = rb[i];
  };
  const int nk = K >> 6;
  gload(0);
  lstore(0, 0);
  if (nk > 1) gload(64);
  __syncthreads();
#pragma unroll 1
  for (int kt = 0; kt < nk; ++kt) {
    const int s = kt & 1;
    if (kt + 1 < nk) lstore(s ^ 1, (kt + 1) * 64);
    if (kt + 2 < nk) gload((kt + 2) * 64);
    {
      const char* Ab = lds + s * G_STAGE + (wm * (32 * MI) + r32) * G_LDT + hi * 16;
      const char* Bb = lds + s * G_STAGE + 256 * G_LDT + (wn * 64 + r32) * G_LDT + hi * 16;
#pragma unroll 2
      for (int ks = 0; ks < 4; ++ks) {
        const bf16x8 b0 = *(const bf16x8*)(Bb + ks * 32), b1 = *(const bf16x8*)(Bb + 32 * G_LDT + ks * 32);
#pragma unroll
        for (int mi = 0; mi < MI; ++mi) {
          const bf16x8 a0 = *(const bf16x8*)(Ab + mi * 32 * G_LDT + ks * 32);
          acc[mi][0] = MFMA(b0, a0, acc[mi][0]); acc[mi][1] = MFMA(b1, a0, acc[mi][1]);
        }
      }
    }
    __syncthreads();
  }
  float* ssq_l = (float*)(lds + G_SSQ_OFF);
  if constexpr (AMODE == 2) {
#pragma unroll
    for (int i = 0; i < 4; ++i) { const float v = red8(ssq[i]); if ((tid & 7) == 0) ssq_l[srow + 64 * i] = v; }
    __syncthreads();
  }
#pragma unroll
  for (int mi = 0; mi < MI; ++mi) {
    const int lrow = wm * (32 * MI) + mi * 32 + r32;
    float aux = 0.f;
    if constexpr (AMODE == 2) aux = ssq_l[lrow];
    epi(lrow, wn * 64 + 4 * hi, acc[mi][0], acc[mi][1], aux);
  }
}

struct EpiBf16 {
  bf16_t* dst; int ldd; int col0; int m0; int act; float invK;
  __device__ __forceinline__ void operator()(int lrow, int nc, const f32x16& a0, const f32x16& a1, float aux) const { one(lrow, nc, a0, aux); one(lrow, nc + 32, a1, aux); }
  __device__ __forceinline__ void one(int lrow, int nc, const f32x16& a, float aux) const {
    float sc = 1.f;
    if (invK > 0.f) sc = rsqrtf(aux * invK + 1e-6f);
    bf16_t* p = dst + (size_t)(m0 + lrow) * ldd + col0 + nc;
#pragma unroll
    for (int g = 0; g < 4; ++g) {
      float v0 = a[4 * g] * sc, v1 = a[4 * g + 1] * sc, v2 = a[4 * g + 2] * sc, v3 = a[4 * g + 3] * sc;
      if (act) {
        v0 = 1.f - 2.f / (__expf(2.f * v0) + 1.f); v1 = 1.f - 2.f / (__expf(2.f * v1) + 1.f);
        v2 = 1.f - 2.f / (__expf(2.f * v2) + 1.f); v3 = 1.f - 2.f / (__expf(2.f * v3) + 1.f);
      }
      st_bf16x4(p + 8 * g, v0, v1, v2, v3);
    }
  }
};
struct EpiResid {
  const float* xin; float* xout; const float* gvec; int n0;
  __device__ __forceinline__ void operator()(int lrow, int nc, const f32x16& a0, const f32x16& a1, float) const {
    const size_t o = (size_t)lrow * 1024 + n0 + nc;
    f32x4 xv[8], gv[8];
#pragma unroll
    for (int g = 0; g < 4; ++g) {
      xv[g] = *(const f32x4*)(xin + o + 8 * g); xv[4 + g] = *(const f32x4*)(xin + o + 32 + 8 * g);
      gv[g] = *(const f32x4*)(gvec + n0 + nc + 8 * g); gv[4 + g] = *(const f32x4*)(gvec + n0 + nc + 32 + 8 * g);
    }
    f32x4 r[8];
#pragma unroll
    for (int g = 0; g < 4; ++g)
#pragma unroll
      for (int e = 0; e < 4; ++e) { r[g][e] = xv[g][e] + gv[g][e] * a0[4 * g + e]; r[4 + g][e] = xv[4 + g][e] + gv[4 + g][e] * a1[4 * g + e]; }
    asm volatile("" ::: "memory");
#pragma unroll
    for (int g = 0; g < 4; ++g) { *(f32x4*)(xout + o + 8 * g) = r[g]; *(f32x4*)(xout + o + 32 + 8 * g) = r[4 + g]; }
  }
};
struct EpiMlaIn {
  bf16_t *QC, *KVC, *KPE, *G1; const float* rope; int n0; int m0;
  __device__ __forceinline__ void operator()(int lrow, int nc, const f32x16& a0, const f32x16& a1, float) const { one(lrow, nc, a0); one(lrow, nc + 32, a1); }
  __device__ __forceinline__ void one(int lrow, int nc, const f32x16& a) const {
    const int row = m0 + lrow, gc = n0 + nc, g32 = gc & ~31;
    if (g32 == 640) {
      const int t = (m0 % TL) + lrow, hi4 = gc - 640;
      bf16_t* p = KPE + (size_t)row * 32;
      if (t < T) {
        const f32x2* tr = (const f32x2*)rope + (t >> 6) * 8 + hi4;
        const f32x2* tc = (const f32x2*)rope + (t & 63) * 8 + hi4;
        float o1[8], o2[8];
#pragma unroll
        for (int e = 0; e < 4; ++e) {
          const f32x2 cs0 = tr[e], cs1 = tc[e];
          const float x1a = a[e], x2a = a[8 + e];
          const float x1b = a[4 + e], x2b = a[12 + e];
          o1[e] = x1a * cs0[0] - x2a * cs0[1]; o2[e] = x1a * cs0[1] + x2a * cs0[0];
          o1[4 + e] = x1b * cs1[0] - x2b * cs1[1]; o2[4 + e] = x1b * cs1[1] + x2b * cs1[0];
        }
        st_bf16x4(p + hi4, o1[0], o1[1], o1[2], o1[3]);
        st_bf16x4(p + 8 + hi4, o1[4], o1[5], o1[6], o1[7]);
        st_bf16x4(p + 16 + hi4, o2[0], o2[1], o2[2], o2[3]);
        st_bf16x4(p + 24 + hi4, o2[4], o2[5], o2[6], o2[7]);
      } else {
#pragma unroll
        for (int g = 0; g < 4; ++g) st_bf16x4(p + 8 * g + hi4, a[4 * g], a[4 * g + 1], a[4 * g + 2], a[4 * g + 3]);
      }
      return;
    }
    if (g32 > 640 && g32 < 768) return;
    bf16_t* p;
    if (gc < 384) p = QC + (size_t)row * 384 + gc;
    else if (gc < 640) p = KVC + (size_t)row * 256 + (gc - 384);
    else p = G1 + (size_t)row * 1024 + (gc - 768);
#pragma unroll
    for (int g = 0; g < 4; ++g) st_bf16x4(p + 8 * g, a[4 * g], a[4 * g + 1], a[4 * g + 2], a[4 * g + 3]);
  }
};

constexpr float AT_SCALE = 0.10206207261596575f;
constexpr float AT_THR = 8.f;
__device__ void tr_job(const float* src, int ld, int K, int N, bf16_t* dst, const float* kscale, char* lds, float gscale = 1.f) {
  float* tile = (float*)lds;
  const int tid = threadIdx.x, nK = K >> 6, nN = (N + 63) >> 6;
  for (int tIdx = blockIdx.x; tIdx < nK * nN; tIdx += gridDim.x) {
    const int k0 = (tIdx % nK) * 64, n0 = (tIdx / nK) * 64;
#pragma unroll
    for (int i = 0; i < 8; ++i) {
      const int kk = (tid >> 6) + 8 * i, nn = tid & 63;
      float v = 0.f;
      if (n0 + nn < N) { v = src[(size_t)(k0 + kk) * ld + n0 + nn] * gscale; if (kscale) v *= kscale[k0 + kk]; }
      tile[kk * 65 + nn] = v;
    }
    __syncthreads();
#pragma unroll
    for (int i = 0; i < 8; ++i) {
      const int nn = (tid >> 6) + 8 * i, kk = tid & 63;
      if (n0 + nn < N) dst[(size_t)(n0 + nn) * K + k0 + kk] = f2bf(tile[kk * 65 + nn]);
    }
    __syncthreads();
  }
}

__device__ void phase_prologue(const Params& p, char* lds) {
  unsigned char* ws = p.ws;
  bf16_t* WIN0 = (bf16_t*)(ws + OFF_WIN0);
  for (int j = 0; j < 4; ++j) tr_job(p.in[8] + (size_t)j * 1024 * 1024, 1024, 1024, 1024, WIN0 + (size_t)j * 1024 * 1024, nullptr, lds);
  for (int d = 0; d < 2; ++d) {
    tr_job(p.in[10] + (size_t)d * 1024 * 64, 64, 1024, 64, WIN0 + (size_t)(4096 + d * 64) * 1024, nullptr, lds);
    tr_job(p.in[13] + (size_t)d * 1024 * 64, 64, 1024, 64, WIN0 + (size_t)(4224 + d * 64) * 1024, nullptr, lds);
  }
  tr_job(p.in[20], 1024, 1024, 1024, (bf16_t*)(ws + OFF_WOUT0), nullptr, lds);
  bf16_t* WIN1 = (bf16_t*)(ws + OFF_WIN1);
  tr_job(p.in[21], 1696, 1024, 640, WIN1, nullptr, lds);
  tr_job(p.in[21] + 640, 1696, 1024, 32, WIN1 + (size_t)640 * 1024, nullptr, lds);
  tr_job(p.in[21] + 672, 1696, 1024, 1024, WIN1 + (size_t)768 * 1024, nullptr, lds);
  for (int i = blockIdx.x * NTHR + threadIdx.x; i < 96 * 1024; i += gridDim.x * NTHR) WIN1[(size_t)672 * 1024 + i] = 0;
  tr_job(p.in[23], 1536, 384, 1536, (bf16_t*)(ws + OFF_WQB), p.in[22], lds, AT_SCALE * 1.4426950408889634f);
  tr_job(p.in[25], 2048, 256, 2048, (bf16_t*)(ws + OFF_WKVB), p.in[24], lds);
  tr_job(p.in[26], 1024, 1024, 1024, (bf16_t*)(ws + OFF_WOUT1), nullptr, lds);
  {
    const int i = blockIdx.x * NTHR + threadIdx.x;
    if (i < 1024) {
      const float invf[8] = {1.f, 0.316227766016838f, 0.1f, 0.0316227766016838f, 0.01f, 0.00316227766016838f, 0.001f, 0.000316227766016838f};
      const int pos = i >> 3, m = i & 7;
      float inv = invf[0];
#pragma unroll
      for (int q = 1; q < 8; ++q) inv = (m == q) ? invf[q] : inv;
      const float ang = (float)pos * inv;
      const float kf = rintf(ang * 0.15915494309189535f);
      float r = fmaf(-kf, 6.28125f, ang);
      r = fmaf(-kf, 1.9353071795864769e-3f, r);
      float* rt = (float*)(ws + OFF_ROPE);
      rt[2 * i] = cosf(r); rt[2 * i + 1] = sinf(r);
    }
  }
  {
    float* sil = (float*)lds;
    float* red = sil + 9 * 1024;
    const int tid = threadIdx.x;
    for (int i = tid; i < 9 * 1024; i += NTHR) {
      const int bi = i >> 10, k = i & 1023;
      const float cv = bi < 8 ? p.in[1][bi * 1024 + k] : p.in[3][k];
      sil[i] = cv / (1.f + __expf(-cv));
    }
    __syncthreads();
    float* mod = (float*)(ws + OFF_MOD);
    for (int item = blockIdx.x; item < 192; item += gridDim.x) {
      const int l = item / 96, n0 = (item % 96) * 32, col = tid & 31, kg = tid >> 5;
      float acc[9];
#pragma unroll
      for (int bi = 0; bi < 9; ++bi) acc[bi] = 0.f;
      const float* wp = p.in[5] + ((size_t)l * 1024 + kg * 64) * 3072 + n0 + col;
      for (int kk = 0; kk < 64; ++kk) {
        const float w = wp[(size_t)kk * 3072];
#pragma unroll
        for (int bi = 0; bi < 9; ++bi) acc[bi] += sil[bi * 1024 + kg * 64 + kk] * w;
      }
#pragma unroll
      for (int bi = 0; bi < 9; ++bi) red[(kg * 9 + bi) * 32 + col] = acc[bi];
      __syncthreads();
      if (tid < 288) {
        const int bi = tid >> 5;
        float s = 0.f;
#pragma unroll
        for (int g = 0; g < 16; ++g) s += red[(g * 9 + bi) * 32 + col];
        mod[((size_t)l * 9 + bi) * 3072 + n0 + col] = s + p.in[6][l * 3072 + n0 + col];
      }
      __syncthreads();
    }
  }
}

__device__ __forceinline__ const float* row_src(const float* xsrc, const float* csrc, int n, int& bi) {
  const int b = n / TL, t = n - b * TL;
  if (t < T) { bi = b; return xsrc + ((size_t)b * T + t) * D; }
  bi = 8; return csrc + ((size_t)b * L + (t - T)) * D;
}
__device__ void phase_norm(const float* xsrc, const float* csrc, const float* ng, const float* mod, bf16_t* H) {
  const int lane = threadIdx.x & 63, gw = blockIdx.x * 8 + (threadIdx.x >> 6), nw = gridDim.x * 8;
  f32x4 g4[4];
#pragma unroll
  for (int i = 0; i < 4; ++i) g4[i] = *(const f32x4*)(ng + i * 256 + lane * 4);
  f32x4 va[4], vb[4]; int bia = 0, bib = 0;
  if (gw < NTOK) { const float* src = row_src(xsrc, csrc, gw, bia);
#pragma unroll
    for (int i = 0; i < 4; ++i) va[i] = *(const f32x4*)(src + i * 256 + lane * 4); }
  for (int n = gw; n < NTOK; n += nw) {
    if (n + nw < NTOK) { const float* src = row_src(xsrc, csrc, n + nw, bib);
#pragma unroll
      for (int i = 0; i < 4; ++i) vb[i] = *(const f32x4*)(src + i * 256 + lane * 4); }
    float ss = 0.f;
#pragma unroll
    for (int i = 0; i < 4; ++i) ss += va[i][0] * va[i][0] + va[i][1] * va[i][1] + va[i][2] * va[i][2] + va[i][3] * va[i][3];
    ss = wave_sum(ss);
    const float rstd = rsqrtf(ss * (1.f / 1024.f) + 1e-6f);
    const float* m = mod + bia * 3072;
#pragma unroll
    for (int i = 0; i < 4; ++i) {
      const int c = i * 256 + lane * 4;
      const f32x4 sh = *(const f32x4*)(m + c), sc = *(const f32x4*)(m + 1024 + c);
      float o[4];
#pragma unroll
      for (int e = 0; e < 4; ++e) o[e] = va[i][e] * rstd * g4[i][e] * (1.f + sc[e]) + sh[e];
      st_bf16x4(H + (size_t)n * 1024 + c, o[0], o[1], o[2], o[3]);
    }
#pragma unroll
    for (int i = 0; i < 4; ++i) va[i] = vb[i];
    bia = bib;
  }
}

constexpr int LERP3_SPLIT = 63488;
__device__ __forceinline__ bf16_t* lerp_base(const Params& p, int j, int row) {
  if (j == 0) return (bf16_t*)(p.ws + OFF_Y0);
  if (j == 1) return (bf16_t*)(p.ws + OFF_Y1);
  if (j == 2) return (bf16_t*)p.out;
  if (row < LERP3_SPLIT) return (bf16_t*)p.out + (size_t)NTOK * 1024;
  return (bf16_t*)(p.ws + WS_END) - (size_t)LERP3_SPLIT * 1024;
}
struct RowX { f32x4 v[4]; int bi; };
__device__ __forceinline__ void ld_row(const Params& p, int n, int lane, RowX& r) {
  const float* src = row_src(p.in[0], p.in[2], n, r.bi);
#pragma unroll
  for (int i = 0; i < 4; ++i) r.v[i] = *(const f32x4*)(src + i * 256 + lane * 4);
}
__device__ __forceinline__ void fin_row(const float* mod, const f32x4 (&g4)[4], int lane, const RowX& r, float (&h)[16]) {
  float ss = 0.f;
#pragma unroll
  for (int i = 0; i < 4; ++i) ss += r.v[i][0] * r.v[i][0] + r.v[i][1] * r.v[i][1] + r.v[i][2] * r.v[i][2] + r.v[i][3] * r.v[i][3];
  ss = wave_sum(ss);
  const float rstd = rsqrtf(ss * (1.f / 1024.f) + 1e-6f);
  const float* m = mod + r.bi * 3072;
#pragma unroll
  for (int i = 0; i < 4; ++i) {
    const int c = i * 256 + lane * 4;
    const f32x4 sh = *(const f32x4*)(m + c), sc = *(const f32x4*)(m + 1024 + c);
#pragma unroll
    for (int e = 0; e < 4; ++e) {
      const float hv = r.v[i][e] * rstd * g4[i][e] * (1.f + sc[e]) + sh[e];
      h[4 * i + e] = __uint_as_float(cvtpk(hv, 0.f) << 16);
    }
  }
}
__device__ void phase_norm_lerp(const Params& p, const float* mod) {
  const int lane = threadIdx.x & 63, gw = blockIdx.x * 8 + (threadIdx.x >> 6), nw = gridDim.x * 8;
  const int per = (NTOK + nw - 1) / nw;
  const int r0 = gw * per, r1 = (r0 + per < NTOK) ? r0 + per : NTOK;
  if (r0 >= r1) return;
  bf16_t* H = (bf16_t*)(p.ws + OFF_H);
  f32x4 g4[4];
#pragma unroll
  for (int i = 0; i < 4; ++i) g4[i] = *(const f32x4*)(p.in[4] + i * 256 + lane * 4);
  float mu[4][16];
#pragma unroll
  for (int j = 0; j < 4; ++j)
#pragma unroll
    for (int i = 0; i < 4; ++i) {
      const f32x4 m4 = *(const f32x4*)(p.in[7] + j * 1024 + i * 256 + lane * 4);
      mu[j][4 * i] = m4[0]; mu[j][4 * i + 1] = m4[1]; mu[j][4 * i + 2] = m4[2]; mu[j][4 * i + 3] = m4[3];
    }
  float hp[16], hc[16], hn[16];
  RowX xa, xb, xc;
  if (r0 > 0) { ld_row(p, r0 - 1, lane, xc); }
  ld_row(p, r0, lane, xa);
  if (r0 + 1 < NTOK) ld_row(p, r0 + 1, lane, xb);
  if (r0 > 0) fin_row(mod, g4, lane, xc, hp);
  else {
#pragma unroll
    for (int e = 0; e < 16; ++e) hp[e] = 0.f;
  }
  fin_row(mod, g4, lane, xa, hc);
  xa = xb;
  if (r0 + 2 < NTOK) ld_row(p, r0 + 2, lane, xb);
  for (int n = r0; n < r1; ++n) {
    const int t = n % TL;
    if (n + 3 < NTOK) ld_row(p, n + 3, lane, xc);
    if (n + 1 < NTOK) fin_row(mod, g4, lane, xa, hn);
    else {
#pragma unroll
      for (int e = 0; e < 16; ++e) hn[e] = 0.f;
    }
    const float fp = (t != 0 && t != T) ? 0.5f : 0.f, fn = (t != T - 1 && t != TL - 1) ? 0.5f : 0.f;
#pragma unroll
    for (int i = 0; i < 4; ++i) st_bf16x4(H + (size_t)n * 1024 + i * 256 + lane * 4, hc[4 * i], hc[4 * i + 1], hc[4 * i + 2], hc[4 * i + 3]);
#pragma unroll
    for (int j = 0; j < 4; ++j) {
      bf16_t* dst = lerp_base(p, j, n) + (size_t)n * 1024 + lane * 4;
#pragma unroll
      for (int i = 0; i < 4; ++i) {
        float o[4];
#pragma unroll
        for (int e = 0; e < 4; ++e) { const float c = hc[4 * i + e]; o[e] = c + (fp * hp[4 * i + e] + fn * hn[4 * i + e] - c) * mu[j][4 * i + e]; }
        st_bf16x4(dst + i * 256, o[0], o[1], o[2], o[3]);
      }
    }
#pragma unroll
    for (int e = 0; e < 16; ++e) { hp[e] = hc[e]; hc[e] = hn[e]; }
    xa = xb; xb = xc;
  }
}

__device__ void phase_final(float* out, const float* fg) {
  const int lane = threadIdx.x & 63, gw = blockIdx.x * 8 + (threadIdx.x >> 6), nw = gridDim.x * 8;
  f32x4 g4[4];
#pragma unroll
  for (int i = 0; i < 4; ++i) g4[i] = *(const f32x4*)(fg + i * 256 + lane * 4);
  f32x4 va[4], vb[4];
  if (gw < NB * T) {
#pragma unroll
    for (int i = 0; i < 4; ++i) va[i] = *(const f32x4*)(out + (size_t)gw * D + i * 256 + lane * 4); }
  for (int n = gw; n < NB * T; n += nw) {
    if (n + nw < NB * T) {
#pragma unroll
      for (int i = 0; i < 4; ++i) vb[i] = *(const f32x4*)(out + (size_t)(n + nw) * D + i * 256 + lane * 4); }
    float ss = 0.f;
#pragma unroll
    for (int i = 0; i < 4; ++i) ss += va[i][0] * va[i][0] + va[i][1] * va[i][1] + va[i][2] * va[i][2] + va[i][3] * va[i][3];
    ss = wave_sum(ss);
    const float rstd = rsqrtf(ss * (1.f / 1024.f) + 1e-6f);
#pragma unroll
    for (int i = 0; i < 4; ++i) {
      f32x4 o;
#pragma unroll
      for (int e = 0; e < 4; ++e) o[e] = va[i][e] * rstd * g4[i][e];
      *(f32x4*)(out + (size_t)n * D + i * 256 + lane * 4) = o;
    }
#pragma unroll
    for (int i = 0; i < 4; ++i) va[i] = vb[i];
  }
}

__device__ __forceinline__ int scan_row(int g, int d, int b) {
  if (g < L) { const int tt = d ? (L - 1 - g) : g; return b * TL + T + tt; }
  g -= L; const int tt = d ? (T - 1 - g) : g; return b * TL + tt;
}
constexpr int SC_WD = 0, SC_AR = 8192, SC_BK = SC_AR + 33 * 256, SC_VV = SC_BK + 32768, SC_BUF = SC_VV + 8192;
constexpr int SC_IC = 2 * SC_BUF, SC_YB = SC_IC + 8192, SC_DUMP = SC_YB + 2 * 33 * 256, SC_END = SC_DUMP + 256;
#define MFMA16(a, b, c) __builtin_amdgcn_mfma_f32_16x16x32_bf16((a), (b), (c), 0, 0, 0)
struct ScCoef { u32x4 a0, a1; f32x4 w0, w1, w2, w3; u32x4 k0, k1, k2, k3; float vi; };
__device__ __forceinline__ ScCoef sc_ld(const char* buf, int t, int arOff, int wOff, int bkOff, int vOff) {
  ScCoef c;
  const char* ar = buf + SC_AR + t * 256 + arOff;
  c.a0 = *(const u32x4*)(ar); c.a1 = *(const u32x4*)(ar + 64);
  const char* wd = buf + SC_WD + t * 256 + wOff;
  c.w0 = *(const f32x4*)(wd); c.w1 = *(const f32x4*)(wd + 64); c.w2 = *(const f32x4*)(wd + 128); c.w3 = *(const f32x4*)(wd + 192);
  const char* bk = buf + SC_BK + t * 1024 + bkOff;
  c.k0 = *(const u32x4*)(bk); c.k1 = *(const u32x4*)(bk + 256); c.k2 = *(const u32x4*)(bk + 512); c.k3 = *(const u32x4*)(bk + 768);
  c.vi = *(const float*)(buf + SC_VV + t * 256 + vOff);
  return c;
}
__device__ void phase_scan(const Params& p, char* lds) {
  unsigned char* ws = p.ws;
  const int tid = threadIdx.x, lane = tid & 63, wid = __builtin_amdgcn_readfirstlane(tid >> 6), r32 = lane & 31, hi = lane >> 5;
  const bf16_t* Rg = (const bf16_t*)(ws + OFF_R); const bf16_t* Kg = (const bf16_t*)(ws + OFF_K); const bf16_t* Vg = (const bf16_t*)(ws + OFF_V);
  const bf16_t* Lg = (const bf16_t*)(ws + OFF_LORA);
  constexpr int NCH = TL / 32;
  for (int sidx = blockIdx.x; sidx < 256; sidx += gridDim.x) {
    const int d = sidx >> 7, b = (sidx >> 4) & 7, h = sidx & 15;
    bf16_t* Yg = (bf16_t*)(ws + (d ? OFF_Y1 : OFF_Y0));
    if (wid < 4) {
      const int cw = wid, c16 = lane & 15, q = lane >> 4;
      const int arOff = (c16 & 1) * 128 + q * 16, wOff = q * 16, bkOff = c16 * 16, vOff = (cw * 16 + c16) * 4;
      f32x4 St0 = {0.f, 0.f, 0.f, 0.f}, St1 = St0, St2 = St0, St3 = St0;
      __syncthreads();
      __syncthreads();
      for (int c = 0; c < NCH; ++c) {
        const char* buf = lds + (c & 1) * SC_BUF;
        char* yb = (q == 0) ? (lds + SC_YB + (c & 1) * (33 * 256) + (cw * 16 + c16) * 4) : (lds + SC_DUMP + lane * 4);
        const int ystride = (q == 0) ? 256 : 0;
        ScCoef cur = sc_ld(buf, 0, arOff, wOff, bkOff, vOff);
#pragma unroll 1
        for (int half = 0; half < 2; ++half) {
#pragma unroll 4
          for (int tt = 0; tt < 16; ++tt) {
            const int t = half * 16 + tt;
            const ScCoef nxt = sc_ld(buf, t + 1, arOff, wOff, bkOff, vOff);
            u32x4 b1 = {cvtpk(St0[0], St0[1]), cvtpk(St0[2], St0[3]), cvtpk(St1[0], St1[1]), cvtpk(St1[2], St1[3])};
            u32x4 b2 = {cvtpk(St2[0], St2[1]), cvtpk(St2[2], St2[3]), cvtpk(St3[0], St3[1]), cvtpk(St3[2], St3[3])};
            f32x4 out = {0.f, 0.f, 0.f, 0.f};
            out = MFMA16(*(bf16x8*)&cur.a0, *(bf16x8*)&b1, out);
            out = MFMA16(*(bf16x8*)&cur.a1, *(bf16x8*)&b2, out);
            St0 *= cur.w0; St1 *= cur.w1; St2 *= cur.w2; St3 *= cur.w3;
            u32x4 bu = {q == 0 ? cvtpk(out[0], cur.vi) : 0u, 0u, 0u, 0u};
            St0 = MFMA16(*(bf16x8*)&cur.k0, *(bf16x8*)&bu, St0);
            St1 = MFMA16(*(bf16x8*)&cur.k1, *(bf16x8*)&bu, St1);
            St2 = MFMA16(*(bf16x8*)&cur.k2, *(bf16x8*)&bu, St2);
            St3 = MFMA16(*(bf16x8*)&cur.k3, *(bf16x8*)&bu, St3);
            *(float*)(yb + t * ystride) = out[1];
            cur = nxt;
          }
          if (half == 1) {
            u32x4 b1 = {cvtpk(St0[0], St0[1]), cvtpk(St0[2], St0[3]), cvtpk(St1[0], St1[1]), cvtpk(St1[2], St1[3])};
            u32x4 b2 = {cvtpk(St2[0], St2[1]), cvtpk(St2[2], St2[3]), cvtpk(St3[0], St3[1]), cvtpk(St3[2], St3[3])};
            f32x4 out = {0.f, 0.f, 0.f, 0.f};
            out = MFMA16(*(bf16x8*)&cur.a0, *(bf16x8*)&b1, out);
            out = MFMA16(*(bf16x8*)&cur.a1, *(bf16x8*)&b2, out);
            *(float*)(yb + 32 * ystride) = out[1];
          }
          __syncthreads();
        }
      }
    } else {
      const int pw = wid - 4, ptid = tid - 256;
      const int pstep = ptid >> 3, j0 = (ptid & 7) * 8;
      const int apos0 = (j0 >> 5) * 32 + (((j0 & 31) & 15) >> 2) * 8 + 4 * ((j0 & 31) >> 4), apos1 = apos0 + 8;
      float* Bg = (float*)(ws + OFF_BONUS) + (size_t)d * NTOK * 16;
      float kkc[8], kac[8], rkc[8];
#pragma unroll
      for (int e = 0; e < 8; ++e) { kkc[e] = p.in[15][h * 64 + j0 + e]; kac[e] = p.in[16][h * 64 + j0 + e]; rkc[e] = p.in[17][h * 64 + j0 + e]; }
      const int mat = pw >> 1, jh = pw & 1;
      bf16x8 w2f[4]; float bias;
      {
        const float* W2 = (mat ? p.in[14] : p.in[11]) + (size_t)d * 64 * 1024;
#pragma unroll
        for (int ks = 0; ks < 4; ++ks) {
          u32x4 w;
#pragma unroll
          for (int qq = 0; qq < 4; ++qq) {
            const int r0 = ks * 16 + 8 * hi + 2 * qq;
            w[qq] = cvtpk(W2[(size_t)r0 * 1024 + h * 64 + jh * 32 + r32], W2[(size_t)(r0 + 1) * 1024 + h * 64 + jh * 32 + r32]);
          }
          w2f[ks] = *(bf16x8*)&w;
        }
        bias = (mat ? p.in[12] : p.in[9])[d * 1024 + h * 64 + jh * 32 + r32];
      }
      u32x4 pR, pK, pV; bf16x8 pl[4];
      float kk[8], kr[8], rr[8];
      float* IC = (float*)(lds + SC_IC);
      auto prefetch = [&](int c) {
        const size_t row = (size_t)scan_row(c * 32 + pstep, d, b) * 1024 + h * 64 + j0;
        pR = *(const u32x4*)(Rg + row); pK = *(const u32x4*)(Kg + row); pV = *(const u32x4*)(Vg + row);
        const size_t lrow = (size_t)scan_row(c * 32 + r32, d, b);
#pragma unroll
        for (int ks = 0; ks < 4; ++ks) pl[ks] = *(const bf16x8*)(Lg + lrow * 256 + mat * 128 + d * 64 + ks * 16 + hi * 8);
      };
      auto stageA = [&](int c) {
        char* buf = lds + (c & 1) * SC_BUF;
        float* Wd = (float*)(buf + SC_WD); float* Vv = (float*)(buf + SC_VV); bf16_t* AR = (bf16_t*)(buf + SC_AR);
        f32x16 acc;
#pragma unroll
        for (int r = 0; r < 16; ++r) acc[r] = 0.f;
#pragma unroll
        for (int ks = 0; ks < 4; ++ks) acc = MFMA(pl[ks], w2f[ks], acc);
#pragma unroll
        for (int r = 0; r < 16; ++r) {
          const int step = crow(r, hi), j = jh * 32 + r32;
          const float sg = __builtin_amdgcn_rcpf(1.f + __expf(-(acc[r] + bias)));
          if (mat == 0) Wd[step * 64 + j] = __expf(-0.6065306597126334f * sg); else IC[step * 64 + j] = sg;
        }
        { u32x2 lo = {pR[0], pR[1]}, hi2 = {pR[2], pR[3]};
          *(u32x2*)(AR + (pstep + 1) * 128 + 64 + apos0) = lo; *(u32x2*)(AR + (pstep + 1) * 128 + 64 + apos1) = hi2; }
        float ss = 0.f;
#pragma unroll
        for (int w = 0; w < 4; ++w) {
          rr[2 * w] = lo16(pR[w]); rr[2 * w + 1] = hi16(pR[w]);
          kr[2 * w] = lo16(pK[w]); kr[2 * w + 1] = hi16(pK[w]);
        }
        f32x4 v0 = {lo16(pV[0]), hi16(pV[0]), lo16(pV[1]), hi16(pV[1])}, v1 = {lo16(pV[2]), hi16(pV[2]), lo16(pV[3]), hi16(pV[3])};
        *(f32x4*)(Vv + pstep * 64 + j0) = v0; *(f32x4*)(Vv + pstep * 64 + j0 + 4) = v1;
#pragma unroll
        for (int e = 0; e < 8; ++e) { kk[e] = kr[e] * kkc[e]; ss += kk[e] * kk[e]; }
        ss = red8(ss);
        const float inv = rsqrtf(fmaxf(ss, 1e-24f));
#pragma unroll
        for (int e = 0; e < 8; ++e) kk[e] *= inv;
      };
      auto stageB = [&](int c) {
        char* buf = lds + (c & 1) * SC_BUF;
        u32x4* BK = (u32x4*)(buf + SC_BK); bf16_t* AR = (bf16_t*)(buf + SC_AR);
        const f32x4 i0 = *(const f32x4*)(IC + pstep * 64 + j0), i1 = *(const f32x4*)(IC + pstep * 64 + j0 + 4);
        const float ic[8] = {i0[0], i0[1], i0[2], i0[3], i1[0], i1[1], i1[2], i1[3]};
        { u32x2 lo = {cvtpk(-kk[0], -kk[1]), cvtpk(-kk[2], -kk[3])}, hi2 = {cvtpk(-kk[4], -kk[5]), cvtpk(-kk[6], -kk[7])};
          *(u32x2*)(AR + pstep * 128 + apos0) = lo; *(u32x2*)(AR + pstep * 128 + apos1) = hi2; }
        float bs = 0.f;
#pragma unroll
        for (int e = 0; e < 8; ++e) {
          const float kd = kr[e] * (1.f + (ic[e] - 1.f) * kac[e]);
          u32x4 slot = {cvtpk(kk[e] * ic[e], kd), 0u, 0u, 0u};
          BK[pstep * 64 + j0 + e] = slot;
          bs += rr[e] * kd * rkc[e];
        }
        bs = red8(bs);
        if ((ptid & 7) == 0) Bg[(size_t)scan_row(c * 32 + pstep, d, b) * 16 + h] = bs;
      };
      auto writeout = [&](int c) {
        const float* Yb = (const float*)(lds + SC_YB + (c & 1) * (33 * 256)) + (pstep + 1) * 64 + j0;
        const f32x4 y0 = *(const f32x4*)(Yb), y1 = *(const f32x4*)(Yb + 4);
        u32x4 w = {cvtpk(y0[0], y0[1]), cvtpk(y0[2], y0[3]), cvtpk(y1[0], y1[1]), cvtpk(y1[2], y1[3])};
        *(u32x4*)(Yg + (size_t)scan_row(c * 32 + pstep, d, b) * 1024 + h * 64 + j0) = w;
      };
      prefetch(0);
      stageA(0);
      __syncthreads();
      stageB(0);
      prefetch(1);
      __syncthreads();
      for (int c = 0; c < NCH; ++c) {
        if (c >= 1) writeout(c - 1);
        if (c + 1 < NCH) stageA(c + 1);
        __syncthreads();
        if (c + 1 < NCH) { stageB(c + 1); if (c + 2 < NCH) prefetch(c + 2); }
        __syncthreads();
      }
      writeout(NCH - 1);
    }
    __syncthreads();
  }
}

__device__ void phase_readout(const Params& p) {
  unsigned char* ws = p.ws;
  const bf16_t* Y0 = (const bf16_t*)(ws + OFF_Y0); const bf16_t* Y1 = (const bf16_t*)(ws + OFF_Y1); const bf16_t* Vg = (const bf16_t*)(ws + OFF_V);
  bf16_t* G = (bf16_t*)(ws + OFF_G);
  const float* B0 = (const float*)(ws + OFF_BONUS); const float* B1 = B0 + (size_t)NTOK * 16;
  const int lane = threadIdx.x & 63, gw = blockIdx.x * 8 + (threadIdx.x >> 6), nw = gridDim.x * 8;
  const int c0 = lane * 16, hd = lane >> 2;
  float lg[16], lb[16];
#pragma unroll
  for (int e = 0; e < 16; ++e) { lg[e] = p.in[18][c0 + e]; lb[e] = p.in[19][c0 + e]; }
  for (int n = gw; n < NTOK; n += nw) {
    const size_t o = (size_t)n * 1024 + c0;
    float y[16], v[16], g[16];
#pragma unroll
    for (int q = 0; q < 2; ++q) {
      const u32x4 a = *(const u32x4*)(Y0 + o + 8 * q), bq = *(const u32x4*)(Y1 + o + 8 * q), vv = *(const u32x4*)(Vg + o + 8 * q), gg = *(const u32x4*)(G + o + 8 * q);
#pragma unroll
      for (int w = 0; w < 4; ++w) {
        y[8 * q + 2 * w] = lo16(a[w]) + lo16(bq[w]); y[8 * q + 2 * w + 1] = hi16(a[w]) + hi16(bq[w]);
        v[8 * q + 2 * w] = lo16(vv[w]); v[8 * q + 2 * w + 1] = hi16(vv[w]);
        g[8 * q + 2 * w] = lo16(gg[w]); g[8 * q + 2 * w + 1] = hi16(gg[w]);
      }
    }
    float s = 0.f;
#pragma unroll
    for (int e = 0; e < 16; ++e) s += y[e];
    s += dpp_f(s, 0); s += dpp_f(s, 1);
    const float mean = s * (1.f / 64.f);
    float q2 = 0.f;
#pragma unroll
    for (int e = 0; e < 16; ++e) { const float dlt = y[e] - mean; q2 += dlt * dlt; }
    q2 += dpp_f(q2, 0); q2 += dpp_f(q2, 1);
    const float rs = rsqrtf(q2 * (1.f / 64.f) + 64e-5f);
    const float bonus = B0[(size_t)n * 16 + hd] + B1[(size_t)n * 16 + hd];
    float r[16];
#pragma unroll
    for (int e = 0; e < 16; ++e) {
      const float yn = (y[e] - mean) * rs * lg[e] + lb[e];
      r[e] = (yn + bonus * v[e]) * (g[e] * sigmoidf_(g[e]));
    }
    u32x4 w0 = {cvtpk(r[0], r[1]), cvtpk(r[2], r[3]), cvtpk(r[4], r[5]), cvtpk(r[6], r[7])};
    u32x4 w1 = {cvtpk(r[8], r[9]), cvtpk(r[10], r[11]), cvtpk(r[12], r[13]), cvtpk(r[14], r[15])};
    *(u32x4*)(G + o) = w0; *(u32x4*)(G + o + 8) = w1;
  }
}

constexpr int AT_SHMV = 16384, AT_KROW = 208, AT_SHMK = 64 * AT_KROW;
constexpr int AT_KOFF = 2 * AT_SHMV, AT_WOFF = AT_KOFF + 2 * AT_SHMK;
#define SBAR() __builtin_amdgcn_sched_barrier(0)
__device__ __forceinline__ void at_partialSM(f32x16& p0, f32x16& p1, float& m_reg, float& alpha, bool force) {
  float pm = p0[0];
#pragma unroll
  for (int r = 1; r < 16; ++r) pm = fmaxf(pm, p0[r]);
#pragma unroll
  for (int r = 0; r < 16; ++r) pm = fmaxf(pm, p1[r]);
  { auto rr = __builtin_amdgcn_permlane32_swap(__float_as_uint(pm), __float_as_uint(pm), false, false);
    pm = fmaxf(__uint_as_float(rr[0]), __uint_as_float(rr[1])); }
  if (__builtin_expect(!force && __all(pm <= AT_THR * 1.4426950408889634f), 1)) { alpha = 1.f; }
  else {
    const float dlt = force ? pm : fmaxf(pm, 0.f);
    alpha = force ? 1.f : __builtin_amdgcn_exp2f(-dlt); m_reg += dlt;
#pragma unroll
    for (int r = 0; r < 16; ++r) { p0[r] -= dlt; p1[r] -= dlt; }
  }
#pragma unroll
  for (int r = 0; r < 16; ++r) p0[r] = __builtin_amdgcn_exp2f(p0[r]);
}
__device__ __forceinline__ void at_finishSM(f32x16& p0, f32x16& p1, float alpha, float& l_reg, bf16x8& pa0, bf16x8& pa1, bf16x8& pa2, bf16x8& pa3) {
#pragma unroll
  for (int r = 0; r < 16; ++r) p1[r] = __builtin_amdgcn_exp2f(p1[r]);
  float ps = 0;
#pragma unroll
  for (int r = 0; r < 16; ++r) ps += p0[r];
#pragma unroll
  for (int r = 0; r < 16; ++r) ps += p1[r];
  { auto rr = __builtin_amdgcn_permlane32_swap(__float_as_uint(ps), __float_as_uint(ps), false, false);
    ps = __uint_as_float(rr[0]) + __uint_as_float(rr[1]); }
  l_reg = l_reg * alpha + ps;
#define PK4(P, BASE, OUT) do { unsigned a0 = cvtpk(P[BASE + 0], P[BASE + 1]), a1 = cvtpk(P[BASE + 2], P[BASE + 3]);   \
    unsigned b0 = cvtpk(P[BASE + 4], P[BASE + 5]), b1 = cvtpk(P[BASE + 6], P[BASE + 7]);                              \
    auto r0 = __builtin_amdgcn_permlane32_swap(a0, b0, false, false); auto r1 = __builtin_amdgcn_permlane32_swap(a1, b1, false, false); \
    u32x4 w = {r0[0], r1[0], r0[1], r1[1]}; OUT = *reinterpret_cast<bf16x8*>(&w); } while (0)
  PK4(p0, 0, pa0); PK4(p0, 8, pa1); PK4(p1, 0, pa2); PK4(p1, 8, pa3);
#undef PK4
}
__device__ __forceinline__ void at_qkt(f32x16& p0, f32x16& p1, const char* Ks, const bf16x8* qr, int r32, int hi, float negm) {
#pragma unroll
  for (int r = 0; r < 16; ++r) { p0[r] = negm; p1[r] = negm; }
#pragma unroll
  for (int d0 = 0; d0 < 6; ++d0) {
    const bf16x8 b0 = *(const bf16x8*)(Ks + r32 * AT_KROW + d0 * 32 + hi * 16);
    const bf16x8 b1 = *(const bf16x8*)(Ks + (32 + r32) * AT_KROW + d0 * 32 + hi * 16);
    p0 = MFMA(b0, qr[d0], p0);
    p1 = MFMA(b1, qr[d0], p1);
  }
}
__device__ __forceinline__ int v_st(int k, int c) { const int kk = (k & ~0xC) | ((k & 4) << 1) | ((k & 8) >> 1); return ((kk >> 3) * 4 + (c >> 5)) * 512 + ((kk & 7) * 32 + (c & 31)) * 2; }
__device__ __forceinline__ int v_rd_base(int lane) { return ((lane & 3) << 3) | (((lane >> 2) & 3) << 6) | (((lane >> 4) & 1) << 5) | (((lane >> 5) & 1) << 8); }
constexpr int v_rd_off(int d0, int ks, int half) { return d0 * 512 + ks * 4096 + half * 2048; }
template <int OFF> __device__ __forceinline__ s16x4 tr_read(int vb) {
  s16x4 r; asm volatile("ds_read_b64_tr_b16 %0, %1 offset:%2" : "=&v"(r) : "v"(vb), "i"(OFF) : "memory"); return r;
}
template <int D0> __device__ __forceinline__ void pv_one(f32x16& od, int vb, bf16x8 pa0, bf16x8 pa1, bf16x8 pa2, bf16x8 pa3) {
  const s16x4 l0 = tr_read<v_rd_off(D0, 0, 0)>(vb), h0 = tr_read<v_rd_off(D0, 0, 1)>(vb), l1 = tr_read<v_rd_off(D0, 1, 0)>(vb), h1 = tr_read<v_rd_off(D0, 1, 1)>(vb);
  const s16x4 l2 = tr_read<v_rd_off(D0, 2, 0)>(vb), h2 = tr_read<v_rd_off(D0, 2, 1)>(vb), l3 = tr_read<v_rd_off(D0, 3, 0)>(vb), h3 = tr_read<v_rd_off(D0, 3, 1)>(vb);
  asm volatile("s_waitcnt lgkmcnt(0)" ::: "memory"); SBAR();
#define PK(Lx, Hx) (bf16x8){Lx[0], Lx[1], Lx[2], Lx[3], Hx[0], Hx[1], Hx[2], Hx[3]}
  od = MFMA(pa0, PK(l0, h0), od);
  od = MFMA(pa1, PK(l1, h1), od);
  od = MFMA(pa2, PK(l2, h2), od);
  od = MFMA(pa3, PK(l3, h3), od);
#undef PK
}
__device__ __forceinline__ void pv_d0(f32x16* o, int vb, bf16x8 pa0, bf16x8 pa1, bf16x8 pa2, bf16x8 pa3) {
  pv_one<0>(o[0], vb, pa0, pa1, pa2, pa3); pv_one<1>(o[1], vb, pa0, pa1, pa2, pa3);
}

__device__ void phase_attn(const Params& p, char* lds) {
  unsigned char* ws = p.ws;
  const bf16_t* Qg = (const bf16_t*)(ws + OFF_Q); const bf16_t* KVg = (const bf16_t*)(ws + OFF_KV); const bf16_t* KPg = (const bf16_t*)(ws + OFF_KPE);
  bf16_t* G1 = (bf16_t*)(ws + OFF_G1);
  const f32x2* rope = (const f32x2*)(ws + OFF_ROPE);
  const int tid = threadIdx.x, wid = tid >> 6, lane = tid & 63, r32 = lane & 31, hi = lane >> 5;
  char* V_lds = lds; char* K_lds = lds + AT_KOFF;
  float* wsl = (float*)(lds + AT_WOFF) + wid * 64; float* li_l = wsl; float* al_l = wsl + 32;
  const int skey = tid >> 3, sc8 = (tid & 7) * 8;
  const int pkey = (tid & 255) >> 2, pc8 = (tid & 3) * 8;
  const int vst = v_st(skey, sc8), kst = skey * AT_KROW + sc8 * 2, pst = pkey * AT_KROW + (64 + pc8) * 2;
  const int vb0 = (int)(uintptr_t)V_lds + v_rd_base(lane);
  const int nitems = NB * 16 * 32;
  const int xcd = blockIdx.x & 7, slot = blockIdx.x >> 3, per = gridDim.x >> 3;
  for (int it = slot; it < nitems / 8; it += per) {
    const int pair = (it >> 5) * 8 + xcd, qblk = it & 31;
    const int b = pair >> 4, h = pair & 15;
    const size_t row0 = (size_t)b * TL;
    const size_t qrow = row0 + qblk * 256 + wid * 32 + r32;
    const bf16_t* Kh = KVg + row0 * 2048 + h * 128;
    const bf16_t* Kp = KPg + row0 * 32;
    float m_reg = 0.f, l_reg = 0.f;
    f32x16 o[2];
#pragma unroll
    for (int dd = 0; dd < 2; ++dd)
#pragma unroll
      for (int r = 0; r < 16; ++r) o[dd][r] = 0.f;
    bf16x8 qr[6];
    {
      const bf16_t* Qw = Qg + qrow * 1536 + h * 96 + hi * 8;
#pragma unroll
      for (int d0 = 0; d0 < 6; ++d0) qr[d0] = *(const bf16x8*)(Qw + d0 * 16);
      const int t = qblk * 256 + wid * 32 + r32;
      const f32x2* tb = rope + (hi ? (t & 63) : (t >> 6)) * 8;
      const u32x4 x1 = *(const u32x4*)&qr[4], x2 = *(const u32x4*)&qr[5];
      u32x4 n1, n2;
#pragma unroll
      for (int q = 0; q < 4; ++q) {
        const f32x2 csA = tb[2 * q], csB = tb[2 * q + 1];
        const float a0 = lo16(x1[q]), a1 = hi16(x1[q]), b0 = lo16(x2[q]), b1 = hi16(x2[q]);
        n1[q] = cvtpk(a0 * csA[0] - b0 * csA[1], a1 * csB[0] - b1 * csB[1]);
        n2[q] = cvtpk(a0 * csA[1] + b0 * csA[0], a1 * csB[1] + b1 * csB[0]);
      }
      qr[4] = *(bf16x8*)&n1; qr[5] = *(bf16x8*)&n2;
    }
    struct { bf16x8 vs, ks, ps; } sr_[2];
#define SLOAD(i, k0) do { sr_[i].vs = *(const bf16x8*)(Kh + (size_t)((k0) + skey) * 2048 + 64 + sc8); \
    sr_[i].ks = *(const bf16x8*)(Kh + (size_t)((k0) + skey) * 2048 + sc8); \
    sr_[i].ps = *(const bf16x8*)(Kp + (size_t)((k0) + pkey) * 32 + pc8); } while (0)
#define SWRITE(bb, i) do { *(bf16x8*)(V_lds + (bb) * AT_SHMV + vst) = sr_[i].vs; \
    *(bf16x8*)(K_lds + (bb) * AT_SHMK + kst) = sr_[i].ks; \
    *(bf16x8*)(K_lds + (bb) * AT_SHMK + pst) = sr_[i].ps; } while (0)
#define SWAIT() asm volatile("s_waitcnt vmcnt(3)" ::: "memory")
#define RESC(a) do { if (__any((a) < 1.f)) { if (hi == 0) al_l[r32] = (a); asm volatile("s_waitcnt lgkmcnt(0)" ::: "memory"); \
    _Pragma("unroll") for (int dd = 0; dd < 2; ++dd) _Pragma("unroll") for (int r = 0; r < 16; ++r) o[dd][r] *= al_l[crow(r, hi)]; } } while (0)
    f32x16 pA0, pA1, pB0, pB1; float alA, alB; bf16x8 pa0, pa1, pa2, pa3;
    constexpr int NT = TL / 64;
    SLOAD(0, 0); asm volatile("s_waitcnt vmcnt(0)" ::: "memory"); SWRITE(0, 0); __syncthreads();
    at_qkt(pA0, pA1, K_lds, qr, r32, hi, 0.f); at_partialSM(pA0, pA1, m_reg, alA, true);
    SLOAD(1, 64); SLOAD(0, 128);
    SWAIT(); SWRITE(1, 1); __syncthreads();
    for (int j = 1; j + 1 < NT; j += 2) {
      SBAR(); at_qkt(pB0, pB1, K_lds + AT_SHMK, qr, r32, hi, -m_reg);
      at_finishSM(pA0, pA1, alA, l_reg, pa0, pa1, pa2, pa3); SBAR();
      SLOAD(1, (j + 2) * 64); SBAR();
      pv_d0(o, vb0, pa0, pa1, pa2, pa3); at_partialSM(pB0, pB1, m_reg, alB, false);
      __syncthreads(); SWAIT(); SWRITE(0, 0);
      RESC(alB); __syncthreads();
      SBAR(); at_qkt(pA0, pA1, K_lds, qr, r32, hi, -m_reg);
      at_finishSM(pB0, pB1, alB, l_reg, pa0, pa1, pa2, pa3); SBAR();
      if (j + 3 < NT) SLOAD(0, (j + 3) * 64); SBAR();
      pv_d0(o, vb0 + AT_SHMV, pa0, pa1, pa2, pa3); at_partialSM(pA0, pA1, m_reg, alA, false);
      __syncthreads(); SWAIT(); SWRITE(1, 1);
      RESC(alA); __syncthreads();
    }
    SBAR(); at_qkt(pB0, pB1, K_lds + AT_SHMK, qr, r32, hi, -m_reg);
    at_finishSM(pA0, pA1, alA, l_reg, pa0, pa1, pa2, pa3); SBAR();
    pv_d0(o, vb0, pa0, pa1, pa2, pa3); at_partialSM(pB0, pB1, m_reg, alB, false);
    __syncthreads(); RESC(alB);
    at_finishSM(pB0, pB1, alB, l_reg, pa0, pa1, pa2, pa3); SBAR();
    pv_d0(o, vb0 + AT_SHMV, pa0, pa1, pa2, pa3);
    if (hi == 0) li_l[r32] = l_reg;
    asm volatile("s_waitcnt lgkmcnt(0)" ::: "memory");
    float rli[16];
#pragma unroll
    for (int r = 0; r < 16; ++r) rli[r] = __builtin_amdgcn_rcpf(li_l[crow(r, hi)]);
    bf16_t* Gw = G1 + (row0 + qblk * 256 + wid * 32) * 1024 + h * 64 + r32;
    bf16_t gin[32];
#pragma unroll
    for (int r = 0; r < 16; ++r) { gin[2 * r] = Gw[(size_t)crow(r, hi) * 1024]; gin[2 * r + 1] = Gw[(size_t)crow(r, hi) * 1024 + 32]; }
    asm volatile("" ::: "memory");
#pragma unroll
    for (int r = 0; r < 16; ++r) {
      const int orow = crow(r, hi);
#pragma unroll
      for (int d0 = 0; d0 < 2; ++d0) {
        const float gt = bf2f(gin[2 * r + d0]);
        Gw[(size_t)orow * 1024 + d0 * 32] = f2bf(o[d0][r] * rli[r] * gt * sigmoidf_(gt));
      }
    }
    __syncthreads();
#undef SLOAD
#undef SWRITE
#undef SWAIT
#undef RESC
  }
}

struct XcdWalk {
  int start, count, step, idx;
  __device__ __forceinline__ void init(int ntiles) {
    const int x = blockIdx.x & 7, base = ntiles >> 3, rem = ntiles & 7;
    count = base + (x < rem ? 1 : 0); start = x * base + (x < rem ? x : rem); step = gridDim.x >> 3; idx = blockIdx.x >> 3;
  }
  __device__ __forceinline__ bool next(int& o) { if (idx >= count) return false; o = start + idx; idx += step; return true; }
};
__device__ __forceinline__ void tile_mn(int o, int NT, int& mt, int& nt) { const int g = o >> 3; mt = (g / NT) * 8 + (o & 7); nt = g % NT; }

__global__ __launch_bounds__(NTHR, 1) void fwd_megakernel(Params p) {
  extern __shared__ __attribute__((aligned(16))) char lds[];
  cg::grid_group grid = cg::this_grid();
  unsigned char* ws = p.ws;
  bf16_t* H = (bf16_t*)(ws + OFF_H);
  float* mod = (float*)(ws + OFF_MOD);
  float* CTX1 = (float*)(ws + OFF_CTX1);

  phase_prologue(p, lds);
  grid.sync();
  phase_norm_lerp(p, mod);
  grid.sync();
  {
    const bf16_t* WIN0 = (const bf16_t*)(ws + OFF_WIN0);
    const int nbig = 264 * 16;
    XcdWalk wk; wk.init(nbig); int o;
    while (wk.next(o)) {
      EpiBf16 e; e.invK = 0.f;
      {
        int mt, jn; tile_mn(o, 16, mt, jn);
        const int j = jn >> 2, n4 = jn & 3, m0 = mt * 256;
        e.dst = (bf16_t*)(ws + OFF_R + (size_t)j * U); e.ldd = 1024; e.col0 = n4 * 256; e.act = 0; e.m0 = m0;
        gemm_tile<0, 256>(lerp_base(p, j, m0), 1024, WIN0 + (size_t)(j * 1024 + n4 * 256) * 1024, 1024, m0, nullptr, lds, e);
      }
    }
    wk.init(264 * 2);
    while (wk.next(o)) {
      EpiBf16 e; e.invK = 0.f;
      {
        int mt, n2; tile_mn(o, 2, mt, n2);
        const int nt = 32 + n2, m0 = mt * 256;
        e.dst = (bf16_t*)(ws + OFF_LORA); e.ldd = 256; e.col0 = (nt - 32) * 128; e.act = (nt == 32) ? 1 : 0; e.m0 = m0;
        gemm_tile<1, 128>(H, 1024, WIN0 + (size_t)nt * 128 * 1024, 1024, m0, p.in[7] + (nt - 28) * 1024, lds, e);
      }
    }
  }
  grid.sync();
  phase_scan(p, lds);
  grid.sync();
  phase_readout(p);
  grid.sync();
  {
    const bf16_t* A = (const bf16_t*)(ws + OFF_G); const bf16_t* W = (const bf16_t*)(ws + OFF_WOUT0);
    XcdWalk wk; wk.init(264 * 4); int o;
    while (wk.next(o)) {
      int mt, nt; tile_mn(o, 4, mt, nt);
      const int m0 = mt * 256;
      const int b = m0 / TL, t0 = m0 - b * TL;
      EpiResid e;
      if (t0 < T) { const size_t orow = (size_t)b * T + t0; e.xin = p.in[0] + orow * 1024; e.xout = p.out + orow * 1024; e.gvec = mod + (size_t)b * 3072 + 2048; }
      else { const size_t orow = (size_t)b * L + (t0 - T); e.xin = p.in[2] + orow * 1024; e.xout = CTX1 + orow * 1024; e.gvec = mod + (size_t)8 * 3072 + 2048; }
      e.n0 = nt * 256;
      gemm_tile<0, 256>(A, 1024, W + (size_t)nt * 256 * 1024, 1024, m0, nullptr, lds, e);
    }
  }
  grid.sync();
  phase_norm(p.out, CTX1, p.in[4] + 1024, mod + 9 * 3072, H);
  grid.sync();
  {
    const bf16_t* W = (const bf16_t*)(ws + OFF_WIN1);
    XcdWalk wk; wk.init(264 * 7); int o;
    while (wk.next(o)) {
      int mt, nt; tile_mn(o, 7, mt, nt);
      const int m0 = mt * 256;
      EpiMlaIn e; e.QC = (bf16_t*)(ws + OFF_QC); e.KVC = (bf16_t*)(ws + OFF_KVC); e.KPE = (bf16_t*)(ws + OFF_KPE); e.G1 = (bf16_t*)(ws + OFF_G1);
      e.rope = (const float*)(ws + OFF_ROPE); e.n0 = nt * 256; e.m0 = m0;
      gemm_tile<0, 256>(H, 1024, W + (size_t)nt * 256 * 1024, 1024, m0, nullptr, lds, e);
    }
  }
  grid.sync();
  {
    const bf16_t* WQ = (const bf16_t*)(ws + OFF_WQB); const bf16_t* WKV = (const bf16_t*)(ws + OFF_WKVB);
    const int nq = 256 * 6, nkv = 264 * 8;
    XcdWalk wk; wk.init(nq); int o;
    while (wk.next(o)) {
      EpiBf16 e; e.act = 0;
      {
        int mt2, nt; tile_mn(o, 6, mt2, nt);
        const int b = mt2 >> 5, m0 = b * TL + (mt2 & 31) * 256;
        e.dst = (bf16_t*)(ws + OFF_Q); e.ldd = 1536; e.col0 = nt * 256; e.m0 = m0; e.invK = 1.f / 384.f;
        gemm_tile<2, 256>((const bf16_t*)(ws + OFF_QC), 384, WQ + (size_t)nt * 256 * 384, 384, m0, nullptr, lds, e);
      }
    }
    wk.init(nkv);
    while (wk.next(o)) {
      EpiBf16 e; e.act = 0;
      {
        int mt, nt; tile_mn(o, 8, mt, nt);
        const int m0 = mt * 256;
        e.dst = (bf16_t*)(ws + OFF_KV); e.ldd = 2048; e.col0 = nt * 256; e.m0 = m0; e.invK = 1.f / 256.f;
        gemm_tile<2, 256>((const bf16_t*)(ws + OFF_KVC), 256, WKV + (size_t)nt * 256 * 256, 256, m0, nullptr, lds, e);
      }
    }
  }
  grid.sync();
  phase_attn(p, lds);
  grid.sync();
  {
    const bf16_t* A = (const bf16_t*)(ws + OFF_G1); const bf16_t* W = (const bf16_t*)(ws + OFF_WOUT1);
    XcdWalk wk; wk.init(256 * 4); int o;
    while (wk.next(o)) {
      int mt2, nt; tile_mn(o, 4, mt2, nt);
      const int b = mt2 >> 5, t0 = (mt2 & 31) * 256, m0 = b * TL + t0;
      const size_t orow = (size_t)b * T + t0;
      EpiResid e; e.xin = p.out + orow * 1024; e.xout = p.out + orow * 1024; e.gvec = mod + (size_t)(9 + b) * 3072 + 2048; e.n0 = nt * 256;
      gemm_tile<0, 256>(A, 1024, W + (size_t)nt * 256 * 1024, 1024, m0, nullptr, lds, e);
    }
  }
  grid.sync();
  phase_final(p.out, p.in[27]);
}

extern "C" void kernel_launch(void* const* d_in, const int* in_sizes, int n_in, void* d_out, int out_size, void* d_ws, size_t ws_size, hipStream_t stream) {
  static int grid_blocks = 0;
  if (grid_blocks == 0) {
    if (n_in != 28 || ws_size < WS_END + (size_t)(NTOK - LERP3_SPLIT) * 2048 || out_size != NB * T * D) { fprintf(stderr, "kernel_launch: unexpected shapes (n_in %d, ws %zu need %zu, out %d)\n", n_in, ws_size, (size_t)WS_END, out_size); grid_blocks = -1; return; }
    int dev = 0, cus = 0, per_cu = 0;
    hipGetDevice(&dev);
    hipDeviceGetAttribute(&cus, hipDeviceAttributeMultiprocessorCount, dev);
    if (hipFuncSetAttribute((const void*)fwd_megakernel, hipFuncAttributeMaxDynamicSharedMemorySize, LDS_BYTES) != hipSuccess) { fprintf(stderr, "kernel_launch: hipFuncSetAttribute failed\n"); grid_blocks = -1; return; }
    hipOccupancyMaxActiveBlocksPerMultiprocessor(&per_cu, (const void*)fwd_megakernel, NTHR, LDS_BYTES);
    if (per_cu < 1) { fprintf(stderr, "kernel_launch: occupancy query says %d blocks per CU\n", per_cu); per_cu = 1; }
    (void)hipGetLastError();
    grid_blocks = cus;
    if (grid_blocks > 256) grid_blocks = 256;
    grid_blocks &= ~7;
  }
  if (grid_blocks <= 0) return;
  Params p{};
  for (int i = 0; i < 28; ++i) p.in[i] = (const float*)d_in[i];
  p.out = (float*)d_out; p.ws = (unsigned char*)d_ws;
  void* args[] = {&p};
  hipError_t e = hipLaunchCooperativeKernel((const void*)fwd_megakernel, dim3(grid_blocks), dim3(NTHR), args, LDS_BYTES, stream);
  if (e != hipSuccess) fprintf(stderr, "cooperative launch failed: %s (grid %d)\n", hipGetErrorString(e), grid_blocks);
}
```

```cpp
#include <hip/hip_runtime.h>
#include <hip/hip_cooperative_groups.h>
#include <cstdio>
#include <cstdint>
namespace cg = cooperative_groups;

typedef unsigned short bf16_t;
typedef short bf16x8 __attribute__((ext_vector_type(8)));
typedef short s16x4 __attribute__((ext_vector_type(4)));
typedef float f32x16 __attribute__((ext_vector_type(16)));
typedef float f32x4 __attribute__((ext_vector_type(4)));
typedef float f32x2 __attribute__((ext_vector_type(2)));
typedef unsigned u32x4 __attribute__((ext_vector_type(4)));
typedef unsigned u32x2 __attribute__((ext_vector_type(2)));

constexpr int D = 1024, NB = 8, T = 8192, L = 256, TL = T + L, NTOK = NB * TL;
constexpr int NTHR = 512;

constexpr size_t U = (size_t)NTOK * 1024 * 2;
constexpr size_t OFF_H = 0, OFF_R = U, OFF_K = 2 * U, OFF_V = 3 * U, OFF_G = 4 * U, OFF_Y0 = 5 * U, OFF_Y1 = 6 * U;
constexpr size_t OFF_LORA = 7 * U;
constexpr size_t OFF_BONUS = OFF_LORA + (size_t)NTOK * 256 * 2;
constexpr size_t OFF_WIN0 = OFF_BONUS + (size_t)2 * NTOK * 16 * 4;
constexpr size_t OFF_WOUT0 = OFF_WIN0 + (size_t)4352 * 1024 * 2;
constexpr size_t OFF_WIN1 = OFF_WOUT0 + (size_t)1024 * 1024 * 2;
constexpr size_t OFF_WQB = OFF_WIN1 + (size_t)1792 * 1024 * 2;
constexpr size_t OFF_WKVB = OFF_WQB + (size_t)1536 * 384 * 2;
constexpr size_t OFF_WOUT1 = OFF_WKVB + (size_t)2048 * 256 * 2;
constexpr size_t OFF_MOD = OFF_WOUT1 + (size_t)1024 * 1024 * 2;
constexpr size_t OFF_ROPE = OFF_MOD + (size_t)2 * 9 * 3072 * 4;
constexpr size_t OFF_CTX1 = OFF_ROPE + (size_t)128 * 8 * 2 * 4;
constexpr size_t WS_END = OFF_CTX1 + (size_t)2048 * 1024 * 4;
constexpr size_t OFF_QC = OFF_V;
constexpr size_t OFF_KVC = OFF_QC + (size_t)NTOK * 384 * 2;
constexpr size_t OFF_KPE = OFF_KVC + (size_t)NTOK * 256 * 2;
constexpr size_t OFF_G1 = OFF_G;
constexpr size_t OFF_Q = OFF_R;
constexpr size_t OFF_KV = OFF_Y0;

struct Params { const float* in[28]; float* out; unsigned char* ws; };

typedef __bf16 bf16x2_t __attribute__((ext_vector_type(2)));
__device__ __forceinline__ unsigned cvtpk(float lo, float hi) { f32x2 v = {lo, hi}; bf16x2_t b = __builtin_convertvector(v, bf16x2_t); return *(unsigned*)&b; }
__device__ __forceinline__ float bf2f(bf16_t u) { return __uint_as_float(((unsigned)u) << 16); }
__device__ __forceinline__ bf16_t f2bf(float f) { return (bf16_t)(cvtpk(f, 0.f) & 0xffffu); }
__device__ __forceinline__ float lo16(unsigned w) { return __uint_as_float(w << 16); }
__device__ __forceinline__ float hi16(unsigned w) { return __uint_as_float(w & 0xffff0000u); }
__device__ __forceinline__ void st_bf16x4(bf16_t* p, float a, float b, float c, float d) { u32x2 w = {cvtpk(a, b), cvtpk(c, d)}; *(u32x2*)p = w; }
__device__ __forceinline__ void st_bf16x4_nt(bf16_t* p, float a, float b, float c, float d) { u32x2 w = {cvtpk(a, b), cvtpk(c, d)}; __builtin_nontemporal_store(w, (u32x2*)p); }
__device__ __forceinline__ float wave_sum(float v) {
#pragma unroll
  for (int o = 32; o; o >>= 1) v += __shfl_xor(v, o);
  return v;
}
__device__ __forceinline__ float dpp_f(float v, const int ctrl_sel) {
  int r;
  if (ctrl_sel == 0) r = __builtin_amdgcn_update_dpp(0, __float_as_int(v), 0xB1, 0xF, 0xF, true);
  else if (ctrl_sel == 1) r = __builtin_amdgcn_update_dpp(0, __float_as_int(v), 0x4E, 0xF, 0xF, true);
  else r = __builtin_amdgcn_update_dpp(0, __float_as_int(v), 0x141, 0xF, 0xF, true);
  return __int_as_float(r);
}
__device__ __forceinline__ float red8(float v) { v += dpp_f(v, 0); v += dpp_f(v, 1); v += dpp_f(v, 2); return v; }
__device__ __forceinline__ int crow(int r, int hi) { return (r & 3) + 8 * (r >> 2) + 4 * hi; }
__device__ __forceinline__ float sigmoidf_(float x) { return 1.f / (1.f + __expf(-x)); }
#define MFMA(a, b, c) __builtin_amdgcn_mfma_f32_32x32x16_bf16((a), (b), (c), 0, 0, 0)

constexpr int G_LDT = 144;
constexpr int G_SSQ_OFF = 2 * (256 + 256) * G_LDT;
constexpr int LDS_BYTES = G_SSQ_OFF + 1024;

template <int AMODE, int BN, class Epi>
__device__ __forceinline__ void gemm_tile(const bf16_t* A, const int lda, const bf16_t* Bt, const int K, const int m0, const float* mu, char* lds, const Epi& epi) {
  constexpr int WN = BN / 64, MI = WN, NBR = BN / 64, G_STAGE = (256 + BN) * G_LDT;
  const int tid = threadIdx.x, lane = tid & 63, wid = tid >> 6, r32 = lane & 31, hi = lane >> 5;
  const int wm = wid / WN, wn = wid % WN;
  const int srow = tid >> 3, scc = (tid & 7) * 8;
  f32x16 acc[MI][2];
#pragma unroll
  for (int i = 0; i < MI; ++i)
#pragma unroll
    for (int j = 0; j < 2; ++j)
#pragma unroll
      for (int r = 0; r < 16; ++r) acc[i][j][r] = 0.f;
  bf16x8 ra[4], rb[NBR], rp[4], rn[4];
  float ssq[4] = {0.f, 0.f, 0.f, 0.f};
  int dprev[4], dnext[4];
  if constexpr (AMODE == 1) {
    const int t0 = m0 % TL;
#pragma unroll
    for (int i = 0; i < 4; ++i) { const int t = t0 + srow + 64 * i; dprev[i] = (t != 0 && t != T) ? 1 : 0; dnext[i] = (t != T - 1 && t != TL - 1) ? 1 : 0; }
  }
  auto gload = [&](int k0) {
#pragma unroll
    for (int i = 0; i < 4; ++i) {
      const bf16_t* ap = A + (size_t)(m0 + srow + 64 * i) * lda + k0 + scc;
      ra[i] = *(const bf16x8*)ap;
      if constexpr (AMODE == 1) { rp[i] = *(const bf16x8*)(ap - dprev[i] * lda); rn[i] = *(const bf16x8*)(ap + dnext[i] * lda); }
    }
#pragma unroll
    for (int i = 0; i < NBR; ++i) rb[i] = *(const bf16x8*)(Bt + (size_t)(srow + 64 * i) * K + k0 + scc);
  };
  auto lstore = [&](int s, int k0) {
    char* base = lds + s * G_STAGE;
    if constexpr (AMODE == 1) {
      const f32x4 m0v = *(const f32x4*)(mu + k0 + scc), m1v = *(const f32x4*)(mu + k0 + scc + 4);
      const float mm[8] = {m0v[0], m0v[1], m0v[2], m0v[3], m1v[0], m1v[1], m1v[2], m1v[3]};
#pragma unroll
      for (int i = 0; i < 4; ++i) {
        const u32x4 hc = *(const u32x4*)&ra[i], hp = *(const u32x4*)&rp[i], hn = *(const u32x4*)&rn[i];
        const float fp = dprev[i] ? 0.5f : 0.f, fn = dnext[i] ? 0.5f : 0.f;
        u32x4 w;
#pragma unroll
        for (int q = 0; q < 4; ++q) {
          const float c0 = lo16(hc[q]), c1 = hi16(hc[q]);
          const float x0 = fp * lo16(hp[q]) + fn * lo16(hn[q]) - c0, x1 = fp * hi16(hp[q]) + fn * hi16(hn[q]) - c1;
          w[q] = cvtpk(c0 + x0 * mm[2 * q], c1 + x1 * mm[2 * q + 1]);
        }
        *(u32x4*)(base + (srow + 64 * i) * G_LDT + scc * 2) = w;
      }
    } else {
#pragma unroll
      for (int i = 0; i < 4; ++i) {
        *(bf16x8*)(base + (srow + 64 * i) * G_LDT + scc * 2) = ra[i];
        if constexpr (AMODE == 2) {
          const u32x4 hc = *(const u32x4*)&ra[i];
#pragma unroll
          for (int q = 0; q < 4; ++q) { const float c0 = lo16(hc[q]), c1 = hi16(hc[q]); ssq[i] += c0 * c0 + c1 * c1; }
        }
      }
    }
#pragma unroll
    for (int i = 0; i < NBR; ++i) *(bf16x8*)(base + 256 * G_LDT + (srow + 64 * i) * G_LDT + scc * 2) = rb[i];
  };
  const int nk = K >> 6;
  gload(0);
  lstore(0, 0);
  if (nk > 1) gload(64);
  __syncthreads();
#pragma unroll 1
  for (int kt = 0; kt < nk; ++kt) {
    const int s = kt & 1;
    if (kt + 1 < nk) lstore(s ^ 1, (kt + 1) * 64);
    if (kt + 2 < nk) gload((kt + 2) * 64);
    {
      const char* Ab = lds + s * G_STAGE + (wm * (32 * MI) + r32) * G_LDT + hi * 16;
      const char* Bb = lds + s * G_STAGE + 256 * G_LDT + (wn * 64 + r32) * G_LDT + hi * 16;
#pragma unroll 2
      for (int ks = 0; ks < 4; ++ks) {
        const bf16x8 b0 = *(const bf16x8*)(Bb + ks * 32), b1 = *(const bf16x8*)(Bb + 32 * G_LDT + ks * 32);
#pragma unroll
        for (int mi = 0; mi < MI; ++mi) {
          const bf16x8 a0 = *(const bf16x8*)(Ab + mi * 32 * G_LDT + ks * 32);
          acc[mi][0] = MFMA(b0, a0, acc[mi][0]); acc[mi][1] = MFMA(b1, a0, acc[mi][1]);
        }
      }
    }
    __syncthreads();
  }
  float* ssq_l = (float*)(lds + G_SSQ_OFF);
  if constexpr (AMODE == 2) {
#pragma unroll
    for (int i = 0; i < 4; ++i) { const float v = red8(ssq[i]); if ((tid & 7) == 0) ssq_l[srow + 64 * i] = v; }
    __syncthreads();
  }
#pragma unroll
  for (int mi = 0; mi < MI; ++mi) {
    const int lrow = wm * (32 * MI) + mi * 32 + r32;
    float aux = 0.f;
    if constexpr (AMODE == 2) aux = ssq_l[lrow];
    epi(lrow, wn * 64 + 4 * hi, acc[mi][0], acc[mi][1], aux);
  }
}

struct EpiBf16 {
  bf16_t* dst; int ldd; int col0; int m0; int act; float invK;
  __device__ __forceinline__ void operator()(int lrow, int nc, const f32x16& a0, const f32x16& a1, float aux) const { one(lrow, nc, a0, aux); one(lrow, nc + 32, a1, aux); }
  __device__ __forceinline__ void one(int lrow, int nc, const f32x16& a, float aux) const {
    float sc = 1.f;
    if (invK > 0.f) sc = rsqrtf(aux * invK + 1e-6f);
    bf16_t* p = dst + (size_t)(m0 + lrow) * ldd + col0 + nc;
#pragma unroll
    for (int g = 0; g < 4; ++g) {
      float v0 = a[4 * g] * sc, v1 = a[4 * g + 1] * sc, v2 = a[4 * g + 2] * sc, v3 = a[4 * g + 3] * sc;
      if (act) {
        v0 = 1.f - 2.f / (__expf(2.f * v0) + 1.f); v1 = 1.f - 2.f / (__expf(2.f * v1) + 1.f);
        v2 = 1.f - 2.f / (__expf(2.f * v2) + 1.f); v3 = 1.f - 2.f / (__expf(2.f * v3) + 1.f);
      }
      st_bf16x4(p + 8 * g, v0, v1, v2, v3);
    }
  }
};
struct EpiResid {
  const float* xin; float* xout; const float* gvec; int n0;
  __device__ __forceinline__ void operator()(int lrow, int nc, const f32x16& a0, const f32x16& a1, float) const {
    const size_t o = (size_t)lrow * 1024 + n0 + nc;
    f32x4 xv[8], gv[8];
#pragma unroll
    for (int g = 0; g < 4; ++g) {
      xv[g] = *(const f32x4*)(xin + o + 8 * g); xv[4 + g] = *(const f32x4*)(xin + o + 32 + 8 * g);
      gv[g] = *(const f32x4*)(gvec + n0 + nc + 8 * g); gv[4 + g] = *(const f32x4*)(gvec + n0 + nc + 32 + 8 * g);
    }
    f32x4 r[8];
#pragma unroll
    for (int g = 0; g < 4; ++g)
#pragma unroll
      for (int e = 0; e < 4; ++e) { r[g][e] = xv[g][e] + gv[g][e] * a0[4 * g + e]; r[4 + g][e] = xv[4 + g][e] + gv[4 + g][e] * a1[4 * g + e]; }
    asm volatile("" ::: "memory");
#pragma unroll
    for (int g = 0; g < 4; ++g) { *(f32x4*)(xout + o + 8 * g) = r[g]; *(f32x4*)(xout + o + 32 + 8 * g) = r[4 + g]; }
  }
};
struct EpiMlaIn {
  bf16_t *QC, *KVC, *KPE, *G1; const float* rope; int n0; int m0;
  __device__ __forceinline__ void operator()(int lrow, int nc, const f32x16& a0, const f32x16& a1, float) const { one(lrow, nc, a0); one(lrow, nc + 32, a1); }
  __device__ __forceinline__ void one(int lrow, int nc, const f32x16& a) const {
    const int row = m0 + lrow, gc = n0 + nc, g32 = gc & ~31;
    if (g32 == 640) {
      const int t = (m0 % TL) + lrow, hi4 = gc - 640;
      bf16_t* p = KPE + (size_t)row * 32;
      if (t < T) {
        const f32x2* tr = (const f32x2*)rope + (t >> 6) * 8 + hi4;
        const f32x2* tc = (const f32x2*)rope + (t & 63) * 8 + hi4;
        float o1[8], o2[8];
#pragma unroll
        for (int e = 0; e < 4; ++e) {
          const f32x2 cs0 = tr[e], cs1 = tc[e];
          const float x1a = a[e], x2a = a[8 + e];
          const float x1b = a[4 + e], x2b = a[12 + e];
          o1[e] = x1a * cs0[0] - x2a * cs0[1]; o2[e] = x1a * cs0[1] + x2a * cs0[0];
          o1[4 + e] = x1b * cs1[0] - x2b * cs1[1]; o2[4 + e] = x1b * cs1[1] + x2b * cs1[0];
        }
        st_bf16x4(p + hi4, o1[0], o1[1], o1[2], o1[3]);
        st_bf16x4(p + 8 + hi4, o1[4], o1[5], o1[6], o1[7]);
        st_bf16x4(p + 16 + hi4, o2[0], o2[1], o2[2], o2[3]);
        st_bf16x4(p + 24 + hi4, o2[4], o2[5], o2[6], o2[7]);
      } else {
#pragma unroll
        for (int g = 0; g < 4; ++g) st_bf16x4(p + 8 * g + hi4, a[4 * g], a[4 * g + 1], a[4 * g + 2], a[4 * g + 3]);
      }
      return;
    }
    if (g32 > 640 && g32 < 768) return;
    bf16_t* p;
    if (gc < 384) p = QC + (size_t)row * 384 + gc;
    else if (gc < 640) p = KVC + (size_t)row * 256 + (gc - 384);
    else p = G1 + (size_t)row * 1024 + (gc - 768);
#pragma unroll
    for (int g = 0; g < 4; ++g) st_bf16x4(p + 8 * g, a[4 * g], a[4 * g + 1], a[4 * g + 2], a[4 * g + 3]);
  }
};

constexpr float AT_SCALE = 0.10206207261596575f;
constexpr float AT_THR = 8.f;
__device__ void tr_job(const float* src, int ld, int K, int N, bf16_t* dst, const float* kscale, char* lds, float gscale = 1.f) {
  float* tile = (float*)lds;
  const int tid = threadIdx.x, nK = K >> 6, nN = (N + 63) >> 6;
  for (int tIdx = blockIdx.x; tIdx < nK * nN; tIdx += gridDim.x) {
    const int k0 = (tIdx % nK) * 64, n0 = (tIdx / nK) * 64;
#pragma unroll
    for (int i = 0; i < 8; ++i) {
      const int kk = (tid >> 6) + 8 * i, nn = tid & 63;
      float v = 0.f;
      if (n0 + nn < N) { v = src[(size_t)(k0 + kk) * ld + n0 + nn] * gscale; if (kscale) v *= kscale[k0 + kk]; }
      tile[kk * 65 + nn] = v;
    }
    __syncthreads();
#pragma unroll
    for (int i = 0; i < 8; ++i) {
      const int nn = (tid >> 6) + 8 * i, kk = tid & 63;
      if (n0 + nn < N) dst[(size_t)(n0 + nn) * K + k0 + kk] = f2bf(tile[kk * 65 + nn]);
    }
    __syncthreads();
  }
}

__device__ void phase_weights(const Params& p, char* lds) {
  unsigned char* ws = p.ws;
  bf16_t* WIN0 = (bf16_t*)(ws + OFF_WIN0);
  for (int j = 0; j < 4; ++j) tr_job(p.in[8] + (size_t)j * 1024 * 1024, 1024, 1024, 1024, WIN0 + (size_t)j * 1024 * 1024, nullptr, lds);
  for (int d = 0; d < 2; ++d) {
    tr_job(p.in[10] + (size_t)d * 1024 * 64, 64, 1024, 64, WIN0 + (size_t)(4096 + d * 64) * 1024, nullptr, lds);
    tr_job(p.in[13] + (size_t)d * 1024 * 64, 64, 1024, 64, WIN0 + (size_t)(4224 + d * 64) * 1024, nullptr, lds);
  }
  tr_job(p.in[20], 1024, 1024, 1024, (bf16_t*)(ws + OFF_WOUT0), nullptr, lds);
  bf16_t* WIN1 = (bf16_t*)(ws + OFF_WIN1);
  tr_job(p.in[21], 1696, 1024, 640, WIN1, nullptr, lds);
  tr_job(p.in[21] + 640, 1696, 1024, 32, WIN1 + (size_t)640 * 1024, nullptr, lds);
  tr_job(p.in[21] + 672, 1696, 1024, 1024, WIN1 + (size_t)768 * 1024, nullptr, lds);
  for (int i = blockIdx.x * NTHR + threadIdx.x; i < 96 * 1024; i += gridDim.x * NTHR) WIN1[(size_t)672 * 1024 + i] = 0;
  tr_job(p.in[23], 1536, 384, 1536, (bf16_t*)(ws + OFF_WQB), p.in[22], lds, AT_SCALE * 1.4426950408889634f);
  tr_job(p.in[25], 2048, 256, 2048, (bf16_t*)(ws + OFF_WKVB), p.in[24], lds);
  tr_job(p.in[26], 1024, 1024, 1024, (bf16_t*)(ws + OFF_WOUT1), nullptr, lds);
}
__device__ void phase_prologue(const Params& p, char* lds) {
  unsigned char* ws = p.ws;
  {
    const int i = blockIdx.x * NTHR + threadIdx.x;
    if (i < 1024) {
      const float invf[8] = {1.f, 0.316227766016838f, 0.1f, 0.0316227766016838f, 0.01f, 0.00316227766016838f, 0.001f, 0.000316227766016838f};
      const int pos = i >> 3, m = i & 7;
      float inv = invf[0];
#pragma unroll
      for (int q = 1; q < 8; ++q) inv = (m == q) ? invf[q] : inv;
      const float ang = (float)pos * inv;
      const float kf = rintf(ang * 0.15915494309189535f);
      float r = fmaf(-kf, 6.28125f, ang);
      r = fmaf(-kf, 1.9353071795864769e-3f, r);
      float* rt = (float*)(ws + OFF_ROPE);
      rt[2 * i] = cosf(r); rt[2 * i + 1] = sinf(r);
    }
  }
  {
    float* sil = (float*)lds;
    float* red = sil + 9 * 1024;
    const int tid = threadIdx.x;
    for (int i = tid; i < 9 * 1024; i += NTHR) {
      const int bi = i >> 10, k = i & 1023;
      const float cv = bi < 8 ? p.in[1][bi * 1024 + k] : p.in[3][k];
      sil[i] = cv / (1.f + __expf(-cv));
    }
    __syncthreads();
    float* mod = (float*)(ws + OFF_MOD);
    for (int item = blockIdx.x; item < 192; item += gridDim.x) {
      const int l = item / 96, n0 = (item % 96) * 32, col = tid & 31, kg = tid >> 5;
      float acc[9];
#pragma unroll
      for (int bi = 0; bi < 9; ++bi) acc[bi] = 0.f;
      const float* wp = p.in[5] + ((size_t)l * 1024 + kg * 64) * 3072 + n0 + col;
      for (int kk = 0; kk < 64; ++kk) {
        const float w = wp[(size_t)kk * 3072];
#pragma unroll
        for (int bi = 0; bi < 9; ++bi) acc[bi] += sil[bi * 1024 + kg * 64 + kk] * w;
      }
#pragma unroll
      for (int bi = 0; bi < 9; ++bi) red[(kg * 9 + bi) * 32 + col] = acc[bi];
      __syncthreads();
      if (tid < 288) {
        const int bi = tid >> 5;
        float s = 0.f;
#pragma unroll
        for (int g = 0; g < 16; ++g) s += red[(g * 9 + bi) * 32 + col];
        mod[((size_t)l * 9 + bi) * 3072 + n0 + col] = s + p.in[6][l * 3072 + n0 + col];
      }
      __syncthreads();
    }
  }
}

__device__ __forceinline__ const float* row_src(const float* xsrc, const float* csrc, int n, int& bi) {
  const int b = n / TL, t = n - b * TL;
  if (t < T) { bi = b; return xsrc + ((size_t)b * T + t) * D; }
  bi = 8; return csrc + ((size_t)b * L + (t - T)) * D;
}
__device__ void phase_norm(const float* xsrc, const float* csrc, const float* ng, const float* mod, bf16_t* H) {
  const int lane = threadIdx.x & 63, gw = blockIdx.x * 8 + (threadIdx.x >> 6), nw = gridDim.x * 8;
  f32x4 g4[4];
#pragma unroll
  for (int i = 0; i < 4; ++i) g4[i] = *(const f32x4*)(ng + i * 256 + lane * 4);
  f32x4 va[4], vb[4]; int bia = 0, bib = 0;
  if (gw < NTOK) { const float* src = row_src(xsrc, csrc, gw, bia);
#pragma unroll
    for (int i = 0; i < 4; ++i) va[i] = *(const f32x4*)(src + i * 256 + lane * 4); }
  for (int n = gw; n < NTOK; n += nw) {
    if (n + nw < NTOK) { const float* src = row_src(xsrc, csrc, n + nw, bib);
#pragma unroll
      for (int i = 0; i < 4; ++i) vb[i] = *(const f32x4*)(src + i * 256 + lane * 4); }
    float ss = 0.f;
#pragma unroll
    for (int i = 0; i < 4; ++i) ss += va[i][0] * va[i][0] + va[i][1] * va[i][1] + va[i][2] * va[i][2] + va[i][3] * va[i][3];
    ss = wave_sum(ss);
    const float rstd = rsqrtf(ss * (1.f / 1024.f) + 1e-6f);
    const float* m = mod + bia * 3072;
#pragma unroll
    for (int i = 0; i < 4; ++i) {
      const int c = i * 256 + lane * 4;
      const f32x4 sh = *(const f32x4*)(m + c), sc = *(const f32x4*)(m + 1024 + c);
      float o[4];
#pragma unroll
      for (int e = 0; e < 4; ++e) o[e] = va[i][e] * rstd * g4[i][e] * (1.f + sc[e]) + sh[e];
      st_bf16x4(H + (size_t)n * 1024 + c, o[0], o[1], o[2], o[3]);
    }
#pragma unroll
    for (int i = 0; i < 4; ++i) va[i] = vb[i];
    bia = bib;
  }
}

constexpr int LERP3_SPLIT = 63488;
__device__ __forceinline__ bf16_t* lerp_base(const Params& p, int j, int row) {
  if (j == 0) return (bf16_t*)(p.ws + OFF_Y0);
  if (j == 1) return (bf16_t*)(p.ws + OFF_Y1);
  if (j == 2) return (bf16_t*)p.out;
  if (row < LERP3_SPLIT) return (bf16_t*)p.out + (size_t)NTOK * 1024;
  return (bf16_t*)(p.ws + WS_END) - (size_t)LERP3_SPLIT * 1024;
}
struct RowX { f32x4 v[4]; int bi; };
__device__ __forceinline__ void ld_row(const Params& p, int n, int lane, RowX& r) {
  const float* src = row_src(p.in[0], p.in[2], n, r.bi);
#pragma unroll
  for (int i = 0; i < 4; ++i) r.v[i] = *(const f32x4*)(src + i * 256 + lane * 4);
}
__device__ __forceinline__ void fin_row(const float* mod, const f32x4 (&g4)[4], int lane, const RowX& r, float (&h)[16]) {
  float ss = 0.f;
#pragma unroll
  for (int i = 0; i < 4; ++i) ss += r.v[i][0] * r.v[i][0] + r.v[i][1] * r.v[i][1] + r.v[i][2] * r.v[i][2] + r.v[i][3] * r.v[i][3];
  ss = wave_sum(ss);
  const float rstd = rsqrtf(ss * (1.f / 1024.f) + 1e-6f);
  const float* m = mod + r.bi * 3072;
#pragma unroll
  for (int i = 0; i < 4; ++i) {
    const int c = i * 256 + lane * 4;
    const f32x4 sh = *(const f32x4*)(m + c), sc = *(const f32x4*)(m + 1024 + c);
#pragma unroll
    for (int e = 0; e < 4; ++e) {
      const float hv = r.v[i][e] * rstd * g4[i][e] * (1.f + sc[e]) + sh[e];
      h[4 * i + e] = __uint_as_float(cvtpk(hv, 0.f) << 16);
    }
  }
}
__device__ void phase_norm_lerp(const Params& p, const float* mod) {
  const int lane = threadIdx.x & 63, gw = blockIdx.x * 8 + (threadIdx.x >> 6), nw = gridDim.x * 8;
  const int per = (NTOK + nw - 1) / nw;
  const int r0 = gw * per, r1 = (r0 + per < NTOK) ? r0 + per : NTOK;
  if (r0 >= r1) return;
  bf16_t* H = (bf16_t*)(p.ws + OFF_H);
  f32x4 g4[4];
#pragma unroll
  for (int i = 0; i < 4; ++i) g4[i] = *(const f32x4*)(p.in[4] + i * 256 + lane * 4);
  float mu[4][16];
#pragma unroll
  for (int j = 0; j < 4; ++j)
#pragma unroll
    for (int i = 0; i < 4; ++i) {
      const f32x4 m4 = *(const f32x4*)(p.in[7] + j * 1024 + i * 256 + lane * 4);
      mu[j][4 * i] = m4[0]; mu[j][4 * i + 1] = m4[1]; mu[j][4 * i + 2] = m4[2]; mu[j][4 * i + 3] = m4[3];
    }
  float hp[16], hc[16], hn[16];
  RowX xa, xb, xc;
  if (r0 > 0) { ld_row(p, r0 - 1, lane, xc); }
  ld_row(p, r0, lane, xa);
  if (r0 + 1 < NTOK) ld_row(p, r0 + 1, lane, xb);
  if (r0 > 0) fin_row(mod, g4, lane, xc, hp);
  else {
#pragma unroll
    for (int e = 0; e < 16; ++e) hp[e] = 0.f;
  }
  fin_row(mod, g4, lane, xa, hc);
  xa = xb;
  if (r0 + 2 < NTOK) ld_row(p, r0 + 2, lane, xb);
  for (int n = r0; n < r1; ++n) {
    const int t = n % TL;
    if (n + 3 < NTOK) ld_row(p, n + 3, lane, xc);
    if (n + 1 < NTOK) fin_row(mod, g4, lane, xa, hn);
    else {
#pragma unroll
      for (int e = 0; e < 16; ++e) hn[e] = 0.f;
    }
    const float fp = (t != 0 && t != T) ? 0.5f : 0.f, fn = (t != T - 1 && t != TL - 1) ? 0.5f : 0.f;
#pragma unroll
    for (int i = 0; i < 4; ++i) st_bf16x4_nt(H + (size_t)n * 1024 + i * 256 + lane * 4, hc[4 * i], hc[4 * i + 1], hc[4 * i + 2], hc[4 * i + 3]);
#pragma unroll
    for (int j = 0; j < 4; ++j) {
      bf16_t* dst = lerp_base(p, j, n) + (size_t)n * 1024 + lane * 4;
#pragma unroll
      for (int i = 0; i < 4; ++i) {
        float o[4];
#pragma unroll
        for (int e = 0; e < 4; ++e) { const float c = hc[4 * i + e]; o[e] = c + (fp * hp[4 * i + e] + fn * hn[4 * i + e] - c) * mu[j][4 * i + e]; }
        st_bf16x4_nt(dst + i * 256, o[0], o[1], o[2], o[3]);
      }
    }
#pragma unroll
    for (int e = 0; e < 16; ++e) { hp[e] = hc[e]; hc[e] = hn[e]; }
    xa = xb; xb = xc;
  }
}

__device__ void phase_final(float* out, const float* fg) {
  const int lane = threadIdx.x & 63, gw = blockIdx.x * 8 + (threadIdx.x >> 6), nw = gridDim.x * 8;
  f32x4 g4[4];
#pragma unroll
  for (int i = 0; i < 4; ++i) g4[i] = *(const f32x4*)(fg + i * 256 + lane * 4);
  f32x4 va[4], vb[4];
  if (gw < NB * T) {
#pragma unroll
    for (int i = 0; i < 4; ++i) va[i] = *(const f32x4*)(out + (size_t)gw * D + i * 256 + lane * 4); }
  for (int n = gw; n < NB * T; n += nw) {
    if (n + nw < NB * T) {
#pragma unroll
      for (int i = 0; i < 4; ++i) vb[i] = *(const f32x4*)(out + (size_t)(n + nw) * D + i * 256 + lane * 4); }
    float ss = 0.f;
#pragma unroll
    for (int i = 0; i < 4; ++i) ss += va[i][0] * va[i][0] + va[i][1] * va[i][1] + va[i][2] * va[i][2] + va[i][3] * va[i][3];
    ss = wave_sum(ss);
    const float rstd = rsqrtf(ss * (1.f / 1024.f) + 1e-6f);
#pragma unroll
    for (int i = 0; i < 4; ++i) {
      f32x4 o;
#pragma unroll
      for (int e = 0; e < 4; ++e) o[e] = va[i][e] * rstd * g4[i][e];
      *(f32x4*)(out + (size_t)n * D + i * 256 + lane * 4) = o;
    }
#pragma unroll
    for (int i = 0; i < 4; ++i) va[i] = vb[i];
  }
}

__device__ __forceinline__ int scan_row(int g, int d, int b) {
  if (g < L) { const int tt = d ? (L - 1 - g) : g; return b * TL + T + tt; }
  g -= L; const int tt = d ? (T - 1 - g) : g; return b * TL + tt;
}
constexpr int SC_WD = 0, SC_AR = 8192, SC_BK = SC_AR + 33 * 256, SC_VV = SC_BK + 32768, SC_BUF = SC_VV + 8192;
constexpr int SC_IC = 2 * SC_BUF, SC_YB = SC_IC + 8192, SC_DUMP = SC_YB + 2 * 33 * 256, SC_END = SC_DUMP + 256;
#define MFMA16(a, b, c) __builtin_amdgcn_mfma_f32_16x16x32_bf16((a), (b), (c), 0, 0, 0)
struct ScCoef { u32x4 a0, a1; u32x4 k0, k1, k2, k3; float vi; };
__device__ __forceinline__ ScCoef sc_ld(const char* buf, int t, int arOff, int wOff, int bkOff, int vOff) {
  ScCoef c;
  const char* ar = buf + SC_AR + t * 256 + arOff;
  c.a0 = *(const u32x4*)(ar); c.a1 = *(const u32x4*)(ar + 64);
  const char* bk = buf + SC_BK + t * 1024 + bkOff;
  c.k0 = *(const u32x4*)(bk); c.k1 = *(const u32x4*)(bk + 256); c.k2 = *(const u32x4*)(bk + 512); c.k3 = *(const u32x4*)(bk + 768);
  c.vi = *(const float*)(buf + SC_VV + t * 256 + vOff);
  return c;
}
__device__ void phase_scan(const Params& p, char* lds) {
  unsigned char* ws = p.ws;
  const int tid = threadIdx.x, lane = tid & 63, wid = __builtin_amdgcn_readfirstlane(tid >> 6), r32 = lane & 31, hi = lane >> 5;
  const bf16_t* Rg = (const bf16_t*)(ws + OFF_R); const bf16_t* Kg = (const bf16_t*)(ws + OFF_K); const bf16_t* Vg = (const bf16_t*)(ws + OFF_V);
  const bf16_t* Lg = (const bf16_t*)(ws + OFF_LORA);
  constexpr int NCH = TL / 32;
  for (int sidx = blockIdx.x; sidx < 256; sidx += gridDim.x) {
    const int d = sidx >> 7, b = (sidx >> 4) & 7, h = sidx & 15;
    bf16_t* Yg = (bf16_t*)(ws + (d ? OFF_Y1 : OFF_Y0));
    if (wid < 4) {
      const int cw = wid, c16 = lane & 15, q = lane >> 4;
      const int arOff = (c16 & 1) * 128 + q * 16, wOff = q * 16, bkOff = c16 * 16, vOff = (cw * 16 + c16) * 4;
      f32x4 St0 = {0.f, 0.f, 0.f, 0.f}, St1 = St0, St2 = St0, St3 = St0;
      __syncthreads();
      __syncthreads();
      for (int c = 0; c < NCH; ++c) {
        const char* buf = lds + (c & 1) * SC_BUF;
        char* yb = (q == 0) ? (lds + SC_YB + (c & 1) * (33 * 256) + (cw * 16 + c16) * 4) : (lds + SC_DUMP + lane * 4);
        const int ystride = (q == 0) ? 256 : 0;
        ScCoef cur = sc_ld(buf, 0, arOff, wOff, bkOff, vOff);
#pragma unroll 1
        for (int half = 0; half < 2; ++half) {
#pragma unroll 4
          for (int tt = 0; tt < 16; ++tt) {
            const int t = half * 16 + tt;
            const ScCoef nxt = sc_ld(buf, t + 1, arOff, wOff, bkOff, vOff);
            u32x4 b1 = {cvtpk(St0[0], St0[1]), cvtpk(St0[2], St0[3]), cvtpk(St1[0], St1[1]), cvtpk(St1[2], St1[3])};
            u32x4 b2 = {cvtpk(St2[0], St2[1]), cvtpk(St2[2], St2[3]), cvtpk(St3[0], St3[1]), cvtpk(St3[2], St3[3])};
            f32x4 out = {0.f, 0.f, 0.f, 0.f};
            out = MFMA16(*(bf16x8*)&cur.a0, *(bf16x8*)&b1, out);
            out = MFMA16(*(bf16x8*)&cur.a1, *(bf16x8*)&b2, out);
            u32x4 bu = {q == 0 ? cvtpk(out[0], cur.vi) : 0u, 0u, 0u, 0u};
            St0 = MFMA16(*(bf16x8*)&cur.k0, *(bf16x8*)&bu, St0);
            St1 = MFMA16(*(bf16x8*)&cur.k1, *(bf16x8*)&bu, St1);
            St2 = MFMA16(*(bf16x8*)&cur.k2, *(bf16x8*)&bu, St2);
            St3 = MFMA16(*(bf16x8*)&cur.k3, *(bf16x8*)&bu, St3);
            *(float*)(yb + t * ystride) = out[1];
            cur = nxt;
          }
          if (half == 1) {
            u32x4 b1 = {cvtpk(St0[0], St0[1]), cvtpk(St0[2], St0[3]), cvtpk(St1[0], St1[1]), cvtpk(St1[2], St1[3])};
            u32x4 b2 = {cvtpk(St2[0], St2[1]), cvtpk(St2[2], St2[3]), cvtpk(St3[0], St3[1]), cvtpk(St3[2], St3[3])};
            f32x4 out = {0.f, 0.f, 0.f, 0.f};
            out = MFMA16(*(bf16x8*)&cur.a0, *(bf16x8*)&b1, out);
            out = MFMA16(*(bf16x8*)&cur.a1, *(bf16x8*)&b2, out);
            *(float*)(yb + 32 * ystride) = out[1];
            const char* pw = buf + SC_WD + 31 * 256 + wOff;
            St0 *= *(const f32x4*)(pw); St1 *= *(const f32x4*)(pw + 64); St2 *= *(const f32x4*)(pw + 128); St3 *= *(const f32x4*)(pw + 192);
          }
          __syncthreads();
        }
      }
    } else {
      const int pw = wid - 4, ptid = tid - 256;
      const int pstep = ptid >> 3, j0 = (ptid & 7) * 8;
      const int apos0 = (j0 >> 5) * 32 + (((j0 & 31) & 15) >> 2) * 8 + 4 * ((j0 & 31) >> 4), apos1 = apos0 + 8;
      float* Bg = (float*)(ws + OFF_BONUS) + (size_t)d * NTOK * 16;
      float kkc[8], kac[8], rkc[8];
#pragma unroll
      for (int e = 0; e < 8; ++e) { kkc[e] = p.in[15][h * 64 + j0 + e]; kac[e] = p.in[16][h * 64 + j0 + e]; rkc[e] = p.in[17][h * 64 + j0 + e]; }
      const int mat = pw >> 1, jh = pw & 1;
      bf16x8 w2f[4]; float bias;
      {
        const float* W2 = (mat ? p.in[14] : p.in[11]) + (size_t)d * 64 * 1024;
#pragma unroll
        for (int ks = 0; ks < 4; ++ks) {
          u32x4 w;
#pragma unroll
          for (int qq = 0; qq < 4; ++qq) {
            const int r0 = ks * 16 + 8 * hi + 2 * qq;
            w[qq] = cvtpk(W2[(size_t)r0 * 1024 + h * 64 + jh * 32 + r32], W2[(size_t)(r0 + 1) * 1024 + h * 64 + jh * 32 + r32]);
          }
          w2f[ks] = *(bf16x8*)&w;
        }
        bias = (mat ? p.in[12] : p.in[9])[d * 1024 + h * 64 + jh * 32 + r32];
      }
      u32x4 pR, pK, pV; bf16x8 pl[4];
      float kk[8], kr[8], rr[8];
      float* IC = (float*)(lds + SC_IC);
      auto prefetch = [&](int c) {
        const size_t row = (size_t)scan_row(c * 32 + pstep, d, b) * 1024 + h * 64 + j0;
        pR = *(const u32x4*)(Rg + row); pK = *(const u32x4*)(Kg + row); pV = *(const u32x4*)(Vg + row);
        const size_t lrow = (size_t)scan_row(c * 32 + r32, d, b);
#pragma unroll
        for (int ks = 0; ks < 4; ++ks) pl[ks] = *(const bf16x8*)(Lg + lrow * 256 + mat * 128 + d * 64 + ks * 16 + hi * 8);
      };
      auto stageA = [&](int c) {
        char* buf = lds + (c & 1) * SC_BUF;
        float* Wd = (float*)(buf + SC_WD); float* Vv = (float*)(buf + SC_VV); bf16_t* AR = (bf16_t*)(buf + SC_AR);
        f32x16 acc;
#pragma unroll
        for (int r = 0; r < 16; ++r) acc[r] = 0.f;
#pragma unroll
        for (int ks = 0; ks < 4; ++ks) acc = MFMA(pl[ks], w2f[ks], acc);
        if (mat == 0) {
          float c[16];
#pragma unroll
          for (int r = 0; r < 16; ++r) c[r] = -0.6065306597126334f * __builtin_amdgcn_rcpf(1.f + __expf(-(acc[r] + bias)));
#pragma unroll
          for (int g = 0; g < 4; ++g) { c[4 * g + 1] += c[4 * g]; c[4 * g + 2] += c[4 * g + 1]; c[4 * g + 3] += c[4 * g + 2]; }
          float run = 0.f;
#pragma unroll
          for (int g = 0; g < 4; ++g) {
            const float own = c[4 * g + 3];
            auto rr2 = __builtin_amdgcn_permlane32_swap(__float_as_uint(own), __float_as_uint(own), false, false);
            const float both = __uint_as_float(rr2[0]) + __uint_as_float(rr2[1]), partner = both - own;
            const float off = hi ? run + partner : run;
#pragma unroll
            for (int e = 0; e < 4; ++e) Wd[crow(4 * g + e, hi) * 64 + jh * 32 + r32] = __expf(off + c[4 * g + e]);
            run += both;
          }
        } else {
#pragma unroll
          for (int r = 0; r < 16; ++r) IC[crow(r, hi) * 64 + jh * 32 + r32] = __builtin_amdgcn_rcpf(1.f + __expf(-(acc[r] + bias)));
        }
        float ss = 0.f;
#pragma unroll
        for (int w = 0; w < 4; ++w) {
          rr[2 * w] = lo16(pR[w]); rr[2 * w + 1] = hi16(pR[w]);
          kr[2 * w] = lo16(pK[w]); kr[2 * w + 1] = hi16(pK[w]);
        }
        f32x4 v0 = {lo16(pV[0]), hi16(pV[0]), lo16(pV[1]), hi16(pV[1])}, v1 = {lo16(pV[2]), hi16(pV[2]), lo16(pV[3]), hi16(pV[3])};
        *(f32x4*)(Vv + pstep * 64 + j0) = v0; *(f32x4*)(Vv + pstep * 64 + j0 + 4) = v1;
#pragma unroll
        for (int e = 0; e < 8; ++e) { kk[e] = kr[e] * kkc[e]; ss += kk[e] * kk[e]; }
        ss = red8(ss);
        const float inv = rsqrtf(fmaxf(ss, 1e-24f));
#pragma unroll
        for (int e = 0; e < 8; ++e) kk[e] *= inv;
      };
      auto stageB = [&](int c) {
        char* buf = lds + (c & 1) * SC_BUF;
        u32x4* BK = (u32x4*)(buf + SC_BK); bf16_t* AR = (bf16_t*)(buf + SC_AR);
        const f32x4 i0 = *(const f32x4*)(IC + pstep * 64 + j0), i1 = *(const f32x4*)(IC + pstep * 64 + j0 + 4);
        const float ic[8] = {i0[0], i0[1], i0[2], i0[3], i1[0], i1[1], i1[2], i1[3]};
        const float* Pt = (const float*)(buf + SC_WD) + pstep * 64 + j0;
        const f32x4 pt0 = *(const f32x4*)(Pt), pt1 = *(const f32x4*)(Pt + 4);
        f32x4 pm0 = {1.f, 1.f, 1.f, 1.f}, pm1 = pm0;
        if (pstep > 0) { pm0 = *(const f32x4*)(Pt - 64); pm1 = *(const f32x4*)(Pt - 60); }
        const float pt[8] = {pt0[0], pt0[1], pt0[2], pt0[3], pt1[0], pt1[1], pt1[2], pt1[3]};
        const float pm[8] = {pm0[0], pm0[1], pm0[2], pm0[3], pm1[0], pm1[1], pm1[2], pm1[3]};
        { u32x2 lo = {cvtpk(-kk[0] * pm[0], -kk[1] * pm[1]), cvtpk(-kk[2] * pm[2], -kk[3] * pm[3])}, hi2 = {cvtpk(-kk[4] * pm[4], -kk[5] * pm[5]), cvtpk(-kk[6] * pm[6], -kk[7] * pm[7])};
          *(u32x2*)(AR + pstep * 128 + apos0) = lo; *(u32x2*)(AR + pstep * 128 + apos1) = hi2; }
        { u32x2 lo = {cvtpk(rr[0] * pt[0], rr[1] * pt[1]), cvtpk(rr[2] * pt[2], rr[3] * pt[3])}, hi2 = {cvtpk(rr[4] * pt[4], rr[5] * pt[5]), cvtpk(rr[6] * pt[6], rr[7] * pt[7])};
          *(u32x2*)(AR + (pstep + 1) * 128 + 64 + apos0) = lo; *(u32x2*)(AR + (pstep + 1) * 128 + 64 + apos1) = hi2; }
        float bs = 0.f;
#pragma unroll
        for (int e = 0; e < 8; ++e) {
          const float kd = kr[e] * (1.f + (ic[e] - 1.f) * kac[e]);
          const float ip = __builtin_amdgcn_rcpf(pt[e]);
          u32x4 slot = {cvtpk(kk[e] * ic[e] * ip, kd * ip), 0u, 0u, 0u};
          BK[pstep * 64 + j0 + e] = slot;
          bs += rr[e] * kd * rkc[e];
        }
        bs = red8(bs);
        if ((ptid & 7) == 0) Bg[(size_t)scan_row(c * 32 + pstep, d, b) * 16 + h] = bs;
      };
      auto writeout = [&](int c) {
        const float* Yb = (const float*)(lds + SC_YB + (c & 1) * (33 * 256)) + (pstep + 1) * 64 + j0;
        const f32x4 y0 = *(const f32x4*)(Yb), y1 = *(const f32x4*)(Yb + 4);
        u32x4 w = {cvtpk(y0[0], y0[1]), cvtpk(y0[2], y0[3]), cvtpk(y1[0], y1[1]), cvtpk(y1[2], y1[3])};
        *(u32x4*)(Yg + (size_t)scan_row(c * 32 + pstep, d, b) * 1024 + h * 64 + j0) = w;
      };
      prefetch(0);
      stageA(0);
      __syncthreads();
      stageB(0);
      prefetch(1);
      __syncthreads();
      for (int c = 0; c < NCH; ++c) {
        if (c >= 1) writeout(c - 1);
        if (c + 1 < NCH) stageA(c + 1);
        __syncthreads();
        if (c + 1 < NCH) { stageB(c + 1); if (c + 2 < NCH) prefetch(c + 2); }
        __syncthreads();
      }
      writeout(NCH - 1);
    }
    __syncthreads();
  }
}

__device__ void phase_readout(const Params& p) {
  unsigned char* ws = p.ws;
  const bf16_t* Y0 = (const bf16_t*)(ws + OFF_Y0); const bf16_t* Y1 = (const bf16_t*)(ws + OFF_Y1); const bf16_t* Vg = (const bf16_t*)(ws + OFF_V);
  bf16_t* G = (bf16_t*)(ws + OFF_G);
  const float* B0 = (const float*)(ws + OFF_BONUS); const float* B1 = B0 + (size_t)NTOK * 16;
  const int lane = threadIdx.x & 63, gw = blockIdx.x * 8 + (threadIdx.x >> 6), nw = gridDim.x * 8;
  const int c0 = lane * 16, hd = lane >> 2;
  float lg[16], lb[16];
#pragma unroll
  for (int e = 0; e < 16; ++e) { lg[e] = p.in[18][c0 + e]; lb[e] = p.in[19][c0 + e]; }
  struct RowIn { u32x4 a[2], b[2], v[2], g[2]; float b0, b1; };
  auto ldr = [&](int n, RowIn& r) {
    const size_t o = (size_t)n * 1024 + c0;
#pragma unroll
    for (int q = 0; q < 2; ++q) { r.a[q] = *(const u32x4*)(Y0 + o + 8 * q); r.b[q] = *(const u32x4*)(Y1 + o + 8 * q); r.v[q] = *(const u32x4*)(Vg + o + 8 * q); r.g[q] = *(const u32x4*)(G + o + 8 * q); }
    r.b0 = B0[(size_t)n * 16 + hd]; r.b1 = B1[(size_t)n * 16 + hd];
  };
  RowIn cur, nxt;
  if (gw < NTOK) ldr(gw, cur);
  for (int n = gw; n < NTOK; n += nw) {
    if (n + nw < NTOK) ldr(n + nw, nxt);
    const size_t o = (size_t)n * 1024 + c0;
    float y[16], v[16], g[16];
#pragma unroll
    for (int q = 0; q < 2; ++q) {
#pragma unroll
      for (int w = 0; w < 4; ++w) {
        y[8 * q + 2 * w] = lo16(cur.a[q][w]) + lo16(cur.b[q][w]); y[8 * q + 2 * w + 1] = hi16(cur.a[q][w]) + hi16(cur.b[q][w]);
        v[8 * q + 2 * w] = lo16(cur.v[q][w]); v[8 * q + 2 * w + 1] = hi16(cur.v[q][w]);
        g[8 * q + 2 * w] = lo16(cur.g[q][w]); g[8 * q + 2 * w + 1] = hi16(cur.g[q][w]);
      }
    }
    float s = 0.f;
#pragma unroll
    for (int e = 0; e < 16; ++e) s += y[e];
    s += dpp_f(s, 0); s += dpp_f(s, 1);
    const float mean = s * (1.f / 64.f);
    float q2 = 0.f;
#pragma unroll
    for (int e = 0; e < 16; ++e) { const float dlt = y[e] - mean; q2 += dlt * dlt; }
    q2 += dpp_f(q2, 0); q2 += dpp_f(q2, 1);
    const float rs = rsqrtf(q2 * (1.f / 64.f) + 64e-5f);
    const float bonus = cur.b0 + cur.b1;
    float r[16];
#pragma unroll
    for (int e = 0; e < 16; ++e) {
      const float yn = (y[e] - mean) * rs * lg[e] + lb[e];
      r[e] = (yn + bonus * v[e]) * (g[e] * sigmoidf_(g[e]));
    }
    u32x4 w0 = {cvtpk(r[0], r[1]), cvtpk(r[2], r[3]), cvtpk(r[4], r[5]), cvtpk(r[6], r[7])};
    u32x4 w1 = {cvtpk(r[8], r[9]), cvtpk(r[10], r[11]), cvtpk(r[12], r[13]), cvtpk(r[14], r[15])};
    *(u32x4*)(G + o) = w0; *(u32x4*)(G + o + 8) = w1;
    cur = nxt;
  }
}

constexpr int AT_SHMV = 16384, AT_KROW = 208, AT_SHMK = 64 * AT_KROW;
constexpr int AT_KOFF = 2 * AT_SHMV, AT_WOFF = AT_KOFF + 2 * AT_SHMK;
#define SBAR() __builtin_amdgcn_sched_barrier(0)
__device__ __forceinline__ void at_partialSM(f32x16& p0, f32x16& p1, float& m_reg, float& alpha, bool force) {
  float pm = p0[0];
#pragma unroll
  for (int r = 1; r < 16; ++r) pm = fmaxf(pm, p0[r]);
#pragma unroll
  for (int r = 0; r < 16; ++r) pm = fmaxf(pm, p1[r]);
  { auto rr = __builtin_amdgcn_permlane32_swap(__float_as_uint(pm), __float_as_uint(pm), false, false);
    pm = fmaxf(__uint_as_float(rr[0]), __uint_as_float(rr[1])); }
  if (__builtin_expect(!force && __all(pm <= AT_THR * 1.4426950408889634f), 1)) { alpha = 1.f; }
  else {
    const float dlt = force ? pm : fmaxf(pm, 0.f);
    alpha = force ? 1.f : __builtin_amdgcn_exp2f(-dlt); m_reg += dlt;
#pragma unroll
    for (int r = 0; r < 16; ++r) { p0[r] -= dlt; p1[r] -= dlt; }
  }
#pragma unroll
  for (int r = 0; r < 16; ++r) p0[r] = __builtin_amdgcn_exp2f(p0[r]);
}
__device__ __forceinline__ void at_finishSM(f32x16& p0, f32x16& p1, float alpha, float& l_reg, bf16x8& pa0, bf16x8& pa1, bf16x8& pa2, bf16x8& pa3) {
#pragma unroll
  for (int r = 0; r < 16; ++r) p1[r] = __builtin_amdgcn_exp2f(p1[r]);
  float ps = 0;
#pragma unroll
  for (int r = 0; r < 16; ++r) ps += p0[r];
#pragma unroll
  for (int r = 0; r < 16; ++r) ps += p1[r];
  { auto rr = __builtin_amdgcn_permlane32_swap(__float_as_uint(ps), __float_as_uint(ps), false, false);
    ps = __uint_as_float(rr[0]) + __uint_as_float(rr[1]); }
  l_reg = l_reg * alpha + ps;
#define PK4(P, BASE, OUT) do { unsigned a0 = cvtpk(P[BASE + 0], P[BASE + 1]), a1 = cvtpk(P[BASE + 2], P[BASE + 3]);   \
    unsigned b0 = cvtpk(P[BASE + 4], P[BASE + 5]), b1 = cvtpk(P[BASE + 6], P[BASE + 7]);                              \
    auto r0 = __builtin_amdgcn_permlane32_swap(a0, b0, false, false); auto r1 = __builtin_amdgcn_permlane32_swap(a1, b1, false, false); \
    u32x4 w = {r0[0], r1[0], r0[1], r1[1]}; OUT = *reinterpret_cast<bf16x8*>(&w); } while (0)
  PK4(p0, 0, pa0); PK4(p0, 8, pa1); PK4(p1, 0, pa2); PK4(p1, 8, pa3);
#undef PK4
}
__device__ __forceinline__ void at_qkt(f32x16& p0, f32x16& p1, const char* Ks, const bf16x8* qr, int r32, int hi, float negm) {
#pragma unroll
  for (int r = 0; r < 16; ++r) { p0[r] = negm; p1[r] = negm; }
#pragma unroll
  for (int d0 = 0; d0 < 6; ++d0) {
    const bf16x8 b0 = *(const bf16x8*)(Ks + r32 * AT_KROW + d0 * 32 + hi * 16);
    const bf16x8 b1 = *(const bf16x8*)(Ks + (32 + r32) * AT_KROW + d0 * 32 + hi * 16);
    p0 = MFMA(b0, qr[d0], p0);
    p1 = MFMA(b1, qr[d0], p1);
  }
}
__device__ __forceinline__ int v_st(int k, int c) { const int kk = (k & ~0xC) | ((k & 4) << 1) | ((k & 8) >> 1); return ((kk >> 3) * 4 + (c >> 5)) * 512 + ((kk & 7) * 32 + (c & 31)) * 2; }
__device__ __forceinline__ int v_rd_base(int lane) { return ((lane & 3) << 3) | (((lane >> 2) & 3) << 6) | (((lane >> 4) & 1) << 5) | (((lane >> 5) & 1) << 8); }
constexpr int v_rd_off(int d0, int ks, int half) { return d0 * 512 + ks * 4096 + half * 2048; }
template <int OFF> __device__ __forceinline__ s16x4 tr_read(int vb) {
  s16x4 r; asm volatile("ds_read_b64_tr_b16 %0, %1 offset:%2" : "=&v"(r) : "v"(vb), "i"(OFF) : "memory"); return r;
}
template <int D0> __device__ __forceinline__ void pv_one(f32x16& od, int vb, bf16x8 pa0, bf16x8 pa1, bf16x8 pa2, bf16x8 pa3) {
  const s16x4 l0 = tr_read<v_rd_off(D0, 0, 0)>(vb), h0 = tr_read<v_rd_off(D0, 0, 1)>(vb), l1 = tr_read<v_rd_off(D0, 1, 0)>(vb), h1 = tr_read<v_rd_off(D0, 1, 1)>(vb);
  const s16x4 l2 = tr_read<v_rd_off(D0, 2, 0)>(vb), h2 = tr_read<v_rd_off(D0, 2, 1)>(vb), l3 = tr_read<v_rd_off(D0, 3, 0)>(vb), h3 = tr_read<v_rd_off(D0, 3, 1)>(vb);
  asm volatile("s_waitcnt lgkmcnt(0)" ::: "memory"); SBAR();
#define PK(Lx, Hx) (bf16x8){Lx[0], Lx[1], Lx[2], Lx[3], Hx[0], Hx[1], Hx[2], Hx[3]}
  od = MFMA(pa0, PK(l0, h0), od);
  od = MFMA(pa1, PK(l1, h1), od);
  od = MFMA(pa2, PK(l2, h2), od);
  od = MFMA(pa3, PK(l3, h3), od);
#undef PK
}
__device__ __forceinline__ void pv_d0(f32x16* o, int vb, bf16x8 pa0, bf16x8 pa1, bf16x8 pa2, bf16x8 pa3) {
  pv_one<0>(o[0], vb, pa0, pa1, pa2, pa3); pv_one<1>(o[1], vb, pa0, pa1, pa2, pa3);
}

__device__ void phase_attn(const Params& p, char* lds) {
  unsigned char* ws = p.ws;
  const bf16_t* Qg = (const bf16_t*)(ws + OFF_Q); const bf16_t* KVg = (const bf16_t*)(ws + OFF_KV); const bf16_t* KPg = (const bf16_t*)(ws + OFF_KPE);
  bf16_t* G1 = (bf16_t*)(ws + OFF_G1);
  const f32x2* rope = (const f32x2*)(ws + OFF_ROPE);
  const int tid = threadIdx.x, wid = tid >> 6, lane = tid & 63, r32 = lane & 31, hi = lane >> 5;
  char* V_lds = lds; char* K_lds = lds + AT_KOFF;
  float* wsl = (float*)(lds + AT_WOFF) + wid * 64; float* li_l = wsl; float* al_l = wsl + 32;
  const int skey = tid >> 3, sc8 = (tid & 7) * 8;
  const int pkey = (tid & 255) >> 2, pc8 = (tid & 3) * 8;
  const int vst = v_st(skey, sc8), kst = skey * AT_KROW + sc8 * 2, pst = pkey * AT_KROW + (64 + pc8) * 2;
  const int vb0 = (int)(uintptr_t)V_lds + v_rd_base(lane);
  const int nitems = NB * 16 * 32;
  const int xcd = blockIdx.x & 7, slot = blockIdx.x >> 3, per = gridDim.x >> 3;
  for (int it = slot; it < nitems / 8; it += per) {
    const int pair = (it >> 5) * 8 + xcd, qblk = it & 31;
    const int b = pair >> 4, h = pair & 15;
    const size_t row0 = (size_t)b * TL;
    const size_t qrow = row0 + qblk * 256 + wid * 32 + r32;
    const bf16_t* Kh = KVg + row0 * 2048 + h * 128;
    const bf16_t* Kp = KPg + row0 * 32;
    float m_reg = 0.f, l_reg = 0.f;
    f32x16 o[2];
#pragma unroll
    for (int dd = 0; dd < 2; ++dd)
#pragma unroll
      for (int r = 0; r < 16; ++r) o[dd][r] = 0.f;
    bf16x8 qr[6];
    {
      const bf16_t* Qw = Qg + qrow * 1536 + h * 96 + hi * 8;
#pragma unroll
      for (int d0 = 0; d0 < 6; ++d0) qr[d0] = *(const bf16x8*)(Qw + d0 * 16);
      const int t = qblk * 256 + wid * 32 + r32;
      const f32x2* tb = rope + (hi ? (t & 63) : (t >> 6)) * 8;
      const u32x4 x1 = *(const u32x4*)&qr[4], x2 = *(const u32x4*)&qr[5];
      u32x4 n1, n2;
#pragma unroll
      for (int q = 0; q < 4; ++q) {
        const f32x2 csA = tb[2 * q], csB = tb[2 * q + 1];
        const float a0 = lo16(x1[q]), a1 = hi16(x1[q]), b0 = lo16(x2[q]), b1 = hi16(x2[q]);
        n1[q] = cvtpk(a0 * csA[0] - b0 * csA[1], a1 * csB[0] - b1 * csB[1]);
        n2[q] = cvtpk(a0 * csA[1] + b0 * csA[0], a1 * csB[1] + b1 * csB[0]);
      }
      qr[4] = *(bf16x8*)&n1; qr[5] = *(bf16x8*)&n2;
    }
    struct { bf16x8 vs, ks, ps; } sr_[2];
#define SLOAD(i, k0) do { sr_[i].vs = *(const bf16x8*)(Kh + (size_t)((k0) + skey) * 2048 + 64 + sc8); \
    sr_[i].ks = *(const bf16x8*)(Kh + (size_t)((k0) + skey) * 2048 + sc8); \
    sr_[i].ps = *(const bf16x8*)(Kp + (size_t)((k0) + pkey) * 32 + pc8); } while (0)
#define SWRITE(bb, i) do { *(bf16x8*)(V_lds + (bb) * AT_SHMV + vst) = sr_[i].vs; \
    *(bf16x8*)(K_lds + (bb) * AT_SHMK + kst) = sr_[i].ks; \
    *(bf16x8*)(K_lds + (bb) * AT_SHMK + pst) = sr_[i].ps; } while (0)
#define SWAIT() asm volatile("s_waitcnt vmcnt(3)" ::: "memory")
#define RESC(a) do { if (__any((a) < 1.f)) { if (hi == 0) al_l[r32] = (a); asm volatile("s_waitcnt lgkmcnt(0)" ::: "memory"); \
    _Pragma("unroll") for (int dd = 0; dd < 2; ++dd) _Pragma("unroll") for (int r = 0; r < 16; ++r) o[dd][r] *= al_l[crow(r, hi)]; } } while (0)
    f32x16 pA0, pA1, pB0, pB1; float alA, alB; bf16x8 pa0, pa1, pa2, pa3;
    constexpr int NT = TL / 64;
    SLOAD(0, 0); asm volatile("s_waitcnt vmcnt(0)" ::: "memory"); SWRITE(0, 0); __syncthreads();
    at_qkt(pA0, pA1, K_lds, qr, r32, hi, 0.f); at_partialSM(pA0, pA1, m_reg, alA, true);
    SLOAD(1, 64); SLOAD(0, 128);
    SWAIT(); SWRITE(1, 1); __syncthreads();
    for (int j = 1; j + 1 < NT; j += 2) {
      SBAR(); at_qkt(pB0, pB1, K_lds + AT_SHMK, qr, r32, hi, -m_reg);
      at_finishSM(pA0, pA1, alA, l_reg, pa0, pa1, pa2, pa3); SBAR();
      SLOAD(1, (j + 2) * 64); SBAR();
      pv_d0(o, vb0, pa0, pa1, pa2, pa3); at_partialSM(pB0, pB1, m_reg, alB, false);
      __syncthreads(); SWAIT(); SWRITE(0, 0);
      RESC(alB); __syncthreads();
      SBAR(); at_qkt(pA0, pA1, K_lds, qr, r32, hi, -m_reg);
      at_finishSM(pB0, pB1, alB, l_reg, pa0, pa1, pa2, pa3); SBAR();
      if (j + 3 < NT) SLOAD(0, (j + 3) * 64); SBAR();
      pv_d0(o, vb0 + AT_SHMV, pa0, pa1, pa2, pa3); at_partialSM(pA0, pA1, m_reg, alA, false);
      __syncthreads(); SWAIT(); SWRITE(1, 1);
      RESC(alA); __syncthreads();
    }
    SBAR(); at_qkt(pB0, pB1, K_lds + AT_SHMK, qr, r32, hi, -m_reg);
    at_finishSM(pA0, pA1, alA, l_reg, pa0, pa1, pa2, pa3); SBAR();
    pv_d0(o, vb0, pa0, pa1, pa2, pa3); at_partialSM(pB0, pB1, m_reg, alB, false);
    __syncthreads(); RESC(alB);
    at_finishSM(pB0, pB1, alB, l_reg, pa0, pa1, pa2, pa3); SBAR();
    pv_d0(o, vb0 + AT_SHMV, pa0, pa1, pa2, pa3);
    if (hi == 0) li_l[r32] = l_reg;
    asm volatile("s_waitcnt lgkmcnt(0)" ::: "memory");
    float rli[16];
#pragma unroll
    for (int r = 0; r < 16; ++r) rli[r] = __builtin_amdgcn_rcpf(li_l[crow(r, hi)]);
    bf16_t* Gw = G1 + (row0 + qblk * 256 + wid * 32) * 1024 + h * 64 + r32;
    bf16_t gin[32];
#pragma unroll
    for (int r = 0; r < 16; ++r) { gin[2 * r] = Gw[(size_t)crow(r, hi) * 1024]; gin[2 * r + 1] = Gw[(size_t)crow(r, hi) * 1024 + 32]; }
    asm volatile("" ::: "memory");
#pragma unroll
    for (int r = 0; r < 16; ++r) {
      const int orow = crow(r, hi);
#pragma unroll
      for (int d0 = 0; d0 < 2; ++d0) {
        const float gt = bf2f(gin[2 * r + d0]);
        Gw[(size_t)orow * 1024 + d0 * 32] = f2bf(o[d0][r] * rli[r] * gt * sigmoidf_(gt));
      }
    }
    __syncthreads();
#undef SLOAD
#undef SWRITE
#undef SWAIT
#undef RESC
  }
}

struct XcdWalk {
  int start, count, step, idx;
  __device__ __forceinline__ void init(int ntiles) {
    const int x = blockIdx.x & 7, base = ntiles >> 3, rem = ntiles & 7;
    count = base + (x < rem ? 1 : 0); start = x * base + (x < rem ? x : rem); step = gridDim.x >> 3; idx = blockIdx.x >> 3;
  }
  __device__ __forceinline__ bool next(int& o) { if (idx >= count) return false; o = start + idx; idx += step; return true; }
};
__device__ __forceinline__ void tile_mn(int o, int NT, int& mt, int& nt) { const int g = o >> 3; mt = (g / NT) * 8 + (o & 7); nt = g % NT; }

__global__ __launch_bounds__(NTHR, 1) void fwd_megakernel(Params p) {
  extern __shared__ __attribute__((aligned(16))) char lds[];
  cg::grid_group grid = cg::this_grid();
  unsigned char* ws = p.ws;
  bf16_t* H = (bf16_t*)(ws + OFF_H);
  float* mod = (float*)(ws + OFF_MOD);
  float* CTX1 = (float*)(ws + OFF_CTX1);

  phase_prologue(p, lds);
  grid.sync();
  phase_norm_lerp(p, mod);
  phase_weights(p, lds);
  grid.sync();
  {
    const bf16_t* WIN0 = (const bf16_t*)(ws + OFF_WIN0);
    const int nbig = 264 * 16;
    XcdWalk wk; wk.init(nbig); int o;
    while (wk.next(o)) {
      EpiBf16 e; e.invK = 0.f;
      {
        int mt, jn; tile_mn(o, 16, mt, jn);
        const int j = jn >> 2, n4 = jn & 3, m0 = mt * 256;
        e.dst = (bf16_t*)(ws + OFF_R + (size_t)j * U); e.ldd = 1024; e.col0 = n4 * 256; e.act = 0; e.m0 = m0;
        gemm_tile<0, 256>(lerp_base(p, j, m0), 1024, WIN0 + (size_t)(j * 1024 + n4 * 256) * 1024, 1024, m0, nullptr, lds, e);
      }
    }
    wk.init(264 * 2);
    while (wk.next(o)) {
      EpiBf16 e; e.invK = 0.f;
      {
        int mt, n2; tile_mn(o, 2, mt, n2);
        const int nt = 32 + n2, m0 = mt * 256;
        e.dst = (bf16_t*)(ws + OFF_LORA); e.ldd = 256; e.col0 = (nt - 32) * 128; e.act = (nt == 32) ? 1 : 0; e.m0 = m0;
        gemm_tile<1, 128>(H, 1024, WIN0 + (size_t)nt * 128 * 1024, 1024, m0, p.in[7] + (nt - 28) * 1024, lds, e);
      }
    }
  }
  grid.sync();
  phase_scan(p, lds);
  grid.sync();
  phase_readout(p);
  grid.sync();
  {
    const bf16_t* A = (const bf16_t*)(ws + OFF_G); const bf16_t* W = (const bf16_t*)(ws + OFF_WOUT0);
    XcdWalk wk; wk.init(264 * 4); int o;
    while (wk.next(o)) {
      int mt, nt; tile_mn(o, 4, mt, nt);
      const int m0 = mt * 256;
      const int b = m0 / TL, t0 = m0 - b * TL;
      EpiResid e;
      if (t0 < T) { const size_t orow = (size_t)b * T + t0; e.xin = p.in[0] + orow * 1024; e.xout = p.out + orow * 1024; e.gvec = mod + (size_t)b * 3072 + 2048; }
      else { const size_t orow = (size_t)b * L + (t0 - T); e.xin = p.in[2] + orow * 1024; e.xout = CTX1 + orow * 1024; e.gvec = mod + (size_t)8 * 3072 + 2048; }
      e.n0 = nt * 256;
      gemm_tile<0, 256>(A, 1024, W + (size_t)nt * 256 * 1024, 1024, m0, nullptr, lds, e);
    }
  }
  grid.sync();
  phase_norm(p.out, CTX1, p.in[4] + 1024, mod + 9 * 3072, H);
  grid.sync();
  {
    const bf16_t* W = (const bf16_t*)(ws + OFF_WIN1);
    XcdWalk wk; wk.init(264 * 7); int o;
    while (wk.next(o)) {
      int mt, nt; tile_mn(o, 7, mt, nt);
      const int m0 = mt * 256;
      EpiMlaIn e; e.QC = (bf16_t*)(ws + OFF_QC); e.KVC = (bf16_t*)(ws + OFF_KVC); e.KPE = (bf16_t*)(ws + OFF_KPE); e.G1 = (bf16_t*)(ws + OFF_G1);
      e.rope = (const float*)(ws + OFF_ROPE); e.n0 = nt * 256; e.m0 = m0;
      gemm_tile<0, 256>(H, 1024, W + (size_t)nt * 256 * 1024, 1024, m0, nullptr, lds, e);
    }
  }
  grid.sync();
  {
    const bf16_t* WQ = (const bf16_t*)(ws + OFF_WQB); const bf16_t* WKV = (const bf16_t*)(ws + OFF_WKVB);
    const int nq = 256 * 6, nkv = 264 * 8;
    XcdWalk wk; wk.init(nq); int o;
    while (wk.next(o)) {
      EpiBf16 e; e.act = 0;
      {
        int mt2, nt; tile_mn(o, 6, mt2, nt);
        const int b = mt2 >> 5, m0 = b * TL + (mt2 & 31) * 256;
        e.dst = (bf16_t*)(ws + OFF_Q); e.ldd = 1536; e.col0 = nt * 256; e.m0 = m0; e.invK = 1.f / 384.f;
        gemm_tile<2, 256>((const bf16_t*)(ws + OFF_QC), 384, WQ + (size_t)nt * 256 * 384, 384, m0, nullptr, lds, e);
      }
    }
    wk.init(nkv);
    while (wk.next(o)) {
      EpiBf16 e; e.act = 0;
      {
        int mt, nt; tile_mn(o, 8, mt, nt);
        const int m0 = mt * 256;
        e.dst = (bf16_t*)(ws + OFF_KV); e.ldd = 2048; e.col0 = nt * 256; e.m0 = m0; e.invK = 1.f / 256.f;
        gemm_tile<2, 256>((const bf16_t*)(ws + OFF_KVC), 256, WKV + (size_t)nt * 256 * 256, 256, m0, nullptr, lds, e);
      }
    }
  }
  grid.sync();
  phase_attn(p, lds);
  grid.sync();
  {
    const bf16_t* A = (const bf16_t*)(ws + OFF_G1); const bf16_t* W = (const bf16_t*)(ws + OFF_WOUT1);
    XcdWalk wk; wk.init(256 * 4); int o;
    while (wk.next(o)) {
      int mt2, nt; tile_mn(o, 4, mt2, nt);
      const int b = mt2 >> 5, t0 = (mt2 & 31) * 256, m0 = b * TL + t0;
      const size_t orow = (size_t)b * T + t0;
      EpiResid e; e.xin = p.out + orow * 1024; e.xout = p.out + orow * 1024; e.gvec = mod + (size_t)(9 + b) * 3072 + 2048; e.n0 = nt * 256;
      gemm_tile<0, 256>(A, 1024, W + (size_t)nt * 256 * 1024, 1024, m0, nullptr, lds, e);
    }
  }
  grid.sync();
  phase_final(p.out, p.in[27]);
}

extern "C" void kernel_launch(void* const* d_in, const int* in_sizes, int n_in, void* d_out, int out_size, void* d_ws, size_t ws_size, hipStream_t stream) {
  static int grid_blocks = 0;
  if (grid_blocks == 0) {
    if (n_in != 28 || ws_size < WS_END + (size_t)(NTOK - LERP3_SPLIT) * 2048 || out_size != NB * T * D) { fprintf(stderr, "kernel_launch: unexpected shapes (n_in %d, ws %zu need %zu, out %d)\n", n_in, ws_size, (size_t)WS_END, out_size); grid_blocks = -1; return; }
    int dev = 0, cus = 0, per_cu = 0;
    hipGetDevice(&dev);
    hipDeviceGetAttribute(&cus, hipDeviceAttributeMultiprocessorCount, dev);
    if (hipFuncSetAttribute((const void*)fwd_megakernel, hipFuncAttributeMaxDynamicSharedMemorySize, LDS_BYTES) != hipSuccess) { fprintf(stderr, "kernel_launch: hipFuncSetAttribute failed\n"); grid_blocks = -1; return; }
    hipOccupancyMaxActiveBlocksPerMultiprocessor(&per_cu, (const void*)fwd_megakernel, NTHR, LDS_BYTES);
    if (per_cu < 1) { fprintf(stderr, "kernel_launch: occupancy query says %d blocks per CU\n", per_cu); per_cu = 1; }
    (void)hipGetLastError();
    grid_blocks = cus;
    if (grid_blocks > 256) grid_blocks = 256;
    grid_blocks &= ~7;
  }
  if (grid_blocks <= 0) return;
  Params p{};
  for (int i = 0; i < 28; ++i) p.in[i] = (const float*)d_in[i];
  p.out = (float*)d_out; p.ws = (unsigned char*)d_ws;
  void* args[] = {&p};
  hipError_t e = hipLaunchCooperativeKernel((const void*)fwd_megakernel, dim3(grid_blocks), dim3(NTHR), args, LDS_BYTES, stream);
  if (e != hipSuccess) fprintf(stderr, "cooperative launch failed: %s (grid %d)\n", hipGetErrorString(e), grid_blocks);
}
```

```cpp
#include <hip/hip_runtime.h>
#include <hip/hip_cooperative_groups.h>
#include <cstdio>
#include <cstdint>
namespace cg = cooperative_groups;

typedef unsigned short bf16_t;
typedef short bf16x8 __attribute__((ext_vector_type(8)));
typedef short s16x4 __attribute__((ext_vector_type(4)));
typedef float f32x16 __attribute__((ext_vector_type(16)));
typedef float f32x4 __attribute__((ext_vector_type(4)));
typedef float f32x2 __attribute__((ext_vector_type(2)));
typedef unsigned u32x4 __attribute__((ext_vector_type(4)));
typedef unsigned u32x2 __attribute__((ext_vector_type(2)));

constexpr int D = 1024, NB = 8, T = 8192, L = 256, TL = T + L, NTOK = NB * TL;
constexpr int NTHR = 512;

constexpr size_t U = (size_t)NTOK * 1024 * 2;
constexpr size_t OFF_H = 0, OFF_R = U, OFF_K = 2 * U, OFF_V = 3 * U, OFF_G = 4 * U, OFF_Y0 = 5 * U, OFF_Y1 = 6 * U;
constexpr size_t OFF_LORA = 7 * U;
constexpr size_t OFF_BONUS = OFF_LORA + (size_t)NTOK * 256 * 2;
constexpr size_t OFF_WIN0 = OFF_BONUS + (size_t)2 * NTOK * 16 * 4;
constexpr size_t OFF_WOUT0 = OFF_WIN0 + (size_t)4352 * 1024 * 2;
constexpr size_t OFF_WIN1 = OFF_WOUT0 + (size_t)1024 * 1024 * 2;
constexpr size_t OFF_WQB = OFF_WIN1 + (size_t)1792 * 1024 * 2;
constexpr size_t OFF_WKVB = OFF_WQB + (size_t)1536 * 384 * 2;
constexpr size_t OFF_WOUT1 = OFF_WKVB + (size_t)2048 * 256 * 2;
constexpr size_t OFF_MOD = OFF_WOUT1 + (size_t)1024 * 1024 * 2;
constexpr size_t OFF_ROPE = OFF_MOD + (size_t)2 * 9 * 3072 * 4;
constexpr size_t OFF_CTX1 = OFF_ROPE + (size_t)128 * 8 * 2 * 4;
constexpr size_t WS_END = OFF_CTX1 + (size_t)2048 * 1024 * 4;
constexpr size_t OFF_QC = OFF_V;
constexpr size_t OFF_KVC = OFF_QC + (size_t)NTOK * 384 * 2;
constexpr size_t OFF_KPE = OFF_KVC + (size_t)NTOK * 256 * 2;
constexpr size_t OFF_G1 = OFF_G;
constexpr size_t OFF_Q = OFF_R;
constexpr size_t OFF_KV = OFF_Y0;

struct Params { const float* in[28]; float* out; unsigned char* ws; };

typedef __bf16 bf16x2_t __attribute__((ext_vector_type(2)));
__device__ __forceinline__ unsigned cvtpk(float lo, float hi) { f32x2 v = {lo, hi}; bf16x2_t b = __builtin_convertvector(v, bf16x2_t); return *(unsigned*)&b; }
__device__ __forceinline__ float bf2f(bf16_t u) { return __uint_as_float(((unsigned)u) << 16); }
__device__ __forceinline__ bf16_t f2bf(float f) { return (bf16_t)(cvtpk(f, 0.f) & 0xffffu); }
__device__ __forceinline__ float lo16(unsigned w) { return __uint_as_float(w << 16); }
__device__ __forceinline__ float hi16(unsigned w) { return __uint_as_float(w & 0xffff0000u); }
__device__ __forceinline__ void st_bf16x4(bf16_t* p, float a, float b, float c, float d) { u32x2 w = {cvtpk(a, b), cvtpk(c, d)}; *(u32x2*)p = w; }
__device__ __forceinline__ void st_bf16x4_nt(bf16_t* p, float a, float b, float c, float d) { u32x2 w = {cvtpk(a, b), cvtpk(c, d)}; __builtin_nontemporal_store(w, (u32x2*)p); }
__device__ __forceinline__ float wave_sum(float v) {
#pragma unroll
  for (int o = 32; o; o >>= 1) v += __shfl_xor(v, o);
  return v;
}
__device__ __forceinline__ float dpp_f(float v, const int ctrl_sel) {
  int r;
  if (ctrl_sel == 0) r = __builtin_amdgcn_update_dpp(0, __float_as_int(v), 0xB1, 0xF, 0xF, true);
  else if (ctrl_sel == 1) r = __builtin_amdgcn_update_dpp(0, __float_as_int(v), 0x4E, 0xF, 0xF, true);
  else r = __builtin_amdgcn_update_dpp(0, __float_as_int(v), 0x141, 0xF, 0xF, true);
  return __int_as_float(r);
}
__device__ __forceinline__ float red8(float v) { v += dpp_f(v, 0); v += dpp_f(v, 1); v += dpp_f(v, 2); return v; }
__device__ __forceinline__ int crow(int r, int hi) { return (r & 3) + 8 * (r >> 2) + 4 * hi; }
__device__ __forceinline__ float sigmoidf_(float x) { return 1.f / (1.f + __expf(-x)); }
#define MFMA(a, b, c) __builtin_amdgcn_mfma_f32_32x32x16_bf16((a), (b), (c), 0, 0, 0)

constexpr int G_LDT = 144;
constexpr int G_SSQ_OFF = 2 * (256 + 256) * G_LDT;
constexpr int LDS_BYTES = G_SSQ_OFF + 1024;

template <int AMODE, int BN, class Epi>
__device__ __forceinline__ void gemm_tile(const bf16_t* A, const int lda, const bf16_t* Bt, const int K, const int m0, const float* mu, char* lds, const Epi& epi) {
  constexpr int WN = BN / 64, MI = WN, NBR = BN / 64, G_STAGE = (256 + BN) * G_LDT;
  const int tid = threadIdx.x, lane = tid & 63, wid = tid >> 6, r32 = lane & 31, hi = lane >> 5;
  const int wm = wid / WN, wn = wid % WN;
  const int srow = tid >> 3, scc = (tid & 7) * 8;
  f32x16 acc[MI][2];
#pragma unroll
  for (int i = 0; i < MI; ++i)
#pragma unroll
    for (int j = 0; j < 2; ++j)
#pragma unroll
      for (int r = 0; r < 16; ++r) acc[i][j][r] = 0.f;
  bf16x8 ra[4], rb[NBR], rp[4], rn[4];
  float ssq[4] = {0.f, 0.f, 0.f, 0.f};
  int dprev[4], dnext[4];
  if constexpr (AMODE == 1) {
    const int t0 = m0 % TL;
#pragma unroll
    for (int i = 0; i < 4; ++i) { const int t = t0 + srow + 64 * i; dprev[i] = (t != 0 && t != T) ? 1 : 0; dnext[i] = (t != T - 1 && t != TL - 1) ? 1 : 0; }
  }
  auto gload = [&](int k0) {
#pragma unroll
    for (int i = 0; i < 4; ++i) {
      const bf16_t* ap = A + (size_t)(m0 + srow + 64 * i) * lda + k0 + scc;
      ra[i] = *(const bf16x8*)ap;
      if constexpr (AMODE == 1) { rp[i] = *(const bf16x8*)(ap - dprev[i] * lda); rn[i] = *(const bf16x8*)(ap + dnext[i] * lda); }
    }
#pragma unroll
    for (int i = 0; i < NBR; ++i) rb[i] = *(const bf16x8*)(Bt + (size_t)(srow + 64 * i) * K + k0 + scc);
  };
  auto lstore = [&](int s, int k0) {
    char* base = lds + s * G_STAGE;
    if constexpr (AMODE == 1) {
      const f32x4 m0v = *(const f32x4*)(mu + k0 + scc), m1v = *(const f32x4*)(mu + k0 + scc + 4);
      const float mm[8] = {m0v[0], m0v[1], m0v[2], m0v[3], m1v[0], m1v[1], m1v[2], m1v[3]};
#pragma unroll
      for (int i = 0; i < 4; ++i) {
        const u32x4 hc = *(const u32x4*)&ra[i], hp = *(const u32x4*)&rp[i], hn = *(const u32x4*)&rn[i];
        const float fp = dprev[i] ? 0.5f : 0.f, fn = dnext[i] ? 0.5f : 0.f;
        u32x4 w;
#pragma unroll
        for (int q = 0; q < 4; ++q) {
          const float c0 = lo16(hc[q]), c1 = hi16(hc[q]);
          const float x0 = fp * lo16(hp[q]) + fn * lo16(hn[q]) - c0, x1 = fp * hi16(hp[q]) + fn * hi16(hn[q]) - c1;
          w[q] = cvtpk(c0 + x0 * mm[2 * q], c1 + x1 * mm[2 * q + 1]);
        }
        *(u32x4*)(base + (srow + 64 * i) * G_LDT + scc * 2) = w;
      }
    } else {
#pragma unroll
      for (int i = 0; i < 4; ++i) {
        *(bf16x8*)(base + (srow + 64 * i) * G_LDT + scc * 2) = ra[i];
        if constexpr (AMODE == 2) {
          const u32x4 hc = *(const u32x4*)&ra[i];
#pragma unroll
          for (int q = 0; q < 4; ++q) { const float c0 = lo16(hc[q]), c1 = hi16(hc[q]); ssq[i] += c0 * c0 + c1 * c1; }
        }
      }
    }
#pragma unroll
    for (int i = 0; i < NBR; ++i) *(bf16x8*)(base + 256 * G_LDT + (srow + 64 * i) * G_LDT + scc * 2) = rb[i];
  };
  const int nk = K >> 6;
  gload(0);
  lstore(0, 0);
  if (nk > 1) gload(64);
  __syncthreads();
#pragma unroll 1
  for (int kt = 0; kt < nk; ++kt) {
    const int s = kt & 1;
    if (kt + 1 < nk) lstore(s ^ 1, (kt + 1) * 64);
    if (kt + 2 < nk) gload((kt + 2) * 64);
    {
      const char* Ab = lds + s * G_STAGE + (wm * (32 * MI) + r32) * G_LDT + hi * 16;
      const char* Bb = lds + s * G_STAGE + 256 * G_LDT + (wn * 64 + r32) * G_LDT + hi * 16;
#pragma unroll 2
      for (int ks = 0; ks < 4; ++ks) {
        const bf16x8 b0 = *(const bf16x8*)(Bb + ks * 32), b1 = *(const bf16x8*)(Bb + 32 * G_LDT + ks * 32);
#pragma unroll
        for (int mi = 0; mi < MI; ++mi) {
          const bf16x8 a0 = *(const bf16x8*)(Ab + mi * 32 * G_LDT + ks * 32);
          acc[mi][0] = MFMA(b0, a0, acc[mi][0]); acc[mi][1] = MFMA(b1, a0, acc[mi][1]);
        }
      }
    }
    __syncthreads();
  }
  float* ssq_l = (float*)(lds + G_SSQ_OFF);
  if constexpr (AMODE == 2) {
#pragma unroll
    for (int i = 0; i < 4; ++i) { const float v = red8(ssq[i]); if ((tid & 7) == 0) ssq_l[srow + 64 * i] = v; }
    __syncthreads();
  }
#pragma unroll
  for (int mi = 0; mi < MI; ++mi) {
    const int lrow = wm * (32 * MI) + mi * 32 + r32;
    float aux = 0.f;
    if constexpr (AMODE == 2) aux = ssq_l[lrow];
    epi(lrow, wn * 64 + 4 * hi, acc[mi][0], acc[mi][1], aux);
  }
}

struct EpiBf16 {
  bf16_t* dst; int ldd; int col0; int m0; int act; float invK;
  __device__ __forceinline__ void operator()(int lrow, int nc, const f32x16& a0, const f32x16& a1, float aux) const { one(lrow, nc, a0, aux); one(lrow, nc + 32, a1, aux); }
  __device__ __forceinline__ void one(int lrow, int nc, const f32x16& a, float aux) const {
    float sc = 1.f;
    if (invK > 0.f) sc = rsqrtf(aux * invK + 1e-6f);
    bf16_t* p = dst + (size_t)(m0 + lrow) * ldd + col0 + nc;
#pragma unroll
    for (int g = 0; g < 4; ++g) {
      float v0 = a[4 * g] * sc, v1 = a[4 * g + 1] * sc, v2 = a[4 * g + 2] * sc, v3 = a[4 * g + 3] * sc;
      if (act) {
        v0 = 1.f - 2.f / (__expf(2.f * v0) + 1.f); v1 = 1.f - 2.f / (__expf(2.f * v1) + 1.f);
        v2 = 1.f - 2.f / (__expf(2.f * v2) + 1.f); v3 = 1.f - 2.f / (__expf(2.f * v3) + 1.f);
      }
      st_bf16x4(p + 8 * g, v0, v1, v2, v3);
    }
  }
};
struct EpiResid {
  const float* xin; float* xout; const float* gvec; int n0;
  __device__ __forceinline__ void operator()(int lrow, int nc, const f32x16& a0, const f32x16& a1, float) const {
    const size_t o = (size_t)lrow * 1024 + n0 + nc;
    f32x4 xv[8], gv[8];
#pragma unroll
    for (int g = 0; g < 4; ++g) {
      xv[g] = *(const f32x4*)(xin + o + 8 * g); xv[4 + g] = *(const f32x4*)(xin + o + 32 + 8 * g);
      gv[g] = *(const f32x4*)(gvec + n0 + nc + 8 * g); gv[4 + g] = *(const f32x4*)(gvec + n0 + nc + 32 + 8 * g);
    }
    f32x4 r[8];
#pragma unroll
    for (int g = 0; g < 4; ++g)
#pragma unroll
      for (int e = 0; e < 4; ++e) { r[g][e] = xv[g][e] + gv[g][e] * a0[4 * g + e]; r[4 + g][e] = xv[4 + g][e] + gv[4 + g][e] * a1[4 * g + e]; }
    asm volatile("" ::: "memory");
#pragma unroll
    for (int g = 0; g < 4; ++g) { *(f32x4*)(xout + o + 8 * g) = r[g]; *(f32x4*)(xout + o + 32 + 8 * g) = r[4 + g]; }
  }
};
struct EpiMlaIn {
  bf16_t *QC, *KVC, *KPE, *G1; const float* rope; int n0; int m0;
  __device__ __forceinline__ void operator()(int lrow, int nc, const f32x16& a0, const f32x16& a1, float) const { one(lrow, nc, a0); one(lrow, nc + 32, a1); }
  __device__ __forceinline__ void one(int lrow, int nc, const f32x16& a) const {
    const int row = m0 + lrow, gc = n0 + nc, g32 = gc & ~31;
    if (g32 == 640) {
      const int t = (m0 % TL) + lrow, hi4 = gc - 640;
      bf16_t* p = KPE + (size_t)row * 32;
      if (t < T) {
        const f32x2* tr = (const f32x2*)rope + (t >> 6) * 8 + hi4;
        const f32x2* tc = (const f32x2*)rope + (t & 63) * 8 + hi4;
        float o1[8], o2[8];
#pragma unroll
        for (int e = 0; e < 4; ++e) {
          const f32x2 cs0 = tr[e], cs1 = tc[e];
          const float x1a = a[e], x2a = a[8 + e];
          const float x1b = a[4 + e], x2b = a[12 + e];
          o1[e] = x1a * cs0[0] - x2a * cs0[1]; o2[e] = x1a * cs0[1] + x2a * cs0[0];
          o1[4 + e] = x1b * cs1[0] - x2b * cs1[1]; o2[4 + e] = x1b * cs1[1] + x2b * cs1[0];
        }
        st_bf16x4(p + hi4, o1[0], o1[1], o1[2], o1[3]);
        st_bf16x4(p + 8 + hi4, o1[4], o1[5], o1[6], o1[7]);
        st_bf16x4(p + 16 + hi4, o2[0], o2[1], o2[2], o2[3]);
        st_bf16x4(p + 24 + hi4, o2[4], o2[5], o2[6], o2[7]);
      } else {
#pragma unroll
        for (int g = 0; g < 4; ++g) st_bf16x4(p + 8 * g + hi4, a[4 * g], a[4 * g + 1], a[4 * g + 2], a[4 * g + 3]);
      }
      return;
    }
    if (g32 > 640 && g32 < 768) return;
    bf16_t* p;
    if (gc < 384) p = QC + (size_t)row * 384 + gc;
    else if (gc < 640) p = KVC + (size_t)row * 256 + (gc - 384);
    else p = G1 + (size_t)row * 1024 + (gc - 768);
#pragma unroll
    for (int g = 0; g < 4; ++g) st_bf16x4(p + 8 * g, a[4 * g], a[4 * g + 1], a[4 * g + 2], a[4 * g + 3]);
  }
};

constexpr float AT_SCALE = 0.10206207261596575f;
constexpr float AT_THR = 8.f;
__device__ void tr_job(const float* src, int ld, int K, int N, bf16_t* dst, const float* kscale, char* lds, float gscale = 1.f) {
  float* tile = (float*)lds;
  const int tid = threadIdx.x, nK = K >> 6, nN = (N + 63) >> 6;
  for (int tIdx = blockIdx.x; tIdx < nK * nN; tIdx += gridDim.x) {
    const int k0 = (tIdx % nK) * 64, n0 = (tIdx / nK) * 64;
#pragma unroll
    for (int i = 0; i < 8; ++i) {
      const int kk = (tid >> 6) + 8 * i, nn = tid & 63;
      float v = 0.f;
      if (n0 + nn < N) { v = src[(size_t)(k0 + kk) * ld + n0 + nn] * gscale; if (kscale) v *= kscale[k0 + kk]; }
      tile[kk * 65 + nn] = v;
    }
    __syncthreads();
#pragma unroll
    for (int i = 0; i < 8; ++i) {
      const int nn = (tid >> 6) + 8 * i, kk = tid & 63;
      if (n0 + nn < N) dst[(size_t)(n0 + nn) * K + k0 + kk] = f2bf(tile[kk * 65 + nn]);
    }
    __syncthreads();
  }
}

__device__ void phase_weights(const Params& p, char* lds) {
  unsigned char* ws = p.ws;
  bf16_t* WIN0 = (bf16_t*)(ws + OFF_WIN0);
  for (int j = 0; j < 4; ++j) tr_job(p.in[8] + (size_t)j * 1024 * 1024, 1024, 1024, 1024, WIN0 + (size_t)j * 1024 * 1024, nullptr, lds);
  for (int d = 0; d < 2; ++d) {
    tr_job(p.in[10] + (size_t)d * 1024 * 64, 64, 1024, 64, WIN0 + (size_t)(4096 + d * 64) * 1024, nullptr, lds);
    tr_job(p.in[13] + (size_t)d * 1024 * 64, 64, 1024, 64, WIN0 + (size_t)(4224 + d * 64) * 1024, nullptr, lds);
  }
  tr_job(p.in[20], 1024, 1024, 1024, (bf16_t*)(ws + OFF_WOUT0), nullptr, lds);
  bf16_t* WIN1 = (bf16_t*)(ws + OFF_WIN1);
  tr_job(p.in[21], 1696, 1024, 640, WIN1, nullptr, lds);
  tr_job(p.in[21] + 640, 1696, 1024, 32, WIN1 + (size_t)640 * 1024, nullptr, lds);
  tr_job(p.in[21] + 672, 1696, 1024, 1024, WIN1 + (size_t)768 * 1024, nullptr, lds);
  for (int i = blockIdx.x * NTHR + threadIdx.x; i < 96 * 1024; i += gridDim.x * NTHR) WIN1[(size_t)672 * 1024 + i] = 0;
  tr_job(p.in[23], 1536, 384, 1536, (bf16_t*)(ws + OFF_WQB), p.in[22], lds, AT_SCALE * 1.4426950408889634f);
  tr_job(p.in[25], 2048, 256, 2048, (bf16_t*)(ws + OFF_WKVB), p.in[24], lds);
  tr_job(p.in[26], 1024, 1024, 1024, (bf16_t*)(ws + OFF_WOUT1), nullptr, lds);
}
__device__ void phase_prologue(const Params& p, char* lds) {
  unsigned char* ws = p.ws;
  {
    const int i = blockIdx.x * NTHR + threadIdx.x;
    if (i < 1024) {
      const float invf[8] = {1.f, 0.316227766016838f, 0.1f, 0.0316227766016838f, 0.01f, 0.00316227766016838f, 0.001f, 0.000316227766016838f};
      const int pos = i >> 3, m = i & 7;
      float inv = invf[0];
#pragma unroll
      for (int q = 1; q < 8; ++q) inv = (m == q) ? invf[q] : inv;
      const float ang = (float)pos * inv;
      const float kf = rintf(ang * 0.15915494309189535f);
      float r = fmaf(-kf, 6.28125f, ang);
      r = fmaf(-kf, 1.9353071795864769e-3f, r);
      float* rt = (float*)(ws + OFF_ROPE);
      rt[2 * i] = cosf(r); rt[2 * i + 1] = sinf(r);
    }
  }
  {
    float* sil = (float*)lds;
    float* red = sil + 9 * 1024;
    const int tid = threadIdx.x;
    for (int i = tid; i < 9 * 1024; i += NTHR) {
      const int bi = i >> 10, k = i & 1023;
      const float cv = bi < 8 ? p.in[1][bi * 1024 + k] : p.in[3][k];
      sil[i] = cv / (1.f + __expf(-cv));
    }
    __syncthreads();
    float* mod = (float*)(ws + OFF_MOD);
    for (int item = blockIdx.x; item < 192; item += gridDim.x) {
      const int l = item / 96, n0 = (item % 96) * 32, col = tid & 31, kg = tid >> 5;
      float acc[9];
#pragma unroll
      for (int bi = 0; bi < 9; ++bi) acc[bi] = 0.f;
      const float* wp = p.in[5] + ((size_t)l * 1024 + kg * 64) * 3072 + n0 + col;
      for (int kk = 0; kk < 64; ++kk) {
        const float w = wp[(size_t)kk * 3072];
#pragma unroll
        for (int bi = 0; bi < 9; ++bi) acc[bi] += sil[bi * 1024 + kg * 64 + kk] * w;
      }
#pragma unroll
      for (int bi = 0; bi < 9; ++bi) red[(kg * 9 + bi) * 32 + col] = acc[bi];
      __syncthreads();
      if (tid < 288) {
        const int bi = tid >> 5;
        float s = 0.f;
#pragma unroll
        for (int g = 0; g < 16; ++g) s += red[(g * 9 + bi) * 32 + col];
        mod[((size_t)l * 9 + bi) * 3072 + n0 + col] = s + p.in[6][l * 3072 + n0 + col];
      }
      __syncthreads();
    }
  }
}

__device__ __forceinline__ const float* row_src(const float* xsrc, const float* csrc, int n, int& bi) {
  const int b = n / TL, t = n - b * TL;
  if (t < T) { bi = b; return xsrc + ((size_t)b * T + t) * D; }
  bi = 8; return csrc + ((size_t)b * L + (t - T)) * D;
}
__device__ void phase_norm(const float* xsrc, const float* csrc, const float* ng, const float* mod, bf16_t* H) {
  const int lane = threadIdx.x & 63, gw = blockIdx.x * 8 + (threadIdx.x >> 6), nw = gridDim.x * 8;
  f32x4 g4[4];
#pragma unroll
  for (int i = 0; i < 4; ++i) g4[i] = *(const f32x4*)(ng + i * 256 + lane * 4);
  f32x4 va[4], vb[4]; int bia = 0, bib = 0;
  if (gw < NTOK) { const float* src = row_src(xsrc, csrc, gw, bia);
#pragma unroll
    for (int i = 0; i < 4; ++i) va[i] = *(const f32x4*)(src + i * 256 + lane * 4); }
  for (int n = gw; n < NTOK; n += nw) {
    if (n + nw < NTOK) { const float* src = row_src(xsrc, csrc, n + nw, bib);
#pragma unroll
      for (int i = 0; i < 4; ++i) vb[i] = *(const f32x4*)(src + i * 256 + lane * 4); }
    float ss = 0.f;
#pragma unroll
    for (int i = 0; i < 4; ++i) ss += va[i][0] * va[i][0] + va[i][1] * va[i][1] + va[i][2] * va[i][2] + va[i][3] * va[i][3];
    ss = wave_sum(ss);
    const float rstd = rsqrtf(ss * (1.f / 1024.f) + 1e-6f);
    const float* m = mod + bia * 3072;
#pragma unroll
    for (int i = 0; i < 4; ++i) {
      const int c = i * 256 + lane * 4;
      const f32x4 sh = *(const f32x4*)(m + c), sc = *(const f32x4*)(m + 1024 + c);
      float o[4];
#pragma unroll
      for (int e = 0; e < 4; ++e) o[e] = va[i][e] * rstd * g4[i][e] * (1.f + sc[e]) + sh[e];
      st_bf16x4(H + (size_t)n * 1024 + c, o[0], o[1], o[2], o[3]);
    }
#pragma unroll
    for (int i = 0; i < 4; ++i) va[i] = vb[i];
    bia = bib;
  }
}

constexpr int LERP3_SPLIT = 63488;
__device__ __forceinline__ bf16_t* lerp_base(const Params& p, int j, int row) {
  if (j == 0) return (bf16_t*)(p.ws + OFF_Y0);
  if (j == 1) return (bf16_t*)(p.ws + OFF_Y1);
  if (j == 2) return (bf16_t*)p.out;
  if (row < LERP3_SPLIT) return (bf16_t*)p.out + (size_t)NTOK * 1024;
  return (bf16_t*)(p.ws + WS_END) - (size_t)LERP3_SPLIT * 1024;
}
struct RowX { f32x4 v[4]; int bi; };
__device__ __forceinline__ void ld_row(const Params& p, int n, int lane, RowX& r) {
  const float* src = row_src(p.in[0], p.in[2], n, r.bi);
#pragma unroll
  for (int i = 0; i < 4; ++i) r.v[i] = *(const f32x4*)(src + i * 256 + lane * 4);
}
__device__ __forceinline__ void fin_row(const float* mod, const f32x4 (&g4)[4], int lane, const RowX& r, float (&h)[16]) {
  float ss = 0.f;
#pragma unroll
  for (int i = 0; i < 4; ++i) ss += r.v[i][0] * r.v[i][0] + r.v[i][1] * r.v[i][1] + r.v[i][2] * r.v[i][2] + r.v[i][3] * r.v[i][3];
  ss = wave_sum(ss);
  const float rstd = rsqrtf(ss * (1.f / 1024.f) + 1e-6f);
  const float* m = mod + r.bi * 3072;
#pragma unroll
  for (int i = 0; i < 4; ++i) {
    const int c = i * 256 + lane * 4;
    const f32x4 sh = *(const f32x4*)(m + c), sc = *(const f32x4*)(m + 1024 + c);
#pragma unroll
    for (int e = 0; e < 4; ++e) {
      const float hv = r.v[i][e] * rstd * g4[i][e] * (1.f + sc[e]) + sh[e];
      h[4 * i + e] = __uint_as_float(cvtpk(hv, 0.f) << 16);
    }
  }
}
__device__ void phase_norm_lerp(const Params& p, const float* mod) {
  const int lane = threadIdx.x & 63, gw = blockIdx.x * 8 + (threadIdx.x >> 6), nw = gridDim.x * 8;
  const int per = (NTOK + nw - 1) / nw;
  const int r0 = gw * per, r1 = (r0 + per < NTOK) ? r0 + per : NTOK;
  if (r0 >= r1) return;
  bf16_t* H = (bf16_t*)(p.ws + OFF_H);
  f32x4 g4[4];
#pragma unroll
  for (int i = 0; i < 4; ++i) g4[i] = *(const f32x4*)(p.in[4] + i * 256 + lane * 4);
  float mu[4][16];
#pragma unroll
  for (int j = 0; j < 4; ++j)
#pragma unroll
    for (int i = 0; i < 4; ++i) {
      const f32x4 m4 = *(const f32x4*)(p.in[7] + j * 1024 + i * 256 + lane * 4);
      mu[j][4 * i] = m4[0]; mu[j][4 * i + 1] = m4[1]; mu[j][4 * i + 2] = m4[2]; mu[j][4 * i + 3] = m4[3];
    }
  float hp[16], hc[16], hn[16];
  RowX xa, xb, xc;
  if (r0 > 0) { ld_row(p, r0 - 1, lane, xc); }
  ld_row(p, r0, lane, xa);
  if (r0 + 1 < NTOK) ld_row(p, r0 + 1, lane, xb);
  if (r0 > 0) fin_row(mod, g4, lane, xc, hp);
  else {
#pragma unroll
    for (int e = 0; e < 16; ++e) hp[e] = 0.f;
  }
  fin_row(mod, g4, lane, xa, hc);
  xa = xb;
  if (r0 + 2 < NTOK) ld_row(p, r0 + 2, lane, xb);
  for (int n = r0; n < r1; ++n) {
    const int t = n % TL;
    if (n + 3 < NTOK) ld_row(p, n + 3, lane, xc);
    if (n + 1 < NTOK) fin_row(mod, g4, lane, xa, hn);
    else {
#pragma unroll
      for (int e = 0; e < 16; ++e) hn[e] = 0.f;
    }
    const float fp = (t != 0 && t != T) ? 0.5f : 0.f, fn = (t != T - 1 && t != TL - 1) ? 0.5f : 0.f;
#pragma unroll
    for (int i = 0; i < 4; ++i) st_bf16x4_nt(H + (size_t)n * 1024 + i * 256 + lane * 4, hc[4 * i], hc[4 * i + 1], hc[4 * i + 2], hc[4 * i + 3]);
#pragma unroll
    for (int j = 0; j < 4; ++j) {
      bf16_t* dst = lerp_base(p, j, n) + (size_t)n * 1024 + lane * 4;
#pragma unroll
      for (int i = 0; i < 4; ++i) {
        float o[4];
#pragma unroll
        for (int e = 0; e < 4; ++e) { const float c = hc[4 * i + e]; o[e] = c + (fp * hp[4 * i + e] + fn * hn[4 * i + e] - c) * mu[j][4 * i + e]; }
        st_bf16x4_nt(dst + i * 256, o[0], o[1], o[2], o[3]);
      }
    }
#pragma unroll
    for (int e = 0; e < 16; ++e) { hp[e] = hc[e]; hc[e] = hn[e]; }
    xa = xb; xb = xc;
  }
}

__device__ void phase_final(float* out, const float* fg) {
  const int lane = threadIdx.x & 63, gw = blockIdx.x * 8 + (threadIdx.x >> 6), nw = gridDim.x * 8;
  f32x4 g4[4];
#pragma unroll
  for (int i = 0; i < 4; ++i) g4[i] = *(const f32x4*)(fg + i * 256 + lane * 4);
  f32x4 va[4], vb[4];
  if (gw < NB * T) {
#pragma unroll
    for (int i = 0; i < 4; ++i) va[i] = *(const f32x4*)(out + (size_t)gw * D + i * 256 + lane * 4); }
  for (int n = gw; n < NB * T; n += nw) {
    if (n + nw < NB * T) {
#pragma unroll
      for (int i = 0; i < 4; ++i) vb[i] = *(const f32x4*)(out + (size_t)(n + nw) * D + i * 256 + lane * 4); }
    float ss = 0.f;
#pragma unroll
    for (int i = 0; i < 4; ++i) ss += va[i][0] * va[i][0] + va[i][1] * va[i][1] + va[i][2] * va[i][2] + va[i][3] * va[i][3];
    ss = wave_sum(ss);
    const float rstd = rsqrtf(ss * (1.f / 1024.f) + 1e-6f);
#pragma unroll
    for (int i = 0; i < 4; ++i) {
      f32x4 o;
#pragma unroll
      for (int e = 0; e < 4; ++e) o[e] = va[i][e] * rstd * g4[i][e];
      *(f32x4*)(out + (size_t)n * D + i * 256 + lane * 4) = o;
    }
#pragma unroll
    for (int i = 0; i < 4; ++i) va[i] = vb[i];
  }
}

__device__ __forceinline__ int scan_row(int g, int d, int b) {
  if (g < L) { const int tt = d ? (L - 1 - g) : g; return b * TL + T + tt; }
  g -= L; const int tt = d ? (T - 1 - g) : g; return b * TL + tt;
}
constexpr int SC_P = 0, SC_ARA = 8192, SC_ARR = SC_ARA + 4096, SC_BK = SC_ARR + 4096, SC_SCAL = SC_BK + 8192, SC_VV = SC_SCAL + 1024, SC_BUF = SC_VV + 8192;
constexpr int SC_IC = 2 * SC_BUF, SC_SCR = SC_IC + 8192, SC_YB = SC_SCR + 16384, SC_END = SC_YB + 2 * 8192;
#define MFMA16(a, b, c) __builtin_amdgcn_mfma_f32_16x16x32_bf16((a), (b), (c), 0, 0, 0)
struct ScBlk { u32x4 aa0, aa1, ar0, ar1, k0, k1, k2, k3; f32x4 v; f32x4 s[8]; };
__device__ __forceinline__ void sc_ldb(ScBlk& c, const char* buf, int blk, int arOff, int bkOff, int vOff) {
  const char* pa = buf + SC_ARA + blk * 512 + arOff; const char* pr = buf + SC_ARR + blk * 512 + arOff;
  c.aa0 = *(const u32x4*)(pa); c.aa1 = *(const u32x4*)(pa + 64); c.ar0 = *(const u32x4*)(pr); c.ar1 = *(const u32x4*)(pr + 64);
  const char* bk = buf + SC_BK + blk * 1024 + bkOff;
  c.k0 = *(const u32x4*)(bk); c.k1 = *(const u32x4*)(bk + 256); c.k2 = *(const u32x4*)(bk + 512); c.k3 = *(const u32x4*)(bk + 768);
  c.v = *(const f32x4*)(buf + SC_VV + blk * 1024 + vOff);
  const char* sp = buf + SC_SCAL + blk * 128;
#pragma unroll
  for (int i = 0; i < 8; ++i) c.s[i] = *(const f32x4*)(sp + i * 16);
}
__device__ void phase_scan(const Params& p, char* lds) {
  unsigned char* ws = p.ws;
  const int tid = threadIdx.x, lane = tid & 63, wid = __builtin_amdgcn_readfirstlane(tid >> 6), r32 = lane & 31, hi = lane >> 5;
  const bf16_t* Rg = (const bf16_t*)(ws + OFF_R); const bf16_t* Kg = (const bf16_t*)(ws + OFF_K); const bf16_t* Vg = (const bf16_t*)(ws + OFF_V);
  const bf16_t* Lg = (const bf16_t*)(ws + OFF_LORA);
  constexpr int NCH = TL / 32;
  for (int sidx = blockIdx.x; sidx < 256; sidx += gridDim.x) {
    const int d = sidx >> 7, b = (sidx >> 4) & 7, h = sidx & 15;
    bf16_t* Yg = (bf16_t*)(ws + (d ? OFF_Y1 : OFF_Y0));
    if (wid < 4) {
      const int cw = wid, c16 = lane & 15, q = lane >> 4;
      const int arOff = (c16 & 3) * 128 + q * 16, wOff = q * 16, bkOff = c16 * 16, vOff = (cw * 16 + c16) * 16;
      f32x4 St0 = {0.f, 0.f, 0.f, 0.f}, St1 = St0, St2 = St0, St3 = St0;
      __syncthreads(); __syncthreads();
      for (int c = 0; c < NCH; ++c) {
        const char* buf = lds + (c & 1) * SC_BUF;
        char* yb = lds + SC_YB + (c & 1) * 8192 + (cw * 16 + c16) * 16;
        ScBlk cur; sc_ldb(cur, buf, 0, arOff, bkOff, vOff);
#pragma unroll 1
        for (int blk = 0; blk < 8; ++blk) {
          ScBlk nxt; sc_ldb(nxt, buf, (blk + 1) & 7, arOff, bkOff, vOff);
          u32x4 b1 = {cvtpk(St0[0], St0[1]), cvtpk(St0[2], St0[3]), cvtpk(St1[0], St1[1]), cvtpk(St1[2], St1[3])};
          u32x4 b2 = {cvtpk(St2[0], St2[1]), cvtpk(St2[2], St2[3]), cvtpk(St3[0], St3[1]), cvtpk(St3[2], St3[3])};
          f32x4 sr = {0.f, 0.f, 0.f, 0.f}, yr = sr;
          sr = MFMA16(*(bf16x8*)&cur.aa0, *(bf16x8*)&b1, sr); yr = MFMA16(*(bf16x8*)&cur.ar0, *(bf16x8*)&b1, yr);
          sr = MFMA16(*(bf16x8*)&cur.aa1, *(bf16x8*)&b2, sr); yr = MFMA16(*(bf16x8*)&cur.ar1, *(bf16x8*)&b2, yr);
          const float v1 = cur.v[0], v2 = cur.v[1], v3 = cur.v[2], v4 = cur.v[3];
          const f32x4 s0 = cur.s[0], s1 = cur.s[1], s2 = cur.s[2], s3 = cur.s[3], s4 = cur.s[4], s5 = cur.s[5], s6 = cur.s[6], s7 = cur.s[7];
          const float sa1 = sr[0];
          const float sa2 = sr[1] + s0[0] * sa1 + s1[2] * v1;
          const float sa3 = sr[2] + s0[1] * sa1 + s1[3] * v1 + s0[2] * sa2 + s2[0] * v2;
          const float sa4 = sr[3] + s0[3] * sa1 + s2[1] * v1 + s1[0] * sa2 + s2[2] * v2 + s1[1] * sa3 + s2[3] * v3;
          f32x4 y;
          y[0] = yr[0] + s3[0] * sa1 + s5[2] * v1;
          y[1] = yr[1] + s3[1] * sa1 + s5[3] * v1 + s3[2] * sa2 + s6[0] * v2;
          y[2] = yr[2] + s3[3] * sa1 + s6[1] * v1 + s4[0] * sa2 + s6[2] * v2 + s4[1] * sa3 + s6[3] * v3;
          y[3] = yr[3] + s4[2] * sa1 + s7[0] * v1 + s4[3] * sa2 + s7[1] * v2 + s5[0] * sa3 + s7[2] * v3 + s5[1] * sa4 + s7[3] * v4;
          u32x4 bu = {cvtpk(sa1, v1), cvtpk(sa2, v2), cvtpk(sa3, v3), cvtpk(sa4, v4)};
          if (q != 0) { bu[0] = 0u; bu[1] = 0u; bu[2] = 0u; bu[3] = 0u; }
          St0 = MFMA16(*(bf16x8*)&cur.k0, *(bf16x8*)&bu, St0);
          St1 = MFMA16(*(bf16x8*)&cur.k1, *(bf16x8*)&bu, St1);
          St2 = MFMA16(*(bf16x8*)&cur.k2, *(bf16x8*)&bu, St2);
          St3 = MFMA16(*(bf16x8*)&cur.k3, *(bf16x8*)&bu, St3);
          *(f32x4*)(yb + blk * 1024) = y;
          cur = nxt;
          if (blk == 7) {
            const char* pw = buf + SC_P + 31 * 256 + wOff;
            St0 *= *(const f32x4*)(pw); St1 *= *(const f32x4*)(pw + 64); St2 *= *(const f32x4*)(pw + 128); St3 *= *(const f32x4*)(pw + 192);
          }
          if (blk == 3 || blk == 7) __syncthreads();
        }
      }
    } else {
      const int pw = wid - 4, ptid = tid - 256;
      const int pstep = ptid >> 3, j0 = (ptid & 7) * 8, pblk = pstep >> 2, psb = pstep & 3;
      const int apos0 = (j0 >> 5) * 32 + (((j0 & 31) & 15) >> 2) * 8 + 4 * ((j0 & 31) >> 4), apos1 = apos0 + 8;
      float* Bg = (float*)(ws + OFF_BONUS) + (size_t)d * NTOK * 16;
      float kkc[8], kac[8], rkc[8];
#pragma unroll
      for (int e = 0; e < 8; ++e) { kkc[e] = p.in[15][h * 64 + j0 + e]; kac[e] = p.in[16][h * 64 + j0 + e]; rkc[e] = p.in[17][h * 64 + j0 + e]; }
      const int mat = pw >> 1, jh = pw & 1;
      bf16x8 w2f[4]; float bias;
      {
        const float* W2 = (mat ? p.in[14] : p.in[11]) + (size_t)d * 64 * 1024;
#pragma unroll
        for (int ks = 0; ks < 4; ++ks) {
          u32x4 w;
#pragma unroll
          for (int qq = 0; qq < 4; ++qq) {
            const int r0 = ks * 16 + 8 * hi + 2 * qq;
            w[qq] = cvtpk(W2[(size_t)r0 * 1024 + h * 64 + jh * 32 + r32], W2[(size_t)(r0 + 1) * 1024 + h * 64 + jh * 32 + r32]);
          }
          w2f[ks] = *(bf16x8*)&w;
        }
        bias = (mat ? p.in[12] : p.in[9])[d * 1024 + h * 64 + jh * 32 + r32];
      }
      u32x4 pR, pK, pV; bf16x8 pl[4];
      float kk[8], kr[8], rr[8];
      float* IC = (float*)(lds + SC_IC);
      bf16_t* SCR = (bf16_t*)(lds + SC_SCR);
      auto prefetch = [&](int c) {
        const size_t row = (size_t)scan_row(c * 32 + pstep, d, b) * 1024 + h * 64 + j0;
        pR = *(const u32x4*)(Rg + row); pK = *(const u32x4*)(Kg + row); pV = *(const u32x4*)(Vg + row);
        const size_t lrow = (size_t)scan_row(c * 32 + r32, d, b);
#pragma unroll
        for (int ks = 0; ks < 4; ++ks) pl[ks] = *(const bf16x8*)(Lg + lrow * 256 + mat * 128 + d * 64 + ks * 16 + hi * 8);
      };
      auto stageA = [&](int c) {
        char* buf = lds + (c & 1) * SC_BUF;
        float* Pd = (float*)(buf + SC_P); float* VV = (float*)(buf + SC_VV);
        f32x16 acc;
#pragma unroll
        for (int r = 0; r < 16; ++r) acc[r] = 0.f;
#pragma unroll
        for (int ks = 0; ks < 4; ++ks) acc = MFMA(pl[ks], w2f[ks], acc);
        if (mat == 0) {
          float cc[16];
#pragma unroll
          for (int r = 0; r < 16; ++r) cc[r] = -0.6065306597126334f * __builtin_amdgcn_rcpf(1.f + __expf(-(acc[r] + bias)));
#pragma unroll
          for (int g = 0; g < 4; ++g) { cc[4 * g + 1] += cc[4 * g]; cc[4 * g + 2] += cc[4 * g + 1]; cc[4 * g + 3] += cc[4 * g + 2]; }
          float run = 0.f;
#pragma unroll
          for (int g = 0; g < 4; ++g) {
            const float own = cc[4 * g + 3];
            auto rr2 = __builtin_amdgcn_permlane32_swap(__float_as_uint(own), __float_as_uint(own), false, false);
            const float both = __uint_as_float(rr2[0]) + __uint_as_float(rr2[1]), partner = both - own;
            const float off = hi ? run + partner : run;
#pragma unroll
            for (int e = 0; e < 4; ++e) Pd[crow(4 * g + e, hi) * 64 + jh * 32 + r32] = __expf(off + cc[4 * g + e]);
            run += both;
          }
        } else {
#pragma unroll
          for (int r = 0; r < 16; ++r) IC[crow(r, hi) * 64 + jh * 32 + r32] = __builtin_amdgcn_rcpf(1.f + __expf(-(acc[r] + bias)));
        }
        float ss = 0.f;
#pragma unroll
        for (int w = 0; w < 4; ++w) {
          rr[2 * w] = lo16(pR[w]); rr[2 * w + 1] = hi16(pR[w]);
          kr[2 * w] = lo16(pK[w]); kr[2 * w + 1] = hi16(pK[w]);
        }
        const float vv[8] = {lo16(pV[0]), hi16(pV[0]), lo16(pV[1]), hi16(pV[1]), lo16(pV[2]), hi16(pV[2]), lo16(pV[3]), hi16(pV[3])};
        if (c + 1 < NCH) prefetch(c + 1);
#pragma unroll
        for (int e = 0; e < 8; ++e) VV[(pblk * 64 + j0 + e) * 4 + psb] = vv[e];
#pragma unroll
        for (int e = 0; e < 8; ++e) { kk[e] = kr[e] * kkc[e]; ss += kk[e] * kk[e]; }
        ss = red8(ss);
        const float inv = rsqrtf(fmaxf(ss, 1e-24f));
#pragma unroll
        for (int e = 0; e < 8; ++e) kk[e] *= inv;
      };
      auto stageB = [&](int c) {
        char* buf = lds + (c & 1) * SC_BUF;
        const f32x4 i0 = *(const f32x4*)(IC + pstep * 64 + j0), i1 = *(const f32x4*)(IC + pstep * 64 + j0 + 4);
        const float ic[8] = {i0[0], i0[1], i0[2], i0[3], i1[0], i1[1], i1[2], i1[3]};
        const float* Pt = (const float*)(buf + SC_P) + pstep * 64 + j0;
        const f32x4 pt0 = *(const f32x4*)(Pt), pt1 = *(const f32x4*)(Pt + 4);
        f32x4 pm0 = {1.f, 1.f, 1.f, 1.f}, pm1 = pm0;
        if (pstep > 0) { pm0 = *(const f32x4*)(Pt - 64); pm1 = *(const f32x4*)(Pt - 60); }
        const float pt[8] = {pt0[0], pt0[1], pt0[2], pt0[3], pt1[0], pt1[1], pt1[2], pt1[3]};
        const float pm[8] = {pm0[0], pm0[1], pm0[2], pm0[3], pm1[0], pm1[1], pm1[2], pm1[3]};
        const u32x4 an = {cvtpk(-kk[0] * pm[0], -kk[1] * pm[1]), cvtpk(-kk[2] * pm[2], -kk[3] * pm[3]), cvtpk(-kk[4] * pm[4], -kk[5] * pm[5]), cvtpk(-kk[6] * pm[6], -kk[7] * pm[7])};
        const u32x4 rn = {cvtpk(rr[0] * pt[0], rr[1] * pt[1]), cvtpk(rr[2] * pt[2], rr[3] * pt[3]), cvtpk(rr[4] * pt[4], rr[5] * pt[5]), cvtpk(rr[6] * pt[6], rr[7] * pt[7])};
        bf16_t* ARa = (bf16_t*)(buf + SC_ARA) + (pblk * 4 + psb) * 64; bf16_t* ARr = (bf16_t*)(buf + SC_ARR) + (pblk * 4 + psb) * 64;
        { u32x2 lo = {an[0], an[1]}, hi2 = {an[2], an[3]}; *(u32x2*)(ARa + apos0) = lo; *(u32x2*)(ARa + apos1) = hi2; }
        { u32x2 lo = {rn[0], rn[1]}, hi2 = {rn[2], rn[3]}; *(u32x2*)(ARr + apos0) = lo; *(u32x2*)(ARr + apos1) = hi2; }
        *(u32x4*)(SCR + (pstep * 4 + 0) * 64 + j0) = an; *(u32x4*)(SCR + (pstep * 4 + 1) * 64 + j0) = rn;
        float bs = 0.f;
        unsigned bq[8], kq[8];
        unsigned* BK = (unsigned*)(buf + SC_BK) + (pblk * 64 + j0) * 4 + psb;
#pragma unroll
        for (int e = 0; e < 8; ++e) {
          const float kd = kr[e] * (1.f + (ic[e] - 1.f) * kac[e]);
          const float ip = __builtin_amdgcn_rcpf(pt[e]);
          const unsigned pr2 = cvtpk(kk[e] * ic[e] * ip, kd * ip);
          BK[e * 4] = pr2;
          bq[e] = pr2 & 0xffffu; kq[e] = pr2 >> 16;
          bs += rr[e] * kd * rkc[e];
        }
        const u32x4 bn = {bq[0] | (bq[1] << 16), bq[2] | (bq[3] << 16), bq[4] | (bq[5] << 16), bq[6] | (bq[7] << 16)};
        const u32x4 kn = {kq[0] | (kq[1] << 16), kq[2] | (kq[3] << 16), kq[4] | (kq[5] << 16), kq[6] | (kq[7] << 16)};
        *(u32x4*)(SCR + (pstep * 4 + 2) * 64 + j0) = bn; *(u32x4*)(SCR + (pstep * 4 + 3) * 64 + j0) = kn;
        bs = red8(bs);
        if ((ptid & 7) == 0) Bg[(size_t)scan_row(c * 32 + pstep, d, b) * 16 + h] = bs;
      };
      auto stageC = [&](int c) {
        char* buf = lds + (c & 1) * SC_BUF;
        asm volatile("s_waitcnt lgkmcnt(0)" ::: "memory");
        const int n16 = lane & 15, q4 = lane >> 4;
        const int stepA = (2 * pw + (n16 >> 3)) * 4 + (n16 & 3);
        const bf16_t* Xr = SCR + (stepA * 4 + 2 + ((n16 >> 2) & 1)) * 64 + q4 * 8;
        const bf16_t* Yc = SCR + (stepA * 4 + ((n16 >> 2) & 1)) * 64 + q4 * 8;
        f32x4 g = {0.f, 0.f, 0.f, 0.f};
        g = MFMA16(*(const bf16x8*)(Xr), *(const bf16x8*)(Yc), g);
        g = MFMA16(*(const bf16x8*)(Xr + 32), *(const bf16x8*)(Yc + 32), g);
        const int ctype = (n16 >> 2) & 1, t0 = n16 & 3, rtype = q4 & 1;
        const int grp = ctype * 2 + rtype, base = grp == 0 ? 0 : (grp == 1 ? 6 : (grp == 2 ? 12 : 22));
        float* sc = (float*)(buf + SC_SCAL) + (2 * pw + (n16 >> 3)) * 32 + base + (ctype ? (t0 + 1) * t0 / 2 : t0 * (t0 - 1) / 2);
        if ((q4 >> 1) == (n16 >> 3)) {
#pragma unroll
          for (int e = 0; e < 4; ++e) if (ctype ? (e <= t0) : (e < t0)) sc[e] = g[e];
        }
      };
      auto writeout = [&](int c) {
        const float* Yb = (const float*)(lds + SC_YB + (c & 1) * 8192) + (pblk * 64 + j0) * 4 + psb;
        u32x4 w = {cvtpk(Yb[0], Yb[4]), cvtpk(Yb[8], Yb[12]), cvtpk(Yb[16], Yb[20]), cvtpk(Yb[24], Yb[28])};
        *(u32x4*)(Yg + (size_t)scan_row(c * 32 + pstep, d, b) * 1024 + h * 64 + j0) = w;
      };
      prefetch(0);
      stageA(0);
      __syncthreads();
      stageB(0); stageC(0);
      __syncthreads();
      for (int c = 0; c < NCH; ++c) {
        if (c >= 1) writeout(c - 1);
        if (c + 1 < NCH) stageA(c + 1);
        __syncthreads();
        if (c + 1 < NCH) { stageB(c + 1); stageC(c + 1); }
        __syncthreads();
      }
      writeout(NCH - 1);
    }
    __syncthreads();
  }
}

__device__ void phase_readout(const Params& p) {
  unsigned char* ws = p.ws;
  const bf16_t* Y0 = (const bf16_t*)(ws + OFF_Y0); const bf16_t* Y1 = (const bf16_t*)(ws + OFF_Y1); const bf16_t* Vg = (const bf16_t*)(ws + OFF_V);
  bf16_t* G = (bf16_t*)(ws + OFF_G);
  const float* B0 = (const float*)(ws + OFF_BONUS); const float* B1 = B0 + (size_t)NTOK * 16;
  const int lane = threadIdx.x & 63, gw = blockIdx.x * 8 + (threadIdx.x >> 6), nw = gridDim.x * 8;
  const int c0 = lane * 16, hd = lane >> 2;
  float lg[16], lb[16];
#pragma unroll
  for (int e = 0; e < 16; ++e) { lg[e] = p.in[18][c0 + e]; lb[e] = p.in[19][c0 + e]; }
  struct RowIn { u32x4 a[2], b[2], v[2], g[2]; float b0, b1; };
  auto ldr = [&](int n, RowIn& r) {
    const size_t o = (size_t)n * 1024 + c0;
#pragma unroll
    for (int q = 0; q < 2; ++q) { r.a[q] = *(const u32x4*)(Y0 + o + 8 * q); r.b[q] = *(const u32x4*)(Y1 + o + 8 * q); r.v[q] = *(const u32x4*)(Vg + o + 8 * q); r.g[q] = *(const u32x4*)(G + o + 8 * q); }
    r.b0 = B0[(size_t)n * 16 + hd]; r.b1 = B1[(size_t)n * 16 + hd];
  };
  RowIn cur, nxt;
  if (gw < NTOK) ldr(gw, cur);
  for (int n = gw; n < NTOK; n += nw) {
    if (n + nw < NTOK) ldr(n + nw, nxt);
    const size_t o = (size_t)n * 1024 + c0;
    float y[16], v[16], g[16];
#pragma unroll
    for (int q = 0; q < 2; ++q) {
#pragma unroll
      for (int w = 0; w < 4; ++w) {
        y[8 * q + 2 * w] = lo16(cur.a[q][w]) + lo16(cur.b[q][w]); y[8 * q + 2 * w + 1] = hi16(cur.a[q][w]) + hi16(cur.b[q][w]);
        v[8 * q + 2 * w] = lo16(cur.v[q][w]); v[8 * q + 2 * w + 1] = hi16(cur.v[q][w]);
        g[8 * q + 2 * w] = lo16(cur.g[q][w]); g[8 * q + 2 * w + 1] = hi16(cur.g[q][w]);
      }
    }
    float s = 0.f;
#pragma unroll
    for (int e = 0; e < 16; ++e) s += y[e];
    s += dpp_f(s, 0); s += dpp_f(s, 1);
    const float mean = s * (1.f / 64.f);
    float q2 = 0.f;
#pragma unroll
    for (int e = 0; e < 16; ++e) { const float dlt = y[e] - mean; q2 += dlt * dlt; }
    q2 += dpp_f(q2, 0); q2 += dpp_f(q2, 1);
    const float rs = rsqrtf(q2 * (1.f / 64.f) + 64e-5f);
    const float bonus = cur.b0 + cur.b1;
    float r[16];
#pragma unroll
    for (int e = 0; e < 16; ++e) {
      const float yn = (y[e] - mean) * rs * lg[e] + lb[e];
      r[e] = (yn + bonus * v[e]) * (g[e] * sigmoidf_(g[e]));
    }
    u32x4 w0 = {cvtpk(r[0], r[1]), cvtpk(r[2], r[3]), cvtpk(r[4], r[5]), cvtpk(r[6], r[7])};
    u32x4 w1 = {cvtpk(r[8], r[9]), cvtpk(r[10], r[11]), cvtpk(r[12], r[13]), cvtpk(r[14], r[15])};
    *(u32x4*)(G + o) = w0; *(u32x4*)(G + o + 8) = w1;
    cur = nxt;
  }
}

constexpr int AT_SHMV = 16384, AT_KROW = 208, AT_SHMK = 64 * AT_KROW;
constexpr int AT_KOFF = 2 * AT_SHMV, AT_WOFF = AT_KOFF + 2 * AT_SHMK;
#define SBAR() __builtin_amdgcn_sched_barrier(0)
__device__ __forceinline__ void at_partialSM(f32x16& p0, f32x16& p1, float& m_reg, float& alpha, bool force) {
  float pm = p0[0];
#pragma unroll
  for (int r = 1; r < 16; ++r) pm = fmaxf(pm, p0[r]);
#pragma unroll
  for (int r = 0; r < 16; ++r) pm = fmaxf(pm, p1[r]);
  { auto rr = __builtin_amdgcn_permlane32_swap(__float_as_uint(pm), __float_as_uint(pm), false, false);
    pm = fmaxf(__uint_as_float(rr[0]), __uint_as_float(rr[1])); }
  if (__builtin_expect(!force && __all(pm <= AT_THR * 1.4426950408889634f), 1)) { alpha = 1.f; }
  else {
    const float dlt = force ? pm : fmaxf(pm, 0.f);
    alpha = force ? 1.f : __builtin_amdgcn_exp2f(-dlt); m_reg += dlt;
#pragma unroll
    for (int r = 0; r < 16; ++r) { p0[r] -= dlt; p1[r] -= dlt; }
  }
#pragma unroll
  for (int r = 0; r < 16; ++r) p0[r] = __builtin_amdgcn_exp2f(p0[r]);
}
__device__ __forceinline__ void at_finishSM(f32x16& p0, f32x16& p1, float alpha, float& l_reg, bf16x8& pa0, bf16x8& pa1, bf16x8& pa2, bf16x8& pa3) {
#pragma unroll
  for (int r = 0; r < 16; ++r) p1[r] = __builtin_amdgcn_exp2f(p1[r]);
  float ps = 0;
#pragma unroll
  for (int r = 0; r < 16; ++r) ps += p0[r];
#pragma unroll
  for (int r = 0; r < 16; ++r) ps += p1[r];
  { auto rr = __builtin_amdgcn_permlane32_swap(__float_as_uint(ps), __float_as_uint(ps), false, false);
    ps = __uint_as_float(rr[0]) + __uint_as_float(rr[1]); }
  l_reg = l_reg * alpha + ps;
#define PK4(P, BASE, OUT) do { unsigned a0 = cvtpk(P[BASE + 0], P[BASE + 1]), a1 = cvtpk(P[BASE + 2], P[BASE + 3]);   \
    unsigned b0 = cvtpk(P[BASE + 4], P[BASE + 5]), b1 = cvtpk(P[BASE + 6], P[BASE + 7]);                              \
    auto r0 = __builtin_amdgcn_permlane32_swap(a0, b0, false, false); auto r1 = __builtin_amdgcn_permlane32_swap(a1, b1, false, false); \
    u32x4 w = {r0[0], r1[0], r0[1], r1[1]}; OUT = *reinterpret_cast<bf16x8*>(&w); } while (0)
  PK4(p0, 0, pa0); PK4(p0, 8, pa1); PK4(p1, 0, pa2); PK4(p1, 8, pa3);
#undef PK4
}
__device__ __forceinline__ void at_qkt(f32x16& p0, f32x16& p1, const char* Ks, const bf16x8* qr, int r32, int hi, float negm) {
#pragma unroll
  for (int r = 0; r < 16; ++r) { p0[r] = negm; p1[r] = negm; }
#pragma unroll
  for (int d0 = 0; d0 < 6; ++d0) {
    const bf16x8 b0 = *(const bf16x8*)(Ks + r32 * AT_KROW + d0 * 32 + hi * 16);
    const bf16x8 b1 = *(const bf16x8*)(Ks + (32 + r32) * AT_KROW + d0 * 32 + hi * 16);
    p0 = MFMA(b0, qr[d0], p0);
    p1 = MFMA(b1, qr[d0], p1);
  }
}
__device__ __forceinline__ int v_st(int k, int c) { const int kk = (k & ~0xC) | ((k & 4) << 1) | ((k & 8) >> 1); return ((kk >> 3) * 4 + (c >> 5)) * 512 + ((kk & 7) * 32 + (c & 31)) * 2; }
__device__ __forceinline__ int v_rd_base(int lane) { return ((lane & 3) << 3) | (((lane >> 2) & 3) << 6) | (((lane >> 4) & 1) << 5) | (((lane >> 5) & 1) << 8); }
constexpr int v_rd_off(int d0, int ks, int half) { return d0 * 512 + ks * 4096 + half * 2048; }
template <int OFF> __device__ __forceinline__ s16x4 tr_read(int vb) {
  s16x4 r; asm volatile("ds_read_b64_tr_b16 %0, %1 offset:%2" : "=&v"(r) : "v"(vb), "i"(OFF) : "memory"); return r;
}
template <int D0> __device__ __forceinline__ void pv_one(f32x16& od, int vb, bf16x8 pa0, bf16x8 pa1, bf16x8 pa2, bf16x8 pa3) {
  const s16x4 l0 = tr_read<v_rd_off(D0, 0, 0)>(vb), h0 = tr_read<v_rd_off(D0, 0, 1)>(vb), l1 = tr_read<v_rd_off(D0, 1, 0)>(vb), h1 = tr_read<v_rd_off(D0, 1, 1)>(vb);
  const s16x4 l2 = tr_read<v_rd_off(D0, 2, 0)>(vb), h2 = tr_read<v_rd_off(D0, 2, 1)>(vb), l3 = tr_read<v_rd_off(D0, 3, 0)>(vb), h3 = tr_read<v_rd_off(D0, 3, 1)>(vb);
  asm volatile("s_waitcnt lgkmcnt(0)" ::: "memory"); SBAR();
#define PK(Lx, Hx) (bf16x8){Lx[0], Lx[1], Lx[2], Lx[3], Hx[0], Hx[1], Hx[2], Hx[3]}
  od = MFMA(pa0, PK(l0, h0), od);
  od = MFMA(pa1, PK(l1, h1), od);
  od = MFMA(pa2, PK(l2, h2), od);
  od = MFMA(pa3, PK(l3, h3), od);
#undef PK
}
__device__ __forceinline__ void pv_d0(f32x16* o, int vb, bf16x8 pa0, bf16x8 pa1, bf16x8 pa2, bf16x8 pa3) {
  pv_one<0>(o[0], vb, pa0, pa1, pa2, pa3); pv_one<1>(o[1], vb, pa0, pa1, pa2, pa3);
}

__device__ void phase_attn(const Params& p, char* lds) {
  unsigned char* ws = p.ws;
  const bf16_t* Qg = (const bf16_t*)(ws + OFF_Q); const bf16_t* KVg = (const bf16_t*)(ws + OFF_KV); const bf16_t* KPg = (const bf16_t*)(ws + OFF_KPE);
  bf16_t* G1 = (bf16_t*)(ws + OFF_G1);
  const f32x2* rope = (const f32x2*)(ws + OFF_ROPE);
  const int tid = threadIdx.x, wid = tid >> 6, lane = tid & 63, r32 = lane & 31, hi = lane >> 5;
  char* V_lds = lds; char* K_lds = lds + AT_KOFF;
  float* wsl = (float*)(lds + AT_WOFF) + wid * 64; float* li_l = wsl; float* al_l = wsl + 32;
  const int skey = tid >> 3, sc8 = (tid & 7) * 8;
  const int pkey = (tid & 255) >> 2, pc8 = (tid & 3) * 8;
  const int vst = v_st(skey, sc8), kst = skey * AT_KROW + sc8 * 2, pst = pkey * AT_KROW + (64 + pc8) * 2;
  const int vb0 = (int)(uintptr_t)V_lds + v_rd_base(lane);
  const int nitems = NB * 16 * 32;
  const int xcd = blockIdx.x & 7, slot = blockIdx.x >> 3, per = gridDim.x >> 3;
  for (int it = slot; it < nitems / 8; it += per) {
    const int pair = (it >> 5) * 8 + xcd, qblk = it & 31;
    const int b = pair >> 4, h = pair & 15;
    const size_t row0 = (size_t)b * TL;
    const size_t qrow = row0 + qblk * 256 + wid * 32 + r32;
    const bf16_t* Kh = KVg + row0 * 2048 + h * 128;
    const bf16_t* Kp = KPg + row0 * 32;
    float m_reg = 0.f, l_reg = 0.f;
    f32x16 o[2];
#pragma unroll
    for (int dd = 0; dd < 2; ++dd)
#pragma unroll
      for (int r = 0; r < 16; ++r) o[dd][r] = 0.f;
    bf16x8 qr[6];
    {
      const bf16_t* Qw = Qg + qrow * 1536 + h * 96 + hi * 8;
#pragma unroll
      for (int d0 = 0; d0 < 6; ++d0) qr[d0] = *(const bf16x8*)(Qw + d0 * 16);
      const int t = qblk * 256 + wid * 32 + r32;
      const f32x2* tb = rope + (hi ? (t & 63) : (t >> 6)) * 8;
      const u32x4 x1 = *(const u32x4*)&qr[4], x2 = *(const u32x4*)&qr[5];
      u32x4 n1, n2;
#pragma unroll
      for (int q = 0; q < 4; ++q) {
        const f32x2 csA = tb[2 * q], csB = tb[2 * q + 1];
        const float a0 = lo16(x1[q]), a1 = hi16(x1[q]), b0 = lo16(x2[q]), b1 = hi16(x2[q]);
        n1[q] = cvtpk(a0 * csA[0] - b0 * csA[1], a1 * csB[0] - b1 * csB[1]);
        n2[q] = cvtpk(a0 * csA[1] + b0 * csA[0], a1 * csB[1] + b1 * csB[0]);
      }
      qr[4] = *(bf16x8*)&n1; qr[5] = *(bf16x8*)&n2;
    }
    struct { bf16x8 vs, ks, ps; } sr_[2];
#define SLOAD(i, k0) do { sr_[i].vs = *(const bf16x8*)(Kh + (size_t)((k0) + skey) * 2048 + 64 + sc8); \
    sr_[i].ks = *(const bf16x8*)(Kh + (size_t)((k0) + skey) * 2048 + sc8); \
    sr_[i].ps = *(const bf16x8*)(Kp + (size_t)((k0) + pkey) * 32 + pc8); } while (0)
#define SWRITE(bb, i) do { *(bf16x8*)(V_lds + (bb) * AT_SHMV + vst) = sr_[i].vs; \
    *(bf16x8*)(K_lds + (bb) * AT_SHMK + kst) = sr_[i].ks; \
    *(bf16x8*)(K_lds + (bb) * AT_SHMK + pst) = sr_[i].ps; } while (0)
#define SWAIT() asm volatile("s_waitcnt vmcnt(3)" ::: "memory")
#define RESC(a) do { if (__any((a) < 1.f)) { if (hi == 0) al_l[r32] = (a); asm volatile("s_waitcnt lgkmcnt(0)" ::: "memory"); \
    _Pragma("unroll") for (int dd = 0; dd < 2; ++dd) _Pragma("unroll") for (int r = 0; r < 16; ++r) o[dd][r] *= al_l[crow(r, hi)]; } } while (0)
    f32x16 pA0, pA1, pB0, pB1; float alA, alB; bf16x8 pa0, pa1, pa2, pa3;
    constexpr int NT = TL / 64;
    SLOAD(0, 0); asm volatile("s_waitcnt vmcnt(0)" ::: "memory"); SWRITE(0, 0); __syncthreads();
    at_qkt(pA0, pA1, K_lds, qr, r32, hi, 0.f); at_partialSM(pA0, pA1, m_reg, alA, true);
    SLOAD(1, 64); SLOAD(0, 128);
    SWAIT(); SWRITE(1, 1); __syncthreads();
    for (int j = 1; j + 1 < NT; j += 2) {
      SBAR(); at_qkt(pB0, pB1, K_lds + AT_SHMK, qr, r32, hi, -m_reg);
      at_finishSM(pA0, pA1, alA, l_reg, pa0, pa1, pa2, pa3); SBAR();
      SLOAD(1, (j + 2) * 64); SBAR();
      pv_d0(o, vb0, pa0, pa1, pa2, pa3); at_partialSM(pB0, pB1, m_reg, alB, false);
      __syncthreads(); SWAIT(); SWRITE(0, 0);
      RESC(alB); __syncthreads();
      SBAR(); at_qkt(pA0, pA1, K_lds, qr, r32, hi, -m_reg);
      at_finishSM(pB0, pB1, alB, l_reg, pa0, pa1, pa2, pa3); SBAR();
      if (j + 3 < NT) SLOAD(0, (j + 3) * 64); SBAR();
      pv_d0(o, vb0 + AT_SHMV, pa0, pa1, pa2, pa3); at_partialSM(pA0, pA1, m_reg, alA, false);
      __syncthreads(); SWAIT(); SWRITE(1, 1);
      RESC(alA); __syncthreads();
    }
    SBAR(); at_qkt(pB0, pB1, K_lds + AT_SHMK, qr, r32, hi, -m_reg);
    at_finishSM(pA0, pA1, alA, l_reg, pa0, pa1, pa2, pa3); SBAR();
    pv_d0(o, vb0, pa0, pa1, pa2, pa3); at_partialSM(pB0, pB1, m_reg, alB, false);
    __syncthreads(); RESC(alB);
    at_finishSM(pB0, pB1, alB, l_reg, pa0, pa1, pa2, pa3); SBAR();
    pv_d0(o, vb0 + AT_SHMV, pa0, pa1, pa2, pa3);
    if (hi == 0) li_l[r32] = l_reg;
    asm volatile("s_waitcnt lgkmcnt(0)" ::: "memory");
    float rli[16];
#pragma unroll
    for (int r = 0; r < 16; ++r) rli[r] = __builtin_amdgcn_rcpf(li_l[crow(r, hi)]);
    bf16_t* Gw = G1 + (row0 + qblk * 256 + wid * 32) * 1024 + h * 64 + r32;
    bf16_t gin[32];
#pragma unroll
    for (int r = 0; r < 16; ++r) { gin[2 * r] = Gw[(size_t)crow(r, hi) * 1024]; gin[2 * r + 1] = Gw[(size_t)crow(r, hi) * 1024 + 32]; }
    asm volatile("" ::: "memory");
#pragma unroll
    for (int r = 0; r < 16; ++r) {
      const int orow = crow(r, hi);
#pragma unroll
      for (int d0 = 0; d0 < 2; ++d0) {
        const float gt = bf2f(gin[2 * r + d0]);
        Gw[(size_t)orow * 1024 + d0 * 32] = f2bf(o[d0][r] * rli[r] * gt * sigmoidf_(gt));
      }
    }
    __syncthreads();
#undef SLOAD
#undef SWRITE
#undef SWAIT
#undef RESC
  }
}

struct XcdWalk {
  int start, count, step, idx;
  __device__ __forceinline__ void init(int ntiles) {
    const int x = blockIdx.x & 7, base = ntiles >> 3, rem = ntiles & 7;
    count = base + (x < rem ? 1 : 0); start = x * base + (x < rem ? x : rem); step = gridDim.x >> 3; idx = blockIdx.x >> 3;
  }
  __device__ __forceinline__ bool next(int& o) { if (idx >= count) return false; o = start + idx; idx += step; return true; }
};
__device__ __forceinline__ void tile_mn(int o, int NT, int& mt, int& nt) { const int g = o >> 3; mt = (g / NT) * 8 + (o & 7); nt = g % NT; }

__global__ __launch_bounds__(NTHR, 1) void fwd_megakernel(Params p) {
  extern __shared__ __attribute__((aligned(16))) char lds[];
  cg::grid_group grid = cg::this_grid();
  unsigned char* ws = p.ws;
  bf16_t* H = (bf16_t*)(ws + OFF_H);
  float* mod = (float*)(ws + OFF_MOD);
  float* CTX1 = (float*)(ws + OFF_CTX1);

  phase_prologue(p, lds);
  grid.sync();
  phase_norm_lerp(p, mod);
  phase_weights(p, lds);
  grid.sync();
  {
    const bf16_t* WIN0 = (const bf16_t*)(ws + OFF_WIN0);
    const int nbig = 264 * 16;
    XcdWalk wk; wk.init(nbig); int o;
    while (wk.next(o)) {
      EpiBf16 e; e.invK = 0.f;
      {
        int mt, jn; tile_mn(o, 16, mt, jn);
        const int j = jn >> 2, n4 = jn & 3, m0 = mt * 256;
        e.dst = (bf16_t*)(ws + OFF_R + (size_t)j * U); e.ldd = 1024; e.col0 = n4 * 256; e.act = 0; e.m0 = m0;
        gemm_tile<0, 256>(lerp_base(p, j, m0), 1024, WIN0 + (size_t)(j * 1024 + n4 * 256) * 1024, 1024, m0, nullptr, lds, e);
      }
    }
    wk.init(264 * 2);
    while (wk.next(o)) {
      EpiBf16 e; e.invK = 0.f;
      {
        int mt, n2; tile_mn(o, 2, mt, n2);
        const int nt = 32 + n2, m0 = mt * 256;
        e.dst = (bf16_t*)(ws + OFF_LORA); e.ldd = 256; e.col0 = (nt - 32) * 128; e.act = (nt == 32) ? 1 : 0; e.m0 = m0;
        gemm_tile<1, 128>(H, 1024, WIN0 + (size_t)nt * 128 * 1024, 1024, m0, p.in[7] + (nt - 28) * 1024, lds, e);
      }
    }
  }
  grid.sync();
  phase_scan(p, lds);
  grid.sync();
  phase_readout(p);
  grid.sync();
  {
    const bf16_t* A = (const bf16_t*)(ws + OFF_G); const bf16_t* W = (const bf16_t*)(ws + OFF_WOUT0);
    XcdWalk wk; wk.init(264 * 4); int o;
    while (wk.next(o)) {
      int mt, nt; tile_mn(o, 4, mt, nt);
      const int m0 = mt * 256;
      const int b = m0 / TL, t0 = m0 - b * TL;
      EpiResid e;
      if (t0 < T) { const size_t orow = (size_t)b * T + t0; e.xin = p.in[0] + orow * 1024; e.xout = p.out + orow * 1024; e.gvec = mod + (size_t)b * 3072 + 2048; }
      else { const size_t orow = (size_t)b * L + (t0 - T); e.xin = p.in[2] + orow * 1024; e.xout = CTX1 + orow * 1024; e.gvec = mod + (size_t)8 * 3072 + 2048; }
      e.n0 = nt * 256;
      gemm_tile<0, 256>(A, 1024, W + (size_t)nt * 256 * 1024, 1024, m0, nullptr, lds, e);
    }
  }
  grid.sync();
  phase_norm(p.out, CTX1, p.in[4] + 1024, mod + 9 * 3072, H);
  grid.sync();
  {
    const bf16_t* W = (const bf16_t*)(ws + OFF_WIN1);
    XcdWalk wk; wk.init(264 * 7); int o;
    while (wk.next(o)) {
      int mt, nt; tile_mn(o, 7, mt, nt);
      const int m0 = mt * 256;
      EpiMlaIn e; e.QC = (bf16_t*)(ws + OFF_QC); e.KVC = (bf16_t*)(ws + OFF_KVC); e.KPE = (bf16_t*)(ws + OFF_KPE); e.G1 = (bf16_t*)(ws + OFF_G1);
      e.rope = (const float*)(ws + OFF_ROPE); e.n0 = nt * 256; e.m0 = m0;
      gemm_tile<0, 256>(H, 1024, W + (size_t)nt * 256 * 1024, 1024, m0, nullptr, lds, e);
    }
  }
  grid.sync();
  {
    const bf16_t* WQ = (const bf16_t*)(ws + OFF_WQB); const bf16_t* WKV = (const bf16_t*)(ws + OFF_WKVB);
    const int nq = 256 * 6, nkv = 264 * 8;
    XcdWalk wk; wk.init(nq); int o;
    while (wk.next(o)) {
      EpiBf16 e; e.act = 0;
      {
        int mt2, nt; tile_mn(o, 6, mt2, nt);
        const int b = mt2 >> 5, m0 = b * TL + (mt2 & 31) * 256;
        e.dst = (bf16_t*)(ws + OFF_Q); e.ldd = 1536; e.col0 = nt * 256; e.m0 = m0; e.invK = 1.f / 384.f;
        gemm_tile<2, 256>((const bf16_t*)(ws + OFF_QC), 384, WQ + (size_t)nt * 256 * 384, 384, m0, nullptr, lds, e);
      }
    }
    wk.init(nkv);
    while (wk.next(o)) {
      EpiBf16 e; e.act = 0;
      {
        int mt, nt; tile_mn(o, 8, mt, nt);
        const int m0 = mt * 256;
        e.dst = (bf16_t*)(ws + OFF_KV); e.ldd = 2048; e.col0 = nt * 256; e.m0 = m0; e.invK = 1.f / 256.f;
        gemm_tile<2, 256>((const bf16_t*)(ws + OFF_KVC), 256, WKV + (size_t)nt * 256 * 256, 256, m0, nullptr, lds, e);
      }
    }
  }
  grid.sync();
  phase_attn(p, lds);
  grid.sync();
  {
    const bf16_t* A = (const bf16_t*)(ws + OFF_G1); const bf16_t* W = (const bf16_t*)(ws + OFF_WOUT1);
    XcdWalk wk; wk.init(256 * 4); int o;
    while (wk.next(o)) {
      int mt2, nt; tile_mn(o, 4, mt2, nt);
      const int b = mt2 >> 5, t0 = (mt2 & 31) * 256, m0 = b * TL + t0;
      const size_t orow = (size_t)b * T + t0;
      EpiResid e; e.xin = p.out + orow * 1024; e.xout = p.out + orow * 1024; e.gvec = mod + (size_t)(9 + b) * 3072 + 2048; e.n0 = nt * 256;
      gemm_tile<0, 256>(A, 1024, W + (size_t)nt * 256 * 1024, 1024, m0, nullptr, lds, e);
    }
  }
  grid.sync();
  phase_final(p.out, p.in[27]);
}

extern "C" void kernel_launch(void* const* d_in, const int* in_sizes, int n_in, void* d_out, int out_size, void* d_ws, size_t ws_size, hipStream_t stream) {
  static int grid_blocks = 0;
  if (grid_blocks == 0) {
    if (n_in != 28 || ws_size < WS_END + (size_t)(NTOK - LERP3_SPLIT) * 2048 || out_size != NB * T * D) { fprintf(stderr, "kernel_launch: unexpected shapes (n_in %d, ws %zu need %zu, out %d)\n", n_in, ws_size, (size_t)WS_END, out_size); grid_blocks = -1; return; }
    int dev = 0, cus = 0, per_cu = 0;
    hipGetDevice(&dev);
    hipDeviceGetAttribute(&cus, hipDeviceAttributeMultiprocessorCount, dev);
    if (hipFuncSetAttribute((const void*)fwd_megakernel, hipFuncAttributeMaxDynamicSharedMemorySize, LDS_BYTES) != hipSuccess) { fprintf(stderr, "kernel_launch: hipFuncSetAttribute failed\n"); grid_blocks = -1; return; }
    hipOccupancyMaxActiveBlocksPerMultiprocessor(&per_cu, (const void*)fwd_megakernel, NTHR, LDS_BYTES);
    if (per_cu < 1) { fprintf(stderr, "kernel_launch: occupancy query says %d blocks per CU\n", per_cu); per_cu = 1; }
    (void)hipGetLastError();
    grid_blocks = cus;
    if (grid_blocks > 256) grid_blocks = 256;
    grid_blocks &= ~7;
  }
  if (grid_blocks <= 0) return;
  Params p{};
  for (int i = 0; i < 28; ++i) p.in[i] = (const float*)d_in[i];
  p.out = (float*)d_out; p.ws = (unsigned char*)d_ws;
  void* args[] = {&p};
  hipError_t e = hipLaunchCooperativeKernel((const void*)fwd_megakernel, dim3(grid_blocks), dim3(NTHR), args, LDS_BYTES, stream);
  if (e != hipSuccess) fprintf(stderr, "cooperative launch failed: %s (grid %d)\n", hipGetErrorString(e), grid_blocks);
}
```

```cpp
#include <hip/hip_runtime.h>
#include <hip/hip_cooperative_groups.h>
#include <cstdio>
#include <cstdint>
namespace cg = cooperative_groups;

typedef unsigned short bf16_t;
typedef short bf16x8 __attribute__((ext_vector_type(8)));
typedef short s16x4 __attribute__((ext_vector_type(4)));
typedef float f32x16 __attribute__((ext_vector_type(16)));
typedef float f32x4 __attribute__((ext_vector_type(4)));
typedef float f32x2 __attribute__((ext_vector_type(2)));
typedef unsigned u32x4 __attribute__((ext_vector_type(4)));
typedef unsigned u32x2 __attribute__((ext_vector_type(2)));

constexpr int D = 1024, NB = 8, T = 8192, L = 256, TL = T + L, NTOK = NB * TL;
constexpr int NTHR = 512;

constexpr size_t U = (size_t)NTOK * 1024 * 2;
constexpr size_t OFF_H = 0, OFF_R = U, OFF_K = 2 * U, OFF_V = 3 * U, OFF_G = 4 * U, OFF_Y0 = 5 * U, OFF_Y1 = 6 * U;
constexpr size_t OFF_LORA = 7 * U;
constexpr size_t OFF_BONUS = OFF_LORA + (size_t)NTOK * 256 * 2;
constexpr size_t OFF_WIN0 = OFF_BONUS + (size_t)2 * NTOK * 16 * 4;
constexpr size_t OFF_WOUT0 = OFF_WIN0 + (size_t)4352 * 1024 * 2;
constexpr size_t OFF_WIN1 = OFF_WOUT0 + (size_t)1024 * 1024 * 2;
constexpr size_t OFF_WQB = OFF_WIN1 + (size_t)1792 * 1024 * 2;
constexpr size_t OFF_WKVB = OFF_WQB + (size_t)1536 * 384 * 2;
constexpr size_t OFF_WOUT1 = OFF_WKVB + (size_t)2048 * 256 * 2;
constexpr size_t OFF_MOD = OFF_WOUT1 + (size_t)1024 * 1024 * 2;
constexpr size_t OFF_ROPE = OFF_MOD + (size_t)2 * 9 * 3072 * 4;
constexpr size_t OFF_CTX1 = OFF_ROPE + (size_t)128 * 8 * 2 * 4;
constexpr size_t WS_END = OFF_CTX1 + (size_t)2048 * 1024 * 4;
constexpr size_t OFF_QC = OFF_V;
constexpr size_t OFF_KVC = OFF_QC + (size_t)NTOK * 384 * 2;
constexpr size_t OFF_KPE = OFF_KVC + (size_t)NTOK * 256 * 2;
constexpr size_t OFF_G1 = OFF_G;
constexpr size_t OFF_Q = OFF_R;
constexpr size_t OFF_KV = OFF_Y0;

struct Params { const float* in[28]; float* out; unsigned char* ws; };

typedef __bf16 bf16x2_t __attribute__((ext_vector_type(2)));
__device__ __forceinline__ unsigned cvtpk(float lo, float hi) { f32x2 v = {lo, hi}; bf16x2_t b = __builtin_convertvector(v, bf16x2_t); return *(unsigned*)&b; }
__device__ __forceinline__ float bf2f(bf16_t u) { return __uint_as_float(((unsigned)u) << 16); }
__device__ __forceinline__ bf16_t f2bf(float f) { return (bf16_t)(cvtpk(f, 0.f) & 0xffffu); }
__device__ __forceinline__ float lo16(unsigned w) { return __uint_as_float(w << 16); }
__device__ __forceinline__ float hi16(unsigned w) { return __uint_as_float(w & 0xffff0000u); }
__device__ __forceinline__ void st_bf16x4(bf16_t* p, float a, float b, float c, float d) { u32x2 w = {cvtpk(a, b), cvtpk(c, d)}; *(u32x2*)p = w; }
__device__ __forceinline__ void st_bf16x4_nt(bf16_t* p, float a, float b, float c, float d) { u32x2 w = {cvtpk(a, b), cvtpk(c, d)}; __builtin_nontemporal_store(w, (u32x2*)p); }
__device__ __forceinline__ float wave_sum(float v) {
#pragma unroll
  for (int o = 32; o; o >>= 1) v += __shfl_xor(v, o);
  return v;
}
__device__ __forceinline__ float dpp_f(float v, const int ctrl_sel) {
  int r;
  if (ctrl_sel == 0) r = __builtin_amdgcn_update_dpp(0, __float_as_int(v), 0xB1, 0xF, 0xF, true);
  else if (ctrl_sel == 1) r = __builtin_amdgcn_update_dpp(0, __float_as_int(v), 0x4E, 0xF, 0xF, true);
  else r = __builtin_amdgcn_update_dpp(0, __float_as_int(v), 0x141, 0xF, 0xF, true);
  return __int_as_float(r);
}
__device__ __forceinline__ float red8(float v) { v += dpp_f(v, 0); v += dpp_f(v, 1); v += dpp_f(v, 2); return v; }
__device__ __forceinline__ int crow(int r, int hi) { return (r & 3) + 8 * (r >> 2) + 4 * hi; }
__device__ __forceinline__ float sigmoidf_(float x) { return 1.f / (1.f + __expf(-x)); }
#define MFMA(a, b, c) __builtin_amdgcn_mfma_f32_32x32x16_bf16((a), (b), (c), 0, 0, 0)

constexpr int G_LDT = 144;
constexpr int G_SSQ_OFF = 2 * (256 + 256) * G_LDT;
constexpr int LDS_BYTES = G_SSQ_OFF + 1024;

template <int AMODE, int BN, class Epi>
__device__ __forceinline__ void gemm_tile(const bf16_t* A, const int lda, const bf16_t* Bt, const int K, const int m0, const float* mu, char* lds, const Epi& epi) {
  constexpr int WN = BN / 64, MI = WN, NBR = BN / 64, G_STAGE = (256 + BN) * G_LDT;
  const int tid = threadIdx.x, lane = tid & 63, wid = tid >> 6, r32 = lane & 31, hi = lane >> 5;
  const int wm = wid / WN, wn = wid % WN;
  const int srow = tid >> 3, scc = (tid & 7) * 8;
  f32x16 acc[MI][2];
#pragma unroll
  for (int i = 0; i < MI; ++i)
#pragma unroll
    for (int j = 0; j < 2; ++j)
#pragma unroll
      for (int r = 0; r < 16; ++r) acc[i][j][r] = 0.f;
  bf16x8 ra[4], rb[NBR], rp[4], rn[4];
  float ssq[4] = {0.f, 0.f, 0.f, 0.f};
  int dprev[4], dnext[4];
  if constexpr (AMODE == 1) {
    const int t0 = m0 % TL;
#pragma unroll
    for (int i = 0; i < 4; ++i) { const int t = t0 + srow + 64 * i; dprev[i] = (t != 0 && t != T) ? 1 : 0; dnext[i] = (t != T - 1 && t != TL - 1) ? 1 : 0; }
  }
  auto gload = [&](int k0) {
#pragma unroll
    for (int i = 0; i < 4; ++i) {
      const bf16_t* ap = A + (size_t)(m0 + srow + 64 * i) * lda + k0 + scc;
      ra[i] = *(const bf16x8*)ap;
      if constexpr (AMODE == 1) { rp[i] = *(const bf16x8*)(ap - dprev[i] * lda); rn[i] = *(const bf16x8*)(ap + dnext[i] * lda); }
    }
#pragma unroll
    for (int i = 0; i < NBR; ++i) rb[i] = *(const bf16x8*)(Bt + (size_t)(srow + 64 * i) * K + k0 + scc);
  };
  auto lstore = [&](int s, int k0) {
    char* base = lds + s * G_STAGE;
    if constexpr (AMODE == 1) {
      const f32x4 m0v = *(const f32x4*)(mu + k0 + scc), m1v = *(const f32x4*)(mu + k0 + scc + 4);
      const float mm[8] = {m0v[0], m0v[1], m0v[2], m0v[3], m1v[0], m1v[1], m1v[2], m1v[3]};
#pragma unroll
      for (int i = 0; i < 4; ++i) {
        const u32x4 hc = *(const u32x4*)&ra[i], hp = *(const u32x4*)&rp[i], hn = *(const u32x4*)&rn[i];
        const float fp = dprev[i] ? 0.5f : 0.f, fn = dnext[i] ? 0.5f : 0.f;
        u32x4 w;
#pragma unroll
        for (int q = 0; q < 4; ++q) {
          const float c0 = lo16(hc[q]), c1 = hi16(hc[q]);
          const float x0 = fp * lo16(hp[q]) + fn * lo16(hn[q]) - c0, x1 = fp * hi16(hp[q]) + fn * hi16(hn[q]) - c1;
          w[q] = cvtpk(c0 + x0 * mm[2 * q], c1 + x1 * mm[2 * q + 1]);
        }
        *(u32x4*)(base + (srow + 64 * i) * G_LDT + scc * 2) = w;
      }
    } else {
#pragma unroll
      for (int i = 0; i < 4; ++i) {
        *(bf16x8*)(base + (srow + 64 * i) * G_LDT + scc * 2) = ra[i];
        if constexpr (AMODE == 2) {
          const u32x4 hc = *(const u32x4*)&ra[i];
#pragma unroll
          for (int q = 0; q < 4; ++q) { const float c0 = lo16(hc[q]), c1 = hi16(hc[q]); ssq[i] += c0 * c0 + c1 * c1; }
        }
      }
    }
#pragma unroll
    for (int i = 0; i < NBR; ++i) *(bf16x8*)(base + 256 * G_LDT + (srow + 64 * i) * G_LDT + scc * 2) = rb[i];
  };
  const int nk = K >> 6;
  gload(0);
  lstore(0, 0);
  if (nk > 1) gload(64);
  __syncthreads();
#pragma unroll 1
  for (int kt = 0; kt < nk; ++kt) {
    const int s = kt & 1;
    if (kt + 1 < nk) lstore(s ^ 1, (kt + 1) * 64);
    if (kt + 2 < nk) gload((kt + 2) * 64);
    {
      const char* Ab = lds + s * G_STAGE + (wm * (32 * MI) + r32) * G_LDT + hi * 16;
      const char* Bb = lds + s * G_STAGE + 256 * G_LDT + (wn * 64 + r32) * G_LDT + hi * 16;
      bf16x8 fb[2][2], fa[2][MI];
      fb[0][0] = *(const bf16x8*)(Bb); fb[0][1] = *(const bf16x8*)(Bb + 32 * G_LDT);
#pragma unroll
      for (int mi = 0; mi < MI; ++mi) fa[0][mi] = *(const bf16x8*)(Ab + mi * 32 * G_LDT);
#pragma unroll
      for (int ks = 0; ks < 4; ++ks) {
        const int sl = ks & 1;
        if (ks + 1 < 4) {
          fb[sl ^ 1][0] = *(const bf16x8*)(Bb + (ks + 1) * 32); fb[sl ^ 1][1] = *(const bf16x8*)(Bb + 32 * G_LDT + (ks + 1) * 32);
#pragma unroll
          for (int mi = 0; mi < MI; ++mi) fa[sl ^ 1][mi] = *(const bf16x8*)(Ab + mi * 32 * G_LDT + (ks + 1) * 32);
        }
#pragma unroll
        for (int mi = 0; mi < MI; ++mi) { acc[mi][0] = MFMA(fb[sl][0], fa[sl][mi], acc[mi][0]); acc[mi][1] = MFMA(fb[sl][1], fa[sl][mi], acc[mi][1]); }
      }
    }
    __syncthreads();
  }
  float* ssq_l = (float*)(lds + G_SSQ_OFF);
  if constexpr (AMODE == 2) {
#pragma unroll
    for (int i = 0; i < 4; ++i) { const float v = red8(ssq[i]); if ((tid & 7) == 0) ssq_l[srow + 64 * i] = v; }
    __syncthreads();
  }
#pragma unroll
  for (int mi = 0; mi < MI; ++mi) {
    const int lrow = wm * (32 * MI) + mi * 32 + r32;
    float aux = 0.f;
    if constexpr (AMODE == 2) aux = ssq_l[lrow];
    epi(lrow, wn * 64 + 4 * hi, acc[mi][0], acc[mi][1], aux);
  }
}

struct EpiBf16 {
  bf16_t* dst; int ldd; int col0; int m0; int act; float invK;
  __device__ __forceinline__ void operator()(int lrow, int nc, const f32x16& a0, const f32x16& a1, float aux) const { one(lrow, nc, a0, aux); one(lrow, nc + 32, a1, aux); }
  __device__ __forceinline__ void one(int lrow, int nc, const f32x16& a, float aux) const {
    float sc = 1.f;
    if (invK > 0.f) sc = rsqrtf(aux * invK + 1e-6f);
    bf16_t* p = dst + (size_t)(m0 + lrow) * ldd + col0 + nc;
#pragma unroll
    for (int g = 0; g < 4; ++g) {
      float v0 = a[4 * g] * sc, v1 = a[4 * g + 1] * sc, v2 = a[4 * g + 2] * sc, v3 = a[4 * g + 3] * sc;
      if (act) {
        v0 = 1.f - 2.f / (__expf(2.f * v0) + 1.f); v1 = 1.f - 2.f / (__expf(2.f * v1) + 1.f);
        v2 = 1.f - 2.f / (__expf(2.f * v2) + 1.f); v3 = 1.f - 2.f / (__expf(2.f * v3) + 1.f);
      }
      st_bf16x4(p + 8 * g, v0, v1, v2, v3);
    }
  }
};
struct EpiResid {
  const float* xin; float* xout; const float* gvec; int n0;
  __device__ __forceinline__ void operator()(int lrow, int nc, const f32x16& a0, const f32x16& a1, float) const {
    const size_t o = (size_t)lrow * 1024 + n0 + nc;
    f32x4 xv[8], gv[8];
#pragma unroll
    for (int g = 0; g < 4; ++g) {
      xv[g] = *(const f32x4*)(xin + o + 8 * g); xv[4 + g] = *(const f32x4*)(xin + o + 32 + 8 * g);
      gv[g] = *(const f32x4*)(gvec + n0 + nc + 8 * g); gv[4 + g] = *(const f32x4*)(gvec + n0 + nc + 32 + 8 * g);
    }
    f32x4 r[8];
#pragma unroll
    for (int g = 0; g < 4; ++g)
#pragma unroll
      for (int e = 0; e < 4; ++e) { r[g][e] = xv[g][e] + gv[g][e] * a0[4 * g + e]; r[4 + g][e] = xv[4 + g][e] + gv[4 + g][e] * a1[4 * g + e]; }
    asm volatile("" ::: "memory");
#pragma unroll
    for (int g = 0; g < 4; ++g) { *(f32x4*)(xout + o + 8 * g) = r[g]; *(f32x4*)(xout + o + 32 + 8 * g) = r[4 + g]; }
  }
};
struct EpiMlaIn {
  bf16_t *QC, *KVC, *KPE, *G1; const float* rope; int n0; int m0;
  __device__ __forceinline__ void operator()(int lrow, int nc, const f32x16& a0, const f32x16& a1, float) const { one(lrow, nc, a0); one(lrow, nc + 32, a1); }
  __device__ __forceinline__ void one(int lrow, int nc, const f32x16& a) const {
    const int row = m0 + lrow, gc = n0 + nc, g32 = gc & ~31;
    if (g32 == 640) {
      const int t = (m0 % TL) + lrow, hi4 = gc - 640;
      bf16_t* p = KPE + (size_t)row * 32;
      if (t < T) {
        const f32x2* tr = (const f32x2*)rope + (t >> 6) * 8 + hi4;
        const f32x2* tc = (const f32x2*)rope + (t & 63) * 8 + hi4;
        float o1[8], o2[8];
#pragma unroll
        for (int e = 0; e < 4; ++e) {
          const f32x2 cs0 = tr[e], cs1 = tc[e];
          const float x1a = a[e], x2a = a[8 + e];
          const float x1b = a[4 + e], x2b = a[12 + e];
          o1[e] = x1a * cs0[0] - x2a * cs0[1]; o2[e] = x1a * cs0[1] + x2a * cs0[0];
          o1[4 + e] = x1b * cs1[0] - x2b * cs1[1]; o2[4 + e] = x1b * cs1[1] + x2b * cs1[0];
        }
        st_bf16x4(p + hi4, o1[0], o1[1], o1[2], o1[3]);
        st_bf16x4(p + 8 + hi4, o1[4], o1[5], o1[6], o1[7]);
        st_bf16x4(p + 16 + hi4, o2[0], o2[1], o2[2], o2[3]);
        st_bf16x4(p + 24 + hi4, o2[4], o2[5], o2[6], o2[7]);
      } else {
#pragma unroll
        for (int g = 0; g < 4; ++g) st_bf16x4(p + 8 * g + hi4, a[4 * g], a[4 * g + 1], a[4 * g + 2], a[4 * g + 3]);
      }
      return;
    }
    if (g32 > 640 && g32 < 768) return;
    bf16_t* p;
    if (gc < 384) p = QC + (size_t)row * 384 + gc;
    else if (gc < 640) p = KVC + (size_t)row * 256 + (gc - 384);
    else p = G1 + (size_t)row * 1024 + (gc - 768);
#pragma unroll
    for (int g = 0; g < 4; ++g) st_bf16x4(p + 8 * g, a[4 * g], a[4 * g + 1], a[4 * g + 2], a[4 * g + 3]);
  }
};

constexpr float AT_SCALE = 0.10206207261596575f;
constexpr float AT_THR = 8.f;
__device__ void tr_job(const float* src, int ld, int K, int N, bf16_t* dst, const float* kscale, char* lds, float gscale = 1.f) {
  float* tile = (float*)lds;
  const int tid = threadIdx.x, nK = K >> 6, nN = (N + 63) >> 6;
  for (int tIdx = blockIdx.x; tIdx < nK * nN; tIdx += gridDim.x) {
    const int k0 = (tIdx % nK) * 64, n0 = (tIdx / nK) * 64;
#pragma unroll
    for (int i = 0; i < 8; ++i) {
      const int kk = (tid >> 6) + 8 * i, nn = tid & 63;
      float v = 0.f;
      if (n0 + nn < N) { v = src[(size_t)(k0 + kk) * ld + n0 + nn] * gscale; if (kscale) v *= kscale[k0 + kk]; }
      tile[kk * 65 + nn] = v;
    }
    __syncthreads();
#pragma unroll
    for (int i = 0; i < 8; ++i) {
      const int nn = (tid >> 6) + 8 * i, kk = tid & 63;
      if (n0 + nn < N) dst[(size_t)(n0 + nn) * K + k0 + kk] = f2bf(tile[kk * 65 + nn]);
    }
    __syncthreads();
  }
}

__device__ void phase_weights(const Params& p, char* lds) {
  unsigned char* ws = p.ws;
  bf16_t* WIN0 = (bf16_t*)(ws + OFF_WIN0);
  for (int j = 0; j < 4; ++j) tr_job(p.in[8] + (size_t)j * 1024 * 1024, 1024, 1024, 1024, WIN0 + (size_t)j * 1024 * 1024, nullptr, lds);
  for (int d = 0; d < 2; ++d) {
    tr_job(p.in[10] + (size_t)d * 1024 * 64, 64, 1024, 64, WIN0 + (size_t)(4096 + d * 64) * 1024, nullptr, lds);
    tr_job(p.in[13] + (size_t)d * 1024 * 64, 64, 1024, 64, WIN0 + (size_t)(4224 + d * 64) * 1024, nullptr, lds);
  }
  tr_job(p.in[20], 1024, 1024, 1024, (bf16_t*)(ws + OFF_WOUT0), nullptr, lds);
  bf16_t* WIN1 = (bf16_t*)(ws + OFF_WIN1);
  tr_job(p.in[21], 1696, 1024, 640, WIN1, nullptr, lds);
  tr_job(p.in[21] + 640, 1696, 1024, 32, WIN1 + (size_t)640 * 1024, nullptr, lds);
  tr_job(p.in[21] + 672, 1696, 1024, 1024, WIN1 + (size_t)768 * 1024, nullptr, lds);
  for (int i = blockIdx.x * NTHR + threadIdx.x; i < 96 * 1024; i += gridDim.x * NTHR) WIN1[(size_t)672 * 1024 + i] = 0;
  tr_job(p.in[23], 1536, 384, 1536, (bf16_t*)(ws + OFF_WQB), p.in[22], lds, AT_SCALE * 1.4426950408889634f);
  tr_job(p.in[25], 2048, 256, 2048, (bf16_t*)(ws + OFF_WKVB), p.in[24], lds);
  tr_job(p.in[26], 1024, 1024, 1024, (bf16_t*)(ws + OFF_WOUT1), nullptr, lds);
}
__device__ void phase_prologue(const Params& p, char* lds) {
  unsigned char* ws = p.ws;
  {
    const int i = blockIdx.x * NTHR + threadIdx.x;
    if (i < 1024) {
      const float invf[8] = {1.f, 0.316227766016838f, 0.1f, 0.0316227766016838f, 0.01f, 0.00316227766016838f, 0.001f, 0.000316227766016838f};
      const int pos = i >> 3, m = i & 7;
      float inv = invf[0];
#pragma unroll
      for (int q = 1; q < 8; ++q) inv = (m == q) ? invf[q] : inv;
      const float ang = (float)pos * inv;
      const float kf = rintf(ang * 0.15915494309189535f);
      float r = fmaf(-kf, 6.28125f, ang);
      r = fmaf(-kf, 1.9353071795864769e-3f, r);
      float* rt = (float*)(ws + OFF_ROPE);
      rt[2 * i] = cosf(r); rt[2 * i + 1] = sinf(r);
    }
  }
  {
    float* sil = (float*)lds;
    float* red = sil + 9 * 1024;
    const int tid = threadIdx.x;
    for (int i = tid; i < 9 * 1024; i += NTHR) {
      const int bi = i >> 10, k = i & 1023;
      const float cv = bi < 8 ? p.in[1][bi * 1024 + k] : p.in[3][k];
      sil[i] = cv / (1.f + __expf(-cv));
    }
    __syncthreads();
    float* mod = (float*)(ws + OFF_MOD);
    for (int item = blockIdx.x; item < 192; item += gridDim.x) {
      const int l = item / 96, n0 = (item % 96) * 32, col = tid & 31, kg = tid >> 5;
      float acc[9];
#pragma unroll
      for (int bi = 0; bi < 9; ++bi) acc[bi] = 0.f;
      const float* wp = p.in[5] + ((size_t)l * 1024 + kg * 64) * 3072 + n0 + col;
      for (int kk = 0; kk < 64; ++kk) {
        const float w = wp[(size_t)kk * 3072];
#pragma unroll
        for (int bi = 0; bi < 9; ++bi) acc[bi] += sil[bi * 1024 + kg * 64 + kk] * w;
      }
#pragma unroll
      for (int bi = 0; bi < 9; ++bi) red[(kg * 9 + bi) * 32 + col] = acc[bi];
      __syncthreads();
      if (tid < 288) {
        const int bi = tid >> 5;
        float s = 0.f;
#pragma unroll
        for (int g = 0; g < 16; ++g) s += red[(g * 9 + bi) * 32 + col];
        mod[((size_t)l * 9 + bi) * 3072 + n0 + col] = s + p.in[6][l * 3072 + n0 + col];
      }
      __syncthreads();
    }
  }
}

__device__ __forceinline__ const float* row_src(const float* xsrc, const float* csrc, int n, int& bi) {
  const int b = n / TL, t = n - b * TL;
  if (t < T) { bi = b; return xsrc + ((size_t)b * T + t) * D; }
  bi = 8; return csrc + ((size_t)b * L + (t - T)) * D;
}
__device__ void phase_norm(const float* xsrc, const float* csrc, const float* ng, const float* mod, bf16_t* H) {
  const int lane = threadIdx.x & 63, gw = blockIdx.x * 8 + (threadIdx.x >> 6), nw = gridDim.x * 8;
  f32x4 g4[4];
#pragma unroll
  for (int i = 0; i < 4; ++i) g4[i] = *(const f32x4*)(ng + i * 256 + lane * 4);
  f32x4 va[4], vb[4]; int bia = 0, bib = 0;
  if (gw < NTOK) { const float* src = row_src(xsrc, csrc, gw, bia);
#pragma unroll
    for (int i = 0; i < 4; ++i) va[i] = *(const f32x4*)(src + i * 256 + lane * 4); }
  for (int n = gw; n < NTOK; n += nw) {
    if (n + nw < NTOK) { const float* src = row_src(xsrc, csrc, n + nw, bib);
#pragma unroll
      for (int i = 0; i < 4; ++i) vb[i] = *(const f32x4*)(src + i * 256 + lane * 4); }
    float ss = 0.f;
#pragma unroll
    for (int i = 0; i < 4; ++i) ss += va[i][0] * va[i][0] + va[i][1] * va[i][1] + va[i][2] * va[i][2] + va[i][3] * va[i][3];
    ss = wave_sum(ss);
    const float rstd = rsqrtf(ss * (1.f / 1024.f) + 1e-6f);
    const float* m = mod + bia * 3072;
#pragma unroll
    for (int i = 0; i < 4; ++i) {
      const int c = i * 256 + lane * 4;
      const f32x4 sh = *(const f32x4*)(m + c), sc = *(const f32x4*)(m + 1024 + c);
      float o[4];
#pragma unroll
      for (int e = 0; e < 4; ++e) o[e] = va[i][e] * rstd * g4[i][e] * (1.f + sc[e]) + sh[e];
      st_bf16x4(H + (size_t)n * 1024 + c, o[0], o[1], o[2], o[3]);
    }
#pragma unroll
    for (int i = 0; i < 4; ++i) va[i] = vb[i];
    bia = bib;
  }
}

constexpr int LERP3_SPLIT = 63488;
__device__ __forceinline__ bf16_t* lerp_base(const Params& p, int j, int row) {
  if (j == 0) return (bf16_t*)(p.ws + OFF_Y0);
  if (j == 1) return (bf16_t*)(p.ws + OFF_Y1);
  if (j == 2) return (bf16_t*)p.out;
  if (row < LERP3_SPLIT) return (bf16_t*)p.out + (size_t)NTOK * 1024;
  return (bf16_t*)(p.ws + WS_END) - (size_t)LERP3_SPLIT * 1024;
}
struct RowX { f32x4 v[4]; int bi; };
__device__ __forceinline__ void ld_row(const Params& p, int n, int lane, RowX& r) {
  const float* src = row_src(p.in[0], p.in[2], n, r.bi);
#pragma unroll
  for (int i = 0; i < 4; ++i) r.v[i] = *(const f32x4*)(src + i * 256 + lane * 4);
}
__device__ __forceinline__ void fin_row(const float* mod, const f32x4 (&g4)[4], int lane, const RowX& r, float (&h)[16]) {
  float ss = 0.f;
#pragma unroll
  for (int i = 0; i < 4; ++i) ss += r.v[i][0] * r.v[i][0] + r.v[i][1] * r.v[i][1] + r.v[i][2] * r.v[i][2] + r.v[i][3] * r.v[i][3];
  ss = wave_sum(ss);
  const float rstd = rsqrtf(ss * (1.f / 1024.f) + 1e-6f);
  const float* m = mod + r.bi * 3072;
#pragma unroll
  for (int i = 0; i < 4; ++i) {
    const int c = i * 256 + lane * 4;
    const f32x4 sh = *(const f32x4*)(m + c), sc = *(const f32x4*)(m + 1024 + c);
#pragma unroll
    for (int e = 0; e < 4; ++e) {
      const float hv = r.v[i][e] * rstd * g4[i][e] * (1.f + sc[e]) + sh[e];
      h[4 * i + e] = __uint_as_float(cvtpk(hv, 0.f) << 16);
    }
  }
}
__device__ void phase_norm_lerp(const Params& p, const float* mod) {
  const int lane = threadIdx.x & 63, gw = blockIdx.x * 8 + (threadIdx.x >> 6), nw = gridDim.x * 8;
  const int per = (NTOK + nw - 1) / nw;
  const int r0 = gw * per, r1 = (r0 + per < NTOK) ? r0 + per : NTOK;
  if (r0 >= r1) return;
  bf16_t* H = (bf16_t*)(p.ws + OFF_H);
  f32x4 g4[4];
#pragma unroll
  for (int i = 0; i < 4; ++i) g4[i] = *(const f32x4*)(p.in[4] + i * 256 + lane * 4);
  float mu[4][16];
#pragma unroll
  for (int j = 0; j < 4; ++j)
#pragma unroll
    for (int i = 0; i < 4; ++i) {
      const f32x4 m4 = *(const f32x4*)(p.in[7] + j * 1024 + i * 256 + lane * 4);
      mu[j][4 * i] = m4[0]; mu[j][4 * i + 1] = m4[1]; mu[j][4 * i + 2] = m4[2]; mu[j][4 * i + 3] = m4[3];
    }
  float hp[16], hc[16], hn[16];
  RowX xa, xb, xc;
  if (r0 > 0) { ld_row(p, r0 - 1, lane, xc); }
  ld_row(p, r0, lane, xa);
  if (r0 + 1 < NTOK) ld_row(p, r0 + 1, lane, xb);
  if (r0 > 0) fin_row(mod, g4, lane, xc, hp);
  else {
#pragma unroll
    for (int e = 0; e < 16; ++e) hp[e] = 0.f;
  }
  fin_row(mod, g4, lane, xa, hc);
  xa = xb;
  if (r0 + 2 < NTOK) ld_row(p, r0 + 2, lane, xb);
  for (int n = r0; n < r1; ++n) {
    const int t = n % TL;
    if (n + 3 < NTOK) ld_row(p, n + 3, lane, xc);
    if (n + 1 < NTOK) fin_row(mod, g4, lane, xa, hn);
    else {
#pragma unroll
      for (int e = 0; e < 16; ++e) hn[e] = 0.f;
    }
    const float fp = (t != 0 && t != T) ? 0.5f : 0.f, fn = (t != T - 1 && t != TL - 1) ? 0.5f : 0.f;
#pragma unroll
    for (int i = 0; i < 4; ++i) st_bf16x4_nt(H + (size_t)n * 1024 + i * 256 + lane * 4, hc[4 * i], hc[4 * i + 1], hc[4 * i + 2], hc[4 * i + 3]);
#pragma unroll
    for (int j = 0; j < 4; ++j) {
      bf16_t* dst = lerp_base(p, j, n) + (size_t)n * 1024 + lane * 4;
#pragma unroll
      for (int i = 0; i < 4; ++i) {
        float o[4];
#pragma unroll
        for (int e = 0; e < 4; ++e) { const float c = hc[4 * i + e]; o[e] = c + (fp * hp[4 * i + e] + fn * hn[4 * i + e] - c) * mu[j][4 * i + e]; }
        st_bf16x4_nt(dst + i * 256, o[0], o[1], o[2], o[3]);
      }
    }
#pragma unroll
    for (int e = 0; e < 16; ++e) { hp[e] = hc[e]; hc[e] = hn[e]; }
    xa = xb; xb = xc;
  }
}

__device__ void phase_final(float* out, const float* fg) {
  const int lane = threadIdx.x & 63, gw = blockIdx.x * 8 + (threadIdx.x >> 6), nw = gridDim.x * 8;
  f32x4 g4[4];
#pragma unroll
  for (int i = 0; i < 4; ++i) g4[i] = *(const f32x4*)(fg + i * 256 + lane * 4);
  f32x4 va[4], vb[4];
  if (gw < NB * T) {
#pragma unroll
    for (int i = 0; i < 4; ++i) va[i] = *(const f32x4*)(out + (size_t)gw * D + i * 256 + lane * 4); }
  for (int n = gw; n < NB * T; n += nw) {
    if (n + nw < NB * T) {
#pragma unroll
      for (int i = 0; i < 4; ++i) vb[i] = *(const f32x4*)(out + (size_t)(n + nw) * D + i * 256 + lane * 4); }
    float ss = 0.f;
#pragma unroll
    for (int i = 0; i < 4; ++i) ss += va[i][0] * va[i][0] + va[i][1] * va[i][1] + va[i][2] * va[i][2] + va[i][3] * va[i][3];
    ss = wave_sum(ss);
    const float rstd = rsqrtf(ss * (1.f / 1024.f) + 1e-6f);
#pragma unroll
    for (int i = 0; i < 4; ++i) {
      f32x4 o;
#pragma unroll
      for (int e = 0; e < 4; ++e) o[e] = va[i][e] * rstd * g4[i][e];
      *(f32x4*)(out + (size_t)n * D + i * 256 + lane * 4) = o;
    }
#pragma unroll
    for (int i = 0; i < 4; ++i) va[i] = vb[i];
  }
}

__device__ __forceinline__ int scan_row(int g, int d, int b) {
  if (g < L) { const int tt = d ? (L - 1 - g) : g; return b * TL + T + tt; }
  g -= L; const int tt = d ? (T - 1 - g) : g; return b * TL + tt;
}
constexpr int SC_P = 0, SC_ARA = 8192, SC_ARR = SC_ARA + 4096, SC_BK = SC_ARR + 4096, SC_SCAL = SC_BK + 8192, SC_VV = SC_SCAL + 1024, SC_BUF = SC_VV + 8192;
constexpr int SC_IC = 2 * SC_BUF, SC_SCR = SC_IC + 8192, SC_YB = SC_SCR + 16384, SC_END = SC_YB + 2 * 8192;
#define MFMA16(a, b, c) __builtin_amdgcn_mfma_f32_16x16x32_bf16((a), (b), (c), 0, 0, 0)
struct ScBlk { u32x4 aa0, aa1, ar0, ar1, k0, k1, k2, k3; f32x4 v; f32x4 s[8]; };
__device__ __forceinline__ void sc_ldb(ScBlk& c, const char* buf, int blk, int arOff, int bkOff, int vOff) {
  const char* pa = buf + SC_ARA + blk * 512 + arOff; const char* pr = buf + SC_ARR + blk * 512 + arOff;
  c.aa0 = *(const u32x4*)(pa); c.aa1 = *(const u32x4*)(pa + 64); c.ar0 = *(const u32x4*)(pr); c.ar1 = *(const u32x4*)(pr + 64);
  const char* bk = buf + SC_BK + blk * 1024 + bkOff;
  c.k0 = *(const u32x4*)(bk); c.k1 = *(const u32x4*)(bk + 256); c.k2 = *(const u32x4*)(bk + 512); c.k3 = *(const u32x4*)(bk + 768);
  c.v = *(const f32x4*)(buf + SC_VV + blk * 1024 + vOff);
  const char* sp = buf + SC_SCAL + blk * 128;
#pragma unroll
  for (int i = 0; i < 8; ++i) c.s[i] = *(const f32x4*)(sp + i * 16);
}
__device__ void phase_scan(const Params& p, char* lds) {
  unsigned char* ws = p.ws;
  const int tid = threadIdx.x, lane = tid & 63, wid = __builtin_amdgcn_readfirstlane(tid >> 6), r32 = lane & 31, hi = lane >> 5;
  const bf16_t* Rg = (const bf16_t*)(ws + OFF_R); const bf16_t* Kg = (const bf16_t*)(ws + OFF_K); const bf16_t* Vg = (const bf16_t*)(ws + OFF_V);
  const bf16_t* Lg = (const bf16_t*)(ws + OFF_LORA);
  constexpr int NCH = TL / 32;
  for (int sidx = blockIdx.x; sidx < 256; sidx += gridDim.x) {
    const int d = sidx >> 7, b = (sidx >> 4) & 7, h = sidx & 15;
    bf16_t* Yg = (bf16_t*)(ws + (d ? OFF_Y1 : OFF_Y0));
    if (wid < 4) {
      const int cw = wid, c16 = lane & 15, q = lane >> 4;
      const int arOff = (c16 & 3) * 128 + q * 16, wOff = q * 16, bkOff = c16 * 16, vOff = (cw * 16 + c16) * 16;
      f32x4 St0 = {0.f, 0.f, 0.f, 0.f}, St1 = St0, St2 = St0, St3 = St0;
      __syncthreads(); __syncthreads();
      for (int c = 0; c < NCH; ++c) {
        const char* buf = lds + (c & 1) * SC_BUF;
        char* yb = lds + SC_YB + (c & 1) * 8192 + (cw * 16 + c16) * 16;
        ScBlk cur; sc_ldb(cur, buf, 0, arOff, bkOff, vOff);
#pragma unroll 1
        for (int blk = 0; blk < 8; ++blk) {
          ScBlk nxt; sc_ldb(nxt, buf, (blk + 1) & 7, arOff, bkOff, vOff);
          u32x4 b1 = {cvtpk(St0[0], St0[1]), cvtpk(St0[2], St0[3]), cvtpk(St1[0], St1[1]), cvtpk(St1[2], St1[3])};
          u32x4 b2 = {cvtpk(St2[0], St2[1]), cvtpk(St2[2], St2[3]), cvtpk(St3[0], St3[1]), cvtpk(St3[2], St3[3])};
          f32x4 sr = {0.f, 0.f, 0.f, 0.f}, yr = sr;
          sr = MFMA16(*(bf16x8*)&cur.aa0, *(bf16x8*)&b1, sr); yr = MFMA16(*(bf16x8*)&cur.ar0, *(bf16x8*)&b1, yr);
          sr = MFMA16(*(bf16x8*)&cur.aa1, *(bf16x8*)&b2, sr); yr = MFMA16(*(bf16x8*)&cur.ar1, *(bf16x8*)&b2, yr);
          const float v1 = cur.v[0], v2 = cur.v[1], v3 = cur.v[2], v4 = cur.v[3];
          const f32x4 s0 = cur.s[0], s1 = cur.s[1], s2 = cur.s[2], s3 = cur.s[3], s4 = cur.s[4], s5 = cur.s[5], s6 = cur.s[6], s7 = cur.s[7];
          const float sa1 = sr[0];
          const float sa2 = sr[1] + s0[0] * sa1 + s1[2] * v1;
          const float sa3 = sr[2] + s0[1] * sa1 + s1[3] * v1 + s0[2] * sa2 + s2[0] * v2;
          const float sa4 = sr[3] + s0[3] * sa1 + s2[1] * v1 + s1[0] * sa2 + s2[2] * v2 + s1[1] * sa3 + s2[3] * v3;
          f32x4 y;
          y[0] = yr[0] + s3[0] * sa1 + s5[2] * v1;
          y[1] = yr[1] + s3[1] * sa1 + s5[3] * v1 + s3[2] * sa2 + s6[0] * v2;
          y[2] = yr[2] + s3[3] * sa1 + s6[1] * v1 + s4[0] * sa2 + s6[2] * v2 + s4[1] * sa3 + s6[3] * v3;
          y[3] = yr[3] + s4[2] * sa1 + s7[0] * v1 + s4[3] * sa2 + s7[1] * v2 + s5[0] * sa3 + s7[2] * v3 + s5[1] * sa4 + s7[3] * v4;
          u32x4 bu = {cvtpk(sa1, v1), cvtpk(sa2, v2), cvtpk(sa3, v3), cvtpk(sa4, v4)};
          if (q != 0) { bu[0] = 0u; bu[1] = 0u; bu[2] = 0u; bu[3] = 0u; }
          St0 = MFMA16(*(bf16x8*)&cur.k0, *(bf16x8*)&bu, St0);
          St1 = MFMA16(*(bf16x8*)&cur.k1, *(bf16x8*)&bu, St1);
          St2 = MFMA16(*(bf16x8*)&cur.k2, *(bf16x8*)&bu, St2);
          St3 = MFMA16(*(bf16x8*)&cur.k3, *(bf16x8*)&bu, St3);
          *(f32x4*)(yb + blk * 1024) = y;
          cur = nxt;
          if (blk == 7) {
            const char* pw = buf + SC_P + 31 * 256 + wOff;
            St0 *= *(const f32x4*)(pw); St1 *= *(const f32x4*)(pw + 64); St2 *= *(const f32x4*)(pw + 128); St3 *= *(const f32x4*)(pw + 192);
          }
          if (blk == 3 || blk == 7) __syncthreads();
        }
      }
    } else {
      const int pw = wid - 4, ptid = tid - 256;
      const int pstep = ptid >> 3, j0 = (ptid & 7) * 8, pblk = pstep >> 2, psb = pstep & 3;
      const int apos0 = (j0 >> 5) * 32 + (((j0 & 31) & 15) >> 2) * 8 + 4 * ((j0 & 31) >> 4), apos1 = apos0 + 8;
      float* Bg = (float*)(ws + OFF_BONUS) + (size_t)d * NTOK * 16;
      float kkc[8], kac[8], rkc[8];
#pragma unroll
      for (int e = 0; e < 8; ++e) { kkc[e] = p.in[15][h * 64 + j0 + e]; kac[e] = p.in[16][h * 64 + j0 + e]; rkc[e] = p.in[17][h * 64 + j0 + e]; }
      const int mat = pw >> 1, jh = pw & 1;
      bf16x8 w2f[4]; float bias;
      {
        const float* W2 = (mat ? p.in[14] : p.in[11]) + (size_t)d * 64 * 1024;
#pragma unroll
        for (int ks = 0; ks < 4; ++ks) {
          u32x4 w;
#pragma unroll
          for (int qq = 0; qq < 4; ++qq) {
            const int r0 = ks * 16 + 8 * hi + 2 * qq;
            w[qq] = cvtpk(W2[(size_t)r0 * 1024 + h * 64 + jh * 32 + r32], W2[(size_t)(r0 + 1) * 1024 + h * 64 + jh * 32 + r32]);
          }
          w2f[ks] = *(bf16x8*)&w;
        }
        bias = (mat ? p.in[12] : p.in[9])[d * 1024 + h * 64 + jh * 32 + r32];
      }
      u32x4 pR, pK, pV; bf16x8 pl[4];
      float kk[8], kr[8], rr[8];
      float* IC = (float*)(lds + SC_IC);
      bf16_t* SCR = (bf16_t*)(lds + SC_SCR);
      auto prefetch = [&](int c) {
        const size_t row = (size_t)scan_row(c * 32 + pstep, d, b) * 1024 + h * 64 + j0;
        pR = *(const u32x4*)(Rg + row); pK = *(const u32x4*)(Kg + row); pV = *(const u32x4*)(Vg + row);
        const size_t lrow = (size_t)scan_row(c * 32 + r32, d, b);
#pragma unroll
        for (int ks = 0; ks < 4; ++ks) pl[ks] = *(const bf16x8*)(Lg + lrow * 256 + mat * 128 + d * 64 + ks * 16 + hi * 8);
      };
      auto stageA = [&](int c) {
        char* buf = lds + (c & 1) * SC_BUF;
        float* Pd = (float*)(buf + SC_P); float* VV = (float*)(buf + SC_VV);
        f32x16 acc;
#pragma unroll
        for (int r = 0; r < 16; ++r) acc[r] = 0.f;
#pragma unroll
        for (int ks = 0; ks < 4; ++ks) acc = MFMA(pl[ks], w2f[ks], acc);
        if (mat == 0) {
          float cc[16];
#pragma unroll
          for (int r = 0; r < 16; ++r) cc[r] = -0.6065306597126334f * __builtin_amdgcn_rcpf(1.f + __expf(-(acc[r] + bias)));
#pragma unroll
          for (int g = 0; g < 4; ++g) { cc[4 * g + 1] += cc[4 * g]; cc[4 * g + 2] += cc[4 * g + 1]; cc[4 * g + 3] += cc[4 * g + 2]; }
          float run = 0.f;
#pragma unroll
          for (int g = 0; g < 4; ++g) {
            const float own = cc[4 * g + 3];
            auto rr2 = __builtin_amdgcn_permlane32_swap(__float_as_uint(own), __float_as_uint(own), false, false);
            const float both = __uint_as_float(rr2[0]) + __uint_as_float(rr2[1]), partner = both - own;
            const float off = hi ? run + partner : run;
#pragma unroll
            for (int e = 0; e < 4; ++e) Pd[crow(4 * g + e, hi) * 64 + jh * 32 + r32] = __expf(off + cc[4 * g + e]);
            run += both;
          }
        } else {
#pragma unroll
          for (int r = 0; r < 16; ++r) IC[crow(r, hi) * 64 + jh * 32 + r32] = __builtin_amdgcn_rcpf(1.f + __expf(-(acc[r] + bias)));
        }
        float ss = 0.f;
#pragma unroll
        for (int w = 0; w < 4; ++w) {
          rr[2 * w] = lo16(pR[w]); rr[2 * w + 1] = hi16(pR[w]);
          kr[2 * w] = lo16(pK[w]); kr[2 * w + 1] = hi16(pK[w]);
        }
        const float vv[8] = {lo16(pV[0]), hi16(pV[0]), lo16(pV[1]), hi16(pV[1]), lo16(pV[2]), hi16(pV[2]), lo16(pV[3]), hi16(pV[3])};
        if (c + 1 < NCH) prefetch(c + 1);
#pragma unroll
        for (int e = 0; e < 8; ++e) VV[(pblk * 64 + j0 + e) * 4 + psb] = vv[e];
#pragma unroll
        for (int e = 0; e < 8; ++e) { kk[e] = kr[e] * kkc[e]; ss += kk[e] * kk[e]; }
        ss = red8(ss);
        const float inv = rsqrtf(fmaxf(ss, 1e-24f));
#pragma unroll
        for (int e = 0; e < 8; ++e) kk[e] *= inv;
      };
      auto stageB = [&](int c) {
        char* buf = lds + (c & 1) * SC_BUF;
        const f32x4 i0 = *(const f32x4*)(IC + pstep * 64 + j0), i1 = *(const f32x4*)(IC + pstep * 64 + j0 + 4);
        const float ic[8] = {i0[0], i0[1], i0[2], i0[3], i1[0], i1[1], i1[2], i1[3]};
        const float* Pt = (const float*)(buf + SC_P) + pstep * 64 + j0;
        const f32x4 pt0 = *(const f32x4*)(Pt), pt1 = *(const f32x4*)(Pt + 4);
        f32x4 pm0 = {1.f, 1.f, 1.f, 1.f}, pm1 = pm0;
        if (pstep > 0) { pm0 = *(const f32x4*)(Pt - 64); pm1 = *(const f32x4*)(Pt - 60); }
        const float pt[8] = {pt0[0], pt0[1], pt0[2], pt0[3], pt1[0], pt1[1], pt1[2], pt1[3]};
        const float pm[8] = {pm0[0], pm0[1], pm0[2], pm0[3], pm1[0], pm1[1], pm1[2], pm1[3]};
        const u32x4 an = {cvtpk(-kk[0] * pm[0], -kk[1] * pm[1]), cvtpk(-kk[2] * pm[2], -kk[3] * pm[3]), cvtpk(-kk[4] * pm[4], -kk[5] * pm[5]), cvtpk(-kk[6] * pm[6], -kk[7] * pm[7])};
        const u32x4 rn = {cvtpk(rr[0] * pt[0], rr[1] * pt[1]), cvtpk(rr[2] * pt[2], rr[3] * pt[3]), cvtpk(rr[4] * pt[4], rr[5] * pt[5]), cvtpk(rr[6] * pt[6], rr[7] * pt[7])};
        bf16_t* ARa = (bf16_t*)(buf + SC_ARA) + (pblk * 4 + psb) * 64; bf16_t* ARr = (bf16_t*)(buf + SC_ARR) + (pblk * 4 + psb) * 64;
        { u32x2 lo = {an[0], an[1]}, hi2 = {an[2], an[3]}; *(u32x2*)(ARa + apos0) = lo; *(u32x2*)(ARa + apos1) = hi2; }
        { u32x2 lo = {rn[0], rn[1]}, hi2 = {rn[2], rn[3]}; *(u32x2*)(ARr + apos0) = lo; *(u32x2*)(ARr + apos1) = hi2; }
        *(u32x4*)(SCR + (pstep * 4 + 0) * 64 + j0) = an; *(u32x4*)(SCR + (pstep * 4 + 1) * 64 + j0) = rn;
        float bs = 0.f;
        unsigned bq[8], kq[8];
        unsigned* BK = (unsigned*)(buf + SC_BK) + (pblk * 64 + j0) * 4 + psb;
#pragma unroll
        for (int e = 0; e < 8; ++e) {
          const float kd = kr[e] * (1.f + (ic[e] - 1.f) * kac[e]);
          const float ip = __builtin_amdgcn_rcpf(pt[e]);
          const unsigned pr2 = cvtpk(kk[e] * ic[e] * ip, kd * ip);
          BK[e * 4] = pr2;
          bq[e] = pr2 & 0xffffu; kq[e] = pr2 >> 16;
          bs += rr[e] * kd * rkc[e];
        }
        const u32x4 bn = {bq[0] | (bq[1] << 16), bq[2] | (bq[3] << 16), bq[4] | (bq[5] << 16), bq[6] | (bq[7] << 16)};
        const u32x4 kn = {kq[0] | (kq[1] << 16), kq[2] | (kq[3] << 16), kq[4] | (kq[5] << 16), kq[6] | (kq[7] << 16)};
        *(u32x4*)(SCR + (pstep * 4 + 2) * 64 + j0) = bn; *(u32x4*)(SCR + (pstep * 4 + 3) * 64 + j0) = kn;
        bs = red8(bs);
        if ((ptid & 7) == 0) Bg[(size_t)scan_row(c * 32 + pstep, d, b) * 16 + h] = bs;
      };
      auto stageC = [&](int c) {
        char* buf = lds + (c & 1) * SC_BUF;
        asm volatile("s_waitcnt lgkmcnt(0)" ::: "memory");
        const int n16 = lane & 15, q4 = lane >> 4;
        const int stepA = (2 * pw + (n16 >> 3)) * 4 + (n16 & 3);
        const bf16_t* Xr = SCR + (stepA * 4 + 2 + ((n16 >> 2) & 1)) * 64 + q4 * 8;
        const bf16_t* Yc = SCR + (stepA * 4 + ((n16 >> 2) & 1)) * 64 + q4 * 8;
        f32x4 g = {0.f, 0.f, 0.f, 0.f};
        g = MFMA16(*(const bf16x8*)(Xr), *(const bf16x8*)(Yc), g);
        g = MFMA16(*(const bf16x8*)(Xr + 32), *(const bf16x8*)(Yc + 32), g);
        const int ctype = (n16 >> 2) & 1, t0 = n16 & 3, rtype = q4 & 1;
        const int grp = ctype * 2 + rtype, base = grp == 0 ? 0 : (grp == 1 ? 6 : (grp == 2 ? 12 : 22));
        float* sc = (float*)(buf + SC_SCAL) + (2 * pw + (n16 >> 3)) * 32 + base + (ctype ? (t0 + 1) * t0 / 2 : t0 * (t0 - 1) / 2);
        if ((q4 >> 1) == (n16 >> 3)) {
#pragma unroll
          for (int e = 0; e < 4; ++e) if (ctype ? (e <= t0) : (e < t0)) sc[e] = g[e];
        }
      };
      auto writeout = [&](int c) {
        const float* Yb = (const float*)(lds + SC_YB + (c & 1) * 8192) + (pblk * 64 + j0) * 4 + psb;
        u32x4 w = {cvtpk(Yb[0], Yb[4]), cvtpk(Yb[8], Yb[12]), cvtpk(Yb[16], Yb[20]), cvtpk(Yb[24], Yb[28])};
        *(u32x4*)(Yg + (size_t)scan_row(c * 32 + pstep, d, b) * 1024 + h * 64 + j0) = w;
      };
      prefetch(0);
      stageA(0);
      __syncthreads();
      stageB(0); stageC(0);
      __syncthreads();
      for (int c = 0; c < NCH; ++c) {
        if (c >= 1) writeout(c - 1);
        if (c + 1 < NCH) stageA(c + 1);
        __syncthreads();
        if (c + 1 < NCH) { stageB(c + 1); stageC(c + 1); }
        __syncthreads();
      }
      writeout(NCH - 1);
    }
    __syncthreads();
  }
}

__device__ void phase_readout(const Params& p) {
  unsigned char* ws = p.ws;
  const bf16_t* Y0 = (const bf16_t*)(ws + OFF_Y0); const bf16_t* Y1 = (const bf16_t*)(ws + OFF_Y1); const bf16_t* Vg = (const bf16_t*)(ws + OFF_V);
  bf16_t* G = (bf16_t*)(ws + OFF_G);
  const float* B0 = (const float*)(ws + OFF_BONUS); const float* B1 = B0 + (size_t)NTOK * 16;
  const int lane = threadIdx.x & 63, gw = blockIdx.x * 8 + (threadIdx.x >> 6), nw = gridDim.x * 8;
  const int c0 = lane * 16, hd = lane >> 2;
  float lg[16], lb[16];
#pragma unroll
  for (int e = 0; e < 16; ++e) { lg[e] = p.in[18][c0 + e]; lb[e] = p.in[19][c0 + e]; }
  struct RowIn { u32x4 a[2], b[2], v[2], g[2]; float b0, b1; };
  auto ldr = [&](int n, RowIn& r) {
    const size_t o = (size_t)n * 1024 + c0;
#pragma unroll
    for (int q = 0; q < 2; ++q) { r.a[q] = *(const u32x4*)(Y0 + o + 8 * q); r.b[q] = *(const u32x4*)(Y1 + o + 8 * q); r.v[q] = *(const u32x4*)(Vg + o + 8 * q); r.g[q] = *(const u32x4*)(G + o + 8 * q); }
    r.b0 = B0[(size_t)n * 16 + hd]; r.b1 = B1[(size_t)n * 16 + hd];
  };
  RowIn cur, nxt;
  if (gw < NTOK) ldr(gw, cur);
  for (int n = gw; n < NTOK; n += nw) {
    if (n + nw < NTOK) ldr(n + nw, nxt);
    const size_t o = (size_t)n * 1024 + c0;
    float y[16], v[16], g[16];
#pragma unroll
    for (int q = 0; q < 2; ++q) {
#pragma unroll
      for (int w = 0; w < 4; ++w) {
        y[8 * q + 2 * w] = lo16(cur.a[q][w]) + lo16(cur.b[q][w]); y[8 * q + 2 * w + 1] = hi16(cur.a[q][w]) + hi16(cur.b[q][w]);
        v[8 * q + 2 * w] = lo16(cur.v[q][w]); v[8 * q + 2 * w + 1] = hi16(cur.v[q][w]);
        g[8 * q + 2 * w] = lo16(cur.g[q][w]); g[8 * q + 2 * w + 1] = hi16(cur.g[q][w]);
      }
    }
    float s = 0.f;
#pragma unroll
    for (int e = 0; e < 16; ++e) s += y[e];
    s += dpp_f(s, 0); s += dpp_f(s, 1);
    const float mean = s * (1.f / 64.f);
    float q2 = 0.f;
#pragma unroll
    for (int e = 0; e < 16; ++e) { const float dlt = y[e] - mean; q2 += dlt * dlt; }
    q2 += dpp_f(q2, 0); q2 += dpp_f(q2, 1);
    const float rs = rsqrtf(q2 * (1.f / 64.f) + 64e-5f);
    const float bonus = cur.b0 + cur.b1;
    float r[16];
#pragma unroll
    for (int e = 0; e < 16; ++e) {
      const float yn = (y[e] - mean) * rs * lg[e] + lb[e];
      r[e] = (yn + bonus * v[e]) * (g[e] * sigmoidf_(g[e]));
    }
    u32x4 w0 = {cvtpk(r[0], r[1]), cvtpk(r[2], r[3]), cvtpk(r[4], r[5]), cvtpk(r[6], r[7])};
    u32x4 w1 = {cvtpk(r[8], r[9]), cvtpk(r[10], r[11]), cvtpk(r[12], r[13]), cvtpk(r[14], r[15])};
    *(u32x4*)(G + o) = w0; *(u32x4*)(G + o + 8) = w1;
    cur = nxt;
  }
}

constexpr int AT_SHMV = 16384, AT_KROW = 208, AT_SHMK = 64 * AT_KROW;
constexpr int AT_KOFF = 2 * AT_SHMV, AT_WOFF = AT_KOFF + 2 * AT_SHMK;
#define SBAR() __builtin_amdgcn_sched_barrier(0)
__device__ __forceinline__ void at_partialSM(f32x16& p0, f32x16& p1, float& m_reg, float& alpha, bool force) {
  float pm = p0[0];
#pragma unroll
  for (int r = 1; r < 16; ++r) pm = fmaxf(pm, p0[r]);
#pragma unroll
  for (int r = 0; r < 16; ++r) pm = fmaxf(pm, p1[r]);
  { auto rr = __builtin_amdgcn_permlane32_swap(__float_as_uint(pm), __float_as_uint(pm), false, false);
    pm = fmaxf(__uint_as_float(rr[0]), __uint_as_float(rr[1])); }
  if (__builtin_expect(!force && __all(pm <= AT_THR * 1.4426950408889634f), 1)) { alpha = 1.f; }
  else {
    const float dlt = force ? pm : fmaxf(pm, 0.f);
    alpha = force ? 1.f : __builtin_amdgcn_exp2f(-dlt); m_reg += dlt;
#pragma unroll
    for (int r = 0; r < 16; ++r) { p0[r] -= dlt; p1[r] -= dlt; }
  }
#pragma unroll
  for (int r = 0; r < 16; ++r) p0[r] = __builtin_amdgcn_exp2f(p0[r]);
}
__device__ __forceinline__ void at_finishSM(f32x16& p0, f32x16& p1, float alpha, float& l_reg, bf16x8& pa0, bf16x8& pa1, bf16x8& pa2, bf16x8& pa3) {
#pragma unroll
  for (int r = 0; r < 16; ++r) p1[r] = __builtin_amdgcn_exp2f(p1[r]);
  float ps = 0;
#pragma unroll
  for (int r = 0; r < 16; ++r) ps += p0[r];
#pragma unroll
  for (int r = 0; r < 16; ++r) ps += p1[r];
  { auto rr = __builtin_amdgcn_permlane32_swap(__float_as_uint(ps), __float_as_uint(ps), false, false);
    ps = __uint_as_float(rr[0]) + __uint_as_float(rr[1]); }
  l_reg = l_reg * alpha + ps;
#define PK4(P, BASE, OUT) do { unsigned a0 = cvtpk(P[BASE + 0], P[BASE + 1]), a1 = cvtpk(P[BASE + 2], P[BASE + 3]);   \
    unsigned b0 = cvtpk(P[BASE + 4], P[BASE + 5]), b1 = cvtpk(P[BASE + 6], P[BASE + 7]);                              \
    auto r0 = __builtin_amdgcn_permlane32_swap(a0, b0, false, false); auto r1 = __builtin_amdgcn_permlane32_swap(a1, b1, false, false); \
    u32x4 w = {r0[0], r1[0], r0[1], r1[1]}; OUT = *reinterpret_cast<bf16x8*>(&w); } while (0)
  PK4(p0, 0, pa0); PK4(p0, 8, pa1); PK4(p1, 0, pa2); PK4(p1, 8, pa3);
#undef PK4
}
__device__ __forceinline__ void at_qkt(f32x16& p0, f32x16& p1, const char* Ks, const bf16x8* qr, int r32, int hi, float negm) {
#pragma unroll
  for (int r = 0; r < 16; ++r) { p0[r] = negm; p1[r] = negm; }
#pragma unroll
  for (int d0 = 0; d0 < 6; ++d0) {
    const bf16x8 b0 = *(const bf16x8*)(Ks + r32 * AT_KROW + d0 * 32 + hi * 16);
    const bf16x8 b1 = *(const bf16x8*)(Ks + (32 + r32) * AT_KROW + d0 * 32 + hi * 16);
    p0 = MFMA(b0, qr[d0], p0);
    p1 = MFMA(b1, qr[d0], p1);
  }
}
__device__ __forceinline__ int v_st(int k, int c) { const int kk = (k & ~0xC) | ((k & 4) << 1) | ((k & 8) >> 1); return ((kk >> 3) * 4 + (c >> 5)) * 512 + ((kk & 7) * 32 + (c & 31)) * 2; }
__device__ __forceinline__ int v_rd_base(int lane) { return ((lane & 3) << 3) | (((lane >> 2) & 3) << 6) | (((lane >> 4) & 1) << 5) | (((lane >> 5) & 1) << 8); }
constexpr int v_rd_off(int d0, int ks, int half) { return d0 * 512 + ks * 4096 + half * 2048; }
template <int OFF> __device__ __forceinline__ s16x4 tr_read(int vb) {
  s16x4 r; asm volatile("ds_read_b64_tr_b16 %0, %1 offset:%2" : "=&v"(r) : "v"(vb), "i"(OFF) : "memory"); return r;
}
template <int D0> __device__ __forceinline__ void pv_one(f32x16& od, int vb, bf16x8 pa0, bf16x8 pa1, bf16x8 pa2, bf16x8 pa3) {
  const s16x4 l0 = tr_read<v_rd_off(D0, 0, 0)>(vb), h0 = tr_read<v_rd_off(D0, 0, 1)>(vb), l1 = tr_read<v_rd_off(D0, 1, 0)>(vb), h1 = tr_read<v_rd_off(D0, 1, 1)>(vb);
  const s16x4 l2 = tr_read<v_rd_off(D0, 2, 0)>(vb), h2 = tr_read<v_rd_off(D0, 2, 1)>(vb), l3 = tr_read<v_rd_off(D0, 3, 0)>(vb), h3 = tr_read<v_rd_off(D0, 3, 1)>(vb);
  asm volatile("s_waitcnt lgkmcnt(0)" ::: "memory"); SBAR();
#define PK(Lx, Hx) (bf16x8){Lx[0], Lx[1], Lx[2], Lx[3], Hx[0], Hx[1], Hx[2], Hx[3]}
  od = MFMA(pa0, PK(l0, h0), od);
  od = MFMA(pa1, PK(l1, h1), od);
  od = MFMA(pa2, PK(l2, h2), od);
  od = MFMA(pa3, PK(l3, h3), od);
#undef PK
}
__device__ __forceinline__ void pv_d0(f32x16* o, int vb, bf16x8 pa0, bf16x8 pa1, bf16x8 pa2, bf16x8 pa3) {
  pv_one<0>(o[0], vb, pa0, pa1, pa2, pa3); pv_one<1>(o[1], vb, pa0, pa1, pa2, pa3);
}

__device__ void phase_attn(const Params& p, char* lds) {
  unsigned char* ws = p.ws;
  const bf16_t* Qg = (const bf16_t*)(ws + OFF_Q); const bf16_t* KVg = (const bf16_t*)(ws + OFF_KV); const bf16_t* KPg = (const bf16_t*)(ws + OFF_KPE);
  bf16_t* G1 = (bf16_t*)(ws + OFF_G1);
  const f32x2* rope = (const f32x2*)(ws + OFF_ROPE);
  const int tid = threadIdx.x, wid = tid >> 6, lane = tid & 63, r32 = lane & 31, hi = lane >> 5;
  char* V_lds = lds; char* K_lds = lds + AT_KOFF;
  float* wsl = (float*)(lds + AT_WOFF) + wid * 64; float* li_l = wsl; float* al_l = wsl + 32;
  const int skey = tid >> 3, sc8 = (tid & 7) * 8;
  const int pkey = (tid & 255) >> 2, pc8 = (tid & 3) * 8;
  const int vst = v_st(skey, sc8), kst = skey * AT_KROW + sc8 * 2, pst = pkey * AT_KROW + (64 + pc8) * 2;
  const int vb0 = (int)(uintptr_t)V_lds + v_rd_base(lane);
  const int nitems = NB * 16 * 32;
  const int xcd = blockIdx.x & 7, slot = blockIdx.x >> 3, per = gridDim.x >> 3;
  for (int it = slot; it < nitems / 8; it += per) {
    const int pair = (it >> 5) * 8 + xcd, qblk = it & 31;
    const int b = pair >> 4, h = pair & 15;
    const size_t row0 = (size_t)b * TL;
    const size_t qrow = row0 + qblk * 256 + wid * 32 + r32;
    const bf16_t* Kh = KVg + row0 * 2048 + h * 128;
    const bf16_t* Kp = KPg + row0 * 32;
    float m_reg = 0.f, l_reg = 0.f;
    f32x16 o[2];
#pragma unroll
    for (int dd = 0; dd < 2; ++dd)
#pragma unroll
      for (int r = 0; r < 16; ++r) o[dd][r] = 0.f;
    bf16x8 qr[6];
    {
      const bf16_t* Qw = Qg + qrow * 1536 + h * 96 + hi * 8;
#pragma unroll
      for (int d0 = 0; d0 < 6; ++d0) qr[d0] = *(const bf16x8*)(Qw + d0 * 16);
      const int t = qblk * 256 + wid * 32 + r32;
      const f32x2* tb = rope + (hi ? (t & 63) : (t >> 6)) * 8;
      const u32x4 x1 = *(const u32x4*)&qr[4], x2 = *(const u32x4*)&qr[5];
      u32x4 n1, n2;
#pragma unroll
      for (int q = 0; q < 4; ++q) {
        const f32x2 csA = tb[2 * q], csB = tb[2 * q + 1];
        const float a0 = lo16(x1[q]), a1 = hi16(x1[q]), b0 = lo16(x2[q]), b1 = hi16(x2[q]);
        n1[q] = cvtpk(a0 * csA[0] - b0 * csA[1], a1 * csB[0] - b1 * csB[1]);
        n2[q] = cvtpk(a0 * csA[1] + b0 * csA[0], a1 * csB[1] + b1 * csB[0]);
      }
      qr[4] = *(bf16x8*)&n1; qr[5] = *(bf16x8*)&n2;
    }
    struct { bf16x8 vs, ks, ps; } sr_[2];
#define SLOAD(i, k0) do { sr_[i].vs = *(const bf16x8*)(Kh + (size_t)((k0) + skey) * 2048 + 64 + sc8); \
    sr_[i].ks = *(const bf16x8*)(Kh + (size_t)((k0) + skey) * 2048 + sc8); \
    sr_[i].ps = *(const bf16x8*)(Kp + (size_t)((k0) + pkey) * 32 + pc8); } while (0)
#define SWRITE(bb, i) do { *(bf16x8*)(V_lds + (bb) * AT_SHMV + vst) = sr_[i].vs; \
    *(bf16x8*)(K_lds + (bb) * AT_SHMK + kst) = sr_[i].ks; \
    *(bf16x8*)(K_lds + (bb) * AT_SHMK + pst) = sr_[i].ps; } while (0)
#define SWAIT() asm volatile("s_waitcnt vmcnt(3)" ::: "memory")
#define RESC(a) do { if (__any((a) < 1.f)) { if (hi == 0) al_l[r32] = (a); asm volatile("s_waitcnt lgkmcnt(0)" ::: "memory"); \
    _Pragma("unroll") for (int dd = 0; dd < 2; ++dd) _Pragma("unroll") for (int r = 0; r < 16; ++r) o[dd][r] *= al_l[crow(r, hi)]; } } while (0)
    f32x16 pA0, pA1, pB0, pB1; float alA, alB; bf16x8 pa0, pa1, pa2, pa3;
    constexpr int NT = TL / 64;
    SLOAD(0, 0); asm volatile("s_waitcnt vmcnt(0)" ::: "memory"); SWRITE(0, 0); __syncthreads();
    at_qkt(pA0, pA1, K_lds, qr, r32, hi, 0.f); at_partialSM(pA0, pA1, m_reg, alA, true);
    SLOAD(1, 64); SLOAD(0, 128);
    SWAIT(); SWRITE(1, 1); __syncthreads();
    for (int j = 1; j + 1 < NT; j += 2) {
      SBAR(); at_qkt(pB0, pB1, K_lds + AT_SHMK, qr, r32, hi, -m_reg);
      at_finishSM(pA0, pA1, alA, l_reg, pa0, pa1, pa2, pa3); SBAR();
      SLOAD(1, (j + 2) * 64); SBAR();
      pv_d0(o, vb0, pa0, pa1, pa2, pa3); at_partialSM(pB0, pB1, m_reg, alB, false);
      __syncthreads(); SWAIT(); SWRITE(0, 0);
      RESC(alB); __syncthreads();
      SBAR(); at_qkt(pA0, pA1, K_lds, qr, r32, hi, -m_reg);
      at_finishSM(pB0, pB1, alB, l_reg, pa0, pa1, pa2, pa3); SBAR();
      if (j + 3 < NT) SLOAD(0, (j + 3) * 64); SBAR();
      pv_d0(o, vb0 + AT_SHMV, pa0, pa1, pa2, pa3); at_partialSM(pA0, pA1, m_reg, alA, false);
      __syncthreads(); SWAIT(); SWRITE(1, 1);
      RESC(alA); __syncthreads();
    }
    SBAR(); at_qkt(pB0, pB1, K_lds + AT_SHMK, qr, r32, hi, -m_reg);
    at_finishSM(pA0, pA1, alA, l_reg, pa0, pa1, pa2, pa3); SBAR();
    pv_d0(o, vb0, pa0, pa1, pa2, pa3); at_partialSM(pB0, pB1, m_reg, alB, false);
    __syncthreads(); RESC(alB);
    at_finishSM(pB0, pB1, alB, l_reg, pa0, pa1, pa2, pa3); SBAR();
    pv_d0(o, vb0 + AT_SHMV, pa0, pa1, pa2, pa3);
    if (hi == 0) li_l[r32] = l_reg;
    asm volatile("s_waitcnt lgkmcnt(0)" ::: "memory");
    float rli[16];
#pragma unroll
    for (int r = 0; r < 16; ++r) rli[r] = __builtin_amdgcn_rcpf(li_l[crow(r, hi)]);
    bf16_t* Gw = G1 + (row0 + qblk * 256 + wid * 32) * 1024 + h * 64 + r32;
    bf16_t gin[32];
#pragma unroll
    for (int r = 0; r < 16; ++r) { gin[2 * r] = Gw[(size_t)crow(r, hi) * 1024]; gin[2 * r + 1] = Gw[(size_t)crow(r, hi) * 1024 + 32]; }
    asm volatile("" ::: "memory");
#pragma unroll
    for (int r = 0; r < 16; ++r) {
      const int orow = crow(r, hi);
#pragma unroll
      for (int d0 = 0; d0 < 2; ++d0) {
        const float gt = bf2f(gin[2 * r + d0]);
        Gw[(size_t)orow * 1024 + d0 * 32] = f2bf(o[d0][r] * rli[r] * gt * sigmoidf_(gt));
      }
    }
    __syncthreads();
#undef SLOAD
#undef SWRITE
#undef SWAIT
#undef RESC
  }
}

struct XcdWalk {
  int start, count, step, idx;
  __device__ __forceinline__ void init(int ntiles) {
    const int x = blockIdx.x & 7, base = ntiles >> 3, rem = ntiles & 7;
    count = base + (x < rem ? 1 : 0); start = x * base + (x < rem ? x : rem); step = gridDim.x >> 3; idx = blockIdx.x >> 3;
  }
  __device__ __forceinline__ bool next(int& o) { if (idx >= count) return false; o = start + idx; idx += step; return true; }
};
__device__ __forceinline__ void tile_mn(int o, int NT, int& mt, int& nt) { const int g = o >> 3; mt = (g / NT) * 8 + (o & 7); nt = g % NT; }

__global__ __launch_bounds__(NTHR, 1) void fwd_megakernel(Params p) {
  extern __shared__ __attribute__((aligned(16))) char lds[];
  cg::grid_group grid = cg::this_grid();
  unsigned char* ws = p.ws;
  bf16_t* H = (bf16_t*)(ws + OFF_H);
  float* mod = (float*)(ws + OFF_MOD);
  float* CTX1 = (float*)(ws + OFF_CTX1);

  phase_prologue(p, lds);
  grid.sync();
  phase_norm_lerp(p, mod);
  phase_weights(p, lds);
  grid.sync();
  {
    const bf16_t* WIN0 = (const bf16_t*)(ws + OFF_WIN0);
    const int nbig = 264 * 16;
    XcdWalk wk; wk.init(nbig); int o;
    while (wk.next(o)) {
      EpiBf16 e; e.invK = 0.f;
      {
        int mt, jn; tile_mn(o, 16, mt, jn);
        const int j = jn >> 2, n4 = jn & 3, m0 = mt * 256;
        e.dst = (bf16_t*)(ws + OFF_R + (size_t)j * U); e.ldd = 1024; e.col0 = n4 * 256; e.act = 0; e.m0 = m0;
        gemm_tile<0, 256>(lerp_base(p, j, m0), 1024, WIN0 + (size_t)(j * 1024 + n4 * 256) * 1024, 1024, m0, nullptr, lds, e);
      }
    }
    wk.init(264 * 2);
    while (wk.next(o)) {
      EpiBf16 e; e.invK = 0.f;
      {
        int mt, n2; tile_mn(o, 2, mt, n2);
        const int nt = 32 + n2, m0 = mt * 256;
        e.dst = (bf16_t*)(ws + OFF_LORA); e.ldd = 256; e.col0 = (nt - 32) * 128; e.act = (nt == 32) ? 1 : 0; e.m0 = m0;
        gemm_tile<1, 128>(H, 1024, WIN0 + (size_t)nt * 128 * 1024, 1024, m0, p.in[7] + (nt - 28) * 1024, lds, e);
      }
    }
  }
  grid.sync();
  phase_scan(p, lds);
  grid.sync();
  phase_readout(p);
  grid.sync();
  {
    const bf16_t* A = (const bf16_t*)(ws + OFF_G); const bf16_t* W = (const bf16_t*)(ws + OFF_WOUT0);
    XcdWalk wk; wk.init(264 * 4); int o;
    while (wk.next(o)) {
      int mt, nt; tile_mn(o, 4, mt, nt);
      const int m0 = mt * 256;
      const int b = m0 / TL, t0 = m0 - b * TL;
      EpiResid e;
      if (t0 < T) { const size_t orow = (size_t)b * T + t0; e.xin = p.in[0] + orow * 1024; e.xout = p.out + orow * 1024; e.gvec = mod + (size_t)b * 3072 + 2048; }
      else { const size_t orow = (size_t)b * L + (t0 - T); e.xin = p.in[2] + orow * 1024; e.xout = CTX1 + orow * 1024; e.gvec = mod + (size_t)8 * 3072 + 2048; }
      e.n0 = nt * 256;
      gemm_tile<0, 256>(A, 1024, W + (size_t)nt * 256 * 1024, 1024, m0, nullptr, lds, e);
    }
  }
  grid.sync();
  phase_norm(p.out, CTX1, p.in[4] + 1024, mod + 9 * 3072, H);
  grid.sync();
  {
    const bf16_t* W = (const bf16_t*)(ws + OFF_WIN1);
    XcdWalk wk; wk.init(264 * 7); int o;
    while (wk.next(o)) {
      int mt, nt; tile_mn(o, 7, mt, nt);
      const int m0 = mt * 256;
      EpiMlaIn e; e.QC = (bf16_t*)(ws + OFF_QC); e.KVC = (bf16_t*)(ws + OFF_KVC); e.KPE = (bf16_t*)(ws + OFF_KPE); e.G1 = (bf16_t*)(ws + OFF_G1);
      e.rope = (const float*)(ws + OFF_ROPE); e.n0 = nt * 256; e.m0 = m0;
      gemm_tile<0, 256>(H, 1024, W + (size_t)nt * 256 * 1024, 1024, m0, nullptr, lds, e);
    }
  }
  grid.sync();
  {
    const bf16_t* WQ = (const bf16_t*)(ws + OFF_WQB); const bf16_t* WKV = (const bf16_t*)(ws + OFF_WKVB);
    const int nq = 256 * 6, nkv = 264 * 8;
    XcdWalk wk; wk.init(nq); int o;
    while (wk.next(o)) {
      EpiBf16 e; e.act = 0;
      {
        int mt2, nt; tile_mn(o, 6, mt2, nt);
        const int b = mt2 >> 5, m0 = b * TL + (mt2 & 31) * 256;
        e.dst = (bf16_t*)(ws + OFF_Q); e.ldd = 1536; e.col0 = nt * 256; e.m0 = m0; e.invK = 1.f / 384.f;
        gemm_tile<2, 256>((const bf16_t*)(ws + OFF_QC), 384, WQ + (size_t)nt * 256 * 384, 384, m0, nullptr, lds, e);
      }
    }
    wk.init(nkv);
    while (wk.next(o)) {
      EpiBf16 e; e.act = 0;
      {
        int mt, nt; tile_mn(o, 8, mt, nt);
        const int m0 = mt * 256;
        e.dst = (bf16_t*)(ws + OFF_KV); e.ldd = 2048; e.col0 = nt * 256; e.m0 = m0; e.invK = 1.f / 256.f;
        gemm_tile<2, 256>((const bf16_t*)(ws + OFF_KVC), 256, WKV + (size_t)nt * 256 * 256, 256, m0, nullptr, lds, e);
      }
    }
  }
  grid.sync();
  phase_attn(p, lds);
  grid.sync();
  {
    const bf16_t* A = (const bf16_t*)(ws + OFF_G1); const bf16_t* W = (const bf16_t*)(ws + OFF_WOUT1);
    XcdWalk wk; wk.init(256 * 4); int o;
    while (wk.next(o)) {
      int mt2, nt; tile_mn(o, 4, mt2, nt);
      const int b = mt2 >> 5, t0 = (mt2 & 31) * 256, m0 = b * TL + t0;
      const size_t orow = (size_t)b * T + t0;
      EpiResid e; e.xin = p.out + orow * 1024; e.xout = p.out + orow * 1024; e.gvec = mod + (size_t)(9 + b) * 3072 + 2048; e.n0 = nt * 256;
      gemm_tile<0, 256>(A, 1024, W + (size_t)nt * 256 * 1024, 1024, m0, nullptr, lds, e);
    }
  }
  grid.sync();
  phase_final(p.out, p.in[27]);
}

extern "C" void kernel_launch(void* const* d_in, const int* in_sizes, int n_in, void* d_out, int out_size, void* d_ws, size_t ws_size, hipStream_t stream) {
  static int grid_blocks = 0;
  if (grid_blocks == 0) {
    if (n_in != 28 || ws_size < WS_END + (size_t)(NTOK - LERP3_SPLIT) * 2048 || out_size != NB * T * D) { fprintf(stderr, "kernel_launch: unexpected shapes (n_in %d, ws %zu need %zu, out %d)\n", n_in, ws_size, (size_t)WS_END, out_size); grid_blocks = -1; return; }
    int dev = 0, cus = 0, per_cu = 0;
    hipGetDevice(&dev);
    hipDeviceGetAttribute(&cus, hipDeviceAttributeMultiprocessorCount, dev);
    if (hipFuncSetAttribute((const void*)fwd_megakernel, hipFuncAttributeMaxDynamicSharedMemorySize, LDS_BYTES) != hipSuccess) { fprintf(stderr, "kernel_launch: hipFuncSetAttribute failed\n"); grid_blocks = -1; return; }
    hipOccupancyMaxActiveBlocksPerMultiprocessor(&per_cu, (const void*)fwd_megakernel, NTHR, LDS_BYTES);
    if (per_cu < 1) { fprintf(stderr, "kernel_launch: occupancy query says %d blocks per CU\n", per_cu); per_cu = 1; }
    (void)hipGetLastError();
    grid_blocks = cus;
    if (grid_blocks > 256) grid_blocks = 256;
    grid_blocks &= ~7;
  }
  if (grid_blocks <= 0) return;
  Params p{};
  for (int i = 0; i < 28; ++i) p.in[i] = (const float*)d_in[i];
  p.out = (float*)d_out; p.ws = (unsigned char*)d_ws;
  void* args[] = {&p};
  hipError_t e = hipLaunchCooperativeKernel((const void*)fwd_megakernel, dim3(grid_blocks), dim3(NTHR), args, LDS_BYTES, stream);
  if (e != hipSuccess) fprintf(stderr, "cooperative launch failed: %s (grid %d)\n", hipGetErrorString(e), grid_blocks);
}
```

```cpp
#include <hip/hip_runtime.h>
#include <hip/hip_cooperative_groups.h>
#include <cstdio>
#include <cstdint>
namespace cg = cooperative_groups;

typedef unsigned short bf16_t;
typedef short bf16x8 __attribute__((ext_vector_type(8)));
typedef short s16x4 __attribute__((ext_vector_type(4)));
typedef float f32x16 __attribute__((ext_vector_type(16)));
typedef float f32x4 __attribute__((ext_vector_type(4)));
typedef float f32x2 __attribute__((ext_vector_type(2)));
typedef unsigned u32x4 __attribute__((ext_vector_type(4)));
typedef unsigned u32x2 __attribute__((ext_vector_type(2)));

constexpr int D = 1024, NB = 8, T = 8192, L = 256, TL = T + L, NTOK = NB * TL;
constexpr int NTHR = 512;

constexpr size_t U = (size_t)NTOK * 1024 * 2;
constexpr size_t OFF_H = 0, OFF_R = U, OFF_K = 2 * U, OFF_V = 3 * U, OFF_G = 4 * U, OFF_Y0 = 5 * U, OFF_Y1 = 6 * U;
constexpr size_t OFF_LORA = 7 * U;
constexpr size_t OFF_BONUS = OFF_LORA + (size_t)NTOK * 256 * 2;
constexpr size_t OFF_WIN0 = OFF_BONUS + (size_t)2 * NTOK * 16 * 4;
constexpr size_t OFF_WOUT0 = OFF_WIN0 + (size_t)4352 * 1024 * 2;
constexpr size_t OFF_WIN1 = OFF_WOUT0 + (size_t)1024 * 1024 * 2;
constexpr size_t OFF_WQB = OFF_WIN1 + (size_t)1792 * 1024 * 2;
constexpr size_t OFF_WKVB = OFF_WQB + (size_t)1536 * 384 * 2;
constexpr size_t OFF_WOUT1 = OFF_WKVB + (size_t)2048 * 256 * 2;
constexpr size_t OFF_MOD = OFF_WOUT1 + (size_t)1024 * 1024 * 2;
constexpr size_t OFF_ROPE = OFF_MOD + (size_t)2 * 9 * 3072 * 4;
constexpr size_t OFF_CTX1 = OFF_ROPE + (size_t)128 * 8 * 2 * 4;
constexpr size_t WS_END = OFF_CTX1 + (size_t)2048 * 1024 * 4;
constexpr size_t OFF_QC = OFF_V;
constexpr size_t OFF_KVC = OFF_QC + (size_t)NTOK * 384 * 2;
constexpr size_t OFF_KPE = OFF_KVC + (size_t)NTOK * 256 * 2;
constexpr size_t OFF_G1 = OFF_G;
constexpr size_t OFF_Q = OFF_R;
constexpr size_t OFF_KV = OFF_Y0;

struct Params { const float* in[28]; float* out; unsigned char* ws; };

typedef __bf16 bf16x2_t __attribute__((ext_vector_type(2)));
__device__ __forceinline__ unsigned cvtpk(float lo, float hi) { f32x2 v = {lo, hi}; bf16x2_t b = __builtin_convertvector(v, bf16x2_t); return *(unsigned*)&b; }
__device__ __forceinline__ float bf2f(bf16_t u) { return __uint_as_float(((unsigned)u) << 16); }
__device__ __forceinline__ bf16_t f2bf(float f) { return (bf16_t)(cvtpk(f, 0.f) & 0xffffu); }
__device__ __forceinline__ float lo16(unsigned w) { return __uint_as_float(w << 16); }
__device__ __forceinline__ float hi16(unsigned w) { return __uint_as_float(w & 0xffff0000u); }
__device__ __forceinline__ void st_bf16x4(bf16_t* p, float a, float b, float c, float d) { u32x2 w = {cvtpk(a, b), cvtpk(c, d)}; *(u32x2*)p = w; }
__device__ __forceinline__ void st_bf16x4_nt(bf16_t* p, float a, float b, float c, float d) { u32x2 w = {cvtpk(a, b), cvtpk(c, d)}; __builtin_nontemporal_store(w, (u32x2*)p); }
__device__ __forceinline__ float wave_sum(float v) {
#pragma unroll
  for (int o = 32; o; o >>= 1) v += __shfl_xor(v, o);
  return v;
}
__device__ __forceinline__ float dpp_f(float v, const int ctrl_sel) {
  int r;
  if (ctrl_sel == 0) r = __builtin_amdgcn_update_dpp(0, __float_as_int(v), 0xB1, 0xF, 0xF, true);
  else if (ctrl_sel == 1) r = __builtin_amdgcn_update_dpp(0, __float_as_int(v), 0x4E, 0xF, 0xF, true);
  else r = __builtin_amdgcn_update_dpp(0, __float_as_int(v), 0x141, 0xF, 0xF, true);
  return __int_as_float(r);
}
__device__ __forceinline__ float red8(float v) { v += dpp_f(v, 0); v += dpp_f(v, 1); v += dpp_f(v, 2); return v; }
__device__ __forceinline__ int crow(int r, int hi) { return (r & 3) + 8 * (r >> 2) + 4 * hi; }
__device__ __forceinline__ float sigmoidf_(float x) { return 1.f / (1.f + __expf(-x)); }
#define MFMA(a, b, c) __builtin_amdgcn_mfma_f32_32x32x16_bf16((a), (b), (c), 0, 0, 0)

constexpr int G_LDT = 144;
constexpr int G_SSQ_OFF = 2 * (256 + 256) * G_LDT;
constexpr int LDS_BYTES = G_SSQ_OFF + 1024;

template <int AMODE, int BN, class Epi>
__device__ __forceinline__ void gemm_tile(const bf16_t* A, const int lda, const bf16_t* Bt, const int K, const int m0, const float* mu, char* lds, const Epi& epi) {
  constexpr int WN = BN / 64, MI = WN, NBR = BN / 64, G_STAGE = (256 + BN) * G_LDT;
  const int tid = threadIdx.x, lane = tid & 63, wid = tid >> 6, r32 = lane & 31, hi = lane >> 5;
  const int wm = wid / WN, wn = wid % WN;
  const int srow = tid >> 3, scc = (tid & 7) * 8;
  const int brow = Epi::PERM ? ((srow & 32) + 16 * ((srow >> 2) & 1) + 4 * ((srow & 31) >> 3) + (srow & 3)) : srow;
  f32x16 acc[MI][2];
#pragma unroll
  for (int i = 0; i < MI; ++i)
#pragma unroll
    for (int j = 0; j < 2; ++j)
#pragma unroll
      for (int r = 0; r < 16; ++r) acc[i][j][r] = 0.f;
  bf16x8 ra[4], rb[NBR], rp[4], rn[4];
  float ssq[4] = {0.f, 0.f, 0.f, 0.f};
  int dprev[4], dnext[4];
  if constexpr (AMODE == 1) {
    const int t0 = m0 % TL;
#pragma unroll
    for (int i = 0; i < 4; ++i) { const int t = t0 + srow + 64 * i; dprev[i] = (t != 0 && t != T) ? 1 : 0; dnext[i] = (t != T - 1 && t != TL - 1) ? 1 : 0; }
  }
  auto gload = [&](int k0) {
#pragma unroll
    for (int i = 0; i < 4; ++i) {
      const bf16_t* ap = A + (size_t)(m0 + srow + 64 * i) * lda + k0 + scc;
      ra[i] = *(const bf16x8*)ap;
      if constexpr (AMODE == 1) { rp[i] = *(const bf16x8*)(ap - dprev[i] * lda); rn[i] = *(const bf16x8*)(ap + dnext[i] * lda); }
    }
#pragma unroll
    for (int i = 0; i < NBR; ++i) rb[i] = *(const bf16x8*)(Bt + (size_t)(brow + 64 * i) * K + k0 + scc);
  };
  auto lstore = [&](int s, int k0) {
    char* base = lds + s * G_STAGE;
    if constexpr (AMODE == 1) {
      const f32x4 m0v = *(const f32x4*)(mu + k0 + scc), m1v = *(const f32x4*)(mu + k0 + scc + 4);
      const float mm[8] = {m0v[0], m0v[1], m0v[2], m0v[3], m1v[0], m1v[1], m1v[2], m1v[3]};
#pragma unroll
      for (int i = 0; i < 4; ++i) {
        const u32x4 hc = *(const u32x4*)&ra[i], hp = *(const u32x4*)&rp[i], hn = *(const u32x4*)&rn[i];
        const float fp = dprev[i] ? 0.5f : 0.f, fn = dnext[i] ? 0.5f : 0.f;
        u32x4 w;
#pragma unroll
        for (int q = 0; q < 4; ++q) {
          const float c0 = lo16(hc[q]), c1 = hi16(hc[q]);
          const float x0 = fp * lo16(hp[q]) + fn * lo16(hn[q]) - c0, x1 = fp * hi16(hp[q]) + fn * hi16(hn[q]) - c1;
          w[q] = cvtpk(c0 + x0 * mm[2 * q], c1 + x1 * mm[2 * q + 1]);
        }
        *(u32x4*)(base + (srow + 64 * i) * G_LDT + scc * 2) = w;
      }
    } else {
#pragma unroll
      for (int i = 0; i < 4; ++i) {
        *(bf16x8*)(base + (srow + 64 * i) * G_LDT + scc * 2) = ra[i];
        if constexpr (AMODE == 2) {
          const u32x4 hc = *(const u32x4*)&ra[i];
#pragma unroll
          for (int q = 0; q < 4; ++q) { const float c0 = lo16(hc[q]), c1 = hi16(hc[q]); ssq[i] += c0 * c0 + c1 * c1; }
        }
      }
    }
#pragma unroll
    for (int i = 0; i < NBR; ++i) *(bf16x8*)(base + 256 * G_LDT + (srow + 64 * i) * G_LDT + scc * 2) = rb[i];
  };
  const int nk = K >> 6;
  gload(0);
  lstore(0, 0);
  if (nk > 1) gload(64);
  __syncthreads();
#pragma unroll 1
  for (int kt = 0; kt < nk; ++kt) {
    const int s = kt & 1;
    if (kt + 1 < nk) lstore(s ^ 1, (kt + 1) * 64);
    if (kt + 2 < nk) gload((kt + 2) * 64);
    {
      const char* Ab = lds + s * G_STAGE + (wm * (32 * MI) + r32) * G_LDT + hi * 16;
      const char* Bb = lds + s * G_STAGE + 256 * G_LDT + (wn * 64 + r32) * G_LDT + hi * 16;
      bf16x8 fb[2][2], fa[2][MI];
      fb[0][0] = *(const bf16x8*)(Bb); fb[0][1] = *(const bf16x8*)(Bb + 32 * G_LDT);
#pragma unroll
      for (int mi = 0; mi < MI; ++mi) fa[0][mi] = *(const bf16x8*)(Ab + mi * 32 * G_LDT);
#pragma unroll
      for (int ks = 0; ks < 4; ++ks) {
        const int sl = ks & 1;
        if (ks + 1 < 4) {
          fb[sl ^ 1][0] = *(const bf16x8*)(Bb + (ks + 1) * 32); fb[sl ^ 1][1] = *(const bf16x8*)(Bb + 32 * G_LDT + (ks + 1) * 32);
#pragma unroll
          for (int mi = 0; mi < MI; ++mi) fa[sl ^ 1][mi] = *(const bf16x8*)(Ab + mi * 32 * G_LDT + (ks + 1) * 32);
        }
#pragma unroll
        for (int mi = 0; mi < MI; ++mi) { acc[mi][0] = MFMA(fb[sl][0], fa[sl][mi], acc[mi][0]); acc[mi][1] = MFMA(fb[sl][1], fa[sl][mi], acc[mi][1]); }
      }
    }
    __syncthreads();
  }
  float* ssq_l = (float*)(lds + G_SSQ_OFF);
  if constexpr (AMODE == 2) {
#pragma unroll
    for (int i = 0; i < 4; ++i) { const float v = red8(ssq[i]); if ((tid & 7) == 0) ssq_l[srow + 64 * i] = v; }
    __syncthreads();
  }
#pragma unroll
  for (int mi = 0; mi < MI; ++mi) {
    const int lrow = wm * (32 * MI) + mi * 32 + r32;
    float aux = 0.f;
    if constexpr (AMODE == 2) aux = ssq_l[lrow];
    epi(lrow, wn * 64 + 4 * hi, acc[mi][0], acc[mi][1], aux);
  }
}

struct EpiBf16 {
  static constexpr bool PERM = true;
  bf16_t* dst; int ldd; int col0; int m0; int act; float invK;
  __device__ __forceinline__ void operator()(int lrow, int nc, const f32x16& a0, const f32x16& a1, float aux) const { one(lrow, nc, a0, aux); one(lrow, nc + 32, a1, aux); }
  __device__ __forceinline__ void one(int lrow, int nc, const f32x16& a, float aux) const {
    float sc = 1.f;
    if (invK > 0.f) sc = rsqrtf(aux * invK + 1e-6f);
    bf16_t* p = dst + (size_t)(m0 + lrow) * ldd + col0 + (nc & ~7) + 4 * (nc & 4);
    if (act) {
#define TANH_(x) (1.f - 2.f / (__expf(2.f * (x) * sc) + 1.f))
      const u32x4 w0 = {cvtpk(TANH_(a[0]), TANH_(a[1])), cvtpk(TANH_(a[2]), TANH_(a[3])), cvtpk(TANH_(a[4]), TANH_(a[5])), cvtpk(TANH_(a[6]), TANH_(a[7]))};
      const u32x4 w1 = {cvtpk(TANH_(a[8]), TANH_(a[9])), cvtpk(TANH_(a[10]), TANH_(a[11])), cvtpk(TANH_(a[12]), TANH_(a[13])), cvtpk(TANH_(a[14]), TANH_(a[15]))};
#undef TANH_
      *(u32x4*)p = w0; *(u32x4*)(p + 8) = w1;
    } else {
      const u32x4 w0 = {cvtpk(a[0] * sc, a[1] * sc), cvtpk(a[2] * sc, a[3] * sc), cvtpk(a[4] * sc, a[5] * sc), cvtpk(a[6] * sc, a[7] * sc)};
      const u32x4 w1 = {cvtpk(a[8] * sc, a[9] * sc), cvtpk(a[10] * sc, a[11] * sc), cvtpk(a[12] * sc, a[13] * sc), cvtpk(a[14] * sc, a[15] * sc)};
      *(u32x4*)p = w0; *(u32x4*)(p + 8) = w1;
    }
  }
};
struct EpiResid {
  static constexpr bool PERM = false;
  const float* xin; float* xout; const float* gvec; int n0;
  __device__ __forceinline__ void operator()(int lrow, int nc, const f32x16& a0, const f32x16& a1, float) const {
    const size_t o = (size_t)lrow * 1024 + n0 + nc;
    f32x4 xv[8], gv[8];
#pragma unroll
    for (int g = 0; g < 4; ++g) {
      xv[g] = *(const f32x4*)(xin + o + 8 * g); xv[4 + g] = *(const f32x4*)(xin + o + 32 + 8 * g);
      gv[g] = *(const f32x4*)(gvec + n0 + nc + 8 * g); gv[4 + g] = *(const f32x4*)(gvec + n0 + nc + 32 + 8 * g);
    }
    f32x4 r[8];
#pragma unroll
    for (int g = 0; g < 4; ++g)
#pragma unroll
      for (int e = 0; e < 4; ++e) { r[g][e] = xv[g][e] + gv[g][e] * a0[4 * g + e]; r[4 + g][e] = xv[4 + g][e] + gv[4 + g][e] * a1[4 * g + e]; }
    asm volatile("" ::: "memory");
#pragma unroll
    for (int g = 0; g < 4; ++g) { *(f32x4*)(xout + o + 8 * g) = r[g]; *(f32x4*)(xout + o + 32 + 8 * g) = r[4 + g]; }
  }
};
struct EpiMlaIn {
  static constexpr bool PERM = false;
  bf16_t *QC, *KVC, *KPE, *G1; const float* rope; int n0; int m0;
  __device__ __forceinline__ void operator()(int lrow, int nc, const f32x16& a0, const f32x16& a1, float) const { one(lrow, nc, a0); one(lrow, nc + 32, a1); }
  __device__ __forceinline__ void one(int lrow, int nc, const f32x16& a) const {
    const int row = m0 + lrow, gc = n0 + nc, g32 = gc & ~31;
    if (g32 == 640) {
      const int t = (m0 % TL) + lrow, hi4 = gc - 640;
      bf16_t* p = KPE + (size_t)row * 32;
      if (t < T) {
        const f32x2* tr = (const f32x2*)rope + (t >> 6) * 8 + hi4;
        const f32x2* tc = (const f32x2*)rope + (t & 63) * 8 + hi4;
        float o1[8], o2[8];
#pragma unroll
        for (int e = 0; e < 4; ++e) {
          const f32x2 cs0 = tr[e], cs1 = tc[e];
          const float x1a = a[e], x2a = a[8 + e];
          const float x1b = a[4 + e], x2b = a[12 + e];
          o1[e] = x1a * cs0[0] - x2a * cs0[1]; o2[e] = x1a * cs0[1] + x2a * cs0[0];
          o1[4 + e] = x1b * cs1[0] - x2b * cs1[1]; o2[4 + e] = x1b * cs1[1] + x2b * cs1[0];
        }
        st_bf16x4(p + hi4, o1[0], o1[1], o1[2], o1[3]);
        st_bf16x4(p + 8 + hi4, o1[4], o1[5], o1[6], o1[7]);
        st_bf16x4(p + 16 + hi4, o2[0], o2[1], o2[2], o2[3]);
        st_bf16x4(p + 24 + hi4, o2[4], o2[5], o2[6], o2[7]);
      } else {
#pragma unroll
        for (int g = 0; g < 4; ++g) st_bf16x4(p + 8 * g + hi4, a[4 * g], a[4 * g + 1], a[4 * g + 2], a[4 * g + 3]);
      }
      return;
    }
    if (g32 > 640 && g32 < 768) return;
    bf16_t* p;
    if (gc < 384) p = QC + (size_t)row * 384 + gc;
    else if (gc < 640) p = KVC + (size_t)row * 256 + (gc - 384);
    else p = G1 + (size_t)row * 1024 + (gc - 768);
#pragma unroll
    for (int g = 0; g < 4; ++g) st_bf16x4(p + 8 * g, a[4 * g], a[4 * g + 1], a[4 * g + 2], a[4 * g + 3]);
  }
};

constexpr float AT_SCALE = 0.10206207261596575f;
constexpr float AT_THR = 8.f;
__device__ void tr_job(const float* src, int ld, int K, int N, bf16_t* dst, const float* kscale, char* lds, float gscale = 1.f) {
  float* tile = (float*)lds;
  const int tid = threadIdx.x, nK = K >> 6, nN = (N + 63) >> 6;
  for (int tIdx = blockIdx.x; tIdx < nK * nN; tIdx += gridDim.x) {
    const int k0 = (tIdx % nK) * 64, n0 = (tIdx / nK) * 64;
#pragma unroll
    for (int i = 0; i < 8; ++i) {
      const int kk = (tid >> 6) + 8 * i, nn = tid & 63;
      float v = 0.f;
      if (n0 + nn < N) { v = src[(size_t)(k0 + kk) * ld + n0 + nn] * gscale; if (kscale) v *= kscale[k0 + kk]; }
      tile[kk * 65 + nn] = v;
    }
    __syncthreads();
#pragma unroll
    for (int i = 0; i < 8; ++i) {
      const int nn = (tid >> 6) + 8 * i, kk = tid & 63;
      if (n0 + nn < N) dst[(size_t)(n0 + nn) * K + k0 + kk] = f2bf(tile[kk * 65 + nn]);
    }
    __syncthreads();
  }
}

__device__ void phase_weights(const Params& p, char* lds) {
  unsigned char* ws = p.ws;
  bf16_t* WIN0 = (bf16_t*)(ws + OFF_WIN0);
  for (int j = 0; j < 4; ++j) tr_job(p.in[8] + (size_t)j * 1024 * 1024, 1024, 1024, 1024, WIN0 + (size_t)j * 1024 * 1024, nullptr, lds);
  for (int d = 0; d < 2; ++d) {
    tr_job(p.in[10] + (size_t)d * 1024 * 64, 64, 1024, 64, WIN0 + (size_t)(4096 + d * 64) * 1024, nullptr, lds);
    tr_job(p.in[13] + (size_t)d * 1024 * 64, 64, 1024, 64, WIN0 + (size_t)(4224 + d * 64) * 1024, nullptr, lds);
  }
  tr_job(p.in[20], 1024, 1024, 1024, (bf16_t*)(ws + OFF_WOUT0), nullptr, lds);
  bf16_t* WIN1 = (bf16_t*)(ws + OFF_WIN1);
  tr_job(p.in[21], 1696, 1024, 640, WIN1, nullptr, lds);
  tr_job(p.in[21] + 640, 1696, 1024, 32, WIN1 + (size_t)640 * 1024, nullptr, lds);
  tr_job(p.in[21] + 672, 1696, 1024, 1024, WIN1 + (size_t)768 * 1024, nullptr, lds);
  for (int i = blockIdx.x * NTHR + threadIdx.x; i < 96 * 1024; i += gridDim.x * NTHR) WIN1[(size_t)672 * 1024 + i] = 0;
  tr_job(p.in[23], 1536, 384, 1536, (bf16_t*)(ws + OFF_WQB), p.in[22], lds, AT_SCALE * 1.4426950408889634f);
  tr_job(p.in[25], 2048, 256, 2048, (bf16_t*)(ws + OFF_WKVB), p.in[24], lds);
  tr_job(p.in[26], 1024, 1024, 1024, (bf16_t*)(ws + OFF_WOUT1), nullptr, lds);
}
__device__ void phase_prologue(const Params& p, char* lds) {
  unsigned char* ws = p.ws;
  {
    const int i = blockIdx.x * NTHR + threadIdx.x;
    if (i < 1024) {
      const float invf[8] = {1.f, 0.316227766016838f, 0.1f, 0.0316227766016838f, 0.01f, 0.00316227766016838f, 0.001f, 0.000316227766016838f};
      const int pos = i >> 3, m = i & 7;
      float inv = invf[0];
#pragma unroll
      for (int q = 1; q < 8; ++q) inv = (m == q) ? invf[q] : inv;
      const float ang = (float)pos * inv;
      const float kf = rintf(ang * 0.15915494309189535f);
      float r = fmaf(-kf, 6.28125f, ang);
      r = fmaf(-kf, 1.9353071795864769e-3f, r);
      float* rt = (float*)(ws + OFF_ROPE);
      rt[2 * i] = cosf(r); rt[2 * i + 1] = sinf(r);
    }
  }
  {
    float* sil = (float*)lds;
    float* red = sil + 9 * 1024;
    const int tid = threadIdx.x;
    for (int i = tid; i < 9 * 1024; i += NTHR) {
      const int bi = i >> 10, k = i & 1023;
      const float cv = bi < 8 ? p.in[1][bi * 1024 + k] : p.in[3][k];
      sil[i] = cv / (1.f + __expf(-cv));
    }
    __syncthreads();
    float* mod = (float*)(ws + OFF_MOD);
    for (int item = blockIdx.x; item < 192; item += gridDim.x) {
      const int l = item / 96, n0 = (item % 96) * 32, col = tid & 31, kg = tid >> 5;
      float acc[9];
#pragma unroll
      for (int bi = 0; bi < 9; ++bi) acc[bi] = 0.f;
      const float* wp = p.in[5] + ((size_t)l * 1024 + kg * 64) * 3072 + n0 + col;
      for (int kk = 0; kk < 64; ++kk) {
        const float w = wp[(size_t)kk * 3072];
#pragma unroll
        for (int bi = 0; bi < 9; ++bi) acc[bi] += sil[bi * 1024 + kg * 64 + kk] * w;
      }
#pragma unroll
      for (int bi = 0; bi < 9; ++bi) red[(kg * 9 + bi) * 32 + col] = acc[bi];
      __syncthreads();
      if (tid < 288) {
        const int bi = tid >> 5;
        float s = 0.f;
#pragma unroll
        for (int g = 0; g < 16; ++g) s += red[(g * 9 + bi) * 32 + col];
        mod[((size_t)l * 9 + bi) * 3072 + n0 + col] = s + p.in[6][l * 3072 + n0 + col];
      }
      __syncthreads();
    }
  }
}

__device__ __forceinline__ const float* row_src(const float* xsrc, const float* csrc, int n, int& bi) {
  const int b = n / TL, t = n - b * TL;
  if (t < T) { bi = b; return xsrc + ((size_t)b * T + t) * D; }
  bi = 8; return csrc + ((size_t)b * L + (t - T)) * D;
}
__device__ void phase_norm(const float* xsrc, const float* csrc, const float* ng, const float* mod, bf16_t* H) {
  const int lane = threadIdx.x & 63, gw = blockIdx.x * 8 + (threadIdx.x >> 6), nw = gridDim.x * 8;
  f32x4 g4[4];
#pragma unroll
  for (int i = 0; i < 4; ++i) g4[i] = *(const f32x4*)(ng + i * 256 + lane * 4);
  f32x4 va[4], vb[4]; int bia = 0, bib = 0;
  if (gw < NTOK) { const float* src = row_src(xsrc, csrc, gw, bia);
#pragma unroll
    for (int i = 0; i < 4; ++i) va[i] = *(const f32x4*)(src + i * 256 + lane * 4); }
  for (int n = gw; n < NTOK; n += nw) {
    if (n + nw < NTOK) { const float* src = row_src(xsrc, csrc, n + nw, bib);
#pragma unroll
      for (int i = 0; i < 4; ++i) vb[i] = *(const f32x4*)(src + i * 256 + lane * 4); }
    float ss = 0.f;
#pragma unroll
    for (int i = 0; i < 4; ++i) ss += va[i][0] * va[i][0] + va[i][1] * va[i][1] + va[i][2] * va[i][2] + va[i][3] * va[i][3];
    ss = wave_sum(ss);
    const float rstd = rsqrtf(ss * (1.f / 1024.f) + 1e-6f);
    const float* m = mod + bia * 3072;
#pragma unroll
    for (int i = 0; i < 4; ++i) {
      const int c = i * 256 + lane * 4;
      const f32x4 sh = *(const f32x4*)(m + c), sc = *(const f32x4*)(m + 1024 + c);
      float o[4];
#pragma unroll
      for (int e = 0; e < 4; ++e) o[e] = va[i][e] * rstd * g4[i][e] * (1.f + sc[e]) + sh[e];
      st_bf16x4(H + (size_t)n * 1024 + c, o[0], o[1], o[2], o[3]);
    }
#pragma unroll
    for (int i = 0; i < 4; ++i) va[i] = vb[i];
    bia = bib;
  }
}

constexpr int LERP3_SPLIT = 63488;
__device__ __forceinline__ bf16_t* lerp_base(const Params& p, int j, int row) {
  if (j == 0) return (bf16_t*)(p.ws + OFF_Y0);
  if (j == 1) return (bf16_t*)(p.ws + OFF_Y1);
  if (j == 2) return (bf16_t*)p.out;
  if (row < LERP3_SPLIT) return (bf16_t*)p.out + (size_t)NTOK * 1024;
  return (bf16_t*)(p.ws + WS_END) - (size_t)LERP3_SPLIT * 1024;
}
struct RowX { f32x4 v[4]; int bi; };
__device__ __forceinline__ void ld_row(const Params& p, int n, int lane, RowX& r) {
  const float* src = row_src(p.in[0], p.in[2], n, r.bi);
#pragma unroll
  for (int i = 0; i < 4; ++i) r.v[i] = *(const f32x4*)(src + i * 256 + lane * 4);
}
__device__ __forceinline__ void fin_row(const float* mod, const f32x4 (&g4)[4], int lane, const RowX& r, float (&h)[16]) {
  float ss = 0.f;
#pragma unroll
  for (int i = 0; i < 4; ++i) ss += r.v[i][0] * r.v[i][0] + r.v[i][1] * r.v[i][1] + r.v[i][2] * r.v[i][2] + r.v[i][3] * r.v[i][3];
  ss = wave_sum(ss);
  const float rstd = rsqrtf(ss * (1.f / 1024.f) + 1e-6f);
  const float* m = mod + r.bi * 3072;
#pragma unroll
  for (int i = 0; i < 4; ++i) {
    const int c = i * 256 + lane * 4;
    const f32x4 sh = *(const f32x4*)(m + c), sc = *(const f32x4*)(m + 1024 + c);
#pragma unroll
    for (int e = 0; e < 4; ++e) {
      const float hv = r.v[i][e] * rstd * g4[i][e] * (1.f + sc[e]) + sh[e];
      h[4 * i + e] = __uint_as_float(cvtpk(hv, 0.f) << 16);
    }
  }
}
__device__ void phase_norm_lerp(const Params& p, const float* mod) {
  const int lane = threadIdx.x & 63, gw = blockIdx.x * 8 + (threadIdx.x >> 6), nw = gridDim.x * 8;
  const int per = (NTOK + nw - 1) / nw;
  const int r0 = gw * per, r1 = (r0 + per < NTOK) ? r0 + per : NTOK;
  if (r0 >= r1) return;
  bf16_t* H = (bf16_t*)(p.ws + OFF_H);
  f32x4 g4[4];
#pragma unroll
  for (int i = 0; i < 4; ++i) g4[i] = *(const f32x4*)(p.in[4] + i * 256 + lane * 4);
  float mu[4][16];
#pragma unroll
  for (int j = 0; j < 4; ++j)
#pragma unroll
    for (int i = 0; i < 4; ++i) {
      const f32x4 m4 = *(const f32x4*)(p.in[7] + j * 1024 + i * 256 + lane * 4);
      mu[j][4 * i] = m4[0]; mu[j][4 * i + 1] = m4[1]; mu[j][4 * i + 2] = m4[2]; mu[j][4 * i + 3] = m4[3];
    }
  float hp[16], hc[16], hn[16];
  RowX xa, xb, xc;
  if (r0 > 0) { ld_row(p, r0 - 1, lane, xc); }
  ld_row(p, r0, lane, xa);
  if (r0 + 1 < NTOK) ld_row(p, r0 + 1, lane, xb);
  if (r0 > 0) fin_row(mod, g4, lane, xc, hp);
  else {
#pragma unroll
    for (int e = 0; e < 16; ++e) hp[e] = 0.f;
  }
  fin_row(mod, g4, lane, xa, hc);
  xa = xb;
  if (r0 + 2 < NTOK) ld_row(p, r0 + 2, lane, xb);
  for (int n = r0; n < r1; ++n) {
    const int t = n % TL;
    if (n + 3 < NTOK) ld_row(p, n + 3, lane, xc);
    if (n + 1 < NTOK) fin_row(mod, g4, lane, xa, hn);
    else {
#pragma unroll
      for (int e = 0; e < 16; ++e) hn[e] = 0.f;
    }
    const float fp = (t != 0 && t != T) ? 0.5f : 0.f, fn = (t != T - 1 && t != TL - 1) ? 0.5f : 0.f;
#pragma unroll
    for (int i = 0; i < 4; ++i) st_bf16x4_nt(H + (size_t)n * 1024 + i * 256 + lane * 4, hc[4 * i], hc[4 * i + 1], hc[4 * i + 2], hc[4 * i + 3]);
#pragma unroll
    for (int j = 0; j < 4; ++j) {
      bf16_t* dst = lerp_base(p, j, n) + (size_t)n * 1024 + lane * 4;
#pragma unroll
      for (int i = 0; i < 4; ++i) {
        float o[4];
#pragma unroll
        for (int e = 0; e < 4; ++e) { const float c = hc[4 * i + e]; o[e] = c + (fp * hp[4 * i + e] + fn * hn[4 * i + e] - c) * mu[j][4 * i + e]; }
        st_bf16x4_nt(dst + i * 256, o[0], o[1], o[2], o[3]);
      }
    }
#pragma unroll
    for (int e = 0; e < 16; ++e) { hp[e] = hc[e]; hc[e] = hn[e]; }
    xa = xb; xb = xc;
  }
}

__device__ void phase_final(float* out, const float* fg) {
  const int lane = threadIdx.x & 63, gw = blockIdx.x * 8 + (threadIdx.x >> 6), nw = gridDim.x * 8;
  f32x4 g4[4];
#pragma unroll
  for (int i = 0; i < 4; ++i) g4[i] = *(const f32x4*)(fg + i * 256 + lane * 4);
  f32x4 va[4], vb[4];
  if (gw < NB * T) {
#pragma unroll
    for (int i = 0; i < 4; ++i) va[i] = *(const f32x4*)(out + (size_t)gw * D + i * 256 + lane * 4); }
  for (int n = gw; n < NB * T; n += nw) {
    if (n + nw < NB * T) {
#pragma unroll
      for (int i = 0; i < 4; ++i) vb[i] = *(const f32x4*)(out + (size_t)(n + nw) * D + i * 256 + lane * 4); }
    float ss = 0.f;
#pragma unroll
    for (int i = 0; i < 4; ++i) ss += va[i][0] * va[i][0] + va[i][1] * va[i][1] + va[i][2] * va[i][2] + va[i][3] * va[i][3];
    ss = wave_sum(ss);
    const float rstd = rsqrtf(ss * (1.f / 1024.f) + 1e-6f);
#pragma unroll
    for (int i = 0; i < 4; ++i) {
      f32x4 o;
#pragma unroll
      for (int e = 0; e < 4; ++e) o[e] = va[i][e] * rstd * g4[i][e];
      *(f32x4*)(out + (size_t)n * D + i * 256 + lane * 4) = o;
    }
#pragma unroll
    for (int i = 0; i < 4; ++i) va[i] = vb[i];
  }
}

__device__ __forceinline__ int scan_row(int g, int d, int b) {
  if (g < L) { const int tt = d ? (L - 1 - g) : g; return b * TL + T + tt; }
  g -= L; const int tt = d ? (T - 1 - g) : g; return b * TL + tt;
}
constexpr int SC_P = 0, SC_ARA = 8192, SC_ARR = SC_ARA + 4096, SC_BK = SC_ARR + 4096, SC_SCAL = SC_BK + 8192, SC_VV = SC_SCAL + 1024, SC_BUF = SC_VV + 8192;
constexpr int SC_IC = 2 * SC_BUF, SC_SCR = SC_IC + 8192, SC_YB = SC_SCR + 16384, SC_END = SC_YB + 2 * 8192;
#define MFMA16(a, b, c) __builtin_amdgcn_mfma_f32_16x16x32_bf16((a), (b), (c), 0, 0, 0)
struct ScBlk { u32x4 aa0, aa1, ar0, ar1, k0, k1, k2, k3; f32x4 v; f32x4 s[8]; };
__device__ __forceinline__ void sc_ldb(ScBlk& c, const char* buf, int blk, int arOff, int bkOff, int vOff) {
  const char* pa = buf + SC_ARA + blk * 512 + arOff; const char* pr = buf + SC_ARR + blk * 512 + arOff;
  c.aa0 = *(const u32x4*)(pa); c.aa1 = *(const u32x4*)(pa + 64); c.ar0 = *(const u32x4*)(pr); c.ar1 = *(const u32x4*)(pr + 64);
  const char* bk = buf + SC_BK + blk * 1024 + bkOff;
  c.k0 = *(const u32x4*)(bk); c.k1 = *(const u32x4*)(bk + 256); c.k2 = *(const u32x4*)(bk + 512); c.k3 = *(const u32x4*)(bk + 768);
  c.v = *(const f32x4*)(buf + SC_VV + blk * 1024 + vOff);
  const char* sp = buf + SC_SCAL + blk * 128;
#pragma unroll
  for (int i = 0; i < 8; ++i) c.s[i] = *(const f32x4*)(sp + i * 16);
}
__device__ void phase_scan(const Params& p, char* lds) {
  unsigned char* ws = p.ws;
  const int tid = threadIdx.x, lane = tid & 63, wid = __builtin_amdgcn_readfirstlane(tid >> 6), r32 = lane & 31, hi = lane >> 5;
  const bf16_t* Rg = (const bf16_t*)(ws + OFF_R); const bf16_t* Kg = (const bf16_t*)(ws + OFF_K); const bf16_t* Vg = (const bf16_t*)(ws + OFF_V);
  const bf16_t* Lg = (const bf16_t*)(ws + OFF_LORA);
  constexpr int NCH = TL / 32;
  for (int sidx = blockIdx.x; sidx < 256; sidx += gridDim.x) {
    const int d = sidx >> 7, b = (sidx >> 4) & 7, h = sidx & 15;
    bf16_t* Yg = (bf16_t*)(ws + (d ? OFF_Y1 : OFF_Y0));
    if (wid < 4) {
      const int cw = wid, c16 = lane & 15, q = lane >> 4;
      const int arOff = (c16 & 3) * 128 + q * 16, wOff = q * 16, bkOff = c16 * 16, vOff = (cw * 16 + c16) * 16;
      f32x4 St0 = {0.f, 0.f, 0.f, 0.f}, St1 = St0, St2 = St0, St3 = St0;
      __syncthreads(); __syncthreads();
      for (int c = 0; c < NCH; ++c) {
        const char* buf = lds + (c & 1) * SC_BUF;
        char* yb = lds + SC_YB + (c & 1) * 8192 + (cw * 16 + c16) * 16;
        ScBlk cur; sc_ldb(cur, buf, 0, arOff, bkOff, vOff);
#pragma unroll 1
        for (int blk = 0; blk < 8; ++blk) {
          ScBlk nxt; sc_ldb(nxt, buf, (blk + 1) & 7, arOff, bkOff, vOff);
          u32x4 b1 = {cvtpk(St0[0], St0[1]), cvtpk(St0[2], St0[3]), cvtpk(St1[0], St1[1]), cvtpk(St1[2], St1[3])};
          u32x4 b2 = {cvtpk(St2[0], St2[1]), cvtpk(St2[2], St2[3]), cvtpk(St3[0], St3[1]), cvtpk(St3[2], St3[3])};
          f32x4 sr = {0.f, 0.f, 0.f, 0.f}, yr = sr;
          sr = MFMA16(*(bf16x8*)&cur.aa0, *(bf16x8*)&b1, sr); yr = MFMA16(*(bf16x8*)&cur.ar0, *(bf16x8*)&b1, yr);
          sr = MFMA16(*(bf16x8*)&cur.aa1, *(bf16x8*)&b2, sr); yr = MFMA16(*(bf16x8*)&cur.ar1, *(bf16x8*)&b2, yr);
          const float v1 = cur.v[0], v2 = cur.v[1], v3 = cur.v[2], v4 = cur.v[3];
          const f32x4 s0 = cur.s[0], s1 = cur.s[1], s2 = cur.s[2], s3 = cur.s[3], s4 = cur.s[4], s5 = cur.s[5], s6 = cur.s[6], s7 = cur.s[7];
          const float sa1 = sr[0];
          const float sa2 = sr[1] + s0[0] * sa1 + s1[2] * v1;
          const float sa3 = sr[2] + s0[1] * sa1 + s1[3] * v1 + s0[2] * sa2 + s2[0] * v2;
          const float sa4 = sr[3] + s0[3] * sa1 + s2[1] * v1 + s1[0] * sa2 + s2[2] * v2 + s1[1] * sa3 + s2[3] * v3;
          f32x4 y;
          y[0] = yr[0] + s3[0] * sa1 + s5[2] * v1;
          y[1] = yr[1] + s3[1] * sa1 + s5[3] * v1 + s3[2] * sa2 + s6[0] * v2;
          y[2] = yr[2] + s3[3] * sa1 + s6[1] * v1 + s4[0] * sa2 + s6[2] * v2 + s4[1] * sa3 + s6[3] * v3;
          y[3] = yr[3] + s4[2] * sa1 + s7[0] * v1 + s4[3] * sa2 + s7[1] * v2 + s5[0] * sa3 + s7[2] * v3 + s5[1] * sa4 + s7[3] * v4;
          u32x4 bu = {cvtpk(sa1, v1), cvtpk(sa2, v2), cvtpk(sa3, v3), cvtpk(sa4, v4)};
          if (q != 0) { bu[0] = 0u; bu[1] = 0u; bu[2] = 0u; bu[3] = 0u; }
          St0 = MFMA16(*(bf16x8*)&cur.k0, *(bf16x8*)&bu, St0);
          St1 = MFMA16(*(bf16x8*)&cur.k1, *(bf16x8*)&bu, St1);
          St2 = MFMA16(*(bf16x8*)&cur.k2, *(bf16x8*)&bu, St2);
          St3 = MFMA16(*(bf16x8*)&cur.k3, *(bf16x8*)&bu, St3);
          *(f32x4*)(yb + blk * 1024) = y;
          cur = nxt;
          if (blk == 7) {
            const char* pw = buf + SC_P + 31 * 256 + wOff;
            St0 *= *(const f32x4*)(pw); St1 *= *(const f32x4*)(pw + 64); St2 *= *(const f32x4*)(pw + 128); St3 *= *(const f32x4*)(pw + 192);
          }
          if (blk == 3 || blk == 7) __syncthreads();
        }
      }
    } else {
      const int pw = wid - 4, ptid = tid - 256;
      const int pstep = ptid >> 3, j0 = (ptid & 7) * 8, pblk = pstep >> 2, psb = pstep & 3;
      const int apos0 = (j0 >> 5) * 32 + (((j0 & 31) & 15) >> 2) * 8 + 4 * ((j0 & 31) >> 4), apos1 = apos0 + 8;
      float* Bg = (float*)(ws + OFF_BONUS) + (size_t)d * NTOK * 16;
      float kkc[8], kac[8], rkc[8];
#pragma unroll
      for (int e = 0; e < 8; ++e) { kkc[e] = p.in[15][h * 64 + j0 + e]; kac[e] = p.in[16][h * 64 + j0 + e]; rkc[e] = p.in[17][h * 64 + j0 + e]; }
      const int mat = pw >> 1, jh = pw & 1;
      bf16x8 w2f[4]; float bias;
      {
        const float* W2 = (mat ? p.in[14] : p.in[11]) + (size_t)d * 64 * 1024;
#pragma unroll
        for (int ks = 0; ks < 4; ++ks) {
          u32x4 w;
#pragma unroll
          for (int qq = 0; qq < 4; ++qq) {
            const int r0 = ks * 16 + 8 * hi + 2 * qq;
            w[qq] = cvtpk(W2[(size_t)r0 * 1024 + h * 64 + jh * 32 + r32], W2[(size_t)(r0 + 1) * 1024 + h * 64 + jh * 32 + r32]);
          }
          w2f[ks] = *(bf16x8*)&w;
        }
        bias = (mat ? p.in[12] : p.in[9])[d * 1024 + h * 64 + jh * 32 + r32];
      }
      u32x4 pR, pK, pV; bf16x8 pl[4];
      float kk[8], kr[8], rr[8];
      float* IC = (float*)(lds + SC_IC);
      bf16_t* SCR = (bf16_t*)(lds + SC_SCR);
      auto prefetch = [&](int c) {
        const size_t row = (size_t)scan_row(c * 32 + pstep, d, b) * 1024 + h * 64 + j0;
        pR = *(const u32x4*)(Rg + row); pK = *(const u32x4*)(Kg + row); pV = *(const u32x4*)(Vg + row);
        const size_t lrow = (size_t)scan_row(c * 32 + r32, d, b);
#pragma unroll
        for (int ks = 0; ks < 4; ++ks) pl[ks] = *(const bf16x8*)(Lg + lrow * 256 + mat * 128 + d * 64 + ks * 16 + hi * 8);
      };
      auto stageA = [&](int c) {
        char* buf = lds + (c & 1) * SC_BUF;
        float* Pd = (float*)(buf + SC_P); float* VV = (float*)(buf + SC_VV);
        f32x16 acc;
#pragma unroll
        for (int r = 0; r < 16; ++r) acc[r] = 0.f;
#pragma unroll
        for (int ks = 0; ks < 4; ++ks) acc = MFMA(pl[ks], w2f[ks], acc);
        if (mat == 0) {
          float cc[16];
#pragma unroll
          for (int r = 0; r < 16; ++r) cc[r] = -0.6065306597126334f * __builtin_amdgcn_rcpf(1.f + __expf(-(acc[r] + bias)));
#pragma unroll
          for (int g = 0; g < 4; ++g) { cc[4 * g + 1] += cc[4 * g]; cc[4 * g + 2] += cc[4 * g + 1]; cc[4 * g + 3] += cc[4 * g + 2]; }
          float run = 0.f;
#pragma unroll
          for (int g = 0; g < 4; ++g) {
            const float own = cc[4 * g + 3];
            auto rr2 = __builtin_amdgcn_permlane32_swap(__float_as_uint(own), __float_as_uint(own), false, false);
            const float both = __uint_as_float(rr2[0]) + __uint_as_float(rr2[1]), partner = both - own;
            const float off = hi ? run + partner : run;
#pragma unroll
            for (int e = 0; e < 4; ++e) Pd[crow(4 * g + e, hi) * 64 + jh * 32 + r32] = __expf(off + cc[4 * g + e]);
            run += both;
          }
        } else {
#pragma unroll
          for (int r = 0; r < 16; ++r) IC[crow(r, hi) * 64 + jh * 32 + r32] = __builtin_amdgcn_rcpf(1.f + __expf(-(acc[r] + bias)));
        }
        float ss = 0.f;
#pragma unroll
        for (int w = 0; w < 4; ++w) {
          rr[2 * w] = lo16(pR[w]); rr[2 * w + 1] = hi16(pR[w]);
          kr[2 * w] = lo16(pK[w]); kr[2 * w + 1] = hi16(pK[w]);
        }
        const float vv[8] = {lo16(pV[0]), hi16(pV[0]), lo16(pV[1]), hi16(pV[1]), lo16(pV[2]), hi16(pV[2]), lo16(pV[3]), hi16(pV[3])};
        if (c + 1 < NCH) prefetch(c + 1);
#pragma unroll
        for (int e = 0; e < 8; ++e) VV[(pblk * 64 + j0 + e) * 4 + psb] = vv[e];
#pragma unroll
        for (int e = 0; e < 8; ++e) { kk[e] = kr[e] * kkc[e]; ss += kk[e] * kk[e]; }
        ss = red8(ss);
        const float inv = rsqrtf(fmaxf(ss, 1e-24f));
#pragma unroll
        for (int e = 0; e < 8; ++e) kk[e] *= inv;
      };
      auto stageB = [&](int c) {
        char* buf = lds + (c & 1) * SC_BUF;
        const f32x4 i0 = *(const f32x4*)(IC + pstep * 64 + j0), i1 = *(const f32x4*)(IC + pstep * 64 + j0 + 4);
        const float ic[8] = {i0[0], i0[1], i0[2], i0[3], i1[0], i1[1], i1[2], i1[3]};
        const float* Pt = (const float*)(buf + SC_P) + pstep * 64 + j0;
        const f32x4 pt0 = *(const f32x4*)(Pt), pt1 = *(const f32x4*)(Pt + 4);
        f32x4 pm0 = {1.f, 1.f, 1.f, 1.f}, pm1 = pm0;
        if (pstep > 0) { pm0 = *(const f32x4*)(Pt - 64); pm1 = *(const f32x4*)(Pt - 60); }
        const float pt[8] = {pt0[0], pt0[1], pt0[2], pt0[3], pt1[0], pt1[1], pt1[2], pt1[3]};
        const float pm[8] = {pm0[0], pm0[1], pm0[2], pm0[3], pm1[0], pm1[1], pm1[2], pm1[3]};
        const u32x4 an = {cvtpk(-kk[0] * pm[0], -kk[1] * pm[1]), cvtpk(-kk[2] * pm[2], -kk[3] * pm[3]), cvtpk(-kk[4] * pm[4], -kk[5] * pm[5]), cvtpk(-kk[6] * pm[6], -kk[7] * pm[7])};
        const u32x4 rn = {cvtpk(rr[0] * pt[0], rr[1] * pt[1]), cvtpk(rr[2] * pt[2], rr[3] * pt[3]), cvtpk(rr[4] * pt[4], rr[5] * pt[5]), cvtpk(rr[6] * pt[6], rr[7] * pt[7])};
        bf16_t* ARa = (bf16_t*)(buf + SC_ARA) + (pblk * 4 + psb) * 64; bf16_t* ARr = (bf16_t*)(buf + SC_ARR) + (pblk * 4 + psb) * 64;
        { u32x2 lo = {an[0], an[1]}, hi2 = {an[2], an[3]}; *(u32x2*)(ARa + apos0) = lo; *(u32x2*)(ARa + apos1) = hi2; }
        { u32x2 lo = {rn[0], rn[1]}, hi2 = {rn[2], rn[3]}; *(u32x2*)(ARr + apos0) = lo; *(u32x2*)(ARr + apos1) = hi2; }
        *(u32x4*)(SCR + (pstep * 4 + 0) * 64 + j0) = an; *(u32x4*)(SCR + (pstep * 4 + 1) * 64 + j0) = rn;
        float bs = 0.f;
        unsigned bq[8], kq[8];
        unsigned* BK = (unsigned*)(buf + SC_BK) + (pblk * 64 + j0) * 4 + psb;
#pragma unroll
        for (int e = 0; e < 8; ++e) {
          const float kd = kr[e] * (1.f + (ic[e] - 1.f) * kac[e]);
          const float ip = __builtin_amdgcn_rcpf(pt[e]);
          const unsigned pr2 = cvtpk(kk[e] * ic[e] * ip, kd * ip);
          BK[e * 4] = pr2;
          bq[e] = pr2 & 0xffffu; kq[e] = pr2 >> 16;
          bs += rr[e] * kd * rkc[e];
        }
        const u32x4 bn = {bq[0] | (bq[1] << 16), bq[2] | (bq[3] << 16), bq[4] | (bq[5] << 16), bq[6] | (bq[7] << 16)};
        const u32x4 kn = {kq[0] | (kq[1] << 16), kq[2] | (kq[3] << 16), kq[4] | (kq[5] << 16), kq[6] | (kq[7] << 16)};
        *(u32x4*)(SCR + (pstep * 4 + 2) * 64 + j0) = bn; *(u32x4*)(SCR + (pstep * 4 + 3) * 64 + j0) = kn;
        bs = red8(bs);
        if ((ptid & 7) == 0) Bg[(size_t)scan_row(c * 32 + pstep, d, b) * 16 + h] = bs;
      };
      auto stageC = [&](int c) {
        char* buf = lds + (c & 1) * SC_BUF;
        asm volatile("s_waitcnt lgkmcnt(0)" ::: "memory");
        const int n16 = lane & 15, q4 = lane >> 4;
        const int stepA = (2 * pw + (n16 >> 3)) * 4 + (n16 & 3);
        const bf16_t* Xr = SCR + (stepA * 4 + 2 + ((n16 >> 2) & 1)) * 64 + q4 * 8;
        const bf16_t* Yc = SCR + (stepA * 4 + ((n16 >> 2) & 1)) * 64 + q4 * 8;
        f32x4 g = {0.f, 0.f, 0.f, 0.f};
        g = MFMA16(*(const bf16x8*)(Xr), *(const bf16x8*)(Yc), g);
        g = MFMA16(*(const bf16x8*)(Xr + 32), *(const bf16x8*)(Yc + 32), g);
        const int ctype = (n16 >> 2) & 1, t0 = n16 & 3, rtype = q4 & 1;
        const int grp = ctype * 2 + rtype, base = grp == 0 ? 0 : (grp == 1 ? 6 : (grp == 2 ? 12 : 22));
        float* sc = (float*)(buf + SC_SCAL) + (2 * pw + (n16 >> 3)) * 32 + base + (ctype ? (t0 + 1) * t0 / 2 : t0 * (t0 - 1) / 2);
        if ((q4 >> 1) == (n16 >> 3)) {
#pragma unroll
          for (int e = 0; e < 4; ++e) if (ctype ? (e <= t0) : (e < t0)) sc[e] = g[e];
        }
      };
      auto writeout = [&](int c) {
        const float* Yb = (const float*)(lds + SC_YB + (c & 1) * 8192) + (pblk * 64 + j0) * 4 + psb;
        u32x4 w = {cvtpk(Yb[0], Yb[4]), cvtpk(Yb[8], Yb[12]), cvtpk(Yb[16], Yb[20]), cvtpk(Yb[24], Yb[28])};
        *(u32x4*)(Yg + (size_t)scan_row(c * 32 + pstep, d, b) * 1024 + h * 64 + j0) = w;
      };
      prefetch(0);
      stageA(0);
      __syncthreads();
      stageB(0); stageC(0);
      __syncthreads();
      for (int c = 0; c < NCH; ++c) {
        if (c >= 1) writeout(c - 1);
        if (c + 1 < NCH) stageA(c + 1);
        __syncthreads();
        if (c + 1 < NCH) { stageB(c + 1); stageC(c + 1); }
        __syncthreads();
      }
      writeout(NCH - 1);
    }
    __syncthreads();
  }
}

__device__ void phase_readout(const Params& p) {
  unsigned char* ws = p.ws;
  const bf16_t* Y0 = (const bf16_t*)(ws + OFF_Y0); const bf16_t* Y1 = (const bf16_t*)(ws + OFF_Y1); const bf16_t* Vg = (const bf16_t*)(ws + OFF_V);
  bf16_t* G = (bf16_t*)(ws + OFF_G);
  const float* B0 = (const float*)(ws + OFF_BONUS); const float* B1 = B0 + (size_t)NTOK * 16;
  const int lane = threadIdx.x & 63, gw = blockIdx.x * 8 + (threadIdx.x >> 6), nw = gridDim.x * 8;
  const int c0 = lane * 16, hd = lane >> 2;
  float lg[16], lb[16];
#pragma unroll
  for (int e = 0; e < 16; ++e) { lg[e] = p.in[18][c0 + e]; lb[e] = p.in[19][c0 + e]; }
  struct RowIn { u32x4 a[2], b[2], v[2], g[2]; float b0, b1; };
  auto ldr = [&](int n, RowIn& r) {
    const size_t o = (size_t)n * 1024 + c0;
#pragma unroll
    for (int q = 0; q < 2; ++q) { r.a[q] = *(const u32x4*)(Y0 + o + 8 * q); r.b[q] = *(const u32x4*)(Y1 + o + 8 * q); r.v[q] = *(const u32x4*)(Vg + o + 8 * q); r.g[q] = *(const u32x4*)(G + o + 8 * q); }
    r.b0 = B0[(size_t)n * 16 + hd]; r.b1 = B1[(size_t)n * 16 + hd];
  };
  RowIn cur, nxt;
  if (gw < NTOK) ldr(gw, cur);
  for (int n = gw; n < NTOK; n += nw) {
    if (n + nw < NTOK) ldr(n + nw, nxt);
    const size_t o = (size_t)n * 1024 + c0;
    float y[16], v[16], g[16];
#pragma unroll
    for (int q = 0; q < 2; ++q) {
#pragma unroll
      for (int w = 0; w < 4; ++w) {
        y[8 * q + 2 * w] = lo16(cur.a[q][w]) + lo16(cur.b[q][w]); y[8 * q + 2 * w + 1] = hi16(cur.a[q][w]) + hi16(cur.b[q][w]);
        v[8 * q + 2 * w] = lo16(cur.v[q][w]); v[8 * q + 2 * w + 1] = hi16(cur.v[q][w]);
        g[8 * q + 2 * w] = lo16(cur.g[q][w]); g[8 * q + 2 * w + 1] = hi16(cur.g[q][w]);
      }
    }
    float s = 0.f;
#pragma unroll
    for (int e = 0; e < 16; ++e) s += y[e];
    s += dpp_f(s, 0); s += dpp_f(s, 1);
    const float mean = s * (1.f / 64.f);
    float q2 = 0.f;
#pragma unroll
    for (int e = 0; e < 16; ++e) { const float dlt = y[e] - mean; q2 += dlt * dlt; }
    q2 += dpp_f(q2, 0); q2 += dpp_f(q2, 1);
    const float rs = rsqrtf(q2 * (1.f / 64.f) + 64e-5f);
    const float bonus = cur.b0 + cur.b1;
    float r[16];
#pragma unroll
    for (int e = 0; e < 16; ++e) {
      const float yn = (y[e] - mean) * rs * lg[e] + lb[e];
      r[e] = (yn + bonus * v[e]) * (g[e] * sigmoidf_(g[e]));
    }
    u32x4 w0 = {cvtpk(r[0], r[1]), cvtpk(r[2], r[3]), cvtpk(r[4], r[5]), cvtpk(r[6], r[7])};
    u32x4 w1 = {cvtpk(r[8], r[9]), cvtpk(r[10], r[11]), cvtpk(r[12], r[13]), cvtpk(r[14], r[15])};
    *(u32x4*)(G + o) = w0; *(u32x4*)(G + o + 8) = w1;
    cur = nxt;
  }
}

constexpr int AT_SHMV = 16384, AT_KROW = 208, AT_SHMK = 64 * AT_KROW;
constexpr int AT_KOFF = 2 * AT_SHMV, AT_WOFF = AT_KOFF + 2 * AT_SHMK;
#define SBAR() __builtin_amdgcn_sched_barrier(0)
__device__ __forceinline__ void at_partialSM(f32x16& p0, f32x16& p1, float& m_reg, float& alpha, bool force) {
  float pm = p0[0];
#pragma unroll
  for (int r = 1; r < 16; ++r) pm = fmaxf(pm, p0[r]);
#pragma unroll
  for (int r = 0; r < 16; ++r) pm = fmaxf(pm, p1[r]);
  { auto rr = __builtin_amdgcn_permlane32_swap(__float_as_uint(pm), __float_as_uint(pm), false, false);
    pm = fmaxf(__uint_as_float(rr[0]), __uint_as_float(rr[1])); }
  if (__builtin_expect(!force && __all(pm <= AT_THR * 1.4426950408889634f), 1)) { alpha = 1.f; }
  else {
    const float dlt = force ? pm : fmaxf(pm, 0.f);
    alpha = force ? 1.f : __builtin_amdgcn_exp2f(-dlt); m_reg += dlt;
#pragma unroll
    for (int r = 0; r < 16; ++r) { p0[r] -= dlt; p1[r] -= dlt; }
  }
#pragma unroll
  for (int r = 0; r < 16; ++r) p0[r] = __builtin_amdgcn_exp2f(p0[r]);
}
__device__ __forceinline__ void at_finishSM(f32x16& p0, f32x16& p1, float alpha, float& l_reg, bf16x8& pa0, bf16x8& pa1, bf16x8& pa2, bf16x8& pa3) {
#pragma unroll
  for (int r = 0; r < 16; ++r) p1[r] = __builtin_amdgcn_exp2f(p1[r]);
  float ps = 0;
#pragma unroll
  for (int r = 0; r < 16; ++r) ps += p0[r];
#pragma unroll
  for (int r = 0; r < 16; ++r) ps += p1[r];
  { auto rr = __builtin_amdgcn_permlane32_swap(__float_as_uint(ps), __float_as_uint(ps), false, false);
    ps = __uint_as_float(rr[0]) + __uint_as_float(rr[1]); }
  l_reg = l_reg * alpha + ps;
#define PK4(P, BASE, OUT) do { unsigned a0 = cvtpk(P[BASE + 0], P[BASE + 1]), a1 = cvtpk(P[BASE + 2], P[BASE + 3]);   \
    unsigned b0 = cvtpk(P[BASE + 4], P[BASE + 5]), b1 = cvtpk(P[BASE + 6], P[BASE + 7]);                              \
    auto r0 = __builtin_amdgcn_permlane32_swap(a0, b0, false, false); auto r1 = __builtin_amdgcn_permlane32_swap(a1, b1, false, false); \
    u32x4 w = {r0[0], r1[0], r0[1], r1[1]}; OUT = *reinterpret_cast<bf16x8*>(&w); } while (0)
  PK4(p0, 0, pa0); PK4(p0, 8, pa1); PK4(p1, 0, pa2); PK4(p1, 8, pa3);
#undef PK4
}
__device__ __forceinline__ void at_qkt(f32x16& p0, f32x16& p1, const char* Ks, const bf16x8* qr, int r32, int hi, float negm) {
#pragma unroll
  for (int r = 0; r < 16; ++r) { p0[r] = negm; p1[r] = negm; }
#pragma unroll
  for (int d0 = 0; d0 < 6; ++d0) {
    const bf16x8 b0 = *(const bf16x8*)(Ks + r32 * AT_KROW + d0 * 32 + hi * 16);
    const bf16x8 b1 = *(const bf16x8*)(Ks + (32 + r32) * AT_KROW + d0 * 32 + hi * 16);
    p0 = MFMA(b0, qr[d0], p0);
    p1 = MFMA(b1, qr[d0], p1);
  }
}
__device__ __forceinline__ int v_st(int k, int c) { const int kk = (k & ~0xC) | ((k & 4) << 1) | ((k & 8) >> 1); return ((kk >> 3) * 4 + (c >> 5)) * 512 + ((kk & 7) * 32 + (c & 31)) * 2; }
__device__ __forceinline__ int v_rd_base(int lane) { return ((lane & 3) << 3) | (((lane >> 2) & 3) << 6) | (((lane >> 4) & 1) << 5) | (((lane >> 5) & 1) << 8); }
constexpr int v_rd_off(int d0, int ks, int half) { return d0 * 512 + ks * 4096 + half * 2048; }
template <int OFF> __device__ __forceinline__ s16x4 tr_read(int vb) {
  s16x4 r; asm volatile("ds_read_b64_tr_b16 %0, %1 offset:%2" : "=&v"(r) : "v"(vb), "i"(OFF) : "memory"); return r;
}
template <int D0> __device__ __forceinline__ void pv_one(f32x16& od, int vb, bf16x8 pa0, bf16x8 pa1, bf16x8 pa2, bf16x8 pa3) {
  const s16x4 l0 = tr_read<v_rd_off(D0, 0, 0)>(vb), h0 = tr_read<v_rd_off(D0, 0, 1)>(vb), l1 = tr_read<v_rd_off(D0, 1, 0)>(vb), h1 = tr_read<v_rd_off(D0, 1, 1)>(vb);
  const s16x4 l2 = tr_read<v_rd_off(D0, 2, 0)>(vb), h2 = tr_read<v_rd_off(D0, 2, 1)>(vb), l3 = tr_read<v_rd_off(D0, 3, 0)>(vb), h3 = tr_read<v_rd_off(D0, 3, 1)>(vb);
  asm volatile("s_waitcnt lgkmcnt(0)" ::: "memory"); SBAR();
#define PK(Lx, Hx) (bf16x8){Lx[0], Lx[1], Lx[2], Lx[3], Hx[0], Hx[1], Hx[2], Hx[3]}
  od = MFMA(pa0, PK(l0, h0), od);
  od = MFMA(pa1, PK(l1, h1), od);
  od = MFMA(pa2, PK(l2, h2), od);
  od = MFMA(pa3, PK(l3, h3), od);
#undef PK
}
__device__ __forceinline__ void pv_d0(f32x16* o, int vb, bf16x8 pa0, bf16x8 pa1, bf16x8 pa2, bf16x8 pa3) {
  pv_one<0>(o[0], vb, pa0, pa1, pa2, pa3); pv_one<1>(o[1], vb, pa0, pa1, pa2, pa3);
}

__device__ void phase_attn(const Params& p, char* lds) {
  unsigned char* ws = p.ws;
  const bf16_t* Qg = (const bf16_t*)(ws + OFF_Q); const bf16_t* KVg = (const bf16_t*)(ws + OFF_KV); const bf16_t* KPg = (const bf16_t*)(ws + OFF_KPE);
  bf16_t* G1 = (bf16_t*)(ws + OFF_G1);
  const f32x2* rope = (const f32x2*)(ws + OFF_ROPE);
  const int tid = threadIdx.x, wid = tid >> 6, lane = tid & 63, r32 = lane & 31, hi = lane >> 5;
  char* V_lds = lds; char* K_lds = lds + AT_KOFF;
  float* wsl = (float*)(lds + AT_WOFF) + wid * 64; float* li_l = wsl; float* al_l = wsl + 32;
  const int skey = tid >> 3, sc8 = (tid & 7) * 8;
  const int pkey = (tid & 255) >> 2, pc8 = (tid & 3) * 8;
  const int vst = v_st(skey, sc8), kst = skey * AT_KROW + sc8 * 2, pst = pkey * AT_KROW + (64 + pc8) * 2;
  const int vb0 = (int)(uintptr_t)V_lds + v_rd_base(lane);
  const int nitems = NB * 16 * 32;
  const int xcd = blockIdx.x & 7, slot = blockIdx.x >> 3, per = gridDim.x >> 3;
  for (int it = slot; it < nitems / 8; it += per) {
    const int pair = (it >> 5) * 8 + xcd, qblk = it & 31;
    const int b = pair >> 4, h = pair & 15;
    const size_t row0 = (size_t)b * TL;
    const size_t qrow = row0 + qblk * 256 + wid * 32 + r32;
    const bf16_t* Kh = KVg + row0 * 2048 + h * 128;
    const bf16_t* Kp = KPg + row0 * 32;
    float m_reg = 0.f, l_reg = 0.f;
    f32x16 o[2];
#pragma unroll
    for (int dd = 0; dd < 2; ++dd)
#pragma unroll
      for (int r = 0; r < 16; ++r) o[dd][r] = 0.f;
    bf16x8 qr[6];
    {
      const bf16_t* Qw = Qg + qrow * 1536 + h * 96 + hi * 8;
#pragma unroll
      for (int d0 = 0; d0 < 6; ++d0) qr[d0] = *(const bf16x8*)(Qw + d0 * 16);
      const int t = qblk * 256 + wid * 32 + r32;
      const f32x2* tb = rope + (hi ? (t & 63) : (t >> 6)) * 8;
      const u32x4 x1 = *(const u32x4*)&qr[4], x2 = *(const u32x4*)&qr[5];
      u32x4 n1, n2;
#pragma unroll
      for (int q = 0; q < 4; ++q) {
        const f32x2 csA = tb[2 * q], csB = tb[2 * q + 1];
        const float a0 = lo16(x1[q]), a1 = hi16(x1[q]), b0 = lo16(x2[q]), b1 = hi16(x2[q]);
        n1[q] = cvtpk(a0 * csA[0] - b0 * csA[1], a1 * csB[0] - b1 * csB[1]);
        n2[q] = cvtpk(a0 * csA[1] + b0 * csA[0], a1 * csB[1] + b1 * csB[0]);
      }
      qr[4] = *(bf16x8*)&n1; qr[5] = *(bf16x8*)&n2;
    }
    struct { bf16x8 vs, ks, ps; } sr_[2];
#define SLOAD(i, k0) do { sr_[i].vs = *(const bf16x8*)(Kh + (size_t)((k0) + skey) * 2048 + 64 + sc8); \
    sr_[i].ks = *(const bf16x8*)(Kh + (size_t)((k0) + skey) * 2048 + sc8); \
    sr_[i].ps = *(const bf16x8*)(Kp + (size_t)((k0) + pkey) * 32 + pc8); } while (0)
#define SWRITE(bb, i) do { *(bf16x8*)(V_lds + (bb) * AT_SHMV + vst) = sr_[i].vs; \
    *(bf16x8*)(K_lds + (bb) * AT_SHMK + kst) = sr_[i].ks; \
    *(bf16x8*)(K_lds + (bb) * AT_SHMK + pst) = sr_[i].ps; } while (0)
#define SWAIT() asm volatile("s_waitcnt vmcnt(3)" ::: "memory")
#define RESC(a) do { if (__any((a) < 1.f)) { if (hi == 0) al_l[r32] = (a); asm volatile("s_waitcnt lgkmcnt(0)" ::: "memory"); \
    _Pragma("unroll") for (int dd = 0; dd < 2; ++dd) _Pragma("unroll") for (int r = 0; r < 16; ++r) o[dd][r] *= al_l[crow(r, hi)]; } } while (0)
    f32x16 pA0, pA1, pB0, pB1; float alA, alB; bf16x8 pa0, pa1, pa2, pa3;
    constexpr int NT = TL / 64;
    SLOAD(0, 0); asm volatile("s_waitcnt vmcnt(0)" ::: "memory"); SWRITE(0, 0); __syncthreads();
    at_qkt(pA0, pA1, K_lds, qr, r32, hi, 0.f); at_partialSM(pA0, pA1, m_reg, alA, true);
    SLOAD(1, 64); SLOAD(0, 128);
    SWAIT(); SWRITE(1, 1); __syncthreads();
    for (int j = 1; j + 1 < NT; j += 2) {
      SBAR(); at_qkt(pB0, pB1, K_lds + AT_SHMK, qr, r32, hi, -m_reg);
      at_finishSM(pA0, pA1, alA, l_reg, pa0, pa1, pa2, pa3); SBAR();
      SLOAD(1, (j + 2) * 64); SBAR();
      pv_d0(o, vb0, pa0, pa1, pa2, pa3); at_partialSM(pB0, pB1, m_reg, alB, false);
      __syncthreads(); SWAIT(); SWRITE(0, 0);
      RESC(alB); __syncthreads();
      SBAR(); at_qkt(pA0, pA1, K_lds, qr, r32, hi, -m_reg);
      at_finishSM(pB0, pB1, alB, l_reg, pa0, pa1, pa2, pa3); SBAR();
      if (j + 3 < NT) SLOAD(0, (j + 3) * 64); SBAR();
      pv_d0(o, vb0 + AT_SHMV, pa0, pa1, pa2, pa3); at_partialSM(pA0, pA1, m_reg, alA, false);
      __syncthreads(); SWAIT(); SWRITE(1, 1);
      RESC(alA); __syncthreads();
    }
    SBAR(); at_qkt(pB0, pB1, K_lds + AT_SHMK, qr, r32, hi, -m_reg);
    at_finishSM(pA0, pA1, alA, l_reg, pa0, pa1, pa2, pa3); SBAR();
    pv_d0(o, vb0, pa0, pa1, pa2, pa3); at_partialSM(pB0, pB1, m_reg, alB, false);
    __syncthreads(); RESC(alB);
    at_finishSM(pB0, pB1, alB, l_reg, pa0, pa1, pa2, pa3); SBAR();
    pv_d0(o, vb0 + AT_SHMV, pa0, pa1, pa2, pa3);
    if (hi == 0) li_l[r32] = l_reg;
    asm volatile("s_waitcnt lgkmcnt(0)" ::: "memory");
    float rli[16];
#pragma unroll
    for (int r = 0; r < 16; ++r) rli[r] = __builtin_amdgcn_rcpf(li_l[crow(r, hi)]);
    bf16_t* Gw = G1 + (row0 + qblk * 256 + wid * 32) * 1024 + h * 64 + r32;
    bf16_t gin[32];
#pragma unroll
    for (int r = 0; r < 16; ++r) { gin[2 * r] = Gw[(size_t)crow(r, hi) * 1024]; gin[2 * r + 1] = Gw[(size_t)crow(r, hi) * 1024 + 32]; }
    asm volatile("" ::: "memory");
#pragma unroll
    for (int r = 0; r < 16; ++r) {
      const int orow = crow(r, hi);
#pragma unroll
      for (int d0 = 0; d0 < 2; ++d0) {
        const float gt = bf2f(gin[2 * r + d0]);
        Gw[(size_t)orow * 1024 + d0 * 32] = f2bf(o[d0][r] * rli[r] * gt * sigmoidf_(gt));
      }
    }
    __syncthreads();
#undef SLOAD
#undef SWRITE
#undef SWAIT
#undef RESC
  }
}

struct XcdWalk {
  int start, count, step, idx;
  __device__ __forceinline__ void init(int ntiles) {
    const int x = blockIdx.x & 7, base = ntiles >> 3, rem = ntiles & 7;
    count = base + (x < rem ? 1 : 0); start = x * base + (x < rem ? x : rem); step = gridDim.x >> 3; idx = blockIdx.x >> 3;
  }
  __device__ __forceinline__ bool next(int& o) { if (idx >= count) return false; o = start + idx; idx += step; return true; }
};
__device__ __forceinline__ void tile_mn(int o, int NT, int& mt, int& nt) { const int g = o >> 3; mt = (g / NT) * 8 + (o & 7); nt = g % NT; }

__global__ __launch_bounds__(NTHR, 1) void fwd_megakernel(Params p) {
  extern __shared__ __attribute__((aligned(16))) char lds[];
  cg::grid_group grid = cg::this_grid();
  unsigned char* ws = p.ws;
  bf16_t* H = (bf16_t*)(ws + OFF_H);
  float* mod = (float*)(ws + OFF_MOD);
  float* CTX1 = (float*)(ws + OFF_CTX1);

  phase_prologue(p, lds);
  grid.sync();
  phase_norm_lerp(p, mod);
  phase_weights(p, lds);
  grid.sync();
  {
    const bf16_t* WIN0 = (const bf16_t*)(ws + OFF_WIN0);
    const int nbig = 264 * 16;
    XcdWalk wk; wk.init(nbig); int o;
    while (wk.next(o)) {
      EpiBf16 e; e.invK = 0.f;
      {
        int mt, jn; tile_mn(o, 16, mt, jn);
        const int j = jn >> 2, n4 = jn & 3, m0 = mt * 256;
        e.dst = (bf16_t*)(ws + OFF_R + (size_t)j * U); e.ldd = 1024; e.col0 = n4 * 256; e.act = 0; e.m0 = m0;
        gemm_tile<0, 256>(lerp_base(p, j, m0), 1024, WIN0 + (size_t)(j * 1024 + n4 * 256) * 1024, 1024, m0, nullptr, lds, e);
      }
    }
    wk.init(264 * 2);
    while (wk.next(o)) {
      EpiBf16 e; e.invK = 0.f;
      {
        int mt, n2; tile_mn(o, 2, mt, n2);
        const int nt = 32 + n2, m0 = mt * 256;
        e.dst = (bf16_t*)(ws + OFF_LORA); e.ldd = 256; e.col0 = (nt - 32) * 128; e.act = (nt == 32) ? 1 : 0; e.m0 = m0;
        gemm_tile<1, 128>(H, 1024, WIN0 + (size_t)nt * 128 * 1024, 1024, m0, p.in[7] + (nt - 28) * 1024, lds, e);
      }
    }
  }
  grid.sync();
  phase_scan(p, lds);
  grid.sync();
  phase_readout(p);
  grid.sync();
  {
    const bf16_t* A = (const bf16_t*)(ws + OFF_G); const bf16_t* W = (const bf16_t*)(ws + OFF_WOUT0);
    XcdWalk wk; wk.init(264 * 4); int o;
    while (wk.next(o)) {
      int mt, nt; tile_mn(o, 4, mt, nt);
      const int m0 = mt * 256;
      const int b = m0 / TL, t0 = m0 - b * TL;
      EpiResid e;
      if (t0 < T) { const size_t orow = (size_t)b * T + t0; e.xin = p.in[0] + orow * 1024; e.xout = p.out + orow * 1024; e.gvec = mod + (size_t)b * 3072 + 2048; }
      else { const size_t orow = (size_t)b * L + (t0 - T); e.xin = p.in[2] + orow * 1024; e.xout = CTX1 + orow * 1024; e.gvec = mod + (size_t)8 * 3072 + 2048; }
      e.n0 = nt * 256;
      gemm_tile<0, 256>(A, 1024, W + (size_t)nt * 256 * 1024, 1024, m0, nullptr, lds, e);
    }
  }
  grid.sync();
  phase_norm(p.out, CTX1, p.in[4] + 1024, mod + 9 * 3072, H);
  grid.sync();
  {
    const bf16_t* W = (const bf16_t*)(ws + OFF_WIN1);
    XcdWalk wk; wk.init(264 * 7); int o;
    while (wk.next(o)) {
      int mt, nt; tile_mn(o, 7, mt, nt);
      const int m0 = mt * 256;
      EpiMlaIn e; e.QC = (bf16_t*)(ws + OFF_QC); e.KVC = (bf16_t*)(ws + OFF_KVC); e.KPE = (bf16_t*)(ws + OFF_KPE); e.G1 = (bf16_t*)(ws + OFF_G1);
      e.rope = (const float*)(ws + OFF_ROPE); e.n0 = nt * 256; e.m0 = m0;
      gemm_tile<0, 256>(H, 1024, W + (size_t)nt * 256 * 1024, 1024, m0, nullptr, lds, e);
    }
  }
  grid.sync();
  {
    const bf16_t* WQ = (const bf16_t*)(ws + OFF_WQB); const bf16_t* WKV = (const bf16_t*)(ws + OFF_WKVB);
    const int nq = 256 * 6, nkv = 264 * 8;
    XcdWalk wk; wk.init(nq); int o;
    while (wk.next(o)) {
      EpiBf16 e; e.act = 0;
      {
        int mt2, nt; tile_mn(o, 6, mt2, nt);
        const int b = mt2 >> 5, m0 = b * TL + (mt2 & 31) * 256;
        e.dst = (bf16_t*)(ws + OFF_Q); e.ldd = 1536; e.col0 = nt * 256; e.m0 = m0; e.invK = 1.f / 384.f;
        gemm_tile<2, 256>((const bf16_t*)(ws + OFF_QC), 384, WQ + (size_t)nt * 256 * 384, 384, m0, nullptr, lds, e);
      }
    }
    wk.init(nkv);
    while (wk.next(o)) {
      EpiBf16 e; e.act = 0;
      {
        int mt, nt; tile_mn(o, 8, mt, nt);
        const int m0 = mt * 256;
        e.dst = (bf16_t*)(ws + OFF_KV); e.ldd = 2048; e.col0 = nt * 256; e.m0 = m0; e.invK = 1.f / 256.f;
        gemm_tile<2, 256>((const bf16_t*)(ws + OFF_KVC), 256, WKV + (size_t)nt * 256 * 256, 256, m0, nullptr, lds, e);
      }
    }
  }
  grid.sync();
  phase_attn(p, lds);
  grid.sync();
  {
    const bf16_t* A = (const bf16_t*)(ws + OFF_G1); const bf16_t* W = (const bf16_t*)(ws + OFF_WOUT1);
    XcdWalk wk; wk.init(256 * 4); int o;
    while (wk.next(o)) {
      int mt2, nt; tile_mn(o, 4, mt2, nt);
      const int b = mt2 >> 5, t0 = (mt2 & 31) * 256, m0 = b * TL + t0;
      const size_t orow = (size_t)b * T + t0;
      EpiResid e; e.xin = p.out + orow * 1024; e.xout = p.out + orow * 1024; e.gvec = mod + (size_t)(9 + b) * 3072 + 2048; e.n0 = nt * 256;
      gemm_tile<0, 256>(A, 1024, W + (size_t)nt * 256 * 1024, 1024, m0, nullptr, lds, e);
    }
  }
  grid.sync();
  phase_final(p.out, p.in[27]);
}

extern "C" void kernel_launch(void* const* d_in, const int* in_sizes, int n_in, void* d_out, int out_size, void* d_ws, size_t ws_size, hipStream_t stream) {
  static int grid_blocks = 0;
  if (grid_blocks == 0) {
    if (n_in != 28 || ws_size < WS_END + (size_t)(NTOK - LERP3_SPLIT) * 2048 || out_size != NB * T * D) { fprintf(stderr, "kernel_launch: unexpected shapes (n_in %d, ws %zu need %zu, out %d)\n", n_in, ws_size, (size_t)WS_END, out_size); grid_blocks = -1; return; }
    int dev = 0, cus = 0, per_cu = 0;
    hipGetDevice(&dev);
    hipDeviceGetAttribute(&cus, hipDeviceAttributeMultiprocessorCount, dev);
    if (hipFuncSetAttribute((const void*)fwd_megakernel, hipFuncAttributeMaxDynamicSharedMemorySize, LDS_BYTES) != hipSuccess) { fprintf(stderr, "kernel_launch: hipFuncSetAttribute failed\n"); grid_blocks = -1; return; }
    hipOccupancyMaxActiveBlocksPerMultiprocessor(&per_cu, (const void*)fwd_megakernel, NTHR, LDS_BYTES);
    if (per_cu < 1) { fprintf(stderr, "kernel_launch: occupancy query says %d blocks per CU\n", per_cu); per_cu = 1; }
    (void)hipGetLastError();
    grid_blocks = cus;
    if (grid_blocks > 256) grid_blocks = 256;
    grid_blocks &= ~7;
  }
  if (grid_blocks <= 0) return;
  Params p{};
  for (int i = 0; i < 28; ++i) p.in[i] = (const float*)d_in[i];
  p.out = (float*)d_out; p.ws = (unsigned char*)d_ws;
  void* args[] = {&p};
  hipError_t e = hipLaunchCooperativeKernel((const void*)fwd_megakernel, dim3(grid_blocks), dim3(NTHR), args, LDS_BYTES, stream);
  if (e != hipSuccess) fprintf(stderr, "cooperative launch failed: %s (grid %d)\n", hipGetErrorString(e), grid_blocks);
}
```

```cpp
#include <hip/hip_runtime.h>
#include <hip/hip_cooperative_groups.h>
#include <cstdio>
#include <cstdint>
namespace cg = cooperative_groups;

typedef unsigned short bf16_t;
typedef short bf16x8 __attribute__((ext_vector_type(8)));
typedef short s16x4 __attribute__((ext_vector_type(4)));
typedef float f32x16 __attribute__((ext_vector_type(16)));
typedef float f32x4 __attribute__((ext_vector_type(4)));
typedef float f32x2 __attribute__((ext_vector_type(2)));
typedef unsigned u32x4 __attribute__((ext_vector_type(4)));
typedef unsigned u32x2 __attribute__((ext_vector_type(2)));

constexpr int D = 1024, NB = 8, T = 8192, L = 256, TL = T + L, NTOK = NB * TL;
constexpr int NTHR = 512;

constexpr size_t U = (size_t)NTOK * 1024 * 2;
constexpr size_t OFF_H = 0, OFF_R = U, OFF_K = 2 * U, OFF_V = 3 * U, OFF_G = 4 * U, OFF_Y0 = 5 * U, OFF_Y1 = 6 * U;
constexpr size_t OFF_LORA = 7 * U;
constexpr size_t OFF_BONUS = OFF_LORA + (size_t)NTOK * 256 * 2;
constexpr size_t OFF_WIN0 = OFF_BONUS + (size_t)2 * NTOK * 16 * 4;
constexpr size_t OFF_WOUT0 = OFF_WIN0 + (size_t)4352 * 1024 * 2;
constexpr size_t OFF_WIN1 = OFF_WOUT0 + (size_t)1024 * 1024 * 2;
constexpr size_t OFF_WQB = OFF_WIN1 + (size_t)1792 * 1024 * 2;
constexpr size_t OFF_WKVB = OFF_WQB + (size_t)1536 * 384 * 2;
constexpr size_t OFF_WOUT1 = OFF_WKVB + (size_t)2048 * 256 * 2;
constexpr size_t OFF_MOD = OFF_WOUT1 + (size_t)1024 * 1024 * 2;
constexpr size_t OFF_ROPE = OFF_MOD + (size_t)2 * 9 * 3072 * 4;
constexpr size_t OFF_CTX1 = OFF_ROPE + (size_t)128 * 8 * 2 * 4;
constexpr size_t WS_END = OFF_CTX1 + (size_t)2048 * 1024 * 4;
constexpr size_t OFF_QC = OFF_V;
constexpr size_t OFF_KVC = OFF_QC + (size_t)NTOK * 384 * 2;
constexpr size_t OFF_KPE = OFF_KVC + (size_t)NTOK * 256 * 2;
constexpr size_t OFF_G1 = OFF_G;
constexpr size_t OFF_Q = OFF_R;
constexpr size_t OFF_KV = OFF_Y0;

struct Params { const float* in[28]; float* out; unsigned char* ws; };

typedef __bf16 bf16x2_t __attribute__((ext_vector_type(2)));
__device__ __forceinline__ unsigned cvtpk(float lo, float hi) { f32x2 v = {lo, hi}; bf16x2_t b = __builtin_convertvector(v, bf16x2_t); return *(unsigned*)&b; }
__device__ __forceinline__ float bf2f(bf16_t u) { return __uint_as_float(((unsigned)u) << 16); }
__device__ __forceinline__ bf16_t f2bf(float f) { return (bf16_t)(cvtpk(f, 0.f) & 0xffffu); }
__device__ __forceinline__ float lo16(unsigned w) { return __uint_as_float(w << 16); }
__device__ __forceinline__ float hi16(unsigned w) { return __uint_as_float(w & 0xffff0000u); }
__device__ __forceinline__ void st_bf16x4(bf16_t* p, float a, float b, float c, float d) { u32x2 w = {cvtpk(a, b), cvtpk(c, d)}; *(u32x2*)p = w; }
__device__ __forceinline__ void st_bf16x4_nt(bf16_t* p, float a, float b, float c, float d) { u32x2 w = {cvtpk(a, b), cvtpk(c, d)}; __builtin_nontemporal_store(w, (u32x2*)p); }
__device__ __forceinline__ float wave_sum(float v) {
#pragma unroll
  for (int o = 32; o; o >>= 1) v += __shfl_xor(v, o);
  return v;
}
__device__ __forceinline__ float dpp_f(float v, const int ctrl_sel) {
  int r;
  if (ctrl_sel == 0) r = __builtin_amdgcn_update_dpp(0, __float_as_int(v), 0xB1, 0xF, 0xF, true);
  else if (ctrl_sel == 1) r = __builtin_amdgcn_update_dpp(0, __float_as_int(v), 0x4E, 0xF, 0xF, true);
  else r = __builtin_amdgcn_update_dpp(0, __float_as_int(v), 0x141, 0xF, 0xF, true);
  return __int_as_float(r);
}
__device__ __forceinline__ float red8(float v) { v += dpp_f(v, 0); v += dpp_f(v, 1); v += dpp_f(v, 2); return v; }
__device__ __forceinline__ int crow(int r, int hi) { return (r & 3) + 8 * (r >> 2) + 4 * hi; }
__device__ __forceinline__ float sigmoidf_(float x) { return 1.f / (1.f + __expf(-x)); }
#define MFMA(a, b, c) __builtin_amdgcn_mfma_f32_32x32x16_bf16((a), (b), (c), 0, 0, 0)

constexpr int G_LDT = 144;
constexpr int G_SSQ_OFF = 2 * (256 + 256) * G_LDT;
constexpr int LDS_BYTES = G_SSQ_OFF + 1024;

template <int AMODE, int BN, class Epi>
__device__ __forceinline__ void gemm_tile(const bf16_t* A, const int lda, const bf16_t* Bt, const int K, const int m0, const float* mu, char* lds, const Epi& epi) {
  constexpr int WN = BN / 64, MI = WN, NBR = BN / 64, G_STAGE = (256 + BN) * G_LDT;
  const int tid = threadIdx.x, lane = tid & 63, wid = tid >> 6, r32 = lane & 31, hi = lane >> 5;
  const int wm = wid / WN, wn = wid % WN;
  const int srow = tid >> 3, scc = (tid & 7) * 8;
  int browi[NBR];
#pragma unroll
  for (int i = 0; i < NBR; ++i) browi[i] = 64 * i + ((Epi::PERM && !epi.natural_group(64 * i + srow)) ? ((srow & 32) + 16 * ((srow >> 2) & 1) + 4 * ((srow & 31) >> 3) + (srow & 3)) : srow);
  f32x16 acc[MI][2];
#pragma unroll
  for (int i = 0; i < MI; ++i)
#pragma unroll
    for (int j = 0; j < 2; ++j)
#pragma unroll
      for (int r = 0; r < 16; ++r) acc[i][j][r] = 0.f;
  bf16x8 ra[4], rb[NBR], rp[4], rn[4];
  float ssq[4] = {0.f, 0.f, 0.f, 0.f};
  int dprev[4], dnext[4];
  if constexpr (AMODE == 1) {
    const int t0 = m0 % TL;
#pragma unroll
    for (int i = 0; i < 4; ++i) { const int t = t0 + srow + 64 * i; dprev[i] = (t != 0 && t != T) ? 1 : 0; dnext[i] = (t != T - 1 && t != TL - 1) ? 1 : 0; }
  }
  auto gload = [&](int k0) {
#pragma unroll
    for (int i = 0; i < 4; ++i) {
      const bf16_t* ap = A + (size_t)(m0 + srow + 64 * i) * lda + k0 + scc;
      ra[i] = *(const bf16x8*)ap;
      if constexpr (AMODE == 1) { rp[i] = *(const bf16x8*)(ap - dprev[i] * lda); rn[i] = *(const bf16x8*)(ap + dnext[i] * lda); }
    }
#pragma unroll
    for (int i = 0; i < NBR; ++i) rb[i] = *(const bf16x8*)(Bt + (size_t)browi[i] * K + k0 + scc);
  };
  auto lstore = [&](int s, int k0) {
    char* base = lds + s * G_STAGE;
    if constexpr (AMODE == 1) {
      const f32x4 m0v = *(const f32x4*)(mu + k0 + scc), m1v = *(const f32x4*)(mu + k0 + scc + 4);
      const float mm[8] = {m0v[0], m0v[1], m0v[2], m0v[3], m1v[0], m1v[1], m1v[2], m1v[3]};
#pragma unroll
      for (int i = 0; i < 4; ++i) {
        const u32x4 hc = *(const u32x4*)&ra[i], hp = *(const u32x4*)&rp[i], hn = *(const u32x4*)&rn[i];
        const float fp = dprev[i] ? 0.5f : 0.f, fn = dnext[i] ? 0.5f : 0.f;
        u32x4 w;
#pragma unroll
        for (int q = 0; q < 4; ++q) {
          const float c0 = lo16(hc[q]), c1 = hi16(hc[q]);
          const float x0 = fp * lo16(hp[q]) + fn * lo16(hn[q]) - c0, x1 = fp * hi16(hp[q]) + fn * hi16(hn[q]) - c1;
          w[q] = cvtpk(c0 + x0 * mm[2 * q], c1 + x1 * mm[2 * q + 1]);
        }
        *(u32x4*)(base + (srow + 64 * i) * G_LDT + scc * 2) = w;
      }
    } else {
#pragma unroll
      for (int i = 0; i < 4; ++i) {
        *(bf16x8*)(base + (srow + 64 * i) * G_LDT + scc * 2) = ra[i];
        if constexpr (AMODE == 2) {
          const u32x4 hc = *(const u32x4*)&ra[i];
#pragma unroll
          for (int q = 0; q < 4; ++q) { const float c0 = lo16(hc[q]), c1 = hi16(hc[q]); ssq[i] += c0 * c0 + c1 * c1; }
        }
      }
    }
#pragma unroll
    for (int i = 0; i < NBR; ++i) *(bf16x8*)(base + 256 * G_LDT + (srow + 64 * i) * G_LDT + scc * 2) = rb[i];
  };
  const int nk = K >> 6;
  gload(0);
  lstore(0, 0);
  if (nk > 1) gload(64);
  __syncthreads();
#pragma unroll 1
  for (int kt = 0; kt < nk; ++kt) {
    const int s = kt & 1;
    if (kt + 1 < nk) lstore(s ^ 1, (kt + 1) * 64);
    if (kt + 2 < nk) gload((kt + 2) * 64);
    {
      const char* Ab = lds + s * G_STAGE + (wm * (32 * MI) + r32) * G_LDT + hi * 16;
      const char* Bb = lds + s * G_STAGE + 256 * G_LDT + (wn * 64 + r32) * G_LDT + hi * 16;
      bf16x8 fb[2][2], fa[2][MI];
      fb[0][0] = *(const bf16x8*)(Bb); fb[0][1] = *(const bf16x8*)(Bb + 32 * G_LDT);
#pragma unroll
      for (int mi = 0; mi < MI; ++mi) fa[0][mi] = *(const bf16x8*)(Ab + mi * 32 * G_LDT);
#pragma unroll
      for (int ks = 0; ks < 4; ++ks) {
        const int sl = ks & 1;
        if (ks + 1 < 4) {
          fb[sl ^ 1][0] = *(const bf16x8*)(Bb + (ks + 1) * 32); fb[sl ^ 1][1] = *(const bf16x8*)(Bb + 32 * G_LDT + (ks + 1) * 32);
#pragma unroll
          for (int mi = 0; mi < MI; ++mi) fa[sl ^ 1][mi] = *(const bf16x8*)(Ab + mi * 32 * G_LDT + (ks + 1) * 32);
        }
#pragma unroll
        for (int mi = 0; mi < MI; ++mi) { acc[mi][0] = MFMA(fb[sl][0], fa[sl][mi], acc[mi][0]); acc[mi][1] = MFMA(fb[sl][1], fa[sl][mi], acc[mi][1]); }
      }
    }
    __syncthreads();
  }
  float* ssq_l = (float*)(lds + G_SSQ_OFF);
  if constexpr (AMODE == 2) {
#pragma unroll
    for (int i = 0; i < 4; ++i) { const float v = red8(ssq[i]); if ((tid & 7) == 0) ssq_l[srow + 64 * i] = v; }
    __syncthreads();
  }
#pragma unroll
  for (int mi = 0; mi < MI; ++mi) {
    const int lrow = wm * (32 * MI) + mi * 32 + r32;
    float aux = 0.f;
    if constexpr (AMODE == 2) aux = ssq_l[lrow];
    epi(lrow, wn * 64 + 4 * hi, acc[mi][0], acc[mi][1], aux);
  }
}

struct EpiBf16 {
  static constexpr bool PERM = true;
  __device__ __forceinline__ bool natural_group(int) const { return false; }
  bf16_t* dst; int ldd; int col0; int m0; int act; float invK;
  __device__ __forceinline__ void operator()(int lrow, int nc, const f32x16& a0, const f32x16& a1, float aux) const { one(lrow, nc, a0, aux); one(lrow, nc + 32, a1, aux); }
  __device__ __forceinline__ void one(int lrow, int nc, const f32x16& a, float aux) const {
    float sc = 1.f;
    if (invK > 0.f) sc = rsqrtf(aux * invK + 1e-6f);
    bf16_t* p = dst + (size_t)(m0 + lrow) * ldd + col0 + (nc & ~7) + 4 * (nc & 4);
    if (act) {
#define TANH_(x) (1.f - 2.f / (__expf(2.f * (x) * sc) + 1.f))
      const u32x4 w0 = {cvtpk(TANH_(a[0]), TANH_(a[1])), cvtpk(TANH_(a[2]), TANH_(a[3])), cvtpk(TANH_(a[4]), TANH_(a[5])), cvtpk(TANH_(a[6]), TANH_(a[7]))};
      const u32x4 w1 = {cvtpk(TANH_(a[8]), TANH_(a[9])), cvtpk(TANH_(a[10]), TANH_(a[11])), cvtpk(TANH_(a[12]), TANH_(a[13])), cvtpk(TANH_(a[14]), TANH_(a[15]))};
#undef TANH_
      *(u32x4*)p = w0; *(u32x4*)(p + 8) = w1;
    } else {
      const u32x4 w0 = {cvtpk(a[0] * sc, a[1] * sc), cvtpk(a[2] * sc, a[3] * sc), cvtpk(a[4] * sc, a[5] * sc), cvtpk(a[6] * sc, a[7] * sc)};
      const u32x4 w1 = {cvtpk(a[8] * sc, a[9] * sc), cvtpk(a[10] * sc, a[11] * sc), cvtpk(a[12] * sc, a[13] * sc), cvtpk(a[14] * sc, a[15] * sc)};
      *(u32x4*)p = w0; *(u32x4*)(p + 8) = w1;
    }
  }
};
struct EpiResid {
  static constexpr bool PERM = false;
  __device__ __forceinline__ bool natural_group(int) const { return true; }
  const float* xin; float* xout; const float* gvec; int n0;
  __device__ __forceinline__ void operator()(int lrow, int nc, const f32x16& a0, const f32x16& a1, float) const {
    const size_t o = (size_t)lrow * 1024 + n0 + nc;
    f32x4 xv[8], gv[8];
#pragma unroll
    for (int g = 0; g < 4; ++g) {
      xv[g] = *(const f32x4*)(xin + o + 8 * g); xv[4 + g] = *(const f32x4*)(xin + o + 32 + 8 * g);
      gv[g] = *(const f32x4*)(gvec + n0 + nc + 8 * g); gv[4 + g] = *(const f32x4*)(gvec + n0 + nc + 32 + 8 * g);
    }
    f32x4 r[8];
#pragma unroll
    for (int g = 0; g < 4; ++g)
#pragma unroll
      for (int e = 0; e < 4; ++e) { r[g][e] = xv[g][e] + gv[g][e] * a0[4 * g + e]; r[4 + g][e] = xv[4 + g][e] + gv[4 + g][e] * a1[4 * g + e]; }
    asm volatile("" ::: "memory");
#pragma unroll
    for (int g = 0; g < 4; ++g) { *(f32x4*)(xout + o + 8 * g) = r[g]; *(f32x4*)(xout + o + 32 + 8 * g) = r[4 + g]; }
  }
};
struct EpiMlaIn {
  static constexpr bool PERM = true;
  bf16_t *QC, *KVC, *KPE, *G1; const float* rope; int n0; int m0;
  __device__ __forceinline__ bool natural_group(int tile_row) const { return ((n0 + tile_row) >> 5) == 20; }
  __device__ __forceinline__ void operator()(int lrow, int nc, const f32x16& a0, const f32x16& a1, float) const { one(lrow, nc, a0); one(lrow, nc + 32, a1); }
  __device__ __forceinline__ void one(int lrow, int nc, const f32x16& a) const {
    const int row = m0 + lrow, g32 = n0 + (nc & ~7);
    if (g32 == 640) {
      const int t = (m0 % TL) + lrow, hi4 = nc & 4;
      bf16_t* p = KPE + (size_t)row * 32;
      if (t < T) {
        const f32x2* tr = (const f32x2*)rope + (t >> 6) * 8 + hi4;
        const f32x2* tc = (const f32x2*)rope + (t & 63) * 8 + hi4;
        float o1[8], o2[8];
#pragma unroll
        for (int e = 0; e < 4; ++e) {
          const f32x2 cs0 = tr[e], cs1 = tc[e];
          const float x1a = a[e], x2a = a[8 + e];
          const float x1b = a[4 + e], x2b = a[12 + e];
          o1[e] = x1a * cs0[0] - x2a * cs0[1]; o2[e] = x1a * cs0[1] + x2a * cs0[0];
          o1[4 + e] = x1b * cs1[0] - x2b * cs1[1]; o2[4 + e] = x1b * cs1[1] + x2b * cs1[0];
        }
        st_bf16x4(p + hi4, o1[0], o1[1], o1[2], o1[3]);
        st_bf16x4(p + 8 + hi4, o1[4], o1[5], o1[6], o1[7]);
        st_bf16x4(p + 16 + hi4, o2[0], o2[1], o2[2], o2[3]);
        st_bf16x4(p + 24 + hi4, o2[4], o2[5], o2[6], o2[7]);
      } else {
#pragma unroll
        for (int g = 0; g < 4; ++g) st_bf16x4(p + 8 * g + hi4, a[4 * g], a[4 * g + 1], a[4 * g + 2], a[4 * g + 3]);
      }
      return;
    }
    if (g32 > 640 && g32 < 768) return;
    const int gc = g32 + 4 * (nc & 4);
    bf16_t* p;
    if (gc < 384) p = QC + (size_t)row * 384 + gc;
    else if (gc < 640) p = KVC + (size_t)row * 256 + (gc - 384);
    else p = G1 + (size_t)row * 1024 + (gc - 768);
    const u32x4 w0 = {cvtpk(a[0], a[1]), cvtpk(a[2], a[3]), cvtpk(a[4], a[5]), cvtpk(a[6], a[7])};
    const u32x4 w1 = {cvtpk(a[8], a[9]), cvtpk(a[10], a[11]), cvtpk(a[12], a[13]), cvtpk(a[14], a[15])};
    *(u32x4*)p = w0; *(u32x4*)(p + 8) = w1;
  }
};

constexpr float AT_SCALE = 0.10206207261596575f;
constexpr float AT_THR = 8.f;
__device__ void tr_job(const float* src, int ld, int K, int N, bf16_t* dst, const float* kscale, char* lds, float gscale = 1.f) {
  float* tile = (float*)lds;
  const int tid = threadIdx.x, nK = K >> 6, nN = (N + 63) >> 6;
  for (int tIdx = blockIdx.x; tIdx < nK * nN; tIdx += gridDim.x) {
    const int k0 = (tIdx % nK) * 64, n0 = (tIdx / nK) * 64;
#pragma unroll
    for (int i = 0; i < 8; ++i) {
      const int kk = (tid >> 6) + 8 * i, nn = tid & 63;
      float v = 0.f;
      if (n0 + nn < N) { v = src[(size_t)(k0 + kk) * ld + n0 + nn] * gscale; if (kscale) v *= kscale[k0 + kk]; }
      tile[kk * 65 + nn] = v;
    }
    __syncthreads();
#pragma unroll
    for (int i = 0; i < 8; ++i) {
      const int nn = (tid >> 6) + 8 * i, kk = tid & 63;
      if (n0 + nn < N) dst[(size_t)(n0 + nn) * K + k0 + kk] = f2bf(tile[kk * 65 + nn]);
    }
    __syncthreads();
  }
}

__device__ void phase_weights(const Params& p, char* lds) {
  unsigned char* ws = p.ws;
  bf16_t* WIN0 = (bf16_t*)(ws + OFF_WIN0);
  for (int j = 0; j < 4; ++j) tr_job(p.in[8] + (size_t)j * 1024 * 1024, 1024, 1024, 1024, WIN0 + (size_t)j * 1024 * 1024, nullptr, lds);
  for (int d = 0; d < 2; ++d) {
    tr_job(p.in[10] + (size_t)d * 1024 * 64, 64, 1024, 64, WIN0 + (size_t)(4096 + d * 64) * 1024, nullptr, lds);
    tr_job(p.in[13] + (size_t)d * 1024 * 64, 64, 1024, 64, WIN0 + (size_t)(4224 + d * 64) * 1024, nullptr, lds);
  }
  tr_job(p.in[20], 1024, 1024, 1024, (bf16_t*)(ws + OFF_WOUT0), nullptr, lds);
  bf16_t* WIN1 = (bf16_t*)(ws + OFF_WIN1);
  tr_job(p.in[21], 1696, 1024, 640, WIN1, nullptr, lds);
  tr_job(p.in[21] + 640, 1696, 1024, 32, WIN1 + (size_t)640 * 1024, nullptr, lds);
  tr_job(p.in[21] + 672, 1696, 1024, 1024, WIN1 + (size_t)768 * 1024, nullptr, lds);
  for (int i = blockIdx.x * NTHR + threadIdx.x; i < 96 * 1024; i += gridDim.x * NTHR) WIN1[(size_t)672 * 1024 + i] = 0;
  tr_job(p.in[23], 1536, 384, 1536, (bf16_t*)(ws + OFF_WQB), p.in[22], lds, AT_SCALE * 1.4426950408889634f);
  tr_job(p.in[25], 2048, 256, 2048, (bf16_t*)(ws + OFF_WKVB), p.in[24], lds);
  tr_job(p.in[26], 1024, 1024, 1024, (bf16_t*)(ws + OFF_WOUT1), nullptr, lds);
}
__device__ void phase_prologue(const Params& p, char* lds) {
  unsigned char* ws = p.ws;
  {
    const int i = blockIdx.x * NTHR + threadIdx.x;
    if (i < 1024) {
      const float invf[8] = {1.f, 0.316227766016838f, 0.1f, 0.0316227766016838f, 0.01f, 0.00316227766016838f, 0.001f, 0.000316227766016838f};
      const int pos = i >> 3, m = i & 7;
      float inv = invf[0];
#pragma unroll
      for (int q = 1; q < 8; ++q) inv = (m == q) ? invf[q] : inv;
      const float ang = (float)pos * inv;
      const float kf = rintf(ang * 0.15915494309189535f);
      float r = fmaf(-kf, 6.28125f, ang);
      r = fmaf(-kf, 1.9353071795864769e-3f, r);
      float* rt = (float*)(ws + OFF_ROPE);
      rt[2 * i] = cosf(r); rt[2 * i + 1] = sinf(r);
    }
  }
  {
    float* sil = (float*)lds;
    float* red = sil + 9 * 1024;
    const int tid = threadIdx.x;
    for (int i = tid; i < 9 * 1024; i += NTHR) {
      const int bi = i >> 10, k = i & 1023;
      const float cv = bi < 8 ? p.in[1][bi * 1024 + k] : p.in[3][k];
      sil[i] = cv / (1.f + __expf(-cv));
    }
    __syncthreads();
    float* mod = (float*)(ws + OFF_MOD);
    for (int item = blockIdx.x; item < 192; item += gridDim.x) {
      const int l = item / 96, n0 = (item % 96) * 32, col = tid & 31, kg = tid >> 5;
      float acc[9];
#pragma unroll
      for (int bi = 0; bi < 9; ++bi) acc[bi] = 0.f;
      const float* wp = p.in[5] + ((size_t)l * 1024 + kg * 64) * 3072 + n0 + col;
      for (int kk = 0; kk < 64; ++kk) {
        const float w = wp[(size_t)kk * 3072];
#pragma unroll
        for (int bi = 0; bi < 9; ++bi) acc[bi] += sil[bi * 1024 + kg * 64 + kk] * w;
      }
#pragma unroll
      for (int bi = 0; bi < 9; ++bi) red[(kg * 9 + bi) * 32 + col] = acc[bi];
      __syncthreads();
      if (tid < 288) {
        const int bi = tid >> 5;
        float s = 0.f;
#pragma unroll
        for (int g = 0; g < 16; ++g) s += red[(g * 9 + bi) * 32 + col];
        mod[((size_t)l * 9 + bi) * 3072 + n0 + col] = s + p.in[6][l * 3072 + n0 + col];
      }
      __syncthreads();
    }
  }
}

__device__ __forceinline__ const float* row_src(const float* xsrc, const float* csrc, int n, int& bi) {
  const int b = n / TL, t = n - b * TL;
  if (t < T) { bi = b; return xsrc + ((size_t)b * T + t) * D; }
  bi = 8; return csrc + ((size_t)b * L + (t - T)) * D;
}
__device__ void phase_norm(const float* xsrc, const float* csrc, const float* ng, const float* mod, bf16_t* H) {
  const int lane = threadIdx.x & 63, gw = blockIdx.x * 8 + (threadIdx.x >> 6), nw = gridDim.x * 8;
  f32x4 g4[4];
#pragma unroll
  for (int i = 0; i < 4; ++i) g4[i] = *(const f32x4*)(ng + i * 256 + lane * 4);
  f32x4 va[4], vb[4]; int bia = 0, bib = 0;
  if (gw < NTOK) { const float* src = row_src(xsrc, csrc, gw, bia);
#pragma unroll
    for (int i = 0; i < 4; ++i) va[i] = *(const f32x4*)(src + i * 256 + lane * 4); }
  for (int n = gw; n < NTOK; n += nw) {
    if (n + nw < NTOK) { const float* src = row_src(xsrc, csrc, n + nw, bib);
#pragma unroll
      for (int i = 0; i < 4; ++i) vb[i] = *(const f32x4*)(src + i * 256 + lane * 4); }
    float ss = 0.f;
#pragma unroll
    for (int i = 0; i < 4; ++i) ss += va[i][0] * va[i][0] + va[i][1] * va[i][1] + va[i][2] * va[i][2] + va[i][3] * va[i][3];
    ss = wave_sum(ss);
    const float rstd = rsqrtf(ss * (1.f / 1024.f) + 1e-6f);
    const float* m = mod + bia * 3072;
#pragma unroll
    for (int i = 0; i < 4; ++i) {
      const int c = i * 256 + lane * 4;
      const f32x4 sh = *(const f32x4*)(m + c), sc = *(const f32x4*)(m + 1024 + c);
      float o[4];
#pragma unroll
      for (int e = 0; e < 4; ++e) o[e] = va[i][e] * rstd * g4[i][e] * (1.f + sc[e]) + sh[e];
      st_bf16x4(H + (size_t)n * 1024 + c, o[0], o[1], o[2], o[3]);
    }
#pragma unroll
    for (int i = 0; i < 4; ++i) va[i] = vb[i];
    bia = bib;
  }
}

constexpr int LERP3_SPLIT = 63488;
__device__ __forceinline__ bf16_t* lerp_base(const Params& p, int j, int row) {
  if (j == 0) return (bf16_t*)(p.ws + OFF_Y0);
  if (j == 1) return (bf16_t*)(p.ws + OFF_Y1);
  if (j == 2) return (bf16_t*)p.out;
  if (row < LERP3_SPLIT) return (bf16_t*)p.out + (size_t)NTOK * 1024;
  return (bf16_t*)(p.ws + WS_END) - (size_t)LERP3_SPLIT * 1024;
}
struct RowX { f32x4 v[4]; int bi; };
__device__ __forceinline__ void ld_row(const Params& p, int n, int lane, RowX& r) {
  const float* src = row_src(p.in[0], p.in[2], n, r.bi);
#pragma unroll
  for (int i = 0; i < 4; ++i) r.v[i] = *(const f32x4*)(src + i * 256 + lane * 4);
}
__device__ __forceinline__ void fin_row(const float* mod, const f32x4 (&g4)[4], int lane, const RowX& r, float (&h)[16]) {
  float ss = 0.f;
#pragma unroll
  for (int i = 0; i < 4; ++i) ss += r.v[i][0] * r.v[i][0] + r.v[i][1] * r.v[i][1] + r.v[i][2] * r.v[i][2] + r.v[i][3] * r.v[i][3];
  ss = wave_sum(ss);
  const float rstd = rsqrtf(ss * (1.f / 1024.f) + 1e-6f);
  const float* m = mod + r.bi * 3072;
#pragma unroll
  for (int i = 0; i < 4; ++i) {
    const int c = i * 256 + lane * 4;
    const f32x4 sh = *(const f32x4*)(m + c), sc = *(const f32x4*)(m + 1024 + c);
#pragma unroll
    for (int e = 0; e < 4; ++e) {
      const float hv = r.v[i][e] * rstd * g4[i][e] * (1.f + sc[e]) + sh[e];
      h[4 * i + e] = __uint_as_float(cvtpk(hv, 0.f) << 16);
    }
  }
}
__device__ void phase_norm_lerp(const Params& p, const float* mod) {
  const int lane = threadIdx.x & 63, gw = blockIdx.x * 8 + (threadIdx.x >> 6), nw = gridDim.x * 8;
  const int per = (NTOK + nw - 1) / nw;
  const int r0 = gw * per, r1 = (r0 + per < NTOK) ? r0 + per : NTOK;
  if (r0 >= r1) return;
  bf16_t* H = (bf16_t*)(p.ws + OFF_H);
  f32x4 g4[4];
#pragma unroll
  for (int i = 0; i < 4; ++i) g4[i] = *(const f32x4*)(p.in[4] + i * 256 + lane * 4);
  float mu[4][16];
#pragma unroll
  for (int j = 0; j < 4; ++j)
#pragma unroll
    for (int i = 0; i < 4; ++i) {
      const f32x4 m4 = *(const f32x4*)(p.in[7] + j * 1024 + i * 256 + lane * 4);
      mu[j][4 * i] = m4[0]; mu[j][4 * i + 1] = m4[1]; mu[j][4 * i + 2] = m4[2]; mu[j][4 * i + 3] = m4[3];
    }
  float hp[16], hc[16], hn[16];
  RowX xa, xb, xc;
  if (r0 > 0) { ld_row(p, r0 - 1, lane, xc); }
  ld_row(p, r0, lane, xa);
  if (r0 + 1 < NTOK) ld_row(p, r0 + 1, lane, xb);
  if (r0 > 0) fin_row(mod, g4, lane, xc, hp);
  else {
#pragma unroll
    for (int e = 0; e < 16; ++e) hp[e] = 0.f;
  }
  fin_row(mod, g4, lane, xa, hc);
  xa = xb;
  if (r0 + 2 < NTOK) ld_row(p, r0 + 2, lane, xb);
  for (int n = r0; n < r1; ++n) {
    const int t = n % TL;
    if (n + 3 < NTOK) ld_row(p, n + 3, lane, xc);
    if (n + 1 < NTOK) fin_row(mod, g4, lane, xa, hn);
    else {
#pragma unroll
      for (int e = 0; e < 16; ++e) hn[e] = 0.f;
    }
    const float fp = (t != 0 && t != T) ? 0.5f : 0.f, fn = (t != T - 1 && t != TL - 1) ? 0.5f : 0.f;
#pragma unroll
    for (int i = 0; i < 4; ++i) st_bf16x4_nt(H + (size_t)n * 1024 + i * 256 + lane * 4, hc[4 * i], hc[4 * i + 1], hc[4 * i + 2], hc[4 * i + 3]);
#pragma unroll
    for (int j = 0; j < 4; ++j) {
      bf16_t* dst = lerp_base(p, j, n) + (size_t)n * 1024 + lane * 4;
#pragma unroll
      for (int i = 0; i < 4; ++i) {
        float o[4];
#pragma unroll
        for (int e = 0; e < 4; ++e) { const float c = hc[4 * i + e]; o[e] = c + (fp * hp[4 * i + e] + fn * hn[4 * i + e] - c) * mu[j][4 * i + e]; }
        st_bf16x4_nt(dst + i * 256, o[0], o[1], o[2], o[3]);
      }
    }
#pragma unroll
    for (int e = 0; e < 16; ++e) { hp[e] = hc[e]; hc[e] = hn[e]; }
    xa = xb; xb = xc;
  }
}

__device__ void phase_final(float* out, const float* fg) {
  const int lane = threadIdx.x & 63, gw = blockIdx.x * 8 + (threadIdx.x >> 6), nw = gridDim.x * 8;
  f32x4 g4[4];
#pragma unroll
  for (int i = 0; i < 4; ++i) g4[i] = *(const f32x4*)(fg + i * 256 + lane * 4);
  f32x4 va[4], vb[4];
  if (gw < NB * T) {
#pragma unroll
    for (int i = 0; i < 4; ++i) va[i] = *(const f32x4*)(out + (size_t)gw * D + i * 256 + lane * 4); }
  for (int n = gw; n < NB * T; n += nw) {
    if (n + nw < NB * T) {
#pragma unroll
      for (int i = 0; i < 4; ++i) vb[i] = *(const f32x4*)(out + (size_t)(n + nw) * D + i * 256 + lane * 4); }
    float ss = 0.f;
#pragma unroll
    for (int i = 0; i < 4; ++i) ss += va[i][0] * va[i][0] + va[i][1] * va[i][1] + va[i][2] * va[i][2] + va[i][3] * va[i][3];
    ss = wave_sum(ss);
    const float rstd = rsqrtf(ss * (1.f / 1024.f) + 1e-6f);
#pragma unroll
    for (int i = 0; i < 4; ++i) {
      f32x4 o;
#pragma unroll
      for (int e = 0; e < 4; ++e) o[e] = va[i][e] * rstd * g4[i][e];
      *(f32x4*)(out + (size_t)n * D + i * 256 + lane * 4) = o;
    }
#pragma unroll
    for (int i = 0; i < 4; ++i) va[i] = vb[i];
  }
}

__device__ __forceinline__ int scan_row(int g, int d, int b) {
  if (g < L) { const int tt = d ? (L - 1 - g) : g; return b * TL + T + tt; }
  g -= L; const int tt = d ? (T - 1 - g) : g; return b * TL + tt;
}
constexpr int SC_P = 0, SC_ARA = 8192, SC_ARR = SC_ARA + 4096, SC_BK = SC_ARR + 4096, SC_SCAL = SC_BK + 8192, SC_VV = SC_SCAL + 1024, SC_BUF = SC_VV + 8192;
constexpr int SC_IC = 2 * SC_BUF, SC_SCR = SC_IC + 8192, SC_YB = SC_SCR + 16384, SC_END = SC_YB + 2 * 8192;
#define MFMA16(a, b, c) __builtin_amdgcn_mfma_f32_16x16x32_bf16((a), (b), (c), 0, 0, 0)
struct ScBlk { u32x4 aa0, aa1, ar0, ar1, k0, k1, k2, k3; f32x4 v; f32x4 s[8]; };
__device__ __forceinline__ void sc_ldb(ScBlk& c, const char* buf, int blk, int arOff, int bkOff, int vOff) {
  const char* pa = buf + SC_ARA + blk * 512 + arOff; const char* pr = buf + SC_ARR + blk * 512 + arOff;
  c.aa0 = *(const u32x4*)(pa); c.aa1 = *(const u32x4*)(pa + 64); c.ar0 = *(const u32x4*)(pr); c.ar1 = *(const u32x4*)(pr + 64);
  const char* bk = buf + SC_BK + blk * 1024 + bkOff;
  c.k0 = *(const u32x4*)(bk); c.k1 = *(const u32x4*)(bk + 256); c.k2 = *(const u32x4*)(bk + 512); c.k3 = *(const u32x4*)(bk + 768);
  c.v = *(const f32x4*)(buf + SC_VV + blk * 1024 + vOff);
  const char* sp = buf + SC_SCAL + blk * 128;
#pragma unroll
  for (int i = 0; i < 8; ++i) c.s[i] = *(const f32x4*)(sp + i * 16);
}
__device__ void phase_scan(const Params& p, char* lds) {
  unsigned char* ws = p.ws;
  const int tid = threadIdx.x, lane = tid & 63, wid = __builtin_amdgcn_readfirstlane(tid >> 6), r32 = lane & 31, hi = lane >> 5;
  const bf16_t* Rg = (const bf16_t*)(ws + OFF_R); const bf16_t* Kg = (const bf16_t*)(ws + OFF_K); const bf16_t* Vg = (const bf16_t*)(ws + OFF_V);
  const bf16_t* Lg = (const bf16_t*)(ws + OFF_LORA);
  constexpr int NCH = TL / 32;
  for (int sidx = blockIdx.x; sidx < 256; sidx += gridDim.x) {
    const int d = sidx >> 7, b = (sidx >> 4) & 7, h = sidx & 15;
    bf16_t* Yg = (bf16_t*)(ws + (d ? OFF_Y1 : OFF_Y0));
    if (wid < 4) {
      const int cw = wid, c16 = lane & 15, q = lane >> 4;
      const int arOff = (c16 & 3) * 128 + q * 16, wOff = q * 16, bkOff = c16 * 16, vOff = (cw * 16 + c16) * 16;
      f32x4 St0 = {0.f, 0.f, 0.f, 0.f}, St1 = St0, St2 = St0, St3 = St0;
      __syncthreads(); __syncthreads();
      for (int c = 0; c < NCH; ++c) {
        const char* buf = lds + (c & 1) * SC_BUF;
        char* yb = lds + SC_YB + (c & 1) * 8192 + (cw * 16 + c16) * 16;
        ScBlk cur; sc_ldb(cur, buf, 0, arOff, bkOff, vOff);
#pragma unroll 1
        for (int blk = 0; blk < 8; ++blk) {
          ScBlk nxt; sc_ldb(nxt, buf, (blk + 1) & 7, arOff, bkOff, vOff);
          u32x4 b1 = {cvtpk(St0[0], St0[1]), cvtpk(St0[2], St0[3]), cvtpk(St1[0], St1[1]), cvtpk(St1[2], St1[3])};
          u32x4 b2 = {cvtpk(St2[0], St2[1]), cvtpk(St2[2], St2[3]), cvtpk(St3[0], St3[1]), cvtpk(St3[2], St3[3])};
          f32x4 sr = {0.f, 0.f, 0.f, 0.f}, yr = sr;
          sr = MFMA16(*(bf16x8*)&cur.aa0, *(bf16x8*)&b1, sr); yr = MFMA16(*(bf16x8*)&cur.ar0, *(bf16x8*)&b1, yr);
          sr = MFMA16(*(bf16x8*)&cur.aa1, *(bf16x8*)&b2, sr); yr = MFMA16(*(bf16x8*)&cur.ar1, *(bf16x8*)&b2, yr);
          const float v1 = cur.v[0], v2 = cur.v[1], v3 = cur.v[2], v4 = cur.v[3];
          const f32x4 s0 = cur.s[0], s1 = cur.s[1], s2 = cur.s[2], s3 = cur.s[3], s4 = cur.s[4], s5 = cur.s[5], s6 = cur.s[6], s7 = cur.s[7];
          const float sa1 = sr[0];
          const float sa2 = sr[1] + s0[0] * sa1 + s1[2] * v1;
          const float sa3 = sr[2] + s0[1] * sa1 + s1[3] * v1 + s0[2] * sa2 + s2[0] * v2;
          const float sa4 = sr[3] + s0[3] * sa1 + s2[1] * v1 + s1[0] * sa2 + s2[2] * v2 + s1[1] * sa3 + s2[3] * v3;
          f32x4 y;
          y[0] = yr[0] + s3[0] * sa1 + s5[2] * v1;
          y[1] = yr[1] + s3[1] * sa1 + s5[3] * v1 + s3[2] * sa2 + s6[0] * v2;
          y[2] = yr[2] + s3[3] * sa1 + s6[1] * v1 + s4[0] * sa2 + s6[2] * v2 + s4[1] * sa3 + s6[3] * v3;
          y[3] = yr[3] + s4[2] * sa1 + s7[0] * v1 + s4[3] * sa2 + s7[1] * v2 + s5[0] * sa3 + s7[2] * v3 + s5[1] * sa4 + s7[3] * v4;
          u32x4 bu = {cvtpk(sa1, v1), cvtpk(sa2, v2), cvtpk(sa3, v3), cvtpk(sa4, v4)};
          if (q != 0) { bu[0] = 0u; bu[1] = 0u; bu[2] = 0u; bu[3] = 0u; }
          St0 = MFMA16(*(bf16x8*)&cur.k0, *(bf16x8*)&bu, St0);
          St1 = MFMA16(*(bf16x8*)&cur.k1, *(bf16x8*)&bu, St1);
          St2 = MFMA16(*(bf16x8*)&cur.k2, *(bf16x8*)&bu, St2);
          St3 = MFMA16(*(bf16x8*)&cur.k3, *(bf16x8*)&bu, St3);
          *(f32x4*)(yb + blk * 1024) = y;
          cur = nxt;
          if (blk == 7) {
            const char* pw = buf + SC_P + 31 * 256 + wOff;
            St0 *= *(const f32x4*)(pw); St1 *= *(const f32x4*)(pw + 64); St2 *= *(const f32x4*)(pw + 128); St3 *= *(const f32x4*)(pw + 192);
          }
          if (blk == 3 || blk == 7) __syncthreads();
        }
      }
    } else {
      const int pw = wid - 4, ptid = tid - 256;
      const int pstep = ptid >> 3, j0 = (ptid & 7) * 8, pblk = pstep >> 2, psb = pstep & 3;
      const int apos0 = (j0 >> 5) * 32 + (((j0 & 31) & 15) >> 2) * 8 + 4 * ((j0 & 31) >> 4), apos1 = apos0 + 8;
      float* Bg = (float*)(ws + OFF_BONUS) + (size_t)d * NTOK * 16;
      float kkc[8], kac[8], rkc[8];
#pragma unroll
      for (int e = 0; e < 8; ++e) { kkc[e] = p.in[15][h * 64 + j0 + e]; kac[e] = p.in[16][h * 64 + j0 + e]; rkc[e] = p.in[17][h * 64 + j0 + e]; }
      const int mat = pw >> 1, jh = pw & 1;
      bf16x8 w2f[4]; float bias;
      {
        const float* W2 = (mat ? p.in[14] : p.in[11]) + (size_t)d * 64 * 1024;
#pragma unroll
        for (int ks = 0; ks < 4; ++ks) {
          u32x4 w;
#pragma unroll
          for (int qq = 0; qq < 4; ++qq) {
            const int r0 = ks * 16 + 8 * hi + 2 * qq;
            w[qq] = cvtpk(W2[(size_t)r0 * 1024 + h * 64 + jh * 32 + r32], W2[(size_t)(r0 + 1) * 1024 + h * 64 + jh * 32 + r32]);
          }
          w2f[ks] = *(bf16x8*)&w;
        }
        bias = (mat ? p.in[12] : p.in[9])[d * 1024 + h * 64 + jh * 32 + r32];
      }
      u32x4 pR, pK, pV; bf16x8 pl[4];
      float kk[8], kr[8], rr[8];
      float* IC = (float*)(lds + SC_IC);
      bf16_t* SCR = (bf16_t*)(lds + SC_SCR);
      auto prefetch = [&](int c) {
        const size_t row = (size_t)scan_row(c * 32 + pstep, d, b) * 1024 + h * 64 + j0;
        pR = *(const u32x4*)(Rg + row); pK = *(const u32x4*)(Kg + row); pV = *(const u32x4*)(Vg + row);
        const size_t lrow = (size_t)scan_row(c * 32 + r32, d, b);
#pragma unroll
        for (int ks = 0; ks < 4; ++ks) pl[ks] = *(const bf16x8*)(Lg + lrow * 256 + mat * 128 + d * 64 + ks * 16 + hi * 8);
      };
      auto stageA = [&](int c) {
        char* buf = lds + (c & 1) * SC_BUF;
        float* Pd = (float*)(buf + SC_P); float* VV = (float*)(buf + SC_VV);
        f32x16 acc;
#pragma unroll
        for (int r = 0; r < 16; ++r) acc[r] = 0.f;
#pragma unroll
        for (int ks = 0; ks < 4; ++ks) acc = MFMA(pl[ks], w2f[ks], acc);
        if (mat == 0) {
          float cc[16];
#pragma unroll
          for (int r = 0; r < 16; ++r) cc[r] = -0.6065306597126334f * __builtin_amdgcn_rcpf(1.f + __expf(-(acc[r] + bias)));
#pragma unroll
          for (int g = 0; g < 4; ++g) { cc[4 * g + 1] += cc[4 * g]; cc[4 * g + 2] += cc[4 * g + 1]; cc[4 * g + 3] += cc[4 * g + 2]; }
          float run = 0.f;
#pragma unroll
          for (int g = 0; g < 4; ++g) {
            const float own = cc[4 * g + 3];
            auto rr2 = __builtin_amdgcn_permlane32_swap(__float_as_uint(own), __float_as_uint(own), false, false);
            const float both = __uint_as_float(rr2[0]) + __uint_as_float(rr2[1]), partner = both - own;
            const float off = hi ? run + partner : run;
#pragma unroll
            for (int e = 0; e < 4; ++e) Pd[crow(4 * g + e, hi) * 64 + jh * 32 + r32] = __expf(off + cc[4 * g + e]);
            run += both;
          }
        } else {
#pragma unroll
          for (int r = 0; r < 16; ++r) IC[crow(r, hi) * 64 + jh * 32 + r32] = __builtin_amdgcn_rcpf(1.f + __expf(-(acc[r] + bias)));
        }
        float ss = 0.f;
#pragma unroll
        for (int w = 0; w < 4; ++w) {
          rr[2 * w] = lo16(pR[w]); rr[2 * w + 1] = hi16(pR[w]);
          kr[2 * w] = lo16(pK[w]); kr[2 * w + 1] = hi16(pK[w]);
        }
        const float vv[8] = {lo16(pV[0]), hi16(pV[0]), lo16(pV[1]), hi16(pV[1]), lo16(pV[2]), hi16(pV[2]), lo16(pV[3]), hi16(pV[3])};
        if (c + 1 < NCH) prefetch(c + 1);
#pragma unroll
        for (int e = 0; e < 8; ++e) VV[(pblk * 64 + j0 + e) * 4 + psb] = vv[e];
#pragma unroll
        for (int e = 0; e < 8; ++e) { kk[e] = kr[e] * kkc[e]; ss += kk[e] * kk[e]; }
        ss = red8(ss);
        const float inv = rsqrtf(fmaxf(ss, 1e-24f));
#pragma unroll
        for (int e = 0; e < 8; ++e) kk[e] *= inv;
      };
      auto stageB = [&](int c) {
        char* buf = lds + (c & 1) * SC_BUF;
        const f32x4 i0 = *(const f32x4*)(IC + pstep * 64 + j0), i1 = *(const f32x4*)(IC + pstep * 64 + j0 + 4);
        const float ic[8] = {i0[0], i0[1], i0[2], i0[3], i1[0], i1[1], i1[2], i1[3]};
        const float* Pt = (const float*)(buf + SC_P) + pstep * 64 + j0;
        const f32x4 pt0 = *(const f32x4*)(Pt), pt1 = *(const f32x4*)(Pt + 4);
        f32x4 pm0 = {1.f, 1.f, 1.f, 1.f}, pm1 = pm0;
        if (pstep > 0) { pm0 = *(const f32x4*)(Pt - 64); pm1 = *(const f32x4*)(Pt - 60); }
        const float pt[8] = {pt0[0], pt0[1], pt0[2], pt0[3], pt1[0], pt1[1], pt1[2], pt1[3]};
        const float pm[8] = {pm0[0], pm0[1], pm0[2], pm0[3], pm1[0], pm1[1], pm1[2], pm1[3]};
        const u32x4 an = {cvtpk(-kk[0] * pm[0], -kk[1] * pm[1]), cvtpk(-kk[2] * pm[2], -kk[3] * pm[3]), cvtpk(-kk[4] * pm[4], -kk[5] * pm[5]), cvtpk(-kk[6] * pm[6], -kk[7] * pm[7])};
        const u32x4 rn = {cvtpk(rr[0] * pt[0], rr[1] * pt[1]), cvtpk(rr[2] * pt[2], rr[3] * pt[3]), cvtpk(rr[4] * pt[4], rr[5] * pt[5]), cvtpk(rr[6] * pt[6], rr[7] * pt[7])};
        bf16_t* ARa = (bf16_t*)(buf + SC_ARA) + (pblk * 4 + psb) * 64; bf16_t* ARr = (bf16_t*)(buf + SC_ARR) + (pblk * 4 + psb) * 64;
        { u32x2 lo = {an[0], an[1]}, hi2 = {an[2], an[3]}; *(u32x2*)(ARa + apos0) = lo; *(u32x2*)(ARa + apos1) = hi2; }
        { u32x2 lo = {rn[0], rn[1]}, hi2 = {rn[2], rn[3]}; *(u32x2*)(ARr + apos0) = lo; *(u32x2*)(ARr + apos1) = hi2; }
        *(u32x4*)(SCR + (pstep * 4 + 0) * 64 + j0) = an; *(u32x4*)(SCR + (pstep * 4 + 1) * 64 + j0) = rn;
        float bs = 0.f;
        unsigned bq[8], kq[8];
        unsigned* BK = (unsigned*)(buf + SC_BK) + (pblk * 64 + j0) * 4 + psb;
#pragma unroll
        for (int e = 0; e < 8; ++e) {
          const float kd = kr[e] * (1.f + (ic[e] - 1.f) * kac[e]);
          const float ip = __builtin_amdgcn_rcpf(pt[e]);
          const unsigned pr2 = cvtpk(kk[e] * ic[e] * ip, kd * ip);
          BK[e * 4] = pr2;
          bq[e] = pr2 & 0xffffu; kq[e] = pr2 >> 16;
          bs += rr[e] * kd * rkc[e];
        }
        const u32x4 bn = {bq[0] | (bq[1] << 16), bq[2] | (bq[3] << 16), bq[4] | (bq[5] << 16), bq[6] | (bq[7] << 16)};
        const u32x4 kn = {kq[0] | (kq[1] << 16), kq[2] | (kq[3] << 16), kq[4] | (kq[5] << 16), kq[6] | (kq[7] << 16)};
        *(u32x4*)(SCR + (pstep * 4 + 2) * 64 + j0) = bn; *(u32x4*)(SCR + (pstep * 4 + 3) * 64 + j0) = kn;
        bs = red8(bs);
        if ((ptid & 7) == 0) Bg[(size_t)scan_row(c * 32 + pstep, d, b) * 16 + h] = bs;
      };
      auto stageC = [&](int c) {
        char* buf = lds + (c & 1) * SC_BUF;
        asm volatile("s_waitcnt lgkmcnt(0)" ::: "memory");
        const int n16 = lane & 15, q4 = lane >> 4;
        const int stepA = (2 * pw + (n16 >> 3)) * 4 + (n16 & 3);
        const bf16_t* Xr = SCR + (stepA * 4 + 2 + ((n16 >> 2) & 1)) * 64 + q4 * 8;
        const bf16_t* Yc = SCR + (stepA * 4 + ((n16 >> 2) & 1)) * 64 + q4 * 8;
        f32x4 g = {0.f, 0.f, 0.f, 0.f};
        g = MFMA16(*(const bf16x8*)(Xr), *(const bf16x8*)(Yc), g);
        g = MFMA16(*(const bf16x8*)(Xr + 32), *(const bf16x8*)(Yc + 32), g);
        const int ctype = (n16 >> 2) & 1, t0 = n16 & 3, rtype = q4 & 1;
        const int grp = ctype * 2 + rtype, base = grp == 0 ? 0 : (grp == 1 ? 6 : (grp == 2 ? 12 : 22));
        float* sc = (float*)(buf + SC_SCAL) + (2 * pw + (n16 >> 3)) * 32 + base + (ctype ? (t0 + 1) * t0 / 2 : t0 * (t0 - 1) / 2);
        if ((q4 >> 1) == (n16 >> 3)) {
#pragma unroll
          for (int e = 0; e < 4; ++e) if (ctype ? (e <= t0) : (e < t0)) sc[e] = g[e];
        }
      };
      auto writeout = [&](int c) {
        const float* Yb = (const float*)(lds + SC_YB + (c & 1) * 8192) + (pblk * 64 + j0) * 4 + psb;
        u32x4 w = {cvtpk(Yb[0], Yb[4]), cvtpk(Yb[8], Yb[12]), cvtpk(Yb[16], Yb[20]), cvtpk(Yb[24], Yb[28])};
        *(u32x4*)(Yg + (size_t)scan_row(c * 32 + pstep, d, b) * 1024 + h * 64 + j0) = w;
      };
      prefetch(0);
      stageA(0);
      __syncthreads();
      stageB(0); stageC(0);
      __syncthreads();
      for (int c = 0; c < NCH; ++c) {
        if (c >= 1) writeout(c - 1);
        if (c + 1 < NCH) stageA(c + 1);
        __syncthreads();
        if (c + 1 < NCH) { stageB(c + 1); stageC(c + 1); }
        __syncthreads();
      }
      writeout(NCH - 1);
    }
    __syncthreads();
  }
}

__device__ void phase_readout(const Params& p) {
  unsigned char* ws = p.ws;
  const bf16_t* Y0 = (const bf16_t*)(ws + OFF_Y0); const bf16_t* Y1 = (const bf16_t*)(ws + OFF_Y1); const bf16_t* Vg = (const bf16_t*)(ws + OFF_V);
  bf16_t* G = (bf16_t*)(ws + OFF_G);
  const float* B0 = (const float*)(ws + OFF_BONUS); const float* B1 = B0 + (size_t)NTOK * 16;
  const int lane = threadIdx.x & 63, gw = blockIdx.x * 8 + (threadIdx.x >> 6), nw = gridDim.x * 8;
  const int c0 = lane * 16, hd = lane >> 2;
  float lg[16], lb[16];
#pragma unroll
  for (int e = 0; e < 16; ++e) { lg[e] = p.in[18][c0 + e]; lb[e] = p.in[19][c0 + e]; }
  struct RowIn { u32x4 a[2], b[2], v[2], g[2]; float b0, b1; };
  auto ldr = [&](int n, RowIn& r) {
    const size_t o = (size_t)n * 1024 + c0;
#pragma unroll
    for (int q = 0; q < 2; ++q) { r.a[q] = *(const u32x4*)(Y0 + o + 8 * q); r.b[q] = *(const u32x4*)(Y1 + o + 8 * q); r.v[q] = *(const u32x4*)(Vg + o + 8 * q); r.g[q] = *(const u32x4*)(G + o + 8 * q); }
    r.b0 = B0[(size_t)n * 16 + hd]; r.b1 = B1[(size_t)n * 16 + hd];
  };
  RowIn cur, nxt;
  if (gw < NTOK) ldr(gw, cur);
  for (int n = gw; n < NTOK; n += nw) {
    if (n + nw < NTOK) ldr(n + nw, nxt);
    const size_t o = (size_t)n * 1024 + c0;
    float y[16], v[16], g[16];
#pragma unroll
    for (int q = 0; q < 2; ++q) {
#pragma unroll
      for (int w = 0; w < 4; ++w) {
        y[8 * q + 2 * w] = lo16(cur.a[q][w]) + lo16(cur.b[q][w]); y[8 * q + 2 * w + 1] = hi16(cur.a[q][w]) + hi16(cur.b[q][w]);
        v[8 * q + 2 * w] = lo16(cur.v[q][w]); v[8 * q + 2 * w + 1] = hi16(cur.v[q][w]);
        g[8 * q + 2 * w] = lo16(cur.g[q][w]); g[8 * q + 2 * w + 1] = hi16(cur.g[q][w]);
      }
    }
    float s = 0.f;
#pragma unroll
    for (int e = 0; e < 16; ++e) s += y[e];
    s += dpp_f(s, 0); s += dpp_f(s, 1);
    const float mean = s * (1.f / 64.f);
    float q2 = 0.f;
#pragma unroll
    for (int e = 0; e < 16; ++e) { const float dlt = y[e] - mean; q2 += dlt * dlt; }
    q2 += dpp_f(q2, 0); q2 += dpp_f(q2, 1);
    const float rs = rsqrtf(q2 * (1.f / 64.f) + 64e-5f);
    const float bonus = cur.b0 + cur.b1;
    float r[16];
#pragma unroll
    for (int e = 0; e < 16; ++e) {
      const float yn = (y[e] - mean) * rs * lg[e] + lb[e];
      r[e] = (yn + bonus * v[e]) * (g[e] * sigmoidf_(g[e]));
    }
    u32x4 w0 = {cvtpk(r[0], r[1]), cvtpk(r[2], r[3]), cvtpk(r[4], r[5]), cvtpk(r[6], r[7])};
    u32x4 w1 = {cvtpk(r[8], r[9]), cvtpk(r[10], r[11]), cvtpk(r[12], r[13]), cvtpk(r[14], r[15])};
    *(u32x4*)(G + o) = w0; *(u32x4*)(G + o + 8) = w1;
    cur = nxt;
  }
}

constexpr int AT_SHMV = 16384, AT_KROW = 208, AT_SHMK = 64 * AT_KROW;
constexpr int AT_KOFF = 2 * AT_SHMV, AT_WOFF = AT_KOFF + 2 * AT_SHMK;
#define SBAR() __builtin_amdgcn_sched_barrier(0)
__device__ __forceinline__ void at_partialSM(f32x16& p0, f32x16& p1, float& m_reg, float& alpha, bool force) {
  float pm = p0[0];
#pragma unroll
  for (int r = 1; r < 16; ++r) pm = fmaxf(pm, p0[r]);
#pragma unroll
  for (int r = 0; r < 16; ++r) pm = fmaxf(pm, p1[r]);
  { auto rr = __builtin_amdgcn_permlane32_swap(__float_as_uint(pm), __float_as_uint(pm), false, false);
    pm = fmaxf(__uint_as_float(rr[0]), __uint_as_float(rr[1])); }
  if (__builtin_expect(!force && __all(pm <= AT_THR * 1.4426950408889634f), 1)) { alpha = 1.f; }
  else {
    const float dlt = force ? pm : fmaxf(pm, 0.f);
    alpha = force ? 1.f : __builtin_amdgcn_exp2f(-dlt); m_reg += dlt;
#pragma unroll
    for (int r = 0; r < 16; ++r) { p0[r] -= dlt; p1[r] -= dlt; }
  }
#pragma unroll
  for (int r = 0; r < 16; ++r) p0[r] = __builtin_amdgcn_exp2f(p0[r]);
}
__device__ __forceinline__ void at_finishSM(f32x16& p0, f32x16& p1, float alpha, float& l_reg, bf16x8& pa0, bf16x8& pa1, bf16x8& pa2, bf16x8& pa3) {
#pragma unroll
  for (int r = 0; r < 16; ++r) p1[r] = __builtin_amdgcn_exp2f(p1[r]);
  float ps = 0;
#pragma unroll
  for (int r = 0; r < 16; ++r) ps += p0[r];
#pragma unroll
  for (int r = 0; r < 16; ++r) ps += p1[r];
  { auto rr = __builtin_amdgcn_permlane32_swap(__float_as_uint(ps), __float_as_uint(ps), false, false);
    ps = __uint_as_float(rr[0]) + __uint_as_float(rr[1]); }
  l_reg = l_reg * alpha + ps;
#define PK4(P, BASE, OUT) do { unsigned a0 = cvtpk(P[BASE + 0], P[BASE + 1]), a1 = cvtpk(P[BASE + 2], P[BASE + 3]);   \
    unsigned b0 = cvtpk(P[BASE + 4], P[BASE + 5]), b1 = cvtpk(P[BASE + 6], P[BASE + 7]);                              \
    auto r0 = __builtin_amdgcn_permlane32_swap(a0, b0, false, false); auto r1 = __builtin_amdgcn_permlane32_swap(a1, b1, false, false); \
    u32x4 w = {r0[0], r1[0], r0[1], r1[1]}; OUT = *reinterpret_cast<bf16x8*>(&w); } while (0)
  PK4(p0, 0, pa0); PK4(p0, 8, pa1); PK4(p1, 0, pa2); PK4(p1, 8, pa3);
#undef PK4
}
__device__ __forceinline__ void at_qkt(f32x16& p0, f32x16& p1, const char* Ks, const bf16x8* qr, int r32, int hi, float negm) {
#pragma unroll
  for (int r = 0; r < 16; ++r) { p0[r] = negm; p1[r] = negm; }
#pragma unroll
  for (int d0 = 0; d0 < 6; ++d0) {
    const bf16x8 b0 = *(const bf16x8*)(Ks + r32 * AT_KROW + d0 * 32 + hi * 16);
    const bf16x8 b1 = *(const bf16x8*)(Ks + (32 + r32) * AT_KROW + d0 * 32 + hi * 16);
    p0 = MFMA(b0, qr[d0], p0);
    p1 = MFMA(b1, qr[d0], p1);
  }
}
__device__ __forceinline__ int v_st(int k, int c) { const int kk = (k & ~0xC) | ((k & 4) << 1) | ((k & 8) >> 1); return ((kk >> 3) * 4 + (c >> 5)) * 512 + ((kk & 7) * 32 + (c & 31)) * 2; }
__device__ __forceinline__ int v_rd_base(int lane) { return ((lane & 3) << 3) | (((lane >> 2) & 3) << 6) | (((lane >> 4) & 1) << 5) | (((lane >> 5) & 1) << 8); }
constexpr int v_rd_off(int d0, int ks, int half) { return d0 * 512 + ks * 4096 + half * 2048; }
template <int OFF> __device__ __forceinline__ s16x4 tr_read(int vb) {
  s16x4 r; asm volatile("ds_read_b64_tr_b16 %0, %1 offset:%2" : "=&v"(r) : "v"(vb), "i"(OFF) : "memory"); return r;
}
template <int D0> __device__ __forceinline__ void pv_one(f32x16& od, int vb, bf16x8 pa0, bf16x8 pa1, bf16x8 pa2, bf16x8 pa3) {
  const s16x4 l0 = tr_read<v_rd_off(D0, 0, 0)>(vb), h0 = tr_read<v_rd_off(D0, 0, 1)>(vb), l1 = tr_read<v_rd_off(D0, 1, 0)>(vb), h1 = tr_read<v_rd_off(D0, 1, 1)>(vb);
  const s16x4 l2 = tr_read<v_rd_off(D0, 2, 0)>(vb), h2 = tr_read<v_rd_off(D0, 2, 1)>(vb), l3 = tr_read<v_rd_off(D0, 3, 0)>(vb), h3 = tr_read<v_rd_off(D0, 3, 1)>(vb);
  asm volatile("s_waitcnt lgkmcnt(0)" ::: "memory"); SBAR();
#define PK(Lx, Hx) (bf16x8){Lx[0], Lx[1], Lx[2], Lx[3], Hx[0], Hx[1], Hx[2], Hx[3]}
  od = MFMA(pa0, PK(l0, h0), od);
  od = MFMA(pa1, PK(l1, h1), od);
  od = MFMA(pa2, PK(l2, h2), od);
  od = MFMA(pa3, PK(l3, h3), od);
#undef PK
}
__device__ __forceinline__ void pv_d0(f32x16* o, int vb, bf16x8 pa0, bf16x8 pa1, bf16x8 pa2, bf16x8 pa3) {
  pv_one<0>(o[0], vb, pa0, pa1, pa2, pa3); pv_one<1>(o[1], vb, pa0, pa1, pa2, pa3);
}

__device__ void phase_attn(const Params& p, char* lds) {
  unsigned char* ws = p.ws;
  const bf16_t* Qg = (const bf16_t*)(ws + OFF_Q); const bf16_t* KVg = (const bf16_t*)(ws + OFF_KV); const bf16_t* KPg = (const bf16_t*)(ws + OFF_KPE);
  bf16_t* G1 = (bf16_t*)(ws + OFF_G1);
  const f32x2* rope = (const f32x2*)(ws + OFF_ROPE);
  const int tid = threadIdx.x, wid = tid >> 6, lane = tid & 63, r32 = lane & 31, hi = lane >> 5;
  char* V_lds = lds; char* K_lds = lds + AT_KOFF;
  float* wsl = (float*)(lds + AT_WOFF) + wid * 64; float* li_l = wsl; float* al_l = wsl + 32;
  const int skey = tid >> 3, sc8 = (tid & 7) * 8;
  const int pkey = (tid & 255) >> 2, pc8 = (tid & 3) * 8;
  const int vst = v_st(skey, sc8), kst = skey * AT_KROW + sc8 * 2, pst = pkey * AT_KROW + (64 + pc8) * 2;
  const int vb0 = (int)(uintptr_t)V_lds + v_rd_base(lane);
  const int nitems = NB * 16 * 32;
  const int xcd = blockIdx.x & 7, slot = blockIdx.x >> 3, per = gridDim.x >> 3;
  for (int it = slot; it < nitems / 8; it += per) {
    const int pair = (it >> 5) * 8 + xcd, qblk = it & 31;
    const int b = pair >> 4, h = pair & 15;
    const size_t row0 = (size_t)b * TL;
    const size_t qrow = row0 + qblk * 256 + wid * 32 + r32;
    const bf16_t* Kh = KVg + row0 * 2048 + h * 128;
    const bf16_t* Kp = KPg + row0 * 32;
    float m_reg = 0.f, l_reg = 0.f;
    f32x16 o[2];
#pragma unroll
    for (int dd = 0; dd < 2; ++dd)
#pragma unroll
      for (int r = 0; r < 16; ++r) o[dd][r] = 0.f;
    bf16x8 qr[6];
    {
      const bf16_t* Qw = Qg + qrow * 1536 + h * 96 + hi * 8;
#pragma unroll
      for (int d0 = 0; d0 < 6; ++d0) qr[d0] = *(const bf16x8*)(Qw + d0 * 16);
      const int t = qblk * 256 + wid * 32 + r32;
      const f32x2* tb = rope + (hi ? (t & 63) : (t >> 6)) * 8;
      const u32x4 x1 = *(const u32x4*)&qr[4], x2 = *(const u32x4*)&qr[5];
      u32x4 n1, n2;
#pragma unroll
      for (int q = 0; q < 4; ++q) {
        const f32x2 csA = tb[2 * q], csB = tb[2 * q + 1];
        const float a0 = lo16(x1[q]), a1 = hi16(x1[q]), b0 = lo16(x2[q]), b1 = hi16(x2[q]);
        n1[q] = cvtpk(a0 * csA[0] - b0 * csA[1], a1 * csB[0] - b1 * csB[1]);
        n2[q] = cvtpk(a0 * csA[1] + b0 * csA[0], a1 * csB[1] + b1 * csB[0]);
      }
      qr[4] = *(bf16x8*)&n1; qr[5] = *(bf16x8*)&n2;
    }
    struct { bf16x8 vs, ks, ps; } sr_[2];
#define SLOAD(i, k0) do { sr_[i].vs = *(const bf16x8*)(Kh + (size_t)((k0) + skey) * 2048 + 64 + sc8); \
    sr_[i].ks = *(const bf16x8*)(Kh + (size_t)((k0) + skey) * 2048 + sc8); \
    sr_[i].ps = *(const bf16x8*)(Kp + (size_t)((k0) + pkey) * 32 + pc8); } while (0)
#define SWRITE(bb, i) do { *(bf16x8*)(V_lds + (bb) * AT_SHMV + vst) = sr_[i].vs; \
    *(bf16x8*)(K_lds + (bb) * AT_SHMK + kst) = sr_[i].ks; \
    *(bf16x8*)(K_lds + (bb) * AT_SHMK + pst) = sr_[i].ps; } while (0)
#define SWAIT() asm volatile("s_waitcnt vmcnt(3)" ::: "memory")
#define RESC(a) do { if (__any((a) < 1.f)) { if (hi == 0) al_l[r32] = (a); asm volatile("s_waitcnt lgkmcnt(0)" ::: "memory"); \
    _Pragma("unroll") for (int dd = 0; dd < 2; ++dd) _Pragma("unroll") for (int r = 0; r < 16; ++r) o[dd][r] *= al_l[crow(r, hi)]; } } while (0)
    f32x16 pA0, pA1, pB0, pB1; float alA, alB; bf16x8 pa0, pa1, pa2, pa3;
    constexpr int NT = TL / 64;
    SLOAD(0, 0); asm volatile("s_waitcnt vmcnt(0)" ::: "memory"); SWRITE(0, 0); __syncthreads();
    at_qkt(pA0, pA1, K_lds, qr, r32, hi, 0.f); at_partialSM(pA0, pA1, m_reg, alA, true);
    SLOAD(1, 64); SLOAD(0, 128);
    SWAIT(); SWRITE(1, 1); __syncthreads();
    for (int j = 1; j + 1 < NT; j += 2) {
      SBAR(); at_qkt(pB0, pB1, K_lds + AT_SHMK, qr, r32, hi, -m_reg);
      at_finishSM(pA0, pA1, alA, l_reg, pa0, pa1, pa2, pa3); SBAR();
      SLOAD(1, (j + 2) * 64); SBAR();
      pv_d0(o, vb0, pa0, pa1, pa2, pa3); at_partialSM(pB0, pB1, m_reg, alB, false);
      __syncthreads(); SWAIT(); SWRITE(0, 0);
      RESC(alB); __syncthreads();
      SBAR(); at_qkt(pA0, pA1, K_lds, qr, r32, hi, -m_reg);
      at_finishSM(pB0, pB1, alB, l_reg, pa0, pa1, pa2, pa3); SBAR();
      if (j + 3 < NT) SLOAD(0, (j + 3) * 64); SBAR();
      pv_d0(o, vb0 + AT_SHMV, pa0, pa1, pa2, pa3); at_partialSM(pA0, pA1, m_reg, alA, false);
      __syncthreads(); SWAIT(); SWRITE(1, 1);
      RESC(alA); __syncthreads();
    }
    SBAR(); at_qkt(pB0, pB1, K_lds + AT_SHMK, qr, r32, hi, -m_reg);
    at_finishSM(pA0, pA1, alA, l_reg, pa0, pa1, pa2, pa3); SBAR();
    pv_d0(o, vb0, pa0, pa1, pa2, pa3); at_partialSM(pB0, pB1, m_reg, alB, false);
    __syncthreads(); RESC(alB);
    at_finishSM(pB0, pB1, alB, l_reg, pa0, pa1, pa2, pa3); SBAR();
    pv_d0(o, vb0 + AT_SHMV, pa0, pa1, pa2, pa3);
    if (hi == 0) li_l[r32] = l_reg;
    asm volatile("s_waitcnt lgkmcnt(0)" ::: "memory");
    float rli[16];
#pragma unroll
    for (int r = 0; r < 16; ++r) rli[r] = __builtin_amdgcn_rcpf(li_l[crow(r, hi)]);
    bf16_t* Gw = G1 + (row0 + qblk * 256 + wid * 32) * 1024 + h * 64 + r32;
    bf16_t gin[32];
#pragma unroll
    for (int r = 0; r < 16; ++r) { gin[2 * r] = Gw[(size_t)crow(r, hi) * 1024]; gin[2 * r + 1] = Gw[(size_t)crow(r, hi) * 1024 + 32]; }
    asm volatile("" ::: "memory");
#pragma unroll
    for (int r = 0; r < 16; ++r) {
      const int orow = crow(r, hi);
#pragma unroll
      for (int d0 = 0; d0 < 2; ++d0) {
        const float gt = bf2f(gin[2 * r + d0]);
        Gw[(size_t)orow * 1024 + d0 * 32] = f2bf(o[d0][r] * rli[r] * gt * sigmoidf_(gt));
      }
    }
    __syncthreads();
#undef SLOAD
#undef SWRITE
#undef SWAIT
#undef RESC
  }
}

struct XcdWalk {
  int start, count, step, idx;
  __device__ __forceinline__ void init(int ntiles) {
    const int x = blockIdx.x & 7, base = ntiles >> 3, rem = ntiles & 7;
    count = base + (x < rem ? 1 : 0); start = x * base + (x < rem ? x : rem); step = gridDim.x >> 3; idx = blockIdx.x >> 3;
  }
  __device__ __forceinline__ bool next(int& o) { if (idx >= count) return false; o = start + idx; idx += step; return true; }
};
__device__ __forceinline__ void tile_mn(int o, int NT, int& mt, int& nt) { const int g = o >> 3; mt = (g / NT) * 8 + (o & 7); nt = g % NT; }

__global__ __launch_bounds__(NTHR, 1) void fwd_megakernel(Params p) {
  extern __shared__ __attribute__((aligned(16))) char lds[];
  cg::grid_group grid = cg::this_grid();
  unsigned char* ws = p.ws;
  bf16_t* H = (bf16_t*)(ws + OFF_H);
  float* mod = (float*)(ws + OFF_MOD);
  float* CTX1 = (float*)(ws + OFF_CTX1);

  phase_prologue(p, lds);
  grid.sync();
  phase_norm_lerp(p, mod);
  phase_weights(p, lds);
  grid.sync();
  {
    const bf16_t* WIN0 = (const bf16_t*)(ws + OFF_WIN0);
    const int nbig = 264 * 16;
    XcdWalk wk; wk.init(nbig); int o;
    while (wk.next(o)) {
      EpiBf16 e; e.invK = 0.f;
      {
        int mt, jn; tile_mn(o, 16, mt, jn);
        const int j = jn >> 2, n4 = jn & 3, m0 = mt * 256;
        e.dst = (bf16_t*)(ws + OFF_R + (size_t)j * U); e.ldd = 1024; e.col0 = n4 * 256; e.act = 0; e.m0 = m0;
        gemm_tile<0, 256>(lerp_base(p, j, m0), 1024, WIN0 + (size_t)(j * 1024 + n4 * 256) * 1024, 1024, m0, nullptr, lds, e);
      }
    }
    wk.init(264 * 2);
    while (wk.next(o)) {
      EpiBf16 e; e.invK = 0.f;
      {
        int mt, n2; tile_mn(o, 2, mt, n2);
        const int nt = 32 + n2, m0 = mt * 256;
        e.dst = (bf16_t*)(ws + OFF_LORA); e.ldd = 256; e.col0 = (nt - 32) * 128; e.act = (nt == 32) ? 1 : 0; e.m0 = m0;
        gemm_tile<1, 128>(H, 1024, WIN0 + (size_t)nt * 128 * 1024, 1024, m0, p.in[7] + (nt - 28) * 1024, lds, e);
      }
    }
  }
  grid.sync();
  phase_scan(p, lds);
  grid.sync();
  phase_readout(p);
  grid.sync();
  {
    const bf16_t* A = (const bf16_t*)(ws + OFF_G); const bf16_t* W = (const bf16_t*)(ws + OFF_WOUT0);
    XcdWalk wk; wk.init(264 * 4); int o;
    while (wk.next(o)) {
      int mt, nt; tile_mn(o, 4, mt, nt);
      const int m0 = mt * 256;
      const int b = m0 / TL, t0 = m0 - b * TL;
      EpiResid e;
      if (t0 < T) { const size_t orow = (size_t)b * T + t0; e.xin = p.in[0] + orow * 1024; e.xout = p.out + orow * 1024; e.gvec = mod + (size_t)b * 3072 + 2048; }
      else { const size_t orow = (size_t)b * L + (t0 - T); e.xin = p.in[2] + orow * 1024; e.xout = CTX1 + orow * 1024; e.gvec = mod + (size_t)8 * 3072 + 2048; }
      e.n0 = nt * 256;
      gemm_tile<0, 256>(A, 1024, W + (size_t)nt * 256 * 1024, 1024, m0, nullptr, lds, e);
    }
  }
  grid.sync();
  phase_norm(p.out, CTX1, p.in[4] + 1024, mod + 9 * 3072, H);
  grid.sync();
  {
    const bf16_t* W = (const bf16_t*)(ws + OFF_WIN1);
    XcdWalk wk; wk.init(264 * 7); int o;
    while (wk.next(o)) {
      int mt, nt; tile_mn(o, 7, mt, nt);
      const int m0 = mt * 256;
      EpiMlaIn e; e.QC = (bf16_t*)(ws + OFF_QC); e.KVC = (bf16_t*)(ws + OFF_KVC); e.KPE = (bf16_t*)(ws + OFF_KPE); e.G1 = (bf16_t*)(ws + OFF_G1);
      e.rope = (const float*)(ws + OFF_ROPE); e.n0 = nt * 256; e.m0 = m0;
      gemm_tile<0, 256>(H, 1024, W + (size_t)nt * 256 * 1024, 1024, m0, nullptr, lds, e);
    }
  }
  grid.sync();
  {
    const bf16_t* WQ = (const bf16_t*)(ws + OFF_WQB); const bf16_t* WKV = (const bf16_t*)(ws + OFF_WKVB);
    const int nq = 256 * 6, nkv = 264 * 8;
    XcdWalk wk; wk.init(nq); int o;
    while (wk.next(o)) {
      EpiBf16 e; e.act = 0;
      {
        int mt2, nt; tile_mn(o, 6, mt2, nt);
        const int b = mt2 >> 5, m0 = b * TL + (mt2 & 31) * 256;
        e.dst = (bf16_t*)(ws + OFF_Q); e.ldd = 1536; e.col0 = nt * 256; e.m0 = m0; e.invK = 1.f / 384.f;
        gemm_tile<2, 256>((const bf16_t*)(ws + OFF_QC), 384, WQ + (size_t)nt * 256 * 384, 384, m0, nullptr, lds, e);
      }
    }
    wk.init(nkv);
    while (wk.next(o)) {
      EpiBf16 e; e.act = 0;
      {
        int mt, nt; tile_mn(o, 8, mt, nt);
        const int m0 = mt * 256;
        e.dst = (bf16_t*)(ws + OFF_KV); e.ldd = 2048; e.col0 = nt * 256; e.m0 = m0; e.invK = 1.f / 256.f;
        gemm_tile<2, 256>((const bf16_t*)(ws + OFF_KVC), 256, WKV + (size_t)nt * 256 * 256, 256, m0, nullptr, lds, e);
      }
    }
  }
  grid.sync();
  phase_attn(p, lds);
  grid.sync();
  {
    const bf16_t* A = (const bf16_t*)(ws + OFF_G1); const bf16_t* W = (const bf16_t*)(ws + OFF_WOUT1);
    XcdWalk wk; wk.init(256 * 4); int o;
    while (wk.next(o)) {
      int mt2, nt; tile_mn(o, 4, mt2, nt);
      const int b = mt2 >> 5, t0 = (mt2 & 31) * 256, m0 = b * TL + t0;
      const size_t orow = (size_t)b * T + t0;
      EpiResid e; e.xin = p.out + orow * 1024; e.xout = p.out + orow * 1024; e.gvec = mod + (size_t)(9 + b) * 3072 + 2048; e.n0 = nt * 256;
      gemm_tile<0, 256>(A, 1024, W + (size_t)nt * 256 * 1024, 1024, m0, nullptr, lds, e);
    }
  }
  grid.sync();
  phase_final(p.out, p.in[27]);
}

extern "C" void kernel_launch(void* const* d_in, const int* in_sizes, int n_in, void* d_out, int out_size, void* d_ws, size_t ws_size, hipStream_t stream) {
  static int grid_blocks = 0;
  if (grid_blocks == 0) {
    if (n_in != 28 || ws_size < WS_END + (size_t)(NTOK - LERP3_SPLIT) * 2048 || out_size != NB * T * D) { fprintf(stderr, "kernel_launch: unexpected shapes (n_in %d, ws %zu need %zu, out %d)\n", n_in, ws_size, (size_t)WS_END, out_size); grid_blocks = -1; return; }
    int dev = 0, cus = 0, per_cu = 0;
    hipGetDevice(&dev);
    hipDeviceGetAttribute(&cus, hipDeviceAttributeMultiprocessorCount, dev);
    if (hipFuncSetAttribute((const void*)fwd_megakernel, hipFuncAttributeMaxDynamicSharedMemorySize, LDS_BYTES) != hipSuccess) { fprintf(stderr, "kernel_launch: hipFuncSetAttribute failed\n"); grid_blocks = -1; return; }
    hipOccupancyMaxActiveBlocksPerMultiprocessor(&per_cu, (const void*)fwd_megakernel, NTHR, LDS_BYTES);
    if (per_cu < 1) { fprintf(stderr, "kernel_launch: occupancy query says %d blocks per CU\n", per_cu); per_cu = 1; }
    (void)hipGetLastError();
    grid_blocks = cus;
    if (grid_blocks > 256) grid_blocks = 256;
    grid_blocks &= ~7;
  }
  if (grid_blocks <= 0) return;
  Params p{};
  for (int i = 0; i < 28; ++i) p.in[i] = (const float*)d_in[i];
  p.out = (float*)d_out; p.ws = (unsigned char*)d_ws;
  void* args[] = {&p};
  hipError_t e = hipLaunchCooperativeKernel((const void*)fwd_megakernel, dim3(grid_blocks), dim3(NTHR), args, LDS_BYTES, stream);
  if (e != hipSuccess) fprintf(stderr, "cooperative launch failed: %s (grid %d)\n", hipGetErrorString(e), grid_blocks);
}
```

```cpp
#include <hip/hip_runtime.h>
#include <hip/hip_cooperative_groups.h>
#include <cstdio>
#include <cstdint>
namespace cg = cooperative_groups;

typedef unsigned short bf16_t;
typedef short bf16x8 __attribute__((ext_vector_type(8)));
typedef short s16x4 __attribute__((ext_vector_type(4)));
typedef float f32x16 __attribute__((ext_vector_type(16)));
typedef float f32x4 __attribute__((ext_vector_type(4)));
typedef float f32x2 __attribute__((ext_vector_type(2)));
typedef unsigned u32x4 __attribute__((ext_vector_type(4)));
typedef unsigned u32x2 __attribute__((ext_vector_type(2)));

constexpr int D = 1024, NB = 8, T = 8192, L = 256, TL = T + L, NTOK = NB * TL;
constexpr int NTHR = 512;

constexpr size_t U = (size_t)NTOK * 1024 * 2;
constexpr size_t OFF_H = 0, OFF_R = U, OFF_K = 2 * U, OFF_V = 3 * U, OFF_G = 4 * U, OFF_Y0 = 5 * U, OFF_Y1 = 6 * U;
constexpr size_t OFF_LORA = 7 * U;
constexpr size_t OFF_BONUS = OFF_LORA + (size_t)NTOK * 256 * 2;
constexpr size_t OFF_WIN0 = OFF_BONUS + (size_t)2 * NTOK * 16 * 4;
constexpr size_t OFF_WOUT0 = OFF_WIN0 + (size_t)4352 * 1024 * 2;
constexpr size_t OFF_WIN1 = OFF_WOUT0 + (size_t)1024 * 1024 * 2;
constexpr size_t OFF_WQB = OFF_WIN1 + (size_t)1792 * 1024 * 2;
constexpr size_t OFF_WKVB = OFF_WQB + (size_t)1536 * 384 * 2;
constexpr size_t OFF_WOUT1 = OFF_WKVB + (size_t)2048 * 256 * 2;
constexpr size_t OFF_MOD = OFF_WOUT1 + (size_t)1024 * 1024 * 2;
constexpr size_t OFF_ROPE = OFF_MOD + (size_t)2 * 9 * 3072 * 4;
constexpr size_t OFF_CTX1 = OFF_ROPE + (size_t)128 * 8 * 2 * 4;
constexpr size_t WS_END = OFF_CTX1 + (size_t)2048 * 1024 * 4;
constexpr size_t OFF_QC = OFF_V;
constexpr size_t OFF_KVC = OFF_QC + (size_t)NTOK * 384 * 2;
constexpr size_t OFF_KPE = OFF_KVC + (size_t)NTOK * 256 * 2;
constexpr size_t OFF_G1 = OFF_G;
constexpr size_t OFF_Q = OFF_R;
constexpr size_t OFF_KV = OFF_Y0;

struct Params { const float* in[28]; float* out; unsigned char* ws; };

typedef __bf16 bf16x2_t __attribute__((ext_vector_type(2)));
__device__ __forceinline__ unsigned cvtpk(float lo, float hi) { f32x2 v = {lo, hi}; bf16x2_t b = __builtin_convertvector(v, bf16x2_t); return *(unsigned*)&b; }
__device__ __forceinline__ float bf2f(bf16_t u) { return __uint_as_float(((unsigned)u) << 16); }
__device__ __forceinline__ bf16_t f2bf(float f) { return (bf16_t)(cvtpk(f, 0.f) & 0xffffu); }
__device__ __forceinline__ float lo16(unsigned w) { return __uint_as_float(w << 16); }
__device__ __forceinline__ float hi16(unsigned w) { return __uint_as_float(w & 0xffff0000u); }
__device__ __forceinline__ void st_bf16x4(bf16_t* p, float a, float b, float c, float d) { u32x2 w = {cvtpk(a, b), cvtpk(c, d)}; *(u32x2*)p = w; }
__device__ __forceinline__ void st_bf16x4_nt(bf16_t* p, float a, float b, float c, float d) { u32x2 w = {cvtpk(a, b), cvtpk(c, d)}; __builtin_nontemporal_store(w, (u32x2*)p); }
__device__ __forceinline__ float wave_sum(float v) {
#pragma unroll
  for (int o = 32; o; o >>= 1) v += __shfl_xor(v, o);
  return v;
}
__device__ __forceinline__ float dpp_f(float v, const int ctrl_sel) {
  int r;
  if (ctrl_sel == 0) r = __builtin_amdgcn_update_dpp(0, __float_as_int(v), 0xB1, 0xF, 0xF, true);
  else if (ctrl_sel == 1) r = __builtin_amdgcn_update_dpp(0, __float_as_int(v), 0x4E, 0xF, 0xF, true);
  else r = __builtin_amdgcn_update_dpp(0, __float_as_int(v), 0x141, 0xF, 0xF, true);
  return __int_as_float(r);
}
__device__ __forceinline__ float red8(float v) { v += dpp_f(v, 0); v += dpp_f(v, 1); v += dpp_f(v, 2); return v; }
__device__ __forceinline__ int crow(int r, int hi) { return (r & 3) + 8 * (r >> 2) + 4 * hi; }
__device__ __forceinline__ float sigmoidf_(float x) { return 1.f / (1.f + __expf(-x)); }
#define MFMA(a, b, c) __builtin_amdgcn_mfma_f32_32x32x16_bf16((a), (b), (c), 0, 0, 0)

constexpr int G_LDT = 144;
constexpr int G_SSQ_OFF = 2 * (256 + 256) * G_LDT;
constexpr int LDS_BYTES = G_SSQ_OFF + 1024;

template <int AMODE, int BN, class Epi>
__device__ __forceinline__ void gemm_tile(const bf16_t* A, const int lda, const bf16_t* Bt, const int K, const int m0, const float* mu, char* lds, const Epi& epi) {
  constexpr int WN = BN / 64, MI = WN, NBR = BN / 64, G_STAGE = (256 + BN) * G_LDT;
  const int tid = threadIdx.x, lane = tid & 63, wid = tid >> 6, r32 = lane & 31, hi = lane >> 5;
  const int wm = wid / WN, wn = wid % WN;
  const int srow = tid >> 3, scc = (tid & 7) * 8;
  int browi[NBR];
#pragma unroll
  for (int i = 0; i < NBR; ++i) browi[i] = 64 * i + ((Epi::PERM && !epi.natural_group(64 * i + srow)) ? ((srow & 32) + 16 * ((srow >> 2) & 1) + 4 * ((srow & 31) >> 3) + (srow & 3)) : srow);
  f32x16 acc[MI][2];
#pragma unroll
  for (int i = 0; i < MI; ++i)
#pragma unroll
    for (int j = 0; j < 2; ++j)
#pragma unroll
      for (int r = 0; r < 16; ++r) acc[i][j][r] = 0.f;
  bf16x8 ra[4], rb[NBR], rp[4], rn[4];
  float ssq[4] = {0.f, 0.f, 0.f, 0.f};
  int dprev[4], dnext[4];
  if constexpr (AMODE == 1) {
    const int t0 = m0 % TL;
#pragma unroll
    for (int i = 0; i < 4; ++i) { const int t = t0 + srow + 64 * i; dprev[i] = (t != 0 && t != T) ? 1 : 0; dnext[i] = (t != T - 1 && t != TL - 1) ? 1 : 0; }
  }
  auto gload = [&](int k0) {
#pragma unroll
    for (int i = 0; i < 4; ++i) {
      const bf16_t* ap = A + (size_t)(m0 + srow + 64 * i) * lda + k0 + scc;
      ra[i] = *(const bf16x8*)ap;
      if constexpr (AMODE == 1) { rp[i] = *(const bf16x8*)(ap - dprev[i] * lda); rn[i] = *(const bf16x8*)(ap + dnext[i] * lda); }
    }
#pragma unroll
    for (int i = 0; i < NBR; ++i) rb[i] = *(const bf16x8*)(Bt + (size_t)browi[i] * K + k0 + scc);
  };
  auto lstore = [&](int s, int k0) {
    char* base = lds + s * G_STAGE;
    if constexpr (AMODE == 1) {
      const f32x4 m0v = *(const f32x4*)(mu + k0 + scc), m1v = *(const f32x4*)(mu + k0 + scc + 4);
      const float mm[8] = {m0v[0], m0v[1], m0v[2], m0v[3], m1v[0], m1v[1], m1v[2], m1v[3]};
#pragma unroll
      for (int i = 0; i < 4; ++i) {
        const u32x4 hc = *(const u32x4*)&ra[i], hp = *(const u32x4*)&rp[i], hn = *(const u32x4*)&rn[i];
        const float fp = dprev[i] ? 0.5f : 0.f, fn = dnext[i] ? 0.5f : 0.f;
        u32x4 w;
#pragma unroll
        for (int q = 0; q < 4; ++q) {
          const float c0 = lo16(hc[q]), c1 = hi16(hc[q]);
          const float x0 = fp * lo16(hp[q]) + fn * lo16(hn[q]) - c0, x1 = fp * hi16(hp[q]) + fn * hi16(hn[q]) - c1;
          w[q] = cvtpk(c0 + x0 * mm[2 * q], c1 + x1 * mm[2 * q + 1]);
        }
        *(u32x4*)(base + (srow + 64 * i) * G_LDT + scc * 2) = w;
      }
    } else {
#pragma unroll
      for (int i = 0; i < 4; ++i) {
        *(bf16x8*)(base + (srow + 64 * i) * G_LDT + scc * 2) = ra[i];
        if constexpr (AMODE == 2) {
          const u32x4 hc = *(const u32x4*)&ra[i];
#pragma unroll
          for (int q = 0; q < 4; ++q) { const float c0 = lo16(hc[q]), c1 = hi16(hc[q]); ssq[i] += c0 * c0 + c1 * c1; }
        }
      }
    }
#pragma unroll
    for (int i = 0; i < NBR; ++i) *(bf16x8*)(base + 256 * G_LDT + (srow + 64 * i) * G_LDT + scc * 2) = rb[i];
  };
  const int nk = K >> 6;
  gload(0);
  lstore(0, 0);
  if (nk > 1) gload(64);
  __syncthreads();
#pragma unroll 1
  for (int kt = 0; kt < nk; ++kt) {
    const int s = kt & 1;
    if (kt + 1 < nk) lstore(s ^ 1, (kt + 1) * 64);
    if (kt + 2 < nk) gload((kt + 2) * 64);
    {
      const char* Ab = lds + s * G_STAGE + (wm * (32 * MI) + r32) * G_LDT + hi * 16;
      const char* Bb = lds + s * G_STAGE + 256 * G_LDT + (wn * 64 + r32) * G_LDT + hi * 16;
      bf16x8 fb[2][2], fa[2][MI];
      fb[0][0] = *(const bf16x8*)(Bb); fb[0][1] = *(const bf16x8*)(Bb + 32 * G_LDT);
#pragma unroll
      for (int mi = 0; mi < MI; ++mi) fa[0][mi] = *(const bf16x8*)(Ab + mi * 32 * G_LDT);
#pragma unroll
      for (int ks = 0; ks < 4; ++ks) {
        const int sl = ks & 1;
        if (ks + 1 < 4) {
          fb[sl ^ 1][0] = *(const bf16x8*)(Bb + (ks + 1) * 32); fb[sl ^ 1][1] = *(const bf16x8*)(Bb + 32 * G_LDT + (ks + 1) * 32);
#pragma unroll
          for (int mi = 0; mi < MI; ++mi) fa[sl ^ 1][mi] = *(const bf16x8*)(Ab + mi * 32 * G_LDT + (ks + 1) * 32);
        }
#pragma unroll
        for (int mi = 0; mi < MI; ++mi) { acc[mi][0] = MFMA(fb[sl][0], fa[sl][mi], acc[mi][0]); acc[mi][1] = MFMA(fb[sl][1], fa[sl][mi], acc[mi][1]); }
      }
    }
    __syncthreads();
  }
  float* ssq_l = (float*)(lds + G_SSQ_OFF);
  if constexpr (AMODE == 2) {
#pragma unroll
    for (int i = 0; i < 4; ++i) { const float v = red8(ssq[i]); if ((tid & 7) == 0) ssq_l[srow + 64 * i] = v; }
    __syncthreads();
  }
#pragma unroll
  for (int mi = 0; mi < MI; ++mi) {
    const int lrow = wm * (32 * MI) + mi * 32 + r32;
    float aux = 0.f;
    if constexpr (AMODE == 2) aux = ssq_l[lrow];
    epi(lrow, wn * 64 + 4 * hi, acc[mi][0], acc[mi][1], aux);
  }
}

struct EpiBf16 {
  static constexpr bool PERM = true;
  __device__ __forceinline__ bool natural_group(int) const { return false; }
  bf16_t* dst; int ldd; int col0; int m0; int act; float invK;
  __device__ __forceinline__ void operator()(int lrow, int nc, const f32x16& a0, const f32x16& a1, float aux) const { one(lrow, nc, a0, aux); one(lrow, nc + 32, a1, aux); }
  __device__ __forceinline__ void one(int lrow, int nc, const f32x16& a, float aux) const {
    float sc = 1.f;
    if (invK > 0.f) sc = rsqrtf(aux * invK + 1e-6f);
    bf16_t* p = dst + (size_t)(m0 + lrow) * ldd + col0 + (nc & ~7) + 4 * (nc & 4);
    if (act) {
#define TANH_(x) (1.f - 2.f / (__expf(2.f * (x) * sc) + 1.f))
      const u32x4 w0 = {cvtpk(TANH_(a[0]), TANH_(a[1])), cvtpk(TANH_(a[2]), TANH_(a[3])), cvtpk(TANH_(a[4]), TANH_(a[5])), cvtpk(TANH_(a[6]), TANH_(a[7]))};
      const u32x4 w1 = {cvtpk(TANH_(a[8]), TANH_(a[9])), cvtpk(TANH_(a[10]), TANH_(a[11])), cvtpk(TANH_(a[12]), TANH_(a[13])), cvtpk(TANH_(a[14]), TANH_(a[15]))};
#undef TANH_
      *(u32x4*)p = w0; *(u32x4*)(p + 8) = w1;
    } else {
      const u32x4 w0 = {cvtpk(a[0] * sc, a[1] * sc), cvtpk(a[2] * sc, a[3] * sc), cvtpk(a[4] * sc, a[5] * sc), cvtpk(a[6] * sc, a[7] * sc)};
      const u32x4 w1 = {cvtpk(a[8] * sc, a[9] * sc), cvtpk(a[10] * sc, a[11] * sc), cvtpk(a[12] * sc, a[13] * sc), cvtpk(a[14] * sc, a[15] * sc)};
      *(u32x4*)p = w0; *(u32x4*)(p + 8) = w1;
    }
  }
};
struct EpiResid {
  static constexpr bool PERM = false;
  __device__ __forceinline__ bool natural_group(int) const { return true; }
  const float* xin; float* xout; const float* gvec; int n0; char* scr;
  __device__ __forceinline__ void operator()(int lrow, int nc, const f32x16& a0, const f32x16& a1, float) const {
    const int lane = threadIdx.x & 63, wid = threadIdx.x >> 6, r32 = lane & 31, hi = lane >> 5;
    float* sp = (float*)(scr + wid * (32 * 272));
#pragma unroll
    for (int g = 0; g < 4; ++g) {
      const f32x4 v0 = {a0[4 * g], a0[4 * g + 1], a0[4 * g + 2], a0[4 * g + 3]}, v1 = {a1[4 * g], a1[4 * g + 1], a1[4 * g + 2], a1[4 * g + 3]};
      *(f32x4*)(sp + r32 * 68 + 4 * hi + 8 * g) = v0; *(f32x4*)(sp + r32 * 68 + 32 + 4 * hi + 8 * g) = v1;
    }
    asm volatile("s_waitcnt lgkmcnt(0)" ::: "memory");
    const int c4 = (lane & 15) * 4, colg = n0 + (nc & ~7) + c4;
    const size_t rbase = (size_t)(lrow - r32) * 1024 + colg;
    const f32x4 gv = *(const f32x4*)(gvec + colg);
    f32x4 xv[8];
#pragma unroll
    for (int i = 0; i < 8; ++i) xv[i] = *(const f32x4*)(xin + rbase + (size_t)((lane >> 4) + 4 * i) * 1024);
    asm volatile("" ::: "memory");
#pragma unroll
    for (int i = 0; i < 8; ++i) {
      const int row = (lane >> 4) + 4 * i;
      const f32x4 av = *(const f32x4*)(sp + row * 68 + c4);
      f32x4 r; r[0] = xv[i][0] + gv[0] * av[0]; r[1] = xv[i][1] + gv[1] * av[1]; r[2] = xv[i][2] + gv[2] * av[2]; r[3] = xv[i][3] + gv[3] * av[3];
      *(f32x4*)(xout + rbase + (size_t)row * 1024) = r;
    }
    asm volatile("s_waitcnt lgkmcnt(0)" ::: "memory");
  }
};
struct EpiMlaIn {
  static constexpr bool PERM = true;
  bf16_t *QC, *KVC, *KPE, *G1; const float* rope; int n0; int m0;
  __device__ __forceinline__ bool natural_group(int tile_row) const { return ((n0 + tile_row) >> 5) == 20; }
  __device__ __forceinline__ void operator()(int lrow, int nc, const f32x16& a0, const f32x16& a1, float) const { one(lrow, nc, a0); one(lrow, nc + 32, a1); }
  __device__ __forceinline__ void one(int lrow, int nc, const f32x16& a) const {
    const int row = m0 + lrow, g32 = n0 + (nc & ~7);
    if (g32 == 640) {
      const int t = (m0 % TL) + lrow, hi4 = nc & 4;
      bf16_t* p = KPE + (size_t)row * 32;
      if (t < T) {
        const f32x2* tr = (const f32x2*)rope + (t >> 6) * 8 + hi4;
        const f32x2* tc = (const f32x2*)rope + (t & 63) * 8 + hi4;
        float o1[8], o2[8];
#pragma unroll
        for (int e = 0; e < 4; ++e) {
          const f32x2 cs0 = tr[e], cs1 = tc[e];
          const float x1a = a[e], x2a = a[8 + e];
          const float x1b = a[4 + e], x2b = a[12 + e];
          o1[e] = x1a * cs0[0] - x2a * cs0[1]; o2[e] = x1a * cs0[1] + x2a * cs0[0];
          o1[4 + e] = x1b * cs1[0] - x2b * cs1[1]; o2[4 + e] = x1b * cs1[1] + x2b * cs1[0];
        }
        st_bf16x4(p + hi4, o1[0], o1[1], o1[2], o1[3]);
        st_bf16x4(p + 8 + hi4, o1[4], o1[5], o1[6], o1[7]);
        st_bf16x4(p + 16 + hi4, o2[0], o2[1], o2[2], o2[3]);
        st_bf16x4(p + 24 + hi4, o2[4], o2[5], o2[6], o2[7]);
      } else {
#pragma unroll
        for (int g = 0; g < 4; ++g) st_bf16x4(p + 8 * g + hi4, a[4 * g], a[4 * g + 1], a[4 * g + 2], a[4 * g + 3]);
      }
      return;
    }
    if (g32 > 640 && g32 < 768) return;
    const int gc = g32 + 4 * (nc & 4);
    bf16_t* p;
    if (gc < 384) p = QC + (size_t)row * 384 + gc;
    else if (gc < 640) p = KVC + (size_t)row * 256 + (gc - 384);
    else p = G1 + (size_t)row * 1024 + (gc - 768);
    const u32x4 w0 = {cvtpk(a[0], a[1]), cvtpk(a[2], a[3]), cvtpk(a[4], a[5]), cvtpk(a[6], a[7])};
    const u32x4 w1 = {cvtpk(a[8], a[9]), cvtpk(a[10], a[11]), cvtpk(a[12], a[13]), cvtpk(a[14], a[15])};
    *(u32x4*)p = w0; *(u32x4*)(p + 8) = w1;
  }
};

constexpr float AT_SCALE = 0.10206207261596575f;
constexpr float AT_THR = 8.f;
__device__ void tr_job(const float* src, int ld, int K, int N, bf16_t* dst, const float* kscale, char* lds, float gscale = 1.f) {
  float* tile = (float*)lds;
  const int tid = threadIdx.x, nK = K >> 6, nN = (N + 63) >> 6;
  for (int tIdx = blockIdx.x; tIdx < nK * nN; tIdx += gridDim.x) {
    const int k0 = (tIdx % nK) * 64, n0 = (tIdx / nK) * 64;
#pragma unroll
    for (int i = 0; i < 8; ++i) {
      const int kk = (tid >> 6) + 8 * i, nn = tid & 63;
      float v = 0.f;
      if (n0 + nn < N) { v = src[(size_t)(k0 + kk) * ld + n0 + nn] * gscale; if (kscale) v *= kscale[k0 + kk]; }
      tile[kk * 65 + nn] = v;
    }
    __syncthreads();
#pragma unroll
    for (int i = 0; i < 8; ++i) {
      const int nn = (tid >> 6) + 8 * i, kk = tid & 63;
      if (n0 + nn < N) dst[(size_t)(n0 + nn) * K + k0 + kk] = f2bf(tile[kk * 65 + nn]);
    }
    __syncthreads();
  }
}

__device__ void phase_weights(const Params& p, char* lds) {
  unsigned char* ws = p.ws;
  bf16_t* WIN0 = (bf16_t*)(ws + OFF_WIN0);
  for (int j = 0; j < 4; ++j) tr_job(p.in[8] + (size_t)j * 1024 * 1024, 1024, 1024, 1024, WIN0 + (size_t)j * 1024 * 1024, nullptr, lds);
  for (int d = 0; d < 2; ++d) {
    tr_job(p.in[10] + (size_t)d * 1024 * 64, 64, 1024, 64, WIN0 + (size_t)(4096 + d * 64) * 1024, nullptr, lds);
    tr_job(p.in[13] + (size_t)d * 1024 * 64, 64, 1024, 64, WIN0 + (size_t)(4224 + d * 64) * 1024, nullptr, lds);
  }
  tr_job(p.in[20], 1024, 1024, 1024, (bf16_t*)(ws + OFF_WOUT0), nullptr, lds);
  bf16_t* WIN1 = (bf16_t*)(ws + OFF_WIN1);
  tr_job(p.in[21], 1696, 1024, 640, WIN1, nullptr, lds);
  tr_job(p.in[21] + 640, 1696, 1024, 32, WIN1 + (size_t)640 * 1024, nullptr, lds);
  tr_job(p.in[21] + 672, 1696, 1024, 1024, WIN1 + (size_t)768 * 1024, nullptr, lds);
  for (int i = blockIdx.x * NTHR + threadIdx.x; i < 96 * 1024; i += gridDim.x * NTHR) WIN1[(size_t)672 * 1024 + i] = 0;
  tr_job(p.in[23], 1536, 384, 1536, (bf16_t*)(ws + OFF_WQB), p.in[22], lds, AT_SCALE * 1.4426950408889634f);
  tr_job(p.in[25], 2048, 256, 2048, (bf16_t*)(ws + OFF_WKVB), p.in[24], lds);
  tr_job(p.in[26], 1024, 1024, 1024, (bf16_t*)(ws + OFF_WOUT1), nullptr, lds);
}
__device__ void phase_prologue(const Params& p, char* lds) {
  unsigned char* ws = p.ws;
  {
    const int i = blockIdx.x * NTHR + threadIdx.x;
    if (i < 1024) {
      const float invf[8] = {1.f, 0.316227766016838f, 0.1f, 0.0316227766016838f, 0.01f, 0.00316227766016838f, 0.001f, 0.000316227766016838f};
      const int pos = i >> 3, m = i & 7;
      float inv = invf[0];
#pragma unroll
      for (int q = 1; q < 8; ++q) inv = (m == q) ? invf[q] : inv;
      const float ang = (float)pos * inv;
      const float kf = rintf(ang * 0.15915494309189535f);
      float r = fmaf(-kf, 6.28125f, ang);
      r = fmaf(-kf, 1.9353071795864769e-3f, r);
      float* rt = (float*)(ws + OFF_ROPE);
      rt[2 * i] = cosf(r); rt[2 * i + 1] = sinf(r);
    }
  }
  {
    float* sil = (float*)lds;
    float* red = sil + 9 * 1024;
    const int tid = threadIdx.x;
    for (int i = tid; i < 9 * 1024; i += NTHR) {
      const int bi = i >> 10, k = i & 1023;
      const float cv = bi < 8 ? p.in[1][bi * 1024 + k] : p.in[3][k];
      sil[i] = cv / (1.f + __expf(-cv));
    }
    __syncthreads();
    float* mod = (float*)(ws + OFF_MOD);
    for (int item = blockIdx.x; item < 192; item += gridDim.x) {
      const int l = item / 96, n0 = (item % 96) * 32, col = tid & 31, kg = tid >> 5;
      float acc[9];
#pragma unroll
      for (int bi = 0; bi < 9; ++bi) acc[bi] = 0.f;
      const float* wp = p.in[5] + ((size_t)l * 1024 + kg * 64) * 3072 + n0 + col;
      for (int kk = 0; kk < 64; ++kk) {
        const float w = wp[(size_t)kk * 3072];
#pragma unroll
        for (int bi = 0; bi < 9; ++bi) acc[bi] += sil[bi * 1024 + kg * 64 + kk] * w;
      }
#pragma unroll
      for (int bi = 0; bi < 9; ++bi) red[(kg * 9 + bi) * 32 + col] = acc[bi];
      __syncthreads();
      if (tid < 288) {
        const int bi = tid >> 5;
        float s = 0.f;
#pragma unroll
        for (int g = 0; g < 16; ++g) s += red[(g * 9 + bi) * 32 + col];
        mod[((size_t)l * 9 + bi) * 3072 + n0 + col] = s + p.in[6][l * 3072 + n0 + col];
      }
      __syncthreads();
    }
  }
}

__device__ __forceinline__ const float* row_src(const float* xsrc, const float* csrc, int n, int& bi) {
  const int b = n / TL, t = n - b * TL;
  if (t < T) { bi = b; return xsrc + ((size_t)b * T + t) * D; }
  bi = 8; return csrc + ((size_t)b * L + (t - T)) * D;
}
__device__ void phase_norm(const float* xsrc, const float* csrc, const float* ng, const float* mod, bf16_t* H) {
  const int lane = threadIdx.x & 63, gw = blockIdx.x * 8 + (threadIdx.x >> 6), nw = gridDim.x * 8;
  f32x4 g4[4];
#pragma unroll
  for (int i = 0; i < 4; ++i) g4[i] = *(const f32x4*)(ng + i * 256 + lane * 4);
  f32x4 va[4], vb[4]; int bia = 0, bib = 0;
  if (gw < NTOK) { const float* src = row_src(xsrc, csrc, gw, bia);
#pragma unroll
    for (int i = 0; i < 4; ++i) va[i] = *(const f32x4*)(src + i * 256 + lane * 4); }
  for (int n = gw; n < NTOK; n += nw) {
    if (n + nw < NTOK) { const float* src = row_src(xsrc, csrc, n + nw, bib);
#pragma unroll
      for (int i = 0; i < 4; ++i) vb[i] = *(const f32x4*)(src + i * 256 + lane * 4); }
    float ss = 0.f;
#pragma unroll
    for (int i = 0; i < 4; ++i) ss += va[i][0] * va[i][0] + va[i][1] * va[i][1] + va[i][2] * va[i][2] + va[i][3] * va[i][3];
    ss = wave_sum(ss);
    const float rstd = rsqrtf(ss * (1.f / 1024.f) + 1e-6f);
    const float* m = mod + bia * 3072;
#pragma unroll
    for (int i = 0; i < 4; ++i) {
      const int c = i * 256 + lane * 4;
      const f32x4 sh = *(const f32x4*)(m + c), sc = *(const f32x4*)(m + 1024 + c);
      float o[4];
#pragma unroll
      for (int e = 0; e < 4; ++e) o[e] = va[i][e] * rstd * g4[i][e] * (1.f + sc[e]) + sh[e];
      st_bf16x4(H + (size_t)n * 1024 + c, o[0], o[1], o[2], o[3]);
    }
#pragma unroll
    for (int i = 0; i < 4; ++i) va[i] = vb[i];
    bia = bib;
  }
}

constexpr int LERP3_SPLIT = 63488;
__device__ __forceinline__ bf16_t* lerp_base(const Params& p, int j, int row) {
  if (j == 0) return (bf16_t*)(p.ws + OFF_Y0);
  if (j == 1) return (bf16_t*)(p.ws + OFF_Y1);
  if (j == 2) return (bf16_t*)p.out;
  if (row < LERP3_SPLIT) return (bf16_t*)p.out + (size_t)NTOK * 1024;
  return (bf16_t*)(p.ws + WS_END) - (size_t)LERP3_SPLIT * 1024;
}
struct RowX { f32x4 v[4]; int bi; };
__device__ __forceinline__ void ld_row(const Params& p, int n, int lane, RowX& r) {
  const float* src = row_src(p.in[0], p.in[2], n, r.bi);
#pragma unroll
  for (int i = 0; i < 4; ++i) r.v[i] = *(const f32x4*)(src + i * 256 + lane * 4);
}
__device__ __forceinline__ void fin_row(const float* mod, const f32x4 (&g4)[4], int lane, const RowX& r, float (&h)[16]) {
  float ss = 0.f;
#pragma unroll
  for (int i = 0; i < 4; ++i) ss += r.v[i][0] * r.v[i][0] + r.v[i][1] * r.v[i][1] + r.v[i][2] * r.v[i][2] + r.v[i][3] * r.v[i][3];
  ss = wave_sum(ss);
  const float rstd = rsqrtf(ss * (1.f / 1024.f) + 1e-6f);
  const float* m = mod + r.bi * 3072;
#pragma unroll
  for (int i = 0; i < 4; ++i) {
    const int c = i * 256 + lane * 4;
    const f32x4 sh = *(const f32x4*)(m + c), sc = *(const f32x4*)(m + 1024 + c);
#pragma unroll
    for (int e = 0; e < 4; ++e) {
      const float hv = r.v[i][e] * rstd * g4[i][e] * (1.f + sc[e]) + sh[e];
      h[4 * i + e] = __uint_as_float(cvtpk(hv, 0.f) << 16);
    }
  }
}
__device__ void phase_norm_lerp(const Params& p, const float* mod) {
  const int lane = threadIdx.x & 63, gw = blockIdx.x * 8 + (threadIdx.x >> 6), nw = gridDim.x * 8;
  const int per = (NTOK + nw - 1) / nw;
  const int r0 = gw * per, r1 = (r0 + per < NTOK) ? r0 + per : NTOK;
  if (r0 >= r1) return;
  bf16_t* H = (bf16_t*)(p.ws + OFF_H);
  f32x4 g4[4];
#pragma unroll
  for (int i = 0; i < 4; ++i) g4[i] = *(const f32x4*)(p.in[4] + i * 256 + lane * 4);
  float mu[4][16];
#pragma unroll
  for (int j = 0; j < 4; ++j)
#pragma unroll
    for (int i = 0; i < 4; ++i) {
      const f32x4 m4 = *(const f32x4*)(p.in[7] + j * 1024 + i * 256 + lane * 4);
      mu[j][4 * i] = m4[0]; mu[j][4 * i + 1] = m4[1]; mu[j][4 * i + 2] = m4[2]; mu[j][4 * i + 3] = m4[3];
    }
  float hp[16], hc[16], hn[16];
  RowX xa, xb, xc;
  if (r0 > 0) { ld_row(p, r0 - 1, lane, xc); }
  ld_row(p, r0, lane, xa);
  if (r0 + 1 < NTOK) ld_row(p, r0 + 1, lane, xb);
  if (r0 > 0) fin_row(mod, g4, lane, xc, hp);
  else {
#pragma unroll
    for (int e = 0; e < 16; ++e) hp[e] = 0.f;
  }
  fin_row(mod, g4, lane, xa, hc);
  xa = xb;
  if (r0 + 2 < NTOK) ld_row(p, r0 + 2, lane, xb);
  for (int n = r0; n < r1; ++n) {
    const int t = n % TL;
    if (n + 3 < NTOK) ld_row(p, n + 3, lane, xc);
    if (n + 1 < NTOK) fin_row(mod, g4, lane, xa, hn);
    else {
#pragma unroll
      for (int e = 0; e < 16; ++e) hn[e] = 0.f;
    }
    const float fp = (t != 0 && t != T) ? 0.5f : 0.f, fn = (t != T - 1 && t != TL - 1) ? 0.5f : 0.f;
#pragma unroll
    for (int i = 0; i < 4; ++i) st_bf16x4_nt(H + (size_t)n * 1024 + i * 256 + lane * 4, hc[4 * i], hc[4 * i + 1], hc[4 * i + 2], hc[4 * i + 3]);
#pragma unroll
    for (int j = 0; j < 4; ++j) {
      bf16_t* dst = lerp_base(p, j, n) + (size_t)n * 1024 + lane * 4;
#pragma unroll
      for (int i = 0; i < 4; ++i) {
        float o[4];
#pragma unroll
        for (int e = 0; e < 4; ++e) { const float c = hc[4 * i + e]; o[e] = c + (fp * hp[4 * i + e] + fn * hn[4 * i + e] - c) * mu[j][4 * i + e]; }
        st_bf16x4_nt(dst + i * 256, o[0], o[1], o[2], o[3]);
      }
    }
#pragma unroll
    for (int e = 0; e < 16; ++e) { hp[e] = hc[e]; hc[e] = hn[e]; }
    xa = xb; xb = xc;
  }
}

__device__ void phase_final(float* out, const float* fg) {
  const int lane = threadIdx.x & 63, gw = blockIdx.x * 8 + (threadIdx.x >> 6), nw = gridDim.x * 8;
  f32x4 g4[4];
#pragma unroll
  for (int i = 0; i < 4; ++i) g4[i] = *(const f32x4*)(fg + i * 256 + lane * 4);
  f32x4 va[4], vb[4];
  if (gw < NB * T) {
#pragma unroll
    for (int i = 0; i < 4; ++i) va[i] = *(const f32x4*)(out + (size_t)gw * D + i * 256 + lane * 4); }
  for (int n = gw; n < NB * T; n += nw) {
    if (n + nw < NB * T) {
#pragma unroll
      for (int i = 0; i < 4; ++i) vb[i] = *(const f32x4*)(out + (size_t)(n + nw) * D + i * 256 + lane * 4); }
    float ss = 0.f;
#pragma unroll
    for (int i = 0; i < 4; ++i) ss += va[i][0] * va[i][0] + va[i][1] * va[i][1] + va[i][2] * va[i][2] + va[i][3] * va[i][3];
    ss = wave_sum(ss);
    const float rstd = rsqrtf(ss * (1.f / 1024.f) + 1e-6f);
#pragma unroll
    for (int i = 0; i < 4; ++i) {
      f32x4 o;
#pragma unroll
      for (int e = 0; e < 4; ++e) o[e] = va[i][e] * rstd * g4[i][e];
      *(f32x4*)(out + (size_t)n * D + i * 256 + lane * 4) = o;
    }
#pragma unroll
    for (int i = 0; i < 4; ++i) va[i] = vb[i];
  }
}

__device__ __forceinline__ int scan_row(int g, int d, int b) {
  if (g < L) { const int tt = d ? (L - 1 - g) : g; return b * TL + T + tt; }
  g -= L; const int tt = d ? (T - 1 - g) : g; return b * TL + tt;
}
constexpr int SC_P = 0, SC_ARA = 8192, SC_ARR = SC_ARA + 4096, SC_BK = SC_ARR + 4096, SC_SCAL = SC_BK + 8192, SC_VV = SC_SCAL + 1024, SC_BUF = SC_VV + 8192;
constexpr int SC_IC = 2 * SC_BUF, SC_SCR = SC_IC + 8192, SC_YB = SC_SCR + 16384, SC_END = SC_YB + 2 * 8192;
#define MFMA16(a, b, c) __builtin_amdgcn_mfma_f32_16x16x32_bf16((a), (b), (c), 0, 0, 0)
struct ScBlk { u32x4 aa0, aa1, ar0, ar1, k0, k1, k2, k3; f32x4 v; f32x4 s[8]; };
__device__ __forceinline__ void sc_ldb(ScBlk& c, const char* buf, int blk, int arOff, int bkOff, int vOff) {
  const char* pa = buf + SC_ARA + blk * 512 + arOff; const char* pr = buf + SC_ARR + blk * 512 + arOff;
  c.aa0 = *(const u32x4*)(pa); c.aa1 = *(const u32x4*)(pa + 64); c.ar0 = *(const u32x4*)(pr); c.ar1 = *(const u32x4*)(pr + 64);
  const char* bk = buf + SC_BK + blk * 1024 + bkOff;
  c.k0 = *(const u32x4*)(bk); c.k1 = *(const u32x4*)(bk + 256); c.k2 = *(const u32x4*)(bk + 512); c.k3 = *(const u32x4*)(bk + 768);
  c.v = *(const f32x4*)(buf + SC_VV + blk * 1024 + vOff);
  const char* sp = buf + SC_SCAL + blk * 128;
#pragma unroll
  for (int i = 0; i < 8; ++i) c.s[i] = *(const f32x4*)(sp + i * 16);
}
__device__ void phase_scan(const Params& p, char* lds) {
  unsigned char* ws = p.ws;
  const int tid = threadIdx.x, lane = tid & 63, wid = __builtin_amdgcn_readfirstlane(tid >> 6), r32 = lane & 31, hi = lane >> 5;
  const bf16_t* Rg = (const bf16_t*)(ws + OFF_R); const bf16_t* Kg = (const bf16_t*)(ws + OFF_K); const bf16_t* Vg = (const bf16_t*)(ws + OFF_V);
  const bf16_t* Lg = (const bf16_t*)(ws + OFF_LORA);
  constexpr int NCH = TL / 32;
  for (int sidx = blockIdx.x; sidx < 256; sidx += gridDim.x) {
    const int d = sidx >> 7, b = (sidx >> 4) & 7, h = sidx & 15;
    bf16_t* Yg = (bf16_t*)(ws + (d ? OFF_Y1 : OFF_Y0));
    if (wid < 4) {
      const int cw = wid, c16 = lane & 15, q = lane >> 4;
      const int arOff = (c16 & 3) * 128 + q * 16, wOff = q * 16, bkOff = c16 * 16, vOff = (cw * 16 + c16) * 16;
      f32x4 St0 = {0.f, 0.f, 0.f, 0.f}, St1 = St0, St2 = St0, St3 = St0;
      __syncthreads(); __syncthreads();
      for (int c = 0; c < NCH; ++c) {
        const char* buf = lds + (c & 1) * SC_BUF;
        char* yb = lds + SC_YB + (c & 1) * 8192 + (cw * 16 + c16) * 16;
        ScBlk cur; sc_ldb(cur, buf, 0, arOff, bkOff, vOff);
#pragma unroll 1
        for (int blk = 0; blk < 8; ++blk) {
          ScBlk nxt; sc_ldb(nxt, buf, (blk + 1) & 7, arOff, bkOff, vOff);
          u32x4 b1 = {cvtpk(St0[0], St0[1]), cvtpk(St0[2], St0[3]), cvtpk(St1[0], St1[1]), cvtpk(St1[2], St1[3])};
          u32x4 b2 = {cvtpk(St2[0], St2[1]), cvtpk(St2[2], St2[3]), cvtpk(St3[0], St3[1]), cvtpk(St3[2], St3[3])};
          f32x4 sr = {0.f, 0.f, 0.f, 0.f}, yr = sr;
          sr = MFMA16(*(bf16x8*)&cur.aa0, *(bf16x8*)&b1, sr); yr = MFMA16(*(bf16x8*)&cur.ar0, *(bf16x8*)&b1, yr);
          sr = MFMA16(*(bf16x8*)&cur.aa1, *(bf16x8*)&b2, sr); yr = MFMA16(*(bf16x8*)&cur.ar1, *(bf16x8*)&b2, yr);
          const float v1 = cur.v[0], v2 = cur.v[1], v3 = cur.v[2], v4 = cur.v[3];
          const f32x4 s0 = cur.s[0], s1 = cur.s[1], s2 = cur.s[2], s3 = cur.s[3], s4 = cur.s[4], s5 = cur.s[5], s6 = cur.s[6], s7 = cur.s[7];
          const float sa1 = sr[0];
          const float sa2 = sr[1] + s0[0] * sa1 + s1[2] * v1;
          const float sa3 = sr[2] + s0[1] * sa1 + s1[3] * v1 + s0[2] * sa2 + s2[0] * v2;
          const float sa4 = sr[3] + s0[3] * sa1 + s2[1] * v1 + s1[0] * sa2 + s2[2] * v2 + s1[1] * sa3 + s2[3] * v3;
          f32x4 y;
          y[0] = yr[0] + s3[0] * sa1 + s5[2] * v1;
          y[1] = yr[1] + s3[1] * sa1 + s5[3] * v1 + s3[2] * sa2 + s6[0] * v2;
          y[2] = yr[2] + s3[3] * sa1 + s6[1] * v1 + s4[0] * sa2 + s6[2] * v2 + s4[1] * sa3 + s6[3] * v3;
          y[3] = yr[3] + s4[2] * sa1 + s7[0] * v1 + s4[3] * sa2 + s7[1] * v2 + s5[0] * sa3 + s7[2] * v3 + s5[1] * sa4 + s7[3] * v4;
          u32x4 bu = {cvtpk(sa1, v1), cvtpk(sa2, v2), cvtpk(sa3, v3), cvtpk(sa4, v4)};
          if (q != 0) { bu[0] = 0u; bu[1] = 0u; bu[2] = 0u; bu[3] = 0u; }
          St0 = MFMA16(*(bf16x8*)&cur.k0, *(bf16x8*)&bu, St0);
          St1 = MFMA16(*(bf16x8*)&cur.k1, *(bf16x8*)&bu, St1);
          St2 = MFMA16(*(bf16x8*)&cur.k2, *(bf16x8*)&bu, St2);
          St3 = MFMA16(*(bf16x8*)&cur.k3, *(bf16x8*)&bu, St3);
          *(f32x4*)(yb + blk * 1024) = y;
          cur = nxt;
          if (blk == 7) {
            const char* pw = buf + SC_P + 31 * 256 + wOff;
            St0 *= *(const f32x4*)(pw); St1 *= *(const f32x4*)(pw + 64); St2 *= *(const f32x4*)(pw + 128); St3 *= *(const f32x4*)(pw + 192);
          }
          if (blk == 3 || blk == 7) __syncthreads();
        }
      }
    } else {
      const int pw = wid - 4, ptid = tid - 256;
      const int pstep = ptid >> 3, j0 = (ptid & 7) * 8, pblk = pstep >> 2, psb = pstep & 3;
      const int apos0 = (j0 >> 5) * 32 + (((j0 & 31) & 15) >> 2) * 8 + 4 * ((j0 & 31) >> 4), apos1 = apos0 + 8;
      float* Bg = (float*)(ws + OFF_BONUS) + (size_t)d * NTOK * 16;
      float kkc[8], kac[8], rkc[8];
#pragma unroll
      for (int e = 0; e < 8; ++e) { kkc[e] = p.in[15][h * 64 + j0 + e]; kac[e] = p.in[16][h * 64 + j0 + e]; rkc[e] = p.in[17][h * 64 + j0 + e]; }
      const int mat = pw >> 1, jh = pw & 1;
      bf16x8 w2f[4]; float bias;
      {
        const float* W2 = (mat ? p.in[14] : p.in[11]) + (size_t)d * 64 * 1024;
#pragma unroll
        for (int ks = 0; ks < 4; ++ks) {
          u32x4 w;
#pragma unroll
          for (int qq = 0; qq < 4; ++qq) {
            const int r0 = ks * 16 + 8 * hi + 2 * qq;
            w[qq] = cvtpk(W2[(size_t)r0 * 1024 + h * 64 + jh * 32 + r32], W2[(size_t)(r0 + 1) * 1024 + h * 64 + jh * 32 + r32]);
          }
          w2f[ks] = *(bf16x8*)&w;
        }
        bias = (mat ? p.in[12] : p.in[9])[d * 1024 + h * 64 + jh * 32 + r32];
      }
      u32x4 pR, pK, pV; bf16x8 pl[4];
      float kk[8], kr[8], rr[8];
      float* IC = (float*)(lds + SC_IC);
      bf16_t* SCR = (bf16_t*)(lds + SC_SCR);
      auto prefetch = [&](int c) {
        const size_t row = (size_t)scan_row(c * 32 + pstep, d, b) * 1024 + h * 64 + j0;
        pR = *(const u32x4*)(Rg + row); pK = *(const u32x4*)(Kg + row); pV = *(const u32x4*)(Vg + row);
        const size_t lrow = (size_t)scan_row(c * 32 + r32, d, b);
#pragma unroll
        for (int ks = 0; ks < 4; ++ks) pl[ks] = *(const bf16x8*)(Lg + lrow * 256 + mat * 128 + d * 64 + ks * 16 + hi * 8);
      };
      auto stageA = [&](int c) {
        char* buf = lds + (c & 1) * SC_BUF;
        float* Pd = (float*)(buf + SC_P); float* VV = (float*)(buf + SC_VV);
        f32x16 acc;
#pragma unroll
        for (int r = 0; r < 16; ++r) acc[r] = 0.f;
#pragma unroll
        for (int ks = 0; ks < 4; ++ks) acc = MFMA(pl[ks], w2f[ks], acc);
        if (mat == 0) {
          float cc[16];
#pragma unroll
          for (int r = 0; r < 16; ++r) cc[r] = -0.6065306597126334f * __builtin_amdgcn_rcpf(1.f + __expf(-(acc[r] + bias)));
#pragma unroll
          for (int g = 0; g < 4; ++g) { cc[4 * g + 1] += cc[4 * g]; cc[4 * g + 2] += cc[4 * g + 1]; cc[4 * g + 3] += cc[4 * g + 2]; }
          float run = 0.f;
#pragma unroll
          for (int g = 0; g < 4; ++g) {
            const float own = cc[4 * g + 3];
            auto rr2 = __builtin_amdgcn_permlane32_swap(__float_as_uint(own), __float_as_uint(own), false, false);
            const float both = __uint_as_float(rr2[0]) + __uint_as_float(rr2[1]), partner = both - own;
            const float off = hi ? run + partner : run;
#pragma unroll
            for (int e = 0; e < 4; ++e) Pd[crow(4 * g + e, hi) * 64 + jh * 32 + r32] = __expf(off + cc[4 * g + e]);
            run += both;
          }
        } else {
#pragma unroll
          for (int r = 0; r < 16; ++r) IC[crow(r, hi) * 64 + jh * 32 + r32] = __builtin_amdgcn_rcpf(1.f + __expf(-(acc[r] + bias)));
        }
        float ss = 0.f;
#pragma unroll
        for (int w = 0; w < 4; ++w) {
          rr[2 * w] = lo16(pR[w]); rr[2 * w + 1] = hi16(pR[w]);
          kr[2 * w] = lo16(pK[w]); kr[2 * w + 1] = hi16(pK[w]);
        }
        const float vv[8] = {lo16(pV[0]), hi16(pV[0]), lo16(pV[1]), hi16(pV[1]), lo16(pV[2]), hi16(pV[2]), lo16(pV[3]), hi16(pV[3])};
        if (c + 1 < NCH) prefetch(c + 1);
#pragma unroll
        for (int e = 0; e < 8; ++e) VV[(pblk * 64 + j0 + e) * 4 + psb] = vv[e];
#pragma unroll
        for (int e = 0; e < 8; ++e) { kk[e] = kr[e] * kkc[e]; ss += kk[e] * kk[e]; }
        ss = red8(ss);
        const float inv = rsqrtf(fmaxf(ss, 1e-24f));
#pragma unroll
        for (int e = 0; e < 8; ++e) kk[e] *= inv;
      };
      auto stageB = [&](int c) {
        char* buf = lds + (c & 1) * SC_BUF;
        const f32x4 i0 = *(const f32x4*)(IC + pstep * 64 + j0), i1 = *(const f32x4*)(IC + pstep * 64 + j0 + 4);
        const float ic[8] = {i0[0], i0[1], i0[2], i0[3], i1[0], i1[1], i1[2], i1[3]};
        const float* Pt = (const float*)(buf + SC_P) + pstep * 64 + j0;
        const f32x4 pt0 = *(const f32x4*)(Pt), pt1 = *(const f32x4*)(Pt + 4);
        f32x4 pm0 = {1.f, 1.f, 1.f, 1.f}, pm1 = pm0;
        if (pstep > 0) { pm0 = *(const f32x4*)(Pt - 64); pm1 = *(const f32x4*)(Pt - 60); }
        const float pt[8] = {pt0[0], pt0[1], pt0[2], pt0[3], pt1[0], pt1[1], pt1[2], pt1[3]};
        const float pm[8] = {pm0[0], pm0[1], pm0[2], pm0[3], pm1[0], pm1[1], pm1[2], pm1[3]};
        const u32x4 an = {cvtpk(-kk[0] * pm[0], -kk[1] * pm[1]), cvtpk(-kk[2] * pm[2], -kk[3] * pm[3]), cvtpk(-kk[4] * pm[4], -kk[5] * pm[5]), cvtpk(-kk[6] * pm[6], -kk[7] * pm[7])};
        const u32x4 rn = {cvtpk(rr[0] * pt[0], rr[1] * pt[1]), cvtpk(rr[2] * pt[2], rr[3] * pt[3]), cvtpk(rr[4] * pt[4], rr[5] * pt[5]), cvtpk(rr[6] * pt[6], rr[7] * pt[7])};
        bf16_t* ARa = (bf16_t*)(buf + SC_ARA) + (pblk * 4 + psb) * 64; bf16_t* ARr = (bf16_t*)(buf + SC_ARR) + (pblk * 4 + psb) * 64;
        { u32x2 lo = {an[0], an[1]}, hi2 = {an[2], an[3]}; *(u32x2*)(ARa + apos0) = lo; *(u32x2*)(ARa + apos1) = hi2; }
        { u32x2 lo = {rn[0], rn[1]}, hi2 = {rn[2], rn[3]}; *(u32x2*)(ARr + apos0) = lo; *(u32x2*)(ARr + apos1) = hi2; }
        *(u32x4*)(SCR + (pstep * 4 + 0) * 64 + j0) = an; *(u32x4*)(SCR + (pstep * 4 + 1) * 64 + j0) = rn;
        float bs = 0.f;
        unsigned bq[8], kq[8];
        unsigned* BK = (unsigned*)(buf + SC_BK) + (pblk * 64 + j0) * 4 + psb;
#pragma unroll
        for (int e = 0; e < 8; ++e) {
          const float kd = kr[e] * (1.f + (ic[e] - 1.f) * kac[e]);
          const float ip = __builtin_amdgcn_rcpf(pt[e]);
          const unsigned pr2 = cvtpk(kk[e] * ic[e] * ip, kd * ip);
          BK[e * 4] = pr2;
          bq[e] = pr2 & 0xffffu; kq[e] = pr2 >> 16;
          bs += rr[e] * kd * rkc[e];
        }
        const u32x4 bn = {bq[0] | (bq[1] << 16), bq[2] | (bq[3] << 16), bq[4] | (bq[5] << 16), bq[6] | (bq[7] << 16)};
        const u32x4 kn = {kq[0] | (kq[1] << 16), kq[2] | (kq[3] << 16), kq[4] | (kq[5] << 16), kq[6] | (kq[7] << 16)};
        *(u32x4*)(SCR + (pstep * 4 + 2) * 64 + j0) = bn; *(u32x4*)(SCR + (pstep * 4 + 3) * 64 + j0) = kn;
        bs = red8(bs);
        if ((ptid & 7) == 0) Bg[(size_t)scan_row(c * 32 + pstep, d, b) * 16 + h] = bs;
      };
      auto stageC = [&](int c) {
        char* buf = lds + (c & 1) * SC_BUF;
        asm volatile("s_waitcnt lgkmcnt(0)" ::: "memory");
        const int n16 = lane & 15, q4 = lane >> 4;
        const int stepA = (2 * pw + (n16 >> 3)) * 4 + (n16 & 3);
        const bf16_t* Xr = SCR + (stepA * 4 + 2 + ((n16 >> 2) & 1)) * 64 + q4 * 8;
        const bf16_t* Yc = SCR + (stepA * 4 + ((n16 >> 2) & 1)) * 64 + q4 * 8;
        f32x4 g = {0.f, 0.f, 0.f, 0.f};
        g = MFMA16(*(const bf16x8*)(Xr), *(const bf16x8*)(Yc), g);
        g = MFMA16(*(const bf16x8*)(Xr + 32), *(const bf16x8*)(Yc + 32), g);
        const int ctype = (n16 >> 2) & 1, t0 = n16 & 3, rtype = q4 & 1;
        const int grp = ctype * 2 + rtype, base = grp == 0 ? 0 : (grp == 1 ? 6 : (grp == 2 ? 12 : 22));
        float* sc = (float*)(buf + SC_SCAL) + (2 * pw + (n16 >> 3)) * 32 + base + (ctype ? (t0 + 1) * t0 / 2 : t0 * (t0 - 1) / 2);
        if ((q4 >> 1) == (n16 >> 3)) {
#pragma unroll
          for (int e = 0; e < 4; ++e) if (ctype ? (e <= t0) : (e < t0)) sc[e] = g[e];
        }
      };
      auto writeout = [&](int c) {
        const float* Yb = (const float*)(lds + SC_YB + (c & 1) * 8192) + (pblk * 64 + j0) * 4 + psb;
        u32x4 w = {cvtpk(Yb[0], Yb[4]), cvtpk(Yb[8], Yb[12]), cvtpk(Yb[16], Yb[20]), cvtpk(Yb[24], Yb[28])};
        *(u32x4*)(Yg + (size_t)scan_row(c * 32 + pstep, d, b) * 1024 + h * 64 + j0) = w;
      };
      prefetch(0);
      stageA(0);
      __syncthreads();
      stageB(0); stageC(0);
      __syncthreads();
      for (int c = 0; c < NCH; ++c) {
        if (c >= 1) writeout(c - 1);
        if (c + 1 < NCH) stageA(c + 1);
        __syncthreads();
        if (c + 1 < NCH) { stageB(c + 1); stageC(c + 1); }
        __syncthreads();
      }
      writeout(NCH - 1);
    }
    __syncthreads();
  }
}

__device__ void phase_readout(const Params& p) {
  unsigned char* ws = p.ws;
  const bf16_t* Y0 = (const bf16_t*)(ws + OFF_Y0); const bf16_t* Y1 = (const bf16_t*)(ws + OFF_Y1); const bf16_t* Vg = (const bf16_t*)(ws + OFF_V);
  bf16_t* G = (bf16_t*)(ws + OFF_G);
  const float* B0 = (const float*)(ws + OFF_BONUS); const float* B1 = B0 + (size_t)NTOK * 16;
  const int lane = threadIdx.x & 63, gw = blockIdx.x * 8 + (threadIdx.x >> 6), nw = gridDim.x * 8;
  const int c0 = lane * 16, hd = lane >> 2;
  float lg[16], lb[16];
#pragma unroll
  for (int e = 0; e < 16; ++e) { lg[e] = p.in[18][c0 + e]; lb[e] = p.in[19][c0 + e]; }
  struct RowIn { u32x4 a[2], b[2], v[2], g[2]; float b0, b1; };
  auto ldr = [&](int n, RowIn& r) {
    const size_t o = (size_t)n * 1024 + c0;
#pragma unroll
    for (int q = 0; q < 2; ++q) { r.a[q] = *(const u32x4*)(Y0 + o + 8 * q); r.b[q] = *(const u32x4*)(Y1 + o + 8 * q); r.v[q] = *(const u32x4*)(Vg + o + 8 * q); r.g[q] = *(const u32x4*)(G + o + 8 * q); }
    r.b0 = B0[(size_t)n * 16 + hd]; r.b1 = B1[(size_t)n * 16 + hd];
  };
  RowIn cur, nxt;
  if (gw < NTOK) ldr(gw, cur);
  for (int n = gw; n < NTOK; n += nw) {
    if (n + nw < NTOK) ldr(n + nw, nxt);
    const size_t o = (size_t)n * 1024 + c0;
    float y[16], v[16], g[16];
#pragma unroll
    for (int q = 0; q < 2; ++q) {
#pragma unroll
      for (int w = 0; w < 4; ++w) {
        y[8 * q + 2 * w] = lo16(cur.a[q][w]) + lo16(cur.b[q][w]); y[8 * q + 2 * w + 1] = hi16(cur.a[q][w]) + hi16(cur.b[q][w]);
        v[8 * q + 2 * w] = lo16(cur.v[q][w]); v[8 * q + 2 * w + 1] = hi16(cur.v[q][w]);
        g[8 * q + 2 * w] = lo16(cur.g[q][w]); g[8 * q + 2 * w + 1] = hi16(cur.g[q][w]);
      }
    }
    float s = 0.f;
#pragma unroll
    for (int e = 0; e < 16; ++e) s += y[e];
    s += dpp_f(s, 0); s += dpp_f(s, 1);
    const float mean = s * (1.f / 64.f);
    float q2 = 0.f;
#pragma unroll
    for (int e = 0; e < 16; ++e) { const float dlt = y[e] - mean; q2 += dlt * dlt; }
    q2 += dpp_f(q2, 0); q2 += dpp_f(q2, 1);
    const float rs = rsqrtf(q2 * (1.f / 64.f) + 64e-5f);
    const float bonus = cur.b0 + cur.b1;
    float r[16];
#pragma unroll
    for (int e = 0; e < 16; ++e) {
      const float yn = (y[e] - mean) * rs * lg[e] + lb[e];
      r[e] = (yn + bonus * v[e]) * (g[e] * sigmoidf_(g[e]));
    }
    u32x4 w0 = {cvtpk(r[0], r[1]), cvtpk(r[2], r[3]), cvtpk(r[4], r[5]), cvtpk(r[6], r[7])};
    u32x4 w1 = {cvtpk(r[8], r[9]), cvtpk(r[10], r[11]), cvtpk(r[12], r[13]), cvtpk(r[14], r[15])};
    *(u32x4*)(G + o) = w0; *(u32x4*)(G + o + 8) = w1;
    cur = nxt;
  }
}

constexpr int AT_SHMV = 16384, AT_KROW = 208, AT_SHMK = 64 * AT_KROW;
constexpr int AT_KOFF = 2 * AT_SHMV, AT_WOFF = AT_KOFF + 2 * AT_SHMK;
#define SBAR() __builtin_amdgcn_sched_barrier(0)
__device__ __forceinline__ void at_partialSM(f32x16& p0, f32x16& p1, float& m_reg, float& alpha, bool force) {
  float pm = p0[0];
#pragma unroll
  for (int r = 1; r < 16; ++r) pm = fmaxf(pm, p0[r]);
#pragma unroll
  for (int r = 0; r < 16; ++r) pm = fmaxf(pm, p1[r]);
  { auto rr = __builtin_amdgcn_permlane32_swap(__float_as_uint(pm), __float_as_uint(pm), false, false);
    pm = fmaxf(__uint_as_float(rr[0]), __uint_as_float(rr[1])); }
  if (__builtin_expect(!force && __all(pm <= AT_THR * 1.4426950408889634f), 1)) { alpha = 1.f; }
  else {
    const float dlt = force ? pm : fmaxf(pm, 0.f);
    alpha = force ? 1.f : __builtin_amdgcn_exp2f(-dlt); m_reg += dlt;
#pragma unroll
    for (int r = 0; r < 16; ++r) { p0[r] -= dlt; p1[r] -= dlt; }
  }
#pragma unroll
  for (int r = 0; r < 16; ++r) p0[r] = __builtin_amdgcn_exp2f(p0[r]);
}
__device__ __forceinline__ void at_finishSM(f32x16& p0, f32x16& p1, float alpha, float& l_reg, bf16x8& pa0, bf16x8& pa1, bf16x8& pa2, bf16x8& pa3) {
#pragma unroll
  for (int r = 0; r < 16; ++r) p1[r] = __builtin_amdgcn_exp2f(p1[r]);
  float ps = 0;
#pragma unroll
  for (int r = 0; r < 16; ++r) ps += p0[r];
#pragma unroll
  for (int r = 0; r < 16; ++r) ps += p1[r];
  { auto rr = __builtin_amdgcn_permlane32_swap(__float_as_uint(ps), __float_as_uint(ps), false, false);
    ps = __uint_as_float(rr[0]) + __uint_as_float(rr[1]); }
  l_reg = l_reg * alpha + ps;
#define PK4(P, BASE, OUT) do { unsigned a0 = cvtpk(P[BASE + 0], P[BASE + 1]), a1 = cvtpk(P[BASE + 2], P[BASE + 3]);   \
    unsigned b0 = cvtpk(P[BASE + 4], P[BASE + 5]), b1 = cvtpk(P[BASE + 6], P[BASE + 7]);                              \
    auto r0 = __builtin_amdgcn_permlane32_swap(a0, b0, false, false); auto r1 = __builtin_amdgcn_permlane32_swap(a1, b1, false, false); \
    u32x4 w = {r0[0], r1[0], r0[1], r1[1]}; OUT = *reinterpret_cast<bf16x8*>(&w); } while (0)
  PK4(p0, 0, pa0); PK4(p0, 8, pa1); PK4(p1, 0, pa2); PK4(p1, 8, pa3);
#undef PK4
}
__device__ __forceinline__ void at_qkt(f32x16& p0, f32x16& p1, const char* Ks, const bf16x8* qr, int r32, int hi, float negm) {
#pragma unroll
  for (int r = 0; r < 16; ++r) { p0[r] = negm; p1[r] = negm; }
#pragma unroll
  for (int d0 = 0; d0 < 6; ++d0) {
    const bf16x8 b0 = *(const bf16x8*)(Ks + r32 * AT_KROW + d0 * 32 + hi * 16);
    const bf16x8 b1 = *(const bf16x8*)(Ks + (32 + r32) * AT_KROW + d0 * 32 + hi * 16);
    p0 = MFMA(b0, qr[d0], p0);
    p1 = MFMA(b1, qr[d0], p1);
  }
}
__device__ __forceinline__ int v_st(int k, int c) { const int kk = (k & ~0xC) | ((k & 4) << 1) | ((k & 8) >> 1); return ((kk >> 3) * 4 + (c >> 5)) * 512 + ((kk & 7) * 32 + (c & 31)) * 2; }
__device__ __forceinline__ int v_rd_base(int lane) { return ((lane & 3) << 3) | (((lane >> 2) & 3) << 6) | (((lane >> 4) & 1) << 5) | (((lane >> 5) & 1) << 8); }
constexpr int v_rd_off(int d0, int ks, int half) { return d0 * 512 + ks * 4096 + half * 2048; }
template <int OFF> __device__ __forceinline__ s16x4 tr_read(int vb) {
  s16x4 r; asm volatile("ds_read_b64_tr_b16 %0, %1 offset:%2" : "=&v"(r) : "v"(vb), "i"(OFF) : "memory"); return r;
}
template <int D0> __device__ __forceinline__ void pv_one(f32x16& od, int vb, bf16x8 pa0, bf16x8 pa1, bf16x8 pa2, bf16x8 pa3) {
  const s16x4 l0 = tr_read<v_rd_off(D0, 0, 0)>(vb), h0 = tr_read<v_rd_off(D0, 0, 1)>(vb), l1 = tr_read<v_rd_off(D0, 1, 0)>(vb), h1 = tr_read<v_rd_off(D0, 1, 1)>(vb);
  const s16x4 l2 = tr_read<v_rd_off(D0, 2, 0)>(vb), h2 = tr_read<v_rd_off(D0, 2, 1)>(vb), l3 = tr_read<v_rd_off(D0, 3, 0)>(vb), h3 = tr_read<v_rd_off(D0, 3, 1)>(vb);
  asm volatile("s_waitcnt lgkmcnt(0)" ::: "memory"); SBAR();
#define PK(Lx, Hx) (bf16x8){Lx[0], Lx[1], Lx[2], Lx[3], Hx[0], Hx[1], Hx[2], Hx[3]}
  od = MFMA(pa0, PK(l0, h0), od);
  od = MFMA(pa1, PK(l1, h1), od);
  od = MFMA(pa2, PK(l2, h2), od);
  od = MFMA(pa3, PK(l3, h3), od);
#undef PK
}
__device__ __forceinline__ void pv_d0(f32x16* o, int vb, bf16x8 pa0, bf16x8 pa1, bf16x8 pa2, bf16x8 pa3) {
  pv_one<0>(o[0], vb, pa0, pa1, pa2, pa3); pv_one<1>(o[1], vb, pa0, pa1, pa2, pa3);
}

__device__ void phase_attn(const Params& p, char* lds) {
  unsigned char* ws = p.ws;
  const bf16_t* Qg = (const bf16_t*)(ws + OFF_Q); const bf16_t* KVg = (const bf16_t*)(ws + OFF_KV); const bf16_t* KPg = (const bf16_t*)(ws + OFF_KPE);
  bf16_t* G1 = (bf16_t*)(ws + OFF_G1);
  const f32x2* rope = (const f32x2*)(ws + OFF_ROPE);
  const int tid = threadIdx.x, wid = tid >> 6, lane = tid & 63, r32 = lane & 31, hi = lane >> 5;
  char* V_lds = lds; char* K_lds = lds + AT_KOFF;
  float* wsl = (float*)(lds + AT_WOFF) + wid * 64; float* li_l = wsl; float* al_l = wsl + 32;
  const int skey = tid >> 3, sc8 = (tid & 7) * 8;
  const int pkey = (tid & 255) >> 2, pc8 = (tid & 3) * 8;
  const int vst = v_st(skey, sc8), kst = skey * AT_KROW + sc8 * 2, pst = pkey * AT_KROW + (64 + pc8) * 2;
  const int vb0 = (int)(uintptr_t)V_lds + v_rd_base(lane);
  const int nitems = NB * 16 * 32;
  const int xcd = blockIdx.x & 7, slot = blockIdx.x >> 3, per = gridDim.x >> 3;
  for (int it = slot; it < nitems / 8; it += per) {
    const int pair = (it >> 5) * 8 + xcd, qblk = it & 31;
    const int b = pair >> 4, h = pair & 15;
    const size_t row0 = (size_t)b * TL;
    const size_t qrow = row0 + qblk * 256 + wid * 32 + r32;
    const bf16_t* Kh = KVg + row0 * 2048 + h * 128;
    const bf16_t* Kp = KPg + row0 * 32;
    float m_reg = 0.f, l_reg = 0.f;
    f32x16 o[2];
#pragma unroll
    for (int dd = 0; dd < 2; ++dd)
#pragma unroll
      for (int r = 0; r < 16; ++r) o[dd][r] = 0.f;
    bf16x8 qr[6];
    {
      const bf16_t* Qw = Qg + qrow * 1536 + h * 96 + hi * 8;
#pragma unroll
      for (int d0 = 0; d0 < 6; ++d0) qr[d0] = *(const bf16x8*)(Qw + d0 * 16);
      const int t = qblk * 256 + wid * 32 + r32;
      const f32x2* tb = rope + (hi ? (t & 63) : (t >> 6)) * 8;
      const u32x4 x1 = *(const u32x4*)&qr[4], x2 = *(const u32x4*)&qr[5];
      u32x4 n1, n2;
#pragma unroll
      for (int q = 0; q < 4; ++q) {
        const f32x2 csA = tb[2 * q], csB = tb[2 * q + 1];
        const float a0 = lo16(x1[q]), a1 = hi16(x1[q]), b0 = lo16(x2[q]), b1 = hi16(x2[q]);
        n1[q] = cvtpk(a0 * csA[0] - b0 * csA[1], a1 * csB[0] - b1 * csB[1]);
        n2[q] = cvtpk(a0 * csA[1] + b0 * csA[0], a1 * csB[1] + b1 * csB[0]);
      }
      qr[4] = *(bf16x8*)&n1; qr[5] = *(bf16x8*)&n2;
    }
    struct { bf16x8 vs, ks, ps; } sr_[2];
#define SLOAD(i, k0) do { sr_[i].vs = *(const bf16x8*)(Kh + (size_t)((k0) + skey) * 2048 + 64 + sc8); \
    sr_[i].ks = *(const bf16x8*)(Kh + (size_t)((k0) + skey) * 2048 + sc8); \
    sr_[i].ps = *(const bf16x8*)(Kp + (size_t)((k0) + pkey) * 32 + pc8); } while (0)
#define SWRITE(bb, i) do { *(bf16x8*)(V_lds + (bb) * AT_SHMV + vst) = sr_[i].vs; \
    *(bf16x8*)(K_lds + (bb) * AT_SHMK + kst) = sr_[i].ks; \
    *(bf16x8*)(K_lds + (bb) * AT_SHMK + pst) = sr_[i].ps; } while (0)
#define SWAIT() asm volatile("s_waitcnt vmcnt(3)" ::: "memory")
#define RESC(a) do { if (__any((a) < 1.f)) { if (hi == 0) al_l[r32] = (a); asm volatile("s_waitcnt lgkmcnt(0)" ::: "memory"); \
    _Pragma("unroll") for (int dd = 0; dd < 2; ++dd) _Pragma("unroll") for (int r = 0; r < 16; ++r) o[dd][r] *= al_l[crow(r, hi)]; } } while (0)
    f32x16 pA0, pA1, pB0, pB1; float alA, alB; bf16x8 pa0, pa1, pa2, pa3;
    constexpr int NT = TL / 64;
    SLOAD(0, 0); asm volatile("s_waitcnt vmcnt(0)" ::: "memory"); SWRITE(0, 0); __syncthreads();
    at_qkt(pA0, pA1, K_lds, qr, r32, hi, 0.f); at_partialSM(pA0, pA1, m_reg, alA, true);
    SLOAD(1, 64); SLOAD(0, 128);
    SWAIT(); SWRITE(1, 1); __syncthreads();
    for (int j = 1; j + 1 < NT; j += 2) {
      SBAR(); at_qkt(pB0, pB1, K_lds + AT_SHMK, qr, r32, hi, -m_reg);
      at_finishSM(pA0, pA1, alA, l_reg, pa0, pa1, pa2, pa3); SBAR();
      SLOAD(1, (j + 2) * 64); SBAR();
      pv_d0(o, vb0, pa0, pa1, pa2, pa3); at_partialSM(pB0, pB1, m_reg, alB, false);
      __syncthreads(); SWAIT(); SWRITE(0, 0);
      RESC(alB); __syncthreads();
      SBAR(); at_qkt(pA0, pA1, K_lds, qr, r32, hi, -m_reg);
      at_finishSM(pB0, pB1, alB, l_reg, pa0, pa1, pa2, pa3); SBAR();
      if (j + 3 < NT) SLOAD(0, (j + 3) * 64); SBAR();
      pv_d0(o, vb0 + AT_SHMV, pa0, pa1, pa2, pa3); at_partialSM(pA0, pA1, m_reg, alA, false);
      __syncthreads(); SWAIT(); SWRITE(1, 1);
      RESC(alA); __syncthreads();
    }
    SBAR(); at_qkt(pB0, pB1, K_lds + AT_SHMK, qr, r32, hi, -m_reg);
    at_finishSM(pA0, pA1, alA, l_reg, pa0, pa1, pa2, pa3); SBAR();
    pv_d0(o, vb0, pa0, pa1, pa2, pa3); at_partialSM(pB0, pB1, m_reg, alB, false);
    __syncthreads(); RESC(alB);
    at_finishSM(pB0, pB1, alB, l_reg, pa0, pa1, pa2, pa3); SBAR();
    pv_d0(o, vb0 + AT_SHMV, pa0, pa1, pa2, pa3);
    if (hi == 0) li_l[r32] = l_reg;
    asm volatile("s_waitcnt lgkmcnt(0)" ::: "memory");
    float rli[16];
#pragma unroll
    for (int r = 0; r < 16; ++r) rli[r] = __builtin_amdgcn_rcpf(li_l[crow(r, hi)]);
    bf16_t* Gw = G1 + (row0 + qblk * 256 + wid * 32) * 1024 + h * 64 + r32;
    bf16_t gin[32];
#pragma unroll
    for (int r = 0; r < 16; ++r) { gin[2 * r] = Gw[(size_t)crow(r, hi) * 1024]; gin[2 * r + 1] = Gw[(size_t)crow(r, hi) * 1024 + 32]; }
    asm volatile("" ::: "memory");
#pragma unroll
    for (int r = 0; r < 16; ++r) {
      const int orow = crow(r, hi);
#pragma unroll
      for (int d0 = 0; d0 < 2; ++d0) {
        const float gt = bf2f(gin[2 * r + d0]);
        Gw[(size_t)orow * 1024 + d0 * 32] = f2bf(o[d0][r] * rli[r] * gt * sigmoidf_(gt));
      }
    }
    __syncthreads();
#undef SLOAD
#undef SWRITE
#undef SWAIT
#undef RESC
  }
}

struct XcdWalk {
  int start, count, step, idx;
  __device__ __forceinline__ void init(int ntiles) {
    const int x = blockIdx.x & 7, base = ntiles >> 3, rem = ntiles & 7;
    count = base + (x < rem ? 1 : 0); start = x * base + (x < rem ? x : rem); step = gridDim.x >> 3; idx = blockIdx.x >> 3;
  }
  __device__ __forceinline__ bool next(int& o) { if (idx >= count) return false; o = start + idx; idx += step; return true; }
};
__device__ __forceinline__ void tile_mn(int o, int NT, int& mt, int& nt) { const int g = o >> 3; mt = (g / NT) * 8 + (o & 7); nt = g % NT; }

__global__ __launch_bounds__(NTHR, 1) void fwd_megakernel(Params p) {
  extern __shared__ __attribute__((aligned(16))) char lds[];
  cg::grid_group grid = cg::this_grid();
  unsigned char* ws = p.ws;
  bf16_t* H = (bf16_t*)(ws + OFF_H);
  float* mod = (float*)(ws + OFF_MOD);
  float* CTX1 = (float*)(ws + OFF_CTX1);

  phase_prologue(p, lds);
  grid.sync();
  phase_norm_lerp(p, mod);
  phase_weights(p, lds);
  grid.sync();
  {
    const bf16_t* WIN0 = (const bf16_t*)(ws + OFF_WIN0);
    const int nbig = 264 * 16;
    XcdWalk wk; wk.init(nbig); int o;
    while (wk.next(o)) {
      EpiBf16 e; e.invK = 0.f;
      {
        int mt, jn; tile_mn(o, 16, mt, jn);
        const int j = jn >> 2, n4 = jn & 3, m0 = mt * 256;
        e.dst = (bf16_t*)(ws + OFF_R + (size_t)j * U); e.ldd = 1024; e.col0 = n4 * 256; e.act = 0; e.m0 = m0;
        gemm_tile<0, 256>(lerp_base(p, j, m0), 1024, WIN0 + (size_t)(j * 1024 + n4 * 256) * 1024, 1024, m0, nullptr, lds, e);
      }
    }
    wk.init(264 * 2);
    while (wk.next(o)) {
      EpiBf16 e; e.invK = 0.f;
      {
        int mt, n2; tile_mn(o, 2, mt, n2);
        const int nt = 32 + n2, m0 = mt * 256;
        e.dst = (bf16_t*)(ws + OFF_LORA); e.ldd = 256; e.col0 = (nt - 32) * 128; e.act = (nt == 32) ? 1 : 0; e.m0 = m0;
        gemm_tile<1, 128>(H, 1024, WIN0 + (size_t)nt * 128 * 1024, 1024, m0, p.in[7] + (nt - 28) * 1024, lds, e);
      }
    }
  }
  grid.sync();
  phase_scan(p, lds);
  grid.sync();
  phase_readout(p);
  grid.sync();
  {
    const bf16_t* A = (const bf16_t*)(ws + OFF_G); const bf16_t* W = (const bf16_t*)(ws + OFF_WOUT0);
    XcdWalk wk; wk.init(264 * 4); int o;
    while (wk.next(o)) {
      int mt, nt; tile_mn(o, 4, mt, nt);
      const int m0 = mt * 256;
      const int b = m0 / TL, t0 = m0 - b * TL;
      EpiResid e;
      if (t0 < T) { const size_t orow = (size_t)b * T + t0; e.xin = p.in[0] + orow * 1024; e.xout = p.out + orow * 1024; e.gvec = mod + (size_t)b * 3072 + 2048; }
      else { const size_t orow = (size_t)b * L + (t0 - T); e.xin = p.in[2] + orow * 1024; e.xout = CTX1 + orow * 1024; e.gvec = mod + (size_t)8 * 3072 + 2048; }
      e.n0 = nt * 256; e.scr = lds + (256 + 256) * G_LDT;
      gemm_tile<0, 256>(A, 1024, W + (size_t)nt * 256 * 1024, 1024, m0, nullptr, lds, e);
    }
  }
  grid.sync();
  phase_norm(p.out, CTX1, p.in[4] + 1024, mod + 9 * 3072, H);
  grid.sync();
  {
    const bf16_t* W = (const bf16_t*)(ws + OFF_WIN1);
    XcdWalk wk; wk.init(264 * 7); int o;
    while (wk.next(o)) {
      int mt, nt; tile_mn(o, 7, mt, nt);
      const int m0 = mt * 256;
      EpiMlaIn e; e.QC = (bf16_t*)(ws + OFF_QC); e.KVC = (bf16_t*)(ws + OFF_KVC); e.KPE = (bf16_t*)(ws + OFF_KPE); e.G1 = (bf16_t*)(ws + OFF_G1);
      e.rope = (const float*)(ws + OFF_ROPE); e.n0 = nt * 256; e.m0 = m0;
      gemm_tile<0, 256>(H, 1024, W + (size_t)nt * 256 * 1024, 1024, m0, nullptr, lds, e);
    }
  }
  grid.sync();
  {
    const bf16_t* WQ = (const bf16_t*)(ws + OFF_WQB); const bf16_t* WKV = (const bf16_t*)(ws + OFF_WKVB);
    const int nq = 256 * 6, nkv = 264 * 8;
    XcdWalk wk; wk.init(nq); int o;
    while (wk.next(o)) {
      EpiBf16 e; e.act = 0;
      {
        int mt2, nt; tile_mn(o, 6, mt2, nt);
        const int b = mt2 >> 5, m0 = b * TL + (mt2 & 31) * 256;
        e.dst = (bf16_t*)(ws + OFF_Q); e.ldd = 1536; e.col0 = nt * 256; e.m0 = m0; e.invK = 1.f / 384.f;
        gemm_tile<2, 256>((const bf16_t*)(ws + OFF_QC), 384, WQ + (size_t)nt * 256 * 384, 384, m0, nullptr, lds, e);
      }
    }
    wk.init(nkv);
    while (wk.next(o)) {
      EpiBf16 e; e.act = 0;
      {
        int mt, nt; tile_mn(o, 8, mt, nt);
        const int m0 = mt * 256;
        e.dst = (bf16_t*)(ws + OFF_KV); e.ldd = 2048; e.col0 = nt * 256; e.m0 = m0; e.invK = 1.f / 256.f;
        gemm_tile<2, 256>((const bf16_t*)(ws + OFF_KVC), 256, WKV + (size_t)nt * 256 * 256, 256, m0, nullptr, lds, e);
      }
    }
  }
  grid.sync();
  phase_attn(p, lds);
  grid.sync();
  {
    const bf16_t* A = (const bf16_t*)(ws + OFF_G1); const bf16_t* W = (const bf16_t*)(ws + OFF_WOUT1);
    XcdWalk wk; wk.init(256 * 4); int o;
    while (wk.next(o)) {
      int mt2, nt; tile_mn(o, 4, mt2, nt);
      const int b = mt2 >> 5, t0 = (mt2 & 31) * 256, m0 = b * TL + t0;
      const size_t orow = (size_t)b * T + t0;
      EpiResid e; e.xin = p.out + orow * 1024; e.xout = p.out + orow * 1024; e.gvec = mod + (size_t)(9 + b) * 3072 + 2048; e.n0 = nt * 256; e.scr = lds + (256 + 256) * G_LDT;
      gemm_tile<0, 256>(A, 1024, W + (size_t)nt * 256 * 1024, 1024, m0, nullptr, lds, e);
    }
  }
  grid.sync();
  phase_final(p.out, p.in[27]);
}

extern "C" void kernel_launch(void* const* d_in, const int* in_sizes, int n_in, void* d_out, int out_size, void* d_ws, size_t ws_size, hipStream_t stream) {
  static int grid_blocks = 0;
  if (grid_blocks == 0) {
    if (n_in != 28 || ws_size < WS_END + (size_t)(NTOK - LERP3_SPLIT) * 2048 || out_size != NB * T * D) { fprintf(stderr, "kernel_launch: unexpected shapes (n_in %d, ws %zu need %zu, out %d)\n", n_in, ws_size, (size_t)WS_END, out_size); grid_blocks = -1; return; }
    int dev = 0, cus = 0, per_cu = 0;
    hipGetDevice(&dev);
    hipDeviceGetAttribute(&cus, hipDeviceAttributeMultiprocessorCount, dev);
    if (hipFuncSetAttribute((const void*)fwd_megakernel, hipFuncAttributeMaxDynamicSharedMemorySize, LDS_BYTES) != hipSuccess) { fprintf(stderr, "kernel_launch: hipFuncSetAttribute failed\n"); grid_blocks = -1; return; }
    hipOccupancyMaxActiveBlocksPerMultiprocessor(&per_cu, (const void*)fwd_megakernel, NTHR, LDS_BYTES);
    if (per_cu < 1) { fprintf(stderr, "kernel_launch: occupancy query says %d blocks per CU\n", per_cu); per_cu = 1; }
    (void)hipGetLastError();
    grid_blocks = cus;
    if (grid_blocks > 256) grid_blocks = 256;
    grid_blocks &= ~7;
  }
  if (grid_blocks <= 0) return;
  Params p{};
  for (int i = 0; i < 28; ++i) p.in[i] = (const float*)d_in[i];
  p.out = (float*)d_out; p.ws = (unsigned char*)d_ws;
  void* args[] = {&p};
  hipError_t e = hipLaunchCooperativeKernel((const void*)fwd_megakernel, dim3(grid_blocks), dim3(NTHR), args, LDS_BYTES, stream);
  if (e != hipSuccess) fprintf(stderr, "cooperative launch failed: %s (grid %d)\n", hipGetErrorString(e), grid_blocks);
}
```

```cpp
#include <hip/hip_runtime.h>
#include <hip/hip_cooperative_groups.h>
#include <cstdio>
#include <cstdint>
namespace cg = cooperative_groups;

typedef unsigned short bf16_t;
typedef short bf16x8 __attribute__((ext_vector_type(8)));
typedef short s16x4 __attribute__((ext_vector_type(4)));
typedef float f32x16 __attribute__((ext_vector_type(16)));
typedef float f32x4 __attribute__((ext_vector_type(4)));
typedef float f32x2 __attribute__((ext_vector_type(2)));
typedef unsigned u32x4 __attribute__((ext_vector_type(4)));
typedef unsigned u32x2 __attribute__((ext_vector_type(2)));

constexpr int D = 1024, NB = 8, T = 8192, L = 256, TL = T + L, NTOK = NB * TL;
constexpr int NTHR = 512;

constexpr size_t U = (size_t)NTOK * 1024 * 2;
constexpr size_t OFF_H = 0, OFF_R = U, OFF_K = 2 * U, OFF_V = 3 * U, OFF_G = 4 * U, OFF_Y0 = 5 * U, OFF_Y1 = 6 * U;
constexpr size_t OFF_LORA = 7 * U;
constexpr size_t OFF_BONUS = OFF_LORA + (size_t)NTOK * 256 * 2;
constexpr size_t OFF_WIN0 = OFF_BONUS + (size_t)2 * NTOK * 16 * 4;
constexpr size_t OFF_WOUT0 = OFF_WIN0 + (size_t)4352 * 1024 * 2;
constexpr size_t OFF_WIN1 = OFF_WOUT0 + (size_t)1024 * 1024 * 2;
constexpr size_t OFF_WQB = OFF_WIN1 + (size_t)1792 * 1024 * 2;
constexpr size_t OFF_WKVB = OFF_WQB + (size_t)1536 * 384 * 2;
constexpr size_t OFF_WOUT1 = OFF_WKVB + (size_t)2048 * 256 * 2;
constexpr size_t OFF_MOD = OFF_WOUT1 + (size_t)1024 * 1024 * 2;
constexpr size_t OFF_ROPE = OFF_MOD + (size_t)2 * 9 * 3072 * 4;
constexpr size_t OFF_CTX1 = OFF_ROPE + (size_t)128 * 8 * 2 * 4;
constexpr size_t WS_END = OFF_CTX1 + (size_t)2048 * 1024 * 4;
constexpr size_t OFF_QC = OFF_V;
constexpr size_t OFF_KVC = OFF_QC + (size_t)NTOK * 384 * 2;
constexpr size_t OFF_KPE = OFF_KVC + (size_t)NTOK * 256 * 2;
constexpr size_t OFF_G1 = OFF_G;
constexpr size_t OFF_Q = OFF_R;
constexpr size_t OFF_KV = OFF_Y0;

struct Params { const float* in[28]; float* out; unsigned char* ws; };

typedef __bf16 bf16x2_t __attribute__((ext_vector_type(2)));
__device__ __forceinline__ unsigned cvtpk(float lo, float hi) { f32x2 v = {lo, hi}; bf16x2_t b = __builtin_convertvector(v, bf16x2_t); return *(unsigned*)&b; }
__device__ __forceinline__ float bf2f(bf16_t u) { return __uint_as_float(((unsigned)u) << 16); }
__device__ __forceinline__ bf16_t f2bf(float f) { return (bf16_t)(cvtpk(f, 0.f) & 0xffffu); }
__device__ __forceinline__ float lo16(unsigned w) { return __uint_as_float(w << 16); }
__device__ __forceinline__ float hi16(unsigned w) { return __uint_as_float(w & 0xffff0000u); }
__device__ __forceinline__ void st_bf16x4(bf16_t* p, float a, float b, float c, float d) { u32x2 w = {cvtpk(a, b), cvtpk(c, d)}; *(u32x2*)p = w; }
__device__ __forceinline__ void st_bf16x4_nt(bf16_t* p, float a, float b, float c, float d) { u32x2 w = {cvtpk(a, b), cvtpk(c, d)}; __builtin_nontemporal_store(w, (u32x2*)p); }
__device__ __forceinline__ float wave_sum(float v) {
#pragma unroll
  for (int o = 32; o; o >>= 1) v += __shfl_xor(v, o);
  return v;
}
__device__ __forceinline__ float dpp_f(float v, const int ctrl_sel) {
  int r;
  if (ctrl_sel == 0) r = __builtin_amdgcn_update_dpp(0, __float_as_int(v), 0xB1, 0xF, 0xF, true);
  else if (ctrl_sel == 1) r = __builtin_amdgcn_update_dpp(0, __float_as_int(v), 0x4E, 0xF, 0xF, true);
  else r = __builtin_amdgcn_update_dpp(0, __float_as_int(v), 0x141, 0xF, 0xF, true);
  return __int_as_float(r);
}
__device__ __forceinline__ float red8(float v) { v += dpp_f(v, 0); v += dpp_f(v, 1); v += dpp_f(v, 2); return v; }
__device__ __forceinline__ int crow(int r, int hi) { return (r & 3) + 8 * (r >> 2) + 4 * hi; }
__device__ __forceinline__ float sigmoidf_(float x) { return 1.f / (1.f + __expf(-x)); }
#define MFMA(a, b, c) __builtin_amdgcn_mfma_f32_32x32x16_bf16((a), (b), (c), 0, 0, 0)

constexpr int G_LDT = 144;
constexpr int G_SSQ_OFF = 2 * (256 + 256) * G_LDT;
constexpr int LDS_BYTES = G_SSQ_OFF + 1024;

template <int AMODE, int BN, class Epi>
__device__ __forceinline__ void gemm_tile(const bf16_t* A, const int lda, const bf16_t* Bt, const int K, const int m0, const float* mu, char* lds, const Epi& epi) {
  constexpr int WN = BN / 64, MI = WN, NBR = BN / 64, G_STAGE = (256 + BN) * G_LDT;
  const int tid = threadIdx.x, lane = tid & 63, wid = tid >> 6, r32 = lane & 31, hi = lane >> 5;
  const int wm = wid / WN, wn = wid % WN;
  const int srow = tid >> 3, scc = (tid & 7) * 8;
  int browi[NBR];
#pragma unroll
  for (int i = 0; i < NBR; ++i) browi[i] = 64 * i + ((Epi::PERM && !epi.natural_group(64 * i + srow)) ? ((srow & 32) + 16 * ((srow >> 2) & 1) + 4 * ((srow & 31) >> 3) + (srow & 3)) : srow);
  f32x16 acc[MI][2];
#pragma unroll
  for (int i = 0; i < MI; ++i)
#pragma unroll
    for (int j = 0; j < 2; ++j)
#pragma unroll
      for (int r = 0; r < 16; ++r) acc[i][j][r] = 0.f;
  bf16x8 ra[4], rb[NBR], rp[4], rn[4];
  float ssq[4] = {0.f, 0.f, 0.f, 0.f};
  int dprev[4], dnext[4];
  if constexpr (AMODE == 1) {
    const int t0 = m0 % TL;
#pragma unroll
    for (int i = 0; i < 4; ++i) { const int t = t0 + srow + 64 * i; dprev[i] = (t != 0 && t != T) ? 1 : 0; dnext[i] = (t != T - 1 && t != TL - 1) ? 1 : 0; }
  }
  auto gload = [&](int k0) {
#pragma unroll
    for (int i = 0; i < 4; ++i) {
      const bf16_t* ap = A + (size_t)(m0 + srow + 64 * i) * lda + k0 + scc;
      ra[i] = *(const bf16x8*)ap;
      if constexpr (AMODE == 1) { rp[i] = *(const bf16x8*)(ap - dprev[i] * lda); rn[i] = *(const bf16x8*)(ap + dnext[i] * lda); }
    }
#pragma unroll
    for (int i = 0; i < NBR; ++i) rb[i] = *(const bf16x8*)(Bt + (size_t)browi[i] * K + k0 + scc);
  };
  auto lstore = [&](int s, int k0) {
    char* base = lds + s * G_STAGE;
    if constexpr (AMODE == 1) {
      const f32x4 m0v = *(const f32x4*)(mu + k0 + scc), m1v = *(const f32x4*)(mu + k0 + scc + 4);
      const float mm[8] = {m0v[0], m0v[1], m0v[2], m0v[3], m1v[0], m1v[1], m1v[2], m1v[3]};
#pragma unroll
      for (int i = 0; i < 4; ++i) {
        const u32x4 hc = *(const u32x4*)&ra[i], hp = *(const u32x4*)&rp[i], hn = *(const u32x4*)&rn[i];
        const float fp = dprev[i] ? 0.5f : 0.f, fn = dnext[i] ? 0.5f : 0.f;
        u32x4 w;
#pragma unroll
        for (int q = 0; q < 4; ++q) {
          const float c0 = lo16(hc[q]), c1 = hi16(hc[q]);
          const float x0 = fp * lo16(hp[q]) + fn * lo16(hn[q]) - c0, x1 = fp * hi16(hp[q]) + fn * hi16(hn[q]) - c1;
          w[q] = cvtpk(c0 + x0 * mm[2 * q], c1 + x1 * mm[2 * q + 1]);
        }
        *(u32x4*)(base + (srow + 64 * i) * G_LDT + scc * 2) = w;
      }
    } else {
#pragma unroll
      for (int i = 0; i < 4; ++i) {
        *(bf16x8*)(base + (srow + 64 * i) * G_LDT + scc * 2) = ra[i];
        if constexpr (AMODE == 2) {
          const u32x4 hc = *(const u32x4*)&ra[i];
#pragma unroll
          for (int q = 0; q < 4; ++q) { const float c0 = lo16(hc[q]), c1 = hi16(hc[q]); ssq[i] += c0 * c0 + c1 * c1; }
        }
      }
    }
#pragma unroll
    for (int i = 0; i < NBR; ++i) *(bf16x8*)(base + 256 * G_LDT + (srow + 64 * i) * G_LDT + scc * 2) = rb[i];
  };
  const int nk = K >> 6;
  gload(0);
  lstore(0, 0);
  if (nk > 1) gload(64);
  __syncthreads();
#pragma unroll 1
  for (int kt = 0; kt < nk; ++kt) {
    const int s = kt & 1;
    if (kt + 1 < nk) lstore(s ^ 1, (kt + 1) * 64);
    if (kt + 2 < nk) gload((kt + 2) * 64);
    {
      const char* Ab = lds + s * G_STAGE + (wm * (32 * MI) + r32) * G_LDT + hi * 16;
      const char* Bb = lds + s * G_STAGE + 256 * G_LDT + (wn * 64 + r32) * G_LDT + hi * 16;
      bf16x8 fb[2][2], fa[2][MI];
      fb[0][0] = *(const bf16x8*)(Bb); fb[0][1] = *(const bf16x8*)(Bb + 32 * G_LDT);
#pragma unroll
      for (int mi = 0; mi < MI; ++mi) fa[0][mi] = *(const bf16x8*)(Ab + mi * 32 * G_LDT);
#pragma unroll
      for (int ks = 0; ks < 4; ++ks) {
        const int sl = ks & 1;
        if (ks + 1 < 4) {
          fb[sl ^ 1][0] = *(const bf16x8*)(Bb + (ks + 1) * 32); fb[sl ^ 1][1] = *(const bf16x8*)(Bb + 32 * G_LDT + (ks + 1) * 32);
#pragma unroll
          for (int mi = 0; mi < MI; ++mi) fa[sl ^ 1][mi] = *(const bf16x8*)(Ab + mi * 32 * G_LDT + (ks + 1) * 32);
        }
#pragma unroll
        for (int mi = 0; mi < MI; ++mi) { acc[mi][0] = MFMA(fb[sl][0], fa[sl][mi], acc[mi][0]); acc[mi][1] = MFMA(fb[sl][1], fa[sl][mi], acc[mi][1]); }
      }
    }
    __syncthreads();
  }
  float* ssq_l = (float*)(lds + G_SSQ_OFF);
  if constexpr (AMODE == 2) {
#pragma unroll
    for (int i = 0; i < 4; ++i) { const float v = red8(ssq[i]); if ((tid & 7) == 0) ssq_l[srow + 64 * i] = v; }
    __syncthreads();
  }
#pragma unroll
  for (int mi = 0; mi < MI; ++mi) {
    const int lrow = wm * (32 * MI) + mi * 32 + r32;
    float aux = 0.f;
    if constexpr (AMODE == 2) aux = ssq_l[lrow];
    epi(lrow, wn * 64 + 4 * hi, acc[mi][0], acc[mi][1], aux);
  }
}

constexpr int G_EPI_SCR = (256 + 256) * G_LDT;
struct EpiBf16 {
  static constexpr bool PERM = true;
  __device__ __forceinline__ bool natural_group(int) const { return false; }
  bf16_t* dst; int ldd; int col0; int m0; int act; float invK; char* scr;
  __device__ __forceinline__ void operator()(int lrow, int nc, const f32x16& a0, const f32x16& a1, float aux) const {
    const int lane = threadIdx.x & 63, wid = threadIdx.x >> 6, r32 = lane & 31, hi = lane >> 5;
    float sc = 1.f;
    if (invK > 0.f) sc = rsqrtf(aux * invK + 1e-6f);
    char* sp = scr + wid * (32 * 144);
    char* wp = sp + r32 * 144 + 32 * hi;
    if (act) {
#define TANH_(x) (1.f - 2.f / (__expf(2.f * (x) * sc) + 1.f))
      const u32x4 w0 = {cvtpk(TANH_(a0[0]), TANH_(a0[1])), cvtpk(TANH_(a0[2]), TANH_(a0[3])), cvtpk(TANH_(a0[4]), TANH_(a0[5])), cvtpk(TANH_(a0[6]), TANH_(a0[7]))};
      const u32x4 w1 = {cvtpk(TANH_(a0[8]), TANH_(a0[9])), cvtpk(TANH_(a0[10]), TANH_(a0[11])), cvtpk(TANH_(a0[12]), TANH_(a0[13])), cvtpk(TANH_(a0[14]), TANH_(a0[15]))};
      const u32x4 w2 = {cvtpk(TANH_(a1[0]), TANH_(a1[1])), cvtpk(TANH_(a1[2]), TANH_(a1[3])), cvtpk(TANH_(a1[4]), TANH_(a1[5])), cvtpk(TANH_(a1[6]), TANH_(a1[7]))};
      const u32x4 w3 = {cvtpk(TANH_(a1[8]), TANH_(a1[9])), cvtpk(TANH_(a1[10]), TANH_(a1[11])), cvtpk(TANH_(a1[12]), TANH_(a1[13])), cvtpk(TANH_(a1[14]), TANH_(a1[15]))};
#undef TANH_
      *(u32x4*)(wp) = w0; *(u32x4*)(wp + 16) = w1; *(u32x4*)(wp + 64) = w2; *(u32x4*)(wp + 80) = w3;
    } else {
      const u32x4 w0 = {cvtpk(a0[0] * sc, a0[1] * sc), cvtpk(a0[2] * sc, a0[3] * sc), cvtpk(a0[4] * sc, a0[5] * sc), cvtpk(a0[6] * sc, a0[7] * sc)};
      const u32x4 w1 = {cvtpk(a0[8] * sc, a0[9] * sc), cvtpk(a0[10] * sc, a0[11] * sc), cvtpk(a0[12] * sc, a0[13] * sc), cvtpk(a0[14] * sc, a0[15] * sc)};
      const u32x4 w2 = {cvtpk(a1[0] * sc, a1[1] * sc), cvtpk(a1[2] * sc, a1[3] * sc), cvtpk(a1[4] * sc, a1[5] * sc), cvtpk(a1[6] * sc, a1[7] * sc)};
      const u32x4 w3 = {cvtpk(a1[8] * sc, a1[9] * sc), cvtpk(a1[10] * sc, a1[11] * sc), cvtpk(a1[12] * sc, a1[13] * sc), cvtpk(a1[14] * sc, a1[15] * sc)};
      *(u32x4*)(wp) = w0; *(u32x4*)(wp + 16) = w1; *(u32x4*)(wp + 64) = w2; *(u32x4*)(wp + 80) = w3;
    }
    asm volatile("s_waitcnt lgkmcnt(0)" ::: "memory");
    bf16_t* gp = dst + (size_t)(m0 + lrow - r32) * ldd + col0 + (nc & ~7) + (lane & 7) * 8;
#pragma unroll
    for (int i = 0; i < 4; ++i) {
      const int row = (lane >> 3) + 8 * i;
      *(u32x4*)(gp + (size_t)row * ldd) = *(const u32x4*)(sp + row * 144 + (lane & 7) * 16);
    }
    asm volatile("s_waitcnt lgkmcnt(0)" ::: "memory");
  }
};
struct EpiResid {
  static constexpr bool PERM = false;
  __device__ __forceinline__ bool natural_group(int) const { return true; }
  const float* xin; float* xout; const float* gvec; int n0; char* scr;
  __device__ __forceinline__ void operator()(int lrow, int nc, const f32x16& a0, const f32x16& a1, float) const {
    const int lane = threadIdx.x & 63, wid = threadIdx.x >> 6, r32 = lane & 31, hi = lane >> 5;
    float* sp = (float*)(scr + wid * (32 * 272));
#pragma unroll
    for (int g = 0; g < 4; ++g) {
      const f32x4 v0 = {a0[4 * g], a0[4 * g + 1], a0[4 * g + 2], a0[4 * g + 3]}, v1 = {a1[4 * g], a1[4 * g + 1], a1[4 * g + 2], a1[4 * g + 3]};
      *(f32x4*)(sp + r32 * 68 + 4 * hi + 8 * g) = v0; *(f32x4*)(sp + r32 * 68 + 32 + 4 * hi + 8 * g) = v1;
    }
    asm volatile("s_waitcnt lgkmcnt(0)" ::: "memory");
    const int c4 = (lane & 15) * 4, colg = n0 + (nc & ~7) + c4;
    const size_t rbase = (size_t)(lrow - r32) * 1024 + colg;
    const f32x4 gv = *(const f32x4*)(gvec + colg);
    f32x4 xv[8];
#pragma unroll
    for (int i = 0; i < 8; ++i) xv[i] = *(const f32x4*)(xin + rbase + (size_t)((lane >> 4) + 4 * i) * 1024);
    asm volatile("" ::: "memory");
#pragma unroll
    for (int i = 0; i < 8; ++i) {
      const int row = (lane >> 4) + 4 * i;
      const f32x4 av = *(const f32x4*)(sp + row * 68 + c4);
      f32x4 r; r[0] = xv[i][0] + gv[0] * av[0]; r[1] = xv[i][1] + gv[1] * av[1]; r[2] = xv[i][2] + gv[2] * av[2]; r[3] = xv[i][3] + gv[3] * av[3];
      *(f32x4*)(xout + rbase + (size_t)row * 1024) = r;
    }
    asm volatile("s_waitcnt lgkmcnt(0)" ::: "memory");
  }
};
struct EpiMlaIn {
  static constexpr bool PERM = true;
  bf16_t *QC, *KVC, *KPE, *G1; const float* rope; int n0; int m0;
  __device__ __forceinline__ bool natural_group(int tile_row) const { return ((n0 + tile_row) >> 5) == 20; }
  __device__ __forceinline__ void operator()(int lrow, int nc, const f32x16& a0, const f32x16& a1, float) const { one(lrow, nc, a0); one(lrow, nc + 32, a1); }
  __device__ __forceinline__ void one(int lrow, int nc, const f32x16& a) const {
    const int row = m0 + lrow, g32 = n0 + (nc & ~7);
    if (g32 == 640) {
      const int t = (m0 % TL) + lrow, hi4 = nc & 4;
      bf16_t* p = KPE + (size_t)row * 32;
      if (t < T) {
        const f32x2* tr = (const f32x2*)rope + (t >> 6) * 8 + hi4;
        const f32x2* tc = (const f32x2*)rope + (t & 63) * 8 + hi4;
        float o1[8], o2[8];
#pragma unroll
        for (int e = 0; e < 4; ++e) {
          const f32x2 cs0 = tr[e], cs1 = tc[e];
          const float x1a = a[e], x2a = a[8 + e];
          const float x1b = a[4 + e], x2b = a[12 + e];
          o1[e] = x1a * cs0[0] - x2a * cs0[1]; o2[e] = x1a * cs0[1] + x2a * cs0[0];
          o1[4 + e] = x1b * cs1[0] - x2b * cs1[1]; o2[4 + e] = x1b * cs1[1] + x2b * cs1[0];
        }
        st_bf16x4(p + hi4, o1[0], o1[1], o1[2], o1[3]);
        st_bf16x4(p + 8 + hi4, o1[4], o1[5], o1[6], o1[7]);
        st_bf16x4(p + 16 + hi4, o2[0], o2[1], o2[2], o2[3]);
        st_bf16x4(p + 24 + hi4, o2[4], o2[5], o2[6], o2[7]);
      } else {
#pragma unroll
        for (int g = 0; g < 4; ++g) st_bf16x4(p + 8 * g + hi4, a[4 * g], a[4 * g + 1], a[4 * g + 2], a[4 * g + 3]);
      }
      return;
    }
    if (g32 > 640 && g32 < 768) return;
    const int gc = g32 + 4 * (nc & 4);
    bf16_t* p;
    if (gc < 384) p = QC + (size_t)row * 384 + gc;
    else if (gc < 640) p = KVC + (size_t)row * 256 + (gc - 384);
    else p = G1 + (size_t)row * 1024 + (gc - 768);
    const u32x4 w0 = {cvtpk(a[0], a[1]), cvtpk(a[2], a[3]), cvtpk(a[4], a[5]), cvtpk(a[6], a[7])};
    const u32x4 w1 = {cvtpk(a[8], a[9]), cvtpk(a[10], a[11]), cvtpk(a[12], a[13]), cvtpk(a[14], a[15])};
    *(u32x4*)p = w0; *(u32x4*)(p + 8) = w1;
  }
};

constexpr float AT_SCALE = 0.10206207261596575f;
constexpr float AT_THR = 8.f;
__device__ void tr_job(const float* src, int ld, int K, int N, bf16_t* dst, const float* kscale, char* lds, float gscale = 1.f) {
  float* tile = (float*)lds;
  const int tid = threadIdx.x, nK = K >> 6, nN = (N + 63) >> 6;
  for (int tIdx = blockIdx.x; tIdx < nK * nN; tIdx += gridDim.x) {
    const int k0 = (tIdx % nK) * 64, n0 = (tIdx / nK) * 64;
#pragma unroll
    for (int i = 0; i < 8; ++i) {
      const int kk = (tid >> 6) + 8 * i, nn = tid & 63;
      float v = 0.f;
      if (n0 + nn < N) { v = src[(size_t)(k0 + kk) * ld + n0 + nn] * gscale; if (kscale) v *= kscale[k0 + kk]; }
      tile[kk * 65 + nn] = v;
    }
    __syncthreads();
#pragma unroll
    for (int i = 0; i < 8; ++i) {
      const int nn = (tid >> 6) + 8 * i, kk = tid & 63;
      if (n0 + nn < N) dst[(size_t)(n0 + nn) * K + k0 + kk] = f2bf(tile[kk * 65 + nn]);
    }
    __syncthreads();
  }
}

__device__ void phase_weights(const Params& p, char* lds) {
  unsigned char* ws = p.ws;
  bf16_t* WIN0 = (bf16_t*)(ws + OFF_WIN0);
  for (int j = 0; j < 4; ++j) tr_job(p.in[8] + (size_t)j * 1024 * 1024, 1024, 1024, 1024, WIN0 + (size_t)j * 1024 * 1024, nullptr, lds);
  for (int d = 0; d < 2; ++d) {
    tr_job(p.in[10] + (size_t)d * 1024 * 64, 64, 1024, 64, WIN0 + (size_t)(4096 + d * 64) * 1024, nullptr, lds);
    tr_job(p.in[13] + (size_t)d * 1024 * 64, 64, 1024, 64, WIN0 + (size_t)(4224 + d * 64) * 1024, nullptr, lds);
  }
  tr_job(p.in[20], 1024, 1024, 1024, (bf16_t*)(ws + OFF_WOUT0), nullptr, lds);
  bf16_t* WIN1 = (bf16_t*)(ws + OFF_WIN1);
  tr_job(p.in[21], 1696, 1024, 640, WIN1, nullptr, lds);
  tr_job(p.in[21] + 640, 1696, 1024, 32, WIN1 + (size_t)640 * 1024, nullptr, lds);
  tr_job(p.in[21] + 672, 1696, 1024, 1024, WIN1 + (size_t)768 * 1024, nullptr, lds);
  for (int i = blockIdx.x * NTHR + threadIdx.x; i < 96 * 1024; i += gridDim.x * NTHR) WIN1[(size_t)672 * 1024 + i] = 0;
  tr_job(p.in[23], 1536, 384, 1536, (bf16_t*)(ws + OFF_WQB), p.in[22], lds, AT_SCALE * 1.4426950408889634f);
  tr_job(p.in[25], 2048, 256, 2048, (bf16_t*)(ws + OFF_WKVB), p.in[24], lds);
  tr_job(p.in[26], 1024, 1024, 1024, (bf16_t*)(ws + OFF_WOUT1), nullptr, lds);
}
__device__ void phase_prologue(const Params& p, char* lds) {
  unsigned char* ws = p.ws;
  {
    const int i = blockIdx.x * NTHR + threadIdx.x;
    if (i < 1024) {
      const float invf[8] = {1.f, 0.316227766016838f, 0.1f, 0.0316227766016838f, 0.01f, 0.00316227766016838f, 0.001f, 0.000316227766016838f};
      const int pos = i >> 3, m = i & 7;
      float inv = invf[0];
#pragma unroll
      for (int q = 1; q < 8; ++q) inv = (m == q) ? invf[q] : inv;
      const float ang = (float)pos * inv;
      const float kf = rintf(ang * 0.15915494309189535f);
      float r = fmaf(-kf, 6.28125f, ang);
      r = fmaf(-kf, 1.9353071795864769e-3f, r);
      float* rt = (float*)(ws + OFF_ROPE);
      rt[2 * i] = cosf(r); rt[2 * i + 1] = sinf(r);
    }
  }
  {
    float* sil = (float*)lds;
    float* red = sil + 9 * 1024;
    const int tid = threadIdx.x;
    for (int i = tid; i < 9 * 1024; i += NTHR) {
      const int bi = i >> 10, k = i & 1023;
      const float cv = bi < 8 ? p.in[1][bi * 1024 + k] : p.in[3][k];
      sil[i] = cv / (1.f + __expf(-cv));
    }
    __syncthreads();
    float* mod = (float*)(ws + OFF_MOD);
    for (int item = blockIdx.x; item < 192; item += gridDim.x) {
      const int l = item / 96, n0 = (item % 96) * 32, col = tid & 31, kg = tid >> 5;
      float acc[9];
#pragma unroll
      for (int bi = 0; bi < 9; ++bi) acc[bi] = 0.f;
      const float* wp = p.in[5] + ((size_t)l * 1024 + kg * 64) * 3072 + n0 + col;
      for (int kk = 0; kk < 64; ++kk) {
        const float w = wp[(size_t)kk * 3072];
#pragma unroll
        for (int bi = 0; bi < 9; ++bi) acc[bi] += sil[bi * 1024 + kg * 64 + kk] * w;
      }
#pragma unroll
      for (int bi = 0; bi < 9; ++bi) red[(kg * 9 + bi) * 32 + col] = acc[bi];
      __syncthreads();
      if (tid < 288) {
        const int bi = tid >> 5;
        float s = 0.f;
#pragma unroll
        for (int g = 0; g < 16; ++g) s += red[(g * 9 + bi) * 32 + col];
        mod[((size_t)l * 9 + bi) * 3072 + n0 + col] = s + p.in[6][l * 3072 + n0 + col];
      }
      __syncthreads();
    }
  }
}

__device__ __forceinline__ const float* row_src(const float* xsrc, const float* csrc, int n, int& bi) {
  const int b = n / TL, t = n - b * TL;
  if (t < T) { bi = b; return xsrc + ((size_t)b * T + t) * D; }
  bi = 8; return csrc + ((size_t)b * L + (t - T)) * D;
}
__device__ void phase_norm(const float* xsrc, const float* csrc, const float* ng, const float* mod, bf16_t* H) {
  const int lane = threadIdx.x & 63, gw = blockIdx.x * 8 + (threadIdx.x >> 6), nw = gridDim.x * 8;
  f32x4 g4[4];
#pragma unroll
  for (int i = 0; i < 4; ++i) g4[i] = *(const f32x4*)(ng + i * 256 + lane * 4);
  f32x4 va[4], vb[4]; int bia = 0, bib = 0;
  if (gw < NTOK) { const float* src = row_src(xsrc, csrc, gw, bia);
#pragma unroll
    for (int i = 0; i < 4; ++i) va[i] = *(const f32x4*)(src + i * 256 + lane * 4); }
  for (int n = gw; n < NTOK; n += nw) {
    if (n + nw < NTOK) { const float* src = row_src(xsrc, csrc, n + nw, bib);
#pragma unroll
      for (int i = 0; i < 4; ++i) vb[i] = *(const f32x4*)(src + i * 256 + lane * 4); }
    float ss = 0.f;
#pragma unroll
    for (int i = 0; i < 4; ++i) ss += va[i][0] * va[i][0] + va[i][1] * va[i][1] + va[i][2] * va[i][2] + va[i][3] * va[i][3];
    ss = wave_sum(ss);
    const float rstd = rsqrtf(ss * (1.f / 1024.f) + 1e-6f);
    const float* m = mod + bia * 3072;
#pragma unroll
    for (int i = 0; i < 4; ++i) {
      const int c = i * 256 + lane * 4;
      const f32x4 sh = *(const f32x4*)(m + c), sc = *(const f32x4*)(m + 1024 + c);
      float o[4];
#pragma unroll
      for (int e = 0; e < 4; ++e) o[e] = va[i][e] * rstd * g4[i][e] * (1.f + sc[e]) + sh[e];
      st_bf16x4(H + (size_t)n * 1024 + c, o[0], o[1], o[2], o[3]);
    }
#pragma unroll
    for (int i = 0; i < 4; ++i) va[i] = vb[i];
    bia = bib;
  }
}

constexpr int LERP3_SPLIT = 63488;
__device__ __forceinline__ bf16_t* lerp_base(const Params& p, int j, int row) {
  if (j == 0) return (bf16_t*)(p.ws + OFF_Y0);
  if (j == 1) return (bf16_t*)(p.ws + OFF_Y1);
  if (j == 2) return (bf16_t*)p.out;
  if (row < LERP3_SPLIT) return (bf16_t*)p.out + (size_t)NTOK * 1024;
  return (bf16_t*)(p.ws + WS_END) - (size_t)LERP3_SPLIT * 1024;
}
struct RowX { f32x4 v[4]; int bi; };
__device__ __forceinline__ void ld_row(const Params& p, int n, int lane, RowX& r) {
  const float* src = row_src(p.in[0], p.in[2], n, r.bi);
#pragma unroll
  for (int i = 0; i < 4; ++i) r.v[i] = *(const f32x4*)(src + i * 256 + lane * 4);
}
__device__ __forceinline__ void fin_row(const float* mod, const f32x4 (&g4)[4], int lane, const RowX& r, float (&h)[16]) {
  float ss = 0.f;
#pragma unroll
  for (int i = 0; i < 4; ++i) ss += r.v[i][0] * r.v[i][0] + r.v[i][1] * r.v[i][1] + r.v[i][2] * r.v[i][2] + r.v[i][3] * r.v[i][3];
  ss = wave_sum(ss);
  const float rstd = rsqrtf(ss * (1.f / 1024.f) + 1e-6f);
  const float* m = mod + r.bi * 3072;
#pragma unroll
  for (int i = 0; i < 4; ++i) {
    const int c = i * 256 + lane * 4;
    const f32x4 sh = *(const f32x4*)(m + c), sc = *(const f32x4*)(m + 1024 + c);
#pragma unroll
    for (int e = 0; e < 4; ++e) {
      const float hv = r.v[i][e] * rstd * g4[i][e] * (1.f + sc[e]) + sh[e];
      h[4 * i + e] = __uint_as_float(cvtpk(hv, 0.f) << 16);
    }
  }
}
__device__ void phase_norm_lerp(const Params& p, const float* mod) {
  const int lane = threadIdx.x & 63, gw = blockIdx.x * 8 + (threadIdx.x >> 6), nw = gridDim.x * 8;
  const int per = (NTOK + nw - 1) / nw;
  const int r0 = gw * per, r1 = (r0 + per < NTOK) ? r0 + per : NTOK;
  if (r0 >= r1) return;
  bf16_t* H = (bf16_t*)(p.ws + OFF_H);
  f32x4 g4[4];
#pragma unroll
  for (int i = 0; i < 4; ++i) g4[i] = *(const f32x4*)(p.in[4] + i * 256 + lane * 4);
  float mu[4][16];
#pragma unroll
  for (int j = 0; j < 4; ++j)
#pragma unroll
    for (int i = 0; i < 4; ++i) {
      const f32x4 m4 = *(const f32x4*)(p.in[7] + j * 1024 + i * 256 + lane * 4);
      mu[j][4 * i] = m4[0]; mu[j][4 * i + 1] = m4[1]; mu[j][4 * i + 2] = m4[2]; mu[j][4 * i + 3] = m4[3];
    }
  float hp[16], hc[16], hn[16];
  RowX xa, xb, xc;
  if (r0 > 0) { ld_row(p, r0 - 1, lane, xc); }
  ld_row(p, r0, lane, xa);
  if (r0 + 1 < NTOK) ld_row(p, r0 + 1, lane, xb);
  if (r0 > 0) fin_row(mod, g4, lane, xc, hp);
  else {
#pragma unroll
    for (int e = 0; e < 16; ++e) hp[e] = 0.f;
  }
  fin_row(mod, g4, lane, xa, hc);
  xa = xb;
  if (r0 + 2 < NTOK) ld_row(p, r0 + 2, lane, xb);
  for (int n = r0; n < r1; ++n) {
    const int t = n % TL;
    if (n + 3 < NTOK) ld_row(p, n + 3, lane, xc);
    if (n + 1 < NTOK) fin_row(mod, g4, lane, xa, hn);
    else {
#pragma unroll
      for (int e = 0; e < 16; ++e) hn[e] = 0.f;
    }
    const float fp = (t != 0 && t != T) ? 0.5f : 0.f, fn = (t != T - 1 && t != TL - 1) ? 0.5f : 0.f;
#pragma unroll
    for (int i = 0; i < 4; ++i) st_bf16x4_nt(H + (size_t)n * 1024 + i * 256 + lane * 4, hc[4 * i], hc[4 * i + 1], hc[4 * i + 2], hc[4 * i + 3]);
#pragma unroll
    for (int j = 0; j < 4; ++j) {
      bf16_t* dst = lerp_base(p, j, n) + (size_t)n * 1024 + lane * 4;
#pragma unroll
      for (int i = 0; i < 4; ++i) {
        float o[4];
#pragma unroll
        for (int e = 0; e < 4; ++e) { const float c = hc[4 * i + e]; o[e] = c + (fp * hp[4 * i + e] + fn * hn[4 * i + e] - c) * mu[j][4 * i + e]; }
        st_bf16x4_nt(dst + i * 256, o[0], o[1], o[2], o[3]);
      }
    }
#pragma unroll
    for (int e = 0; e < 16; ++e) { hp[e] = hc[e]; hc[e] = hn[e]; }
    xa = xb; xb = xc;
  }
}

__device__ void phase_final(float* out, const float* fg) {
  const int lane = threadIdx.x & 63, gw = blockIdx.x * 8 + (threadIdx.x >> 6), nw = gridDim.x * 8;
  f32x4 g4[4];
#pragma unroll
  for (int i = 0; i < 4; ++i) g4[i] = *(const f32x4*)(fg + i * 256 + lane * 4);
  f32x4 va[4], vb[4];
  if (gw < NB * T) {
#pragma unroll
    for (int i = 0; i < 4; ++i) va[i] = *(const f32x4*)(out + (size_t)gw * D + i * 256 + lane * 4); }
  for (int n = gw; n < NB * T; n += nw) {
    if (n + nw < NB * T) {
#pragma unroll
      for (int i = 0; i < 4; ++i) vb[i] = *(const f32x4*)(out + (size_t)(n + nw) * D + i * 256 + lane * 4); }
    float ss = 0.f;
#pragma unroll
    for (int i = 0; i < 4; ++i) ss += va[i][0] * va[i][0] + va[i][1] * va[i][1] + va[i][2] * va[i][2] + va[i][3] * va[i][3];
    ss = wave_sum(ss);
    const float rstd = rsqrtf(ss * (1.f / 1024.f) + 1e-6f);
#pragma unroll
    for (int i = 0; i < 4; ++i) {
      f32x4 o;
#pragma unroll
      for (int e = 0; e < 4; ++e) o[e] = va[i][e] * rstd * g4[i][e];
      *(f32x4*)(out + (size_t)n * D + i * 256 + lane * 4) = o;
    }
#pragma unroll
    for (int i = 0; i < 4; ++i) va[i] = vb[i];
  }
}

__device__ __forceinline__ int scan_row(int g, int d, int b) {
  if (g < L) { const int tt = d ? (L - 1 - g) : g; return b * TL + T + tt; }
  g -= L; const int tt = d ? (T - 1 - g) : g; return b * TL + tt;
}
constexpr int SC_P = 0, SC_ARA = 8192, SC_ARR = SC_ARA + 4096, SC_BK = SC_ARR + 4096, SC_SCAL = SC_BK + 8192, SC_VV = SC_SCAL + 1024, SC_BUF = SC_VV + 8192;
constexpr int SC_IC = 2 * SC_BUF, SC_SCR = SC_IC + 8192, SC_YB = SC_SCR + 16384, SC_END = SC_YB + 2 * 8192;
#define MFMA16(a, b, c) __builtin_amdgcn_mfma_f32_16x16x32_bf16((a), (b), (c), 0, 0, 0)
struct ScBlk { u32x4 aa0, aa1, ar0, ar1, k0, k1, k2, k3; f32x4 v; f32x4 s[8]; };
__device__ __forceinline__ void sc_ldb(ScBlk& c, const char* buf, int blk, int arOff, int bkOff, int vOff) {
  const char* pa = buf + SC_ARA + blk * 512 + arOff; const char* pr = buf + SC_ARR + blk * 512 + arOff;
  c.aa0 = *(const u32x4*)(pa); c.aa1 = *(const u32x4*)(pa + 64); c.ar0 = *(const u32x4*)(pr); c.ar1 = *(const u32x4*)(pr + 64);
  const char* bk = buf + SC_BK + blk * 1024 + bkOff;
  c.k0 = *(const u32x4*)(bk); c.k1 = *(const u32x4*)(bk + 256); c.k2 = *(const u32x4*)(bk + 512); c.k3 = *(const u32x4*)(bk + 768);
  c.v = *(const f32x4*)(buf + SC_VV + blk * 1024 + vOff);
  const char* sp = buf + SC_SCAL + blk * 128;
#pragma unroll
  for (int i = 0; i < 8; ++i) c.s[i] = *(const f32x4*)(sp + i * 16);
}
__device__ void phase_scan(const Params& p, char* lds) {
  unsigned char* ws = p.ws;
  const int tid = threadIdx.x, lane = tid & 63, wid = __builtin_amdgcn_readfirstlane(tid >> 6), r32 = lane & 31, hi = lane >> 5;
  const bf16_t* Rg = (const bf16_t*)(ws + OFF_R); const bf16_t* Kg = (const bf16_t*)(ws + OFF_K); const bf16_t* Vg = (const bf16_t*)(ws + OFF_V);
  const bf16_t* Lg = (const bf16_t*)(ws + OFF_LORA);
  constexpr int NCH = TL / 32;
  for (int sidx = blockIdx.x; sidx < 256; sidx += gridDim.x) {
    const int d = sidx >> 7, b = (sidx >> 4) & 7, h = sidx & 15;
    bf16_t* Yg = (bf16_t*)(ws + (d ? OFF_Y1 : OFF_Y0));
    if (wid < 4) {
      const int cw = wid, c16 = lane & 15, q = lane >> 4;
      const int arOff = (c16 & 3) * 128 + q * 16, wOff = q * 16, bkOff = c16 * 16, vOff = (cw * 16 + c16) * 16;
      f32x4 St0 = {0.f, 0.f, 0.f, 0.f}, St1 = St0, St2 = St0, St3 = St0;
      __syncthreads(); __syncthreads();
      for (int c = 0; c < NCH; ++c) {
        const char* buf = lds + (c & 1) * SC_BUF;
        char* yb = lds + SC_YB + (c & 1) * 8192 + (cw * 16 + c16) * 16;
        ScBlk cur; sc_ldb(cur, buf, 0, arOff, bkOff, vOff);
#pragma unroll 1
        for (int blk = 0; blk < 8; ++blk) {
          ScBlk nxt; sc_ldb(nxt, buf, (blk + 1) & 7, arOff, bkOff, vOff);
          u32x4 b1 = {cvtpk(St0[0], St0[1]), cvtpk(St0[2], St0[3]), cvtpk(St1[0], St1[1]), cvtpk(St1[2], St1[3])};
          u32x4 b2 = {cvtpk(St2[0], St2[1]), cvtpk(St2[2], St2[3]), cvtpk(St3[0], St3[1]), cvtpk(St3[2], St3[3])};
          f32x4 sr = {0.f, 0.f, 0.f, 0.f}, yr = sr;
          sr = MFMA16(*(bf16x8*)&cur.aa0, *(bf16x8*)&b1, sr); yr = MFMA16(*(bf16x8*)&cur.ar0, *(bf16x8*)&b1, yr);
          sr = MFMA16(*(bf16x8*)&cur.aa1, *(bf16x8*)&b2, sr); yr = MFMA16(*(bf16x8*)&cur.ar1, *(bf16x8*)&b2, yr);
          const float v1 = cur.v[0], v2 = cur.v[1], v3 = cur.v[2], v4 = cur.v[3];
          const f32x4 s0 = cur.s[0], s1 = cur.s[1], s2 = cur.s[2], s3 = cur.s[3], s4 = cur.s[4], s5 = cur.s[5], s6 = cur.s[6], s7 = cur.s[7];
          const float sa1 = sr[0];
          const float sa2 = sr[1] + s0[0] * sa1 + s1[2] * v1;
          const float sa3 = sr[2] + s0[1] * sa1 + s1[3] * v1 + s0[2] * sa2 + s2[0] * v2;
          const float sa4 = sr[3] + s0[3] * sa1 + s2[1] * v1 + s1[0] * sa2 + s2[2] * v2 + s1[1] * sa3 + s2[3] * v3;
          f32x4 y;
          y[0] = yr[0] + s3[0] * sa1 + s5[2] * v1;
          y[1] = yr[1] + s3[1] * sa1 + s5[3] * v1 + s3[2] * sa2 + s6[0] * v2;
          y[2] = yr[2] + s3[3] * sa1 + s6[1] * v1 + s4[0] * sa2 + s6[2] * v2 + s4[1] * sa3 + s6[3] * v3;
          y[3] = yr[3] + s4[2] * sa1 + s7[0] * v1 + s4[3] * sa2 + s7[1] * v2 + s5[0] * sa3 + s7[2] * v3 + s5[1] * sa4 + s7[3] * v4;
          u32x4 bu = {cvtpk(sa1, v1), cvtpk(sa2, v2), cvtpk(sa3, v3), cvtpk(sa4, v4)};
          if (q != 0) { bu[0] = 0u; bu[1] = 0u; bu[2] = 0u; bu[3] = 0u; }
          St0 = MFMA16(*(bf16x8*)&cur.k0, *(bf16x8*)&bu, St0);
          St1 = MFMA16(*(bf16x8*)&cur.k1, *(bf16x8*)&bu, St1);
          St2 = MFMA16(*(bf16x8*)&cur.k2, *(bf16x8*)&bu, St2);
          St3 = MFMA16(*(bf16x8*)&cur.k3, *(bf16x8*)&bu, St3);
          *(f32x4*)(yb + blk * 1024) = y;
          cur = nxt;
          if (blk == 7) {
            const char* pw = buf + SC_P + 31 * 256 + wOff;
            St0 *= *(const f32x4*)(pw); St1 *= *(const f32x4*)(pw + 64); St2 *= *(const f32x4*)(pw + 128); St3 *= *(const f32x4*)(pw + 192);
          }
          if (blk == 3 || blk == 7) __syncthreads();
        }
      }
    } else {
      const int pw = wid - 4, ptid = tid - 256;
      const int pstep = ptid >> 3, j0 = (ptid & 7) * 8, pblk = pstep >> 2, psb = pstep & 3;
      const int apos0 = (j0 >> 5) * 32 + (((j0 & 31) & 15) >> 2) * 8 + 4 * ((j0 & 31) >> 4), apos1 = apos0 + 8;
      float* Bg = (float*)(ws + OFF_BONUS) + (size_t)d * NTOK * 16;
      float kkc[8], kac[8], rkc[8];
#pragma unroll
      for (int e = 0; e < 8; ++e) { kkc[e] = p.in[15][h * 64 + j0 + e]; kac[e] = p.in[16][h * 64 + j0 + e]; rkc[e] = p.in[17][h * 64 + j0 + e]; }
      const int mat = pw >> 1, jh = pw & 1;
      bf16x8 w2f[4]; float bias;
      {
        const float* W2 = (mat ? p.in[14] : p.in[11]) + (size_t)d * 64 * 1024;
#pragma unroll
        for (int ks = 0; ks < 4; ++ks) {
          u32x4 w;
#pragma unroll
          for (int qq = 0; qq < 4; ++qq) {
            const int r0 = ks * 16 + 8 * hi + 2 * qq;
            w[qq] = cvtpk(W2[(size_t)r0 * 1024 + h * 64 + jh * 32 + r32], W2[(size_t)(r0 + 1) * 1024 + h * 64 + jh * 32 + r32]);
          }
          w2f[ks] = *(bf16x8*)&w;
        }
        bias = (mat ? p.in[12] : p.in[9])[d * 1024 + h * 64 + jh * 32 + r32];
      }
      u32x4 pR, pK, pV; bf16x8 pl[4];
      float kk[8], kr[8], rr[8];
      float* IC = (float*)(lds + SC_IC);
      bf16_t* SCR = (bf16_t*)(lds + SC_SCR);
      auto prefetch = [&](int c) {
        const size_t row = (size_t)scan_row(c * 32 + pstep, d, b) * 1024 + h * 64 + j0;
        pR = *(const u32x4*)(Rg + row); pK = *(const u32x4*)(Kg + row); pV = *(const u32x4*)(Vg + row);
        const size_t lrow = (size_t)scan_row(c * 32 + r32, d, b);
#pragma unroll
        for (int ks = 0; ks < 4; ++ks) pl[ks] = *(const bf16x8*)(Lg + lrow * 256 + mat * 128 + d * 64 + ks * 16 + hi * 8);
      };
      auto stageA = [&](int c) {
        char* buf = lds + (c & 1) * SC_BUF;
        float* Pd = (float*)(buf + SC_P); float* VV = (float*)(buf + SC_VV);
        f32x16 acc;
#pragma unroll
        for (int r = 0; r < 16; ++r) acc[r] = 0.f;
#pragma unroll
        for (int ks = 0; ks < 4; ++ks) acc = MFMA(pl[ks], w2f[ks], acc);
        if (mat == 0) {
          float cc[16];
#pragma unroll
          for (int r = 0; r < 16; ++r) cc[r] = -0.6065306597126334f * __builtin_amdgcn_rcpf(1.f + __expf(-(acc[r] + bias)));
#pragma unroll
          for (int g = 0; g < 4; ++g) { cc[4 * g + 1] += cc[4 * g]; cc[4 * g + 2] += cc[4 * g + 1]; cc[4 * g + 3] += cc[4 * g + 2]; }
          float run = 0.f;
#pragma unroll
          for (int g = 0; g < 4; ++g) {
            const float own = cc[4 * g + 3];
            auto rr2 = __builtin_amdgcn_permlane32_swap(__float_as_uint(own), __float_as_uint(own), false, false);
            const float both = __uint_as_float(rr2[0]) + __uint_as_float(rr2[1]), partner = both - own;
            const float off = hi ? run + partner : run;
#pragma unroll
            for (int e = 0; e < 4; ++e) Pd[crow(4 * g + e, hi) * 64 + jh * 32 + r32] = __expf(off + cc[4 * g + e]);
            run += both;
          }
        } else {
#pragma unroll
          for (int r = 0; r < 16; ++r) IC[crow(r, hi) * 64 + jh * 32 + r32] = __builtin_amdgcn_rcpf(1.f + __expf(-(acc[r] + bias)));
        }
        float ss = 0.f;
#pragma unroll
        for (int w = 0; w < 4; ++w) {
          rr[2 * w] = lo16(pR[w]); rr[2 * w + 1] = hi16(pR[w]);
          kr[2 * w] = lo16(pK[w]); kr[2 * w + 1] = hi16(pK[w]);
        }
        const float vv[8] = {lo16(pV[0]), hi16(pV[0]), lo16(pV[1]), hi16(pV[1]), lo16(pV[2]), hi16(pV[2]), lo16(pV[3]), hi16(pV[3])};
        if (c + 1 < NCH) prefetch(c + 1);
#pragma unroll
        for (int e = 0; e < 8; ++e) VV[(pblk * 64 + j0 + e) * 4 + psb] = vv[e];
#pragma unroll
        for (int e = 0; e < 8; ++e) { kk[e] = kr[e] * kkc[e]; ss += kk[e] * kk[e]; }
        ss = red8(ss);
        const float inv = rsqrtf(fmaxf(ss, 1e-24f));
#pragma unroll
        for (int e = 0; e < 8; ++e) kk[e] *= inv;
      };
      auto stageB = [&](int c) {
        char* buf = lds + (c & 1) * SC_BUF;
        const f32x4 i0 = *(const f32x4*)(IC + pstep * 64 + j0), i1 = *(const f32x4*)(IC + pstep * 64 + j0 + 4);
        const float ic[8] = {i0[0], i0[1], i0[2], i0[3], i1[0], i1[1], i1[2], i1[3]};
        const float* Pt = (const float*)(buf + SC_P) + pstep * 64 + j0;
        const f32x4 pt0 = *(const f32x4*)(Pt), pt1 = *(const f32x4*)(Pt + 4);
        f32x4 pm0 = {1.f, 1.f, 1.f, 1.f}, pm1 = pm0;
        if (pstep > 0) { pm0 = *(const f32x4*)(Pt - 64); pm1 = *(const f32x4*)(Pt - 60); }
        const float pt[8] = {pt0[0], pt0[1], pt0[2], pt0[3], pt1[0], pt1[1], pt1[2], pt1[3]};
        const float pm[8] = {pm0[0], pm0[1], pm0[2], pm0[3], pm1[0], pm1[1], pm1[2], pm1[3]};
        const u32x4 an = {cvtpk(-kk[0] * pm[0], -kk[1] * pm[1]), cvtpk(-kk[2] * pm[2], -kk[3] * pm[3]), cvtpk(-kk[4] * pm[4], -kk[5] * pm[5]), cvtpk(-kk[6] * pm[6], -kk[7] * pm[7])};
        const u32x4 rn = {cvtpk(rr[0] * pt[0], rr[1] * pt[1]), cvtpk(rr[2] * pt[2], rr[3] * pt[3]), cvtpk(rr[4] * pt[4], rr[5] * pt[5]), cvtpk(rr[6] * pt[6], rr[7] * pt[7])};
        bf16_t* ARa = (bf16_t*)(buf + SC_ARA) + (pblk * 4 + psb) * 64; bf16_t* ARr = (bf16_t*)(buf + SC_ARR) + (pblk * 4 + psb) * 64;
        { u32x2 lo = {an[0], an[1]}, hi2 = {an[2], an[3]}; *(u32x2*)(ARa + apos0) = lo; *(u32x2*)(ARa + apos1) = hi2; }
        { u32x2 lo = {rn[0], rn[1]}, hi2 = {rn[2], rn[3]}; *(u32x2*)(ARr + apos0) = lo; *(u32x2*)(ARr + apos1) = hi2; }
        *(u32x4*)(SCR + (pstep * 4 + 0) * 64 + j0) = an; *(u32x4*)(SCR + (pstep * 4 + 1) * 64 + j0) = rn;
        float bs = 0.f;
        unsigned bq[8], kq[8];
        unsigned* BK = (unsigned*)(buf + SC_BK) + (pblk * 64 + j0) * 4 + psb;
#pragma unroll
        for (int e = 0; e < 8; ++e) {
          const float kd = kr[e] * (1.f + (ic[e] - 1.f) * kac[e]);
          const float ip = __builtin_amdgcn_rcpf(pt[e]);
          const unsigned pr2 = cvtpk(kk[e] * ic[e] * ip, kd * ip);
          BK[e * 4] = pr2;
          bq[e] = pr2 & 0xffffu; kq[e] = pr2 >> 16;
          bs += rr[e] * kd * rkc[e];
        }
        const u32x4 bn = {bq[0] | (bq[1] << 16), bq[2] | (bq[3] << 16), bq[4] | (bq[5] << 16), bq[6] | (bq[7] << 16)};
        const u32x4 kn = {kq[0] | (kq[1] << 16), kq[2] | (kq[3] << 16), kq[4] | (kq[5] << 16), kq[6] | (kq[7] << 16)};
        *(u32x4*)(SCR + (pstep * 4 + 2) * 64 + j0) = bn; *(u32x4*)(SCR + (pstep * 4 + 3) * 64 + j0) = kn;
        bs = red8(bs);
        if ((ptid & 7) == 0) Bg[(size_t)scan_row(c * 32 + pstep, d, b) * 16 + h] = bs;
      };
      auto stageC = [&](int c) {
        char* buf = lds + (c & 1) * SC_BUF;
        asm volatile("s_waitcnt lgkmcnt(0)" ::: "memory");
        const int n16 = lane & 15, q4 = lane >> 4;
        const int stepA = (2 * pw + (n16 >> 3)) * 4 + (n16 & 3);
        const bf16_t* Xr = SCR + (stepA * 4 + 2 + ((n16 >> 2) & 1)) * 64 + q4 * 8;
        const bf16_t* Yc = SCR + (stepA * 4 + ((n16 >> 2) & 1)) * 64 + q4 * 8;
        f32x4 g = {0.f, 0.f, 0.f, 0.f};
        g = MFMA16(*(const bf16x8*)(Xr), *(const bf16x8*)(Yc), g);
        g = MFMA16(*(const bf16x8*)(Xr + 32), *(const bf16x8*)(Yc + 32), g);
        const int ctype = (n16 >> 2) & 1, t0 = n16 & 3, rtype = q4 & 1;
        const int grp = ctype * 2 + rtype, base = grp == 0 ? 0 : (grp == 1 ? 6 : (grp == 2 ? 12 : 22));
        float* sc = (float*)(buf + SC_SCAL) + (2 * pw + (n16 >> 3)) * 32 + base + (ctype ? (t0 + 1) * t0 / 2 : t0 * (t0 - 1) / 2);
        if ((q4 >> 1) == (n16 >> 3)) {
#pragma unroll
          for (int e = 0; e < 4; ++e) if (ctype ? (e <= t0) : (e < t0)) sc[e] = g[e];
        }
      };
      auto writeout = [&](int c) {
        const float* Yb = (const float*)(lds + SC_YB + (c & 1) * 8192) + (pblk * 64 + j0) * 4 + psb;
        u32x4 w = {cvtpk(Yb[0], Yb[4]), cvtpk(Yb[8], Yb[12]), cvtpk(Yb[16], Yb[20]), cvtpk(Yb[24], Yb[28])};
        *(u32x4*)(Yg + (size_t)scan_row(c * 32 + pstep, d, b) * 1024 + h * 64 + j0) = w;
      };
      prefetch(0);
      stageA(0);
      __syncthreads();
      stageB(0); stageC(0);
      __syncthreads();
      for (int c = 0; c < NCH; ++c) {
        if (c >= 1) writeout(c - 1);
        if (c + 1 < NCH) stageA(c + 1);
        __syncthreads();
        if (c + 1 < NCH) { stageB(c + 1); stageC(c + 1); }
        __syncthreads();
      }
      writeout(NCH - 1);
    }
    __syncthreads();
  }
}

__device__ void phase_readout(const Params& p) {
  unsigned char* ws = p.ws;
  const bf16_t* Y0 = (const bf16_t*)(ws + OFF_Y0); const bf16_t* Y1 = (const bf16_t*)(ws + OFF_Y1); const bf16_t* Vg = (const bf16_t*)(ws + OFF_V);
  bf16_t* G = (bf16_t*)(ws + OFF_G);
  const float* B0 = (const float*)(ws + OFF_BONUS); const float* B1 = B0 + (size_t)NTOK * 16;
  const int lane = threadIdx.x & 63, gw = blockIdx.x * 8 + (threadIdx.x >> 6), nw = gridDim.x * 8;
  const int c0 = lane * 16, hd = lane >> 2;
  float lg[16], lb[16];
#pragma unroll
  for (int e = 0; e < 16; ++e) { lg[e] = p.in[18][c0 + e]; lb[e] = p.in[19][c0 + e]; }
  struct RowIn { u32x4 a[2], b[2], v[2], g[2]; float b0, b1; };
  auto ldr = [&](int n, RowIn& r) {
    const size_t o = (size_t)n * 1024 + c0;
#pragma unroll
    for (int q = 0; q < 2; ++q) { r.a[q] = *(const u32x4*)(Y0 + o + 8 * q); r.b[q] = *(const u32x4*)(Y1 + o + 8 * q); r.v[q] = *(const u32x4*)(Vg + o + 8 * q); r.g[q] = *(const u32x4*)(G + o + 8 * q); }
    r.b0 = B0[(size_t)n * 16 + hd]; r.b1 = B1[(size_t)n * 16 + hd];
  };
  RowIn cur, nxt;
  if (gw < NTOK) ldr(gw, cur);
  for (int n = gw; n < NTOK; n += nw) {
    if (n + nw < NTOK) ldr(n + nw, nxt);
    const size_t o = (size_t)n * 1024 + c0;
    float y[16], v[16], g[16];
#pragma unroll
    for (int q = 0; q < 2; ++q) {
#pragma unroll
      for (int w = 0; w < 4; ++w) {
        y[8 * q + 2 * w] = lo16(cur.a[q][w]) + lo16(cur.b[q][w]); y[8 * q + 2 * w + 1] = hi16(cur.a[q][w]) + hi16(cur.b[q][w]);
        v[8 * q + 2 * w] = lo16(cur.v[q][w]); v[8 * q + 2 * w + 1] = hi16(cur.v[q][w]);
        g[8 * q + 2 * w] = lo16(cur.g[q][w]); g[8 * q + 2 * w + 1] = hi16(cur.g[q][w]);
      }
    }
    float s = 0.f;
#pragma unroll
    for (int e = 0; e < 16; ++e) s += y[e];
    s += dpp_f(s, 0); s += dpp_f(s, 1);
    const float mean = s * (1.f / 64.f);
    float q2 = 0.f;
#pragma unroll
    for (int e = 0; e < 16; ++e) { const float dlt = y[e] - mean; q2 += dlt * dlt; }
    q2 += dpp_f(q2, 0); q2 += dpp_f(q2, 1);
    const float rs = rsqrtf(q2 * (1.f / 64.f) + 64e-5f);
    const float bonus = cur.b0 + cur.b1;
    float r[16];
#pragma unroll
    for (int e = 0; e < 16; ++e) {
      const float yn = (y[e] - mean) * rs * lg[e] + lb[e];
      r[e] = (yn + bonus * v[e]) * (g[e] * sigmoidf_(g[e]));
    }
    u32x4 w0 = {cvtpk(r[0], r[1]), cvtpk(r[2], r[3]), cvtpk(r[4], r[5]), cvtpk(r[6], r[7])};
    u32x4 w1 = {cvtpk(r[8], r[9]), cvtpk(r[10], r[11]), cvtpk(r[12], r[13]), cvtpk(r[14], r[15])};
    *(u32x4*)(G + o) = w0; *(u32x4*)(G + o + 8) = w1;
    cur = nxt;
  }
}

constexpr int AT_SHMV = 16384, AT_KROW = 208, AT_SHMK = 64 * AT_KROW;
constexpr int AT_KOFF = 2 * AT_SHMV, AT_WOFF = AT_KOFF + 2 * AT_SHMK;
#define SBAR() __builtin_amdgcn_sched_barrier(0)
__device__ __forceinline__ void at_partialSM(f32x16& p0, f32x16& p1, float& m_reg, float& alpha, bool force) {
  float pm = p0[0];
#pragma unroll
  for (int r = 1; r < 16; ++r) pm = fmaxf(pm, p0[r]);
#pragma unroll
  for (int r = 0; r < 16; ++r) pm = fmaxf(pm, p1[r]);
  { auto rr = __builtin_amdgcn_permlane32_swap(__float_as_uint(pm), __float_as_uint(pm), false, false);
    pm = fmaxf(__uint_as_float(rr[0]), __uint_as_float(rr[1])); }
  if (__builtin_expect(!force && __all(pm <= AT_THR * 1.4426950408889634f), 1)) { alpha = 1.f; }
  else {
    const float dlt = force ? pm : fmaxf(pm, 0.f);
    alpha = force ? 1.f : __builtin_amdgcn_exp2f(-dlt); m_reg += dlt;
#pragma unroll
    for (int r = 0; r < 16; ++r) { p0[r] -= dlt; p1[r] -= dlt; }
  }
#pragma unroll
  for (int r = 0; r < 16; ++r) p0[r] = __builtin_amdgcn_exp2f(p0[r]);
}
__device__ __forceinline__ void at_finishSM(f32x16& p0, f32x16& p1, float alpha, float& l_reg, bf16x8& pa0, bf16x8& pa1, bf16x8& pa2, bf16x8& pa3) {
#pragma unroll
  for (int r = 0; r < 16; ++r) p1[r] = __builtin_amdgcn_exp2f(p1[r]);
  float ps = 0;
#pragma unroll
  for (int r = 0; r < 16; ++r) ps += p0[r];
#pragma unroll
  for (int r = 0; r < 16; ++r) ps += p1[r];
  { auto rr = __builtin_amdgcn_permlane32_swap(__float_as_uint(ps), __float_as_uint(ps), false, false);
    ps = __uint_as_float(rr[0]) + __uint_as_float(rr[1]); }
  l_reg = l_reg * alpha + ps;
#define PK4(P, BASE, OUT) do { unsigned a0 = cvtpk(P[BASE + 0], P[BASE + 1]), a1 = cvtpk(P[BASE + 2], P[BASE + 3]);   \
    unsigned b0 = cvtpk(P[BASE + 4], P[BASE + 5]), b1 = cvtpk(P[BASE + 6], P[BASE + 7]);                              \
    auto r0 = __builtin_amdgcn_permlane32_swap(a0, b0, false, false); auto r1 = __builtin_amdgcn_permlane32_swap(a1, b1, false, false); \
    u32x4 w = {r0[0], r1[0], r0[1], r1[1]}; OUT = *reinterpret_cast<bf16x8*>(&w); } while (0)
  PK4(p0, 0, pa0); PK4(p0, 8, pa1); PK4(p1, 0, pa2); PK4(p1, 8, pa3);
#undef PK4
}
__device__ __forceinline__ void at_qkt(f32x16& p0, f32x16& p1, const char* Ks, const bf16x8* qr, int r32, int hi, float negm) {
#pragma unroll
  for (int r = 0; r < 16; ++r) { p0[r] = negm; p1[r] = negm; }
#pragma unroll
  for (int d0 = 0; d0 < 6; ++d0) {
    const bf16x8 b0 = *(const bf16x8*)(Ks + r32 * AT_KROW + d0 * 32 + hi * 16);
    const bf16x8 b1 = *(const bf16x8*)(Ks + (32 + r32) * AT_KROW + d0 * 32 + hi * 16);
    p0 = MFMA(b0, qr[d0], p0);
    p1 = MFMA(b1, qr[d0], p1);
  }
}
__device__ __forceinline__ int v_st(int k, int c) { const int kk = (k & ~0xC) | ((k & 4) << 1) | ((k & 8) >> 1); return ((kk >> 3) * 4 + (c >> 5)) * 512 + ((kk & 7) * 32 + (c & 31)) * 2; }
__device__ __forceinline__ int v_rd_base(int lane) { return ((lane & 3) << 3) | (((lane >> 2) & 3) << 6) | (((lane >> 4) & 1) << 5) | (((lane >> 5) & 1) << 8); }
constexpr int v_rd_off(int d0, int ks, int half) { return d0 * 512 + ks * 4096 + half * 2048; }
template <int OFF> __device__ __forceinline__ s16x4 tr_read(int vb) {
  s16x4 r; asm volatile("ds_read_b64_tr_b16 %0, %1 offset:%2" : "=&v"(r) : "v"(vb), "i"(OFF) : "memory"); return r;
}
template <int D0> __device__ __forceinline__ void pv_one(f32x16& od, int vb, bf16x8 pa0, bf16x8 pa1, bf16x8 pa2, bf16x8 pa3) {
  const s16x4 l0 = tr_read<v_rd_off(D0, 0, 0)>(vb), h0 = tr_read<v_rd_off(D0, 0, 1)>(vb), l1 = tr_read<v_rd_off(D0, 1, 0)>(vb), h1 = tr_read<v_rd_off(D0, 1, 1)>(vb);
  const s16x4 l2 = tr_read<v_rd_off(D0, 2, 0)>(vb), h2 = tr_read<v_rd_off(D0, 2, 1)>(vb), l3 = tr_read<v_rd_off(D0, 3, 0)>(vb), h3 = tr_read<v_rd_off(D0, 3, 1)>(vb);
  asm volatile("s_waitcnt lgkmcnt(0)" ::: "memory"); SBAR();
#define PK(Lx, Hx) (bf16x8){Lx[0], Lx[1], Lx[2], Lx[3], Hx[0], Hx[1], Hx[2], Hx[3]}
  od = MFMA(pa0, PK(l0, h0), od);
  od = MFMA(pa1, PK(l1, h1), od);
  od = MFMA(pa2, PK(l2, h2), od);
  od = MFMA(pa3, PK(l3, h3), od);
#undef PK
}
__device__ __forceinline__ void pv_d0(f32x16* o, int vb, bf16x8 pa0, bf16x8 pa1, bf16x8 pa2, bf16x8 pa3) {
  pv_one<0>(o[0], vb, pa0, pa1, pa2, pa3); pv_one<1>(o[1], vb, pa0, pa1, pa2, pa3);
}

__device__ void phase_attn(const Params& p, char* lds) {
  unsigned char* ws = p.ws;
  const bf16_t* Qg = (const bf16_t*)(ws + OFF_Q); const bf16_t* KVg = (const bf16_t*)(ws + OFF_KV); const bf16_t* KPg = (const bf16_t*)(ws + OFF_KPE);
  bf16_t* G1 = (bf16_t*)(ws + OFF_G1);
  const f32x2* rope = (const f32x2*)(ws + OFF_ROPE);
  const int tid = threadIdx.x, wid = tid >> 6, lane = tid & 63, r32 = lane & 31, hi = lane >> 5;
  char* V_lds = lds; char* K_lds = lds + AT_KOFF;
  float* wsl = (float*)(lds + AT_WOFF) + wid * 64; float* li_l = wsl; float* al_l = wsl + 32;
  const int skey = tid >> 3, sc8 = (tid & 7) * 8;
  const int pkey = (tid & 255) >> 2, pc8 = (tid & 3) * 8;
  const int vst = v_st(skey, sc8), kst = skey * AT_KROW + sc8 * 2, pst = pkey * AT_KROW + (64 + pc8) * 2;
  const int vb0 = (int)(uintptr_t)V_lds + v_rd_base(lane);
  const int nitems = NB * 16 * 32;
  const int xcd = blockIdx.x & 7, slot = blockIdx.x >> 3, per = gridDim.x >> 3;
  for (int it = slot; it < nitems / 8; it += per) {
    const int pair = (it >> 5) * 8 + xcd, qblk = it & 31;
    const int b = pair >> 4, h = pair & 15;
    const size_t row0 = (size_t)b * TL;
    const size_t qrow = row0 + qblk * 256 + wid * 32 + r32;
    const bf16_t* Kh = KVg + row0 * 2048 + h * 128;
    const bf16_t* Kp = KPg + row0 * 32;
    float m_reg = 0.f, l_reg = 0.f;
    f32x16 o[2];
#pragma unroll
    for (int dd = 0; dd < 2; ++dd)
#pragma unroll
      for (int r = 0; r < 16; ++r) o[dd][r] = 0.f;
    bf16x8 qr[6];
    {
      const bf16_t* Qw = Qg + qrow * 1536 + h * 96 + hi * 8;
#pragma unroll
      for (int d0 = 0; d0 < 6; ++d0) qr[d0] = *(const bf16x8*)(Qw + d0 * 16);
      const int t = qblk * 256 + wid * 32 + r32;
      const f32x2* tb = rope + (hi ? (t & 63) : (t >> 6)) * 8;
      const u32x4 x1 = *(const u32x4*)&qr[4], x2 = *(const u32x4*)&qr[5];
      u32x4 n1, n2;
#pragma unroll
      for (int q = 0; q < 4; ++q) {
        const f32x2 csA = tb[2 * q], csB = tb[2 * q + 1];
        const float a0 = lo16(x1[q]), a1 = hi16(x1[q]), b0 = lo16(x2[q]), b1 = hi16(x2[q]);
        n1[q] = cvtpk(a0 * csA[0] - b0 * csA[1], a1 * csB[0] - b1 * csB[1]);
        n2[q] = cvtpk(a0 * csA[1] + b0 * csA[0], a1 * csB[1] + b1 * csB[0]);
      }
      qr[4] = *(bf16x8*)&n1; qr[5] = *(bf16x8*)&n2;
    }
    struct { bf16x8 vs, ks, ps; } sr_[2];
#define SLOAD(i, k0) do { sr_[i].vs = *(const bf16x8*)(Kh + (size_t)((k0) + skey) * 2048 + 64 + sc8); \
    sr_[i].ks = *(const bf16x8*)(Kh + (size_t)((k0) + skey) * 2048 + sc8); \
    sr_[i].ps = *(const bf16x8*)(Kp + (size_t)((k0) + pkey) * 32 + pc8); } while (0)
#define SWRITE(bb, i) do { *(bf16x8*)(V_lds + (bb) * AT_SHMV + vst) = sr_[i].vs; \
    *(bf16x8*)(K_lds + (bb) * AT_SHMK + kst) = sr_[i].ks; \
    *(bf16x8*)(K_lds + (bb) * AT_SHMK + pst) = sr_[i].ps; } while (0)
#define SWAIT() asm volatile("s_waitcnt vmcnt(3)" ::: "memory")
#define RESC(a) do { if (__any((a) < 1.f)) { if (hi == 0) al_l[r32] = (a); asm volatile("s_waitcnt lgkmcnt(0)" ::: "memory"); \
    _Pragma("unroll") for (int dd = 0; dd < 2; ++dd) _Pragma("unroll") for (int r = 0; r < 16; ++r) o[dd][r] *= al_l[crow(r, hi)]; } } while (0)
    f32x16 pA0, pA1, pB0, pB1; float alA, alB; bf16x8 pa0, pa1, pa2, pa3;
    constexpr int NT = TL / 64;
    SLOAD(0, 0); asm volatile("s_waitcnt vmcnt(0)" ::: "memory"); SWRITE(0, 0); __syncthreads();
    at_qkt(pA0, pA1, K_lds, qr, r32, hi, 0.f); at_partialSM(pA0, pA1, m_reg, alA, true);
    SLOAD(1, 64); SLOAD(0, 128);
    SWAIT(); SWRITE(1, 1); __syncthreads();
    for (int j = 1; j + 1 < NT; j += 2) {
      SBAR(); at_qkt(pB0, pB1, K_lds + AT_SHMK, qr, r32, hi, -m_reg);
      at_finishSM(pA0, pA1, alA, l_reg, pa0, pa1, pa2, pa3); SBAR();
      SLOAD(1, (j + 2) * 64); SBAR();
      pv_d0(o, vb0, pa0, pa1, pa2, pa3); at_partialSM(pB0, pB1, m_reg, alB, false);
      __syncthreads(); SWAIT(); SWRITE(0, 0);
      RESC(alB); __syncthreads();
      SBAR(); at_qkt(pA0, pA1, K_lds, qr, r32, hi, -m_reg);
      at_finishSM(pB0, pB1, alB, l_reg, pa0, pa1, pa2, pa3); SBAR();
      if (j + 3 < NT) SLOAD(0, (j + 3) * 64); SBAR();
      pv_d0(o, vb0 + AT_SHMV, pa0, pa1, pa2, pa3); at_partialSM(pA0, pA1, m_reg, alA, false);
      __syncthreads(); SWAIT(); SWRITE(1, 1);
      RESC(alA); __syncthreads();
    }
    SBAR(); at_qkt(pB0, pB1, K_lds + AT_SHMK, qr, r32, hi, -m_reg);
    at_finishSM(pA0, pA1, alA, l_reg, pa0, pa1, pa2, pa3); SBAR();
    pv_d0(o, vb0, pa0, pa1, pa2, pa3); at_partialSM(pB0, pB1, m_reg, alB, false);
    __syncthreads(); RESC(alB);
    at_finishSM(pB0, pB1, alB, l_reg, pa0, pa1, pa2, pa3); SBAR();
    pv_d0(o, vb0 + AT_SHMV, pa0, pa1, pa2, pa3);
    if (hi == 0) li_l[r32] = l_reg;
    asm volatile("s_waitcnt lgkmcnt(0)" ::: "memory");
    float rli[16];
#pragma unroll
    for (int r = 0; r < 16; ++r) rli[r] = __builtin_amdgcn_rcpf(li_l[crow(r, hi)]);
    bf16_t* Gw = G1 + (row0 + qblk * 256 + wid * 32) * 1024 + h * 64 + r32;
    bf16_t gin[32];
#pragma unroll
    for (int r = 0; r < 16; ++r) { gin[2 * r] = Gw[(size_t)crow(r, hi) * 1024]; gin[2 * r + 1] = Gw[(size_t)crow(r, hi) * 1024 + 32]; }
    asm volatile("" ::: "memory");
#pragma unroll
    for (int r = 0; r < 16; ++r) {
      const int orow = crow(r, hi);
#pragma unroll
      for (int d0 = 0; d0 < 2; ++d0) {
        const float gt = bf2f(gin[2 * r + d0]);
        Gw[(size_t)orow * 1024 + d0 * 32] = f2bf(o[d0][r] * rli[r] * gt * sigmoidf_(gt));
      }
    }
    __syncthreads();
#undef SLOAD
#undef SWRITE
#undef SWAIT
#undef RESC
  }
}

struct XcdWalk {
  int start, count, step, idx;
  __device__ __forceinline__ void init(int ntiles) {
    const int x = blockIdx.x & 7, base = ntiles >> 3, rem = ntiles & 7;
    count = base + (x < rem ? 1 : 0); start = x * base + (x < rem ? x : rem); step = gridDim.x >> 3; idx = blockIdx.x >> 3;
  }
  __device__ __forceinline__ bool next(int& o) { if (idx >= count) return false; o = start + idx; idx += step; return true; }
};
__device__ __forceinline__ void tile_mn(int o, int NT, int& mt, int& nt) { const int g = o >> 3; mt = (g / NT) * 8 + (o & 7); nt = g % NT; }

__global__ __launch_bounds__(NTHR, 1) void fwd_megakernel(Params p) {
  extern __shared__ __attribute__((aligned(16))) char lds[];
  cg::grid_group grid = cg::this_grid();
  unsigned char* ws = p.ws;
  bf16_t* H = (bf16_t*)(ws + OFF_H);
  float* mod = (float*)(ws + OFF_MOD);
  float* CTX1 = (float*)(ws + OFF_CTX1);

  phase_prologue(p, lds);
  grid.sync();
  phase_norm_lerp(p, mod);
  phase_weights(p, lds);
  grid.sync();
  {
    const bf16_t* WIN0 = (const bf16_t*)(ws + OFF_WIN0);
    const int nbig = 264 * 16;
    XcdWalk wk; wk.init(nbig); int o;
    while (wk.next(o)) {
      EpiBf16 e; e.invK = 0.f; e.scr = lds + G_EPI_SCR;
      {
        int mt, jn; tile_mn(o, 16, mt, jn);
        const int j = jn >> 2, n4 = jn & 3, m0 = mt * 256;
        e.dst = (bf16_t*)(ws + OFF_R + (size_t)j * U); e.ldd = 1024; e.col0 = n4 * 256; e.act = 0; e.m0 = m0;
        gemm_tile<0, 256>(lerp_base(p, j, m0), 1024, WIN0 + (size_t)(j * 1024 + n4 * 256) * 1024, 1024, m0, nullptr, lds, e);
      }
    }
    wk.init(264 * 2);
    while (wk.next(o)) {
      EpiBf16 e; e.invK = 0.f; e.scr = lds + G_EPI_SCR;
      {
        int mt, n2; tile_mn(o, 2, mt, n2);
        const int nt = 32 + n2, m0 = mt * 256;
        e.dst = (bf16_t*)(ws + OFF_LORA); e.ldd = 256; e.col0 = (nt - 32) * 128; e.act = (nt == 32) ? 1 : 0; e.m0 = m0;
        gemm_tile<1, 128>(H, 1024, WIN0 + (size_t)nt * 128 * 1024, 1024, m0, p.in[7] + (nt - 28) * 1024, lds, e);
      }
    }
  }
  grid.sync();
  phase_scan(p, lds);
  grid.sync();
  phase_readout(p);
  grid.sync();
  {
    const bf16_t* A = (const bf16_t*)(ws + OFF_G); const bf16_t* W = (const bf16_t*)(ws + OFF_WOUT0);
    XcdWalk wk; wk.init(264 * 4); int o;
    while (wk.next(o)) {
      int mt, nt; tile_mn(o, 4, mt, nt);
      const int m0 = mt * 256;
      const int b = m0 / TL, t0 = m0 - b * TL;
      EpiResid e;
      if (t0 < T) { const size_t orow = (size_t)b * T + t0; e.xin = p.in[0] + orow * 1024; e.xout = p.out + orow * 1024; e.gvec = mod + (size_t)b * 3072 + 2048; }
      else { const size_t orow = (size_t)b * L + (t0 - T); e.xin = p.in[2] + orow * 1024; e.xout = CTX1 + orow * 1024; e.gvec = mod + (size_t)8 * 3072 + 2048; }
      e.n0 = nt * 256; e.scr = lds + G_EPI_SCR;
      gemm_tile<0, 256>(A, 1024, W + (size_t)nt * 256 * 1024, 1024, m0, nullptr, lds, e);
    }
  }
  grid.sync();
  phase_norm(p.out, CTX1, p.in[4] + 1024, mod + 9 * 3072, H);
  grid.sync();
  {
    const bf16_t* W = (const bf16_t*)(ws + OFF_WIN1);
    XcdWalk wk; wk.init(264 * 7); int o;
    while (wk.next(o)) {
      int mt, nt; tile_mn(o, 7, mt, nt);
      const int m0 = mt * 256;
      EpiMlaIn e; e.QC = (bf16_t*)(ws + OFF_QC); e.KVC = (bf16_t*)(ws + OFF_KVC); e.KPE = (bf16_t*)(ws + OFF_KPE); e.G1 = (bf16_t*)(ws + OFF_G1);
      e.rope = (const float*)(ws + OFF_ROPE); e.n0 = nt * 256; e.m0 = m0;
      gemm_tile<0, 256>(H, 1024, W + (size_t)nt * 256 * 1024, 1024, m0, nullptr, lds, e);
    }
  }
  grid.sync();
  {
    const bf16_t* WQ = (const bf16_t*)(ws + OFF_WQB); const bf16_t* WKV = (const bf16_t*)(ws + OFF_WKVB);
    const int nq = 256 * 6, nkv = 264 * 8;
    XcdWalk wk; wk.init(nq); int o;
    while (wk.next(o)) {
      EpiBf16 e; e.act = 0; e.scr = lds + G_EPI_SCR;
      {
        int mt2, nt; tile_mn(o, 6, mt2, nt);
        const int b = mt2 >> 5, m0 = b * TL + (mt2 & 31) * 256;
        e.dst = (bf16_t*)(ws + OFF_Q); e.ldd = 1536; e.col0 = nt * 256; e.m0 = m0; e.invK = 1.f / 384.f;
        gemm_tile<2, 256>((const bf16_t*)(ws + OFF_QC), 384, WQ + (size_t)nt * 256 * 384, 384, m0, nullptr, lds, e);
      }
    }
    wk.init(nkv);
    while (wk.next(o)) {
      EpiBf16 e; e.act = 0; e.scr = lds + G_EPI_SCR;
      {
        int mt, nt; tile_mn(o, 8, mt, nt);
        const int m0 = mt * 256;
        e.dst = (bf16_t*)(ws + OFF_KV); e.ldd = 2048; e.col0 = nt * 256; e.m0 = m0; e.invK = 1.f / 256.f;
        gemm_tile<2, 256>((const bf16_t*)(ws + OFF_KVC), 256, WKV + (size_t)nt * 256 * 256, 256, m0, nullptr, lds, e);
      }
    }
  }
  grid.sync();
  phase_attn(p, lds);
  grid.sync();
  {
    const bf16_t* A = (const bf16_t*)(ws + OFF_G1); const bf16_t* W = (const bf16_t*)(ws + OFF_WOUT1);
    XcdWalk wk; wk.init(256 * 4); int o;
    while (wk.next(o)) {
      int mt2, nt; tile_mn(o, 4, mt2, nt);
      const int b = mt2 >> 5, t0 = (mt2 & 31) * 256, m0 = b * TL + t0;
      const size_t orow = (size_t)b * T + t0;
      EpiResid e; e.xin = p.out + orow * 1024; e.xout = p.out + orow * 1024; e.gvec = mod + (size_t)(9 + b) * 3072 + 2048; e.n0 = nt * 256; e.scr = lds + G_EPI_SCR;
      gemm_tile<0, 256>(A, 1024, W + (size_t)nt * 256 * 1024, 1024, m0, nullptr, lds, e);
    }
  }
  grid.sync();
  phase_final(p.out, p.in[27]);
}

extern "C" void kernel_launch(void* const* d_in, const int* in_sizes, int n_in, void* d_out, int out_size, void* d_ws, size_t ws_size, hipStream_t stream) {
  static int grid_blocks = 0;
  if (grid_blocks == 0) {
    if (n_in != 28 || ws_size < WS_END + (size_t)(NTOK - LERP3_SPLIT) * 2048 || out_size != NB * T * D) { fprintf(stderr, "kernel_launch: unexpected shapes (n_in %d, ws %zu need %zu, out %d)\n", n_in, ws_size, (size_t)WS_END, out_size); grid_blocks = -1; return; }
    int dev = 0, cus = 0, per_cu = 0;
    hipGetDevice(&dev);
    hipDeviceGetAttribute(&cus, hipDeviceAttributeMultiprocessorCount, dev);
    if (hipFuncSetAttribute((const void*)fwd_megakernel, hipFuncAttributeMaxDynamicSharedMemorySize, LDS_BYTES) != hipSuccess) { fprintf(stderr, "kernel_launch: hipFuncSetAttribute failed\n"); grid_blocks = -1; return; }
    hipOccupancyMaxActiveBlocksPerMultiprocessor(&per_cu, (const void*)fwd_megakernel, NTHR, LDS_BYTES);
    if (per_cu < 1) { fprintf(stderr, "kernel_launch: occupancy query says %d blocks per CU\n", per_cu); per_cu = 1; }
    (void)hipGetLastError();
    grid_blocks = cus;
    if (grid_blocks > 256) grid_blocks = 256;
    grid_blocks &= ~7;
  }
  if (grid_blocks <= 0) return;
  Params p{};
  for (int i = 0; i < 28; ++i) p.in[i] = (const float*)d_in[i];
  p.out = (float*)d_out; p.ws = (unsigned char*)d_ws;
  void* args[] = {&p};
  hipError_t e = hipLaunchCooperativeKernel((const void*)fwd_megakernel, dim3(grid_blocks), dim3(NTHR), args, LDS_BYTES, stream);
  if (e != hipSuccess) fprintf(stderr, "cooperative launch failed: %s (grid %d)\n", hipGetErrorString(e), grid_blocks);
}
```

```cpp
#include <hip/hip_runtime.h>
#include <hip/hip_cooperative_groups.h>
#include <cstdio>
#include <cstdint>
namespace cg = cooperative_groups;

typedef unsigned short bf16_t;
typedef short bf16x8 __attribute__((ext_vector_type(8)));
typedef short s16x4 __attribute__((ext_vector_type(4)));
typedef float f32x16 __attribute__((ext_vector_type(16)));
typedef float f32x4 __attribute__((ext_vector_type(4)));
typedef float f32x2 __attribute__((ext_vector_type(2)));
typedef unsigned u32x4 __attribute__((ext_vector_type(4)));
typedef unsigned u32x2 __attribute__((ext_vector_type(2)));

constexpr int D = 1024, NB = 8, T = 8192, L = 256, TL = T + L, NTOK = NB * TL;
constexpr int NTHR = 512;

constexpr size_t U = (size_t)NTOK * 1024 * 2;
constexpr size_t OFF_H = 0, OFF_R = U, OFF_K = 2 * U, OFF_V = 3 * U, OFF_G = 4 * U, OFF_Y0 = 5 * U, OFF_Y1 = 6 * U;
constexpr size_t OFF_LORA = 7 * U;
constexpr size_t OFF_BONUS = OFF_LORA + (size_t)NTOK * 256 * 2;
constexpr size_t OFF_WIN0 = OFF_BONUS + (size_t)2 * NTOK * 16 * 4;
constexpr size_t OFF_WOUT0 = OFF_WIN0 + (size_t)4352 * 1024 * 2;
constexpr size_t OFF_WIN1 = OFF_WOUT0 + (size_t)1024 * 1024 * 2;
constexpr size_t OFF_WQB = OFF_WIN1 + (size_t)1792 * 1024 * 2;
constexpr size_t OFF_WKVB = OFF_WQB + (size_t)1536 * 384 * 2;
constexpr size_t OFF_WOUT1 = OFF_WKVB + (size_t)2048 * 256 * 2;
constexpr size_t OFF_MOD = OFF_WOUT1 + (size_t)1024 * 1024 * 2;
constexpr size_t OFF_ROPE = OFF_MOD + (size_t)2 * 9 * 3072 * 4;
constexpr size_t OFF_CTX1 = OFF_ROPE + (size_t)128 * 8 * 2 * 4;
constexpr size_t WS_END = OFF_CTX1 + (size_t)2048 * 1024 * 4;
constexpr size_t OFF_QC = OFF_V;
constexpr size_t OFF_KVC = OFF_QC + (size_t)NTOK * 384 * 2;
constexpr size_t OFF_KPE = OFF_KVC + (size_t)NTOK * 256 * 2;
constexpr size_t OFF_G1 = OFF_G;
constexpr size_t OFF_Q = OFF_R;
constexpr size_t OFF_KV = OFF_Y0;

struct Params { const float* in[28]; float* out; unsigned char* ws; };

typedef __bf16 bf16x2_t __attribute__((ext_vector_type(2)));
__device__ __forceinline__ unsigned cvtpk(float lo, float hi) { f32x2 v = {lo, hi}; bf16x2_t b = __builtin_convertvector(v, bf16x2_t); return *(unsigned*)&b; }
__device__ __forceinline__ float bf2f(bf16_t u) { return __uint_as_float(((unsigned)u) << 16); }
__device__ __forceinline__ bf16_t f2bf(float f) { return (bf16_t)(cvtpk(f, 0.f) & 0xffffu); }
__device__ __forceinline__ float lo16(unsigned w) { return __uint_as_float(w << 16); }
__device__ __forceinline__ float hi16(unsigned w) { return __uint_as_float(w & 0xffff0000u); }
__device__ __forceinline__ void st_bf16x4(bf16_t* p, float a, float b, float c, float d) { u32x2 w = {cvtpk(a, b), cvtpk(c, d)}; *(u32x2*)p = w; }
__device__ __forceinline__ void st_bf16x4_nt(bf16_t* p, float a, float b, float c, float d) { u32x2 w = {cvtpk(a, b), cvtpk(c, d)}; __builtin_nontemporal_store(w, (u32x2*)p); }
__device__ __forceinline__ float wave_sum(float v) {
#pragma unroll
  for (int o = 32; o; o >>= 1) v += __shfl_xor(v, o);
  return v;
}
__device__ __forceinline__ float dpp_f(float v, const int ctrl_sel) {
  int r;
  if (ctrl_sel == 0) r = __builtin_amdgcn_update_dpp(0, __float_as_int(v), 0xB1, 0xF, 0xF, true);
  else if (ctrl_sel == 1) r = __builtin_amdgcn_update_dpp(0, __float_as_int(v), 0x4E, 0xF, 0xF, true);
  else r = __builtin_amdgcn_update_dpp(0, __float_as_int(v), 0x141, 0xF, 0xF, true);
  return __int_as_float(r);
}
__device__ __forceinline__ float red8(float v) { v += dpp_f(v, 0); v += dpp_f(v, 1); v += dpp_f(v, 2); return v; }
__device__ __forceinline__ int crow(int r, int hi) { return (r & 3) + 8 * (r >> 2) + 4 * hi; }
__device__ __forceinline__ float sigmoidf_(float x) { return 1.f / (1.f + __expf(-x)); }
#define MFMA(a, b, c) __builtin_amdgcn_mfma_f32_32x32x16_bf16((a), (b), (c), 0, 0, 0)

constexpr int G_LDT = 144;
constexpr int G_SSQ_OFF = 2 * (256 + 256) * G_LDT;
constexpr int LDS_BYTES = G_SSQ_OFF + 1024;

template <int AMODE, int BN, class Epi>
__device__ __forceinline__ void gemm_tile(const bf16_t* A, const int lda, const bf16_t* Bt, const int K, const int m0, const float* mu, char* lds, const Epi& epi) {
  constexpr int WN = BN / 64, MI = WN, NBR = BN / 64, G_STAGE = (256 + BN) * G_LDT;
  const int tid = threadIdx.x, lane = tid & 63, wid = tid >> 6, r32 = lane & 31, hi = lane >> 5;
  const int wm = wid / WN, wn = wid % WN;
  const int srow = tid >> 3, scc = (tid & 7) * 8;
  int browi[NBR];
#pragma unroll
  for (int i = 0; i < NBR; ++i) browi[i] = 64 * i + ((Epi::PERM && !epi.natural_group(64 * i + srow)) ? ((srow & 32) + 16 * ((srow >> 2) & 1) + 4 * ((srow & 31) >> 3) + (srow & 3)) : srow);
  f32x16 acc[MI][2];
#pragma unroll
  for (int i = 0; i < MI; ++i)
#pragma unroll
    for (int j = 0; j < 2; ++j)
#pragma unroll
      for (int r = 0; r < 16; ++r) acc[i][j][r] = 0.f;
  bf16x8 ra[4], rb[NBR], rp[4], rn[4];
  float ssq[4] = {0.f, 0.f, 0.f, 0.f};
  int dprev[4], dnext[4];
  if constexpr (AMODE == 1) {
    const int t0 = m0 % TL;
#pragma unroll
    for (int i = 0; i < 4; ++i) { const int t = t0 + srow + 64 * i; dprev[i] = (t != 0 && t != T) ? 1 : 0; dnext[i] = (t != T - 1 && t != TL - 1) ? 1 : 0; }
  }
  auto gload = [&](int k0) {
#pragma unroll
    for (int i = 0; i < 4; ++i) {
      const bf16_t* ap = A + (size_t)(m0 + srow + 64 * i) * lda + k0 + scc;
      ra[i] = *(const bf16x8*)ap;
      if constexpr (AMODE == 1) { rp[i] = *(const bf16x8*)(ap - dprev[i] * lda); rn[i] = *(const bf16x8*)(ap + dnext[i] * lda); }
    }
#pragma unroll
    for (int i = 0; i < NBR; ++i) rb[i] = *(const bf16x8*)(Bt + (size_t)browi[i] * K + k0 + scc);
  };
  auto lstore = [&](int s, int k0) {
    char* base = lds + s * G_STAGE;
    if constexpr (AMODE == 1) {
      const f32x4 m0v = *(const f32x4*)(mu + k0 + scc), m1v = *(const f32x4*)(mu + k0 + scc + 4);
      const float mm[8] = {m0v[0], m0v[1], m0v[2], m0v[3], m1v[0], m1v[1], m1v[2], m1v[3]};
#pragma unroll
      for (int i = 0; i < 4; ++i) {
        const u32x4 hc = *(const u32x4*)&ra[i], hp = *(const u32x4*)&rp[i], hn = *(const u32x4*)&rn[i];
        const float fp = dprev[i] ? 0.5f : 0.f, fn = dnext[i] ? 0.5f : 0.f;
        u32x4 w;
#pragma unroll
        for (int q = 0; q < 4; ++q) {
          const float c0 = lo16(hc[q]), c1 = hi16(hc[q]);
          const float x0 = fp * lo16(hp[q]) + fn * lo16(hn[q]) - c0, x1 = fp * hi16(hp[q]) + fn * hi16(hn[q]) - c1;
          w[q] = cvtpk(c0 + x0 * mm[2 * q], c1 + x1 * mm[2 * q + 1]);
        }
        *(u32x4*)(base + (srow + 64 * i) * G_LDT + scc * 2) = w;
      }
    } else {
#pragma unroll
      for (int i = 0; i < 4; ++i) {
        *(bf16x8*)(base + (srow + 64 * i) * G_LDT + scc * 2) = ra[i];
        if constexpr (AMODE == 2) {
          const u32x4 hc = *(const u32x4*)&ra[i];
#pragma unroll
          for (int q = 0; q < 4; ++q) { const float c0 = lo16(hc[q]), c1 = hi16(hc[q]); ssq[i] += c0 * c0 + c1 * c1; }
        }
      }
    }
#pragma unroll
    for (int i = 0; i < NBR; ++i) *(bf16x8*)(base + 256 * G_LDT + (srow + 64 * i) * G_LDT + scc * 2) = rb[i];
  };
  const int nk = K >> 6;
  gload(0);
  lstore(0, 0);
  if (nk > 1) gload(64);
  __syncthreads();
#pragma unroll 1
  for (int kt = 0; kt < nk; ++kt) {
    const int s = kt & 1;
    if (kt + 1 < nk) lstore(s ^ 1, (kt + 1) * 64);
    if (kt + 2 < nk) gload((kt + 2) * 64);
    {
      const char* Ab = lds + s * G_STAGE + (wm * (32 * MI) + r32) * G_LDT + hi * 16;
      const char* Bb = lds + s * G_STAGE + 256 * G_LDT + (wn * 64 + r32) * G_LDT + hi * 16;
      bf16x8 fb[2][2], fa[2][MI];
      fb[0][0] = *(const bf16x8*)(Bb); fb[0][1] = *(const bf16x8*)(Bb + 32 * G_LDT);
#pragma unroll
      for (int mi = 0; mi < MI; ++mi) fa[0][mi] = *(const bf16x8*)(Ab + mi * 32 * G_LDT);
#pragma unroll
      for (int ks = 0; ks < 4; ++ks) {
        const int sl = ks & 1;
        if (ks + 1 < 4) {
          fb[sl ^ 1][0] = *(const bf16x8*)(Bb + (ks + 1) * 32); fb[sl ^ 1][1] = *(const bf16x8*)(Bb + 32 * G_LDT + (ks + 1) * 32);
#pragma unroll
          for (int mi = 0; mi < MI; ++mi) fa[sl ^ 1][mi] = *(const bf16x8*)(Ab + mi * 32 * G_LDT + (ks + 1) * 32);
        }
#pragma unroll
        for (int mi = 0; mi < MI; ++mi) { acc[mi][0] = MFMA(fb[sl][0], fa[sl][mi], acc[mi][0]); acc[mi][1] = MFMA(fb[sl][1], fa[sl][mi], acc[mi][1]); }
      }
    }
    __syncthreads();
  }
  float* ssq_l = (float*)(lds + G_SSQ_OFF);
  if constexpr (AMODE == 2) {
#pragma unroll
    for (int i = 0; i < 4; ++i) { const float v = red8(ssq[i]); if ((tid & 7) == 0) ssq_l[srow + 64 * i] = v; }
    __syncthreads();
  }
#pragma unroll
  for (int mi = 0; mi < MI; ++mi) {
    const int lrow = wm * (32 * MI) + mi * 32 + r32;
    float aux = 0.f;
    if constexpr (AMODE == 2) aux = ssq_l[lrow];
    epi(lrow, wn * 64 + 4 * hi, acc[mi][0], acc[mi][1], aux);
  }
}

constexpr int G_EPI_SCR = (256 + 256) * G_LDT;
struct EpiBf16 {
  static constexpr bool PERM = true;
  __device__ __forceinline__ bool natural_group(int) const { return false; }
  bf16_t* dst; int ldd; int col0; int m0; int act; float invK; char* scr;
  __device__ __forceinline__ void operator()(int lrow, int nc, const f32x16& a0, const f32x16& a1, float aux) const {
    const int lane = threadIdx.x & 63, wid = threadIdx.x >> 6, r32 = lane & 31, hi = lane >> 5;
    float sc = 1.f;
    if (invK > 0.f) sc = rsqrtf(aux * invK + 1e-6f);
    char* sp = scr + wid * (32 * 144);
    char* wp = sp + r32 * 144 + 32 * hi;
    if (act) {
#define TANH_(x) (1.f - 2.f / (__expf(2.f * (x) * sc) + 1.f))
      const u32x4 w0 = {cvtpk(TANH_(a0[0]), TANH_(a0[1])), cvtpk(TANH_(a0[2]), TANH_(a0[3])), cvtpk(TANH_(a0[4]), TANH_(a0[5])), cvtpk(TANH_(a0[6]), TANH_(a0[7]))};
      const u32x4 w1 = {cvtpk(TANH_(a0[8]), TANH_(a0[9])), cvtpk(TANH_(a0[10]), TANH_(a0[11])), cvtpk(TANH_(a0[12]), TANH_(a0[13])), cvtpk(TANH_(a0[14]), TANH_(a0[15]))};
      const u32x4 w2 = {cvtpk(TANH_(a1[0]), TANH_(a1[1])), cvtpk(TANH_(a1[2]), TANH_(a1[3])), cvtpk(TANH_(a1[4]), TANH_(a1[5])), cvtpk(TANH_(a1[6]), TANH_(a1[7]))};
      const u32x4 w3 = {cvtpk(TANH_(a1[8]), TANH_(a1[9])), cvtpk(TANH_(a1[10]), TANH_(a1[11])), cvtpk(TANH_(a1[12]), TANH_(a1[13])), cvtpk(TANH_(a1[14]), TANH_(a1[15]))};
#undef TANH_
      *(u32x4*)(wp) = w0; *(u32x4*)(wp + 16) = w1; *(u32x4*)(wp + 64) = w2; *(u32x4*)(wp + 80) = w3;
    } else {
      const u32x4 w0 = {cvtpk(a0[0] * sc, a0[1] * sc), cvtpk(a0[2] * sc, a0[3] * sc), cvtpk(a0[4] * sc, a0[5] * sc), cvtpk(a0[6] * sc, a0[7] * sc)};
      const u32x4 w1 = {cvtpk(a0[8] * sc, a0[9] * sc), cvtpk(a0[10] * sc, a0[11] * sc), cvtpk(a0[12] * sc, a0[13] * sc), cvtpk(a0[14] * sc, a0[15] * sc)};
      const u32x4 w2 = {cvtpk(a1[0] * sc, a1[1] * sc), cvtpk(a1[2] * sc, a1[3] * sc), cvtpk(a1[4] * sc, a1[5] * sc), cvtpk(a1[6] * sc, a1[7] * sc)};
      const u32x4 w3 = {cvtpk(a1[8] * sc, a1[9] * sc), cvtpk(a1[10] * sc, a1[11] * sc), cvtpk(a1[12] * sc, a1[13] * sc), cvtpk(a1[14] * sc, a1[15] * sc)};
      *(u32x4*)(wp) = w0; *(u32x4*)(wp + 16) = w1; *(u32x4*)(wp + 64) = w2; *(u32x4*)(wp + 80) = w3;
    }
    asm volatile("s_waitcnt lgkmcnt(0)" ::: "memory");
    bf16_t* gp = dst + (size_t)(m0 + lrow - r32) * ldd + col0 + (nc & ~7) + (lane & 7) * 8;
#pragma unroll
    for (int i = 0; i < 4; ++i) {
      const int row = (lane >> 3) + 8 * i;
      *(u32x4*)(gp + (size_t)row * ldd) = *(const u32x4*)(sp + row * 144 + (lane & 7) * 16);
    }
    asm volatile("s_waitcnt lgkmcnt(0)" ::: "memory");
  }
};
struct EpiResid {
  static constexpr bool PERM = false;
  __device__ __forceinline__ bool natural_group(int) const { return true; }
  const float* xin; float* xout; const float* gvec; int n0; char* scr;
  __device__ __forceinline__ void operator()(int lrow, int nc, const f32x16& a0, const f32x16& a1, float) const {
    const int lane = threadIdx.x & 63, wid = threadIdx.x >> 6, r32 = lane & 31, hi = lane >> 5;
    float* sp = (float*)(scr + wid * (32 * 272));
#pragma unroll
    for (int g = 0; g < 4; ++g) {
      const f32x4 v0 = {a0[4 * g], a0[4 * g + 1], a0[4 * g + 2], a0[4 * g + 3]}, v1 = {a1[4 * g], a1[4 * g + 1], a1[4 * g + 2], a1[4 * g + 3]};
      *(f32x4*)(sp + r32 * 68 + 4 * hi + 8 * g) = v0; *(f32x4*)(sp + r32 * 68 + 32 + 4 * hi + 8 * g) = v1;
    }
    asm volatile("s_waitcnt lgkmcnt(0)" ::: "memory");
    const int c4 = (lane & 15) * 4, colg = n0 + (nc & ~7) + c4;
    const size_t rbase = (size_t)(lrow - r32) * 1024 + colg;
    const f32x4 gv = *(const f32x4*)(gvec + colg);
    f32x4 xv[8];
#pragma unroll
    for (int i = 0; i < 8; ++i) xv[i] = *(const f32x4*)(xin + rbase + (size_t)((lane >> 4) + 4 * i) * 1024);
    asm volatile("" ::: "memory");
#pragma unroll
    for (int i = 0; i < 8; ++i) {
      const int row = (lane >> 4) + 4 * i;
      const f32x4 av = *(const f32x4*)(sp + row * 68 + c4);
      f32x4 r; r[0] = xv[i][0] + gv[0] * av[0]; r[1] = xv[i][1] + gv[1] * av[1]; r[2] = xv[i][2] + gv[2] * av[2]; r[3] = xv[i][3] + gv[3] * av[3];
      *(f32x4*)(xout + rbase + (size_t)row * 1024) = r;
    }
    asm volatile("s_waitcnt lgkmcnt(0)" ::: "memory");
  }
};
struct EpiMlaIn {
  static constexpr bool PERM = true;
  bf16_t *QC, *KVC, *KPE, *G1; const float* rope; int n0; int m0; char* scr;
  __device__ __forceinline__ bool natural_group(int tile_row) const { return ((n0 + tile_row) >> 5) == 20; }
  __device__ __forceinline__ void operator()(int lrow, int nc, const f32x16& a0, const f32x16& a1, float) const {
    const int g64 = n0 + (nc & ~7);
    if (g64 == 640) { rope_one(lrow, nc, a0); return; }
    if (g64 == 704) return;
    bf16_t* base; int ld;
    if (g64 < 384) { base = QC + g64; ld = 384; } else if (g64 < 640) { base = KVC + (g64 - 384); ld = 256; } else { base = G1 + (g64 - 768); ld = 1024; }
    const int lane = threadIdx.x & 63, wid = threadIdx.x >> 6, r32 = lane & 31, hi = lane >> 5;
    char* sp = scr + wid * (32 * 144);
    char* wp = sp + r32 * 144 + 32 * hi;
    const u32x4 w0 = {cvtpk(a0[0], a0[1]), cvtpk(a0[2], a0[3]), cvtpk(a0[4], a0[5]), cvtpk(a0[6], a0[7])};
    const u32x4 w1 = {cvtpk(a0[8], a0[9]), cvtpk(a0[10], a0[11]), cvtpk(a0[12], a0[13]), cvtpk(a0[14], a0[15])};
    const u32x4 w2 = {cvtpk(a1[0], a1[1]), cvtpk(a1[2], a1[3]), cvtpk(a1[4], a1[5]), cvtpk(a1[6], a1[7])};
    const u32x4 w3 = {cvtpk(a1[8], a1[9]), cvtpk(a1[10], a1[11]), cvtpk(a1[12], a1[13]), cvtpk(a1[14], a1[15])};
    *(u32x4*)(wp) = w0; *(u32x4*)(wp + 16) = w1; *(u32x4*)(wp + 64) = w2; *(u32x4*)(wp + 80) = w3;
    asm volatile("s_waitcnt lgkmcnt(0)" ::: "memory");
    bf16_t* gp = base + (size_t)(m0 + lrow - r32) * ld + (lane & 7) * 8;
#pragma unroll
    for (int i = 0; i < 4; ++i) {
      const int row = (lane >> 3) + 8 * i;
      *(u32x4*)(gp + (size_t)row * ld) = *(const u32x4*)(sp + row * 144 + (lane & 7) * 16);
    }
    asm volatile("s_waitcnt lgkmcnt(0)" ::: "memory");
  }
  __device__ __forceinline__ void rope_one(int lrow, int nc, const f32x16& a) const {
    const int row = m0 + lrow, t = (m0 % TL) + lrow, hi4 = nc & 4;
    bf16_t* p = KPE + (size_t)row * 32;
    if (t < T) {
      const f32x2* tr = (const f32x2*)rope + (t >> 6) * 8 + hi4;
      const f32x2* tc = (const f32x2*)rope + (t & 63) * 8 + hi4;
      float o1[8], o2[8];
#pragma unroll
      for (int e = 0; e < 4; ++e) {
        const f32x2 cs0 = tr[e], cs1 = tc[e];
        const float x1a = a[e], x2a = a[8 + e];
        const float x1b = a[4 + e], x2b = a[12 + e];
        o1[e] = x1a * cs0[0] - x2a * cs0[1]; o2[e] = x1a * cs0[1] + x2a * cs0[0];
        o1[4 + e] = x1b * cs1[0] - x2b * cs1[1]; o2[4 + e] = x1b * cs1[1] + x2b * cs1[0];
      }
      st_bf16x4(p + hi4, o1[0], o1[1], o1[2], o1[3]);
      st_bf16x4(p + 8 + hi4, o1[4], o1[5], o1[6], o1[7]);
      st_bf16x4(p + 16 + hi4, o2[0], o2[1], o2[2], o2[3]);
      st_bf16x4(p + 24 + hi4, o2[4], o2[5], o2[6], o2[7]);
    } else {
#pragma unroll
      for (int g = 0; g < 4; ++g) st_bf16x4(p + 8 * g + hi4, a[4 * g], a[4 * g + 1], a[4 * g + 2], a[4 * g + 3]);
    }
  }
};

constexpr float AT_SCALE = 0.10206207261596575f;
constexpr float AT_THR = 8.f;
__device__ void tr_job(const float* src, int ld, int K, int N, bf16_t* dst, const float* kscale, char* lds, float gscale = 1.f) {
  float* tile = (float*)lds;
  const int tid = threadIdx.x, nK = K >> 6, nN = (N + 63) >> 6;
  for (int tIdx = blockIdx.x; tIdx < nK * nN; tIdx += gridDim.x) {
    const int k0 = (tIdx % nK) * 64, n0 = (tIdx / nK) * 64;
#pragma unroll
    for (int i = 0; i < 8; ++i) {
      const int kk = (tid >> 6) + 8 * i, nn = tid & 63;
      float v = 0.f;
      if (n0 + nn < N) { v = src[(size_t)(k0 + kk) * ld + n0 + nn] * gscale; if (kscale) v *= kscale[k0 + kk]; }
      tile[kk * 65 + nn] = v;
    }
    __syncthreads();
#pragma unroll
    for (int i = 0; i < 8; ++i) {
      const int nn = (tid >> 6) + 8 * i, kk = tid & 63;
      if (n0 + nn < N) dst[(size_t)(n0 + nn) * K + k0 + kk] = f2bf(tile[kk * 65 + nn]);
    }
    __syncthreads();
  }
}

__device__ void phase_weights(const Params& p, char* lds) {
  unsigned char* ws = p.ws;
  bf16_t* WIN0 = (bf16_t*)(ws + OFF_WIN0);
  for (int j = 0; j < 4; ++j) tr_job(p.in[8] + (size_t)j * 1024 * 1024, 1024, 1024, 1024, WIN0 + (size_t)j * 1024 * 1024, nullptr, lds);
  for (int d = 0; d < 2; ++d) {
    tr_job(p.in[10] + (size_t)d * 1024 * 64, 64, 1024, 64, WIN0 + (size_t)(4096 + d * 64) * 1024, nullptr, lds);
    tr_job(p.in[13] + (size_t)d * 1024 * 64, 64, 1024, 64, WIN0 + (size_t)(4224 + d * 64) * 1024, nullptr, lds);
  }
  tr_job(p.in[20], 1024, 1024, 1024, (bf16_t*)(ws + OFF_WOUT0), nullptr, lds);
  bf16_t* WIN1 = (bf16_t*)(ws + OFF_WIN1);
  tr_job(p.in[21], 1696, 1024, 640, WIN1, nullptr, lds);
  tr_job(p.in[21] + 640, 1696, 1024, 32, WIN1 + (size_t)640 * 1024, nullptr, lds);
  tr_job(p.in[21] + 672, 1696, 1024, 1024, WIN1 + (size_t)768 * 1024, nullptr, lds);
  for (int i = blockIdx.x * NTHR + threadIdx.x; i < 96 * 1024; i += gridDim.x * NTHR) WIN1[(size_t)672 * 1024 + i] = 0;
  tr_job(p.in[23], 1536, 384, 1536, (bf16_t*)(ws + OFF_WQB), p.in[22], lds, AT_SCALE * 1.4426950408889634f);
  tr_job(p.in[25], 2048, 256, 2048, (bf16_t*)(ws + OFF_WKVB), p.in[24], lds);
  tr_job(p.in[26], 1024, 1024, 1024, (bf16_t*)(ws + OFF_WOUT1), nullptr, lds);
}
__device__ void phase_prologue(const Params& p, char* lds) {
  unsigned char* ws = p.ws;
  {
    const int i = blockIdx.x * NTHR + threadIdx.x;
    if (i < 1024) {
      const float invf[8] = {1.f, 0.316227766016838f, 0.1f, 0.0316227766016838f, 0.01f, 0.00316227766016838f, 0.001f, 0.000316227766016838f};
      const int pos = i >> 3, m = i & 7;
      float inv = invf[0];
#pragma unroll
      for (int q = 1; q < 8; ++q) inv = (m == q) ? invf[q] : inv;
      const float ang = (float)pos * inv;
      const float kf = rintf(ang * 0.15915494309189535f);
      float r = fmaf(-kf, 6.28125f, ang);
      r = fmaf(-kf, 1.9353071795864769e-3f, r);
      float* rt = (float*)(ws + OFF_ROPE);
      rt[2 * i] = cosf(r); rt[2 * i + 1] = sinf(r);
    }
  }
  {
    float* sil = (float*)lds;
    float* red = sil + 9 * 1024;
    const int tid = threadIdx.x;
    for (int i = tid; i < 9 * 1024; i += NTHR) {
      const int bi = i >> 10, k = i & 1023;
      const float cv = bi < 8 ? p.in[1][bi * 1024 + k] : p.in[3][k];
      sil[i] = cv / (1.f + __expf(-cv));
    }
    __syncthreads();
    float* mod = (float*)(ws + OFF_MOD);
    for (int item = blockIdx.x; item < 192; item += gridDim.x) {
      const int l = item / 96, n0 = (item % 96) * 32, col = tid & 31, kg = tid >> 5;
      float acc[9];
#pragma unroll
      for (int bi = 0; bi < 9; ++bi) acc[bi] = 0.f;
      const float* wp = p.in[5] + ((size_t)l * 1024 + kg * 64) * 3072 + n0 + col;
      for (int kk = 0; kk < 64; ++kk) {
        const float w = wp[(size_t)kk * 3072];
#pragma unroll
        for (int bi = 0; bi < 9; ++bi) acc[bi] += sil[bi * 1024 + kg * 64 + kk] * w;
      }
#pragma unroll
      for (int bi = 0; bi < 9; ++bi) red[(kg * 9 + bi) * 32 + col] = acc[bi];
      __syncthreads();
      if (tid < 288) {
        const int bi = tid >> 5;
        float s = 0.f;
#pragma unroll
        for (int g = 0; g < 16; ++g) s += red[(g * 9 + bi) * 32 + col];
        mod[((size_t)l * 9 + bi) * 3072 + n0 + col] = s + p.in[6][l * 3072 + n0 + col];
      }
      __syncthreads();
    }
  }
}

__device__ __forceinline__ const float* row_src(const float* xsrc, const float* csrc, int n, int& bi) {
  const int b = n / TL, t = n - b * TL;
  if (t < T) { bi = b; return xsrc + ((size_t)b * T + t) * D; }
  bi = 8; return csrc + ((size_t)b * L + (t - T)) * D;
}
__device__ void phase_norm(const float* xsrc, const float* csrc, const float* ng, const float* mod, bf16_t* H) {
  const int lane = threadIdx.x & 63, gw = blockIdx.x * 8 + (threadIdx.x >> 6), nw = gridDim.x * 8;
  f32x4 g4[4];
#pragma unroll
  for (int i = 0; i < 4; ++i) g4[i] = *(const f32x4*)(ng + i * 256 + lane * 4);
  f32x4 va[4], vb[4]; int bia = 0, bib = 0;
  if (gw < NTOK) { const float* src = row_src(xsrc, csrc, gw, bia);
#pragma unroll
    for (int i = 0; i < 4; ++i) va[i] = *(const f32x4*)(src + i * 256 + lane * 4); }
  for (int n = gw; n < NTOK; n += nw) {
    if (n + nw < NTOK) { const float* src = row_src(xsrc, csrc, n + nw, bib);
#pragma unroll
      for (int i = 0; i < 4; ++i) vb[i] = *(const f32x4*)(src + i * 256 + lane * 4); }
    float ss = 0.f;
#pragma unroll
    for (int i = 0; i < 4; ++i) ss += va[i][0] * va[i][0] + va[i][1] * va[i][1] + va[i][2] * va[i][2] + va[i][3] * va[i][3];
    ss = wave_sum(ss);
    const float rstd = rsqrtf(ss * (1.f / 1024.f) + 1e-6f);
    const float* m = mod + bia * 3072;
#pragma unroll
    for (int i = 0; i < 4; ++i) {
      const int c = i * 256 + lane * 4;
      const f32x4 sh = *(const f32x4*)(m + c), sc = *(const f32x4*)(m + 1024 + c);
      float o[4];
#pragma unroll
      for (int e = 0; e < 4; ++e) o[e] = va[i][e] * rstd * g4[i][e] * (1.f + sc[e]) + sh[e];
      st_bf16x4(H + (size_t)n * 1024 + c, o[0], o[1], o[2], o[3]);
    }
#pragma unroll
    for (int i = 0; i < 4; ++i) va[i] = vb[i];
    bia = bib;
  }
}

constexpr int LERP3_SPLIT = 63488;
__device__ __forceinline__ bf16_t* lerp_base(const Params& p, int j, int row) {
  if (j == 0) return (bf16_t*)(p.ws + OFF_Y0);
  if (j == 1) return (bf16_t*)(p.ws + OFF_Y1);
  if (j == 2) return (bf16_t*)p.out;
  if (row < LERP3_SPLIT) return (bf16_t*)p.out + (size_t)NTOK * 1024;
  return (bf16_t*)(p.ws + WS_END) - (size_t)LERP3_SPLIT * 1024;
}
struct RowX { f32x4 v[4]; int bi; };
__device__ __forceinline__ void ld_row(const Params& p, int n, int lane, RowX& r) {
  const float* src = row_src(p.in[0], p.in[2], n, r.bi);
#pragma unroll
  for (int i = 0; i < 4; ++i) r.v[i] = *(const f32x4*)(src + i * 256 + lane * 4);
}
__device__ __forceinline__ void fin_row(const float* mod, const f32x4 (&g4)[4], int lane, const RowX& r, float (&h)[16]) {
  float ss = 0.f;
#pragma unroll
  for (int i = 0; i < 4; ++i) ss += r.v[i][0] * r.v[i][0] + r.v[i][1] * r.v[i][1] + r.v[i][2] * r.v[i][2] + r.v[i][3] * r.v[i][3];
  ss = wave_sum(ss);
  const float rstd = rsqrtf(ss * (1.f / 1024.f) + 1e-6f);
  const float* m = mod + r.bi * 3072;
#pragma unroll
  for (int i = 0; i < 4; ++i) {
    const int c = i * 256 + lane * 4;
    const f32x4 sh = *(const f32x4*)(m + c), sc = *(const f32x4*)(m + 1024 + c);
#pragma unroll
    for (int e = 0; e < 4; ++e) {
      const float hv = r.v[i][e] * rstd * g4[i][e] * (1.f + sc[e]) + sh[e];
      h[4 * i + e] = __uint_as_float(cvtpk(hv, 0.f) << 16);
    }
  }
}
__device__ void phase_norm_lerp(const Params& p, const float* mod) {
  const int lane = threadIdx.x & 63, gw = blockIdx.x * 8 + (threadIdx.x >> 6), nw = gridDim.x * 8;
  const int per = (NTOK + nw - 1) / nw;
  const int r0 = gw * per, r1 = (r0 + per < NTOK) ? r0 + per : NTOK;
  if (r0 >= r1) return;
  bf16_t* H = (bf16_t*)(p.ws + OFF_H);
  f32x4 g4[4];
#pragma unroll
  for (int i = 0; i < 4; ++i) g4[i] = *(const f32x4*)(p.in[4] + i * 256 + lane * 4);
  float mu[4][16];
#pragma unroll
  for (int j = 0; j < 4; ++j)
#pragma unroll
    for (int i = 0; i < 4; ++i) {
      const f32x4 m4 = *(const f32x4*)(p.in[7] + j * 1024 + i * 256 + lane * 4);
      mu[j][4 * i] = m4[0]; mu[j][4 * i + 1] = m4[1]; mu[j][4 * i + 2] = m4[2]; mu[j][4 * i + 3] = m4[3];
    }
  float hp[16], hc[16], hn[16];
  RowX xa, xb, xc;
  if (r0 > 0) { ld_row(p, r0 - 1, lane, xc); }
  ld_row(p, r0, lane, xa);
  if (r0 + 1 < NTOK) ld_row(p, r0 + 1, lane, xb);
  if (r0 > 0) fin_row(mod, g4, lane, xc, hp);
  else {
#pragma unroll
    for (int e = 0; e < 16; ++e) hp[e] = 0.f;
  }
  fin_row(mod, g4, lane, xa, hc);
  xa = xb;
  if (r0 + 2 < NTOK) ld_row(p, r0 + 2, lane, xb);
  for (int n = r0; n < r1; ++n) {
    const int t = n % TL;
    if (n + 3 < NTOK) ld_row(p, n + 3, lane, xc);
    if (n + 1 < NTOK) fin_row(mod, g4, lane, xa, hn);
    else {
#pragma unroll
      for (int e = 0; e < 16; ++e) hn[e] = 0.f;
    }
    const float fp = (t != 0 && t != T) ? 0.5f : 0.f, fn = (t != T - 1 && t != TL - 1) ? 0.5f : 0.f;
#pragma unroll
    for (int i = 0; i < 4; ++i) st_bf16x4_nt(H + (size_t)n * 1024 + i * 256 + lane * 4, hc[4 * i], hc[4 * i + 1], hc[4 * i + 2], hc[4 * i + 3]);
#pragma unroll
    for (int j = 0; j < 4; ++j) {
      bf16_t* dst = lerp_base(p, j, n) + (size_t)n * 1024 + lane * 4;
#pragma unroll
      for (int i = 0; i < 4; ++i) {
        float o[4];
#pragma unroll
        for (int e = 0; e < 4; ++e) { const float c = hc[4 * i + e]; o[e] = c + (fp * hp[4 * i + e] + fn * hn[4 * i + e] - c) * mu[j][4 * i + e]; }
        st_bf16x4_nt(dst + i * 256, o[0], o[1], o[2], o[3]);
      }
    }
#pragma unroll
    for (int e = 0; e < 16; ++e) { hp[e] = hc[e]; hc[e] = hn[e]; }
    xa = xb; xb = xc;
  }
}

__device__ void phase_final(float* out, const float* fg) {
  const int lane = threadIdx.x & 63, gw = blockIdx.x * 8 + (threadIdx.x >> 6), nw = gridDim.x * 8;
  f32x4 g4[4];
#pragma unroll
  for (int i = 0; i < 4; ++i) g4[i] = *(const f32x4*)(fg + i * 256 + lane * 4);
  f32x4 va[4], vb[4];
  if (gw < NB * T) {
#pragma unroll
    for (int i = 0; i < 4; ++i) va[i] = *(const f32x4*)(out + (size_t)gw * D + i * 256 + lane * 4); }
  for (int n = gw; n < NB * T; n += nw) {
    if (n + nw < NB * T) {
#pragma unroll
      for (int i = 0; i < 4; ++i) vb[i] = *(const f32x4*)(out + (size_t)(n + nw) * D + i * 256 + lane * 4); }
    float ss = 0.f;
#pragma unroll
    for (int i = 0; i < 4; ++i) ss += va[i][0] * va[i][0] + va[i][1] * va[i][1] + va[i][2] * va[i][2] + va[i][3] * va[i][3];
    ss = wave_sum(ss);
    const float rstd = rsqrtf(ss * (1.f / 1024.f) + 1e-6f);
#pragma unroll
    for (int i = 0; i < 4; ++i) {
      f32x4 o;
#pragma unroll
      for (int e = 0; e < 4; ++e) o[e] = va[i][e] * rstd * g4[i][e];
      *(f32x4*)(out + (size_t)n * D + i * 256 + lane * 4) = o;
    }
#pragma unroll
    for (int i = 0; i < 4; ++i) va[i] = vb[i];
  }
}

__device__ __forceinline__ int scan_row(int g, int d, int b) {
  if (g < L) { const int tt = d ? (L - 1 - g) : g; return b * TL + T + tt; }
  g -= L; const int tt = d ? (T - 1 - g) : g; return b * TL + tt;
}
constexpr int SC_P = 0, SC_ARA = 8192, SC_ARR = SC_ARA + 4096, SC_BK = SC_ARR + 4096, SC_SCAL = SC_BK + 8192, SC_VV = SC_SCAL + 1024, SC_BUF = SC_VV + 8192;
constexpr int SC_IC = 2 * SC_BUF, SC_SCR = SC_IC + 8192, SC_YB = SC_SCR + 16384, SC_END = SC_YB + 2 * 8192;
#define MFMA16(a, b, c) __builtin_amdgcn_mfma_f32_16x16x32_bf16((a), (b), (c), 0, 0, 0)
struct ScBlk { u32x4 aa0, aa1, ar0, ar1, k0, k1, k2, k3; f32x4 v; f32x4 s[8]; };
__device__ __forceinline__ void sc_ldb(ScBlk& c, const char* buf, int blk, int arOff, int bkOff, int vOff) {
  const char* pa = buf + SC_ARA + blk * 512 + arOff; const char* pr = buf + SC_ARR + blk * 512 + arOff;
  c.aa0 = *(const u32x4*)(pa); c.aa1 = *(const u32x4*)(pa + 64); c.ar0 = *(const u32x4*)(pr); c.ar1 = *(const u32x4*)(pr + 64);
  const char* bk = buf + SC_BK + blk * 1024 + bkOff;
  c.k0 = *(const u32x4*)(bk); c.k1 = *(const u32x4*)(bk + 256); c.k2 = *(const u32x4*)(bk + 512); c.k3 = *(const u32x4*)(bk + 768);
  c.v = *(const f32x4*)(buf + SC_VV + blk * 1024 + vOff);
  const char* sp = buf + SC_SCAL + blk * 128;
#pragma unroll
  for (int i = 0; i < 8; ++i) c.s[i] = *(const f32x4*)(sp + i * 16);
}
__device__ void phase_scan(const Params& p, char* lds) {
  unsigned char* ws = p.ws;
  const int tid = threadIdx.x, lane = tid & 63, wid = __builtin_amdgcn_readfirstlane(tid >> 6), r32 = lane & 31, hi = lane >> 5;
  const bf16_t* Rg = (const bf16_t*)(ws + OFF_R); const bf16_t* Kg = (const bf16_t*)(ws + OFF_K); const bf16_t* Vg = (const bf16_t*)(ws + OFF_V);
  const bf16_t* Lg = (const bf16_t*)(ws + OFF_LORA);
  constexpr int NCH = TL / 32;
  for (int sidx = blockIdx.x; sidx < 256; sidx += gridDim.x) {
    const int d = sidx >> 7, b = (sidx >> 4) & 7, h = sidx & 15;
    bf16_t* Yg = (bf16_t*)(ws + (d ? OFF_Y1 : OFF_Y0));
    if (wid < 4) {
      const int cw = wid, c16 = lane & 15, q = lane >> 4;
      const int arOff = (c16 & 3) * 128 + q * 16, wOff = q * 16, bkOff = c16 * 16, vOff = (cw * 16 + c16) * 16;
      f32x4 St0 = {0.f, 0.f, 0.f, 0.f}, St1 = St0, St2 = St0, St3 = St0;
      __syncthreads(); __syncthreads();
      for (int c = 0; c < NCH; ++c) {
        const char* buf = lds + (c & 1) * SC_BUF;
        char* yb = lds + SC_YB + (c & 1) * 8192 + (cw * 16 + c16) * 16;
        ScBlk cur; sc_ldb(cur, buf, 0, arOff, bkOff, vOff);
#pragma unroll 1
        for (int blk = 0; blk < 8; ++blk) {
          ScBlk nxt; sc_ldb(nxt, buf, (blk + 1) & 7, arOff, bkOff, vOff);
          u32x4 b1 = {cvtpk(St0[0], St0[1]), cvtpk(St0[2], St0[3]), cvtpk(St1[0], St1[1]), cvtpk(St1[2], St1[3])};
          u32x4 b2 = {cvtpk(St2[0], St2[1]), cvtpk(St2[2], St2[3]), cvtpk(St3[0], St3[1]), cvtpk(St3[2], St3[3])};
          f32x4 sr = {0.f, 0.f, 0.f, 0.f}, yr = sr;
          sr = MFMA16(*(bf16x8*)&cur.aa0, *(bf16x8*)&b1, sr); yr = MFMA16(*(bf16x8*)&cur.ar0, *(bf16x8*)&b1, yr);
          sr = MFMA16(*(bf16x8*)&cur.aa1, *(bf16x8*)&b2, sr); yr = MFMA16(*(bf16x8*)&cur.ar1, *(bf16x8*)&b2, yr);
          const float v1 = cur.v[0], v2 = cur.v[1], v3 = cur.v[2], v4 = cur.v[3];
          const f32x4 s0 = cur.s[0], s1 = cur.s[1], s2 = cur.s[2], s3 = cur.s[3], s4 = cur.s[4], s5 = cur.s[5], s6 = cur.s[6], s7 = cur.s[7];
          const float sa1 = sr[0];
          const float sa2 = sr[1] + s0[0] * sa1 + s1[2] * v1;
          const float sa3 = sr[2] + s0[1] * sa1 + s1[3] * v1 + s0[2] * sa2 + s2[0] * v2;
          const float sa4 = sr[3] + s0[3] * sa1 + s2[1] * v1 + s1[0] * sa2 + s2[2] * v2 + s1[1] * sa3 + s2[3] * v3;
          f32x4 y;
          y[0] = yr[0] + s3[0] * sa1 + s5[2] * v1;
          y[1] = yr[1] + s3[1] * sa1 + s5[3] * v1 + s3[2] * sa2 + s6[0] * v2;
          y[2] = yr[2] + s3[3] * sa1 + s6[1] * v1 + s4[0] * sa2 + s6[2] * v2 + s4[1] * sa3 + s6[3] * v3;
          y[3] = yr[3] + s4[2] * sa1 + s7[0] * v1 + s4[3] * sa2 + s7[1] * v2 + s5[0] * sa3 + s7[2] * v3 + s5[1] * sa4 + s7[3] * v4;
          u32x4 bu = {cvtpk(sa1, v1), cvtpk(sa2, v2), cvtpk(sa3, v3), cvtpk(sa4, v4)};
          if (q != 0) { bu[0] = 0u; bu[1] = 0u; bu[2] = 0u; bu[3] = 0u; }
          St0 = MFMA16(*(bf16x8*)&cur.k0, *(bf16x8*)&bu, St0);
          St1 = MFMA16(*(bf16x8*)&cur.k1, *(bf16x8*)&bu, St1);
          St2 = MFMA16(*(bf16x8*)&cur.k2, *(bf16x8*)&bu, St2);
          St3 = MFMA16(*(bf16x8*)&cur.k3, *(bf16x8*)&bu, St3);
          *(f32x4*)(yb + blk * 1024) = y;
          cur = nxt;
          if (blk == 7) {
            const char* pw = buf + SC_P + 31 * 256 + wOff;
            St0 *= *(const f32x4*)(pw); St1 *= *(const f32x4*)(pw + 64); St2 *= *(const f32x4*)(pw + 128); St3 *= *(const f32x4*)(pw + 192);
          }
          if (blk == 3 || blk == 7) __syncthreads();
        }
      }
    } else {
      const int pw = wid - 4, ptid = tid - 256;
      const int pstep = ptid >> 3, j0 = (ptid & 7) * 8, pblk = pstep >> 2, psb = pstep & 3;
      const int apos0 = (j0 >> 5) * 32 + (((j0 & 31) & 15) >> 2) * 8 + 4 * ((j0 & 31) >> 4), apos1 = apos0 + 8;
      float* Bg = (float*)(ws + OFF_BONUS) + (size_t)d * NTOK * 16;
      float kkc[8], kac[8], rkc[8];
#pragma unroll
      for (int e = 0; e < 8; ++e) { kkc[e] = p.in[15][h * 64 + j0 + e]; kac[e] = p.in[16][h * 64 + j0 + e]; rkc[e] = p.in[17][h * 64 + j0 + e]; }
      const int mat = pw >> 1, jh = pw & 1;
      bf16x8 w2f[4]; float bias;
      {
        const float* W2 = (mat ? p.in[14] : p.in[11]) + (size_t)d * 64 * 1024;
#pragma unroll
        for (int ks = 0; ks < 4; ++ks) {
          u32x4 w;
#pragma unroll
          for (int qq = 0; qq < 4; ++qq) {
            const int r0 = ks * 16 + 8 * hi + 2 * qq;
            w[qq] = cvtpk(W2[(size_t)r0 * 1024 + h * 64 + jh * 32 + r32], W2[(size_t)(r0 + 1) * 1024 + h * 64 + jh * 32 + r32]);
          }
          w2f[ks] = *(bf16x8*)&w;
        }
        bias = (mat ? p.in[12] : p.in[9])[d * 1024 + h * 64 + jh * 32 + r32];
      }
      u32x4 pR, pK, pV; bf16x8 pl[4];
      float kk[8], kr[8], rr[8];
      float* IC = (float*)(lds + SC_IC);
      bf16_t* SCR = (bf16_t*)(lds + SC_SCR);
      auto prefetch = [&](int c) {
        const size_t row = (size_t)scan_row(c * 32 + pstep, d, b) * 1024 + h * 64 + j0;
        pR = *(const u32x4*)(Rg + row); pK = *(const u32x4*)(Kg + row); pV = *(const u32x4*)(Vg + row);
        const size_t lrow = (size_t)scan_row(c * 32 + r32, d, b);
#pragma unroll
        for (int ks = 0; ks < 4; ++ks) pl[ks] = *(const bf16x8*)(Lg + lrow * 256 + mat * 128 + d * 64 + ks * 16 + hi * 8);
      };
      auto stageA = [&](int c) {
        char* buf = lds + (c & 1) * SC_BUF;
        float* Pd = (float*)(buf + SC_P); float* VV = (float*)(buf + SC_VV);
        f32x16 acc;
#pragma unroll
        for (int r = 0; r < 16; ++r) acc[r] = 0.f;
#pragma unroll
        for (int ks = 0; ks < 4; ++ks) acc = MFMA(pl[ks], w2f[ks], acc);
        if (mat == 0) {
          float cc[16];
#pragma unroll
          for (int r = 0; r < 16; ++r) cc[r] = -0.6065306597126334f * __builtin_amdgcn_rcpf(1.f + __expf(-(acc[r] + bias)));
#pragma unroll
          for (int g = 0; g < 4; ++g) { cc[4 * g + 1] += cc[4 * g]; cc[4 * g + 2] += cc[4 * g + 1]; cc[4 * g + 3] += cc[4 * g + 2]; }
          float run = 0.f;
#pragma unroll
          for (int g = 0; g < 4; ++g) {
            const float own = cc[4 * g + 3];
            auto rr2 = __builtin_amdgcn_permlane32_swap(__float_as_uint(own), __float_as_uint(own), false, false);
            const float both = __uint_as_float(rr2[0]) + __uint_as_float(rr2[1]), partner = both - own;
            const float off = hi ? run + partner : run;
#pragma unroll
            for (int e = 0; e < 4; ++e) Pd[crow(4 * g + e, hi) * 64 + jh * 32 + r32] = __expf(off + cc[4 * g + e]);
            run += both;
          }
        } else {
#pragma unroll
          for (int r = 0; r < 16; ++r) IC[crow(r, hi) * 64 + jh * 32 + r32] = __builtin_amdgcn_rcpf(1.f + __expf(-(acc[r] + bias)));
        }
        float ss = 0.f;
#pragma unroll
        for (int w = 0; w < 4; ++w) {
          rr[2 * w] = lo16(pR[w]); rr[2 * w + 1] = hi16(pR[w]);
          kr[2 * w] = lo16(pK[w]); kr[2 * w + 1] = hi16(pK[w]);
        }
        const float vv[8] = {lo16(pV[0]), hi16(pV[0]), lo16(pV[1]), hi16(pV[1]), lo16(pV[2]), hi16(pV[2]), lo16(pV[3]), hi16(pV[3])};
        if (c + 1 < NCH) prefetch(c + 1);
#pragma unroll
        for (int e = 0; e < 8; ++e) VV[(pblk * 64 + j0 + e) * 4 + psb] = vv[e];
#pragma unroll
        for (int e = 0; e < 8; ++e) { kk[e] = kr[e] * kkc[e]; ss += kk[e] * kk[e]; }
        ss = red8(ss);
        const float inv = rsqrtf(fmaxf(ss, 1e-24f));
#pragma unroll
        for (int e = 0; e < 8; ++e) kk[e] *= inv;
      };
      auto stageB = [&](int c) {
        char* buf = lds + (c & 1) * SC_BUF;
        const f32x4 i0 = *(const f32x4*)(IC + pstep * 64 + j0), i1 = *(const f32x4*)(IC + pstep * 64 + j0 + 4);
        const float ic[8] = {i0[0], i0[1], i0[2], i0[3], i1[0], i1[1], i1[2], i1[3]};
        const float* Pt = (const float*)(buf + SC_P) + pstep * 64 + j0;
        const f32x4 pt0 = *(const f32x4*)(Pt), pt1 = *(const f32x4*)(Pt + 4);
        f32x4 pm0 = {1.f, 1.f, 1.f, 1.f}, pm1 = pm0;
        if (pstep > 0) { pm0 = *(const f32x4*)(Pt - 64); pm1 = *(const f32x4*)(Pt - 60); }
        const float pt[8] = {pt0[0], pt0[1], pt0[2], pt0[3], pt1[0], pt1[1], pt1[2], pt1[3]};
        const float pm[8] = {pm0[0], pm0[1], pm0[2], pm0[3], pm1[0], pm1[1], pm1[2], pm1[3]};
        const u32x4 an = {cvtpk(-kk[0] * pm[0], -kk[1] * pm[1]), cvtpk(-kk[2] * pm[2], -kk[3] * pm[3]), cvtpk(-kk[4] * pm[4], -kk[5] * pm[5]), cvtpk(-kk[6] * pm[6], -kk[7] * pm[7])};
        const u32x4 rn = {cvtpk(rr[0] * pt[0], rr[1] * pt[1]), cvtpk(rr[2] * pt[2], rr[3] * pt[3]), cvtpk(rr[4] * pt[4], rr[5] * pt[5]), cvtpk(rr[6] * pt[6], rr[7] * pt[7])};
        bf16_t* ARa = (bf16_t*)(buf + SC_ARA) + (pblk * 4 + psb) * 64; bf16_t* ARr = (bf16_t*)(buf + SC_ARR) + (pblk * 4 + psb) * 64;
        { u32x2 lo = {an[0], an[1]}, hi2 = {an[2], an[3]}; *(u32x2*)(ARa + apos0) = lo; *(u32x2*)(ARa + apos1) = hi2; }
        { u32x2 lo = {rn[0], rn[1]}, hi2 = {rn[2], rn[3]}; *(u32x2*)(ARr + apos0) = lo; *(u32x2*)(ARr + apos1) = hi2; }
        *(u32x4*)(SCR + (pstep * 4 + 0) * 64 + j0) = an; *(u32x4*)(SCR + (pstep * 4 + 1) * 64 + j0) = rn;
        float bs = 0.f;
        unsigned bq[8], kq[8];
        unsigned* BK = (unsigned*)(buf + SC_BK) + (pblk * 64 + j0) * 4 + psb;
#pragma unroll
        for (int e = 0; e < 8; ++e) {
          const float kd = kr[e] * (1.f + (ic[e] - 1.f) * kac[e]);
          const float ip = __builtin_amdgcn_rcpf(pt[e]);
          const unsigned pr2 = cvtpk(kk[e] * ic[e] * ip, kd * ip);
          BK[e * 4] = pr2;
          bq[e] = pr2 & 0xffffu; kq[e] = pr2 >> 16;
          bs += rr[e] * kd * rkc[e];
        }
        const u32x4 bn = {bq[0] | (bq[1] << 16), bq[2] | (bq[3] << 16), bq[4] | (bq[5] << 16), bq[6] | (bq[7] << 16)};
        const u32x4 kn = {kq[0] | (kq[1] << 16), kq[2] | (kq[3] << 16), kq[4] | (kq[5] << 16), kq[6] | (kq[7] << 16)};
        *(u32x4*)(SCR + (pstep * 4 + 2) * 64 + j0) = bn; *(u32x4*)(SCR + (pstep * 4 + 3) * 64 + j0) = kn;
        bs = red8(bs);
        if ((ptid & 7) == 0) Bg[(size_t)scan_row(c * 32 + pstep, d, b) * 16 + h] = bs;
      };
      auto stageC = [&](int c) {
        char* buf = lds + (c & 1) * SC_BUF;
        asm volatile("s_waitcnt lgkmcnt(0)" ::: "memory");
        const int n16 = lane & 15, q4 = lane >> 4;
        const int stepA = (2 * pw + (n16 >> 3)) * 4 + (n16 & 3);
        const bf16_t* Xr = SCR + (stepA * 4 + 2 + ((n16 >> 2) & 1)) * 64 + q4 * 8;
        const bf16_t* Yc = SCR + (stepA * 4 + ((n16 >> 2) & 1)) * 64 + q4 * 8;
        f32x4 g = {0.f, 0.f, 0.f, 0.f};
        g = MFMA16(*(const bf16x8*)(Xr), *(const bf16x8*)(Yc), g);
        g = MFMA16(*(const bf16x8*)(Xr + 32), *(const bf16x8*)(Yc + 32), g);
        const int ctype = (n16 >> 2) & 1, t0 = n16 & 3, rtype = q4 & 1;
        const int grp = ctype * 2 + rtype, base = grp == 0 ? 0 : (grp == 1 ? 6 : (grp == 2 ? 12 : 22));
        float* sc = (float*)(buf + SC_SCAL) + (2 * pw + (n16 >> 3)) * 32 + base + (ctype ? (t0 + 1) * t0 / 2 : t0 * (t0 - 1) / 2);
        if ((q4 >> 1) == (n16 >> 3)) {
#pragma unroll
          for (int e = 0; e < 4; ++e) if (ctype ? (e <= t0) : (e < t0)) sc[e] = g[e];
        }
      };
      auto writeout = [&](int c) {
        const float* Yb = (const float*)(lds + SC_YB + (c & 1) * 8192) + (pblk * 64 + j0) * 4 + psb;
        u32x4 w = {cvtpk(Yb[0], Yb[4]), cvtpk(Yb[8], Yb[12]), cvtpk(Yb[16], Yb[20]), cvtpk(Yb[24], Yb[28])};
        *(u32x4*)(Yg + (size_t)scan_row(c * 32 + pstep, d, b) * 1024 + h * 64 + j0) = w;
      };
      prefetch(0);
      stageA(0);
      __syncthreads();
      stageB(0); stageC(0);
      __syncthreads();
      for (int c = 0; c < NCH; ++c) {
        if (c >= 1) writeout(c - 1);
        if (c + 1 < NCH) stageA(c + 1);
        __syncthreads();
        if (c + 1 < NCH) { stageB(c + 1); stageC(c + 1); }
        __syncthreads();
      }
      writeout(NCH - 1);
    }
    __syncthreads();
  }
}

__device__ void phase_readout(const Params& p) {
  unsigned char* ws = p.ws;
  const bf16_t* Y0 = (const bf16_t*)(ws + OFF_Y0); const bf16_t* Y1 = (const bf16_t*)(ws + OFF_Y1); const bf16_t* Vg = (const bf16_t*)(ws + OFF_V);
  bf16_t* G = (bf16_t*)(ws + OFF_G);
  const float* B0 = (const float*)(ws + OFF_BONUS); const float* B1 = B0 + (size_t)NTOK * 16;
  const int lane = threadIdx.x & 63, gw = blockIdx.x * 8 + (threadIdx.x >> 6), nw = gridDim.x * 8;
  const int c0 = lane * 16, hd = lane >> 2;
  float lg[16], lb[16];
#pragma unroll
  for (int e = 0; e < 16; ++e) { lg[e] = p.in[18][c0 + e]; lb[e] = p.in[19][c0 + e]; }
  struct RowIn { u32x4 a[2], b[2], v[2], g[2]; float b0, b1; };
  auto ldr = [&](int n, RowIn& r) {
    const size_t o = (size_t)n * 1024 + c0;
#pragma unroll
    for (int q = 0; q < 2; ++q) { r.a[q] = *(const u32x4*)(Y0 + o + 8 * q); r.b[q] = *(const u32x4*)(Y1 + o + 8 * q); r.v[q] = *(const u32x4*)(Vg + o + 8 * q); r.g[q] = *(const u32x4*)(G + o + 8 * q); }
    r.b0 = B0[(size_t)n * 16 + hd]; r.b1 = B1[(size_t)n * 16 + hd];
  };
  RowIn cur, nxt;
  if (gw < NTOK) ldr(gw, cur);
  for (int n = gw; n < NTOK; n += nw) {
    if (n + nw < NTOK) ldr(n + nw, nxt);
    const size_t o = (size_t)n * 1024 + c0;
    float y[16], v[16], g[16];
#pragma unroll
    for (int q = 0; q < 2; ++q) {
#pragma unroll
      for (int w = 0; w < 4; ++w) {
        y[8 * q + 2 * w] = lo16(cur.a[q][w]) + lo16(cur.b[q][w]); y[8 * q + 2 * w + 1] = hi16(cur.a[q][w]) + hi16(cur.b[q][w]);
        v[8 * q + 2 * w] = lo16(cur.v[q][w]); v[8 * q + 2 * w + 1] = hi16(cur.v[q][w]);
        g[8 * q + 2 * w] = lo16(cur.g[q][w]); g[8 * q + 2 * w + 1] = hi16(cur.g[q][w]);
      }
    }
    float s = 0.f;
#pragma unroll
    for (int e = 0; e < 16; ++e) s += y[e];
    s += dpp_f(s, 0); s += dpp_f(s, 1);
    const float mean = s * (1.f / 64.f);
    float q2 = 0.f;
#pragma unroll
    for (int e = 0; e < 16; ++e) { const float dlt = y[e] - mean; q2 += dlt * dlt; }
    q2 += dpp_f(q2, 0); q2 += dpp_f(q2, 1);
    const float rs = rsqrtf(q2 * (1.f / 64.f) + 64e-5f);
    const float bonus = cur.b0 + cur.b1;
    float r[16];
#pragma unroll
    for (int e = 0; e < 16; ++e) {
      const float yn = (y[e] - mean) * rs * lg[e] + lb[e];
      r[e] = (yn + bonus * v[e]) * (g[e] * sigmoidf_(g[e]));
    }
    u32x4 w0 = {cvtpk(r[0], r[1]), cvtpk(r[2], r[3]), cvtpk(r[4], r[5]), cvtpk(r[6], r[7])};
    u32x4 w1 = {cvtpk(r[8], r[9]), cvtpk(r[10], r[11]), cvtpk(r[12], r[13]), cvtpk(r[14], r[15])};
    *(u32x4*)(G + o) = w0; *(u32x4*)(G + o + 8) = w1;
    cur = nxt;
  }
}

constexpr int AT_SHMV = 16384, AT_KROW = 208, AT_SHMK = 64 * AT_KROW;
constexpr int AT_KOFF = 2 * AT_SHMV, AT_WOFF = AT_KOFF + 2 * AT_SHMK;
#define SBAR() __builtin_amdgcn_sched_barrier(0)
__device__ __forceinline__ void at_partialSM(f32x16& p0, f32x16& p1, float& m_reg, float& alpha, bool force) {
  float pm = p0[0];
#pragma unroll
  for (int r = 1; r < 16; ++r) pm = fmaxf(pm, p0[r]);
#pragma unroll
  for (int r = 0; r < 16; ++r) pm = fmaxf(pm, p1[r]);
  { auto rr = __builtin_amdgcn_permlane32_swap(__float_as_uint(pm), __float_as_uint(pm), false, false);
    pm = fmaxf(__uint_as_float(rr[0]), __uint_as_float(rr[1])); }
  if (__builtin_expect(!force && __all(pm <= AT_THR * 1.4426950408889634f), 1)) { alpha = 1.f; }
  else {
    const float dlt = force ? pm : fmaxf(pm, 0.f);
    alpha = force ? 1.f : __builtin_amdgcn_exp2f(-dlt); m_reg += dlt;
#pragma unroll
    for (int r = 0; r < 16; ++r) { p0[r] -= dlt; p1[r] -= dlt; }
  }
#pragma unroll
  for (int r = 0; r < 16; ++r) p0[r] = __builtin_amdgcn_exp2f(p0[r]);
}
__device__ __forceinline__ void at_finishSM(f32x16& p0, f32x16& p1, float alpha, float& l_reg, bf16x8& pa0, bf16x8& pa1, bf16x8& pa2, bf16x8& pa3) {
#pragma unroll
  for (int r = 0; r < 16; ++r) p1[r] = __builtin_amdgcn_exp2f(p1[r]);
  float ps = 0;
#pragma unroll
  for (int r = 0; r < 16; ++r) ps += p0[r];
#pragma unroll
  for (int r = 0; r < 16; ++r) ps += p1[r];
  { auto rr = __builtin_amdgcn_permlane32_swap(__float_as_uint(ps), __float_as_uint(ps), false, false);
    ps = __uint_as_float(rr[0]) + __uint_as_float(rr[1]); }
  l_reg = l_reg * alpha + ps;
#define PK4(P, BASE, OUT) do { unsigned a0 = cvtpk(P[BASE + 0], P[BASE + 1]), a1 = cvtpk(P[BASE + 2], P[BASE + 3]);   \
    unsigned b0 = cvtpk(P[BASE + 4], P[BASE + 5]), b1 = cvtpk(P[BASE + 6], P[BASE + 7]);                              \
    auto r0 = __builtin_amdgcn_permlane32_swap(a0, b0, false, false); auto r1 = __builtin_amdgcn_permlane32_swap(a1, b1, false, false); \
    u32x4 w = {r0[0], r1[0], r0[1], r1[1]}; OUT = *reinterpret_cast<bf16x8*>(&w); } while (0)
  PK4(p0, 0, pa0); PK4(p0, 8, pa1); PK4(p1, 0, pa2); PK4(p1, 8, pa3);
#undef PK4
}
__device__ __forceinline__ void at_qkt(f32x16& p0, f32x16& p1, const char* Ks, const bf16x8* qr, int r32, int hi, float negm) {
#pragma unroll
  for (int r = 0; r < 16; ++r) { p0[r] = negm; p1[r] = negm; }
#pragma unroll
  for (int d0 = 0; d0 < 6; ++d0) {
    const bf16x8 b0 = *(const bf16x8*)(Ks + r32 * AT_KROW + d0 * 32 + hi * 16);
    const bf16x8 b1 = *(const bf16x8*)(Ks + (32 + r32) * AT_KROW + d0 * 32 + hi * 16);
    p0 = MFMA(b0, qr[d0], p0);
    p1 = MFMA(b1, qr[d0], p1);
  }
}
__device__ __forceinline__ int v_st(int k, int c) { const int kk = (k & ~0xC) | ((k & 4) << 1) | ((k & 8) >> 1); return ((kk >> 3) * 4 + (c >> 5)) * 512 + ((kk & 7) * 32 + (c & 31)) * 2; }
__device__ __forceinline__ int v_rd_base(int lane) { return ((lane & 3) << 3) | (((lane >> 2) & 3) << 6) | (((lane >> 4) & 1) << 5) | (((lane >> 5) & 1) << 8); }
constexpr int v_rd_off(int d0, int ks, int half) { return d0 * 512 + ks * 4096 + half * 2048; }
template <int OFF> __device__ __forceinline__ s16x4 tr_read(int vb) {
  s16x4 r; asm volatile("ds_read_b64_tr_b16 %0, %1 offset:%2" : "=&v"(r) : "v"(vb), "i"(OFF) : "memory"); return r;
}
template <int D0> __device__ __forceinline__ void pv_one(f32x16& od, int vb, bf16x8 pa0, bf16x8 pa1, bf16x8 pa2, bf16x8 pa3) {
  const s16x4 l0 = tr_read<v_rd_off(D0, 0, 0)>(vb), h0 = tr_read<v_rd_off(D0, 0, 1)>(vb), l1 = tr_read<v_rd_off(D0, 1, 0)>(vb), h1 = tr_read<v_rd_off(D0, 1, 1)>(vb);
  const s16x4 l2 = tr_read<v_rd_off(D0, 2, 0)>(vb), h2 = tr_read<v_rd_off(D0, 2, 1)>(vb), l3 = tr_read<v_rd_off(D0, 3, 0)>(vb), h3 = tr_read<v_rd_off(D0, 3, 1)>(vb);
  asm volatile("s_waitcnt lgkmcnt(0)" ::: "memory"); SBAR();
#define PK(Lx, Hx) (bf16x8){Lx[0], Lx[1], Lx[2], Lx[3], Hx[0], Hx[1], Hx[2], Hx[3]}
  od = MFMA(pa0, PK(l0, h0), od);
  od = MFMA(pa1, PK(l1, h1), od);
  od = MFMA(pa2, PK(l2, h2), od);
  od = MFMA(pa3, PK(l3, h3), od);
#undef PK
}
__device__ __forceinline__ void pv_d0(f32x16* o, int vb, bf16x8 pa0, bf16x8 pa1, bf16x8 pa2, bf16x8 pa3) {
  pv_one<0>(o[0], vb, pa0, pa1, pa2, pa3); pv_one<1>(o[1], vb, pa0, pa1, pa2, pa3);
}

__device__ void phase_attn(const Params& p, char* lds) {
  unsigned char* ws = p.ws;
  const bf16_t* Qg = (const bf16_t*)(ws + OFF_Q); const bf16_t* KVg = (const bf16_t*)(ws + OFF_KV); const bf16_t* KPg = (const bf16_t*)(ws + OFF_KPE);
  bf16_t* G1 = (bf16_t*)(ws + OFF_G1);
  const f32x2* rope = (const f32x2*)(ws + OFF_ROPE);
  const int tid = threadIdx.x, wid = tid >> 6, lane = tid & 63, r32 = lane & 31, hi = lane >> 5;
  char* V_lds = lds; char* K_lds = lds + AT_KOFF;
  float* wsl = (float*)(lds + AT_WOFF) + wid * 64; float* li_l = wsl; float* al_l = wsl + 32;
  const int skey = tid >> 3, sc8 = (tid & 7) * 8;
  const int pkey = (tid & 255) >> 2, pc8 = (tid & 3) * 8;
  const int vst = v_st(skey, sc8), kst = skey * AT_KROW + sc8 * 2, pst = pkey * AT_KROW + (64 + pc8) * 2;
  const int vb0 = (int)(uintptr_t)V_lds + v_rd_base(lane);
  const int nitems = NB * 16 * 32;
  const int xcd = blockIdx.x & 7, slot = blockIdx.x >> 3, per = gridDim.x >> 3;
  for (int it = slot; it < nitems / 8; it += per) {
    const int pair = (it >> 5) * 8 + xcd, qblk = it & 31;
    const int b = pair >> 4, h = pair & 15;
    const size_t row0 = (size_t)b * TL;
    const size_t qrow = row0 + qblk * 256 + wid * 32 + r32;
    const bf16_t* Kh = KVg + row0 * 2048 + h * 128;
    const bf16_t* Kp = KPg + row0 * 32;
    float m_reg = 0.f, l_reg = 0.f;
    f32x16 o[2];
#pragma unroll
    for (int dd = 0; dd < 2; ++dd)
#pragma unroll
      for (int r = 0; r < 16; ++r) o[dd][r] = 0.f;
    bf16x8 qr[6];
    {
      const bf16_t* Qw = Qg + qrow * 1536 + h * 96 + hi * 8;
#pragma unroll
      for (int d0 = 0; d0 < 6; ++d0) qr[d0] = *(const bf16x8*)(Qw + d0 * 16);
      const int t = qblk * 256 + wid * 32 + r32;
      const f32x2* tb = rope + (hi ? (t & 63) : (t >> 6)) * 8;
      const u32x4 x1 = *(const u32x4*)&qr[4], x2 = *(const u32x4*)&qr[5];
      u32x4 n1, n2;
#pragma unroll
      for (int q = 0; q < 4; ++q) {
        const f32x2 csA = tb[2 * q], csB = tb[2 * q + 1];
        const float a0 = lo16(x1[q]), a1 = hi16(x1[q]), b0 = lo16(x2[q]), b1 = hi16(x2[q]);
        n1[q] = cvtpk(a0 * csA[0] - b0 * csA[1], a1 * csB[0] - b1 * csB[1]);
        n2[q] = cvtpk(a0 * csA[1] + b0 * csA[0], a1 * csB[1] + b1 * csB[0]);
      }
      qr[4] = *(bf16x8*)&n1; qr[5] = *(bf16x8*)&n2;
    }
    struct { bf16x8 vs, ks, ps; } sr_[2];
#define SLOAD(i, k0) do { sr_[i].vs = *(const bf16x8*)(Kh + (size_t)((k0) + skey) * 2048 + 64 + sc8); \
    sr_[i].ks = *(const bf16x8*)(Kh + (size_t)((k0) + skey) * 2048 + sc8); \
    sr_[i].ps = *(const bf16x8*)(Kp + (size_t)((k0) + pkey) * 32 + pc8); } while (0)
#define SWRITE(bb, i) do { *(bf16x8*)(V_lds + (bb) * AT_SHMV + vst) = sr_[i].vs; \
    *(bf16x8*)(K_lds + (bb) * AT_SHMK + kst) = sr_[i].ks; \
    *(bf16x8*)(K_lds + (bb) * AT_SHMK + pst) = sr_[i].ps; } while (0)
#define SWAIT() asm volatile("s_waitcnt vmcnt(3)" ::: "memory")
#define RESC(a) do { if (__any((a) < 1.f)) { if (hi == 0) al_l[r32] = (a); asm volatile("s_waitcnt lgkmcnt(0)" ::: "memory"); \
    _Pragma("unroll") for (int dd = 0; dd < 2; ++dd) _Pragma("unroll") for (int r = 0; r < 16; ++r) o[dd][r] *= al_l[crow(r, hi)]; } } while (0)
    f32x16 pA0, pA1, pB0, pB1; float alA, alB; bf16x8 pa0, pa1, pa2, pa3;
    constexpr int NT = TL / 64;
    SLOAD(0, 0); asm volatile("s_waitcnt vmcnt(0)" ::: "memory"); SWRITE(0, 0); __syncthreads();
    at_qkt(pA0, pA1, K_lds, qr, r32, hi, 0.f); at_partialSM(pA0, pA1, m_reg, alA, true);
    SLOAD(1, 64); SLOAD(0, 128);
    SWAIT(); SWRITE(1, 1); __syncthreads();
    for (int j = 1; j + 1 < NT; j += 2) {
      SBAR(); at_qkt(pB0, pB1, K_lds + AT_SHMK, qr, r32, hi, -m_reg);
      at_finishSM(pA0, pA1, alA, l_reg, pa0, pa1, pa2, pa3); SBAR();
      SLOAD(1, (j + 2) * 64); SBAR();
      pv_d0(o, vb0, pa0, pa1, pa2, pa3); at_partialSM(pB0, pB1, m_reg, alB, false);
      __syncthreads(); SWAIT(); SWRITE(0, 0);
      RESC(alB); __syncthreads();
      SBAR(); at_qkt(pA0, pA1, K_lds, qr, r32, hi, -m_reg);
      at_finishSM(pB0, pB1, alB, l_reg, pa0, pa1, pa2, pa3); SBAR();
      if (j + 3 < NT) SLOAD(0, (j + 3) * 64); SBAR();
      pv_d0(o, vb0 + AT_SHMV, pa0, pa1, pa2, pa3); at_partialSM(pA0, pA1, m_reg, alA, false);
      __syncthreads(); SWAIT(); SWRITE(1, 1);
      RESC(alA); __syncthreads();
    }
    SBAR(); at_qkt(pB0, pB1, K_lds + AT_SHMK, qr, r32, hi, -m_reg);
    at_finishSM(pA0, pA1, alA, l_reg, pa0, pa1, pa2, pa3); SBAR();
    pv_d0(o, vb0, pa0, pa1, pa2, pa3); at_partialSM(pB0, pB1, m_reg, alB, false);
    __syncthreads(); RESC(alB);
    at_finishSM(pB0, pB1, alB, l_reg, pa0, pa1, pa2, pa3); SBAR();
    pv_d0(o, vb0 + AT_SHMV, pa0, pa1, pa2, pa3);
    if (hi == 0) li_l[r32] = l_reg;
    asm volatile("s_waitcnt lgkmcnt(0)" ::: "memory");
    float rli[16];
#pragma unroll
    for (int r = 0; r < 16; ++r) rli[r] = __builtin_amdgcn_rcpf(li_l[crow(r, hi)]);
    bf16_t* Gw = G1 + (row0 + qblk * 256 + wid * 32) * 1024 + h * 64 + r32;
    bf16_t gin[32];
#pragma unroll
    for (int r = 0; r < 16; ++r) { gin[2 * r] = Gw[(size_t)crow(r, hi) * 1024]; gin[2 * r + 1] = Gw[(size_t)crow(r, hi) * 1024 + 32]; }
    asm volatile("" ::: "memory");
#pragma unroll
    for (int r = 0; r < 16; ++r) {
      const int orow = crow(r, hi);
#pragma unroll
      for (int d0 = 0; d0 < 2; ++d0) {
        const float gt = bf2f(gin[2 * r + d0]);
        Gw[(size_t)orow * 1024 + d0 * 32] = f2bf(o[d0][r] * rli[r] * gt * sigmoidf_(gt));
      }
    }
    __syncthreads();
#undef SLOAD
#undef SWRITE
#undef SWAIT
#undef RESC
  }
}

struct XcdWalk {
  int start, count, step, idx;
  __device__ __forceinline__ void init(int ntiles) {
    const int x = blockIdx.x & 7, base = ntiles >> 3, rem = ntiles & 7;
    count = base + (x < rem ? 1 : 0); start = x * base + (x < rem ? x : rem); step = gridDim.x >> 3; idx = blockIdx.x >> 3;
  }
  __device__ __forceinline__ bool next(int& o) { if (idx >= count) return false; o = start + idx; idx += step; return true; }
};
__device__ __forceinline__ void tile_mn(int o, int NT, int& mt, int& nt) { const int g = o >> 3; mt = (g / NT) * 8 + (o & 7); nt = g % NT; }

__global__ __launch_bounds__(NTHR, 1) void fwd_megakernel(Params p) {
  extern __shared__ __attribute__((aligned(16))) char lds[];
  cg::grid_group grid = cg::this_grid();
  unsigned char* ws = p.ws;
  bf16_t* H = (bf16_t*)(ws + OFF_H);
  float* mod = (float*)(ws + OFF_MOD);
  float* CTX1 = (float*)(ws + OFF_CTX1);

  phase_prologue(p, lds);
  grid.sync();
  phase_norm_lerp(p, mod);
  phase_weights(p, lds);
  grid.sync();
  {
    const bf16_t* WIN0 = (const bf16_t*)(ws + OFF_WIN0);
    const int nbig = 264 * 16;
    XcdWalk wk; wk.init(nbig); int o;
    while (wk.next(o)) {
      EpiBf16 e; e.invK = 0.f; e.scr = lds + G_EPI_SCR;
      {
        int mt, jn; tile_mn(o, 16, mt, jn);
        const int j = jn >> 2, n4 = jn & 3, m0 = mt * 256;
        e.dst = (bf16_t*)(ws + OFF_R + (size_t)j * U); e.ldd = 1024; e.col0 = n4 * 256; e.act = 0; e.m0 = m0;
        gemm_tile<0, 256>(lerp_base(p, j, m0), 1024, WIN0 + (size_t)(j * 1024 + n4 * 256) * 1024, 1024, m0, nullptr, lds, e);
      }
    }
    wk.init(264 * 2);
    while (wk.next(o)) {
      EpiBf16 e; e.invK = 0.f; e.scr = lds + G_EPI_SCR;
      {
        int mt, n2; tile_mn(o, 2, mt, n2);
        const int nt = 32 + n2, m0 = mt * 256;
        e.dst = (bf16_t*)(ws + OFF_LORA); e.ldd = 256; e.col0 = (nt - 32) * 128; e.act = (nt == 32) ? 1 : 0; e.m0 = m0;
        gemm_tile<1, 128>(H, 1024, WIN0 + (size_t)nt * 128 * 1024, 1024, m0, p.in[7] + (nt - 28) * 1024, lds, e);
      }
    }
  }
  grid.sync();
  phase_scan(p, lds);
  grid.sync();
  phase_readout(p);
  grid.sync();
  {
    const bf16_t* A = (const bf16_t*)(ws + OFF_G); const bf16_t* W = (const bf16_t*)(ws + OFF_WOUT0);
    XcdWalk wk; wk.init(264 * 4); int o;
    while (wk.next(o)) {
      int mt, nt; tile_mn(o, 4, mt, nt);
      const int m0 = mt * 256;
      const int b = m0 / TL, t0 = m0 - b * TL;
      EpiResid e;
      if (t0 < T) { const size_t orow = (size_t)b * T + t0; e.xin = p.in[0] + orow * 1024; e.xout = p.out + orow * 1024; e.gvec = mod + (size_t)b * 3072 + 2048; }
      else { const size_t orow = (size_t)b * L + (t0 - T); e.xin = p.in[2] + orow * 1024; e.xout = CTX1 + orow * 1024; e.gvec = mod + (size_t)8 * 3072 + 2048; }
      e.n0 = nt * 256; e.scr = lds + G_EPI_SCR;
      gemm_tile<0, 256>(A, 1024, W + (size_t)nt * 256 * 1024, 1024, m0, nullptr, lds, e);
    }
  }
  grid.sync();
  phase_norm(p.out, CTX1, p.in[4] + 1024, mod + 9 * 3072, H);
  grid.sync();
  {
    const bf16_t* W = (const bf16_t*)(ws + OFF_WIN1);
    XcdWalk wk; wk.init(264 * 7); int o;
    while (wk.next(o)) {
      int mt, nt; tile_mn(o, 7, mt, nt);
      const int m0 = mt * 256;
      EpiMlaIn e; e.QC = (bf16_t*)(ws + OFF_QC); e.KVC = (bf16_t*)(ws + OFF_KVC); e.KPE = (bf16_t*)(ws + OFF_KPE); e.G1 = (bf16_t*)(ws + OFF_G1);
      e.rope = (const float*)(ws + OFF_ROPE); e.n0 = nt * 256; e.m0 = m0; e.scr = lds + G_EPI_SCR;
      gemm_tile<0, 256>(H, 1024, W + (size_t)nt * 256 * 1024, 1024, m0, nullptr, lds, e);
    }
  }
  grid.sync();
  {
    const bf16_t* WQ = (const bf16_t*)(ws + OFF_WQB); const bf16_t* WKV = (const bf16_t*)(ws + OFF_WKVB);
    const int nq = 256 * 6, nkv = 264 * 8;
    XcdWalk wk; wk.init(nq); int o;
    while (wk.next(o)) {
      EpiBf16 e; e.act = 0; e.scr = lds + G_EPI_SCR;
      {
        int mt2, nt; tile_mn(o, 6, mt2, nt);
        const int b = mt2 >> 5, m0 = b * TL + (mt2 & 31) * 256;
        e.dst = (bf16_t*)(ws + OFF_Q); e.ldd = 1536; e.col0 = nt * 256; e.m0 = m0; e.invK = 1.f / 384.f;
        gemm_tile<2, 256>((const bf16_t*)(ws + OFF_QC), 384, WQ + (size_t)nt * 256 * 384, 384, m0, nullptr, lds, e);
      }
    }
    wk.init(nkv);
    while (wk.next(o)) {
      EpiBf16 e; e.act = 0; e.scr = lds + G_EPI_SCR;
      {
        int mt, nt; tile_mn(o, 8, mt, nt);
        const int m0 = mt * 256;
        e.dst = (bf16_t*)(ws + OFF_KV); e.ldd = 2048; e.col0 = nt * 256; e.m0 = m0; e.invK = 1.f / 256.f;
        gemm_tile<2, 256>((const bf16_t*)(ws + OFF_KVC), 256, WKV + (size_t)nt * 256 * 256, 256, m0, nullptr, lds, e);
      }
    }
  }
  grid.sync();
  phase_attn(p, lds);
  grid.sync();
  {
    const bf16_t* A = (const bf16_t*)(ws + OFF_G1); const bf16_t* W = (const bf16_t*)(ws + OFF_WOUT1);
    XcdWalk wk; wk.init(256 * 4); int o;
    while (wk.next(o)) {
      int mt2, nt; tile_mn(o, 4, mt2, nt);
      const int b = mt2 >> 5, t0 = (mt2 & 31) * 256, m0 = b * TL + t0;
      const size_t orow = (size_t)b * T + t0;
      EpiResid e; e.xin = p.out + orow * 1024; e.xout = p.out + orow * 1024; e.gvec = mod + (size_t)(9 + b) * 3072 + 2048; e.n0 = nt * 256; e.scr = lds + G_EPI_SCR;
      gemm_tile<0, 256>(A, 1024, W + (size_t)nt * 256 * 1024, 1024, m0, nullptr, lds, e);
    }
  }
  grid.sync();
  phase_final(p.out, p.in[27]);
}

extern "C" void kernel_launch(void* const* d_in, const int* in_sizes, int n_in, void* d_out, int out_size, void* d_ws, size_t ws_size, hipStream_t stream) {
  static int grid_blocks = 0;
  if (grid_blocks == 0) {
    if (n_in != 28 || ws_size < WS_END + (size_t)(NTOK - LERP3_SPLIT) * 2048 || out_size != NB * T * D) { fprintf(stderr, "kernel_launch: unexpected shapes (n_in %d, ws %zu need %zu, out %d)\n", n_in, ws_size, (size_t)WS_END, out_size); grid_blocks = -1; return; }
    int dev = 0, cus = 0, per_cu = 0;
    hipGetDevice(&dev);
    hipDeviceGetAttribute(&cus, hipDeviceAttributeMultiprocessorCount, dev);
    if (hipFuncSetAttribute((const void*)fwd_megakernel, hipFuncAttributeMaxDynamicSharedMemorySize, LDS_BYTES) != hipSuccess) { fprintf(stderr, "kernel_launch: hipFuncSetAttribute failed\n"); grid_blocks = -1; return; }
    hipOccupancyMaxActiveBlocksPerMultiprocessor(&per_cu, (const void*)fwd_megakernel, NTHR, LDS_BYTES);
    if (per_cu < 1) { fprintf(stderr, "kernel_launch: occupancy query says %d blocks per CU\n", per_cu); per_cu = 1; }
    (void)hipGetLastError();
    grid_blocks = cus;
    if (grid_blocks > 256) grid_blocks = 256;
    grid_blocks &= ~7;
  }
  if (grid_blocks <= 0) return;
  Params p{};
  for (int i = 0; i < 28; ++i) p.in[i] = (const float*)d_in[i];
  p.out = (float*)d_out; p.ws = (unsigned char*)d_ws;
  void* args[] = {&p};
  hipError_t e = hipLaunchCooperativeKernel((const void*)fwd_megakernel, dim3(grid_blocks), dim3(NTHR), args, LDS_BYTES, stream);
  if (e != hipSuccess) fprintf(stderr, "cooperative launch failed: %s (grid %d)\n", hipGetErrorString(e), grid_blocks);
}
```

```cpp
#include <hip/hip_runtime.h>
#include <hip/hip_cooperative_groups.h>
#include <cstdio>
#include <cstdint>
namespace cg = cooperative_groups;

typedef unsigned short bf16_t;
typedef short bf16x8 __attribute__((ext_vector_type(8)));
typedef short s16x4 __attribute__((ext_vector_type(4)));
typedef float f32x16 __attribute__((ext_vector_type(16)));
typedef float f32x4 __attribute__((ext_vector_type(4)));
typedef float f32x2 __attribute__((ext_vector_type(2)));
typedef unsigned u32x4 __attribute__((ext_vector_type(4)));
typedef unsigned u32x2 __attribute__((ext_vector_type(2)));

constexpr int D = 1024, NB = 8, T = 8192, L = 256, TL = T + L, NTOK = NB * TL;
constexpr int NTHR = 512;

constexpr size_t U = (size_t)NTOK * 1024 * 2;
constexpr size_t OFF_H = 0, OFF_R = U, OFF_K = 2 * U, OFF_V = 3 * U, OFF_G = 4 * U, OFF_Y0 = 5 * U, OFF_Y1 = 6 * U;
constexpr size_t OFF_LORA = 7 * U;
constexpr size_t OFF_BONUS = OFF_LORA + (size_t)NTOK * 256 * 2;
constexpr size_t OFF_WIN0 = OFF_BONUS + (size_t)2 * NTOK * 16 * 4;
constexpr size_t OFF_WOUT0 = OFF_WIN0 + (size_t)4352 * 1024 * 2;
constexpr size_t OFF_WIN1 = OFF_WOUT0 + (size_t)1024 * 1024 * 2;
constexpr size_t OFF_WQB = OFF_WIN1 + (size_t)1792 * 1024 * 2;
constexpr size_t OFF_WKVB = OFF_WQB + (size_t)1536 * 384 * 2;
constexpr size_t OFF_WOUT1 = OFF_WKVB + (size_t)2048 * 256 * 2;
constexpr size_t OFF_MOD = OFF_WOUT1 + (size_t)1024 * 1024 * 2;
constexpr size_t OFF_ROPE = OFF_MOD + (size_t)2 * 9 * 3072 * 4;
constexpr size_t OFF_CTX1 = OFF_ROPE + (size_t)128 * 8 * 2 * 4;
constexpr size_t WS_END = OFF_CTX1 + (size_t)2048 * 1024 * 4;
constexpr size_t OFF_QC = OFF_V;
constexpr size_t OFF_KVC = OFF_QC + (size_t)NTOK * 384 * 2;
constexpr size_t OFF_KPE = OFF_KVC + (size_t)NTOK * 256 * 2;
constexpr size_t OFF_G1 = OFF_G;
constexpr size_t OFF_Q = OFF_R;
constexpr size_t OFF_KV = OFF_Y0;

struct Params { const float* in[28]; float* out; unsigned char* ws; };

typedef __bf16 bf16x2_t __attribute__((ext_vector_type(2)));
__device__ __forceinline__ unsigned cvtpk(float lo, float hi) { f32x2 v = {lo, hi}; bf16x2_t b = __builtin_convertvector(v, bf16x2_t); return *(unsigned*)&b; }
__device__ __forceinline__ float bf2f(bf16_t u) { return __uint_as_float(((unsigned)u) << 16); }
__device__ __forceinline__ bf16_t f2bf(float f) { return (bf16_t)(cvtpk(f, 0.f) & 0xffffu); }
__device__ __forceinline__ float lo16(unsigned w) { return __uint_as_float(w << 16); }
__device__ __forceinline__ float hi16(unsigned w) { return __uint_as_float(w & 0xffff0000u); }
__device__ __forceinline__ void st_bf16x4(bf16_t* p, float a, float b, float c, float d) { u32x2 w = {cvtpk(a, b), cvtpk(c, d)}; *(u32x2*)p = w; }
__device__ __forceinline__ void st_bf16x4_nt(bf16_t* p, float a, float b, float c, float d) { u32x2 w = {cvtpk(a, b), cvtpk(c, d)}; __builtin_nontemporal_store(w, (u32x2*)p); }
__device__ __forceinline__ float wave_sum(float v) {
#pragma unroll
  for (int o = 32; o; o >>= 1) v += __shfl_xor(v, o);
  return v;
}
__device__ __forceinline__ float dpp_f(float v, const int ctrl_sel) {
  int r;
  if (ctrl_sel == 0) r = __builtin_amdgcn_update_dpp(0, __float_as_int(v), 0xB1, 0xF, 0xF, true);
  else if (ctrl_sel == 1) r = __builtin_amdgcn_update_dpp(0, __float_as_int(v), 0x4E, 0xF, 0xF, true);
  else r = __builtin_amdgcn_update_dpp(0, __float_as_int(v), 0x141, 0xF, 0xF, true);
  return __int_as_float(r);
}
__device__ __forceinline__ float red8(float v) { v += dpp_f(v, 0); v += dpp_f(v, 1); v += dpp_f(v, 2); return v; }
__device__ __forceinline__ int crow(int r, int hi) { return (r & 3) + 8 * (r >> 2) + 4 * hi; }
__device__ __forceinline__ float sigmoidf_(float x) { return 1.f / (1.f + __expf(-x)); }
#define MFMA(a, b, c) __builtin_amdgcn_mfma_f32_32x32x16_bf16((a), (b), (c), 0, 0, 0)

constexpr int G_LDT = 144;
constexpr int G_SSQ_OFF = 2 * (256 + 256) * G_LDT;
constexpr int LDS_BYTES = G_SSQ_OFF + 1024;

template <int AMODE, int BN, class Epi>
__device__ __forceinline__ void gemm_tile(const bf16_t* A, const int lda, const bf16_t* Bt, const int K, const int m0, const float* mu, char* lds, const Epi& epi) {
  constexpr int WN = BN / 64, MI = WN, NBR = BN / 64, G_STAGE = (256 + BN) * G_LDT;
  const int tid = threadIdx.x, lane = tid & 63, wid = tid >> 6, r32 = lane & 31, hi = lane >> 5;
  const int wm = wid / WN, wn = wid % WN;
  const int srow = tid >> 3, scc = (tid & 7) * 8;
  int browi[NBR];
#pragma unroll
  for (int i = 0; i < NBR; ++i) browi[i] = 64 * i + ((Epi::PERM && !epi.natural_group(64 * i + srow)) ? ((srow & 32) + 16 * ((srow >> 2) & 1) + 4 * ((srow & 31) >> 3) + (srow & 3)) : srow);
  f32x16 acc[MI][2];
#pragma unroll
  for (int i = 0; i < MI; ++i)
#pragma unroll
    for (int j = 0; j < 2; ++j)
#pragma unroll
      for (int r = 0; r < 16; ++r) acc[i][j][r] = 0.f;
  bf16x8 ra[4], rb[NBR], rp[4], rn[4];
  float ssq[4] = {0.f, 0.f, 0.f, 0.f};
  int dprev[4], dnext[4];
  if constexpr (AMODE == 1) {
    const int t0 = m0 % TL;
#pragma unroll
    for (int i = 0; i < 4; ++i) { const int t = t0 + srow + 64 * i; dprev[i] = (t != 0 && t != T) ? 1 : 0; dnext[i] = (t != T - 1 && t != TL - 1) ? 1 : 0; }
  }
  auto gload = [&](int k0) {
#pragma unroll
    for (int i = 0; i < 4; ++i) {
      const bf16_t* ap = A + (size_t)(m0 + srow + 64 * i) * lda + k0 + scc;
      ra[i] = *(const bf16x8*)ap;
      if constexpr (AMODE == 1) { rp[i] = *(const bf16x8*)(ap - dprev[i] * lda); rn[i] = *(const bf16x8*)(ap + dnext[i] * lda); }
    }
#pragma unroll
    for (int i = 0; i < NBR; ++i) rb[i] = *(const bf16x8*)(Bt + (size_t)browi[i] * K + k0 + scc);
  };
  auto lstore = [&](int s, int k0) {
    char* base = lds + s * G_STAGE;
    if constexpr (AMODE == 1) {
      const f32x4 m0v = *(const f32x4*)(mu + k0 + scc), m1v = *(const f32x4*)(mu + k0 + scc + 4);
      const float mm[8] = {m0v[0], m0v[1], m0v[2], m0v[3], m1v[0], m1v[1], m1v[2], m1v[3]};
#pragma unroll
      for (int i = 0; i < 4; ++i) {
        const u32x4 hc = *(const u32x4*)&ra[i], hp = *(const u32x4*)&rp[i], hn = *(const u32x4*)&rn[i];
        const float fp = dprev[i] ? 0.5f : 0.f, fn = dnext[i] ? 0.5f : 0.f;
        u32x4 w;
#pragma unroll
        for (int q = 0; q < 4; ++q) {
          const float c0 = lo16(hc[q]), c1 = hi16(hc[q]);
          const float x0 = fp * lo16(hp[q]) + fn * lo16(hn[q]) - c0, x1 = fp * hi16(hp[q]) + fn * hi16(hn[q]) - c1;
          w[q] = cvtpk(c0 + x0 * mm[2 * q], c1 + x1 * mm[2 * q + 1]);
        }
        *(u32x4*)(base + (srow + 64 * i) * G_LDT + scc * 2) = w;
      }
    } else {
#pragma unroll
      for (int i = 0; i < 4; ++i) {
        *(bf16x8*)(base + (srow + 64 * i) * G_LDT + scc * 2) = ra[i];
        if constexpr (AMODE == 2) {
          const u32x4 hc = *(const u32x4*)&ra[i];
#pragma unroll
          for (int q = 0; q < 4; ++q) { const float c0 = lo16(hc[q]), c1 = hi16(hc[q]); ssq[i] += c0 * c0 + c1 * c1; }
        }
      }
    }
#pragma unroll
    for (int i = 0; i < NBR; ++i) *(bf16x8*)(base + 256 * G_LDT + (srow + 64 * i) * G_LDT + scc * 2) = rb[i];
  };
  const int nk = K >> 6;
  gload(0);
  lstore(0, 0);
  if (nk > 1) gload(64);
  __syncthreads();
#pragma unroll 1
  for (int kt = 0; kt < nk; ++kt) {
    const int s = kt & 1;
    if (kt + 1 < nk) lstore(s ^ 1, (kt + 1) * 64);
    if (kt + 2 < nk) gload((kt + 2) * 64);
    {
      const char* Ab = lds + s * G_STAGE + (wm * (32 * MI) + r32) * G_LDT + hi * 16;
      const char* Bb = lds + s * G_STAGE + 256 * G_LDT + (wn * 64 + r32) * G_LDT + hi * 16;
      bf16x8 fb[2][2], fa[2][MI];
      fb[0][0] = *(const bf16x8*)(Bb); fb[0][1] = *(const bf16x8*)(Bb + 32 * G_LDT);
#pragma unroll
      for (int mi = 0; mi < MI; ++mi) fa[0][mi] = *(const bf16x8*)(Ab + mi * 32 * G_LDT);
#pragma unroll
      for (int ks = 0; ks < 4; ++ks) {
        const int sl = ks & 1;
        if (ks + 1 < 4) {
          fb[sl ^ 1][0] = *(const bf16x8*)(Bb + (ks + 1) * 32); fb[sl ^ 1][1] = *(const bf16x8*)(Bb + 32 * G_LDT + (ks + 1) * 32);
#pragma unroll
          for (int mi = 0; mi < MI; ++mi) fa[sl ^ 1][mi] = *(const bf16x8*)(Ab + mi * 32 * G_LDT + (ks + 1) * 32);
        }
#pragma unroll
        for (int mi = 0; mi < MI; ++mi) { acc[mi][0] = MFMA(fb[sl][0], fa[sl][mi], acc[mi][0]); acc[mi][1] = MFMA(fb[sl][1], fa[sl][mi], acc[mi][1]); }
      }
    }
    __syncthreads();
  }
  float* ssq_l = (float*)(lds + G_SSQ_OFF);
  if constexpr (AMODE == 2) {
#pragma unroll
    for (int i = 0; i < 4; ++i) { const float v = red8(ssq[i]); if ((tid & 7) == 0) ssq_l[srow + 64 * i] = v; }
    __syncthreads();
  }
#pragma unroll
  for (int mi = 0; mi < MI; ++mi) {
    const int lrow = wm * (32 * MI) + mi * 32 + r32;
    float aux = 0.f;
    if constexpr (AMODE == 2) aux = ssq_l[lrow];
    epi(lrow, wn * 64 + 4 * hi, acc[mi][0], acc[mi][1], aux);
  }
}

constexpr int G_EPI_SCR = (256 + 256) * G_LDT;
struct EpiBf16 {
  static constexpr bool PERM = true;
  __device__ __forceinline__ bool natural_group(int) const { return false; }
  bf16_t* dst; int ldd; int col0; int m0; int act; float invK; char* scr;
  __device__ __forceinline__ void operator()(int lrow, int nc, const f32x16& a0, const f32x16& a1, float aux) const {
    const int lane = threadIdx.x & 63, wid = threadIdx.x >> 6, r32 = lane & 31, hi = lane >> 5;
    float sc = 1.f;
    if (invK > 0.f) sc = rsqrtf(aux * invK + 1e-6f);
    char* sp = scr + wid * (32 * 144);
    char* wp = sp + r32 * 144 + 32 * hi;
    if (act) {
#define TANH_(x) (1.f - 2.f / (__expf(2.f * (x) * sc) + 1.f))
      const u32x4 w0 = {cvtpk(TANH_(a0[0]), TANH_(a0[1])), cvtpk(TANH_(a0[2]), TANH_(a0[3])), cvtpk(TANH_(a0[4]), TANH_(a0[5])), cvtpk(TANH_(a0[6]), TANH_(a0[7]))};
      const u32x4 w1 = {cvtpk(TANH_(a0[8]), TANH_(a0[9])), cvtpk(TANH_(a0[10]), TANH_(a0[11])), cvtpk(TANH_(a0[12]), TANH_(a0[13])), cvtpk(TANH_(a0[14]), TANH_(a0[15]))};
      const u32x4 w2 = {cvtpk(TANH_(a1[0]), TANH_(a1[1])), cvtpk(TANH_(a1[2]), TANH_(a1[3])), cvtpk(TANH_(a1[4]), TANH_(a1[5])), cvtpk(TANH_(a1[6]), TANH_(a1[7]))};
      const u32x4 w3 = {cvtpk(TANH_(a1[8]), TANH_(a1[9])), cvtpk(TANH_(a1[10]), TANH_(a1[11])), cvtpk(TANH_(a1[12]), TANH_(a1[13])), cvtpk(TANH_(a1[14]), TANH_(a1[15]))};
#undef TANH_
      *(u32x4*)(wp) = w0; *(u32x4*)(wp + 16) = w1; *(u32x4*)(wp + 64) = w2; *(u32x4*)(wp + 80) = w3;
    } else {
      const u32x4 w0 = {cvtpk(a0[0] * sc, a0[1] * sc), cvtpk(a0[2] * sc, a0[3] * sc), cvtpk(a0[4] * sc, a0[5] * sc), cvtpk(a0[6] * sc, a0[7] * sc)};
      const u32x4 w1 = {cvtpk(a0[8] * sc, a0[9] * sc), cvtpk(a0[10] * sc, a0[11] * sc), cvtpk(a0[12] * sc, a0[13] * sc), cvtpk(a0[14] * sc, a0[15] * sc)};
      const u32x4 w2 = {cvtpk(a1[0] * sc, a1[1] * sc), cvtpk(a1[2] * sc, a1[3] * sc), cvtpk(a1[4] * sc, a1[5] * sc), cvtpk(a1[6] * sc, a1[7] * sc)};
      const u32x4 w3 = {cvtpk(a1[8] * sc, a1[9] * sc), cvtpk(a1[10] * sc, a1[11] * sc), cvtpk(a1[12] * sc, a1[13] * sc), cvtpk(a1[14] * sc, a1[15] * sc)};
      *(u32x4*)(wp) = w0; *(u32x4*)(wp + 16) = w1; *(u32x4*)(wp + 64) = w2; *(u32x4*)(wp + 80) = w3;
    }
    asm volatile("s_waitcnt lgkmcnt(0)" ::: "memory");
    bf16_t* gp = dst + (size_t)(m0 + lrow - r32) * ldd + col0 + (nc & ~7) + (lane & 7) * 8;
#pragma unroll
    for (int i = 0; i < 4; ++i) {
      const int row = (lane >> 3) + 8 * i;
      *(u32x4*)(gp + (size_t)row * ldd) = *(const u32x4*)(sp + row * 144 + (lane & 7) * 16);
    }
    asm volatile("s_waitcnt lgkmcnt(0)" ::: "memory");
  }
};
struct EpiResid {
  static constexpr bool PERM = false;
  __device__ __forceinline__ bool natural_group(int) const { return true; }
  const float* xin; float* xout; const float* gvec; int n0; char* scr;
  __device__ __forceinline__ void operator()(int lrow, int nc, const f32x16& a0, const f32x16& a1, float) const {
    const int lane = threadIdx.x & 63, wid = threadIdx.x >> 6, r32 = lane & 31, hi = lane >> 5;
    float* sp = (float*)(scr + wid * (32 * 272));
#pragma unroll
    for (int g = 0; g < 4; ++g) {
      const f32x4 v0 = {a0[4 * g], a0[4 * g + 1], a0[4 * g + 2], a0[4 * g + 3]}, v1 = {a1[4 * g], a1[4 * g + 1], a1[4 * g + 2], a1[4 * g + 3]};
      *(f32x4*)(sp + r32 * 68 + 4 * hi + 8 * g) = v0; *(f32x4*)(sp + r32 * 68 + 32 + 4 * hi + 8 * g) = v1;
    }
    asm volatile("s_waitcnt lgkmcnt(0)" ::: "memory");
    const int c4 = (lane & 15) * 4, colg = n0 + (nc & ~7) + c4;
    const size_t rbase = (size_t)(lrow - r32) * 1024 + colg;
    const f32x4 gv = *(const f32x4*)(gvec + colg);
    f32x4 xv[8];
#pragma unroll
    for (int i = 0; i < 8; ++i) xv[i] = *(const f32x4*)(xin + rbase + (size_t)((lane >> 4) + 4 * i) * 1024);
    asm volatile("" ::: "memory");
#pragma unroll
    for (int i = 0; i < 8; ++i) {
      const int row = (lane >> 4) + 4 * i;
      const f32x4 av = *(const f32x4*)(sp + row * 68 + c4);
      f32x4 r; r[0] = xv[i][0] + gv[0] * av[0]; r[1] = xv[i][1] + gv[1] * av[1]; r[2] = xv[i][2] + gv[2] * av[2]; r[3] = xv[i][3] + gv[3] * av[3];
      *(f32x4*)(xout + rbase + (size_t)row * 1024) = r;
    }
    asm volatile("s_waitcnt lgkmcnt(0)" ::: "memory");
  }
};
struct EpiMlaIn {
  static constexpr bool PERM = true;
  bf16_t *QC, *KVC, *KPE, *G1; const float* rope; int n0; int m0; char* scr;
  __device__ __forceinline__ bool natural_group(int tile_row) const { return ((n0 + tile_row) >> 5) == 20; }
  __device__ __forceinline__ void operator()(int lrow, int nc, const f32x16& a0, const f32x16& a1, float) const {
    const int g64 = n0 + (nc & ~7);
    if (g64 == 640) { rope_one(lrow, nc, a0); return; }
    if (g64 == 704) return;
    bf16_t* base; int ld;
    if (g64 < 384) { base = QC + g64; ld = 384; } else if (g64 < 640) { base = KVC + (g64 - 384); ld = 256; } else { base = G1 + (g64 - 768); ld = 1024; }
    const int lane = threadIdx.x & 63, wid = threadIdx.x >> 6, r32 = lane & 31, hi = lane >> 5;
    char* sp = scr + wid * (32 * 144);
    char* wp = sp + r32 * 144 + 32 * hi;
    const u32x4 w0 = {cvtpk(a0[0], a0[1]), cvtpk(a0[2], a0[3]), cvtpk(a0[4], a0[5]), cvtpk(a0[6], a0[7])};
    const u32x4 w1 = {cvtpk(a0[8], a0[9]), cvtpk(a0[10], a0[11]), cvtpk(a0[12], a0[13]), cvtpk(a0[14], a0[15])};
    const u32x4 w2 = {cvtpk(a1[0], a1[1]), cvtpk(a1[2], a1[3]), cvtpk(a1[4], a1[5]), cvtpk(a1[6], a1[7])};
    const u32x4 w3 = {cvtpk(a1[8], a1[9]), cvtpk(a1[10], a1[11]), cvtpk(a1[12], a1[13]), cvtpk(a1[14], a1[15])};
    *(u32x4*)(wp) = w0; *(u32x4*)(wp + 16) = w1; *(u32x4*)(wp + 64) = w2; *(u32x4*)(wp + 80) = w3;
    asm volatile("s_waitcnt lgkmcnt(0)" ::: "memory");
    bf16_t* gp = base + (size_t)(m0 + lrow - r32) * ld + (lane & 7) * 8;
#pragma unroll
    for (int i = 0; i < 4; ++i) {
      const int row = (lane >> 3) + 8 * i;
      *(u32x4*)(gp + (size_t)row * ld) = *(const u32x4*)(sp + row * 144 + (lane & 7) * 16);
    }
    asm volatile("s_waitcnt lgkmcnt(0)" ::: "memory");
  }
  __device__ __forceinline__ void rope_one(int lrow, int nc, const f32x16& a) const {
    const int row = m0 + lrow, t = (m0 % TL) + lrow, hi4 = nc & 4;
    bf16_t* p = KPE + (size_t)row * 32;
    if (t < T) {
      const f32x2* tr = (const f32x2*)rope + (t >> 6) * 8 + hi4;
      const f32x2* tc = (const f32x2*)rope + (t & 63) * 8 + hi4;
      float o1[8], o2[8];
#pragma unroll
      for (int e = 0; e < 4; ++e) {
        const f32x2 cs0 = tr[e], cs1 = tc[e];
        const float x1a = a[e], x2a = a[8 + e];
        const float x1b = a[4 + e], x2b = a[12 + e];
        o1[e] = x1a * cs0[0] - x2a * cs0[1]; o2[e] = x1a * cs0[1] + x2a * cs0[0];
        o1[4 + e] = x1b * cs1[0] - x2b * cs1[1]; o2[4 + e] = x1b * cs1[1] + x2b * cs1[0];
      }
      st_bf16x4(p + hi4, o1[0], o1[1], o1[2], o1[3]);
      st_bf16x4(p + 8 + hi4, o1[4], o1[5], o1[6], o1[7]);
      st_bf16x4(p + 16 + hi4, o2[0], o2[1], o2[2], o2[3]);
      st_bf16x4(p + 24 + hi4, o2[4], o2[5], o2[6], o2[7]);
    } else {
#pragma unroll
      for (int g = 0; g < 4; ++g) st_bf16x4(p + 8 * g + hi4, a[4 * g], a[4 * g + 1], a[4 * g + 2], a[4 * g + 3]);
    }
  }
};

constexpr float AT_SCALE = 0.10206207261596575f;
constexpr float AT_THR = 8.f;
__device__ void tr_job(const float* src, int ld, int K, int N, bf16_t* dst, const float* kscale, char* lds, float gscale = 1.f) {
  float* tile = (float*)lds;
  const int tid = threadIdx.x, nK = K >> 6, nN = (N + 63) >> 6;
  for (int tIdx = blockIdx.x; tIdx < nK * nN; tIdx += gridDim.x) {
    const int k0 = (tIdx % nK) * 64, n0 = (tIdx / nK) * 64;
#pragma unroll
    for (int i = 0; i < 8; ++i) {
      const int kk = (tid >> 6) + 8 * i, nn = tid & 63;
      float v = 0.f;
      if (n0 + nn < N) { v = src[(size_t)(k0 + kk) * ld + n0 + nn] * gscale; if (kscale) v *= kscale[k0 + kk]; }
      tile[kk * 65 + nn] = v;
    }
    __syncthreads();
#pragma unroll
    for (int i = 0; i < 8; ++i) {
      const int nn = (tid >> 6) + 8 * i, kk = tid & 63;
      if (n0 + nn < N) dst[(size_t)(n0 + nn) * K + k0 + kk] = f2bf(tile[kk * 65 + nn]);
    }
    __syncthreads();
  }
}

__device__ void phase_weights(const Params& p, char* lds) {
  unsigned char* ws = p.ws;
  bf16_t* WIN0 = (bf16_t*)(ws + OFF_WIN0);
  for (int j = 0; j < 4; ++j) tr_job(p.in[8] + (size_t)j * 1024 * 1024, 1024, 1024, 1024, WIN0 + (size_t)j * 1024 * 1024, nullptr, lds);
  for (int d = 0; d < 2; ++d) {
    tr_job(p.in[10] + (size_t)d * 1024 * 64, 64, 1024, 64, WIN0 + (size_t)(4096 + d * 64) * 1024, nullptr, lds);
    tr_job(p.in[13] + (size_t)d * 1024 * 64, 64, 1024, 64, WIN0 + (size_t)(4224 + d * 64) * 1024, nullptr, lds);
  }
  tr_job(p.in[20], 1024, 1024, 1024, (bf16_t*)(ws + OFF_WOUT0), nullptr, lds);
  bf16_t* WIN1 = (bf16_t*)(ws + OFF_WIN1);
  tr_job(p.in[21], 1696, 1024, 640, WIN1, nullptr, lds);
  tr_job(p.in[21] + 640, 1696, 1024, 32, WIN1 + (size_t)640 * 1024, nullptr, lds);
  tr_job(p.in[21] + 672, 1696, 1024, 1024, WIN1 + (size_t)768 * 1024, nullptr, lds);
  for (int i = blockIdx.x * NTHR + threadIdx.x; i < 96 * 1024; i += gridDim.x * NTHR) WIN1[(size_t)672 * 1024 + i] = 0;
  tr_job(p.in[23], 1536, 384, 1536, (bf16_t*)(ws + OFF_WQB), p.in[22], lds, AT_SCALE * 1.4426950408889634f);
  tr_job(p.in[25], 2048, 256, 2048, (bf16_t*)(ws + OFF_WKVB), p.in[24], lds);
  tr_job(p.in[26], 1024, 1024, 1024, (bf16_t*)(ws + OFF_WOUT1), nullptr, lds);
}
__device__ void phase_prologue(const Params& p, char* lds) {
  unsigned char* ws = p.ws;
  {
    const int i = blockIdx.x * NTHR + threadIdx.x;
    if (i < 1024) {
      const float invf[8] = {1.f, 0.316227766016838f, 0.1f, 0.0316227766016838f, 0.01f, 0.00316227766016838f, 0.001f, 0.000316227766016838f};
      const int pos = i >> 3, m = i & 7;
      float inv = invf[0];
#pragma unroll
      for (int q = 1; q < 8; ++q) inv = (m == q) ? invf[q] : inv;
      const float ang = (float)pos * inv;
      const float kf = rintf(ang * 0.15915494309189535f);
      float r = fmaf(-kf, 6.28125f, ang);
      r = fmaf(-kf, 1.9353071795864769e-3f, r);
      float* rt = (float*)(ws + OFF_ROPE);
      rt[2 * i] = cosf(r); rt[2 * i + 1] = sinf(r);
    }
  }
  {
    float* sil = (float*)lds;
    float* red = sil + 9 * 1024;
    const int tid = threadIdx.x;
    for (int i = tid; i < 9 * 1024; i += NTHR) {
      const int bi = i >> 10, k = i & 1023;
      const float cv = bi < 8 ? p.in[1][bi * 1024 + k] : p.in[3][k];
      sil[i] = cv / (1.f + __expf(-cv));
    }
    __syncthreads();
    float* mod = (float*)(ws + OFF_MOD);
    for (int item = blockIdx.x; item < 192; item += gridDim.x) {
      const int l = item / 96, n0 = (item % 96) * 32, col = tid & 31, kg = tid >> 5;
      float acc[9];
#pragma unroll
      for (int bi = 0; bi < 9; ++bi) acc[bi] = 0.f;
      const float* wp = p.in[5] + ((size_t)l * 1024 + kg * 64) * 3072 + n0 + col;
      for (int kk = 0; kk < 64; ++kk) {
        const float w = wp[(size_t)kk * 3072];
#pragma unroll
        for (int bi = 0; bi < 9; ++bi) acc[bi] += sil[bi * 1024 + kg * 64 + kk] * w;
      }
#pragma unroll
      for (int bi = 0; bi < 9; ++bi) red[(kg * 9 + bi) * 32 + col] = acc[bi];
      __syncthreads();
      if (tid < 288) {
        const int bi = tid >> 5;
        float s = 0.f;
#pragma unroll
        for (int g = 0; g < 16; ++g) s += red[(g * 9 + bi) * 32 + col];
        mod[((size_t)l * 9 + bi) * 3072 + n0 + col] = s + p.in[6][l * 3072 + n0 + col];
      }
      __syncthreads();
    }
  }
}

__device__ __forceinline__ const float* row_src(const float* xsrc, const float* csrc, int n, int& bi) {
  const int b = n / TL, t = n - b * TL;
  if (t < T) { bi = b; return xsrc + ((size_t)b * T + t) * D; }
  bi = 8; return csrc + ((size_t)b * L + (t - T)) * D;
}
__device__ void phase_norm(const float* xsrc, const float* csrc, const float* ng, const float* mod, bf16_t* H) {
  const int lane = threadIdx.x & 63, gw = blockIdx.x * 8 + (threadIdx.x >> 6), nw = gridDim.x * 8;
  f32x4 g4[4];
#pragma unroll
  for (int i = 0; i < 4; ++i) g4[i] = *(const f32x4*)(ng + i * 256 + lane * 4);
  f32x4 va[4], vb[4]; int bia = 0, bib = 0;
  if (gw < NTOK) { const float* src = row_src(xsrc, csrc, gw, bia);
#pragma unroll
    for (int i = 0; i < 4; ++i) va[i] = *(const f32x4*)(src + i * 256 + lane * 4); }
  for (int n = gw; n < NTOK; n += nw) {
    if (n + nw < NTOK) { const float* src = row_src(xsrc, csrc, n + nw, bib);
#pragma unroll
      for (int i = 0; i < 4; ++i) vb[i] = *(const f32x4*)(src + i * 256 + lane * 4); }
    float ss = 0.f;
#pragma unroll
    for (int i = 0; i < 4; ++i) ss += va[i][0] * va[i][0] + va[i][1] * va[i][1] + va[i][2] * va[i][2] + va[i][3] * va[i][3];
    ss = wave_sum(ss);
    const float rstd = rsqrtf(ss * (1.f / 1024.f) + 1e-6f);
    const float* m = mod + bia * 3072;
#pragma unroll
    for (int i = 0; i < 4; ++i) {
      const int c = i * 256 + lane * 4;
      const f32x4 sh = *(const f32x4*)(m + c), sc = *(const f32x4*)(m + 1024 + c);
      float o[4];
#pragma unroll
      for (int e = 0; e < 4; ++e) o[e] = va[i][e] * rstd * g4[i][e] * (1.f + sc[e]) + sh[e];
      st_bf16x4(H + (size_t)n * 1024 + c, o[0], o[1], o[2], o[3]);
    }
#pragma unroll
    for (int i = 0; i < 4; ++i) va[i] = vb[i];
    bia = bib;
  }
}

constexpr int LERP3_SPLIT = 63488;
__device__ __forceinline__ bf16_t* lerp_base(const Params& p, int j, int row) {
  if (j == 0) return (bf16_t*)(p.ws + OFF_Y0);
  if (j == 1) return (bf16_t*)(p.ws + OFF_Y1);
  if (j == 2) return (bf16_t*)p.out;
  if (row < LERP3_SPLIT) return (bf16_t*)p.out + (size_t)NTOK * 1024;
  return (bf16_t*)(p.ws + WS_END) - (size_t)LERP3_SPLIT * 1024;
}
struct RowX { f32x4 v[4]; int bi; };
__device__ __forceinline__ void ld_row(const Params& p, int n, int lane, RowX& r) {
  const float* src = row_src(p.in[0], p.in[2], n, r.bi);
#pragma unroll
  for (int i = 0; i < 4; ++i) r.v[i] = *(const f32x4*)(src + i * 256 + lane * 4);
}
__device__ __forceinline__ void fin_row(const float* mod, const f32x4 (&g4)[4], int lane, const RowX& r, float (&h)[16]) {
  float ss = 0.f;
#pragma unroll
  for (int i = 0; i < 4; ++i) ss += r.v[i][0] * r.v[i][0] + r.v[i][1] * r.v[i][1] + r.v[i][2] * r.v[i][2] + r.v[i][3] * r.v[i][3];
  ss = wave_sum(ss);
  const float rstd = rsqrtf(ss * (1.f / 1024.f) + 1e-6f);
  const float* m = mod + r.bi * 3072;
#pragma unroll
  for (int i = 0; i < 4; ++i) {
    const int c = i * 256 + lane * 4;
    const f32x4 sh = *(const f32x4*)(m + c), sc = *(const f32x4*)(m + 1024 + c);
#pragma unroll
    for (int e = 0; e < 4; ++e) {
      const float hv = r.v[i][e] * rstd * g4[i][e] * (1.f + sc[e]) + sh[e];
      h[4 * i + e] = __uint_as_float(cvtpk(hv, 0.f) << 16);
    }
  }
}
__device__ void phase_norm_lerp(const Params& p, const float* mod) {
  const int lane = threadIdx.x & 63, gw = blockIdx.x * 8 + (threadIdx.x >> 6), nw = gridDim.x * 8;
  const int per = (NTOK + nw - 1) / nw;
  const int r0 = gw * per, r1 = (r0 + per < NTOK) ? r0 + per : NTOK;
  if (r0 >= r1) return;
  bf16_t* H = (bf16_t*)(p.ws + OFF_H);
  f32x4 g4[4];
#pragma unroll
  for (int i = 0; i < 4; ++i) g4[i] = *(const f32x4*)(p.in[4] + i * 256 + lane * 4);
  float mu[4][16];
#pragma unroll
  for (int j = 0; j < 4; ++j)
#pragma unroll
    for (int i = 0; i < 4; ++i) {
      const f32x4 m4 = *(const f32x4*)(p.in[7] + j * 1024 + i * 256 + lane * 4);
      mu[j][4 * i] = m4[0]; mu[j][4 * i + 1] = m4[1]; mu[j][4 * i + 2] = m4[2]; mu[j][4 * i + 3] = m4[3];
    }
  float hp[16], hc[16], hn[16];
  RowX xa, xb, xc;
  if (r0 > 0) { ld_row(p, r0 - 1, lane, xc); }
  ld_row(p, r0, lane, xa);
  if (r0 + 1 < NTOK) ld_row(p, r0 + 1, lane, xb);
  if (r0 > 0) fin_row(mod, g4, lane, xc, hp);
  else {
#pragma unroll
    for (int e = 0; e < 16; ++e) hp[e] = 0.f;
  }
  fin_row(mod, g4, lane, xa, hc);
  xa = xb;
  if (r0 + 2 < NTOK) ld_row(p, r0 + 2, lane, xb);
  for (int n = r0; n < r1; ++n) {
    const int t = n % TL;
    if (n + 3 < NTOK) ld_row(p, n + 3, lane, xc);
    if (n + 1 < NTOK) fin_row(mod, g4, lane, xa, hn);
    else {
#pragma unroll
      for (int e = 0; e < 16; ++e) hn[e] = 0.f;
    }
    const float fp = (t != 0 && t != T) ? 0.5f : 0.f, fn = (t != T - 1 && t != TL - 1) ? 0.5f : 0.f;
#pragma unroll
    for (int i = 0; i < 4; ++i) st_bf16x4_nt(H + (size_t)n * 1024 + i * 256 + lane * 4, hc[4 * i], hc[4 * i + 1], hc[4 * i + 2], hc[4 * i + 3]);
#pragma unroll
    for (int j = 0; j < 4; ++j) {
      bf16_t* dst = lerp_base(p, j, n) + (size_t)n * 1024 + lane * 4;
#pragma unroll
      for (int i = 0; i < 4; ++i) {
        float o[4];
#pragma unroll
        for (int e = 0; e < 4; ++e) { const float c = hc[4 * i + e]; o[e] = c + (fp * hp[4 * i + e] + fn * hn[4 * i + e] - c) * mu[j][4 * i + e]; }
        st_bf16x4_nt(dst + i * 256, o[0], o[1], o[2], o[3]);
      }
    }
#pragma unroll
    for (int e = 0; e < 16; ++e) { hp[e] = hc[e]; hc[e] = hn[e]; }
    xa = xb; xb = xc;
  }
}

__device__ void phase_final(float* out, const float* fg) {
  const int lane = threadIdx.x & 63, gw = blockIdx.x * 8 + (threadIdx.x >> 6), nw = gridDim.x * 8;
  f32x4 g4[4];
#pragma unroll
  for (int i = 0; i < 4; ++i) g4[i] = *(const f32x4*)(fg + i * 256 + lane * 4);
  f32x4 va[4], vb[4];
  if (gw < NB * T) {
#pragma unroll
    for (int i = 0; i < 4; ++i) va[i] = *(const f32x4*)(out + (size_t)gw * D + i * 256 + lane * 4); }
  for (int n = gw; n < NB * T; n += nw) {
    if (n + nw < NB * T) {
#pragma unroll
      for (int i = 0; i < 4; ++i) vb[i] = *(const f32x4*)(out + (size_t)(n + nw) * D + i * 256 + lane * 4); }
    float ss = 0.f;
#pragma unroll
    for (int i = 0; i < 4; ++i) ss += va[i][0] * va[i][0] + va[i][1] * va[i][1] + va[i][2] * va[i][2] + va[i][3] * va[i][3];
    ss = wave_sum(ss);
    const float rstd = rsqrtf(ss * (1.f / 1024.f) + 1e-6f);
#pragma unroll
    for (int i = 0; i < 4; ++i) {
      f32x4 o;
#pragma unroll
      for (int e = 0; e < 4; ++e) o[e] = va[i][e] * rstd * g4[i][e];
      *(f32x4*)(out + (size_t)n * D + i * 256 + lane * 4) = o;
    }
#pragma unroll
    for (int i = 0; i < 4; ++i) va[i] = vb[i];
  }
}

__device__ __forceinline__ int scan_row(int g, int d, int b) {
  if (g < L) { const int tt = d ? (L - 1 - g) : g; return b * TL + T + tt; }
  g -= L; const int tt = d ? (T - 1 - g) : g; return b * TL + tt;
}
constexpr int SC_P = 0, SC_ARA = 8192, SC_ARR = SC_ARA + 4096, SC_BK = SC_ARR + 4096, SC_SCAL = SC_BK + 8192, SC_VV = SC_SCAL + 1024, SC_BUF = SC_VV + 8192;
constexpr int SC_IC = 2 * SC_BUF, SC_SCR = SC_IC + 8192, SC_YB = SC_SCR + 16384, SC_END = SC_YB + 2 * 8192;
#define MFMA16(a, b, c) __builtin_amdgcn_mfma_f32_16x16x32_bf16((a), (b), (c), 0, 0, 0)
struct ScBlk { u32x4 aa0, aa1, ar0, ar1, k0, k1, k2, k3; f32x4 v; f32x4 s[8]; };
__device__ __forceinline__ void sc_ldb(ScBlk& c, const char* buf, int blk, int arOff, int bkOff, int vOff) {
  const char* pa = buf + SC_ARA + blk * 512 + arOff; const char* pr = buf + SC_ARR + blk * 512 + arOff;
  c.aa0 = *(const u32x4*)(pa); c.aa1 = *(const u32x4*)(pa + 64); c.ar0 = *(const u32x4*)(pr); c.ar1 = *(const u32x4*)(pr + 64);
  const char* bk = buf + SC_BK + blk * 1024 + bkOff;
  c.k0 = *(const u32x4*)(bk); c.k1 = *(const u32x4*)(bk + 256); c.k2 = *(const u32x4*)(bk + 512); c.k3 = *(const u32x4*)(bk + 768);
  c.v = *(const f32x4*)(buf + SC_VV + blk * 1024 + vOff);
  const char* sp = buf + SC_SCAL + blk * 128;
#pragma unroll
  for (int i = 0; i < 8; ++i) c.s[i] = *(const f32x4*)(sp + i * 16);
}
__device__ void phase_scan(const Params& p, char* lds) {
  unsigned char* ws = p.ws;
  const int tid = threadIdx.x, lane = tid & 63, wid = __builtin_amdgcn_readfirstlane(tid >> 6), r32 = lane & 31, hi = lane >> 5;
  const bf16_t* Rg = (const bf16_t*)(ws + OFF_R); const bf16_t* Kg = (const bf16_t*)(ws + OFF_K); const bf16_t* Vg = (const bf16_t*)(ws + OFF_V);
  const bf16_t* Lg = (const bf16_t*)(ws + OFF_LORA);
  constexpr int NCH = TL / 32;
  for (int sidx = blockIdx.x; sidx < 256; sidx += gridDim.x) {
    const int d = sidx >> 7, b = (sidx >> 4) & 7, h = sidx & 15;
    bf16_t* Yg = (bf16_t*)(ws + (d ? OFF_Y1 : OFF_Y0));
    if (wid < 4) {
      const int cw = wid, c16 = lane & 15, q = lane >> 4;
      const int arOff = (c16 & 3) * 128 + q * 16, wOff = q * 16, bkOff = c16 * 16, vOff = (cw * 16 + c16) * 16;
      f32x4 St0 = {0.f, 0.f, 0.f, 0.f}, St1 = St0, St2 = St0, St3 = St0;
      __syncthreads(); __syncthreads();
      for (int c = 0; c < NCH; ++c) {
        const char* buf = lds + (c & 1) * SC_BUF;
        char* yb = lds + SC_YB + (c & 1) * 8192 + (cw * 16 + c16) * 16;
        ScBlk cur; sc_ldb(cur, buf, 0, arOff, bkOff, vOff);
#pragma unroll 1
        for (int blk = 0; blk < 8; ++blk) {
          ScBlk nxt; sc_ldb(nxt, buf, (blk + 1) & 7, arOff, bkOff, vOff);
          u32x4 b1 = {cvtpk(St0[0], St0[1]), cvtpk(St0[2], St0[3]), cvtpk(St1[0], St1[1]), cvtpk(St1[2], St1[3])};
          u32x4 b2 = {cvtpk(St2[0], St2[1]), cvtpk(St2[2], St2[3]), cvtpk(St3[0], St3[1]), cvtpk(St3[2], St3[3])};
          f32x4 sr = {0.f, 0.f, 0.f, 0.f}, yr = sr;
          sr = MFMA16(*(bf16x8*)&cur.aa0, *(bf16x8*)&b1, sr); yr = MFMA16(*(bf16x8*)&cur.ar0, *(bf16x8*)&b1, yr);
          sr = MFMA16(*(bf16x8*)&cur.aa1, *(bf16x8*)&b2, sr); yr = MFMA16(*(bf16x8*)&cur.ar1, *(bf16x8*)&b2, yr);
          const float v1 = cur.v[0], v2 = cur.v[1], v3 = cur.v[2], v4 = cur.v[3];
          const f32x4 s0 = cur.s[0], s1 = cur.s[1], s2 = cur.s[2], s3 = cur.s[3], s4 = cur.s[4], s5 = cur.s[5], s6 = cur.s[6], s7 = cur.s[7];
          const float sa1 = sr[0];
          const float sa2 = sr[1] + s0[0] * sa1 + s1[2] * v1;
          const float sa3 = sr[2] + s0[1] * sa1 + s1[3] * v1 + s0[2] * sa2 + s2[0] * v2;
          const float sa4 = sr[3] + s0[3] * sa1 + s2[1] * v1 + s1[0] * sa2 + s2[2] * v2 + s1[1] * sa3 + s2[3] * v3;
          f32x4 y;
          y[0] = yr[0] + s3[0] * sa1 + s5[2] * v1;
          y[1] = yr[1] + s3[1] * sa1 + s5[3] * v1 + s3[2] * sa2 + s6[0] * v2;
          y[2] = yr[2] + s3[3] * sa1 + s6[1] * v1 + s4[0] * sa2 + s6[2] * v2 + s4[1] * sa3 + s6[3] * v3;
          y[3] = yr[3] + s4[2] * sa1 + s7[0] * v1 + s4[3] * sa2 + s7[1] * v2 + s5[0] * sa3 + s7[2] * v3 + s5[1] * sa4 + s7[3] * v4;
          u32x4 bu = {cvtpk(sa1, v1), cvtpk(sa2, v2), cvtpk(sa3, v3), cvtpk(sa4, v4)};
          if (q != 0) { bu[0] = 0u; bu[1] = 0u; bu[2] = 0u; bu[3] = 0u; }
          St0 = MFMA16(*(bf16x8*)&cur.k0, *(bf16x8*)&bu, St0);
          St1 = MFMA16(*(bf16x8*)&cur.k1, *(bf16x8*)&bu, St1);
          St2 = MFMA16(*(bf16x8*)&cur.k2, *(bf16x8*)&bu, St2);
          St3 = MFMA16(*(bf16x8*)&cur.k3, *(bf16x8*)&bu, St3);
          *(f32x4*)(yb + blk * 1024) = y;
          cur = nxt;
          if (blk == 7) {
            const char* pw = buf + SC_P + 31 * 256 + wOff;
            St0 *= *(const f32x4*)(pw); St1 *= *(const f32x4*)(pw + 64); St2 *= *(const f32x4*)(pw + 128); St3 *= *(const f32x4*)(pw + 192);
          }
          if (blk == 3 || blk == 7) __syncthreads();
        }
      }
    } else {
      const int pw = wid - 4, ptid = tid - 256;
      const int pstep = ptid >> 3, j0 = (ptid & 7) * 8, pblk = pstep >> 2, psb = pstep & 3;
      const int apos0 = (j0 >> 5) * 32 + (((j0 & 31) & 15) >> 2) * 8 + 4 * ((j0 & 31) >> 4), apos1 = apos0 + 8;
      float* Bg = (float*)(ws + OFF_BONUS) + (size_t)d * NTOK * 16;
      float kkc[8], kac[8], rkc[8];
#pragma unroll
      for (int e = 0; e < 8; ++e) { kkc[e] = p.in[15][h * 64 + j0 + e]; kac[e] = p.in[16][h * 64 + j0 + e]; rkc[e] = p.in[17][h * 64 + j0 + e]; }
      const int mat = pw >> 1, jh = pw & 1;
      bf16x8 w2f[4]; float bias;
      {
        const float* W2 = (mat ? p.in[14] : p.in[11]) + (size_t)d * 64 * 1024;
#pragma unroll
        for (int ks = 0; ks < 4; ++ks) {
          u32x4 w;
#pragma unroll
          for (int qq = 0; qq < 4; ++qq) {
            const int r0 = ks * 16 + 8 * hi + 2 * qq;
            w[qq] = cvtpk(W2[(size_t)r0 * 1024 + h * 64 + jh * 32 + r32], W2[(size_t)(r0 + 1) * 1024 + h * 64 + jh * 32 + r32]);
          }
          w2f[ks] = *(bf16x8*)&w;
        }
        bias = (mat ? p.in[12] : p.in[9])[d * 1024 + h * 64 + jh * 32 + r32];
      }
      u32x4 pR, pK, pV; bf16x8 pl[4];
      float kk[8], kr[8], rr[8];
      float* IC = (float*)(lds + SC_IC);
      bf16_t* SCR = (bf16_t*)(lds + SC_SCR);
      auto prefetch = [&](int c) {
        const size_t row = (size_t)scan_row(c * 32 + pstep, d, b) * 1024 + h * 64 + j0;
        pR = *(const u32x4*)(Rg + row); pK = *(const u32x4*)(Kg + row); pV = *(const u32x4*)(Vg + row);
        const size_t lrow = (size_t)scan_row(c * 32 + r32, d, b);
#pragma unroll
        for (int ks = 0; ks < 4; ++ks) pl[ks] = *(const bf16x8*)(Lg + lrow * 256 + mat * 128 + d * 64 + ks * 16 + hi * 8);
      };
      auto stageA = [&](int c) {
        char* buf = lds + (c & 1) * SC_BUF;
        float* Pd = (float*)(buf + SC_P); float* VV = (float*)(buf + SC_VV);
        f32x16 acc;
#pragma unroll
        for (int r = 0; r < 16; ++r) acc[r] = 0.f;
#pragma unroll
        for (int ks = 0; ks < 4; ++ks) acc = MFMA(pl[ks], w2f[ks], acc);
        if (mat == 0) {
          float cc[16];
#pragma unroll
          for (int r = 0; r < 16; ++r) cc[r] = -0.6065306597126334f * __builtin_amdgcn_rcpf(1.f + __expf(-(acc[r] + bias)));
#pragma unroll
          for (int g = 0; g < 4; ++g) { cc[4 * g + 1] += cc[4 * g]; cc[4 * g + 2] += cc[4 * g + 1]; cc[4 * g + 3] += cc[4 * g + 2]; }
          float run = 0.f;
#pragma unroll
          for (int g = 0; g < 4; ++g) {
            const float own = cc[4 * g + 3];
            auto rr2 = __builtin_amdgcn_permlane32_swap(__float_as_uint(own), __float_as_uint(own), false, false);
            const float both = __uint_as_float(rr2[0]) + __uint_as_float(rr2[1]), partner = both - own;
            const float off = hi ? run + partner : run;
#pragma unroll
            for (int e = 0; e < 4; ++e) Pd[crow(4 * g + e, hi) * 64 + jh * 32 + r32] = __expf(off + cc[4 * g + e]);
            run += both;
          }
        } else {
#pragma unroll
          for (int r = 0; r < 16; ++r) IC[crow(r, hi) * 64 + jh * 32 + r32] = __builtin_amdgcn_rcpf(1.f + __expf(-(acc[r] + bias)));
        }
        float ss = 0.f;
#pragma unroll
        for (int w = 0; w < 4; ++w) {
          rr[2 * w] = lo16(pR[w]); rr[2 * w + 1] = hi16(pR[w]);
          kr[2 * w] = lo16(pK[w]); kr[2 * w + 1] = hi16(pK[w]);
        }
        const float vv[8] = {lo16(pV[0]), hi16(pV[0]), lo16(pV[1]), hi16(pV[1]), lo16(pV[2]), hi16(pV[2]), lo16(pV[3]), hi16(pV[3])};
        if (c + 1 < NCH) prefetch(c + 1);
#pragma unroll
        for (int e = 0; e < 8; ++e) VV[(pblk * 64 + j0 + e) * 4 + psb] = vv[e];
#pragma unroll
        for (int e = 0; e < 8; ++e) { kk[e] = kr[e] * kkc[e]; ss += kk[e] * kk[e]; }
        ss = red8(ss);
        const float inv = rsqrtf(fmaxf(ss, 1e-24f));
#pragma unroll
        for (int e = 0; e < 8; ++e) kk[e] *= inv;
      };
      auto stageB = [&](int c) {
        char* buf = lds + (c & 1) * SC_BUF;
        const f32x4 i0 = *(const f32x4*)(IC + pstep * 64 + j0), i1 = *(const f32x4*)(IC + pstep * 64 + j0 + 4);
        const float ic[8] = {i0[0], i0[1], i0[2], i0[3], i1[0], i1[1], i1[2], i1[3]};
        const float* Pt = (const float*)(buf + SC_P) + pstep * 64 + j0;
        const f32x4 pt0 = *(const f32x4*)(Pt), pt1 = *(const f32x4*)(Pt + 4);
        f32x4 pm0 = {1.f, 1.f, 1.f, 1.f}, pm1 = pm0;
        if (pstep > 0) { pm0 = *(const f32x4*)(Pt - 64); pm1 = *(const f32x4*)(Pt - 60); }
        const float pt[8] = {pt0[0], pt0[1], pt0[2], pt0[3], pt1[0], pt1[1], pt1[2], pt1[3]};
        const float pm[8] = {pm0[0], pm0[1], pm0[2], pm0[3], pm1[0], pm1[1], pm1[2], pm1[3]};
        const u32x4 an = {cvtpk(-kk[0] * pm[0], -kk[1] * pm[1]), cvtpk(-kk[2] * pm[2], -kk[3] * pm[3]), cvtpk(-kk[4] * pm[4], -kk[5] * pm[5]), cvtpk(-kk[6] * pm[6], -kk[7] * pm[7])};
        const u32x4 rn = {cvtpk(rr[0] * pt[0], rr[1] * pt[1]), cvtpk(rr[2] * pt[2], rr[3] * pt[3]), cvtpk(rr[4] * pt[4], rr[5] * pt[5]), cvtpk(rr[6] * pt[6], rr[7] * pt[7])};
        bf16_t* ARa = (bf16_t*)(buf + SC_ARA) + (pblk * 4 + psb) * 64; bf16_t* ARr = (bf16_t*)(buf + SC_ARR) + (pblk * 4 + psb) * 64;
        { u32x2 lo = {an[0], an[1]}, hi2 = {an[2], an[3]}; *(u32x2*)(ARa + apos0) = lo; *(u32x2*)(ARa + apos1) = hi2; }
        { u32x2 lo = {rn[0], rn[1]}, hi2 = {rn[2], rn[3]}; *(u32x2*)(ARr + apos0) = lo; *(u32x2*)(ARr + apos1) = hi2; }
        *(u32x4*)(SCR + (pstep * 4 + 0) * 64 + j0) = an; *(u32x4*)(SCR + (pstep * 4 + 1) * 64 + j0) = rn;
        float bs = 0.f;
        unsigned bq[8], kq[8];
        unsigned* BK = (unsigned*)(buf + SC_BK) + (pblk * 64 + j0) * 4 + psb;
#pragma unroll
        for (int e = 0; e < 8; ++e) {
          const float kd = kr[e] * (1.f + (ic[e] - 1.f) * kac[e]);
          const float ip = __builtin_amdgcn_rcpf(pt[e]);
          const unsigned pr2 = cvtpk(kk[e] * ic[e] * ip, kd * ip);
          BK[e * 4] = pr2;
          bq[e] = pr2 & 0xffffu; kq[e] = pr2 >> 16;
          bs += rr[e] * kd * rkc[e];
        }
        const u32x4 bn = {bq[0] | (bq[1] << 16), bq[2] | (bq[3] << 16), bq[4] | (bq[5] << 16), bq[6] | (bq[7] << 16)};
        const u32x4 kn = {kq[0] | (kq[1] << 16), kq[2] | (kq[3] << 16), kq[4] | (kq[5] << 16), kq[6] | (kq[7] << 16)};
        *(u32x4*)(SCR + (pstep * 4 + 2) * 64 + j0) = bn; *(u32x4*)(SCR + (pstep * 4 + 3) * 64 + j0) = kn;
        bs = red8(bs);
        if ((ptid & 7) == 0) Bg[(size_t)scan_row(c * 32 + pstep, d, b) * 16 + h] = bs;
      };
      auto stageC = [&](int c) {
        char* buf = lds + (c & 1) * SC_BUF;
        asm volatile("s_waitcnt lgkmcnt(0)" ::: "memory");
        const int n16 = lane & 15, q4 = lane >> 4;
        const int stepA = (2 * pw + (n16 >> 3)) * 4 + (n16 & 3);
        const bf16_t* Xr = SCR + (stepA * 4 + 2 + ((n16 >> 2) & 1)) * 64 + q4 * 8;
        const bf16_t* Yc = SCR + (stepA * 4 + ((n16 >> 2) & 1)) * 64 + q4 * 8;
        f32x4 g = {0.f, 0.f, 0.f, 0.f};
        g = MFMA16(*(const bf16x8*)(Xr), *(const bf16x8*)(Yc), g);
        g = MFMA16(*(const bf16x8*)(Xr + 32), *(const bf16x8*)(Yc + 32), g);
        const int ctype = (n16 >> 2) & 1, t0 = n16 & 3, rtype = q4 & 1;
        const int grp = ctype * 2 + rtype, base = grp == 0 ? 0 : (grp == 1 ? 6 : (grp == 2 ? 12 : 22));
        float* sc = (float*)(buf + SC_SCAL) + (2 * pw + (n16 >> 3)) * 32 + base + (ctype ? (t0 + 1) * t0 / 2 : t0 * (t0 - 1) / 2);
        if ((q4 >> 1) == (n16 >> 3)) {
#pragma unroll
          for (int e = 0; e < 4; ++e) if (ctype ? (e <= t0) : (e < t0)) sc[e] = g[e];
        }
      };
      auto writeout = [&](int c) {
        const float* Yb = (const float*)(lds + SC_YB + (c & 1) * 8192) + (pblk * 64 + j0) * 4 + psb;
        u32x4 w = {cvtpk(Yb[0], Yb[4]), cvtpk(Yb[8], Yb[12]), cvtpk(Yb[16], Yb[20]), cvtpk(Yb[24], Yb[28])};
        *(u32x4*)(Yg + (size_t)scan_row(c * 32 + pstep, d, b) * 1024 + h * 64 + j0) = w;
      };
      prefetch(0);
      stageA(0);
      __syncthreads();
      stageB(0); stageC(0);
      __syncthreads();
      for (int c = 0; c < NCH; ++c) {
        if (c >= 1) writeout(c - 1);
        if (c + 1 < NCH) stageA(c + 1);
        __syncthreads();
        if (c + 1 < NCH) { stageB(c + 1); stageC(c + 1); }
        __syncthreads();
      }
      writeout(NCH - 1);
    }
    __syncthreads();
  }
}

__device__ void phase_readout(const Params& p) {
  unsigned char* ws = p.ws;
  const bf16_t* Y0 = (const bf16_t*)(ws + OFF_Y0); const bf16_t* Y1 = (const bf16_t*)(ws + OFF_Y1); const bf16_t* Vg = (const bf16_t*)(ws + OFF_V);
  bf16_t* G = (bf16_t*)(ws + OFF_G);
  const float* B0 = (const float*)(ws + OFF_BONUS); const float* B1 = B0 + (size_t)NTOK * 16;
  const int lane = threadIdx.x & 63, gw = blockIdx.x * 8 + (threadIdx.x >> 6), nw = gridDim.x * 8;
  const int c0 = lane * 16, hd = lane >> 2;
  float lg[16], lb[16];
#pragma unroll
  for (int e = 0; e < 16; ++e) { lg[e] = p.in[18][c0 + e]; lb[e] = p.in[19][c0 + e]; }
  struct RowIn { u32x4 a[2], b[2], v[2], g[2]; float b0, b1; };
  auto ldr = [&](int n, RowIn& r) {
    const size_t o = (size_t)n * 1024 + c0;
#pragma unroll
    for (int q = 0; q < 2; ++q) { r.a[q] = *(const u32x4*)(Y0 + o + 8 * q); r.b[q] = *(const u32x4*)(Y1 + o + 8 * q); r.v[q] = *(const u32x4*)(Vg + o + 8 * q); r.g[q] = *(const u32x4*)(G + o + 8 * q); }
    r.b0 = B0[(size_t)n * 16 + hd]; r.b1 = B1[(size_t)n * 16 + hd];
  };
  RowIn cur, nxt;
  if (gw < NTOK) ldr(gw, cur);
  for (int n = gw; n < NTOK; n += nw) {
    if (n + nw < NTOK) ldr(n + nw, nxt);
    const size_t o = (size_t)n * 1024 + c0;
    float y[16], v[16], g[16];
#pragma unroll
    for (int q = 0; q < 2; ++q) {
#pragma unroll
      for (int w = 0; w < 4; ++w) {
        y[8 * q + 2 * w] = lo16(cur.a[q][w]) + lo16(cur.b[q][w]); y[8 * q + 2 * w + 1] = hi16(cur.a[q][w]) + hi16(cur.b[q][w]);
        v[8 * q + 2 * w] = lo16(cur.v[q][w]); v[8 * q + 2 * w + 1] = hi16(cur.v[q][w]);
        g[8 * q + 2 * w] = lo16(cur.g[q][w]); g[8 * q + 2 * w + 1] = hi16(cur.g[q][w]);
      }
    }
    float s = 0.f;
#pragma unroll
    for (int e = 0; e < 16; ++e) s += y[e];
    s += dpp_f(s, 0); s += dpp_f(s, 1);
    const float mean = s * (1.f / 64.f);
    float q2 = 0.f;
#pragma unroll
    for (int e = 0; e < 16; ++e) { const float dlt = y[e] - mean; q2 += dlt * dlt; }
    q2 += dpp_f(q2, 0); q2 += dpp_f(q2, 1);
    const float rs = rsqrtf(q2 * (1.f / 64.f) + 64e-5f);
    const float bonus = cur.b0 + cur.b1;
    float r[16];
#pragma unroll
    for (int e = 0; e < 16; ++e) {
      const float yn = (y[e] - mean) * rs * lg[e] + lb[e];
      r[e] = (yn + bonus * v[e]) * (g[e] * sigmoidf_(g[e]));
    }
    u32x4 w0 = {cvtpk(r[0], r[1]), cvtpk(r[2], r[3]), cvtpk(r[4], r[5]), cvtpk(r[6], r[7])};
    u32x4 w1 = {cvtpk(r[8], r[9]), cvtpk(r[10], r[11]), cvtpk(r[12], r[13]), cvtpk(r[14], r[15])};
    *(u32x4*)(G + o) = w0; *(u32x4*)(G + o + 8) = w1;
    cur = nxt;
  }
}

constexpr int AT_SHMV = 16384, AT_KROW = 208, AT_SHMK = 64 * AT_KROW;
constexpr int AT_KOFF = 2 * AT_SHMV, AT_WOFF = AT_KOFF + 2 * AT_SHMK;
#define SBAR() __builtin_amdgcn_sched_barrier(0)
__device__ __forceinline__ void at_partialSM(f32x16& p0, f32x16& p1, float& m_reg, float& alpha, bool force) {
  float pm = p0[0];
#pragma unroll
  for (int r = 1; r < 16; ++r) pm = fmaxf(pm, p0[r]);
#pragma unroll
  for (int r = 0; r < 16; ++r) pm = fmaxf(pm, p1[r]);
  { auto rr = __builtin_amdgcn_permlane32_swap(__float_as_uint(pm), __float_as_uint(pm), false, false);
    pm = fmaxf(__uint_as_float(rr[0]), __uint_as_float(rr[1])); }
  if (__builtin_expect(!force && __all(pm <= AT_THR * 1.4426950408889634f), 1)) { alpha = 1.f; }
  else {
    const float dlt = force ? pm : fmaxf(pm, 0.f);
    alpha = force ? 1.f : __builtin_amdgcn_exp2f(-dlt); m_reg += dlt;
#pragma unroll
    for (int r = 0; r < 16; ++r) { p0[r] -= dlt; p1[r] -= dlt; }
  }
#pragma unroll
  for (int r = 0; r < 16; ++r) p0[r] = __builtin_amdgcn_exp2f(p0[r]);
}
__device__ __forceinline__ void at_finishSM(f32x16& p0, f32x16& p1, float alpha, float& l_reg, bf16x8& pa0, bf16x8& pa1, bf16x8& pa2, bf16x8& pa3) {
#pragma unroll
  for (int r = 0; r < 16; ++r) p1[r] = __builtin_amdgcn_exp2f(p1[r]);
  float ps = 0;
#pragma unroll
  for (int r = 0; r < 16; ++r) ps += p0[r];
#pragma unroll
  for (int r = 0; r < 16; ++r) ps += p1[r];
  { auto rr = __builtin_amdgcn_permlane32_swap(__float_as_uint(ps), __float_as_uint(ps), false, false);
    ps = __uint_as_float(rr[0]) + __uint_as_float(rr[1]); }
  l_reg = l_reg * alpha + ps;
#define PK4(P, BASE, OUT) do { unsigned a0 = cvtpk(P[BASE + 0], P[BASE + 1]), a1 = cvtpk(P[BASE + 2], P[BASE + 3]);   \
    unsigned b0 = cvtpk(P[BASE + 4], P[BASE + 5]), b1 = cvtpk(P[BASE + 6], P[BASE + 7]);                              \
    auto r0 = __builtin_amdgcn_permlane32_swap(a0, b0, false, false); auto r1 = __builtin_amdgcn_permlane32_swap(a1, b1, false, false); \
    u32x4 w = {r0[0], r1[0], r0[1], r1[1]}; OUT = *reinterpret_cast<bf16x8*>(&w); } while (0)
  PK4(p0, 0, pa0); PK4(p0, 8, pa1); PK4(p1, 0, pa2); PK4(p1, 8, pa3);
#undef PK4
}
__device__ __forceinline__ void at_qkt(f32x16& p0, f32x16& p1, const char* Ks, const bf16x8* qr, int r32, int hi, float negm) {
#pragma unroll
  for (int r = 0; r < 16; ++r) { p0[r] = negm; p1[r] = negm; }
#pragma unroll
  for (int d0 = 0; d0 < 6; ++d0) {
    const bf16x8 b0 = *(const bf16x8*)(Ks + r32 * AT_KROW + d0 * 32 + hi * 16);
    const bf16x8 b1 = *(const bf16x8*)(Ks + (32 + r32) * AT_KROW + d0 * 32 + hi * 16);
    p0 = MFMA(b0, qr[d0], p0);
    p1 = MFMA(b1, qr[d0], p1);
  }
}
__device__ __forceinline__ int v_st(int k, int c) { const int kk = (k & ~0xC) | ((k & 4) << 1) | ((k & 8) >> 1); return ((kk >> 3) * 4 + (c >> 5)) * 512 + ((kk & 7) * 32 + (c & 31)) * 2; }
__device__ __forceinline__ int v_rd_base(int lane) { return ((lane & 3) << 3) | (((lane >> 2) & 3) << 6) | (((lane >> 4) & 1) << 5) | (((lane >> 5) & 1) << 8); }
constexpr int v_rd_off(int d0, int ks, int half) { return d0 * 512 + ks * 4096 + half * 2048; }
template <int OFF> __device__ __forceinline__ s16x4 tr_read(int vb) {
  s16x4 r; asm volatile("ds_read_b64_tr_b16 %0, %1 offset:%2" : "=&v"(r) : "v"(vb), "i"(OFF) : "memory"); return r;
}
template <int D0> __device__ __forceinline__ void pv_one(f32x16& od, int vb, bf16x8 pa0, bf16x8 pa1, bf16x8 pa2, bf16x8 pa3) {
  const s16x4 l0 = tr_read<v_rd_off(D0, 0, 0)>(vb), h0 = tr_read<v_rd_off(D0, 0, 1)>(vb), l1 = tr_read<v_rd_off(D0, 1, 0)>(vb), h1 = tr_read<v_rd_off(D0, 1, 1)>(vb);
  const s16x4 l2 = tr_read<v_rd_off(D0, 2, 0)>(vb), h2 = tr_read<v_rd_off(D0, 2, 1)>(vb), l3 = tr_read<v_rd_off(D0, 3, 0)>(vb), h3 = tr_read<v_rd_off(D0, 3, 1)>(vb);
  asm volatile("s_waitcnt lgkmcnt(0)" ::: "memory"); SBAR();
#define PK(Lx, Hx) (bf16x8){Lx[0], Lx[1], Lx[2], Lx[3], Hx[0], Hx[1], Hx[2], Hx[3]}
  od = MFMA(pa0, PK(l0, h0), od);
  od = MFMA(pa1, PK(l1, h1), od);
  od = MFMA(pa2, PK(l2, h2), od);
  od = MFMA(pa3, PK(l3, h3), od);
#undef PK
}
__device__ __forceinline__ void pv_d0(f32x16* o, int vb, bf16x8 pa0, bf16x8 pa1, bf16x8 pa2, bf16x8 pa3) {
  pv_one<0>(o[0], vb, pa0, pa1, pa2, pa3); pv_one<1>(o[1], vb, pa0, pa1, pa2, pa3);
}

__device__ void phase_attn(const Params& p, char* lds) {
  unsigned char* ws = p.ws;
  const bf16_t* Qg = (const bf16_t*)(ws + OFF_Q); const bf16_t* KVg = (const bf16_t*)(ws + OFF_KV); const bf16_t* KPg = (const bf16_t*)(ws + OFF_KPE);
  bf16_t* G1 = (bf16_t*)(ws + OFF_G1);
  const f32x2* rope = (const f32x2*)(ws + OFF_ROPE);
  const int tid = threadIdx.x, wid = tid >> 6, lane = tid & 63, r32 = lane & 31, hi = lane >> 5;
  char* V_lds = lds; char* K_lds = lds + AT_KOFF;
  float* wsl = (float*)(lds + AT_WOFF) + wid * 64; float* li_l = wsl; float* al_l = wsl + 32;
  const int skey = tid >> 3, sc8 = (tid & 7) * 8;
  const int pkey = (tid & 255) >> 2, pc8 = (tid & 3) * 8;
  const int vst = v_st(skey, sc8), kst = skey * AT_KROW + sc8 * 2, pst = pkey * AT_KROW + (64 + pc8) * 2;
  const int vb0 = (int)(uintptr_t)V_lds + v_rd_base(lane);
  const int nitems = NB * 16 * 32;
  const int xcd = blockIdx.x & 7, slot = blockIdx.x >> 3, per = gridDim.x >> 3;
  for (int it = slot; it < nitems / 8; it += per) {
    const int pair = (it >> 5) * 8 + xcd, qblk = it & 31;
    const int b = pair >> 4, h = pair & 15;
    const size_t row0 = (size_t)b * TL;
    const size_t qrow = row0 + qblk * 256 + wid * 32 + r32;
    const bf16_t* Kh = KVg + row0 * 2048 + h * 128;
    const bf16_t* Kp = KPg + row0 * 32;
    float m_reg = 0.f, l_reg = 0.f;
    f32x16 o[2];
#pragma unroll
    for (int dd = 0; dd < 2; ++dd)
#pragma unroll
      for (int r = 0; r < 16; ++r) o[dd][r] = 0.f;
    bf16x8 qr[6];
    {
      const bf16_t* Qw = Qg + qrow * 1536 + h * 96 + hi * 8;
#pragma unroll
      for (int d0 = 0; d0 < 6; ++d0) qr[d0] = *(const bf16x8*)(Qw + d0 * 16);
      const int t = qblk * 256 + wid * 32 + r32;
      const f32x2* tb = rope + (hi ? (t & 63) : (t >> 6)) * 8;
      const u32x4 x1 = *(const u32x4*)&qr[4], x2 = *(const u32x4*)&qr[5];
      u32x4 n1, n2;
#pragma unroll
      for (int q = 0; q < 4; ++q) {
        const f32x2 csA = tb[2 * q], csB = tb[2 * q + 1];
        const float a0 = lo16(x1[q]), a1 = hi16(x1[q]), b0 = lo16(x2[q]), b1 = hi16(x2[q]);
        n1[q] = cvtpk(a0 * csA[0] - b0 * csA[1], a1 * csB[0] - b1 * csB[1]);
        n2[q] = cvtpk(a0 * csA[1] + b0 * csA[0], a1 * csB[1] + b1 * csB[0]);
      }
      qr[4] = *(bf16x8*)&n1; qr[5] = *(bf16x8*)&n2;
    }
    struct { bf16x8 vs, ks, ps; } sr_[2];
#define SLOAD(i, k0) do { sr_[i].vs = *(const bf16x8*)(Kh + (size_t)((k0) + skey) * 2048 + 64 + sc8); \
    sr_[i].ks = *(const bf16x8*)(Kh + (size_t)((k0) + skey) * 2048 + sc8); \
    sr_[i].ps = *(const bf16x8*)(Kp + (size_t)((k0) + pkey) * 32 + pc8); } while (0)
#define SWRITE(bb, i) do { *(bf16x8*)(V_lds + (bb) * AT_SHMV + vst) = sr_[i].vs; \
    *(bf16x8*)(K_lds + (bb) * AT_SHMK + kst) = sr_[i].ks; \
    *(bf16x8*)(K_lds + (bb) * AT_SHMK + pst) = sr_[i].ps; } while (0)
#define SWAIT() asm volatile("s_waitcnt vmcnt(3)" ::: "memory")
#define RESC(a) do { if (__any((a) < 1.f)) { if (hi == 0) al_l[r32] = (a); asm volatile("s_waitcnt lgkmcnt(0)" ::: "memory"); \
    _Pragma("unroll") for (int dd = 0; dd < 2; ++dd) _Pragma("unroll") for (int r = 0; r < 16; ++r) o[dd][r] *= al_l[crow(r, hi)]; } } while (0)
    f32x16 pA0, pA1, pB0, pB1; float alA, alB; bf16x8 pa0, pa1, pa2, pa3;
    constexpr int NT = TL / 64;
    SLOAD(0, 0); asm volatile("s_waitcnt vmcnt(0)" ::: "memory"); SWRITE(0, 0); __syncthreads();
    at_qkt(pA0, pA1, K_lds, qr, r32, hi, 0.f); at_partialSM(pA0, pA1, m_reg, alA, true);
    SLOAD(1, 64); SLOAD(0, 128);
    SWAIT(); SWRITE(1, 1); __syncthreads();
    for (int j = 1; j + 1 < NT; j += 2) {
      SBAR(); at_qkt(pB0, pB1, K_lds + AT_SHMK, qr, r32, hi, -m_reg);
      at_finishSM(pA0, pA1, alA, l_reg, pa0, pa1, pa2, pa3); SBAR();
      SLOAD(1, (j + 2) * 64); SBAR();
      pv_d0(o, vb0, pa0, pa1, pa2, pa3); at_partialSM(pB0, pB1, m_reg, alB, false);
      __syncthreads(); SWAIT(); SWRITE(0, 0);
      RESC(alB); __syncthreads();
      SBAR(); at_qkt(pA0, pA1, K_lds, qr, r32, hi, -m_reg);
      at_finishSM(pB0, pB1, alB, l_reg, pa0, pa1, pa2, pa3); SBAR();
      if (j + 3 < NT) SLOAD(0, (j + 3) * 64); SBAR();
      pv_d0(o, vb0 + AT_SHMV, pa0, pa1, pa2, pa3); at_partialSM(pA0, pA1, m_reg, alA, false);
      __syncthreads(); SWAIT(); SWRITE(1, 1);
      RESC(alA); __syncthreads();
    }
    SBAR(); at_qkt(pB0, pB1, K_lds + AT_SHMK, qr, r32, hi, -m_reg);
    at_finishSM(pA0, pA1, alA, l_reg, pa0, pa1, pa2, pa3); SBAR();
    pv_d0(o, vb0, pa0, pa1, pa2, pa3); at_partialSM(pB0, pB1, m_reg, alB, false);
    __syncthreads(); RESC(alB);
    at_finishSM(pB0, pB1, alB, l_reg, pa0, pa1, pa2, pa3); SBAR();
    pv_d0(o, vb0 + AT_SHMV, pa0, pa1, pa2, pa3);
    if (hi == 0) li_l[r32] = l_reg;
    asm volatile("s_waitcnt lgkmcnt(0)" ::: "memory");
    float rli[16];
#pragma unroll
    for (int r = 0; r < 16; ++r) rli[r] = __builtin_amdgcn_rcpf(li_l[crow(r, hi)]);
    bf16_t* Gw = G1 + (row0 + qblk * 256 + wid * 32) * 1024 + h * 64 + r32;
    bf16_t gin[32];
#pragma unroll
    for (int r = 0; r < 16; ++r) { gin[2 * r] = Gw[(size_t)crow(r, hi) * 1024]; gin[2 * r + 1] = Gw[(size_t)crow(r, hi) * 1024 + 32]; }
    asm volatile("" ::: "memory");
#pragma unroll
    for (int r = 0; r < 16; ++r) {
      const int orow = crow(r, hi);
#pragma unroll
      for (int d0 = 0; d0 < 2; ++d0) {
        const float gt = bf2f(gin[2 * r + d0]);
        Gw[(size_t)orow * 1024 + d0 * 32] = f2bf(o[d0][r] * rli[r] * gt * sigmoidf_(gt));
      }
    }
    __syncthreads();
#undef SLOAD
#undef SWRITE
#undef SWAIT
#undef RESC
  }
}

struct XcdWalk {
  int start, count, step, idx;
  __device__ __forceinline__ void init(int ntiles) {
    const int x = blockIdx.x & 7, base = ntiles >> 3, rem = ntiles & 7;
    count = base + (x < rem ? 1 : 0); start = x * base + (x < rem ? x : rem); step = gridDim.x >> 3; idx = blockIdx.x >> 3;
  }
  __device__ __forceinline__ bool next(int& o) { if (idx >= count) return false; o = start + idx; idx += step; return true; }
  __device__ __forceinline__ bool next_full(int& o) { const int full = (count / step) * step; if (idx >= full) return false; o = start + idx; idx += step; return true; }
  __device__ __forceinline__ bool tail(int& o, int& half) const {
    const int full = (count / step) * step, rem = count - full, sl = blockIdx.x >> 3;
    if (2 * rem <= step) { if (sl >= 2 * rem) return false; o = start + full + (sl >> 1); half = sl & 1; return true; }
    if (sl >= rem) return false; o = start + full + sl; half = -1; return true;
  }
};
__device__ __forceinline__ void tile_mn(int o, int NT, int& mt, int& nt) { const int g = o >> 3; mt = (g / NT) * 8 + (o & 7); nt = g % NT; }

__global__ __launch_bounds__(NTHR, 1) void fwd_megakernel(Params p) {
  extern __shared__ __attribute__((aligned(16))) char lds[];
  cg::grid_group grid = cg::this_grid();
  unsigned char* ws = p.ws;
  bf16_t* H = (bf16_t*)(ws + OFF_H);
  float* mod = (float*)(ws + OFF_MOD);
  float* CTX1 = (float*)(ws + OFF_CTX1);

  phase_prologue(p, lds);
  grid.sync();
  phase_norm_lerp(p, mod);
  phase_weights(p, lds);
  grid.sync();
  {
    const bf16_t* WIN0 = (const bf16_t*)(ws + OFF_WIN0);
    const int nbig = 264 * 16;
    XcdWalk wk; wk.init(nbig); int o, half;
    auto big = [&](int oo, int hf) {
      EpiBf16 e; e.invK = 0.f; e.scr = lds + G_EPI_SCR;
      int mt, jn; tile_mn(oo, 16, mt, jn);
      const int j = jn >> 2, n4 = jn & 3, m0 = mt * 256, c0 = n4 * 256 + (hf > 0 ? 128 : 0);
      e.dst = (bf16_t*)(ws + OFF_R + (size_t)j * U); e.ldd = 1024; e.col0 = c0; e.act = 0; e.m0 = m0;
      if (hf < 0) gemm_tile<0, 256>(lerp_base(p, j, m0), 1024, WIN0 + (size_t)(j * 1024 + c0) * 1024, 1024, m0, nullptr, lds, e);
      else gemm_tile<0, 128>(lerp_base(p, j, m0), 1024, WIN0 + (size_t)(j * 1024 + c0) * 1024, 1024, m0, nullptr, lds, e);
    };
    while (wk.next_full(o)) big(o, -1);
    if (wk.tail(o, half)) big(o, half);
    wk.init(264 * 2);
    while (wk.next(o)) {
      EpiBf16 e; e.invK = 0.f; e.scr = lds + G_EPI_SCR;
      {
        int mt, n2; tile_mn(o, 2, mt, n2);
        const int nt = 32 + n2, m0 = mt * 256;
        e.dst = (bf16_t*)(ws + OFF_LORA); e.ldd = 256; e.col0 = (nt - 32) * 128; e.act = (nt == 32) ? 1 : 0; e.m0 = m0;
        gemm_tile<1, 128>(H, 1024, WIN0 + (size_t)nt * 128 * 1024, 1024, m0, p.in[7] + (nt - 28) * 1024, lds, e);
      }
    }
  }
  grid.sync();
  phase_scan(p, lds);
  grid.sync();
  phase_readout(p);
  grid.sync();
  {
    const bf16_t* A = (const bf16_t*)(ws + OFF_G); const bf16_t* W = (const bf16_t*)(ws + OFF_WOUT0);
    XcdWalk wk; wk.init(264 * 4); int o, half;
    auto tile5 = [&](int oo, int hf) {
      int mt, nt; tile_mn(oo, 4, mt, nt);
      const int m0 = mt * 256;
      const int b = m0 / TL, t0 = m0 - b * TL;
      EpiResid e;
      if (t0 < T) { const size_t orow = (size_t)b * T + t0; e.xin = p.in[0] + orow * 1024; e.xout = p.out + orow * 1024; e.gvec = mod + (size_t)b * 3072 + 2048; }
      else { const size_t orow = (size_t)b * L + (t0 - T); e.xin = p.in[2] + orow * 1024; e.xout = CTX1 + orow * 1024; e.gvec = mod + (size_t)8 * 3072 + 2048; }
      e.n0 = nt * 256 + (hf > 0 ? 128 : 0); e.scr = lds + G_EPI_SCR;
      if (hf < 0) gemm_tile<0, 256>(A, 1024, W + (size_t)e.n0 * 1024, 1024, m0, nullptr, lds, e);
      else gemm_tile<0, 128>(A, 1024, W + (size_t)e.n0 * 1024, 1024, m0, nullptr, lds, e);
    };
    while (wk.next_full(o)) tile5(o, -1);
    if (wk.tail(o, half)) tile5(o, half);
  }
  grid.sync();
  phase_norm(p.out, CTX1, p.in[4] + 1024, mod + 9 * 3072, H);
  grid.sync();
  {
    const bf16_t* W = (const bf16_t*)(ws + OFF_WIN1);
    XcdWalk wk; wk.init(264 * 7); int o, half;
    auto tile7 = [&](int oo, int hf) {
      int mt, nt; tile_mn(oo, 7, mt, nt);
      const int m0 = mt * 256;
      EpiMlaIn e; e.QC = (bf16_t*)(ws + OFF_QC); e.KVC = (bf16_t*)(ws + OFF_KVC); e.KPE = (bf16_t*)(ws + OFF_KPE); e.G1 = (bf16_t*)(ws + OFF_G1);
      e.rope = (const float*)(ws + OFF_ROPE); e.n0 = nt * 256 + (hf > 0 ? 128 : 0); e.m0 = m0; e.scr = lds + G_EPI_SCR;
      if (hf < 0) gemm_tile<0, 256>(H, 1024, W + (size_t)e.n0 * 1024, 1024, m0, nullptr, lds, e);
      else gemm_tile<0, 128>(H, 1024, W + (size_t)e.n0 * 1024, 1024, m0, nullptr, lds, e);
    };
    while (wk.next_full(o)) tile7(o, -1);
    if (wk.tail(o, half)) tile7(o, half);
  }
  grid.sync();
  {
    const bf16_t* WQ = (const bf16_t*)(ws + OFF_WQB); const bf16_t* WKV = (const bf16_t*)(ws + OFF_WKVB);
    const int nq = 256 * 6, nkv = 264 * 8;
    XcdWalk wk; wk.init(nq); int o;
    while (wk.next(o)) {
      EpiBf16 e; e.act = 0; e.scr = lds + G_EPI_SCR;
      {
        int mt2, nt; tile_mn(o, 6, mt2, nt);
        const int b = mt2 >> 5, m0 = b * TL + (mt2 & 31) * 256;
        e.dst = (bf16_t*)(ws + OFF_Q); e.ldd = 1536; e.col0 = nt * 256; e.m0 = m0; e.invK = 1.f / 384.f;
        gemm_tile<2, 256>((const bf16_t*)(ws + OFF_QC), 384, WQ + (size_t)nt * 256 * 384, 384, m0, nullptr, lds, e);
      }
    }
    wk.init(nkv);
    while (wk.next(o)) {
      EpiBf16 e; e.act = 0; e.scr = lds + G_EPI_SCR;
      {
        int mt, nt; tile_mn(o, 8, mt, nt);
        const int m0 = mt * 256;
        e.dst = (bf16_t*)(ws + OFF_KV); e.ldd = 2048; e.col0 = nt * 256; e.m0 = m0; e.invK = 1.f / 256.f;
        gemm_tile<2, 256>((const bf16_t*)(ws + OFF_KVC), 256, WKV + (size_t)nt * 256 * 256, 256, m0, nullptr, lds, e);
      }
    }
  }
  grid.sync();
  phase_attn(p, lds);
  grid.sync();
  {
    const bf16_t* A = (const bf16_t*)(ws + OFF_G1); const bf16_t* W = (const bf16_t*)(ws + OFF_WOUT1);
    XcdWalk wk; wk.init(256 * 4); int o;
    while (wk.next(o)) {
      int mt2, nt; tile_mn(o, 4, mt2, nt);
      const int b = mt2 >> 5, t0 = (mt2 & 31) * 256, m0 = b * TL + t0;
      const size_t orow = (size_t)b * T + t0;
      EpiResid e; e.xin = p.out + orow * 1024; e.xout = p.out + orow * 1024; e.gvec = mod + (size_t)(9 + b) * 3072 + 2048; e.n0 = nt * 256; e.scr = lds + G_EPI_SCR;
      gemm_tile<0, 256>(A, 1024, W + (size_t)nt * 256 * 1024, 1024, m0, nullptr, lds, e);
    }
  }
  grid.sync();
  phase_final(p.out, p.in[27]);
}

extern "C" void kernel_launch(void* const* d_in, const int* in_sizes, int n_in, void* d_out, int out_size, void* d_ws, size_t ws_size, hipStream_t stream) {
  static int grid_blocks = 0;
  if (grid_blocks == 0) {
    if (n_in != 28 || ws_size < WS_END + (size_t)(NTOK - LERP3_SPLIT) * 2048 || out_size != NB * T * D) { fprintf(stderr, "kernel_launch: unexpected shapes (n_in %d, ws %zu need %zu, out %d)\n", n_in, ws_size, (size_t)WS_END, out_size); grid_blocks = -1; return; }
    int dev = 0, cus = 0, per_cu = 0;
    hipGetDevice(&dev);
    hipDeviceGetAttribute(&cus, hipDeviceAttributeMultiprocessorCount, dev);
    if (hipFuncSetAttribute((const void*)fwd_megakernel, hipFuncAttributeMaxDynamicSharedMemorySize, LDS_BYTES) != hipSuccess) { fprintf(stderr, "kernel_launch: hipFuncSetAttribute failed\n"); grid_blocks = -1; return; }
    hipOccupancyMaxActiveBlocksPerMultiprocessor(&per_cu, (const void*)fwd_megakernel, NTHR, LDS_BYTES);
    if (per_cu < 1) { fprintf(stderr, "kernel_launch: occupancy query says %d blocks per CU\n", per_cu); per_cu = 1; }
    (void)hipGetLastError();
    grid_blocks = cus;
    if (grid_blocks > 256) grid_blocks = 256;
    grid_blocks &= ~7;
  }
  if (grid_blocks <= 0) return;
  Params p{};
  for (int i = 0; i < 28; ++i) p.in[i] = (const float*)d_in[i];
  p.out = (float*)d_out; p.ws = (unsigned char*)d_ws;
  void* args[] = {&p};
  hipError_t e = hipLaunchCooperativeKernel((const void*)fwd_megakernel, dim3(grid_blocks), dim3(NTHR), args, LDS_BYTES, stream);
  if (e != hipSuccess) fprintf(stderr, "cooperative launch failed: %s (grid %d)\n", hipGetErrorString(e), grid_blocks);
}
```

```cpp
#include <hip/hip_runtime.h>
#include <hip/hip_cooperative_groups.h>
#include <cstdio>
#include <cstdint>
namespace cg = cooperative_groups;

typedef unsigned short bf16_t;
typedef short bf16x8 __attribute__((ext_vector_type(8)));
typedef short s16x4 __attribute__((ext_vector_type(4)));
typedef float f32x16 __attribute__((ext_vector_type(16)));
typedef float f32x4 __attribute__((ext_vector_type(4)));
typedef float f32x2 __attribute__((ext_vector_type(2)));
typedef unsigned u32x4 __attribute__((ext_vector_type(4)));
typedef unsigned u32x2 __attribute__((ext_vector_type(2)));

constexpr int D = 1024, NB = 8, T = 8192, L = 256, TL = T + L, NTOK = NB * TL;
constexpr int NTHR = 512;

constexpr size_t U = (size_t)NTOK * 1024 * 2;
constexpr size_t OFF_H = 0, OFF_R = U, OFF_K = 2 * U, OFF_V = 3 * U, OFF_G = 4 * U, OFF_Y0 = 5 * U, OFF_Y1 = 6 * U;
constexpr size_t OFF_LORA = 7 * U;
constexpr size_t OFF_BONUS = OFF_LORA + (size_t)NTOK * 256 * 2;
constexpr size_t OFF_WIN0 = OFF_BONUS + (size_t)2 * NTOK * 16 * 4;
constexpr size_t OFF_WOUT0 = OFF_WIN0 + (size_t)4352 * 1024 * 2;
constexpr size_t OFF_WIN1 = OFF_WOUT0 + (size_t)1024 * 1024 * 2;
constexpr size_t OFF_WQB = OFF_WIN1 + (size_t)1792 * 1024 * 2;
constexpr size_t OFF_WKVB = OFF_WQB + (size_t)1536 * 384 * 2;
constexpr size_t OFF_WOUT1 = OFF_WKVB + (size_t)2048 * 256 * 2;
constexpr size_t OFF_MOD = OFF_WOUT1 + (size_t)1024 * 1024 * 2;
constexpr size_t OFF_ROPE = OFF_MOD + (size_t)2 * 9 * 3072 * 4;
constexpr size_t OFF_CTX1 = OFF_ROPE + (size_t)128 * 8 * 2 * 4;
constexpr size_t WS_END = OFF_CTX1 + (size_t)2048 * 1024 * 4;
constexpr size_t OFF_QC = OFF_V;
constexpr size_t OFF_KVC = OFF_QC + (size_t)NTOK * 384 * 2;
constexpr size_t OFF_KPE = OFF_KVC + (size_t)NTOK * 256 * 2;
constexpr size_t OFF_G1 = OFF_G;
constexpr size_t OFF_Q = OFF_R;
constexpr size_t OFF_KV = OFF_Y0;

struct Params { const float* in[28]; float* out; unsigned char* ws; };

typedef __bf16 bf16x2_t __attribute__((ext_vector_type(2)));
__device__ __forceinline__ unsigned cvtpk(float lo, float hi) { f32x2 v = {lo, hi}; bf16x2_t b = __builtin_convertvector(v, bf16x2_t); return *(unsigned*)&b; }
__device__ __forceinline__ float bf2f(bf16_t u) { return __uint_as_float(((unsigned)u) << 16); }
__device__ __forceinline__ bf16_t f2bf(float f) { return (bf16_t)(cvtpk(f, 0.f) & 0xffffu); }
__device__ __forceinline__ float lo16(unsigned w) { return __uint_as_float(w << 16); }
__device__ __forceinline__ float hi16(unsigned w) { return __uint_as_float(w & 0xffff0000u); }
__device__ __forceinline__ void st_bf16x4(bf16_t* p, float a, float b, float c, float d) { u32x2 w = {cvtpk(a, b), cvtpk(c, d)}; *(u32x2*)p = w; }
__device__ __forceinline__ void st_bf16x4_nt(bf16_t* p, float a, float b, float c, float d) { u32x2 w = {cvtpk(a, b), cvtpk(c, d)}; __builtin_nontemporal_store(w, (u32x2*)p); }
__device__ __forceinline__ float wave_sum(float v) {
#pragma unroll
  for (int o = 32; o; o >>= 1) v += __shfl_xor(v, o);
  return v;
}
__device__ __forceinline__ float dpp_f(float v, const int ctrl_sel) {
  int r;
  if (ctrl_sel == 0) r = __builtin_amdgcn_update_dpp(0, __float_as_int(v), 0xB1, 0xF, 0xF, true);
  else if (ctrl_sel == 1) r = __builtin_amdgcn_update_dpp(0, __float_as_int(v), 0x4E, 0xF, 0xF, true);
  else r = __builtin_amdgcn_update_dpp(0, __float_as_int(v), 0x141, 0xF, 0xF, true);
  return __int_as_float(r);
}
__device__ __forceinline__ float red8(float v) { v += dpp_f(v, 0); v += dpp_f(v, 1); v += dpp_f(v, 2); return v; }
__device__ __forceinline__ int crow(int r, int hi) { return (r & 3) + 8 * (r >> 2) + 4 * hi; }
__device__ __forceinline__ float sigmoidf_(float x) { return __builtin_amdgcn_rcpf(1.f + __expf(-x)); }
#define MFMA(a, b, c) __builtin_amdgcn_mfma_f32_32x32x16_bf16((a), (b), (c), 0, 0, 0)

constexpr int G_LDT = 144;
constexpr int G_SSQ_OFF = 2 * (256 + 256) * G_LDT;
constexpr int LDS_BYTES = G_SSQ_OFF + 1024;

template <int AMODE, int BN, class Epi>
__device__ __forceinline__ void gemm_tile(const bf16_t* A, const int lda, const bf16_t* Bt, const int K, const int m0, const float* mu, char* lds, const Epi& epi) {
  constexpr int WN = BN / 64, MI = WN, NBR = BN / 64, G_STAGE = (256 + BN) * G_LDT;
  const int tid = threadIdx.x, lane = tid & 63, wid = tid >> 6, r32 = lane & 31, hi = lane >> 5;
  const int wm = wid / WN, wn = wid % WN;
  const int srow = tid >> 3, scc = (tid & 7) * 8;
  int browi[NBR];
#pragma unroll
  for (int i = 0; i < NBR; ++i) browi[i] = 64 * i + ((Epi::PERM && !epi.natural_group(64 * i + srow)) ? ((srow & 32) + 16 * ((srow >> 2) & 1) + 4 * ((srow & 31) >> 3) + (srow & 3)) : srow);
  f32x16 acc[MI][2];
#pragma unroll
  for (int i = 0; i < MI; ++i)
#pragma unroll
    for (int j = 0; j < 2; ++j)
#pragma unroll
      for (int r = 0; r < 16; ++r) acc[i][j][r] = 0.f;
  bf16x8 ra[4], rb[NBR], rp[4], rn[4];
  float ssq[4] = {0.f, 0.f, 0.f, 0.f};
  int dprev[4], dnext[4];
  if constexpr (AMODE == 1) {
    const int t0 = m0 % TL;
#pragma unroll
    for (int i = 0; i < 4; ++i) { const int t = t0 + srow + 64 * i; dprev[i] = (t != 0 && t != T) ? 1 : 0; dnext[i] = (t != T - 1 && t != TL - 1) ? 1 : 0; }
  }
  auto gload = [&](int k0) {
#pragma unroll
    for (int i = 0; i < 4; ++i) {
      const bf16_t* ap = A + (size_t)(m0 + srow + 64 * i) * lda + k0 + scc;
      ra[i] = *(const bf16x8*)ap;
      if constexpr (AMODE == 1) { rp[i] = *(const bf16x8*)(ap - dprev[i] * lda); rn[i] = *(const bf16x8*)(ap + dnext[i] * lda); }
    }
#pragma unroll
    for (int i = 0; i < NBR; ++i) rb[i] = *(const bf16x8*)(Bt + (size_t)browi[i] * K + k0 + scc);
  };
  auto lstore = [&](int s, int k0) {
    char* base = lds + s * G_STAGE;
    if constexpr (AMODE == 1) {
      const f32x4 m0v = *(const f32x4*)(mu + k0 + scc), m1v = *(const f32x4*)(mu + k0 + scc + 4);
      const float mm[8] = {m0v[0], m0v[1], m0v[2], m0v[3], m1v[0], m1v[1], m1v[2], m1v[3]};
#pragma unroll
      for (int i = 0; i < 4; ++i) {
        const u32x4 hc = *(const u32x4*)&ra[i], hp = *(const u32x4*)&rp[i], hn = *(const u32x4*)&rn[i];
        const float fp = dprev[i] ? 0.5f : 0.f, fn = dnext[i] ? 0.5f : 0.f;
        u32x4 w;
#pragma unroll
        for (int q = 0; q < 4; ++q) {
          const float c0 = lo16(hc[q]), c1 = hi16(hc[q]);
          const float x0 = fp * lo16(hp[q]) + fn * lo16(hn[q]) - c0, x1 = fp * hi16(hp[q]) + fn * hi16(hn[q]) - c1;
          w[q] = cvtpk(c0 + x0 * mm[2 * q], c1 + x1 * mm[2 * q + 1]);
        }
        *(u32x4*)(base + (srow + 64 * i) * G_LDT + scc * 2) = w;
      }
    } else {
#pragma unroll
      for (int i = 0; i < 4; ++i) {
        *(bf16x8*)(base + (srow + 64 * i) * G_LDT + scc * 2) = ra[i];
        if constexpr (AMODE == 2) {
          const u32x4 hc = *(const u32x4*)&ra[i];
#pragma unroll
          for (int q = 0; q < 4; ++q) { const float c0 = lo16(hc[q]), c1 = hi16(hc[q]); ssq[i] += c0 * c0 + c1 * c1; }
        }
      }
    }
#pragma unroll
    for (int i = 0; i < NBR; ++i) *(bf16x8*)(base + 256 * G_LDT + (srow + 64 * i) * G_LDT + scc * 2) = rb[i];
  };
  const int nk = K >> 6;
  gload(0);
  lstore(0, 0);
  if (nk > 1) gload(64);
  __syncthreads();
#pragma unroll 1
  for (int kt = 0; kt < nk; ++kt) {
    const int s = kt & 1;
    if (kt + 1 < nk) lstore(s ^ 1, (kt + 1) * 64);
    if (kt + 2 < nk) gload((kt + 2) * 64);
    {
      const char* Ab = lds + s * G_STAGE + (wm * (32 * MI) + r32) * G_LDT + hi * 16;
      const char* Bb = lds + s * G_STAGE + 256 * G_LDT + (wn * 64 + r32) * G_LDT + hi * 16;
      bf16x8 fb[2][2], fa[2][MI];
      fb[0][0] = *(const bf16x8*)(Bb); fb[0][1] = *(const bf16x8*)(Bb + 32 * G_LDT);
#pragma unroll
      for (int mi = 0; mi < MI; ++mi) fa[0][mi] = *(const bf16x8*)(Ab + mi * 32 * G_LDT);
#pragma unroll
      for (int ks = 0; ks < 4; ++ks) {
        const int sl = ks & 1;
        if (ks + 1 < 4) {
          fb[sl ^ 1][0] = *(const bf16x8*)(Bb + (ks + 1) * 32); fb[sl ^ 1][1] = *(const bf16x8*)(Bb + 32 * G_LDT + (ks + 1) * 32);
#pragma unroll
          for (int mi = 0; mi < MI; ++mi) fa[sl ^ 1][mi] = *(const bf16x8*)(Ab + mi * 32 * G_LDT + (ks + 1) * 32);
        }
#pragma unroll
        for (int mi = 0; mi < MI; ++mi) { acc[mi][0] = MFMA(fb[sl][0], fa[sl][mi], acc[mi][0]); acc[mi][1] = MFMA(fb[sl][1], fa[sl][mi], acc[mi][1]); }
      }
    }
    __syncthreads();
  }
  float* ssq_l = (float*)(lds + G_SSQ_OFF);
  if constexpr (AMODE == 2) {
#pragma unroll
    for (int i = 0; i < 4; ++i) { const float v = red8(ssq[i]); if ((tid & 7) == 0) ssq_l[srow + 64 * i] = v; }
    __syncthreads();
  }
#pragma unroll
  for (int mi = 0; mi < MI; ++mi) {
    const int lrow = wm * (32 * MI) + mi * 32 + r32;
    float aux = 0.f;
    if constexpr (AMODE == 2) aux = ssq_l[lrow];
    epi(lrow, wn * 64 + 4 * hi, acc[mi][0], acc[mi][1], aux);
  }
}

constexpr int G_EPI_SCR = (256 + 256) * G_LDT;
struct EpiBf16 {
  static constexpr bool PERM = true;
  __device__ __forceinline__ bool natural_group(int) const { return false; }
  bf16_t* dst; int ldd; int col0; int m0; int act; float invK; char* scr;
  __device__ __forceinline__ void operator()(int lrow, int nc, const f32x16& a0, const f32x16& a1, float aux) const {
    const int lane = threadIdx.x & 63, wid = threadIdx.x >> 6, r32 = lane & 31, hi = lane >> 5;
    float sc = 1.f;
    if (invK > 0.f) sc = rsqrtf(aux * invK + 1e-6f);
    char* sp = scr + wid * (32 * 144);
    char* wp = sp + r32 * 144 + 32 * hi;
    if (act) {
#define TANH_(x) (1.f - 2.f * __builtin_amdgcn_rcpf(__expf(2.f * (x) * sc) + 1.f))
      const u32x4 w0 = {cvtpk(TANH_(a0[0]), TANH_(a0[1])), cvtpk(TANH_(a0[2]), TANH_(a0[3])), cvtpk(TANH_(a0[4]), TANH_(a0[5])), cvtpk(TANH_(a0[6]), TANH_(a0[7]))};
      const u32x4 w1 = {cvtpk(TANH_(a0[8]), TANH_(a0[9])), cvtpk(TANH_(a0[10]), TANH_(a0[11])), cvtpk(TANH_(a0[12]), TANH_(a0[13])), cvtpk(TANH_(a0[14]), TANH_(a0[15]))};
      const u32x4 w2 = {cvtpk(TANH_(a1[0]), TANH_(a1[1])), cvtpk(TANH_(a1[2]), TANH_(a1[3])), cvtpk(TANH_(a1[4]), TANH_(a1[5])), cvtpk(TANH_(a1[6]), TANH_(a1[7]))};
      const u32x4 w3 = {cvtpk(TANH_(a1[8]), TANH_(a1[9])), cvtpk(TANH_(a1[10]), TANH_(a1[11])), cvtpk(TANH_(a1[12]), TANH_(a1[13])), cvtpk(TANH_(a1[14]), TANH_(a1[15]))};
#undef TANH_
      *(u32x4*)(wp) = w0; *(u32x4*)(wp + 16) = w1; *(u32x4*)(wp + 64) = w2; *(u32x4*)(wp + 80) = w3;
    } else {
      const u32x4 w0 = {cvtpk(a0[0] * sc, a0[1] * sc), cvtpk(a0[2] * sc, a0[3] * sc), cvtpk(a0[4] * sc, a0[5] * sc), cvtpk(a0[6] * sc, a0[7] * sc)};
      const u32x4 w1 = {cvtpk(a0[8] * sc, a0[9] * sc), cvtpk(a0[10] * sc, a0[11] * sc), cvtpk(a0[12] * sc, a0[13] * sc), cvtpk(a0[14] * sc, a0[15] * sc)};
      const u32x4 w2 = {cvtpk(a1[0] * sc, a1[1] * sc), cvtpk(a1[2] * sc, a1[3] * sc), cvtpk(a1[4] * sc, a1[5] * sc), cvtpk(a1[6] * sc, a1[7] * sc)};
      const u32x4 w3 = {cvtpk(a1[8] * sc, a1[9] * sc), cvtpk(a1[10] * sc, a1[11] * sc), cvtpk(a1[12] * sc, a1[13] * sc), cvtpk(a1[14] * sc, a1[15] * sc)};
      *(u32x4*)(wp) = w0; *(u32x4*)(wp + 16) = w1; *(u32x4*)(wp + 64) = w2; *(u32x4*)(wp + 80) = w3;
    }
    asm volatile("s_waitcnt lgkmcnt(0)" ::: "memory");
    bf16_t* gp = dst + (size_t)(m0 + lrow - r32) * ldd + col0 + (nc & ~7) + (lane & 7) * 8;
#pragma unroll
    for (int i = 0; i < 4; ++i) {
      const int row = (lane >> 3) + 8 * i;
      *(u32x4*)(gp + (size_t)row * ldd) = *(const u32x4*)(sp + row * 144 + (lane & 7) * 16);
    }
    asm volatile("s_waitcnt lgkmcnt(0)" ::: "memory");
  }
};
struct EpiResid {
  static constexpr bool PERM = false;
  __device__ __forceinline__ bool natural_group(int) const { return true; }
  const float* xin; float* xout; const float* gvec; int n0; char* scr;
  __device__ __forceinline__ void operator()(int lrow, int nc, const f32x16& a0, const f32x16& a1, float) const {
    const int lane = threadIdx.x & 63, wid = threadIdx.x >> 6, r32 = lane & 31, hi = lane >> 5;
    float* sp = (float*)(scr + wid * (32 * 272));
#pragma unroll
    for (int g = 0; g < 4; ++g) {
      const f32x4 v0 = {a0[4 * g], a0[4 * g + 1], a0[4 * g + 2], a0[4 * g + 3]}, v1 = {a1[4 * g], a1[4 * g + 1], a1[4 * g + 2], a1[4 * g + 3]};
      *(f32x4*)(sp + r32 * 68 + 4 * hi + 8 * g) = v0; *(f32x4*)(sp + r32 * 68 + 32 + 4 * hi + 8 * g) = v1;
    }
    asm volatile("s_waitcnt lgkmcnt(0)" ::: "memory");
    const int c4 = (lane & 15) * 4, colg = n0 + (nc & ~7) + c4;
    const size_t rbase = (size_t)(lrow - r32) * 1024 + colg;
    const f32x4 gv = *(const f32x4*)(gvec + colg);
    f32x4 xv[8];
#pragma unroll
    for (int i = 0; i < 8; ++i) xv[i] = *(const f32x4*)(xin + rbase + (size_t)((lane >> 4) + 4 * i) * 1024);
    asm volatile("" ::: "memory");
#pragma unroll
    for (int i = 0; i < 8; ++i) {
      const int row = (lane >> 4) + 4 * i;
      const f32x4 av = *(const f32x4*)(sp + row * 68 + c4);
      f32x4 r; r[0] = xv[i][0] + gv[0] * av[0]; r[1] = xv[i][1] + gv[1] * av[1]; r[2] = xv[i][2] + gv[2] * av[2]; r[3] = xv[i][3] + gv[3] * av[3];
      *(f32x4*)(xout + rbase + (size_t)row * 1024) = r;
    }
    asm volatile("s_waitcnt lgkmcnt(0)" ::: "memory");
  }
};
struct EpiMlaIn {
  static constexpr bool PERM = true;
  bf16_t *QC, *KVC, *KPE, *G1; const float* rope; int n0; int m0; char* scr;
  __device__ __forceinline__ bool natural_group(int tile_row) const { return ((n0 + tile_row) >> 5) == 20; }
  __device__ __forceinline__ void operator()(int lrow, int nc, const f32x16& a0, const f32x16& a1, float) const {
    const int g64 = n0 + (nc & ~7);
    if (g64 == 640) { rope_one(lrow, nc, a0); return; }
    if (g64 == 704) return;
    bf16_t* base; int ld;
    if (g64 < 384) { base = QC + g64; ld = 384; } else if (g64 < 640) { base = KVC + (g64 - 384); ld = 256; } else { base = G1 + (g64 - 768); ld = 1024; }
    const int lane = threadIdx.x & 63, wid = threadIdx.x >> 6, r32 = lane & 31, hi = lane >> 5;
    char* sp = scr + wid * (32 * 144);
    char* wp = sp + r32 * 144 + 32 * hi;
    const u32x4 w0 = {cvtpk(a0[0], a0[1]), cvtpk(a0[2], a0[3]), cvtpk(a0[4], a0[5]), cvtpk(a0[6], a0[7])};
    const u32x4 w1 = {cvtpk(a0[8], a0[9]), cvtpk(a0[10], a0[11]), cvtpk(a0[12], a0[13]), cvtpk(a0[14], a0[15])};
    const u32x4 w2 = {cvtpk(a1[0], a1[1]), cvtpk(a1[2], a1[3]), cvtpk(a1[4], a1[5]), cvtpk(a1[6], a1[7])};
    const u32x4 w3 = {cvtpk(a1[8], a1[9]), cvtpk(a1[10], a1[11]), cvtpk(a1[12], a1[13]), cvtpk(a1[14], a1[15])};
    *(u32x4*)(wp) = w0; *(u32x4*)(wp + 16) = w1; *(u32x4*)(wp + 64) = w2; *(u32x4*)(wp + 80) = w3;
    asm volatile("s_waitcnt lgkmcnt(0)" ::: "memory");
    bf16_t* gp = base + (size_t)(m0 + lrow - r32) * ld + (lane & 7) * 8;
#pragma unroll
    for (int i = 0; i < 4; ++i) {
      const int row = (lane >> 3) + 8 * i;
      *(u32x4*)(gp + (size_t)row * ld) = *(const u32x4*)(sp + row * 144 + (lane & 7) * 16);
    }
    asm volatile("s_waitcnt lgkmcnt(0)" ::: "memory");
  }
  __device__ __forceinline__ void rope_one(int lrow, int nc, const f32x16& a) const {
    const int row = m0 + lrow, t = (m0 % TL) + lrow, hi4 = nc & 4;
    bf16_t* p = KPE + (size_t)row * 32;
    if (t < T) {
      const f32x2* tr = (const f32x2*)rope + (t >> 6) * 8 + hi4;
      const f32x2* tc = (const f32x2*)rope + (t & 63) * 8 + hi4;
      float o1[8], o2[8];
#pragma unroll
      for (int e = 0; e < 4; ++e) {
        const f32x2 cs0 = tr[e], cs1 = tc[e];
        const float x1a = a[e], x2a = a[8 + e];
        const float x1b = a[4 + e], x2b = a[12 + e];
        o1[e] = x1a * cs0[0] - x2a * cs0[1]; o2[e] = x1a * cs0[1] + x2a * cs0[0];
        o1[4 + e] = x1b * cs1[0] - x2b * cs1[1]; o2[4 + e] = x1b * cs1[1] + x2b * cs1[0];
      }
      st_bf16x4(p + hi4, o1[0], o1[1], o1[2], o1[3]);
      st_bf16x4(p + 8 + hi4, o1[4], o1[5], o1[6], o1[7]);
      st_bf16x4(p + 16 + hi4, o2[0], o2[1], o2[2], o2[3]);
      st_bf16x4(p + 24 + hi4, o2[4], o2[5], o2[6], o2[7]);
    } else {
#pragma unroll
      for (int g = 0; g < 4; ++g) st_bf16x4(p + 8 * g + hi4, a[4 * g], a[4 * g + 1], a[4 * g + 2], a[4 * g + 3]);
    }
  }
};

constexpr float AT_SCALE = 0.10206207261596575f;
constexpr float AT_THR = 8.f;
__device__ void tr_job(const float* src, int ld, int K, int N, bf16_t* dst, const float* kscale, char* lds, float gscale = 1.f) {
  float* tile = (float*)lds;
  const int tid = threadIdx.x, nK = K >> 6, nN = (N + 63) >> 6;
  for (int tIdx = blockIdx.x; tIdx < nK * nN; tIdx += gridDim.x) {
    const int k0 = (tIdx % nK) * 64, n0 = (tIdx / nK) * 64;
#pragma unroll
    for (int i = 0; i < 8; ++i) {
      const int kk = (tid >> 6) + 8 * i, nn = tid & 63;
      float v = 0.f;
      if (n0 + nn < N) { v = src[(size_t)(k0 + kk) * ld + n0 + nn] * gscale; if (kscale) v *= kscale[k0 + kk]; }
      tile[kk * 65 + nn] = v;
    }
    __syncthreads();
#pragma unroll
    for (int i = 0; i < 8; ++i) {
      const int nn = (tid >> 6) + 8 * i, kk = tid & 63;
      if (n0 + nn < N) dst[(size_t)(n0 + nn) * K + k0 + kk] = f2bf(tile[kk * 65 + nn]);
    }
    __syncthreads();
  }
}

__device__ void phase_weights(const Params& p, char* lds) {
  unsigned char* ws = p.ws;
  bf16_t* WIN0 = (bf16_t*)(ws + OFF_WIN0);
  for (int j = 0; j < 4; ++j) tr_job(p.in[8] + (size_t)j * 1024 * 1024, 1024, 1024, 1024, WIN0 + (size_t)j * 1024 * 1024, nullptr, lds);
  for (int d = 0; d < 2; ++d) {
    tr_job(p.in[10] + (size_t)d * 1024 * 64, 64, 1024, 64, WIN0 + (size_t)(4096 + d * 64) * 1024, nullptr, lds);
    tr_job(p.in[13] + (size_t)d * 1024 * 64, 64, 1024, 64, WIN0 + (size_t)(4224 + d * 64) * 1024, nullptr, lds);
  }
  tr_job(p.in[20], 1024, 1024, 1024, (bf16_t*)(ws + OFF_WOUT0), nullptr, lds);
  bf16_t* WIN1 = (bf16_t*)(ws + OFF_WIN1);
  tr_job(p.in[21], 1696, 1024, 640, WIN1, nullptr, lds);
  tr_job(p.in[21] + 640, 1696, 1024, 32, WIN1 + (size_t)640 * 1024, nullptr, lds);
  tr_job(p.in[21] + 672, 1696, 1024, 1024, WIN1 + (size_t)768 * 1024, nullptr, lds);
  for (int i = blockIdx.x * NTHR + threadIdx.x; i < 96 * 1024; i += gridDim.x * NTHR) WIN1[(size_t)672 * 1024 + i] = 0;
  tr_job(p.in[23], 1536, 384, 1536, (bf16_t*)(ws + OFF_WQB), p.in[22], lds, AT_SCALE * 1.4426950408889634f);
  tr_job(p.in[25], 2048, 256, 2048, (bf16_t*)(ws + OFF_WKVB), p.in[24], lds);
  tr_job(p.in[26], 1024, 1024, 1024, (bf16_t*)(ws + OFF_WOUT1), nullptr, lds);
}
__device__ void phase_prologue(const Params& p, char* lds) {
  unsigned char* ws = p.ws;
  {
    const int i = blockIdx.x * NTHR + threadIdx.x;
    if (i < 1024) {
      const float invf[8] = {1.f, 0.316227766016838f, 0.1f, 0.0316227766016838f, 0.01f, 0.00316227766016838f, 0.001f, 0.000316227766016838f};
      const int pos = i >> 3, m = i & 7;
      float inv = invf[0];
#pragma unroll
      for (int q = 1; q < 8; ++q) inv = (m == q) ? invf[q] : inv;
      const float ang = (float)pos * inv;
      const float kf = rintf(ang * 0.15915494309189535f);
      float r = fmaf(-kf, 6.28125f, ang);
      r = fmaf(-kf, 1.9353071795864769e-3f, r);
      float* rt = (float*)(ws + OFF_ROPE);
      rt[2 * i] = cosf(r); rt[2 * i + 1] = sinf(r);
    }
  }
  {
    float* sil = (float*)lds;
    float* red = sil + 9 * 1024;
    const int tid = threadIdx.x;
    for (int i = tid; i < 9 * 1024; i += NTHR) {
      const int bi = i >> 10, k = i & 1023;
      const float cv = bi < 8 ? p.in[1][bi * 1024 + k] : p.in[3][k];
      sil[i] = cv / (1.f + __expf(-cv));
    }
    __syncthreads();
    float* mod = (float*)(ws + OFF_MOD);
    for (int item = blockIdx.x; item < 192; item += gridDim.x) {
      const int l = item / 96, n0 = (item % 96) * 32, col = tid & 31, kg = tid >> 5;
      float acc[9];
#pragma unroll
      for (int bi = 0; bi < 9; ++bi) acc[bi] = 0.f;
      const float* wp = p.in[5] + ((size_t)l * 1024 + kg * 64) * 3072 + n0 + col;
      for (int kk = 0; kk < 64; ++kk) {
        const float w = wp[(size_t)kk * 3072];
#pragma unroll
        for (int bi = 0; bi < 9; ++bi) acc[bi] += sil[bi * 1024 + kg * 64 + kk] * w;
      }
#pragma unroll
      for (int bi = 0; bi < 9; ++bi) red[(kg * 9 + bi) * 32 + col] = acc[bi];
      __syncthreads();
      if (tid < 288) {
        const int bi = tid >> 5;
        float s = 0.f;
#pragma unroll
        for (int g = 0; g < 16; ++g) s += red[(g * 9 + bi) * 32 + col];
        mod[((size_t)l * 9 + bi) * 3072 + n0 + col] = s + p.in[6][l * 3072 + n0 + col];
      }
      __syncthreads();
    }
  }
}

__device__ __forceinline__ const float* row_src(const float* xsrc, const float* csrc, int n, int& bi) {
  const int b = n / TL, t = n - b * TL;
  if (t < T) { bi = b; return xsrc + ((size_t)b * T + t) * D; }
  bi = 8; return csrc + ((size_t)b * L + (t - T)) * D;
}
__device__ void phase_norm(const float* xsrc, const float* csrc, const float* ng, const float* mod, bf16_t* H) {
  const int lane = threadIdx.x & 63, gw = blockIdx.x * 8 + (threadIdx.x >> 6), nw = gridDim.x * 8;
  f32x4 g4[4];
#pragma unroll
  for (int i = 0; i < 4; ++i) g4[i] = *(const f32x4*)(ng + i * 256 + lane * 4);
  f32x4 va[4], vb[4]; int bia = 0, bib = 0;
  if (gw < NTOK) { const float* src = row_src(xsrc, csrc, gw, bia);
#pragma unroll
    for (int i = 0; i < 4; ++i) va[i] = *(const f32x4*)(src + i * 256 + lane * 4); }
  for (int n = gw; n < NTOK; n += nw) {
    if (n + nw < NTOK) { const float* src = row_src(xsrc, csrc, n + nw, bib);
#pragma unroll
      for (int i = 0; i < 4; ++i) vb[i] = *(const f32x4*)(src + i * 256 + lane * 4); }
    float ss = 0.f;
#pragma unroll
    for (int i = 0; i < 4; ++i) ss += va[i][0] * va[i][0] + va[i][1] * va[i][1] + va[i][2] * va[i][2] + va[i][3] * va[i][3];
    ss = wave_sum(ss);
    const float rstd = rsqrtf(ss * (1.f / 1024.f) + 1e-6f);
    const float* m = mod + bia * 3072;
#pragma unroll
    for (int i = 0; i < 4; ++i) {
      const int c = i * 256 + lane * 4;
      const f32x4 sh = *(const f32x4*)(m + c), sc = *(const f32x4*)(m + 1024 + c);
      float o[4];
#pragma unroll
      for (int e = 0; e < 4; ++e) o[e] = va[i][e] * rstd * g4[i][e] * (1.f + sc[e]) + sh[e];
      st_bf16x4(H + (size_t)n * 1024 + c, o[0], o[1], o[2], o[3]);
    }
#pragma unroll
    for (int i = 0; i < 4; ++i) va[i] = vb[i];
    bia = bib;
  }
}

constexpr int LERP3_SPLIT = 63488;
__device__ __forceinline__ bf16_t* lerp_base(const Params& p, int j, int row) {
  if (j == 0) return (bf16_t*)(p.ws + OFF_Y0);
  if (j == 1) return (bf16_t*)(p.ws + OFF_Y1);
  if (j == 2) return (bf16_t*)p.out;
  if (row < LERP3_SPLIT) return (bf16_t*)p.out + (size_t)NTOK * 1024;
  return (bf16_t*)(p.ws + WS_END) - (size_t)LERP3_SPLIT * 1024;
}
struct RowX { f32x4 v[4]; int bi; };
__device__ __forceinline__ void ld_row(const Params& p, int n, int lane, RowX& r) {
  const float* src = row_src(p.in[0], p.in[2], n, r.bi);
#pragma unroll
  for (int i = 0; i < 4; ++i) r.v[i] = *(const f32x4*)(src + i * 256 + lane * 4);
}
__device__ __forceinline__ void fin_row(const float* mod, const f32x4 (&g4)[4], int lane, const RowX& r, float (&h)[16]) {
  float ss = 0.f;
#pragma unroll
  for (int i = 0; i < 4; ++i) ss += r.v[i][0] * r.v[i][0] + r.v[i][1] * r.v[i][1] + r.v[i][2] * r.v[i][2] + r.v[i][3] * r.v[i][3];
  ss = wave_sum(ss);
  const float rstd = rsqrtf(ss * (1.f / 1024.f) + 1e-6f);
  const float* m = mod + r.bi * 3072;
#pragma unroll
  for (int i = 0; i < 4; ++i) {
    const int c = i * 256 + lane * 4;
    const f32x4 sh = *(const f32x4*)(m + c), sc = *(const f32x4*)(m + 1024 + c);
#pragma unroll
    for (int e = 0; e < 4; ++e) {
      const float hv = r.v[i][e] * rstd * g4[i][e] * (1.f + sc[e]) + sh[e];
      h[4 * i + e] = __uint_as_float(cvtpk(hv, 0.f) << 16);
    }
  }
}
__device__ void phase_norm_lerp(const Params& p, const float* mod) {
  const int lane = threadIdx.x & 63, gw = blockIdx.x * 8 + (threadIdx.x >> 6), nw = gridDim.x * 8;
  const int per = (NTOK + nw - 1) / nw;
  const int r0 = gw * per, r1 = (r0 + per < NTOK) ? r0 + per : NTOK;
  if (r0 >= r1) return;
  bf16_t* H = (bf16_t*)(p.ws + OFF_H);
  f32x4 g4[4];
#pragma unroll
  for (int i = 0; i < 4; ++i) g4[i] = *(const f32x4*)(p.in[4] + i * 256 + lane * 4);
  float mu[4][16];
#pragma unroll
  for (int j = 0; j < 4; ++j)
#pragma unroll
    for (int i = 0; i < 4; ++i) {
      const f32x4 m4 = *(const f32x4*)(p.in[7] + j * 1024 + i * 256 + lane * 4);
      mu[j][4 * i] = m4[0]; mu[j][4 * i + 1] = m4[1]; mu[j][4 * i + 2] = m4[2]; mu[j][4 * i + 3] = m4[3];
    }
  float hp[16], hc[16], hn[16];
  RowX xa, xb, xc;
  if (r0 > 0) { ld_row(p, r0 - 1, lane, xc); }
  ld_row(p, r0, lane, xa);
  if (r0 + 1 < NTOK) ld_row(p, r0 + 1, lane, xb);
  if (r0 > 0) fin_row(mod, g4, lane, xc, hp);
  else {
#pragma unroll
    for (int e = 0; e < 16; ++e) hp[e] = 0.f;
  }
  fin_row(mod, g4, lane, xa, hc);
  xa = xb;
  if (r0 + 2 < NTOK) ld_row(p, r0 + 2, lane, xb);
  for (int n = r0; n < r1; ++n) {
    const int t = n % TL;
    if (n + 3 < NTOK) ld_row(p, n + 3, lane, xc);
    if (n + 1 < NTOK) fin_row(mod, g4, lane, xa, hn);
    else {
#pragma unroll
      for (int e = 0; e < 16; ++e) hn[e] = 0.f;
    }
    const float fp = (t != 0 && t != T) ? 0.5f : 0.f, fn = (t != T - 1 && t != TL - 1) ? 0.5f : 0.f;
#pragma unroll
    for (int i = 0; i < 4; ++i) st_bf16x4_nt(H + (size_t)n * 1024 + i * 256 + lane * 4, hc[4 * i], hc[4 * i + 1], hc[4 * i + 2], hc[4 * i + 3]);
#pragma unroll
    for (int j = 0; j < 4; ++j) {
      bf16_t* dst = lerp_base(p, j, n) + (size_t)n * 1024 + lane * 4;
#pragma unroll
      for (int i = 0; i < 4; ++i) {
        float o[4];
#pragma unroll
        for (int e = 0; e < 4; ++e) { const float c = hc[4 * i + e]; o[e] = c + (fp * hp[4 * i + e] + fn * hn[4 * i + e] - c) * mu[j][4 * i + e]; }
        st_bf16x4_nt(dst + i * 256, o[0], o[1], o[2], o[3]);
      }
    }
#pragma unroll
    for (int e = 0; e < 16; ++e) { hp[e] = hc[e]; hc[e] = hn[e]; }
    xa = xb; xb = xc;
  }
}

__device__ void phase_final(float* out, const float* fg) {
  const int lane = threadIdx.x & 63, gw = blockIdx.x * 8 + (threadIdx.x >> 6), nw = gridDim.x * 8;
  f32x4 g4[4];
#pragma unroll
  for (int i = 0; i < 4; ++i) g4[i] = *(const f32x4*)(fg + i * 256 + lane * 4);
  f32x4 va[4], vb[4];
  if (gw < NB * T) {
#pragma unroll
    for (int i = 0; i < 4; ++i) va[i] = *(const f32x4*)(out + (size_t)gw * D + i * 256 + lane * 4); }
  for (int n = gw; n < NB * T; n += nw) {
    if (n + nw < NB * T) {
#pragma unroll
      for (int i = 0; i < 4; ++i) vb[i] = *(const f32x4*)(out + (size_t)(n + nw) * D + i * 256 + lane * 4); }
    float ss = 0.f;
#pragma unroll
    for (int i = 0; i < 4; ++i) ss += va[i][0] * va[i][0] + va[i][1] * va[i][1] + va[i][2] * va[i][2] + va[i][3] * va[i][3];
    ss = wave_sum(ss);
    const float rstd = rsqrtf(ss * (1.f / 1024.f) + 1e-6f);
#pragma unroll
    for (int i = 0; i < 4; ++i) {
      f32x4 o;
#pragma unroll
      for (int e = 0; e < 4; ++e) o[e] = va[i][e] * rstd * g4[i][e];
      *(f32x4*)(out + (size_t)n * D + i * 256 + lane * 4) = o;
    }
#pragma unroll
    for (int i = 0; i < 4; ++i) va[i] = vb[i];
  }
}

__device__ __forceinline__ int scan_row(int g, int d, int b) {
  if (g < L) { const int tt = d ? (L - 1 - g) : g; return b * TL + T + tt; }
  g -= L; const int tt = d ? (T - 1 - g) : g; return b * TL + tt;
}
constexpr int SC_P = 0, SC_ARA = 8192, SC_ARR = SC_ARA + 4096, SC_BK = SC_ARR + 4096, SC_SCAL = SC_BK + 8192, SC_VV = SC_SCAL + 1024, SC_BUF = SC_VV + 8192;
constexpr int SC_IC = 2 * SC_BUF, SC_SCR = SC_IC + 8192, SC_YB = SC_SCR + 16384, SC_END = SC_YB + 2 * 8192;
#define MFMA16(a, b, c) __builtin_amdgcn_mfma_f32_16x16x32_bf16((a), (b), (c), 0, 0, 0)
struct ScBlk { u32x4 aa0, aa1, ar0, ar1, k0, k1, k2, k3; f32x4 v; f32x4 s[8]; };
__device__ __forceinline__ void sc_ldb(ScBlk& c, const char* buf, int blk, int arOff, int bkOff, int vOff) {
  const char* pa = buf + SC_ARA + blk * 512 + arOff; const char* pr = buf + SC_ARR + blk * 512 + arOff;
  c.aa0 = *(const u32x4*)(pa); c.aa1 = *(const u32x4*)(pa + 64); c.ar0 = *(const u32x4*)(pr); c.ar1 = *(const u32x4*)(pr + 64);
  const char* bk = buf + SC_BK + blk * 1024 + bkOff;
  c.k0 = *(const u32x4*)(bk); c.k1 = *(const u32x4*)(bk + 256); c.k2 = *(const u32x4*)(bk + 512); c.k3 = *(const u32x4*)(bk + 768);
  c.v = *(const f32x4*)(buf + SC_VV + blk * 1024 + vOff);
  const char* sp = buf + SC_SCAL + blk * 128;
#pragma unroll
  for (int i = 0; i < 8; ++i) c.s[i] = *(const f32x4*)(sp + i * 16);
}
__device__ void phase_scan(const Params& p, char* lds) {
  unsigned char* ws = p.ws;
  const int tid = threadIdx.x, lane = tid & 63, wid = __builtin_amdgcn_readfirstlane(tid >> 6), r32 = lane & 31, hi = lane >> 5;
  const bf16_t* Rg = (const bf16_t*)(ws + OFF_R); const bf16_t* Kg = (const bf16_t*)(ws + OFF_K); const bf16_t* Vg = (const bf16_t*)(ws + OFF_V);
  const bf16_t* Lg = (const bf16_t*)(ws + OFF_LORA);
  constexpr int NCH = TL / 32;
  for (int sidx = blockIdx.x; sidx < 256; sidx += gridDim.x) {
    const int d = sidx >> 7, b = (sidx >> 4) & 7, h = sidx & 15;
    bf16_t* Yg = (bf16_t*)(ws + (d ? OFF_Y1 : OFF_Y0));
    if (wid < 4) {
      const int cw = wid, c16 = lane & 15, q = lane >> 4;
      const int arOff = (c16 & 3) * 128 + q * 16, wOff = q * 16, bkOff = c16 * 16, vOff = (cw * 16 + c16) * 16;
      f32x4 St0 = {0.f, 0.f, 0.f, 0.f}, St1 = St0, St2 = St0, St3 = St0;
      __syncthreads(); __syncthreads();
      for (int c = 0; c < NCH; ++c) {
        const char* buf = lds + (c & 1) * SC_BUF;
        char* yb = lds + SC_YB + (c & 1) * 8192 + (cw * 16 + c16) * 16;
        ScBlk cur; sc_ldb(cur, buf, 0, arOff, bkOff, vOff);
#pragma unroll 1
        for (int blk = 0; blk < 8; ++blk) {
          ScBlk nxt; sc_ldb(nxt, buf, (blk + 1) & 7, arOff, bkOff, vOff);
          u32x4 b1 = {cvtpk(St0[0], St0[1]), cvtpk(St0[2], St0[3]), cvtpk(St1[0], St1[1]), cvtpk(St1[2], St1[3])};
          u32x4 b2 = {cvtpk(St2[0], St2[1]), cvtpk(St2[2], St2[3]), cvtpk(St3[0], St3[1]), cvtpk(St3[2], St3[3])};
          f32x4 sr = {0.f, 0.f, 0.f, 0.f}, yr = sr;
          sr = MFMA16(*(bf16x8*)&cur.aa0, *(bf16x8*)&b1, sr); yr = MFMA16(*(bf16x8*)&cur.ar0, *(bf16x8*)&b1, yr);
          sr = MFMA16(*(bf16x8*)&cur.aa1, *(bf16x8*)&b2, sr); yr = MFMA16(*(bf16x8*)&cur.ar1, *(bf16x8*)&b2, yr);
          const float v1 = cur.v[0], v2 = cur.v[1], v3 = cur.v[2], v4 = cur.v[3];
          const f32x4 s0 = cur.s[0], s1 = cur.s[1], s2 = cur.s[2], s3 = cur.s[3], s4 = cur.s[4], s5 = cur.s[5], s6 = cur.s[6], s7 = cur.s[7];
          const float sa1 = sr[0];
          const float sa2 = sr[1] + s0[0] * sa1 + s1[2] * v1;
          const float sa3 = sr[2] + s0[1] * sa1 + s1[3] * v1 + s0[2] * sa2 + s2[0] * v2;
          const float sa4 = sr[3] + s0[3] * sa1 + s2[1] * v1 + s1[0] * sa2 + s2[2] * v2 + s1[1] * sa3 + s2[3] * v3;
          f32x4 y;
          y[0] = yr[0] + s3[0] * sa1 + s5[2] * v1;
          y[1] = yr[1] + s3[1] * sa1 + s5[3] * v1 + s3[2] * sa2 + s6[0] * v2;
          y[2] = yr[2] + s3[3] * sa1 + s6[1] * v1 + s4[0] * sa2 + s6[2] * v2 + s4[1] * sa3 + s6[3] * v3;
          y[3] = yr[3] + s4[2] * sa1 + s7[0] * v1 + s4[3] * sa2 + s7[1] * v2 + s5[0] * sa3 + s7[2] * v3 + s5[1] * sa4 + s7[3] * v4;
          u32x4 bu = {cvtpk(sa1, v1), cvtpk(sa2, v2), cvtpk(sa3, v3), cvtpk(sa4, v4)};
          if (q != 0) { bu[0] = 0u; bu[1] = 0u; bu[2] = 0u; bu[3] = 0u; }
          St0 = MFMA16(*(bf16x8*)&cur.k0, *(bf16x8*)&bu, St0);
          St1 = MFMA16(*(bf16x8*)&cur.k1, *(bf16x8*)&bu, St1);
          St2 = MFMA16(*(bf16x8*)&cur.k2, *(bf16x8*)&bu, St2);
          St3 = MFMA16(*(bf16x8*)&cur.k3, *(bf16x8*)&bu, St3);
          *(f32x4*)(yb + blk * 1024) = y;
          cur = nxt;
          if (blk == 7) {
            const char* pw = buf + SC_P + 31 * 256 + wOff;
            St0 *= *(const f32x4*)(pw); St1 *= *(const f32x4*)(pw + 64); St2 *= *(const f32x4*)(pw + 128); St3 *= *(const f32x4*)(pw + 192);
          }
          if (blk == 3 || blk == 7) __syncthreads();
        }
      }
    } else {
      const int pw = wid - 4, ptid = tid - 256;
      const int pstep = ptid >> 3, j0 = (ptid & 7) * 8, pblk = pstep >> 2, psb = pstep & 3;
      const int apos0 = (j0 >> 5) * 32 + (((j0 & 31) & 15) >> 2) * 8 + 4 * ((j0 & 31) >> 4), apos1 = apos0 + 8;
      float* Bg = (float*)(ws + OFF_BONUS) + (size_t)d * NTOK * 16;
      float kkc[8], kac[8], rkc[8];
#pragma unroll
      for (int e = 0; e < 8; ++e) { kkc[e] = p.in[15][h * 64 + j0 + e]; kac[e] = p.in[16][h * 64 + j0 + e]; rkc[e] = p.in[17][h * 64 + j0 + e]; }
      const int mat = pw >> 1, jh = pw & 1;
      bf16x8 w2f[4]; float bias;
      {
        const float* W2 = (mat ? p.in[14] : p.in[11]) + (size_t)d * 64 * 1024;
#pragma unroll
        for (int ks = 0; ks < 4; ++ks) {
          u32x4 w;
#pragma unroll
          for (int qq = 0; qq < 4; ++qq) {
            const int r0 = ks * 16 + 8 * hi + 2 * qq;
            w[qq] = cvtpk(W2[(size_t)r0 * 1024 + h * 64 + jh * 32 + r32], W2[(size_t)(r0 + 1) * 1024 + h * 64 + jh * 32 + r32]);
          }
          w2f[ks] = *(bf16x8*)&w;
        }
        bias = (mat ? p.in[12] : p.in[9])[d * 1024 + h * 64 + jh * 32 + r32];
      }
      u32x4 pR, pK, pV; bf16x8 pl[4];
      float kk[8], kr[8], rr[8];
      float* IC = (float*)(lds + SC_IC);
      bf16_t* SCR = (bf16_t*)(lds + SC_SCR);
      auto prefetch = [&](int c) {
        const size_t row = (size_t)scan_row(c * 32 + pstep, d, b) * 1024 + h * 64 + j0;
        pR = *(const u32x4*)(Rg + row); pK = *(const u32x4*)(Kg + row); pV = *(const u32x4*)(Vg + row);
        const size_t lrow = (size_t)scan_row(c * 32 + r32, d, b);
#pragma unroll
        for (int ks = 0; ks < 4; ++ks) pl[ks] = *(const bf16x8*)(Lg + lrow * 256 + mat * 128 + d * 64 + ks * 16 + hi * 8);
      };
      auto stageA = [&](int c) {
        char* buf = lds + (c & 1) * SC_BUF;
        float* Pd = (float*)(buf + SC_P); float* VV = (float*)(buf + SC_VV);
        f32x16 acc;
#pragma unroll
        for (int r = 0; r < 16; ++r) acc[r] = 0.f;
#pragma unroll
        for (int ks = 0; ks < 4; ++ks) acc = MFMA(pl[ks], w2f[ks], acc);
        if (mat == 0) {
          float cc[16];
#pragma unroll
          for (int r = 0; r < 16; ++r) cc[r] = -0.6065306597126334f * __builtin_amdgcn_rcpf(1.f + __expf(-(acc[r] + bias)));
#pragma unroll
          for (int g = 0; g < 4; ++g) { cc[4 * g + 1] += cc[4 * g]; cc[4 * g + 2] += cc[4 * g + 1]; cc[4 * g + 3] += cc[4 * g + 2]; }
          float run = 0.f;
#pragma unroll
          for (int g = 0; g < 4; ++g) {
            const float own = cc[4 * g + 3];
            auto rr2 = __builtin_amdgcn_permlane32_swap(__float_as_uint(own), __float_as_uint(own), false, false);
            const float both = __uint_as_float(rr2[0]) + __uint_as_float(rr2[1]), partner = both - own;
            const float off = hi ? run + partner : run;
#pragma unroll
            for (int e = 0; e < 4; ++e) Pd[crow(4 * g + e, hi) * 64 + jh * 32 + r32] = __expf(off + cc[4 * g + e]);
            run += both;
          }
        } else {
#pragma unroll
          for (int r = 0; r < 16; ++r) IC[crow(r, hi) * 64 + jh * 32 + r32] = __builtin_amdgcn_rcpf(1.f + __expf(-(acc[r] + bias)));
        }
        float ss = 0.f;
#pragma unroll
        for (int w = 0; w < 4; ++w) {
          rr[2 * w] = lo16(pR[w]); rr[2 * w + 1] = hi16(pR[w]);
          kr[2 * w] = lo16(pK[w]); kr[2 * w + 1] = hi16(pK[w]);
        }
        const float vv[8] = {lo16(pV[0]), hi16(pV[0]), lo16(pV[1]), hi16(pV[1]), lo16(pV[2]), hi16(pV[2]), lo16(pV[3]), hi16(pV[3])};
        if (c + 1 < NCH) prefetch(c + 1);
#pragma unroll
        for (int e = 0; e < 8; ++e) VV[(pblk * 64 + j0 + e) * 4 + psb] = vv[e];
#pragma unroll
        for (int e = 0; e < 8; ++e) { kk[e] = kr[e] * kkc[e]; ss += kk[e] * kk[e]; }
        ss = red8(ss);
        const float inv = rsqrtf(fmaxf(ss, 1e-24f));
#pragma unroll
        for (int e = 0; e < 8; ++e) kk[e] *= inv;
      };
      auto stageB = [&](int c) {
        char* buf = lds + (c & 1) * SC_BUF;
        const f32x4 i0 = *(const f32x4*)(IC + pstep * 64 + j0), i1 = *(const f32x4*)(IC + pstep * 64 + j0 + 4);
        const float ic[8] = {i0[0], i0[1], i0[2], i0[3], i1[0], i1[1], i1[2], i1[3]};
        const float* Pt = (const float*)(buf + SC_P) + pstep * 64 + j0;
        const f32x4 pt0 = *(const f32x4*)(Pt), pt1 = *(const f32x4*)(Pt + 4);
        f32x4 pm0 = {1.f, 1.f, 1.f, 1.f}, pm1 = pm0;
        if (pstep > 0) { pm0 = *(const f32x4*)(Pt - 64); pm1 = *(const f32x4*)(Pt - 60); }
        const float pt[8] = {pt0[0], pt0[1], pt0[2], pt0[3], pt1[0], pt1[1], pt1[2], pt1[3]};
        const float pm[8] = {pm0[0], pm0[1], pm0[2], pm0[3], pm1[0], pm1[1], pm1[2], pm1[3]};
        const u32x4 an = {cvtpk(-kk[0] * pm[0], -kk[1] * pm[1]), cvtpk(-kk[2] * pm[2], -kk[3] * pm[3]), cvtpk(-kk[4] * pm[4], -kk[5] * pm[5]), cvtpk(-kk[6] * pm[6], -kk[7] * pm[7])};
        const u32x4 rn = {cvtpk(rr[0] * pt[0], rr[1] * pt[1]), cvtpk(rr[2] * pt[2], rr[3] * pt[3]), cvtpk(rr[4] * pt[4], rr[5] * pt[5]), cvtpk(rr[6] * pt[6], rr[7] * pt[7])};
        bf16_t* ARa = (bf16_t*)(buf + SC_ARA) + (pblk * 4 + psb) * 64; bf16_t* ARr = (bf16_t*)(buf + SC_ARR) + (pblk * 4 + psb) * 64;
        { u32x2 lo = {an[0], an[1]}, hi2 = {an[2], an[3]}; *(u32x2*)(ARa + apos0) = lo; *(u32x2*)(ARa + apos1) = hi2; }
        { u32x2 lo = {rn[0], rn[1]}, hi2 = {rn[2], rn[3]}; *(u32x2*)(ARr + apos0) = lo; *(u32x2*)(ARr + apos1) = hi2; }
        *(u32x4*)(SCR + (pstep * 4 + 0) * 64 + j0) = an; *(u32x4*)(SCR + (pstep * 4 + 1) * 64 + j0) = rn;
        float bs = 0.f;
        unsigned bq[8], kq[8];
        unsigned* BK = (unsigned*)(buf + SC_BK) + (pblk * 64 + j0) * 4 + psb;
#pragma unroll
        for (int e = 0; e < 8; ++e) {
          const float kd = kr[e] * (1.f + (ic[e] - 1.f) * kac[e]);
          const float ip = __builtin_amdgcn_rcpf(pt[e]);
          const unsigned pr2 = cvtpk(kk[e] * ic[e] * ip, kd * ip);
          BK[e * 4] = pr2;
          bq[e] = pr2 & 0xffffu; kq[e] = pr2 >> 16;
          bs += rr[e] * kd * rkc[e];
        }
        const u32x4 bn = {bq[0] | (bq[1] << 16), bq[2] | (bq[3] << 16), bq[4] | (bq[5] << 16), bq[6] | (bq[7] << 16)};
        const u32x4 kn = {kq[0] | (kq[1] << 16), kq[2] | (kq[3] << 16), kq[4] | (kq[5] << 16), kq[6] | (kq[7] << 16)};
        *(u32x4*)(SCR + (pstep * 4 + 2) * 64 + j0) = bn; *(u32x4*)(SCR + (pstep * 4 + 3) * 64 + j0) = kn;
        bs = red8(bs);
        if ((ptid & 7) == 0) Bg[(size_t)scan_row(c * 32 + pstep, d, b) * 16 + h] = bs;
      };
      auto stageC = [&](int c) {
        char* buf = lds + (c & 1) * SC_BUF;
        asm volatile("s_waitcnt lgkmcnt(0)" ::: "memory");
        const int n16 = lane & 15, q4 = lane >> 4;
        const int stepA = (2 * pw + (n16 >> 3)) * 4 + (n16 & 3);
        const bf16_t* Xr = SCR + (stepA * 4 + 2 + ((n16 >> 2) & 1)) * 64 + q4 * 8;
        const bf16_t* Yc = SCR + (stepA * 4 + ((n16 >> 2) & 1)) * 64 + q4 * 8;
        f32x4 g = {0.f, 0.f, 0.f, 0.f};
        g = MFMA16(*(const bf16x8*)(Xr), *(const bf16x8*)(Yc), g);
        g = MFMA16(*(const bf16x8*)(Xr + 32), *(const bf16x8*)(Yc + 32), g);
        const int ctype = (n16 >> 2) & 1, t0 = n16 & 3, rtype = q4 & 1;
        const int grp = ctype * 2 + rtype, base = grp == 0 ? 0 : (grp == 1 ? 6 : (grp == 2 ? 12 : 22));
        float* sc = (float*)(buf + SC_SCAL) + (2 * pw + (n16 >> 3)) * 32 + base + (ctype ? (t0 + 1) * t0 / 2 : t0 * (t0 - 1) / 2);
        if ((q4 >> 1) == (n16 >> 3)) {
#pragma unroll
          for (int e = 0; e < 4; ++e) if (ctype ? (e <= t0) : (e < t0)) sc[e] = g[e];
        }
      };
      auto writeout = [&](int c) {
        const float* Yb = (const float*)(lds + SC_YB + (c & 1) * 8192) + (pblk * 64 + j0) * 4 + psb;
        u32x4 w = {cvtpk(Yb[0], Yb[4]), cvtpk(Yb[8], Yb[12]), cvtpk(Yb[16], Yb[20]), cvtpk(Yb[24], Yb[28])};
        *(u32x4*)(Yg + (size_t)scan_row(c * 32 + pstep, d, b) * 1024 + h * 64 + j0) = w;
      };
      prefetch(0);
      stageA(0);
      __syncthreads();
      stageB(0); stageC(0);
      __syncthreads();
      for (int c = 0; c < NCH; ++c) {
        if (c >= 1) writeout(c - 1);
        if (c + 1 < NCH) stageA(c + 1);
        __syncthreads();
        if (c + 1 < NCH) { stageB(c + 1); stageC(c + 1); }
        __syncthreads();
      }
      writeout(NCH - 1);
    }
    __syncthreads();
  }
}

__device__ void phase_readout(const Params& p) {
  unsigned char* ws = p.ws;
  const bf16_t* Y0 = (const bf16_t*)(ws + OFF_Y0); const bf16_t* Y1 = (const bf16_t*)(ws + OFF_Y1); const bf16_t* Vg = (const bf16_t*)(ws + OFF_V);
  bf16_t* G = (bf16_t*)(ws + OFF_G);
  const float* B0 = (const float*)(ws + OFF_BONUS); const float* B1 = B0 + (size_t)NTOK * 16;
  const int lane = threadIdx.x & 63, gw = blockIdx.x * 8 + (threadIdx.x >> 6), nw = gridDim.x * 8;
  const int c0 = lane * 16, hd = lane >> 2;
  float lg[16], lb[16];
#pragma unroll
  for (int e = 0; e < 16; ++e) { lg[e] = p.in[18][c0 + e]; lb[e] = p.in[19][c0 + e]; }
  struct RowIn { u32x4 a[2], b[2], v[2], g[2]; float b0, b1; };
  auto ldr = [&](int n, RowIn& r) {
    const size_t o = (size_t)n * 1024 + c0;
#pragma unroll
    for (int q = 0; q < 2; ++q) { r.a[q] = *(const u32x4*)(Y0 + o + 8 * q); r.b[q] = *(const u32x4*)(Y1 + o + 8 * q); r.v[q] = *(const u32x4*)(Vg + o + 8 * q); r.g[q] = *(const u32x4*)(G + o + 8 * q); }
    r.b0 = B0[(size_t)n * 16 + hd]; r.b1 = B1[(size_t)n * 16 + hd];
  };
  RowIn cur, nxt;
  if (gw < NTOK) ldr(gw, cur);
  for (int n = gw; n < NTOK; n += nw) {
    if (n + nw < NTOK) ldr(n + nw, nxt);
    const size_t o = (size_t)n * 1024 + c0;
    float y[16], v[16], g[16];
#pragma unroll
    for (int q = 0; q < 2; ++q) {
#pragma unroll
      for (int w = 0; w < 4; ++w) {
        y[8 * q + 2 * w] = lo16(cur.a[q][w]) + lo16(cur.b[q][w]); y[8 * q + 2 * w + 1] = hi16(cur.a[q][w]) + hi16(cur.b[q][w]);
        v[8 * q + 2 * w] = lo16(cur.v[q][w]); v[8 * q + 2 * w + 1] = hi16(cur.v[q][w]);
        g[8 * q + 2 * w] = lo16(cur.g[q][w]); g[8 * q + 2 * w + 1] = hi16(cur.g[q][w]);
      }
    }
    float s = 0.f;
#pragma unroll
    for (int e = 0; e < 16; ++e) s += y[e];
    s += dpp_f(s, 0); s += dpp_f(s, 1);
    const float mean = s * (1.f / 64.f);
    float q2 = 0.f;
#pragma unroll
    for (int e = 0; e < 16; ++e) { const float dlt = y[e] - mean; q2 += dlt * dlt; }
    q2 += dpp_f(q2, 0); q2 += dpp_f(q2, 1);
    const float rs = rsqrtf(q2 * (1.f / 64.f) + 64e-5f);
    const float bonus = cur.b0 + cur.b1;
    float r[16];
#pragma unroll
    for (int e = 0; e < 16; ++e) {
      const float yn = (y[e] - mean) * rs * lg[e] + lb[e];
      r[e] = (yn + bonus * v[e]) * (g[e] * sigmoidf_(g[e]));
    }
    u32x4 w0 = {cvtpk(r[0], r[1]), cvtpk(r[2], r[3]), cvtpk(r[4], r[5]), cvtpk(r[6], r[7])};
    u32x4 w1 = {cvtpk(r[8], r[9]), cvtpk(r[10], r[11]), cvtpk(r[12], r[13]), cvtpk(r[14], r[15])};
    *(u32x4*)(G + o) = w0; *(u32x4*)(G + o + 8) = w1;
    cur = nxt;
  }
}

constexpr int AT_SHMV = 16384, AT_KROW = 208, AT_SHMK = 64 * AT_KROW;
constexpr int AT_KOFF = 2 * AT_SHMV, AT_WOFF = AT_KOFF + 2 * AT_SHMK;
#define SBAR() __builtin_amdgcn_sched_barrier(0)
__device__ __forceinline__ void at_partialSM(f32x16& p0, f32x16& p1, float& m_reg, float& alpha, bool force) {
  float pm = p0[0];
#pragma unroll
  for (int r = 1; r < 16; ++r) pm = fmaxf(pm, p0[r]);
#pragma unroll
  for (int r = 0; r < 16; ++r) pm = fmaxf(pm, p1[r]);
  { auto rr = __builtin_amdgcn_permlane32_swap(__float_as_uint(pm), __float_as_uint(pm), false, false);
    pm = fmaxf(__uint_as_float(rr[0]), __uint_as_float(rr[1])); }
  if (__builtin_expect(!force && __all(pm <= AT_THR * 1.4426950408889634f), 1)) { alpha = 1.f; }
  else {
    const float dlt = force ? pm : fmaxf(pm, 0.f);
    alpha = force ? 1.f : __builtin_amdgcn_exp2f(-dlt); m_reg += dlt;
#pragma unroll
    for (int r = 0; r < 16; ++r) { p0[r] -= dlt; p1[r] -= dlt; }
  }
#pragma unroll
  for (int r = 0; r < 16; ++r) p0[r] = __builtin_amdgcn_exp2f(p0[r]);
}
__device__ __forceinline__ void at_finishSM(f32x16& p0, f32x16& p1, float alpha, float& l_reg, bf16x8& pa0, bf16x8& pa1, bf16x8& pa2, bf16x8& pa3) {
#pragma unroll
  for (int r = 0; r < 16; ++r) p1[r] = __builtin_amdgcn_exp2f(p1[r]);
  float ps = 0;
#pragma unroll
  for (int r = 0; r < 16; ++r) ps += p0[r];
#pragma unroll
  for (int r = 0; r < 16; ++r) ps += p1[r];
  { auto rr = __builtin_amdgcn_permlane32_swap(__float_as_uint(ps), __float_as_uint(ps), false, false);
    ps = __uint_as_float(rr[0]) + __uint_as_float(rr[1]); }
  l_reg = l_reg * alpha + ps;
#define PK4(P, BASE, OUT) do { unsigned a0 = cvtpk(P[BASE + 0], P[BASE + 1]), a1 = cvtpk(P[BASE + 2], P[BASE + 3]);   \
    unsigned b0 = cvtpk(P[BASE + 4], P[BASE + 5]), b1 = cvtpk(P[BASE + 6], P[BASE + 7]);                              \
    auto r0 = __builtin_amdgcn_permlane32_swap(a0, b0, false, false); auto r1 = __builtin_amdgcn_permlane32_swap(a1, b1, false, false); \
    u32x4 w = {r0[0], r1[0], r0[1], r1[1]}; OUT = *reinterpret_cast<bf16x8*>(&w); } while (0)
  PK4(p0, 0, pa0); PK4(p0, 8, pa1); PK4(p1, 0, pa2); PK4(p1, 8, pa3);
#undef PK4
}
__device__ __forceinline__ void at_qkt(f32x16& p0, f32x16& p1, const char* Ks, const bf16x8* qr, int r32, int hi, float negm) {
#pragma unroll
  for (int r = 0; r < 16; ++r) { p0[r] = negm; p1[r] = negm; }
#pragma unroll
  for (int d0 = 0; d0 < 6; ++d0) {
    const bf16x8 b0 = *(const bf16x8*)(Ks + r32 * AT_KROW + d0 * 32 + hi * 16);
    const bf16x8 b1 = *(const bf16x8*)(Ks + (32 + r32) * AT_KROW + d0 * 32 + hi * 16);
    p0 = MFMA(b0, qr[d0], p0);
    p1 = MFMA(b1, qr[d0], p1);
  }
}
__device__ __forceinline__ int v_st(int k, int c) { const int kk = (k & ~0xC) | ((k & 4) << 1) | ((k & 8) >> 1); return ((kk >> 3) * 4 + (c >> 5)) * 512 + ((kk & 7) * 32 + (c & 31)) * 2; }
__device__ __forceinline__ int v_rd_base(int lane) { return ((lane & 3) << 3) | (((lane >> 2) & 3) << 6) | (((lane >> 4) & 1) << 5) | (((lane >> 5) & 1) << 8); }
constexpr int v_rd_off(int d0, int ks, int half) { return d0 * 512 + ks * 4096 + half * 2048; }
template <int OFF> __device__ __forceinline__ s16x4 tr_read(int vb) {
  s16x4 r; asm volatile("ds_read_b64_tr_b16 %0, %1 offset:%2" : "=&v"(r) : "v"(vb), "i"(OFF) : "memory"); return r;
}
template <int D0> __device__ __forceinline__ void pv_one(f32x16& od, int vb, bf16x8 pa0, bf16x8 pa1, bf16x8 pa2, bf16x8 pa3) {
  const s16x4 l0 = tr_read<v_rd_off(D0, 0, 0)>(vb), h0 = tr_read<v_rd_off(D0, 0, 1)>(vb), l1 = tr_read<v_rd_off(D0, 1, 0)>(vb), h1 = tr_read<v_rd_off(D0, 1, 1)>(vb);
  const s16x4 l2 = tr_read<v_rd_off(D0, 2, 0)>(vb), h2 = tr_read<v_rd_off(D0, 2, 1)>(vb), l3 = tr_read<v_rd_off(D0, 3, 0)>(vb), h3 = tr_read<v_rd_off(D0, 3, 1)>(vb);
  asm volatile("s_waitcnt lgkmcnt(0)" ::: "memory"); SBAR();
#define PK(Lx, Hx) (bf16x8){Lx[0], Lx[1], Lx[2], Lx[3], Hx[0], Hx[1], Hx[2], Hx[3]}
  od = MFMA(pa0, PK(l0, h0), od);
  od = MFMA(pa1, PK(l1, h1), od);
  od = MFMA(pa2, PK(l2, h2), od);
  od = MFMA(pa3, PK(l3, h3), od);
#undef PK
}
__device__ __forceinline__ void pv_d0(f32x16* o, int vb, bf16x8 pa0, bf16x8 pa1, bf16x8 pa2, bf16x8 pa3) {
  pv_one<0>(o[0], vb, pa0, pa1, pa2, pa3); pv_one<1>(o[1], vb, pa0, pa1, pa2, pa3);
}

__device__ void phase_attn(const Params& p, char* lds) {
  unsigned char* ws = p.ws;
  const bf16_t* Qg = (const bf16_t*)(ws + OFF_Q); const bf16_t* KVg = (const bf16_t*)(ws + OFF_KV); const bf16_t* KPg = (const bf16_t*)(ws + OFF_KPE);
  bf16_t* G1 = (bf16_t*)(ws + OFF_G1);
  const f32x2* rope = (const f32x2*)(ws + OFF_ROPE);
  const int tid = threadIdx.x, wid = tid >> 6, lane = tid & 63, r32 = lane & 31, hi = lane >> 5;
  char* V_lds = lds; char* K_lds = lds + AT_KOFF;
  float* wsl = (float*)(lds + AT_WOFF) + wid * 64; float* li_l = wsl; float* al_l = wsl + 32;
  const int skey = tid >> 3, sc8 = (tid & 7) * 8;
  const int pkey = (tid & 255) >> 2, pc8 = (tid & 3) * 8;
  const int vst = v_st(skey, sc8), kst = skey * AT_KROW + sc8 * 2, pst = pkey * AT_KROW + (64 + pc8) * 2;
  const int vb0 = (int)(uintptr_t)V_lds + v_rd_base(lane);
  const int nitems = NB * 16 * 32;
  const int xcd = blockIdx.x & 7, slot = blockIdx.x >> 3, per = gridDim.x >> 3;
  for (int it = slot; it < nitems / 8; it += per) {
    const int pair = (it >> 5) * 8 + xcd, qblk = it & 31;
    const int b = pair >> 4, h = pair & 15;
    const size_t row0 = (size_t)b * TL;
    const size_t qrow = row0 + qblk * 256 + wid * 32 + r32;
    const bf16_t* Kh = KVg + row0 * 2048 + h * 128;
    const bf16_t* Kp = KPg + row0 * 32;
    float m_reg = 0.f, l_reg = 0.f;
    f32x16 o[2];
#pragma unroll
    for (int dd = 0; dd < 2; ++dd)
#pragma unroll
      for (int r = 0; r < 16; ++r) o[dd][r] = 0.f;
    bf16x8 qr[6];
    {
      const bf16_t* Qw = Qg + qrow * 1536 + h * 96 + hi * 8;
#pragma unroll
      for (int d0 = 0; d0 < 6; ++d0) qr[d0] = *(const bf16x8*)(Qw + d0 * 16);
      const int t = qblk * 256 + wid * 32 + r32;
      const f32x2* tb = rope + (hi ? (t & 63) : (t >> 6)) * 8;
      const u32x4 x1 = *(const u32x4*)&qr[4], x2 = *(const u32x4*)&qr[5];
      u32x4 n1, n2;
#pragma unroll
      for (int q = 0; q < 4; ++q) {
        const f32x2 csA = tb[2 * q], csB = tb[2 * q + 1];
        const float a0 = lo16(x1[q]), a1 = hi16(x1[q]), b0 = lo16(x2[q]), b1 = hi16(x2[q]);
        n1[q] = cvtpk(a0 * csA[0] - b0 * csA[1], a1 * csB[0] - b1 * csB[1]);
        n2[q] = cvtpk(a0 * csA[1] + b0 * csA[0], a1 * csB[1] + b1 * csB[0]);
      }
      qr[4] = *(bf16x8*)&n1; qr[5] = *(bf16x8*)&n2;
    }
    struct { bf16x8 vs, ks, ps; } sr_[2];
#define SLOAD(i, k0) do { sr_[i].vs = *(const bf16x8*)(Kh + (size_t)((k0) + skey) * 2048 + 64 + sc8); \
    sr_[i].ks = *(const bf16x8*)(Kh + (size_t)((k0) + skey) * 2048 + sc8); \
    sr_[i].ps = *(const bf16x8*)(Kp + (size_t)((k0) + pkey) * 32 + pc8); } while (0)
#define SWRITE(bb, i) do { *(bf16x8*)(V_lds + (bb) * AT_SHMV + vst) = sr_[i].vs; \
    *(bf16x8*)(K_lds + (bb) * AT_SHMK + kst) = sr_[i].ks; \
    *(bf16x8*)(K_lds + (bb) * AT_SHMK + pst) = sr_[i].ps; } while (0)
#define SWAIT() asm volatile("s_waitcnt vmcnt(3)" ::: "memory")
#define RESC(a) do { if (__any((a) < 1.f)) { if (hi == 0) al_l[r32] = (a); asm volatile("s_waitcnt lgkmcnt(0)" ::: "memory"); \
    _Pragma("unroll") for (int dd = 0; dd < 2; ++dd) _Pragma("unroll") for (int r = 0; r < 16; ++r) o[dd][r] *= al_l[crow(r, hi)]; } } while (0)
    f32x16 pA0, pA1, pB0, pB1; float alA, alB; bf16x8 pa0, pa1, pa2, pa3;
    constexpr int NT = TL / 64;
    SLOAD(0, 0); asm volatile("s_waitcnt vmcnt(0)" ::: "memory"); SWRITE(0, 0); __syncthreads();
    at_qkt(pA0, pA1, K_lds, qr, r32, hi, 0.f); at_partialSM(pA0, pA1, m_reg, alA, true);
    SLOAD(1, 64); SLOAD(0, 128);
    SWAIT(); SWRITE(1, 1); __syncthreads();
    for (int j = 1; j + 1 < NT; j += 2) {
      SBAR(); at_qkt(pB0, pB1, K_lds + AT_SHMK, qr, r32, hi, -m_reg);
      at_finishSM(pA0, pA1, alA, l_reg, pa0, pa1, pa2, pa3); SBAR();
      SLOAD(1, (j + 2) * 64); SBAR();
      pv_d0(o, vb0, pa0, pa1, pa2, pa3); at_partialSM(pB0, pB1, m_reg, alB, false);
      __syncthreads(); SWAIT(); SWRITE(0, 0);
      RESC(alB); __syncthreads();
      SBAR(); at_qkt(pA0, pA1, K_lds, qr, r32, hi, -m_reg);
      at_finishSM(pB0, pB1, alB, l_reg, pa0, pa1, pa2, pa3); SBAR();
      if (j + 3 < NT) SLOAD(0, (j + 3) * 64); SBAR();
      pv_d0(o, vb0 + AT_SHMV, pa0, pa1, pa2, pa3); at_partialSM(pA0, pA1, m_reg, alA, false);
      __syncthreads(); SWAIT(); SWRITE(1, 1);
      RESC(alA); __syncthreads();
    }
    SBAR(); at_qkt(pB0, pB1, K_lds + AT_SHMK, qr, r32, hi, -m_reg);
    at_finishSM(pA0, pA1, alA, l_reg, pa0, pa1, pa2, pa3); SBAR();
    pv_d0(o, vb0, pa0, pa1, pa2, pa3); at_partialSM(pB0, pB1, m_reg, alB, false);
    __syncthreads(); RESC(alB);
    at_finishSM(pB0, pB1, alB, l_reg, pa0, pa1, pa2, pa3); SBAR();
    pv_d0(o, vb0 + AT_SHMV, pa0, pa1, pa2, pa3);
    if (hi == 0) li_l[r32] = l_reg;
    asm volatile("s_waitcnt lgkmcnt(0)" ::: "memory");
    float rli[16];
#pragma unroll
    for (int r = 0; r < 16; ++r) rli[r] = __builtin_amdgcn_rcpf(li_l[crow(r, hi)]);
    bf16_t* Gw = G1 + (row0 + qblk * 256 + wid * 32) * 1024 + h * 64 + r32;
    bf16_t gin[32];
#pragma unroll
    for (int r = 0; r < 16; ++r) { gin[2 * r] = Gw[(size_t)crow(r, hi) * 1024]; gin[2 * r + 1] = Gw[(size_t)crow(r, hi) * 1024 + 32]; }
    asm volatile("" ::: "memory");
#pragma unroll
    for (int r = 0; r < 16; ++r) {
      const int orow = crow(r, hi);
#pragma unroll
      for (int d0 = 0; d0 < 2; ++d0) {
        const float gt = bf2f(gin[2 * r + d0]);
        Gw[(size_t)orow * 1024 + d0 * 32] = f2bf(o[d0][r] * rli[r] * gt * sigmoidf_(gt));
      }
    }
    __syncthreads();
#undef SLOAD
#undef SWRITE
#undef SWAIT
#undef RESC
  }
}

struct XcdWalk {
  int start, count, step, idx;
  __device__ __forceinline__ void init(int ntiles) {
    const int x = blockIdx.x & 7, base = ntiles >> 3, rem = ntiles & 7;
    count = base + (x < rem ? 1 : 0); start = x * base + (x < rem ? x : rem); step = gridDim.x >> 3; idx = blockIdx.x >> 3;
  }
  __device__ __forceinline__ bool next(int& o) { if (idx >= count) return false; o = start + idx; idx += step; return true; }
  __device__ __forceinline__ bool next_full(int& o) { const int full = (count / step) * step; if (idx >= full) return false; o = start + idx; idx += step; return true; }
  __device__ __forceinline__ bool tail(int& o, int& half) const {
    const int full = (count / step) * step, rem = count - full, sl = blockIdx.x >> 3;
    if (2 * rem <= step) { if (sl >= 2 * rem) return false; o = start + full + (sl >> 1); half = sl & 1; return true; }
    if (sl >= rem) return false; o = start + full + sl; half = -1; return true;
  }
};
__device__ __forceinline__ void tile_mn(int o, int NT, int& mt, int& nt) { const int g = o >> 3; mt = (g / NT) * 8 + (o & 7); nt = g % NT; }

__global__ __launch_bounds__(NTHR, 1) void fwd_megakernel(Params p) {
  extern __shared__ __attribute__((aligned(16))) char lds[];
  cg::grid_group grid = cg::this_grid();
  unsigned char* ws = p.ws;
  bf16_t* H = (bf16_t*)(ws + OFF_H);
  float* mod = (float*)(ws + OFF_MOD);
  float* CTX1 = (float*)(ws + OFF_CTX1);

  phase_prologue(p, lds);
  grid.sync();
  phase_norm_lerp(p, mod);
  phase_weights(p, lds);
  grid.sync();
  {
    const bf16_t* WIN0 = (const bf16_t*)(ws + OFF_WIN0);
    const int nbig = 264 * 16;
    XcdWalk wk; wk.init(nbig); int o, half;
    auto big = [&](int oo, int hf) {
      EpiBf16 e; e.invK = 0.f; e.scr = lds + G_EPI_SCR;
      int mt, jn; tile_mn(oo, 16, mt, jn);
      const int j = jn >> 2, n4 = jn & 3, m0 = mt * 256, c0 = n4 * 256 + (hf > 0 ? 128 : 0);
      e.dst = (bf16_t*)(ws + OFF_R + (size_t)j * U); e.ldd = 1024; e.col0 = c0; e.act = 0; e.m0 = m0;
      if (hf < 0) gemm_tile<0, 256>(lerp_base(p, j, m0), 1024, WIN0 + (size_t)(j * 1024 + c0) * 1024, 1024, m0, nullptr, lds, e);
      else gemm_tile<0, 128>(lerp_base(p, j, m0), 1024, WIN0 + (size_t)(j * 1024 + c0) * 1024, 1024, m0, nullptr, lds, e);
    };
    while (wk.next_full(o)) big(o, -1);
    if (wk.tail(o, half)) big(o, half);
    wk.init(264 * 2);
    while (wk.next(o)) {
      EpiBf16 e; e.invK = 0.f; e.scr = lds + G_EPI_SCR;
      {
        int mt, n2; tile_mn(o, 2, mt, n2);
        const int nt = 32 + n2, m0 = mt * 256;
        e.dst = (bf16_t*)(ws + OFF_LORA); e.ldd = 256; e.col0 = (nt - 32) * 128; e.act = (nt == 32) ? 1 : 0; e.m0 = m0;
        gemm_tile<1, 128>(H, 1024, WIN0 + (size_t)nt * 128 * 1024, 1024, m0, p.in[7] + (nt - 28) * 1024, lds, e);
      }
    }
  }
  grid.sync();
  phase_scan(p, lds);
  grid.sync();
  phase_readout(p);
  grid.sync();
  {
    const bf16_t* A = (const bf16_t*)(ws + OFF_G); const bf16_t* W = (const bf16_t*)(ws + OFF_WOUT0);
    XcdWalk wk; wk.init(264 * 4); int o, half;
    auto tile5 = [&](int oo, int hf) {
      int mt, nt; tile_mn(oo, 4, mt, nt);
      const int m0 = mt * 256;
      const int b = m0 / TL, t0 = m0 - b * TL;
      EpiResid e;
      if (t0 < T) { const size_t orow = (size_t)b * T + t0; e.xin = p.in[0] + orow * 1024; e.xout = p.out + orow * 1024; e.gvec = mod + (size_t)b * 3072 + 2048; }
      else { const size_t orow = (size_t)b * L + (t0 - T); e.xin = p.in[2] + orow * 1024; e.xout = CTX1 + orow * 1024; e.gvec = mod + (size_t)8 * 3072 + 2048; }
      e.n0 = nt * 256 + (hf > 0 ? 128 : 0); e.scr = lds + G_EPI_SCR;
      if (hf < 0) gemm_tile<0, 256>(A, 1024, W + (size_t)e.n0 * 1024, 1024, m0, nullptr, lds, e);
      else gemm_tile<0, 128>(A, 1024, W + (size_t)e.n0 * 1024, 1024, m0, nullptr, lds, e);
    };
    while (wk.next_full(o)) tile5(o, -1);
    if (wk.tail(o, half)) tile5(o, half);
  }
  grid.sync();
  phase_norm(p.out, CTX1, p.in[4] + 1024, mod + 9 * 3072, H);
  grid.sync();
  {
    const bf16_t* W = (const bf16_t*)(ws + OFF_WIN1);
    XcdWalk wk; wk.init(264 * 7); int o, half;
    auto tile7 = [&](int oo, int hf) {
      int mt, nt; tile_mn(oo, 7, mt, nt);
      const int m0 = mt * 256;
      EpiMlaIn e; e.QC = (bf16_t*)(ws + OFF_QC); e.KVC = (bf16_t*)(ws + OFF_KVC); e.KPE = (bf16_t*)(ws + OFF_KPE); e.G1 = (bf16_t*)(ws + OFF_G1);
      e.rope = (const float*)(ws + OFF_ROPE); e.n0 = nt * 256 + (hf > 0 ? 128 : 0); e.m0 = m0; e.scr = lds + G_EPI_SCR;
      if (hf < 0) gemm_tile<0, 256>(H, 1024, W + (size_t)e.n0 * 1024, 1024, m0, nullptr, lds, e);
      else gemm_tile<0, 128>(H, 1024, W + (size_t)e.n0 * 1024, 1024, m0, nullptr, lds, e);
    };
    while (wk.next_full(o)) tile7(o, -1);
    if (wk.tail(o, half)) tile7(o, half);
  }
  grid.sync();
  {
    const bf16_t* WQ = (const bf16_t*)(ws + OFF_WQB); const bf16_t* WKV = (const bf16_t*)(ws + OFF_WKVB);
    const int nq = 256 * 6, nkv = 264 * 8;
    XcdWalk wk; wk.init(nq); int o;
    while (wk.next(o)) {
      EpiBf16 e; e.act = 0; e.scr = lds + G_EPI_SCR;
      {
        int mt2, nt; tile_mn(o, 6, mt2, nt);
        const int b = mt2 >> 5, m0 = b * TL + (mt2 & 31) * 256;
        e.dst = (bf16_t*)(ws + OFF_Q); e.ldd = 1536; e.col0 = nt * 256; e.m0 = m0; e.invK = 1.f / 384.f;
        gemm_tile<2, 256>((const bf16_t*)(ws + OFF_QC), 384, WQ + (size_t)nt * 256 * 384, 384, m0, nullptr, lds, e);
      }
    }
    wk.init(nkv);
    while (wk.next(o)) {
      EpiBf16 e; e.act = 0; e.scr = lds + G_EPI_SCR;
      {
        int mt, nt; tile_mn(o, 8, mt, nt);
        const int m0 = mt * 256;
        e.dst = (bf16_t*)(ws + OFF_KV); e.ldd = 2048; e.col0 = nt * 256; e.m0 = m0; e.invK = 1.f / 256.f;
        gemm_tile<2, 256>((const bf16_t*)(ws + OFF_KVC), 256, WKV + (size_t)nt * 256 * 256, 256, m0, nullptr, lds, e);
      }
    }
  }
  grid.sync();
  phase_attn(p, lds);
  grid.sync();
  {
    const bf16_t* A = (const bf16_t*)(ws + OFF_G1); const bf16_t* W = (const bf16_t*)(ws + OFF_WOUT1);
    XcdWalk wk; wk.init(256 * 4); int o;
    while (wk.next(o)) {
      int mt2, nt; tile_mn(o, 4, mt2, nt);
      const int b = mt2 >> 5, t0 = (mt2 & 31) * 256, m0 = b * TL + t0;
      const size_t orow = (size_t)b * T + t0;
      EpiResid e; e.xin = p.out + orow * 1024; e.xout = p.out + orow * 1024; e.gvec = mod + (size_t)(9 + b) * 3072 + 2048; e.n0 = nt * 256; e.scr = lds + G_EPI_SCR;
      gemm_tile<0, 256>(A, 1024, W + (size_t)nt * 256 * 1024, 1024, m0, nullptr, lds, e);
    }
  }
  grid.sync();
  phase_final(p.out, p.in[27]);
}

extern "C" void kernel_launch(void* const* d_in, const int* in_sizes, int n_in, void* d_out, int out_size, void* d_ws, size_t ws_size, hipStream_t stream) {
  static int grid_blocks = 0;
  if (grid_blocks == 0) {
    if (n_in != 28 || ws_size < WS_END + (size_t)(NTOK - LERP3_SPLIT) * 2048 || out_size != NB * T * D) { fprintf(stderr, "kernel_launch: unexpected shapes (n_in %d, ws %zu need %zu, out %d)\n", n_in, ws_size, (size_t)WS_END, out_size); grid_blocks = -1; return; }
    int dev = 0, cus = 0, per_cu = 0;
    hipGetDevice(&dev);
    hipDeviceGetAttribute(&cus, hipDeviceAttributeMultiprocessorCount, dev);
    if (hipFuncSetAttribute((const void*)fwd_megakernel, hipFuncAttributeMaxDynamicSharedMemorySize, LDS_BYTES) != hipSuccess) { fprintf(stderr, "kernel_launch: hipFuncSetAttribute failed\n"); grid_blocks = -1; return; }
    hipOccupancyMaxActiveBlocksPerMultiprocessor(&per_cu, (const void*)fwd_megakernel, NTHR, LDS_BYTES);
    if (per_cu < 1) { fprintf(stderr, "kernel_launch: occupancy query says %d blocks per CU\n", per_cu); per_cu = 1; }
    (void)hipGetLastError();
    grid_blocks = cus;
    if (grid_blocks > 256) grid_blocks = 256;
    grid_blocks &= ~7;
  }
  if (grid_blocks <= 0) return;
  Params p{};
  for (int i = 0; i < 28; ++i) p.in[i] = (const float*)d_in[i];
  p.out = (float*)d_out; p.ws = (unsigned char*)d_ws;
  void* args[] = {&p};
  hipError_t e = hipLaunchCooperativeKernel((const void*)fwd_megakernel, dim3(grid_blocks), dim3(NTHR), args, LDS_BYTES, stream);
  if (e != hipSuccess) fprintf(stderr, "cooperative launch failed: %s (grid %d)\n", hipGetErrorString(e), grid_blocks);
}
```

```cpp
#include <hip/hip_runtime.h>
#include <hip/hip_cooperative_groups.h>
#include <cstdio>
#include <cstdint>
namespace cg = cooperative_groups;

typedef unsigned short bf16_t;
typedef short bf16x8 __attribute__((ext_vector_type(8)));
typedef short s16x4 __attribute__((ext_vector_type(4)));
typedef float f32x16 __attribute__((ext_vector_type(16)));
typedef float f32x4 __attribute__((ext_vector_type(4)));
typedef float f32x2 __attribute__((ext_vector_type(2)));
typedef unsigned u32x4 __attribute__((ext_vector_type(4)));
typedef unsigned u32x2 __attribute__((ext_vector_type(2)));

constexpr int D = 1024, NB = 8, T = 8192, L = 256, TL = T + L, NTOK = NB * TL;
constexpr int NTHR = 512;

constexpr size_t U = (size_t)NTOK * 1024 * 2;
constexpr size_t OFF_H = 0, OFF_R = U, OFF_K = 2 * U, OFF_V = 3 * U, OFF_G = 4 * U, OFF_Y0 = 5 * U, OFF_Y1 = 6 * U;
constexpr size_t OFF_LORA = 7 * U;
constexpr size_t OFF_BONUS = OFF_LORA + (size_t)NTOK * 256 * 2;
constexpr size_t OFF_WIN0 = OFF_BONUS + (size_t)2 * NTOK * 16 * 4;
constexpr size_t OFF_WOUT0 = OFF_WIN0 + (size_t)4352 * 1024 * 2;
constexpr size_t OFF_WIN1 = OFF_WOUT0 + (size_t)1024 * 1024 * 2;
constexpr size_t OFF_WQB = OFF_WIN1 + (size_t)1792 * 1024 * 2;
constexpr size_t OFF_WKVB = OFF_WQB + (size_t)1536 * 384 * 2;
constexpr size_t OFF_WOUT1 = OFF_WKVB + (size_t)2048 * 256 * 2;
constexpr size_t OFF_MOD = OFF_WOUT1 + (size_t)1024 * 1024 * 2;
constexpr size_t OFF_ROPE = OFF_MOD + (size_t)2 * 9 * 3072 * 4;
constexpr size_t OFF_CTX1 = OFF_ROPE + (size_t)128 * 8 * 2 * 4;
constexpr size_t WS_END = OFF_CTX1 + (size_t)2048 * 1024 * 4;
constexpr size_t OFF_QC = OFF_V;
constexpr size_t OFF_KVC = OFF_QC + (size_t)NTOK * 384 * 2;
constexpr size_t OFF_KPE = OFF_KVC + (size_t)NTOK * 256 * 2;
constexpr size_t OFF_G1 = OFF_G;
constexpr size_t OFF_Q = OFF_R;
constexpr size_t OFF_KV = OFF_Y0;

struct Params { const float* in[28]; float* out; unsigned char* ws; };

typedef __bf16 bf16x2_t __attribute__((ext_vector_type(2)));
__device__ __forceinline__ unsigned cvtpk(float lo, float hi) { f32x2 v = {lo, hi}; bf16x2_t b = __builtin_convertvector(v, bf16x2_t); return *(unsigned*)&b; }
__device__ __forceinline__ float bf2f(bf16_t u) { return __uint_as_float(((unsigned)u) << 16); }
__device__ __forceinline__ bf16_t f2bf(float f) { return (bf16_t)(cvtpk(f, 0.f) & 0xffffu); }
__device__ __forceinline__ float lo16(unsigned w) { return __uint_as_float(w << 16); }
__device__ __forceinline__ float hi16(unsigned w) { return __uint_as_float(w & 0xffff0000u); }
__device__ __forceinline__ void st_bf16x4(bf16_t* p, float a, float b, float c, float d) { u32x2 w = {cvtpk(a, b), cvtpk(c, d)}; *(u32x2*)p = w; }
__device__ __forceinline__ void st_bf16x4_nt(bf16_t* p, float a, float b, float c, float d) { u32x2 w = {cvtpk(a, b), cvtpk(c, d)}; __builtin_nontemporal_store(w, (u32x2*)p); }
__device__ __forceinline__ float wave_sum(float v) {
#pragma unroll
  for (int o = 32; o; o >>= 1) v += __shfl_xor(v, o);
  return v;
}
__device__ __forceinline__ float dpp_f(float v, const int ctrl_sel) {
  int r;
  if (ctrl_sel == 0) r = __builtin_amdgcn_update_dpp(0, __float_as_int(v), 0xB1, 0xF, 0xF, true);
  else if (ctrl_sel == 1) r = __builtin_amdgcn_update_dpp(0, __float_as_int(v), 0x4E, 0xF, 0xF, true);
  else r = __builtin_amdgcn_update_dpp(0, __float_as_int(v), 0x141, 0xF, 0xF, true);
  return __int_as_float(r);
}
__device__ __forceinline__ float red8(float v) { v += dpp_f(v, 0); v += dpp_f(v, 1); v += dpp_f(v, 2); return v; }
__device__ __forceinline__ int crow(int r, int hi) { return (r & 3) + 8 * (r >> 2) + 4 * hi; }
__device__ __forceinline__ float sigmoidf_(float x) { return __builtin_amdgcn_rcpf(1.f + __expf(-x)); }
#define MFMA(a, b, c) __builtin_amdgcn_mfma_f32_32x32x16_bf16((a), (b), (c), 0, 0, 0)

constexpr int G_LDT = 144;
constexpr int G_SSQ_OFF = 2 * (256 + 256) * G_LDT;
constexpr int LDS_BYTES = G_SSQ_OFF + 1024;

template <int AMODE, int BN, class Epi>
__device__ __forceinline__ void gemm_tile(const bf16_t* A, const int lda, const bf16_t* Bt, const int K, const int m0, const float* mu, char* lds, const Epi& epi) {
  constexpr int WN = BN / 64, MI = WN, NBR = BN / 64, G_STAGE = (256 + BN) * G_LDT;
  const int tid = threadIdx.x, lane = tid & 63, wid = tid >> 6, r32 = lane & 31, hi = lane >> 5;
  const int wm = wid / WN, wn = wid % WN;
  const int srow = tid >> 3, scc = (tid & 7) * 8;
  int browi[NBR];
#pragma unroll
  for (int i = 0; i < NBR; ++i) browi[i] = 64 * i + ((Epi::PERM && !epi.natural_group(64 * i + srow)) ? ((srow & 32) + 16 * ((srow >> 2) & 1) + 4 * ((srow & 31) >> 3) + (srow & 3)) : srow);
  f32x16 acc[MI][2];
#pragma unroll
  for (int i = 0; i < MI; ++i)
#pragma unroll
    for (int j = 0; j < 2; ++j)
#pragma unroll
      for (int r = 0; r < 16; ++r) acc[i][j][r] = 0.f;
  bf16x8 ra[4], rb[NBR], rp[4], rn[4];
  float ssq[4] = {0.f, 0.f, 0.f, 0.f};
  int dprev[4], dnext[4];
  if constexpr (AMODE == 1) {
    const int t0 = m0 % TL;
#pragma unroll
    for (int i = 0; i < 4; ++i) { const int t = t0 + srow + 64 * i; dprev[i] = (t != 0 && t != T) ? 1 : 0; dnext[i] = (t != T - 1 && t != TL - 1) ? 1 : 0; }
  }
  auto gload = [&](int k0) {
#pragma unroll
    for (int i = 0; i < 4; ++i) {
      const bf16_t* ap = A + (size_t)(m0 + srow + 64 * i) * lda + k0 + scc;
      ra[i] = *(const bf16x8*)ap;
      if constexpr (AMODE == 1) { rp[i] = *(const bf16x8*)(ap - dprev[i] * lda); rn[i] = *(const bf16x8*)(ap + dnext[i] * lda); }
    }
#pragma unroll
    for (int i = 0; i < NBR; ++i) rb[i] = *(const bf16x8*)(Bt + (size_t)browi[i] * K + k0 + scc);
  };
  auto lstore = [&](int s, int k0) {
    char* base = lds + s * G_STAGE;
    if constexpr (AMODE == 1) {
      const f32x4 m0v = *(const f32x4*)(mu + k0 + scc), m1v = *(const f32x4*)(mu + k0 + scc + 4);
      const float mm[8] = {m0v[0], m0v[1], m0v[2], m0v[3], m1v[0], m1v[1], m1v[2], m1v[3]};
#pragma unroll
      for (int i = 0; i < 4; ++i) {
        const u32x4 hc = *(const u32x4*)&ra[i], hp = *(const u32x4*)&rp[i], hn = *(const u32x4*)&rn[i];
        const float fp = dprev[i] ? 0.5f : 0.f, fn = dnext[i] ? 0.5f : 0.f;
        u32x4 w;
#pragma unroll
        for (int q = 0; q < 4; ++q) {
          const float c0 = lo16(hc[q]), c1 = hi16(hc[q]);
          const float x0 = fp * lo16(hp[q]) + fn * lo16(hn[q]) - c0, x1 = fp * hi16(hp[q]) + fn * hi16(hn[q]) - c1;
          w[q] = cvtpk(c0 + x0 * mm[2 * q], c1 + x1 * mm[2 * q + 1]);
        }
        *(u32x4*)(base + (srow + 64 * i) * G_LDT + scc * 2) = w;
      }
    } else {
#pragma unroll
      for (int i = 0; i < 4; ++i) {
        *(bf16x8*)(base + (srow + 64 * i) * G_LDT + scc * 2) = ra[i];
        if constexpr (AMODE == 2) {
          const u32x4 hc = *(const u32x4*)&ra[i];
#pragma unroll
          for (int q = 0; q < 4; ++q) { const float c0 = lo16(hc[q]), c1 = hi16(hc[q]); ssq[i] += c0 * c0 + c1 * c1; }
        }
      }
    }
#pragma unroll
    for (int i = 0; i < NBR; ++i) *(bf16x8*)(base + 256 * G_LDT + (srow + 64 * i) * G_LDT + scc * 2) = rb[i];
  };
  const int nk = K >> 6;
  gload(0);
  lstore(0, 0);
  if (nk > 1) gload(64);
  __syncthreads();
#pragma unroll 1
  for (int kt = 0; kt < nk; ++kt) {
    const int s = kt & 1;
    if (kt + 1 < nk) lstore(s ^ 1, (kt + 1) * 64);
    if (kt + 2 < nk) gload((kt + 2) * 64);
    {
      const char* Ab = lds + s * G_STAGE + (wm * (32 * MI) + r32) * G_LDT + hi * 16;
      const char* Bb = lds + s * G_STAGE + 256 * G_LDT + (wn * 64 + r32) * G_LDT + hi * 16;
      bf16x8 fb[2][2], fa[2][MI];
      fb[0][0] = *(const bf16x8*)(Bb); fb[0][1] = *(const bf16x8*)(Bb + 32 * G_LDT);
#pragma unroll
      for (int mi = 0; mi < MI; ++mi) fa[0][mi] = *(const bf16x8*)(Ab + mi * 32 * G_LDT);
#pragma unroll
      for (int ks = 0; ks < 4; ++ks) {
        const int sl = ks & 1;
        if (ks + 1 < 4) {
          fb[sl ^ 1][0] = *(const bf16x8*)(Bb + (ks + 1) * 32); fb[sl ^ 1][1] = *(const bf16x8*)(Bb + 32 * G_LDT + (ks + 1) * 32);
#pragma unroll
          for (int mi = 0; mi < MI; ++mi) fa[sl ^ 1][mi] = *(const bf16x8*)(Ab + mi * 32 * G_LDT + (ks + 1) * 32);
        }
#pragma unroll
        for (int mi = 0; mi < MI; ++mi) { acc[mi][0] = MFMA(fb[sl][0], fa[sl][mi], acc[mi][0]); acc[mi][1] = MFMA(fb[sl][1], fa[sl][mi], acc[mi][1]); }
      }
    }
    __syncthreads();
  }
  float* ssq_l = (float*)(lds + G_SSQ_OFF);
  if constexpr (AMODE == 2) {
#pragma unroll
    for (int i = 0; i < 4; ++i) { const float v = red8(ssq[i]); if ((tid & 7) == 0) ssq_l[srow + 64 * i] = v; }
    __syncthreads();
  }
#pragma unroll
  for (int mi = 0; mi < MI; ++mi) {
    const int lrow = wm * (32 * MI) + mi * 32 + r32;
    float aux = 0.f;
    if constexpr (AMODE == 2) aux = ssq_l[lrow];
    epi(lrow, wn * 64 + 4 * hi, acc[mi][0], acc[mi][1], aux);
  }
}

constexpr int G_EPI_SCR = (256 + 256) * G_LDT;
struct EpiBf16 {
  static constexpr bool PERM = true;
  __device__ __forceinline__ bool natural_group(int) const { return false; }
  bf16_t* dst; int ldd; int col0; int m0; int act; float invK; char* scr;
  __device__ __forceinline__ void operator()(int lrow, int nc, const f32x16& a0, const f32x16& a1, float aux) const {
    const int lane = threadIdx.x & 63, wid = threadIdx.x >> 6, r32 = lane & 31, hi = lane >> 5;
    float sc = 1.f;
    if (invK > 0.f) sc = rsqrtf(aux * invK + 1e-6f);
    char* sp = scr + wid * (32 * 144);
    char* wp = sp + r32 * 144 + 32 * hi;
    if (act) {
#define TANH_(x) (1.f - 2.f * __builtin_amdgcn_rcpf(__expf(2.f * (x) * sc) + 1.f))
      const u32x4 w0 = {cvtpk(TANH_(a0[0]), TANH_(a0[1])), cvtpk(TANH_(a0[2]), TANH_(a0[3])), cvtpk(TANH_(a0[4]), TANH_(a0[5])), cvtpk(TANH_(a0[6]), TANH_(a0[7]))};
      const u32x4 w1 = {cvtpk(TANH_(a0[8]), TANH_(a0[9])), cvtpk(TANH_(a0[10]), TANH_(a0[11])), cvtpk(TANH_(a0[12]), TANH_(a0[13])), cvtpk(TANH_(a0[14]), TANH_(a0[15]))};
      const u32x4 w2 = {cvtpk(TANH_(a1[0]), TANH_(a1[1])), cvtpk(TANH_(a1[2]), TANH_(a1[3])), cvtpk(TANH_(a1[4]), TANH_(a1[5])), cvtpk(TANH_(a1[6]), TANH_(a1[7]))};
      const u32x4 w3 = {cvtpk(TANH_(a1[8]), TANH_(a1[9])), cvtpk(TANH_(a1[10]), TANH_(a1[11])), cvtpk(TANH_(a1[12]), TANH_(a1[13])), cvtpk(TANH_(a1[14]), TANH_(a1[15]))};
#undef TANH_
      *(u32x4*)(wp) = w0; *(u32x4*)(wp + 16) = w1; *(u32x4*)(wp + 64) = w2; *(u32x4*)(wp + 80) = w3;
    } else {
      const u32x4 w0 = {cvtpk(a0[0] * sc, a0[1] * sc), cvtpk(a0[2] * sc, a0[3] * sc), cvtpk(a0[4] * sc, a0[5] * sc), cvtpk(a0[6] * sc, a0[7] * sc)};
      const u32x4 w1 = {cvtpk(a0[8] * sc, a0[9] * sc), cvtpk(a0[10] * sc, a0[11] * sc), cvtpk(a0[12] * sc, a0[13] * sc), cvtpk(a0[14] * sc, a0[15] * sc)};
      const u32x4 w2 = {cvtpk(a1[0] * sc, a1[1] * sc), cvtpk(a1[2] * sc, a1[3] * sc), cvtpk(a1[4] * sc, a1[5] * sc), cvtpk(a1[6] * sc, a1[7] * sc)};
      const u32x4 w3 = {cvtpk(a1[8] * sc, a1[9] * sc), cvtpk(a1[10] * sc, a1[11] * sc), cvtpk(a1[12] * sc, a1[13] * sc), cvtpk(a1[14] * sc, a1[15] * sc)};
      *(u32x4*)(wp) = w0; *(u32x4*)(wp + 16) = w1; *(u32x4*)(wp + 64) = w2; *(u32x4*)(wp + 80) = w3;
    }
    asm volatile("s_waitcnt lgkmcnt(0)" ::: "memory");
    bf16_t* gp = dst + (size_t)(m0 + lrow - r32) * ldd + col0 + (nc & ~7) + (lane & 7) * 8;
#pragma unroll
    for (int i = 0; i < 4; ++i) {
      const int row = (lane >> 3) + 8 * i;
      *(u32x4*)(gp + (size_t)row * ldd) = *(const u32x4*)(sp + row * 144 + (lane & 7) * 16);
    }
    asm volatile("s_waitcnt lgkmcnt(0)" ::: "memory");
  }
};
struct EpiResid {
  static constexpr bool PERM = false;
  __device__ __forceinline__ bool natural_group(int) const { return true; }
  const float* xin; float* xout; const float* gvec; int n0; char* scr;
  __device__ __forceinline__ void operator()(int lrow, int nc, const f32x16& a0, const f32x16& a1, float) const {
    const int lane = threadIdx.x & 63, wid = threadIdx.x >> 6, r32 = lane & 31, hi = lane >> 5;
    float* sp = (float*)(scr + wid * (32 * 272));
#pragma unroll
    for (int g = 0; g < 4; ++g) {
      const f32x4 v0 = {a0[4 * g], a0[4 * g + 1], a0[4 * g + 2], a0[4 * g + 3]}, v1 = {a1[4 * g], a1[4 * g + 1], a1[4 * g + 2], a1[4 * g + 3]};
      *(f32x4*)(sp + r32 * 68 + 4 * hi + 8 * g) = v0; *(f32x4*)(sp + r32 * 68 + 32 + 4 * hi + 8 * g) = v1;
    }
    asm volatile("s_waitcnt lgkmcnt(0)" ::: "memory");
    const int c4 = (lane & 15) * 4, colg = n0 + (nc & ~7) + c4;
    const size_t rbase = (size_t)(lrow - r32) * 1024 + colg;
    const f32x4 gv = *(const f32x4*)(gvec + colg);
    f32x4 xv[8];
#pragma unroll
    for (int i = 0; i < 8; ++i) xv[i] = *(const f32x4*)(xin + rbase + (size_t)((lane >> 4) + 4 * i) * 1024);
    asm volatile("" ::: "memory");
#pragma unroll
    for (int i = 0; i < 8; ++i) {
      const int row = (lane >> 4) + 4 * i;
      const f32x4 av = *(const f32x4*)(sp + row * 68 + c4);
      f32x4 r; r[0] = xv[i][0] + gv[0] * av[0]; r[1] = xv[i][1] + gv[1] * av[1]; r[2] = xv[i][2] + gv[2] * av[2]; r[3] = xv[i][3] + gv[3] * av[3];
      *(f32x4*)(xout + rbase + (size_t)row * 1024) = r;
    }
    asm volatile("s_waitcnt lgkmcnt(0)" ::: "memory");
  }
};
struct EpiMlaIn {
  static constexpr bool PERM = true;
  bf16_t *QC, *KVC, *KPE, *G1; const float* rope; int n0; int m0; char* scr;
  __device__ __forceinline__ bool natural_group(int tile_row) const { return ((n0 + tile_row) >> 5) == 20; }
  __device__ __forceinline__ void operator()(int lrow, int nc, const f32x16& a0, const f32x16& a1, float) const {
    const int g64 = n0 + (nc & ~7);
    if (g64 == 640) { rope_one(lrow, nc, a0); return; }
    if (g64 == 704) return;
    bf16_t* base; int ld;
    if (g64 < 384) { base = QC + g64; ld = 384; } else if (g64 < 640) { base = KVC + (g64 - 384); ld = 256; } else { base = G1 + (g64 - 768); ld = 1024; }
    const int lane = threadIdx.x & 63, wid = threadIdx.x >> 6, r32 = lane & 31, hi = lane >> 5;
    char* sp = scr + wid * (32 * 144);
    char* wp = sp + r32 * 144 + 32 * hi;
    const u32x4 w0 = {cvtpk(a0[0], a0[1]), cvtpk(a0[2], a0[3]), cvtpk(a0[4], a0[5]), cvtpk(a0[6], a0[7])};
    const u32x4 w1 = {cvtpk(a0[8], a0[9]), cvtpk(a0[10], a0[11]), cvtpk(a0[12], a0[13]), cvtpk(a0[14], a0[15])};
    const u32x4 w2 = {cvtpk(a1[0], a1[1]), cvtpk(a1[2], a1[3]), cvtpk(a1[4], a1[5]), cvtpk(a1[6], a1[7])};
    const u32x4 w3 = {cvtpk(a1[8], a1[9]), cvtpk(a1[10], a1[11]), cvtpk(a1[12], a1[13]), cvtpk(a1[14], a1[15])};
    *(u32x4*)(wp) = w0; *(u32x4*)(wp + 16) = w1; *(u32x4*)(wp + 64) = w2; *(u32x4*)(wp + 80) = w3;
    asm volatile("s_waitcnt lgkmcnt(0)" ::: "memory");
    bf16_t* gp = base + (size_t)(m0 + lrow - r32) * ld + (lane & 7) * 8;
#pragma unroll
    for (int i = 0; i < 4; ++i) {
      const int row = (lane >> 3) + 8 * i;
      *(u32x4*)(gp + (size_t)row * ld) = *(const u32x4*)(sp + row * 144 + (lane & 7) * 16);
    }
    asm volatile("s_waitcnt lgkmcnt(0)" ::: "memory");
  }
  __device__ __forceinline__ void rope_one(int lrow, int nc, const f32x16& a) const {
    const int row = m0 + lrow, t = (m0 % TL) + lrow, hi4 = nc & 4;
    bf16_t* p = KPE + (size_t)row * 32;
    if (t < T) {
      const f32x2* tr = (const f32x2*)rope + (t >> 6) * 8 + hi4;
      const f32x2* tc = (const f32x2*)rope + (t & 63) * 8 + hi4;
      float o1[8], o2[8];
#pragma unroll
      for (int e = 0; e < 4; ++e) {
        const f32x2 cs0 = tr[e], cs1 = tc[e];
        const float x1a = a[e], x2a = a[8 + e];
        const float x1b = a[4 + e], x2b = a[12 + e];
        o1[e] = x1a * cs0[0] - x2a * cs0[1]; o2[e] = x1a * cs0[1] + x2a * cs0[0];
        o1[4 + e] = x1b * cs1[0] - x2b * cs1[1]; o2[4 + e] = x1b * cs1[1] + x2b * cs1[0];
      }
      st_bf16x4(p + hi4, o1[0], o1[1], o1[2], o1[3]);
      st_bf16x4(p + 8 + hi4, o1[4], o1[5], o1[6], o1[7]);
      st_bf16x4(p + 16 + hi4, o2[0], o2[1], o2[2], o2[3]);
      st_bf16x4(p + 24 + hi4, o2[4], o2[5], o2[6], o2[7]);
    } else {
#pragma unroll
      for (int g = 0; g < 4; ++g) st_bf16x4(p + 8 * g + hi4, a[4 * g], a[4 * g + 1], a[4 * g + 2], a[4 * g + 3]);
    }
  }
};

constexpr float AT_SCALE = 0.10206207261596575f;
constexpr float AT_THR = 8.f;
__device__ void tr_job(const float* src, int ld, int K, int N, bf16_t* dst, const float* kscale, char* lds, float gscale = 1.f) {
  float* tile = (float*)lds;
  const int tid = threadIdx.x, nK = K >> 6, nN = (N + 63) >> 6;
  for (int tIdx = blockIdx.x; tIdx < nK * nN; tIdx += gridDim.x) {
    const int k0 = (tIdx % nK) * 64, n0 = (tIdx / nK) * 64;
#pragma unroll
    for (int i = 0; i < 8; ++i) {
      const int kk = (tid >> 6) + 8 * i, nn = tid & 63;
      float v = 0.f;
      if (n0 + nn < N) { v = src[(size_t)(k0 + kk) * ld + n0 + nn] * gscale; if (kscale) v *= kscale[k0 + kk]; }
      tile[kk * 65 + nn] = v;
    }
    __syncthreads();
#pragma unroll
    for (int i = 0; i < 8; ++i) {
      const int nn = (tid >> 6) + 8 * i, kk = tid & 63;
      if (n0 + nn < N) dst[(size_t)(n0 + nn) * K + k0 + kk] = f2bf(tile[kk * 65 + nn]);
    }
    __syncthreads();
  }
}

__device__ void phase_weights(const Params& p, char* lds) {
  unsigned char* ws = p.ws;
  bf16_t* WIN0 = (bf16_t*)(ws + OFF_WIN0);
  for (int j = 0; j < 4; ++j) tr_job(p.in[8] + (size_t)j * 1024 * 1024, 1024, 1024, 1024, WIN0 + (size_t)j * 1024 * 1024, nullptr, lds);
  for (int d = 0; d < 2; ++d) {
    tr_job(p.in[10] + (size_t)d * 1024 * 64, 64, 1024, 64, WIN0 + (size_t)(4096 + d * 64) * 1024, nullptr, lds);
    tr_job(p.in[13] + (size_t)d * 1024 * 64, 64, 1024, 64, WIN0 + (size_t)(4224 + d * 64) * 1024, nullptr, lds);
  }
  tr_job(p.in[20], 1024, 1024, 1024, (bf16_t*)(ws + OFF_WOUT0), nullptr, lds);
  bf16_t* WIN1 = (bf16_t*)(ws + OFF_WIN1);
  tr_job(p.in[21], 1696, 1024, 640, WIN1, nullptr, lds);
  tr_job(p.in[21] + 640, 1696, 1024, 32, WIN1 + (size_t)640 * 1024, nullptr, lds);
  tr_job(p.in[21] + 672, 1696, 1024, 1024, WIN1 + (size_t)768 * 1024, nullptr, lds);
  for (int i = blockIdx.x * NTHR + threadIdx.x; i < 96 * 1024; i += gridDim.x * NTHR) WIN1[(size_t)672 * 1024 + i] = 0;
  tr_job(p.in[23], 1536, 384, 1536, (bf16_t*)(ws + OFF_WQB), p.in[22], lds, AT_SCALE * 1.4426950408889634f);
  tr_job(p.in[25], 2048, 256, 2048, (bf16_t*)(ws + OFF_WKVB), p.in[24], lds);
  tr_job(p.in[26], 1024, 1024, 1024, (bf16_t*)(ws + OFF_WOUT1), nullptr, lds);
}
__device__ void phase_prologue(const Params& p, char* lds) {
  unsigned char* ws = p.ws;
  {
    const int i = blockIdx.x * NTHR + threadIdx.x;
    if (i < 1024) {
      const float invf[8] = {1.f, 0.316227766016838f, 0.1f, 0.0316227766016838f, 0.01f, 0.00316227766016838f, 0.001f, 0.000316227766016838f};
      const int pos = i >> 3, m = i & 7;
      float inv = invf[0];
#pragma unroll
      for (int q = 1; q < 8; ++q) inv = (m == q) ? invf[q] : inv;
      const float ang = (float)pos * inv;
      const float kf = rintf(ang * 0.15915494309189535f);
      float r = fmaf(-kf, 6.28125f, ang);
      r = fmaf(-kf, 1.9353071795864769e-3f, r);
      float* rt = (float*)(ws + OFF_ROPE);
      rt[2 * i] = cosf(r); rt[2 * i + 1] = sinf(r);
    }
  }
  {
    float* sil = (float*)lds;
    float* red = sil + 9 * 1024;
    const int tid = threadIdx.x;
    for (int i = tid; i < 9 * 1024; i += NTHR) {
      const int bi = i >> 10, k = i & 1023;
      const float cv = bi < 8 ? p.in[1][bi * 1024 + k] : p.in[3][k];
      sil[i] = cv / (1.f + __expf(-cv));
    }
    __syncthreads();
    float* mod = (float*)(ws + OFF_MOD);
    for (int item = blockIdx.x; item < 192; item += gridDim.x) {
      const int l = item / 96, n0 = (item % 96) * 32, col = tid & 31, kg = tid >> 5;
      float acc[9];
#pragma unroll
      for (int bi = 0; bi < 9; ++bi) acc[bi] = 0.f;
      const float* wp = p.in[5] + ((size_t)l * 1024 + kg * 64) * 3072 + n0 + col;
      for (int kk = 0; kk < 64; ++kk) {
        const float w = wp[(size_t)kk * 3072];
#pragma unroll
        for (int bi = 0; bi < 9; ++bi) acc[bi] += sil[bi * 1024 + kg * 64 + kk] * w;
      }
#pragma unroll
      for (int bi = 0; bi < 9; ++bi) red[(kg * 9 + bi) * 32 + col] = acc[bi];
      __syncthreads();
      if (tid < 288) {
        const int bi = tid >> 5;
        float s = 0.f;
#pragma unroll
        for (int g = 0; g < 16; ++g) s += red[(g * 9 + bi) * 32 + col];
        mod[((size_t)l * 9 + bi) * 3072 + n0 + col] = s + p.in[6][l * 3072 + n0 + col];
      }
      __syncthreads();
    }
  }
}

__device__ __forceinline__ const float* row_src(const float* xsrc, const float* csrc, int n, int& bi) {
  const int b = n / TL, t = n - b * TL;
  if (t < T) { bi = b; return xsrc + ((size_t)b * T + t) * D; }
  bi = 8; return csrc + ((size_t)b * L + (t - T)) * D;
}
__device__ void phase_norm(const float* xsrc, const float* csrc, const float* ng, const float* mod, bf16_t* H) {
  const int lane = threadIdx.x & 63, gw = blockIdx.x * 8 + (threadIdx.x >> 6), nw = gridDim.x * 8;
  f32x4 g4[4];
#pragma unroll
  for (int i = 0; i < 4; ++i) g4[i] = *(const f32x4*)(ng + i * 256 + lane * 4);
  f32x4 va[4], vb[4]; int bia = 0, bib = 0;
  if (gw < NTOK) { const float* src = row_src(xsrc, csrc, gw, bia);
#pragma unroll
    for (int i = 0; i < 4; ++i) va[i] = *(const f32x4*)(src + i * 256 + lane * 4); }
  for (int n = gw; n < NTOK; n += nw) {
    if (n + nw < NTOK) { const float* src = row_src(xsrc, csrc, n + nw, bib);
#pragma unroll
      for (int i = 0; i < 4; ++i) vb[i] = *(const f32x4*)(src + i * 256 + lane * 4); }
    float ss = 0.f;
#pragma unroll
    for (int i = 0; i < 4; ++i) ss += va[i][0] * va[i][0] + va[i][1] * va[i][1] + va[i][2] * va[i][2] + va[i][3] * va[i][3];
    ss = wave_sum(ss);
    const float rstd = rsqrtf(ss * (1.f / 1024.f) + 1e-6f);
    const float* m = mod + bia * 3072;
#pragma unroll
    for (int i = 0; i < 4; ++i) {
      const int c = i * 256 + lane * 4;
      const f32x4 sh = *(const f32x4*)(m + c), sc = *(const f32x4*)(m + 1024 + c);
      float o[4];
#pragma unroll
      for (int e = 0; e < 4; ++e) o[e] = va[i][e] * rstd * g4[i][e] * (1.f + sc[e]) + sh[e];
      st_bf16x4(H + (size_t)n * 1024 + c, o[0], o[1], o[2], o[3]);
    }
#pragma unroll
    for (int i = 0; i < 4; ++i) va[i] = vb[i];
    bia = bib;
  }
}

constexpr int LERP3_SPLIT = 63488;
__device__ __forceinline__ bf16_t* lerp_base(const Params& p, int j, int row) {
  if (j == 0) return (bf16_t*)(p.ws + OFF_Y0);
  if (j == 1) return (bf16_t*)(p.ws + OFF_Y1);
  if (j == 2) return (bf16_t*)p.out;
  if (row < LERP3_SPLIT) return (bf16_t*)p.out + (size_t)NTOK * 1024;
  return (bf16_t*)(p.ws + WS_END) - (size_t)LERP3_SPLIT * 1024;
}
struct RowX { f32x4 v[4]; int bi; };
__device__ __forceinline__ void ld_row(const Params& p, int n, int lane, RowX& r) {
  const float* src = row_src(p.in[0], p.in[2], n, r.bi);
#pragma unroll
  for (int i = 0; i < 4; ++i) r.v[i] = *(const f32x4*)(src + i * 256 + lane * 4);
}
__device__ __forceinline__ void fin_row(const float* mod, const f32x4 (&g4)[4], int lane, const RowX& r, float (&h)[16]) {
  float ss = 0.f;
#pragma unroll
  for (int i = 0; i < 4; ++i) ss += r.v[i][0] * r.v[i][0] + r.v[i][1] * r.v[i][1] + r.v[i][2] * r.v[i][2] + r.v[i][3] * r.v[i][3];
  ss = wave_sum(ss);
  const float rstd = rsqrtf(ss * (1.f / 1024.f) + 1e-6f);
  const float* m = mod + r.bi * 3072;
#pragma unroll
  for (int i = 0; i < 4; ++i) {
    const int c = i * 256 + lane * 4;
    const f32x4 sh = *(const f32x4*)(m + c), sc = *(const f32x4*)(m + 1024 + c);
#pragma unroll
    for (int e = 0; e < 4; ++e) {
      const float hv = r.v[i][e] * rstd * g4[i][e] * (1.f + sc[e]) + sh[e];
      h[4 * i + e] = __uint_as_float(cvtpk(hv, 0.f) << 16);
    }
  }
}
__device__ void phase_norm_lerp(const Params& p, const float* mod) {
  const int lane = threadIdx.x & 63, gw = blockIdx.x * 8 + (threadIdx.x >> 6), nw = gridDim.x * 8;
  const int per = (NTOK + nw - 1) / nw;
  const int r0 = gw * per, r1 = (r0 + per < NTOK) ? r0 + per : NTOK;
  if (r0 >= r1) return;
  bf16_t* H = (bf16_t*)(p.ws + OFF_H);
  f32x4 g4[4];
#pragma unroll
  for (int i = 0; i < 4; ++i) g4[i] = *(const f32x4*)(p.in[4] + i * 256 + lane * 4);
  float mu[4][16];
#pragma unroll
  for (int j = 0; j < 4; ++j)
#pragma unroll
    for (int i = 0; i < 4; ++i) {
      const f32x4 m4 = *(const f32x4*)(p.in[7] + j * 1024 + i * 256 + lane * 4);
      mu[j][4 * i] = m4[0]; mu[j][4 * i + 1] = m4[1]; mu[j][4 * i + 2] = m4[2]; mu[j][4 * i + 3] = m4[3];
    }
  float hp[16], hc[16], hn[16];
  RowX xa, xb, xc;
  if (r0 > 0) { ld_row(p, r0 - 1, lane, xc); }
  ld_row(p, r0, lane, xa);
  if (r0 + 1 < NTOK) ld_row(p, r0 + 1, lane, xb);
  if (r0 > 0) fin_row(mod, g4, lane, xc, hp);
  else {
#pragma unroll
    for (int e = 0; e < 16; ++e) hp[e] = 0.f;
  }
  fin_row(mod, g4, lane, xa, hc);
  xa = xb;
  if (r0 + 2 < NTOK) ld_row(p, r0 + 2, lane, xb);
  for (int n = r0; n < r1; ++n) {
    const int t = n % TL;
    if (n + 3 < NTOK) ld_row(p, n + 3, lane, xc);
    if (n + 1 < NTOK) fin_row(mod, g4, lane, xa, hn);
    else {
#pragma unroll
      for (int e = 0; e < 16; ++e) hn[e] = 0.f;
    }
    const float fp = (t != 0 && t != T) ? 0.5f : 0.f, fn = (t != T - 1 && t != TL - 1) ? 0.5f : 0.f;
#pragma unroll
    for (int i = 0; i < 4; ++i) st_bf16x4_nt(H + (size_t)n * 1024 + i * 256 + lane * 4, hc[4 * i], hc[4 * i + 1], hc[4 * i + 2], hc[4 * i + 3]);
#pragma unroll
    for (int j = 0; j < 4; ++j) {
      bf16_t* dst = lerp_base(p, j, n) + (size_t)n * 1024 + lane * 4;
#pragma unroll
      for (int i = 0; i < 4; ++i) {
        float o[4];
#pragma unroll
        for (int e = 0; e < 4; ++e) { const float c = hc[4 * i + e]; o[e] = c + (fp * hp[4 * i + e] + fn * hn[4 * i + e] - c) * mu[j][4 * i + e]; }
        st_bf16x4_nt(dst + i * 256, o[0], o[1], o[2], o[3]);
      }
    }
#pragma unroll
    for (int e = 0; e < 16; ++e) { hp[e] = hc[e]; hc[e] = hn[e]; }
    xa = xb; xb = xc;
  }
}

__device__ void phase_final(float* out, const float* fg) {
  const int lane = threadIdx.x & 63, gw = blockIdx.x * 8 + (threadIdx.x >> 6), nw = gridDim.x * 8;
  f32x4 g4[4];
#pragma unroll
  for (int i = 0; i < 4; ++i) g4[i] = *(const f32x4*)(fg + i * 256 + lane * 4);
  f32x4 va[4], vb[4];
  if (gw < NB * T) {
#pragma unroll
    for (int i = 0; i < 4; ++i) va[i] = *(const f32x4*)(out + (size_t)gw * D + i * 256 + lane * 4); }
  for (int n = gw; n < NB * T; n += nw) {
    if (n + nw < NB * T) {
#pragma unroll
      for (int i = 0; i < 4; ++i) vb[i] = *(const f32x4*)(out + (size_t)(n + nw) * D + i * 256 + lane * 4); }
    float ss = 0.f;
#pragma unroll
    for (int i = 0; i < 4; ++i) ss += va[i][0] * va[i][0] + va[i][1] * va[i][1] + va[i][2] * va[i][2] + va[i][3] * va[i][3];
    ss = wave_sum(ss);
    const float rstd = rsqrtf(ss * (1.f / 1024.f) + 1e-6f);
#pragma unroll
    for (int i = 0; i < 4; ++i) {
      f32x4 o;
#pragma unroll
      for (int e = 0; e < 4; ++e) o[e] = va[i][e] * rstd * g4[i][e];
      *(f32x4*)(out + (size_t)n * D + i * 256 + lane * 4) = o;
    }
#pragma unroll
    for (int i = 0; i < 4; ++i) va[i] = vb[i];
  }
}

__device__ __forceinline__ int scan_row(int g, int d, int b) {
  if (g < L) { const int tt = d ? (L - 1 - g) : g; return b * TL + T + tt; }
  g -= L; const int tt = d ? (T - 1 - g) : g; return b * TL + tt;
}
constexpr int SC_P = 0, SC_ARA = 8192, SC_ARR = SC_ARA + 4096, SC_BK = SC_ARR + 4096, SC_SCAL = SC_BK + 8192, SC_VV = SC_SCAL + 1024, SC_BUF = SC_VV + 8192;
constexpr int SC_IC = 2 * SC_BUF, SC_SCR = SC_IC + 8192, SC_YB = SC_SCR + 16384, SC_END = SC_YB + 2 * 8192;
#define MFMA16(a, b, c) __builtin_amdgcn_mfma_f32_16x16x32_bf16((a), (b), (c), 0, 0, 0)
struct ScBlk { u32x4 aa0, aa1, ar0, ar1, k0, k1, k2, k3; f32x4 v; f32x4 s[8]; };
__device__ __forceinline__ void sc_ldb(ScBlk& c, const char* buf, int blk, int arOff, int bkOff, int vOff) {
  const char* pa = buf + SC_ARA + blk * 512 + arOff; const char* pr = buf + SC_ARR + blk * 512 + arOff;
  c.aa0 = *(const u32x4*)(pa); c.aa1 = *(const u32x4*)(pa + 64); c.ar0 = *(const u32x4*)(pr); c.ar1 = *(const u32x4*)(pr + 64);
  const char* bk = buf + SC_BK + blk * 1024 + bkOff;
  c.k0 = *(const u32x4*)(bk); c.k1 = *(const u32x4*)(bk + 256); c.k2 = *(const u32x4*)(bk + 512); c.k3 = *(const u32x4*)(bk + 768);
  c.v = *(const f32x4*)(buf + SC_VV + blk * 1024 + vOff);
  const char* sp = buf + SC_SCAL + blk * 128;
#pragma unroll
  for (int i = 0; i < 8; ++i) c.s[i] = *(const f32x4*)(sp + i * 16);
}
__device__ void phase_scan(const Params& p, char* lds) {
  unsigned char* ws = p.ws;
  const int tid = threadIdx.x, lane = tid & 63, wid = __builtin_amdgcn_readfirstlane(tid >> 6), r32 = lane & 31, hi = lane >> 5;
  const bf16_t* Rg = (const bf16_t*)(ws + OFF_R); const bf16_t* Kg = (const bf16_t*)(ws + OFF_K); const bf16_t* Vg = (const bf16_t*)(ws + OFF_V);
  const bf16_t* Lg = (const bf16_t*)(ws + OFF_LORA);
  constexpr int NCH = TL / 32;
  for (int sidx = blockIdx.x; sidx < 256; sidx += gridDim.x) {
    const int d = sidx >> 7, b = (sidx >> 4) & 7, h = sidx & 15;
    bf16_t* Yg = (bf16_t*)(ws + (d ? OFF_Y1 : OFF_Y0));
    if (wid < 4) {
      const int cw = wid, c16 = lane & 15, q = lane >> 4;
      const int arOff = (c16 & 3) * 128 + q * 16, wOff = q * 16, bkOff = c16 * 16, vOff = (cw * 16 + c16) * 16;
      f32x4 St0 = {0.f, 0.f, 0.f, 0.f}, St1 = St0, St2 = St0, St3 = St0;
      __syncthreads(); __syncthreads();
      for (int c = 0; c < NCH; ++c) {
        const char* buf = lds + (c & 1) * SC_BUF;
        char* yb = lds + SC_YB + (c & 1) * 8192 + (cw * 16 + c16) * 16;
        ScBlk cur; sc_ldb(cur, buf, 0, arOff, bkOff, vOff);
#pragma unroll 2
        for (int blk = 0; blk < 8; ++blk) {
          ScBlk nxt; sc_ldb(nxt, buf, (blk + 1) & 7, arOff, bkOff, vOff);
          u32x4 b1 = {cvtpk(St0[0], St0[1]), cvtpk(St0[2], St0[3]), cvtpk(St1[0], St1[1]), cvtpk(St1[2], St1[3])};
          u32x4 b2 = {cvtpk(St2[0], St2[1]), cvtpk(St2[2], St2[3]), cvtpk(St3[0], St3[1]), cvtpk(St3[2], St3[3])};
          f32x4 sr = {0.f, 0.f, 0.f, 0.f}, yr = sr;
          sr = MFMA16(*(bf16x8*)&cur.aa0, *(bf16x8*)&b1, sr); yr = MFMA16(*(bf16x8*)&cur.ar0, *(bf16x8*)&b1, yr);
          sr = MFMA16(*(bf16x8*)&cur.aa1, *(bf16x8*)&b2, sr); yr = MFMA16(*(bf16x8*)&cur.ar1, *(bf16x8*)&b2, yr);
          const float v1 = cur.v[0], v2 = cur.v[1], v3 = cur.v[2], v4 = cur.v[3];
          const f32x4 s0 = cur.s[0], s1 = cur.s[1], s2 = cur.s[2], s3 = cur.s[3], s4 = cur.s[4], s5 = cur.s[5], s6 = cur.s[6], s7 = cur.s[7];
          const float sa1 = sr[0];
          const float sa2 = sr[1] + s0[0] * sa1 + s1[2] * v1;
          const float sa3 = sr[2] + s0[1] * sa1 + s1[3] * v1 + s0[2] * sa2 + s2[0] * v2;
          const float sa4 = sr[3] + s0[3] * sa1 + s2[1] * v1 + s1[0] * sa2 + s2[2] * v2 + s1[1] * sa3 + s2[3] * v3;
          f32x4 y;
          y[0] = yr[0] + s3[0] * sa1 + s5[2] * v1;
          y[1] = yr[1] + s3[1] * sa1 + s5[3] * v1 + s3[2] * sa2 + s6[0] * v2;
          y[2] = yr[2] + s3[3] * sa1 + s6[1] * v1 + s4[0] * sa2 + s6[2] * v2 + s4[1] * sa3 + s6[3] * v3;
          y[3] = yr[3] + s4[2] * sa1 + s7[0] * v1 + s4[3] * sa2 + s7[1] * v2 + s5[0] * sa3 + s7[2] * v3 + s5[1] * sa4 + s7[3] * v4;
          u32x4 bu = {cvtpk(sa1, v1), cvtpk(sa2, v2), cvtpk(sa3, v3), cvtpk(sa4, v4)};
          if (q != 0) { bu[0] = 0u; bu[1] = 0u; bu[2] = 0u; bu[3] = 0u; }
          St0 = MFMA16(*(bf16x8*)&cur.k0, *(bf16x8*)&bu, St0);
          St1 = MFMA16(*(bf16x8*)&cur.k1, *(bf16x8*)&bu, St1);
          St2 = MFMA16(*(bf16x8*)&cur.k2, *(bf16x8*)&bu, St2);
          St3 = MFMA16(*(bf16x8*)&cur.k3, *(bf16x8*)&bu, St3);
          *(f32x4*)(yb + blk * 1024) = y;
          cur = nxt;
          if (blk == 7) {
            const char* pw = buf + SC_P + 31 * 256 + wOff;
            St0 *= *(const f32x4*)(pw); St1 *= *(const f32x4*)(pw + 64); St2 *= *(const f32x4*)(pw + 128); St3 *= *(const f32x4*)(pw + 192);
          }
          if (blk == 3 || blk == 7) __syncthreads();
        }
      }
    } else {
      const int pw = wid - 4, ptid = tid - 256;
      const int pstep = ptid >> 3, j0 = (ptid & 7) * 8, pblk = pstep >> 2, psb = pstep & 3;
      const int apos0 = (j0 >> 5) * 32 + (((j0 & 31) & 15) >> 2) * 8 + 4 * ((j0 & 31) >> 4), apos1 = apos0 + 8;
      float* Bg = (float*)(ws + OFF_BONUS) + (size_t)d * NTOK * 16;
      float kkc[8], kac[8], rkc[8];
#pragma unroll
      for (int e = 0; e < 8; ++e) { kkc[e] = p.in[15][h * 64 + j0 + e]; kac[e] = p.in[16][h * 64 + j0 + e]; rkc[e] = p.in[17][h * 64 + j0 + e]; }
      const int mat = pw >> 1, jh = pw & 1;
      bf16x8 w2f[4]; float bias;
      {
        const float* W2 = (mat ? p.in[14] : p.in[11]) + (size_t)d * 64 * 1024;
#pragma unroll
        for (int ks = 0; ks < 4; ++ks) {
          u32x4 w;
#pragma unroll
          for (int qq = 0; qq < 4; ++qq) {
            const int r0 = ks * 16 + 8 * hi + 2 * qq;
            w[qq] = cvtpk(W2[(size_t)r0 * 1024 + h * 64 + jh * 32 + r32], W2[(size_t)(r0 + 1) * 1024 + h * 64 + jh * 32 + r32]);
          }
          w2f[ks] = *(bf16x8*)&w;
        }
        bias = (mat ? p.in[12] : p.in[9])[d * 1024 + h * 64 + jh * 32 + r32];
      }
      u32x4 pR, pK, pV; bf16x8 pl[4];
      float kk[8], kr[8], rr[8];
      float* IC = (float*)(lds + SC_IC);
      bf16_t* SCR = (bf16_t*)(lds + SC_SCR);
      auto prefetch = [&](int c) {
        const size_t row = (size_t)scan_row(c * 32 + pstep, d, b) * 1024 + h * 64 + j0;
        pR = *(const u32x4*)(Rg + row); pK = *(const u32x4*)(Kg + row); pV = *(const u32x4*)(Vg + row);
        const size_t lrow = (size_t)scan_row(c * 32 + r32, d, b);
#pragma unroll
        for (int ks = 0; ks < 4; ++ks) pl[ks] = *(const bf16x8*)(Lg + lrow * 256 + mat * 128 + d * 64 + ks * 16 + hi * 8);
      };
      auto stageA = [&](int c) {
        char* buf = lds + (c & 1) * SC_BUF;
        float* Pd = (float*)(buf + SC_P); float* VV = (float*)(buf + SC_VV);
        f32x16 acc;
#pragma unroll
        for (int r = 0; r < 16; ++r) acc[r] = 0.f;
#pragma unroll
        for (int ks = 0; ks < 4; ++ks) acc = MFMA(pl[ks], w2f[ks], acc);
        if (mat == 0) {
          float cc[16];
#pragma unroll
          for (int r = 0; r < 16; ++r) cc[r] = -0.6065306597126334f * __builtin_amdgcn_rcpf(1.f + __expf(-(acc[r] + bias)));
#pragma unroll
          for (int g = 0; g < 4; ++g) { cc[4 * g + 1] += cc[4 * g]; cc[4 * g + 2] += cc[4 * g + 1]; cc[4 * g + 3] += cc[4 * g + 2]; }
          float run = 0.f;
#pragma unroll
          for (int g = 0; g < 4; ++g) {
            const float own = cc[4 * g + 3];
            auto rr2 = __builtin_amdgcn_permlane32_swap(__float_as_uint(own), __float_as_uint(own), false, false);
            const float both = __uint_as_float(rr2[0]) + __uint_as_float(rr2[1]), partner = both - own;
            const float off = hi ? run + partner : run;
#pragma unroll
            for (int e = 0; e < 4; ++e) Pd[crow(4 * g + e, hi) * 64 + jh * 32 + r32] = __expf(off + cc[4 * g + e]);
            run += both;
          }
        } else {
#pragma unroll
          for (int r = 0; r < 16; ++r) IC[crow(r, hi) * 64 + jh * 32 + r32] = __builtin_amdgcn_rcpf(1.f + __expf(-(acc[r] + bias)));
        }
        float ss = 0.f;
#pragma unroll
        for (int w = 0; w < 4; ++w) {
          rr[2 * w] = lo16(pR[w]); rr[2 * w + 1] = hi16(pR[w]);
          kr[2 * w] = lo16(pK[w]); kr[2 * w + 1] = hi16(pK[w]);
        }
        const float vv[8] = {lo16(pV[0]), hi16(pV[0]), lo16(pV[1]), hi16(pV[1]), lo16(pV[2]), hi16(pV[2]), lo16(pV[3]), hi16(pV[3])};
        if (c + 1 < NCH) prefetch(c + 1);
#pragma unroll
        for (int e = 0; e < 8; ++e) VV[(pblk * 64 + j0 + e) * 4 + psb] = vv[e];
#pragma unroll
        for (int e = 0; e < 8; ++e) { kk[e] = kr[e] * kkc[e]; ss += kk[e] * kk[e]; }
        ss = red8(ss);
        const float inv = rsqrtf(fmaxf(ss, 1e-24f));
#pragma unroll
        for (int e = 0; e < 8; ++e) kk[e] *= inv;
      };
      auto stageB = [&](int c) {
        char* buf = lds + (c & 1) * SC_BUF;
        const f32x4 i0 = *(const f32x4*)(IC + pstep * 64 + j0), i1 = *(const f32x4*)(IC + pstep * 64 + j0 + 4);
        const float ic[8] = {i0[0], i0[1], i0[2], i0[3], i1[0], i1[1], i1[2], i1[3]};
        const float* Pt = (const float*)(buf + SC_P) + pstep * 64 + j0;
        const f32x4 pt0 = *(const f32x4*)(Pt), pt1 = *(const f32x4*)(Pt + 4);
        f32x4 pm0 = {1.f, 1.f, 1.f, 1.f}, pm1 = pm0;
        if (pstep > 0) { pm0 = *(const f32x4*)(Pt - 64); pm1 = *(const f32x4*)(Pt - 60); }
        const float pt[8] = {pt0[0], pt0[1], pt0[2], pt0[3], pt1[0], pt1[1], pt1[2], pt1[3]};
        const float pm[8] = {pm0[0], pm0[1], pm0[2], pm0[3], pm1[0], pm1[1], pm1[2], pm1[3]};
        const u32x4 an = {cvtpk(-kk[0] * pm[0], -kk[1] * pm[1]), cvtpk(-kk[2] * pm[2], -kk[3] * pm[3]), cvtpk(-kk[4] * pm[4], -kk[5] * pm[5]), cvtpk(-kk[6] * pm[6], -kk[7] * pm[7])};
        const u32x4 rn = {cvtpk(rr[0] * pt[0], rr[1] * pt[1]), cvtpk(rr[2] * pt[2], rr[3] * pt[3]), cvtpk(rr[4] * pt[4], rr[5] * pt[5]), cvtpk(rr[6] * pt[6], rr[7] * pt[7])};
        bf16_t* ARa = (bf16_t*)(buf + SC_ARA) + (pblk * 4 + psb) * 64; bf16_t* ARr = (bf16_t*)(buf + SC_ARR) + (pblk * 4 + psb) * 64;
        { u32x2 lo = {an[0], an[1]}, hi2 = {an[2], an[3]}; *(u32x2*)(ARa + apos0) = lo; *(u32x2*)(ARa + apos1) = hi2; }
        { u32x2 lo = {rn[0], rn[1]}, hi2 = {rn[2], rn[3]}; *(u32x2*)(ARr + apos0) = lo; *(u32x2*)(ARr + apos1) = hi2; }
        *(u32x4*)(SCR + (pstep * 4 + 0) * 64 + j0) = an; *(u32x4*)(SCR + (pstep * 4 + 1) * 64 + j0) = rn;
        float bs = 0.f;
        unsigned bq[8], kq[8];
        unsigned* BK = (unsigned*)(buf + SC_BK) + (pblk * 64 + j0) * 4 + psb;
#pragma unroll
        for (int e = 0; e < 8; ++e) {
          const float kd = kr[e] * (1.f + (ic[e] - 1.f) * kac[e]);
          const float ip = __builtin_amdgcn_rcpf(pt[e]);
          const unsigned pr2 = cvtpk(kk[e] * ic[e] * ip, kd * ip);
          BK[e * 4] = pr2;
          bq[e] = pr2 & 0xffffu; kq[e] = pr2 >> 16;
          bs += rr[e] * kd * rkc[e];
        }
        const u32x4 bn = {bq[0] | (bq[1] << 16), bq[2] | (bq[3] << 16), bq[4] | (bq[5] << 16), bq[6] | (bq[7] << 16)};
        const u32x4 kn = {kq[0] | (kq[1] << 16), kq[2] | (kq[3] << 16), kq[4] | (kq[5] << 16), kq[6] | (kq[7] << 16)};
        *(u32x4*)(SCR + (pstep * 4 + 2) * 64 + j0) = bn; *(u32x4*)(SCR + (pstep * 4 + 3) * 64 + j0) = kn;
        bs = red8(bs);
        if ((ptid & 7) == 0) Bg[(size_t)scan_row(c * 32 + pstep, d, b) * 16 + h] = bs;
      };
      auto stageC = [&](int c) {
        char* buf = lds + (c & 1) * SC_BUF;
        asm volatile("s_waitcnt lgkmcnt(0)" ::: "memory");
        const int n16 = lane & 15, q4 = lane >> 4;
        const int stepA = (2 * pw + (n16 >> 3)) * 4 + (n16 & 3);
        const bf16_t* Xr = SCR + (stepA * 4 + 2 + ((n16 >> 2) & 1)) * 64 + q4 * 8;
        const bf16_t* Yc = SCR + (stepA * 4 + ((n16 >> 2) & 1)) * 64 + q4 * 8;
        f32x4 g = {0.f, 0.f, 0.f, 0.f};
        g = MFMA16(*(const bf16x8*)(Xr), *(const bf16x8*)(Yc), g);
        g = MFMA16(*(const bf16x8*)(Xr + 32), *(const bf16x8*)(Yc + 32), g);
        const int ctype = (n16 >> 2) & 1, t0 = n16 & 3, rtype = q4 & 1;
        const int grp = ctype * 2 + rtype, base = grp == 0 ? 0 : (grp == 1 ? 6 : (grp == 2 ? 12 : 22));
        float* sc = (float*)(buf + SC_SCAL) + (2 * pw + (n16 >> 3)) * 32 + base + (ctype ? (t0 + 1) * t0 / 2 : t0 * (t0 - 1) / 2);
        if ((q4 >> 1) == (n16 >> 3)) {
#pragma unroll
          for (int e = 0; e < 4; ++e) if (ctype ? (e <= t0) : (e < t0)) sc[e] = g[e];
        }
      };
      auto writeout = [&](int c) {
        const float* Yb = (const float*)(lds + SC_YB + (c & 1) * 8192) + (pblk * 64 + j0) * 4 + psb;
        u32x4 w = {cvtpk(Yb[0], Yb[4]), cvtpk(Yb[8], Yb[12]), cvtpk(Yb[16], Yb[20]), cvtpk(Yb[24], Yb[28])};
        *(u32x4*)(Yg + (size_t)scan_row(c * 32 + pstep, d, b) * 1024 + h * 64 + j0) = w;
      };
      prefetch(0);
      stageA(0);
      __syncthreads();
      stageB(0); stageC(0);
      __syncthreads();
      for (int c = 0; c < NCH; ++c) {
        if (c >= 1) writeout(c - 1);
        if (c + 1 < NCH) stageA(c + 1);
        __syncthreads();
        if (c + 1 < NCH) { stageB(c + 1); stageC(c + 1); }
        __syncthreads();
      }
      writeout(NCH - 1);
    }
    __syncthreads();
  }
}

__device__ void phase_readout(const Params& p) {
  unsigned char* ws = p.ws;
  const bf16_t* Y0 = (const bf16_t*)(ws + OFF_Y0); const bf16_t* Y1 = (const bf16_t*)(ws + OFF_Y1); const bf16_t* Vg = (const bf16_t*)(ws + OFF_V);
  bf16_t* G = (bf16_t*)(ws + OFF_G);
  const float* B0 = (const float*)(ws + OFF_BONUS); const float* B1 = B0 + (size_t)NTOK * 16;
  const int lane = threadIdx.x & 63, gw = blockIdx.x * 8 + (threadIdx.x >> 6), nw = gridDim.x * 8;
  const int c0 = lane * 16, hd = lane >> 2;
  float lg[16], lb[16];
#pragma unroll
  for (int e = 0; e < 16; ++e) { lg[e] = p.in[18][c0 + e]; lb[e] = p.in[19][c0 + e]; }
  struct RowIn { u32x4 a[2], b[2], v[2], g[2]; float b0, b1; };
  auto ldr = [&](int n, RowIn& r) {
    const size_t o = (size_t)n * 1024 + c0;
#pragma unroll
    for (int q = 0; q < 2; ++q) { r.a[q] = *(const u32x4*)(Y0 + o + 8 * q); r.b[q] = *(const u32x4*)(Y1 + o + 8 * q); r.v[q] = *(const u32x4*)(Vg + o + 8 * q); r.g[q] = *(const u32x4*)(G + o + 8 * q); }
    r.b0 = B0[(size_t)n * 16 + hd]; r.b1 = B1[(size_t)n * 16 + hd];
  };
  RowIn cur, nxt;
  if (gw < NTOK) ldr(gw, cur);
  for (int n = gw; n < NTOK; n += nw) {
    if (n + nw < NTOK) ldr(n + nw, nxt);
    const size_t o = (size_t)n * 1024 + c0;
    float y[16], v[16], g[16];
#pragma unroll
    for (int q = 0; q < 2; ++q) {
#pragma unroll
      for (int w = 0; w < 4; ++w) {
        y[8 * q + 2 * w] = lo16(cur.a[q][w]) + lo16(cur.b[q][w]); y[8 * q + 2 * w + 1] = hi16(cur.a[q][w]) + hi16(cur.b[q][w]);
        v[8 * q + 2 * w] = lo16(cur.v[q][w]); v[8 * q + 2 * w + 1] = hi16(cur.v[q][w]);
        g[8 * q + 2 * w] = lo16(cur.g[q][w]); g[8 * q + 2 * w + 1] = hi16(cur.g[q][w]);
      }
    }
    float s = 0.f;
#pragma unroll
    for (int e = 0; e < 16; ++e) s += y[e];
    s += dpp_f(s, 0); s += dpp_f(s, 1);
    const float mean = s * (1.f / 64.f);
    float q2 = 0.f;
#pragma unroll
    for (int e = 0; e < 16; ++e) { const float dlt = y[e] - mean; q2 += dlt * dlt; }
    q2 += dpp_f(q2, 0); q2 += dpp_f(q2, 1);
    const float rs = rsqrtf(q2 * (1.f / 64.f) + 64e-5f);
    const float bonus = cur.b0 + cur.b1;
    float r[16];
#pragma unroll
    for (int e = 0; e < 16; ++e) {
      const float yn = (y[e] - mean) * rs * lg[e] + lb[e];
      r[e] = (yn + bonus * v[e]) * (g[e] * sigmoidf_(g[e]));
    }
    u32x4 w0 = {cvtpk(r[0], r[1]), cvtpk(r[2], r[3]), cvtpk(r[4], r[5]), cvtpk(r[6], r[7])};
    u32x4 w1 = {cvtpk(r[8], r[9]), cvtpk(r[10], r[11]), cvtpk(r[12], r[13]), cvtpk(r[14], r[15])};
    *(u32x4*)(G + o) = w0; *(u32x4*)(G + o + 8) = w1;
    cur = nxt;
  }
}

constexpr int AT_SHMV = 16384, AT_KROW = 208, AT_SHMK = 64 * AT_KROW;
constexpr int AT_KOFF = 2 * AT_SHMV, AT_WOFF = AT_KOFF + 2 * AT_SHMK;
#define SBAR() __builtin_amdgcn_sched_barrier(0)
__device__ __forceinline__ void at_partialSM(f32x16& p0, f32x16& p1, float& m_reg, float& alpha, bool force) {
  float pm = p0[0];
#pragma unroll
  for (int r = 1; r < 16; ++r) pm = fmaxf(pm, p0[r]);
#pragma unroll
  for (int r = 0; r < 16; ++r) pm = fmaxf(pm, p1[r]);
  { auto rr = __builtin_amdgcn_permlane32_swap(__float_as_uint(pm), __float_as_uint(pm), false, false);
    pm = fmaxf(__uint_as_float(rr[0]), __uint_as_float(rr[1])); }
  if (__builtin_expect(!force && __all(pm <= AT_THR * 1.4426950408889634f), 1)) { alpha = 1.f; }
  else {
    const float dlt = force ? pm : fmaxf(pm, 0.f);
    alpha = force ? 1.f : __builtin_amdgcn_exp2f(-dlt); m_reg += dlt;
#pragma unroll
    for (int r = 0; r < 16; ++r) { p0[r] -= dlt; p1[r] -= dlt; }
  }
#pragma unroll
  for (int r = 0; r < 16; ++r) p0[r] = __builtin_amdgcn_exp2f(p0[r]);
}
__device__ __forceinline__ void at_finishSM(f32x16& p0, f32x16& p1, float alpha, float& l_reg, bf16x8& pa0, bf16x8& pa1, bf16x8& pa2, bf16x8& pa3) {
#pragma unroll
  for (int r = 0; r < 16; ++r) p1[r] = __builtin_amdgcn_exp2f(p1[r]);
  float ps = 0;
#pragma unroll
  for (int r = 0; r < 16; ++r) ps += p0[r];
#pragma unroll
  for (int r = 0; r < 16; ++r) ps += p1[r];
  { auto rr = __builtin_amdgcn_permlane32_swap(__float_as_uint(ps), __float_as_uint(ps), false, false);
    ps = __uint_as_float(rr[0]) + __uint_as_float(rr[1]); }
  l_reg = l_reg * alpha + ps;
#define PK4(P, BASE, OUT) do { unsigned a0 = cvtpk(P[BASE + 0], P[BASE + 1]), a1 = cvtpk(P[BASE + 2], P[BASE + 3]);   \
    unsigned b0 = cvtpk(P[BASE + 4], P[BASE + 5]), b1 = cvtpk(P[BASE + 6], P[BASE + 7]);                              \
    auto r0 = __builtin_amdgcn_permlane32_swap(a0, b0, false, false); auto r1 = __builtin_amdgcn_permlane32_swap(a1, b1, false, false); \
    u32x4 w = {r0[0], r1[0], r0[1], r1[1]}; OUT = *reinterpret_cast<bf16x8*>(&w); } while (0)
  PK4(p0, 0, pa0); PK4(p0, 8, pa1); PK4(p1, 0, pa2); PK4(p1, 8, pa3);
#undef PK4
}
__device__ __forceinline__ void at_qkt(f32x16& p0, f32x16& p1, const char* Ks, const bf16x8* qr, int r32, int hi, float negm) {
#pragma unroll
  for (int r = 0; r < 16; ++r) { p0[r] = negm; p1[r] = negm; }
#pragma unroll
  for (int d0 = 0; d0 < 6; ++d0) {
    const bf16x8 b0 = *(const bf16x8*)(Ks + r32 * AT_KROW + d0 * 32 + hi * 16);
    const bf16x8 b1 = *(const bf16x8*)(Ks + (32 + r32) * AT_KROW + d0 * 32 + hi * 16);
    p0 = MFMA(b0, qr[d0], p0);
    p1 = MFMA(b1, qr[d0], p1);
  }
}
__device__ __forceinline__ int v_st(int k, int c) { const int kk = (k & ~0xC) | ((k & 4) << 1) | ((k & 8) >> 1); return ((kk >> 3) * 4 + (c >> 5)) * 512 + ((kk & 7) * 32 + (c & 31)) * 2; }
__device__ __forceinline__ int v_rd_base(int lane) { return ((lane & 3) << 3) | (((lane >> 2) & 3) << 6) | (((lane >> 4) & 1) << 5) | (((lane >> 5) & 1) << 8); }
constexpr int v_rd_off(int d0, int ks, int half) { return d0 * 512 + ks * 4096 + half * 2048; }
template <int OFF> __device__ __forceinline__ s16x4 tr_read(int vb) {
  s16x4 r; asm volatile("ds_read_b64_tr_b16 %0, %1 offset:%2" : "=&v"(r) : "v"(vb), "i"(OFF) : "memory"); return r;
}
template <int D0> __device__ __forceinline__ void pv_one(f32x16& od, int vb, bf16x8 pa0, bf16x8 pa1, bf16x8 pa2, bf16x8 pa3) {
  const s16x4 l0 = tr_read<v_rd_off(D0, 0, 0)>(vb), h0 = tr_read<v_rd_off(D0, 0, 1)>(vb), l1 = tr_read<v_rd_off(D0, 1, 0)>(vb), h1 = tr_read<v_rd_off(D0, 1, 1)>(vb);
  const s16x4 l2 = tr_read<v_rd_off(D0, 2, 0)>(vb), h2 = tr_read<v_rd_off(D0, 2, 1)>(vb), l3 = tr_read<v_rd_off(D0, 3, 0)>(vb), h3 = tr_read<v_rd_off(D0, 3, 1)>(vb);
  asm volatile("s_waitcnt lgkmcnt(0)" ::: "memory"); SBAR();
#define PK(Lx, Hx) (bf16x8){Lx[0], Lx[1], Lx[2], Lx[3], Hx[0], Hx[1], Hx[2], Hx[3]}
  od = MFMA(pa0, PK(l0, h0), od);
  od = MFMA(pa1, PK(l1, h1), od);
  od = MFMA(pa2, PK(l2, h2), od);
  od = MFMA(pa3, PK(l3, h3), od);
#undef PK
}
__device__ __forceinline__ void pv_d0(f32x16* o, int vb, bf16x8 pa0, bf16x8 pa1, bf16x8 pa2, bf16x8 pa3) {
  pv_one<0>(o[0], vb, pa0, pa1, pa2, pa3); pv_one<1>(o[1], vb, pa0, pa1, pa2, pa3);
}

__device__ void phase_attn(const Params& p, char* lds) {
  unsigned char* ws = p.ws;
  const bf16_t* Qg = (const bf16_t*)(ws + OFF_Q); const bf16_t* KVg = (const bf16_t*)(ws + OFF_KV); const bf16_t* KPg = (const bf16_t*)(ws + OFF_KPE);
  bf16_t* G1 = (bf16_t*)(ws + OFF_G1);
  const f32x2* rope = (const f32x2*)(ws + OFF_ROPE);
  const int tid = threadIdx.x, wid = tid >> 6, lane = tid & 63, r32 = lane & 31, hi = lane >> 5;
  char* V_lds = lds; char* K_lds = lds + AT_KOFF;
  float* wsl = (float*)(lds + AT_WOFF) + wid * 64; float* li_l = wsl; float* al_l = wsl + 32;
  const int skey = tid >> 3, sc8 = (tid & 7) * 8;
  const int pkey = (tid & 255) >> 2, pc8 = (tid & 3) * 8;
  const int vst = v_st(skey, sc8), kst = skey * AT_KROW + sc8 * 2, pst = pkey * AT_KROW + (64 + pc8) * 2;
  const int vb0 = (int)(uintptr_t)V_lds + v_rd_base(lane);
  const int nitems = NB * 16 * 32;
  const int xcd = blockIdx.x & 7, slot = blockIdx.x >> 3, per = gridDim.x >> 3;
  for (int it = slot; it < nitems / 8; it += per) {
    const int pair = (it >> 5) * 8 + xcd, qblk = it & 31;
    const int b = pair >> 4, h = pair & 15;
    const size_t row0 = (size_t)b * TL;
    const size_t qrow = row0 + qblk * 256 + wid * 32 + r32;
    const bf16_t* Kh = KVg + row0 * 2048 + h * 128;
    const bf16_t* Kp = KPg + row0 * 32;
    float m_reg = 0.f, l_reg = 0.f;
    f32x16 o[2];
#pragma unroll
    for (int dd = 0; dd < 2; ++dd)
#pragma unroll
      for (int r = 0; r < 16; ++r) o[dd][r] = 0.f;
    bf16x8 qr[6];
    {
      const bf16_t* Qw = Qg + qrow * 1536 + h * 96 + hi * 8;
#pragma unroll
      for (int d0 = 0; d0 < 6; ++d0) qr[d0] = *(const bf16x8*)(Qw + d0 * 16);
      const int t = qblk * 256 + wid * 32 + r32;
      const f32x2* tb = rope + (hi ? (t & 63) : (t >> 6)) * 8;
      const u32x4 x1 = *(const u32x4*)&qr[4], x2 = *(const u32x4*)&qr[5];
      u32x4 n1, n2;
#pragma unroll
      for (int q = 0; q < 4; ++q) {
        const f32x2 csA = tb[2 * q], csB = tb[2 * q + 1];
        const float a0 = lo16(x1[q]), a1 = hi16(x1[q]), b0 = lo16(x2[q]), b1 = hi16(x2[q]);
        n1[q] = cvtpk(a0 * csA[0] - b0 * csA[1], a1 * csB[0] - b1 * csB[1]);
        n2[q] = cvtpk(a0 * csA[1] + b0 * csA[0], a1 * csB[1] + b1 * csB[0]);
      }
      qr[4] = *(bf16x8*)&n1; qr[5] = *(bf16x8*)&n2;
    }
    struct { bf16x8 vs, ks, ps; } sr_[2];
#define SLOAD(i, k0) do { sr_[i].vs = *(const bf16x8*)(Kh + (size_t)((k0) + skey) * 2048 + 64 + sc8); \
    sr_[i].ks = *(const bf16x8*)(Kh + (size_t)((k0) + skey) * 2048 + sc8); \
    sr_[i].ps = *(const bf16x8*)(Kp + (size_t)((k0) + pkey) * 32 + pc8); } while (0)
#define SWRITE(bb, i) do { *(bf16x8*)(V_lds + (bb) * AT_SHMV + vst) = sr_[i].vs; \
    *(bf16x8*)(K_lds + (bb) * AT_SHMK + kst) = sr_[i].ks; \
    *(bf16x8*)(K_lds + (bb) * AT_SHMK + pst) = sr_[i].ps; } while (0)
#define SWAIT() asm volatile("s_waitcnt vmcnt(3)" ::: "memory")
#define RESC(a) do { if (__any((a) < 1.f)) { if (hi == 0) al_l[r32] = (a); asm volatile("s_waitcnt lgkmcnt(0)" ::: "memory"); \
    _Pragma("unroll") for (int dd = 0; dd < 2; ++dd) _Pragma("unroll") for (int r = 0; r < 16; ++r) o[dd][r] *= al_l[crow(r, hi)]; } } while (0)
    f32x16 pA0, pA1, pB0, pB1; float alA, alB; bf16x8 pa0, pa1, pa2, pa3;
    constexpr int NT = TL / 64;
    SLOAD(0, 0); asm volatile("s_waitcnt vmcnt(0)" ::: "memory"); SWRITE(0, 0); __syncthreads();
    at_qkt(pA0, pA1, K_lds, qr, r32, hi, 0.f); at_partialSM(pA0, pA1, m_reg, alA, true);
    SLOAD(1, 64); SLOAD(0, 128);
    SWAIT(); SWRITE(1, 1); __syncthreads();
    for (int j = 1; j + 1 < NT; j += 2) {
      SBAR(); at_qkt(pB0, pB1, K_lds + AT_SHMK, qr, r32, hi, -m_reg);
      at_finishSM(pA0, pA1, alA, l_reg, pa0, pa1, pa2, pa3); SBAR();
      SLOAD(1, (j + 2) * 64); SBAR();
      pv_d0(o, vb0, pa0, pa1, pa2, pa3); at_partialSM(pB0, pB1, m_reg, alB, false);
      __syncthreads(); SWAIT(); SWRITE(0, 0);
      RESC(alB); __syncthreads();
      SBAR(); at_qkt(pA0, pA1, K_lds, qr, r32, hi, -m_reg);
      at_finishSM(pB0, pB1, alB, l_reg, pa0, pa1, pa2, pa3); SBAR();
      if (j + 3 < NT) SLOAD(0, (j + 3) * 64); SBAR();
      pv_d0(o, vb0 + AT_SHMV, pa0, pa1, pa2, pa3); at_partialSM(pA0, pA1, m_reg, alA, false);
      __syncthreads(); SWAIT(); SWRITE(1, 1);
      RESC(alA); __syncthreads();
    }
    SBAR(); at_qkt(pB0, pB1, K_lds + AT_SHMK, qr, r32, hi, -m_reg);
    at_finishSM(pA0, pA1, alA, l_reg, pa0, pa1, pa2, pa3); SBAR();
    pv_d0(o, vb0, pa0, pa1, pa2, pa3); at_partialSM(pB0, pB1, m_reg, alB, false);
    __syncthreads(); RESC(alB);
    at_finishSM(pB0, pB1, alB, l_reg, pa0, pa1, pa2, pa3); SBAR();
    pv_d0(o, vb0 + AT_SHMV, pa0, pa1, pa2, pa3);
    if (hi == 0) li_l[r32] = l_reg;
    asm volatile("s_waitcnt lgkmcnt(0)" ::: "memory");
    float rli[16];
#pragma unroll
    for (int r = 0; r < 16; ++r) rli[r] = __builtin_amdgcn_rcpf(li_l[crow(r, hi)]);
    bf16_t* Gw = G1 + (row0 + qblk * 256 + wid * 32) * 1024 + h * 64 + r32;
    bf16_t gin[32];
#pragma unroll
    for (int r = 0; r < 16; ++r) { gin[2 * r] = Gw[(size_t)crow(r, hi) * 1024]; gin[2 * r + 1] = Gw[(size_t)crow(r, hi) * 1024 + 32]; }
    asm volatile("" ::: "memory");
#pragma unroll
    for (int r = 0; r < 16; ++r) {
      const int orow = crow(r, hi);
#pragma unroll
      for (int d0 = 0; d0 < 2; ++d0) {
        const float gt = bf2f(gin[2 * r + d0]);
        Gw[(size_t)orow * 1024 + d0 * 32] = f2bf(o[d0][r] * rli[r] * gt * sigmoidf_(gt));
      }
    }
    __syncthreads();
#undef SLOAD
#undef SWRITE
#undef SWAIT
#undef RESC
  }
}

struct XcdWalk {
  int start, count, step, idx;
  __device__ __forceinline__ void init(int ntiles) {
    const int x = blockIdx.x & 7, base = ntiles >> 3, rem = ntiles & 7;
    count = base + (x < rem ? 1 : 0); start = x * base + (x < rem ? x : rem); step = gridDim.x >> 3; idx = blockIdx.x >> 3;
  }
  __device__ __forceinline__ bool next(int& o) { if (idx >= count) return false; o = start + idx; idx += step; return true; }
  __device__ __forceinline__ bool next_full(int& o) { const int full = (count / step) * step; if (idx >= full) return false; o = start + idx; idx += step; return true; }
  __device__ __forceinline__ bool tail(int& o, int& half) const {
    const int full = (count / step) * step, rem = count - full, sl = blockIdx.x >> 3;
    if (2 * rem <= step) { if (sl >= 2 * rem) return false; o = start + full + (sl >> 1); half = sl & 1; return true; }
    if (sl >= rem) return false; o = start + full + sl; half = -1; return true;
  }
};
__device__ __forceinline__ void tile_mn(int o, int NT, int& mt, int& nt) { const int g = o >> 3; mt = (g / NT) * 8 + (o & 7); nt = g % NT; }

__global__ __launch_bounds__(NTHR, 1) void fwd_megakernel(Params p) {
  extern __shared__ __attribute__((aligned(16))) char lds[];
  cg::grid_group grid = cg::this_grid();
  unsigned char* ws = p.ws;
  bf16_t* H = (bf16_t*)(ws + OFF_H);
  float* mod = (float*)(ws + OFF_MOD);
  float* CTX1 = (float*)(ws + OFF_CTX1);

  phase_prologue(p, lds);
  grid.sync();
  phase_norm_lerp(p, mod);
  phase_weights(p, lds);
  grid.sync();
  {
    const bf16_t* WIN0 = (const bf16_t*)(ws + OFF_WIN0);
    const int nbig = 264 * 16;
    XcdWalk wk; wk.init(nbig); int o, half;
    auto big = [&](int oo, int hf) {
      EpiBf16 e; e.invK = 0.f; e.scr = lds + G_EPI_SCR;
      int mt, jn; tile_mn(oo, 16, mt, jn);
      const int j = jn >> 2, n4 = jn & 3, m0 = mt * 256, c0 = n4 * 256 + (hf > 0 ? 128 : 0);
      e.dst = (bf16_t*)(ws + OFF_R + (size_t)j * U); e.ldd = 1024; e.col0 = c0; e.act = 0; e.m0 = m0;
      if (hf < 0) gemm_tile<0, 256>(lerp_base(p, j, m0), 1024, WIN0 + (size_t)(j * 1024 + c0) * 1024, 1024, m0, nullptr, lds, e);
      else gemm_tile<0, 128>(lerp_base(p, j, m0), 1024, WIN0 + (size_t)(j * 1024 + c0) * 1024, 1024, m0, nullptr, lds, e);
    };
    while (wk.next_full(o)) big(o, -1);
    if (wk.tail(o, half)) big(o, half);
    wk.init(264 * 2);
    while (wk.next(o)) {
      EpiBf16 e; e.invK = 0.f; e.scr = lds + G_EPI_SCR;
      {
        int mt, n2; tile_mn(o, 2, mt, n2);
        const int nt = 32 + n2, m0 = mt * 256;
        e.dst = (bf16_t*)(ws + OFF_LORA); e.ldd = 256; e.col0 = (nt - 32) * 128; e.act = (nt == 32) ? 1 : 0; e.m0 = m0;
        gemm_tile<1, 128>(H, 1024, WIN0 + (size_t)nt * 128 * 1024, 1024, m0, p.in[7] + (nt - 28) * 1024, lds, e);
      }
    }
  }
  grid.sync();
  phase_scan(p, lds);
  grid.sync();
  phase_readout(p);
  grid.sync();
  {
    const bf16_t* A = (const bf16_t*)(ws + OFF_G); const bf16_t* W = (const bf16_t*)(ws + OFF_WOUT0);
    XcdWalk wk; wk.init(264 * 4); int o, half;
    auto tile5 = [&](int oo, int hf) {
      int mt, nt; tile_mn(oo, 4, mt, nt);
      const int m0 = mt * 256;
      const int b = m0 / TL, t0 = m0 - b * TL;
      EpiResid e;
      if (t0 < T) { const size_t orow = (size_t)b * T + t0; e.xin = p.in[0] + orow * 1024; e.xout = p.out + orow * 1024; e.gvec = mod + (size_t)b * 3072 + 2048; }
      else { const size_t orow = (size_t)b * L + (t0 - T); e.xin = p.in[2] + orow * 1024; e.xout = CTX1 + orow * 1024; e.gvec = mod + (size_t)8 * 3072 + 2048; }
      e.n0 = nt * 256 + (hf > 0 ? 128 : 0); e.scr = lds + G_EPI_SCR;
      if (hf < 0) gemm_tile<0, 256>(A, 1024, W + (size_t)e.n0 * 1024, 1024, m0, nullptr, lds, e);
      else gemm_tile<0, 128>(A, 1024, W + (size_t)e.n0 * 1024, 1024, m0, nullptr, lds, e);
    };
    while (wk.next_full(o)) tile5(o, -1);
    if (wk.tail(o, half)) tile5(o, half);
  }
  grid.sync();
  phase_norm(p.out, CTX1, p.in[4] + 1024, mod + 9 * 3072, H);
  grid.sync();
  {
    const bf16_t* W = (const bf16_t*)(ws + OFF_WIN1);
    XcdWalk wk; wk.init(264 * 7); int o, half;
    auto tile7 = [&](int oo, int hf) {
      int mt, nt; tile_mn(oo, 7, mt, nt);
      const int m0 = mt * 256;
      EpiMlaIn e; e.QC = (bf16_t*)(ws + OFF_QC); e.KVC = (bf16_t*)(ws + OFF_KVC); e.KPE = (bf16_t*)(ws + OFF_KPE); e.G1 = (bf16_t*)(ws + OFF_G1);
      e.rope = (const float*)(ws + OFF_ROPE); e.n0 = nt * 256 + (hf > 0 ? 128 : 0); e.m0 = m0; e.scr = lds + G_EPI_SCR;
      if (hf < 0) gemm_tile<0, 256>(H, 1024, W + (size_t)e.n0 * 1024, 1024, m0, nullptr, lds, e);
      else gemm_tile<0, 128>(H, 1024, W + (size_t)e.n0 * 1024, 1024, m0, nullptr, lds, e);
    };
    while (wk.next_full(o)) tile7(o, -1);
    if (wk.tail(o, half)) tile7(o, half);
  }
  grid.sync();
  {
    const bf16_t* WQ = (const bf16_t*)(ws + OFF_WQB); const bf16_t* WKV = (const bf16_t*)(ws + OFF_WKVB);
    const int nq = 256 * 6, nkv = 264 * 8;
    XcdWalk wk; wk.init(nq); int o;
    while (wk.next(o)) {
      EpiBf16 e; e.act = 0; e.scr = lds + G_EPI_SCR;
      {
        int mt2, nt; tile_mn(o, 6, mt2, nt);
        const int b = mt2 >> 5, m0 = b * TL + (mt2 & 31) * 256;
        e.dst = (bf16_t*)(ws + OFF_Q); e.ldd = 1536; e.col0 = nt * 256; e.m0 = m0; e.invK = 1.f / 384.f;
        gemm_tile<2, 256>((const bf16_t*)(ws + OFF_QC), 384, WQ + (size_t)nt * 256 * 384, 384, m0, nullptr, lds, e);
      }
    }
    wk.init(nkv);
    while (wk.next(o)) {
      EpiBf16 e; e.act = 0; e.scr = lds + G_EPI_SCR;
      {
        int mt, nt; tile_mn(o, 8, mt, nt);
        const int m0 = mt * 256;
        e.dst = (bf16_t*)(ws + OFF_KV); e.ldd = 2048; e.col0 = nt * 256; e.m0 = m0; e.invK = 1.f / 256.f;
        gemm_tile<2, 256>((const bf16_t*)(ws + OFF_KVC), 256, WKV + (size_t)nt * 256 * 256, 256, m0, nullptr, lds, e);
      }
    }
  }
  grid.sync();
  phase_attn(p, lds);
  grid.sync();
  {
    const bf16_t* A = (const bf16_t*)(ws + OFF_G1); const bf16_t* W = (const bf16_t*)(ws + OFF_WOUT1);
    XcdWalk wk; wk.init(256 * 4); int o;
    while (wk.next(o)) {
      int mt2, nt; tile_mn(o, 4, mt2, nt);
      const int b = mt2 >> 5, t0 = (mt2 & 31) * 256, m0 = b * TL + t0;
      const size_t orow = (size_t)b * T + t0;
      EpiResid e; e.xin = p.out + orow * 1024; e.xout = p.out + orow * 1024; e.gvec = mod + (size_t)(9 + b) * 3072 + 2048; e.n0 = nt * 256; e.scr = lds + G_EPI_SCR;
      gemm_tile<0, 256>(A, 1024, W + (size_t)nt * 256 * 1024, 1024, m0, nullptr, lds, e);
    }
  }
  grid.sync();
  phase_final(p.out, p.in[27]);
}

extern "C" void kernel_launch(void* const* d_in, const int* in_sizes, int n_in, void* d_out, int out_size, void* d_ws, size_t ws_size, hipStream_t stream) {
  static int grid_blocks = 0;
  if (grid_blocks == 0) {
    if (n_in != 28 || ws_size < WS_END + (size_t)(NTOK - LERP3_SPLIT) * 2048 || out_size != NB * T * D) { fprintf(stderr, "kernel_launch: unexpected shapes (n_in %d, ws %zu need %zu, out %d)\n", n_in, ws_size, (size_t)WS_END, out_size); grid_blocks = -1; return; }
    int dev = 0, cus = 0, per_cu = 0;
    hipGetDevice(&dev);
    hipDeviceGetAttribute(&cus, hipDeviceAttributeMultiprocessorCount, dev);
    if (hipFuncSetAttribute((const void*)fwd_megakernel, hipFuncAttributeMaxDynamicSharedMemorySize, LDS_BYTES) != hipSuccess) { fprintf(stderr, "kernel_launch: hipFuncSetAttribute failed\n"); grid_blocks = -1; return; }
    hipOccupancyMaxActiveBlocksPerMultiprocessor(&per_cu, (const void*)fwd_megakernel, NTHR, LDS_BYTES);
    if (per_cu < 1) { fprintf(stderr, "kernel_launch: occupancy query says %d blocks per CU\n", per_cu); per_cu = 1; }
    (void)hipGetLastError();
    grid_blocks = cus;
    if (grid_blocks > 256) grid_blocks = 256;
    grid_blocks &= ~7;
  }
  if (grid_blocks <= 0) return;
  Params p{};
  for (int i = 0; i < 28; ++i) p.in[i] = (const float*)d_in[i];
  p.out = (float*)d_out; p.ws = (unsigned char*)d_ws;
  void* args[] = {&p};
  hipError_t e = hipLaunchCooperativeKernel((const void*)fwd_megakernel, dim3(grid_blocks), dim3(NTHR), args, LDS_BYTES, stream);
  if (e != hipSuccess) fprintf(stderr, "cooperative launch failed: %s (grid %d)\n", hipGetErrorString(e), grid_blocks);
}
```
